# Optimizing an MI355X kernel written in HIP

```python
import math
import jax
import jax.numpy as jnp
from jax import lax
import numpy as np

D_MODEL = 1024
BATCH = 16
SEQ = 256
DEPTH = 2
DEC_BATCH = 2
DEC_SEQ = 4096
PAST_LEN = 512

GRID_W = 64
HD = 64
SCALE = 1.0 / math.sqrt(HD)
BLK = 128
H_A = 8
KV_A = 2
G_A = H_A // KV_A
WINDOW = 128
D_A = H_A * HD
D_LRU = 512
LRU_BLOCKS = 8
LRU_BW = D_LRU // LRU_BLOCKS
CONV_W = 4
LRU_C = 8.0
H_C = 4
DV_C = 2 * HD
D_C = H_C * DV_C
N_BRANCH = 3
ROPE_BASE = 10000.0
ROPE_FREQS = HD // 4
EPS = 1e-6
SPLIT_SIZES = (D_A, KV_A * HD, KV_A * HD, D_A,
               D_LRU, D_LRU,
               H_C * 2 * HD, H_C * 2 * HD, D_C, D_C,
               N_BRANCH * D_MODEL)
IN_COLS = sum(SPLIT_SIZES)

kernel_name = "hybrid_dit_swa_rglru_diffattn_step"


def rmsnorm(x, g):
    xf = x.astype(jnp.float32)
    y = xf * lax.rsqrt(jnp.mean(xf * xf, axis=-1, keepdims=True) + EPS)
    return (y * g.astype(jnp.float32)).astype(x.dtype)


def split_cols(p):
    idx = [int(v) for v in np.cumsum(SPLIT_SIZES)[:-1]]
    return jnp.split(p, idx, axis=-1)


def modulation(cvec, mod_w, mod_b):
    m = jax.nn.silu(cvec) @ mod_w + mod_b
    m = m.reshape(-1, 1, 3 * D_MODEL)
    return jnp.split(m, 3, axis=-1)


def axial_rope_tables(T):
    n_rows = T // GRID_W
    row = jnp.repeat(jnp.arange(n_rows), GRID_W).astype(jnp.float32)
    col = jnp.tile(jnp.arange(GRID_W), n_rows).astype(jnp.float32)
    inv = jnp.power(ROPE_BASE, -jnp.arange(ROPE_FREQS, dtype=jnp.float32) / ROPE_FREQS)
    ang_r = row[:, None] * inv
    ang_c = col[:, None] * inv
    return (jnp.cos(ang_r), jnp.sin(ang_r), jnp.cos(ang_c), jnp.sin(ang_c))


def _rotate(x, cos, sin):
    x1, x2 = x[..., :ROPE_FREQS], x[..., ROPE_FREQS:]
    return jnp.concatenate([x1 * cos - x2 * sin, x2 * cos + x1 * sin], axis=-1)


def apply_axial_rope(x, tabs):
    shape = (x.shape[1],) + (1,) * (x.ndim - 3) + (ROPE_FREQS,)
    cr, sr, cc, sc = [t.reshape(shape).astype(x.dtype) for t in tabs]
    return jnp.concatenate([_rotate(x[..., :HD // 2], cr, sr),
                            _rotate(x[..., HD // 2:], cc, sc)], axis=-1)


def mixer_front(x, mod, norm_g, w_in):
    shift, scale, gate = mod
    h = rmsnorm(x, norm_g) * (1 + scale) + shift
    return split_cols(h @ w_in), gate


def mixer_tail(x, gate, oa, g_a, ob, g_b, oc, g_c, merge, P):
    B, T, _ = x.shape
    m = jax.nn.sigmoid(merge).reshape(B, T, N_BRANCH, D_MODEL)
    y = (m[:, :, 0] * ((oa * jax.nn.silu(g_a)) @ P['w_br_a'])
         + m[:, :, 1] * ((ob * jax.nn.silu(g_b)) @ P['w_br_b'])
         + m[:, :, 2] * ((oc * jax.nn.silu(g_c)) @ P['w_br_c']))
    return x + gate * (y @ P['w_out'])


def attn_a_context(q, k, v, sink):
    B, T = q.shape[:2]
    nb = T // BLK
    qb = jnp.moveaxis(q.reshape(B, nb, BLK, KV_A, G_A, HD), 1, 0)
    snk = sink.astype(jnp.float32).reshape(1, KV_A, G_A, 1)

    def block(qblk):
        s = jnp.einsum('bqkgd,bskd->bkgqs', qblk, k).astype(jnp.float32) * SCALE
        m = jnp.maximum(jnp.max(s, axis=-1), snk)[..., None]
        e = jnp.exp(s - m)
        p = e / (jnp.sum(e, axis=-1, keepdims=True) + jnp.exp(snk[..., None] - m))
        return jnp.einsum('bkgqs,bskd->bqkgd', p.astype(v.dtype), v)

    o = lax.map(block, qb)
    return jnp.moveaxis(o, 0, 1).reshape(B, T, D_A)


def attn_a_latent(q, k, v, k_ctx, v_ctx, sink):
    B, T = q.shape[:2]
    nb = T // BLK
    qb = jnp.moveaxis(q.reshape(B, nb, BLK, KV_A, G_A, HD), 1, 0)

    def band(t):
        tp = jnp.pad(t, ((0, 0), (BLK, BLK), (0, 0), (0, 0))).reshape(B, nb + 2, BLK, KV_A, HD)
        w = jnp.concatenate([tp[:, :-2], tp[:, 1:-1], tp[:, 2:]], axis=2)
        return jnp.moveaxis(w, 1, 0)

    kw, vw = band(k), band(v)
    kj = jnp.arange(3 * BLK) - BLK
    rel = kj[None, :] - jnp.arange(BLK)[:, None]
    pos = jnp.arange(nb)[:, None] * BLK + kj[None, :]
    mask = (jnp.abs(rel)[None] <= WINDOW) & ((pos >= 0) & (pos < T))[:, None, :]
    snk = sink.astype(jnp.float32).reshape(1, KV_A, G_A, 1)

    def block(args):
        qblk, kblk, vblk, mblk = args
        s_w = jnp.einsum('bqkgd,bskd->bkgqs', qblk, kblk).astype(jnp.float32) * SCALE
        s_w = jnp.where(mblk, s_w, -jnp.inf)
        s_c = jnp.einsum('bqkgd,bskd->bkgqs', qblk, k_ctx).astype(jnp.float32) * SCALE
        m = jnp.maximum(jnp.maximum(jnp.max(s_w, axis=-1), jnp.max(s_c, axis=-1)), snk)[..., None]
        e_w = jnp.exp(s_w - m)
        e_c = jnp.exp(s_c - m)
        denom = (jnp.sum(e_w, axis=-1, keepdims=True) + jnp.sum(e_c, axis=-1, keepdims=True)
                 + jnp.exp(snk[..., None] - m))
        return (jnp.einsum('bkgqs,bskd->bqkgd', (e_w / denom).astype(v.dtype), vblk)
                + jnp.einsum('bkgqs,bskd->bqkgd', (e_c / denom).astype(v.dtype), v_ctx))

    o = lax.map(block, (qb, kw, vw, mask))
    return jnp.moveaxis(o, 0, 1).reshape(B, T, D_A)


def centred_conv(x, w, b):
    T = x.shape[1]
    xp = jnp.pad(x, ((0, 0), (CONV_W // 2, CONV_W - 1 - CONV_W // 2), (0, 0)))
    y = b
    for j in range(CONV_W):
        y = y + xp[:, j:j + T] * w[j]
    return y


def rglru_coeffs(x, wa, ba, wx, bx, lam):
    B, T, _ = x.shape
    xb = x.reshape(B, T, LRU_BLOCKS, LRU_BW)
    r = jax.nn.sigmoid(jnp.einsum('btnc,ncd->btnd', xb, wa).reshape(B, T, D_LRU) + ba)
    i = jax.nn.sigmoid(jnp.einsum('btnc,ncd->btnd', xb, wx).reshape(B, T, D_LRU) + bx)
    log_a = -LRU_C * r.astype(jnp.float32) * jax.nn.softplus(-lam.astype(jnp.float32))
    a = jnp.exp(log_a)
    b = jnp.sqrt(-jnp.expm1(2.0 * log_a)) * (i * x).astype(jnp.float32)
    return a, b


def linear_scan(a, b, h0, reverse):
    def combine(left, right):
        a_l, b_l = left
        a_r, b_r = right
        return a_l * a_r, a_r * b_l + b_r
    a_cum, b_cum = lax.associative_scan(combine, (a, b), axis=1, reverse=reverse)
    return a_cum * h0[:, None] + b_cum


def rglru_bidir(x, h0, P):
    y = jnp.zeros(x.shape, jnp.float32)
    finals = []
    for d in range(2):
        a, b = rglru_coeffs(x, P['lru_wa'][d], P['lru_ba'][d], P['lru_wx'][d],
                            P['lru_bx'][d], P['lru_lam'][d])
        h = linear_scan(a, b, h0[:, d].astype(jnp.float32), reverse=(d == 1))
        y = y + h
        finals.append(h[:, -1] if d == 0 else h[:, 0])
    return y.astype(x.dtype), jnp.stack(finals, axis=1).astype(x.dtype)


def diff_lambda(lq1, lk1, lq2, lk2, lam_init):
    f = lambda t: t.astype(jnp.float32)
    return jnp.exp(jnp.sum(f(lq1) * f(lk1))) - jnp.exp(jnp.sum(f(lq2) * f(lk2))) + lam_init


def diff_attn(q, k, v, lam, subln, lam_init):
    B, T = q.shape[:2]
    nb = T // BLK
    qb = jnp.moveaxis(q.reshape(B, nb, BLK, H_C, 2, HD), 1, 0)

    def block(qblk):
        s = jnp.einsum('bqhmd,bshmd->bhmqs', qblk, k).astype(jnp.float32) * SCALE
        p = jax.nn.softmax(s, axis=-1)
        pd = p[:, :, 0] - lam * p[:, :, 1]
        return jnp.einsum('bhqs,bshe->bqhe', pd.astype(v.dtype), v)

    o = jnp.moveaxis(lax.map(block, qb), 0, 1).reshape(B, T, H_C, DV_C)
    o = rmsnorm(o, subln) * (1 - lam_init)
    return o.reshape(B, T, D_C)


def project_heads(x, q_a, k_a, v_a, q_c, k_c, v_c, P):
    B, T, _ = x.shape
    q_a = rmsnorm(q_a.reshape(B, T, H_A, HD), P['qn_a'])
    k_a = rmsnorm(k_a.reshape(B, T, KV_A, HD), P['kn_a'])
    v_a = v_a.reshape(B, T, KV_A, HD)
    q_c = rmsnorm(q_c.reshape(B, T, H_C, 2, HD), P['qn_c'])
    k_c = rmsnorm(k_c.reshape(B, T, H_C, 2, HD), P['kn_c'])
    v_c = v_c.reshape(B, T, H_C, DV_C)
    return q_a, k_a, v_a, q_c, k_c, v_c


def context_layer(x, mod, P, lam, lam_init):
    (q_a, k_a, v_a, g_a, x_b, g_b, q_c, k_c, v_c, g_c, merge), gate = mixer_front(x, mod, P['norm_g'], P['w_in'])
    q_a, k_a, v_a, q_c, k_c, v_c = project_heads(x, q_a, k_a, v_a, q_c, k_c, v_c, P)
    oa = attn_a_context(q_a, k_a, v_a, P['sink_a'])
    xb = centred_conv(x_b, P['conv_w'], P['conv_b'])
    h0 = jnp.zeros((x.shape[0], 2, D_LRU), jnp.float32)
    ob, st = rglru_bidir(xb, h0, P)
    oc = diff_attn(q_c, k_c, v_c, lam, P['subln_c'], lam_init)
    x = mixer_tail(x, gate, oa, g_a, ob, g_b, oc, g_c, merge, P)
    return x, (k_a, v_a, k_c, v_c, st)


def latent_layer(x, mod, P, lam, lam_init, tabs, ck_a, cv_a, ck_c, cv_c, st):
    (q_a, k_a, v_a, g_a, x_b, g_b, q_c, k_c, v_c, g_c, merge), gate = mixer_front(x, mod, P['norm_g'], P['w_in'])
    q_a, k_a, v_a, q_c, k_c, v_c = project_heads(x, q_a, k_a, v_a, q_c, k_c, v_c, P)
    q_a, k_a = apply_axial_rope(q_a, tabs), apply_axial_rope(k_a, tabs)
    oa = attn_a_latent(q_a, k_a, v_a, ck_a, cv_a, P['sink_a'])
    xb = centred_conv(x_b, P['conv_w'], P['conv_b'])
    ob, _ = rglru_bidir(xb, st, P)
    q_c, k_c = apply_axial_rope(q_c, tabs), apply_axial_rope(k_c, tabs)
    k_all = jnp.concatenate([k_c, ck_c.astype(k_c.dtype)], axis=1)
    v_all = jnp.concatenate([v_c, cv_c.astype(v_c.dtype)], axis=1)
    oc = diff_attn(q_c, k_all, v_all, lam, P['subln_c'], lam_init)
    return mixer_tail(x, gate, oa, g_a, ob, g_b, oc, g_c, merge, P)


def setup_inputs(seed: int = 0) -> dict:
    key = jax.random.key(seed)
    ks = jax.random.split(key, 40)
    n = lambda i, shape, s: jax.random.normal(ks[i], shape, jnp.float32) * s
    u = jax.random.uniform(ks[20], (DEPTH, 2, D_LRU), jnp.float32, 0.9, 0.999)
    s_lam = jnp.power(u, 1.0 / LRU_C)
    return {
        "x_prompt": n(0, (BATCH, SEQ, D_MODEL), 1.0),
        "x_sample": n(1, (DEC_BATCH, DEC_SEQ, D_MODEL), 1.0),
        "cache_a_k": n(2, (DEC_BATCH, DEPTH, PAST_LEN, KV_A, HD), 1.0),
        "cache_a_v": n(3, (DEC_BATCH, DEPTH, PAST_LEN, KV_A, HD), 1.0),
        "cache_c_k": n(4, (DEC_BATCH, DEPTH, PAST_LEN, H_C, 2, HD), 1.0),
        "cache_c_v": n(5, (DEC_BATCH, DEPTH, PAST_LEN, H_C, DV_C), 1.0),
        "state_lru": n(6, (DEC_BATCH, DEPTH, 2, D_LRU), 0.5),
        "c": n(7, (DEC_BATCH, D_MODEL), 1.0),
        "c_ctx": n(8, (D_MODEL,), 1.0),
        "norm_g": 1.0 + n(9, (DEPTH, D_MODEL), 0.02),
        "mod_w": n(10, (DEPTH, D_MODEL, 3 * D_MODEL), D_MODEL ** -0.5),
        "mod_b": n(11, (DEPTH, 3 * D_MODEL), 0.01),
        "w_in": n(12, (DEPTH, D_MODEL, IN_COLS), D_MODEL ** -0.5),
        "qn_a": 1.0 + n(13, (DEPTH, HD), 0.02),
        "kn_a": 1.0 + n(14, (DEPTH, HD), 0.02),
        "sink_a": n(15, (DEPTH, H_A), 0.5),
        "conv_w": n(16, (DEPTH, CONV_W, D_LRU), CONV_W ** -0.5),
        "conv_b": n(17, (DEPTH, D_LRU), 0.01),
        "lru_wa": n(18, (DEPTH, 2, LRU_BLOCKS, LRU_BW, LRU_BW), LRU_BW ** -0.5),
        "lru_ba": n(19, (DEPTH, 2, D_LRU), 0.01),
        "lru_wx": n(21, (DEPTH, 2, LRU_BLOCKS, LRU_BW, LRU_BW), LRU_BW ** -0.5),
        "lru_bx": n(22, (DEPTH, 2, D_LRU), 0.01),
        "lru_lam": jnp.log(s_lam) - jnp.log1p(-s_lam),
        "qn_c": 1.0 + n(23, (DEPTH, HD), 0.02),
        "kn_c": 1.0 + n(24, (DEPTH, HD), 0.02),
        "lam_q1": n(25, (DEPTH, HD), 0.1),
        "lam_k1": n(26, (DEPTH, HD), 0.1),
        "lam_q2": n(27, (DEPTH, HD), 0.1),
        "lam_k2": n(28, (DEPTH, HD), 0.1),
        "subln_c": 1.0 + n(29, (DEPTH, DV_C), 0.02),
        "w_br_a": n(30, (DEPTH, D_A, D_MODEL), D_A ** -0.5),
        "w_br_b": n(31, (DEPTH, D_LRU, D_MODEL), D_LRU ** -0.5),
        "w_br_c": n(32, (DEPTH, D_C, D_MODEL), D_C ** -0.5),
        "w_out": n(33, (DEPTH, D_MODEL, D_MODEL), D_MODEL ** -0.5),
    }


def reference(x_prompt, x_sample, cache_a_k, cache_a_v, cache_c_k, cache_c_v, state_lru,
              c, c_ctx, norm_g, mod_w, mod_b, w_in, qn_a, kn_a, sink_a, conv_w, conv_b,
              lru_wa, lru_ba, lru_wx, lru_bx, lru_lam, qn_c, kn_c, lam_q1, lam_k1,
              lam_q2, lam_k2, subln_c, w_br_a, w_br_b, w_br_c, w_out):
    tabs = axial_rope_tables(x_sample.shape[1])
    xp, xs = x_prompt, x_sample
    ka_l, va_l, kc_l, vc_l, st_l = [], [], [], [], []
    for l in range(DEPTH):
        P = {'norm_g': norm_g[l], 'w_in': w_in[l], 'qn_a': qn_a[l], 'kn_a': kn_a[l],
             'sink_a': sink_a[l], 'conv_w': conv_w[l], 'conv_b': conv_b[l],
             'lru_wa': lru_wa[l], 'lru_ba': lru_ba[l], 'lru_wx': lru_wx[l],
             'lru_bx': lru_bx[l], 'lru_lam': lru_lam[l], 'qn_c': qn_c[l], 'kn_c': kn_c[l],
             'subln_c': subln_c[l], 'w_br_a': w_br_a[l], 'w_br_b': w_br_b[l],
             'w_br_c': w_br_c[l], 'w_out': w_out[l]}
        lam_init = 0.8 - 0.6 * math.exp(-0.3 * l)
        lam = diff_lambda(lam_q1[l], lam_k1[l], lam_q2[l], lam_k2[l], lam_init)
        xp, (ka, va, kc, vc, st) = context_layer(xp, modulation(c_ctx, mod_w[l], mod_b[l]), P, lam, lam_init)
        ka_l.append(ka)
        va_l.append(va)
        kc_l.append(kc)
        vc_l.append(vc)
        st_l.append(st)
        xs = latent_layer(xs, modulation(c, mod_w[l], mod_b[l]), P, lam, lam_init, tabs,
                          cache_a_k[:, l], cache_a_v[:, l], cache_c_k[:, l], cache_c_v[:, l],
                          state_lru[:, l])
    return (xp, xs, jnp.stack(ka_l, axis=1), jnp.stack(va_l, axis=1), jnp.stack(kc_l, axis=1),
            jnp.stack(vc_l, axis=1), jnp.stack(st_l, axis=1))
```

```cpp
#include <hip/hip_runtime.h>
#include <hip/hip_cooperative_groups.h>
#include <stdint.h>
#include <math.h>
namespace cg = cooperative_groups;

typedef unsigned short u16;
typedef __attribute__((ext_vector_type(8))) short bf16x8;
typedef __attribute__((ext_vector_type(4))) short bf16x4;
typedef __attribute__((ext_vector_type(16))) float f32x16;

#define NT 256
constexpr int DM = 1024, NTOK = 12288, NCTX = 4096;
constexpr int INC = 7424;
constexpr int PP = 6784;
constexpr int C_QA = 0, C_KA = 512, C_GA = 640, C_XB = 1152, C_GB = 1664, C_QC = 2176, C_KC = 2688, C_GC = 3200, C_MG = 3712;
constexpr int LROW = 72;
constexpr int VROW = 68;
constexpr int FROW = 132;
constexpr int TROW = 136;
constexpr float EPS = 1e-6f;
constexpr int SMEM_BYTES = 2 * 256 * LROW * 2;

constexpr size_t O_X = 0, O_KA = 12582912, O_VA = 13631488, O_KC = 14680064, O_VC = 18874368, O_ST = 23068672;

struct Params {
  const float *x_prompt, *x_sample, *cache_a_k, *cache_a_v, *cache_c_k, *cache_c_v, *state_lru, *c, *c_ctx,
      *norm_g, *mod_w, *mod_b, *w_in, *qn_a, *kn_a, *sink_a, *conv_w, *conv_b, *lru_wa, *lru_ba, *lru_wx, *lru_bx,
      *lru_lam, *qn_c, *kn_c, *lam_q1, *lam_k1, *lam_q2, *lam_k2, *subln_c, *w_br_a, *w_br_b, *w_br_c, *w_out;
  float* out;
  u16 *Wt_in, *Wt_br, *Wt_out, *H, *P, *VtA_ctx, *VtA_lat, *VtC_ctx, *VtC_lat, *cKa, *cVtA, *cKc, *cVtC;
  float *mod, *rope, *lruTot;
  int phase_lo, phase_hi;
};

__device__ __forceinline__ u16 f2bf(float f) {
  uint32_t u = __float_as_uint(f);
  u += 0x7FFFu + ((u >> 16) & 1u);
  return (u16)(u >> 16);
}
__device__ __forceinline__ float bf2f(u16 h) { return __uint_as_float(((uint32_t)h) << 16); }
__device__ __forceinline__ uint32_t pack2(float a, float b) { return (uint32_t)f2bf(a) | ((uint32_t)f2bf(b) << 16); }
__device__ __forceinline__ float sigmoidf_(float x) { return 1.f / (1.f + __expf(-x)); }
__device__ __forceinline__ float siluf_(float x) { return x / (1.f + __expf(-x)); }
__device__ __forceinline__ f32x16 mfma32(bf16x8 a, bf16x8 b, f32x16 c) {
  return __builtin_amdgcn_mfma_f32_32x32x16_bf16(a, b, c, 0, 0, 0);
}

__device__ void transpose_tile(const float* __restrict__ src, int spitch, u16* __restrict__ dst, int dpitch,
                               int r0, int c0, float* sm) {
  const int tid = threadIdx.x;
#pragma unroll
  for (int i = 0; i < 4; i++) {
    int c = tid + i * NT; int r = c >> 4, q = c & 15;
    float4 v = *(const float4*)(src + (size_t)(r0 + r) * spitch + c0 + q * 4);
    float* d = sm + r * 65 + q * 4;
    d[0] = v.x; d[1] = v.y; d[2] = v.z; d[3] = v.w;
  }
  __syncthreads();
#pragma unroll
  for (int i = 0; i < 2; i++) {
    int c = tid + i * NT; int cc = c >> 3, q = c & 7;
    uint32_t w[4];
#pragma unroll
    for (int j = 0; j < 4; j++) w[j] = pack2(sm[(q * 8 + 2 * j) * 65 + cc], sm[(q * 8 + 2 * j + 1) * 65 + cc]);
    uint4 v; v.x = w[0]; v.y = w[1]; v.z = w[2]; v.w = w[3];
    *(uint4*)(dst + (size_t)(c0 + cc) * dpitch + r0 + q * 8) = v;
  }
  __syncthreads();
}

__device__ void mod_item(const Params& p, int it, float* sm) {
  const int tid = threadIdx.x;
  const int l = it / 48, n0 = (it % 48) * 64;
  float* sv = sm;
  float* red = sm + 3072;
  for (int e = tid; e < 3072; e += NT) {
    int v = e >> 10, k = e & 1023;
    float x = (v == 0) ? p.c_ctx[k] : p.c[(v - 1) * 1024 + k];
    sv[e] = siluf_(x);
  }
  __syncthreads();
  const int col = tid & 63, kg = tid >> 6;
  const float* w = p.mod_w + (size_t)l * 1024 * 3072 + n0 + col;
  float a0 = 0, a1 = 0, a2 = 0;
#pragma unroll 8
  for (int k = kg * 256; k < kg * 256 + 256; k++) {
    float wv = w[(size_t)k * 3072];
    a0 += sv[k] * wv; a1 += sv[1024 + k] * wv; a2 += sv[2048 + k] * wv;
  }
  red[(kg * 3 + 0) * 64 + col] = a0; red[(kg * 3 + 1) * 64 + col] = a1; red[(kg * 3 + 2) * 64 + col] = a2;
  __syncthreads();
  if (tid < 192) {
    int v = tid >> 6, c = tid & 63;
    float s = p.mod_b[l * 3072 + n0 + c];
#pragma unroll
    for (int g = 0; g < 4; g++) s += red[(g * 3 + v) * 64 + c];
    p.mod[(l * 3 + v) * 3072 + n0 + c] = s;
  }
  __syncthreads();
}

__device__ void prologue_phase(const Params& p, float* sm) {
  constexpr int N_MOD = 96, N_ROPE = 1, N_WIN = 2 * 16 * 116, N_WBR = 6 * 8 * 16, N_WOUT = 2 * 16 * 16;
  constexpr int N_CK = 128 + 512, N_CVA = 4 * 16, N_CVC = 4 * 64;
  constexpr int E0 = N_MOD, E1 = E0 + N_ROPE, E2 = E1 + N_WIN, E3 = E2 + N_WBR, E4 = E3 + N_WOUT, E5 = E4 + N_CK,
                E6 = E5 + N_CVA, E7 = E6 + N_CVC;
  const int tid = threadIdx.x;
  for (int it = blockIdx.x; it < E7; it += gridDim.x) {
    if (it < E0) {
      mod_item(p, it, sm);
    } else if (it < E1) {
      for (int e = tid; e < 1024; e += NT) {
        int pos = e >> 4, f = e & 15;
        float inv = powf(10000.f, -(float)f / 16.f);
        float ang = (float)pos * inv;
        p.rope[e] = cosf(ang); p.rope[1024 + e] = sinf(ang);
      }
    } else if (it < E2) {
      int j = it - E1; int l = j / (16 * 116); int r = j % (16 * 116);
      int kt = r / 116, nt = r % 116;
      transpose_tile(p.w_in + (size_t)l * 1024 * INC, INC, p.Wt_in + (size_t)l * INC * 1024, 1024, kt * 64, nt * 64, sm);
    } else if (it < E3) {
      int j = it - E2; int m = j / 128; int r = j % 128;
      int l = m / 3, i = m % 3;
      const float* src = (i == 0 ? p.w_br_a : (i == 1 ? p.w_br_b : p.w_br_c)) + (size_t)l * 512 * 1024;
      int kt = r / 16, nt = r % 16;
      transpose_tile(src, 1024, p.Wt_br + (size_t)m * 1024 * 512, 512, kt * 64, nt * 64, sm);
    } else if (it < E4) {
      int j = it - E3; int l = j / 256; int r = j % 256;
      int kt = r / 16, nt = r % 16;
      transpose_tile(p.w_out + (size_t)l * 1024 * 1024, 1024, p.Wt_out + (size_t)l * 1024 * 1024, 1024, kt * 64, nt * 64, sm);
    } else if (it < E5) {
      int j = it - E4;
      const float* src; u16* dst; size_t off;
      if (j < 128) { src = p.cache_a_k; dst = p.cKa; off = (size_t)j * 2048; }
      else { src = p.cache_c_k; dst = p.cKc; off = (size_t)(j - 128) * 2048; }
      size_t e = off + (size_t)tid * 8;
      float4 a = *(const float4*)(src + e), b = *(const float4*)(src + e + 4);
      uint4 v; v.x = pack2(a.x, a.y); v.y = pack2(a.z, a.w); v.z = pack2(b.x, b.y); v.w = pack2(b.z, b.w);
      *(uint4*)(dst + e) = v;
    } else if (it < E6) {
      int j = it - E5; int bl = j / 16; int r = j % 16;
      int rt = r / 2, ct = r % 2;
      transpose_tile(p.cache_a_v + (size_t)bl * 512 * 128, 128, p.cVtA + (size_t)bl * 128 * 512, 512, rt * 64, ct * 64, sm);
    } else {
      int j = it - E6; int bl = j / 64; int r = j % 64;
      int rt = r / 8, ct = r % 8;
      transpose_tile(p.cache_c_v + (size_t)bl * 512 * 512, 512, p.cVtC + (size_t)bl * 512 * 512, 512, rt * 64, ct * 64, sm);
    }
  }
}

__device__ void norm_phase(const Params& p, int l) {
  const int tid = threadIdx.x, lane = tid & 63, wid = tid >> 6;
  const float* g = p.norm_g + l * 1024;
  for (int it = blockIdx.x; it < NTOK / 4; it += gridDim.x) {
    int row = it * 4 + wid;
    const float* x;
    if (l == 0) x = (row < NCTX) ? p.x_prompt + (size_t)row * 1024 : p.x_sample + (size_t)(row - NCTX) * 1024;
    else x = p.out + O_X + (size_t)row * 1024;
    int v = (row < NCTX) ? 0 : 1 + (row - NCTX) / 4096;
    const float* md = p.mod + (l * 3 + v) * 3072;
    float4 xv[4]; float ss = 0;
#pragma unroll
    for (int i = 0; i < 4; i++) {
      xv[i] = *(const float4*)(x + i * 256 + lane * 4);
      ss += xv[i].x * xv[i].x + xv[i].y * xv[i].y + xv[i].z * xv[i].z + xv[i].w * xv[i].w;
    }
#pragma unroll
    for (int o = 32; o > 0; o >>= 1) ss += __shfl_xor(ss, o);
    float rinv = rsqrtf(ss * (1.f / 1024.f) + EPS);
#pragma unroll
    for (int i = 0; i < 4; i++) {
      int c = i * 256 + lane * 4;
      float4 gv = *(const float4*)(g + c), sh = *(const float4*)(md + c), sc = *(const float4*)(md + 1024 + c);
      float h0 = xv[i].x * rinv * gv.x * (1.f + sc.x) + sh.x;
      float h1 = xv[i].y * rinv * gv.y * (1.f + sc.y) + sh.y;
      float h2 = xv[i].z * rinv * gv.z * (1.f + sc.z) + sh.z;
      float h3 = xv[i].w * rinv * gv.w * (1.f + sc.w) + sh.w;
      uint2 o2; o2.x = pack2(h0, h1); o2.y = pack2(h2, h3);
      *(uint2*)(p.H + (size_t)row * 1024 + c) = o2;
    }
  }
}

__device__ __forceinline__ void gemm_core(const u16* __restrict__ A, int lda, const u16* __restrict__ Bt, int ldb,
                                          int K, u16* smem, f32x16 (&acc)[2][2]) {
  const int tid = threadIdx.x, lane = tid & 63, wid = tid >> 6, wr = wid >> 1, wc = wid & 1;
  const int r = lane & 31, h = lane >> 5;
  uint4 ra[4], rb[4];
  const int srow = tid >> 3, skc = tid & 7;
  const u16* ap = A + (size_t)srow * lda + skc * 8;
  const u16* bp = Bt + (size_t)srow * ldb + skc * 8;
  const int nk = K >> 6;
#pragma unroll
  for (int i = 0; i < 4; i++) {
    ra[i] = *(const uint4*)(ap + (size_t)i * 32 * lda);
    rb[i] = *(const uint4*)(bp + (size_t)i * 32 * ldb);
  }
  {
    u16* sa = smem; u16* sb = smem + 128 * LROW;
#pragma unroll
    for (int i = 0; i < 4; i++) {
      *(uint4*)(sa + (srow + i * 32) * LROW + skc * 8) = ra[i];
      *(uint4*)(sb + (srow + i * 32) * LROW + skc * 8) = rb[i];
    }
  }
  __syncthreads();
  for (int kt = 0; kt < nk; kt++) {
    const bool more = (kt + 1 < nk);
    if (more) {
#pragma unroll
      for (int i = 0; i < 4; i++) {
        ra[i] = *(const uint4*)(ap + (size_t)i * 32 * lda + (kt + 1) * 64);
        rb[i] = *(const uint4*)(bp + (size_t)i * 32 * ldb + (kt + 1) * 64);
      }
    }
    const u16* sa = smem + (kt & 1) * (256 * LROW);
    const u16* sb = sa + 128 * LROW;
#pragma unroll
    for (int ks = 0; ks < 4; ks++) {
      bf16x8 af[2], bfr[2];
#pragma unroll
      for (int mt = 0; mt < 2; mt++) af[mt] = *(const bf16x8*)(sa + (wr * 64 + mt * 32 + r) * LROW + ks * 16 + h * 8);
#pragma unroll
      for (int nt = 0; nt < 2; nt++) bfr[nt] = *(const bf16x8*)(sb + (wc * 64 + nt * 32 + r) * LROW + ks * 16 + h * 8);
#pragma unroll
      for (int mt = 0; mt < 2; mt++)
#pragma unroll
        for (int nt = 0; nt < 2; nt++) acc[mt][nt] = mfma32(af[mt], bfr[nt], acc[mt][nt]);
    }
    if (more) {
      u16* wa = smem + ((kt + 1) & 1) * (256 * LROW); u16* wb = wa + 128 * LROW;
#pragma unroll
      for (int i = 0; i < 4; i++) {
        *(uint4*)(wa + (srow + i * 32) * LROW + skc * 8) = ra[i];
        *(uint4*)(wb + (srow + i * 32) * LROW + skc * 8) = rb[i];
      }
    }
    __syncthreads();
  }
}

__device__ __forceinline__ void acc_to_lds(float* Tf, const f32x16 (&acc)[2][2], int wr, int wc, int r, int h) {
#pragma unroll
  for (int mt = 0; mt < 2; mt++)
#pragma unroll
    for (int nt = 0; nt < 2; nt++)
#pragma unroll
      for (int e = 0; e < 16; e++) {
        const int rl = wr * 64 + mt * 32 + (e & 3) + 8 * (e >> 2) + 4 * h;
        Tf[rl * FROW + wc * 64 + nt * 32 + r] = acc[mt][nt][e];
      }
}

__device__ void inproj_phase(const Params& p, int l, u16* smem) {
  const int tid = threadIdx.x, lane = tid & 63, wid = tid >> 6, wr = wid >> 1, wc = wid & 1;
  const int r = lane & 31, h = lane >> 5;
  constexpr int NMT = NTOK / 128, NNT = INC / 128, GM = 16;
  for (int it = blockIdx.x; it < NMT * NNT; it += gridDim.x) {
    int grp = it / (GM * NNT), rem = it % (GM * NNT);
    int mt_ = grp * GM + (rem % GM), nt_ = rem / GM;
    const int m0 = mt_ * 128, n0 = nt_ * 128;
    f32x16 acc[2][2];
#pragma unroll
    for (int a = 0; a < 2; a++)
#pragma unroll
      for (int b = 0; b < 2; b++)
#pragma unroll
        for (int e = 0; e < 16; e++) acc[a][b][e] = 0.f;
    gemm_core(p.H + (size_t)m0 * 1024, 1024, p.Wt_in + ((size_t)l * INC + n0) * 1024, 1024, 1024, smem, acc);

    const bool isctx = (m0 < NCTX);
    float* Tf = (float*)smem;
    acc_to_lds(Tf, acc, wr, wc, r, h);
    __syncthreads();
    if (n0 == 640 || (n0 >= 3328 && n0 < 3840)) {
      const bool isA = (n0 == 640);
#pragma unroll 2
      for (int i = 0; i < 8; i++) {
        int c = tid + i * NT; int col = c & 127, rg = c >> 7;
        float v[8];
#pragma unroll
        for (int j = 0; j < 8; j++) v[j] = Tf[(rg * 8 + j) * FROW + col];
        uint4 pk; pk.x = pack2(v[0], v[1]); pk.y = pack2(v[2], v[3]); pk.z = pack2(v[4], v[5]); pk.w = pack2(v[6], v[7]);
        int row = m0 + rg * 8;
        u16* dst;
        if (isctx) {
          int b = row >> 8, t = row & 255;
          dst = isA ? p.VtA_ctx + ((size_t)(b * 128 + col)) * 256 + t
                    : p.VtC_ctx + ((size_t)(b * 512 + (n0 - 3328) + col)) * 256 + t;
        } else {
          int rr = row - NCTX; int b = rr >> 12, t = rr & 4095;
          dst = isA ? p.VtA_lat + ((size_t)(b * 128 + col)) * 4096 + t
                    : p.VtC_lat + ((size_t)(b * 512 + (n0 - 3328) + col)) * 4096 + t;
        }
        *(uint4*)dst = pk;
      }
      if (isctx) {
#pragma unroll 4
        for (int i = 0; i < 16; i++) {
          int c = tid + i * NT; int row = c >> 5, q = c & 31;
          float4 v = *(const float4*)(Tf + row * FROW + q * 4);
          int grow = m0 + row; int b = grow >> 8, t = grow & 255;
          float* dst = isA ? p.out + O_VA + ((size_t)(b * 2 + l) * 256 + t) * 128 + q * 4
                           : p.out + O_VC + ((size_t)(b * 2 + l) * 256 + t) * 512 + (n0 - 3328) + q * 4;
          *(float4*)dst = v;
        }
      }
    } else {
      const int pcb = (n0 < 640) ? n0 : (n0 < 3328 ? n0 - 128 : n0 - 640);
      const bool is_qa = n0 < 512, is_ka = (n0 == 512);
      const bool is_qc = (n0 >= 2304 && n0 < 2816), is_kc = (n0 >= 2816 && n0 < 3328);
      const bool qk = is_qa || is_ka || is_qc || is_kc;
      const int mode = (n0 >= 4352) ? 2 : ((n0 >= 1280 && n0 < 1792) ? 0 : 1);
      const float* gn = (is_qa ? p.qn_a : is_ka ? p.kn_a : is_qc ? p.qn_c : p.kn_c) + l * 64;
      const float qs = (is_qa || is_qc) ? 0.125f : 1.f;
#pragma unroll 2
      for (int i = 0; i < 8; i++) {
        int c = tid + i * NT; int row = c >> 4, j16 = c & 15;
        float v[8];
        {
          float4 a = *(const float4*)(Tf + row * FROW + j16 * 8), bq = *(const float4*)(Tf + row * FROW + j16 * 8 + 4);
          v[0] = a.x; v[1] = a.y; v[2] = a.z; v[3] = a.w; v[4] = bq.x; v[5] = bq.y; v[6] = bq.z; v[7] = bq.w;
        }
        const int grow = m0 + row;
        if (qk) {
          float ss = 0.f;
#pragma unroll
          for (int k = 0; k < 8; k++) ss += v[k] * v[k];
          ss += __shfl_xor(ss, 1); ss += __shfl_xor(ss, 2); ss += __shfl_xor(ss, 4);
          const float rinv = rsqrtf(ss * (1.f / 64.f) + EPS);
          const int j = j16 & 7;
          float4 ga = *(const float4*)(gn + j * 8), gb = *(const float4*)(gn + j * 8 + 4);
          v[0] *= rinv * ga.x; v[1] *= rinv * ga.y; v[2] *= rinv * ga.z; v[3] *= rinv * ga.w;
          v[4] *= rinv * gb.x; v[5] *= rinv * gb.y; v[6] *= rinv * gb.z; v[7] *= rinv * gb.w;
          if (!isctx) {
            int t = (grow - NCTX) & 4095;
            int pos = (j < 4) ? (t >> 6) : (t & 63);
            const float* ct = p.rope + pos * 16 + (j & 1) * 8;
            float4 c0 = *(const float4*)ct, c1 = *(const float4*)(ct + 4);
            float4 s0 = *(const float4*)(ct + 1024), s1 = *(const float4*)(ct + 1028);
            float cs[8] = {c0.x, c0.y, c0.z, c0.w, c1.x, c1.y, c1.z, c1.w};
            float sn[8] = {s0.x, s0.y, s0.z, s0.w, s1.x, s1.y, s1.z, s1.w};
            const float sg = (j & 2) ? 1.f : -1.f;
#pragma unroll
            for (int k = 0; k < 8; k++) {
              float pv = __shfl_xor(v[k], 2);
              v[k] = v[k] * cs[k] + sg * pv * sn[k];
            }
          } else if (is_ka || is_kc) {
            int b = grow >> 8, t = grow & 255;
            float* dst = is_ka ? p.out + O_KA + ((size_t)(b * 2 + l) * 256 + t) * 128 + j16 * 8
                               : p.out + O_KC + ((size_t)(b * 2 + l) * 256 + t) * 512 + (n0 - 2816) + j16 * 8;
            *(float4*)dst = make_float4(v[0], v[1], v[2], v[3]);
            *(float4*)(dst + 4) = make_float4(v[4], v[5], v[6], v[7]);
          }
#pragma unroll
          for (int k = 0; k < 8; k++) v[k] *= qs;
        } else if (mode == 1) {
#pragma unroll
          for (int k = 0; k < 8; k++) v[k] = siluf_(v[k]);
        } else if (mode == 2) {
#pragma unroll
          for (int k = 0; k < 8; k++) v[k] = sigmoidf_(v[k]);
        }
        uint4 pk; pk.x = pack2(v[0], v[1]); pk.y = pack2(v[2], v[3]); pk.z = pack2(v[4], v[5]); pk.w = pack2(v[6], v[7]);
        *(uint4*)(p.P + (size_t)grow * PP + pcb + j16 * 8) = pk;
      }
    }
    __syncthreads();
  }
}

__device__ __forceinline__ void stage_k(u16* dst, const u16* __restrict__ src, size_t pitch, int r0, int nrows) {
  const int tid = threadIdx.x;
#pragma unroll
  for (int i = 0; i < 2; i++) {
    int c = tid + i * NT; int row = c >> 3, kc = c & 7; int rr = r0 + row;
    uint4 v = make_uint4(0, 0, 0, 0);
    if (rr >= 0 && rr < nrows) v = *(const uint4*)(src + (size_t)rr * pitch + kc * 8);
    *(uint4*)(dst + row * LROW + kc * 8) = v;
  }
}
template <int DV>
__device__ __forceinline__ void stage_vt(u16* dst, const u16* __restrict__ src, int T, int k0) {
  const int tid = threadIdx.x;
#pragma unroll
  for (int i = 0; i < DV / 32; i++) {
    int c = tid + i * NT; int d = c >> 3, kc = c & 7; int k = k0 + kc * 8;
    uint4 v = make_uint4(0, 0, 0, 0);
    if (k >= 0 && k < T) v = *(const uint4*)(src + (size_t)d * T + k);
    uint2* q = (uint2*)(dst + d * VROW + kc * 8);
    q[0] = make_uint2(v.x, v.y); q[1] = make_uint2(v.z, v.w);
  }
}

template <int DV, bool MASK>
__device__ __forceinline__ void flash_step(const u16* Ks, const u16* Vts, const bf16x8 (&qf)[4], float& m, float& l,
                                           f32x16 (&o)[DV / 32], int lane, int kpos0, int qpos, int T) {
  const int r = lane & 31, h = lane >> 5;
  f32x16 s[2];
#pragma unroll
  for (int sub = 0; sub < 2; sub++) {
#pragma unroll
    for (int e = 0; e < 16; e++) s[sub][e] = 0.f;
#pragma unroll
    for (int ks = 0; ks < 4; ks++) {
      bf16x8 kf = *(const bf16x8*)(Ks + (sub * 32 + r) * LROW + ks * 16 + h * 8);
      s[sub] = mfma32(kf, qf[ks], s[sub]);
    }
  }
  if (MASK) {
#pragma unroll
    for (int sub = 0; sub < 2; sub++)
#pragma unroll
      for (int e = 0; e < 16; e++) {
        int kp = kpos0 + sub * 32 + (e & 3) + 8 * (e >> 2) + 4 * h;
        int dlt = kp - qpos;
        bool ok = (kp >= 0) && (kp < T) && (dlt <= 128) && (dlt >= -128);
        if (!ok) s[sub][e] = -INFINITY;
      }
  }
  float mx = s[0][0];
#pragma unroll
  for (int sub = 0; sub < 2; sub++)
#pragma unroll
    for (int e = 0; e < 16; e++) mx = fmaxf(mx, s[sub][e]);
  mx = fmaxf(mx, __shfl_xor(mx, 32));
  const float mn = fmaxf(m, mx);
  const float alpha = __expf(m - mn);
  float sum = 0.f;
#pragma unroll
  for (int sub = 0; sub < 2; sub++)
#pragma unroll
    for (int e = 0; e < 16; e++) { float pv = __expf(s[sub][e] - mn); s[sub][e] = pv; sum += pv; }
  sum += __shfl_xor(sum, 32);
  l = l * alpha + sum; m = mn;
#pragma unroll
  for (int ds = 0; ds < DV / 32; ds++)
#pragma unroll
    for (int e = 0; e < 16; e++) o[ds][e] *= alpha;
#pragma unroll
  for (int sub = 0; sub < 2; sub++)
#pragma unroll
    for (int st = 0; st < 2; st++) {
      bf16x8 pf;
#pragma unroll
      for (int j = 0; j < 8; j++) pf[j] = (short)f2bf(s[sub][8 * st + j]);
#pragma unroll
      for (int ds = 0; ds < DV / 32; ds++) {
        const u16* vp = Vts + (ds * 32 + r) * VROW + sub * 32 + 16 * st + 4 * h;
        bf16x4 lo = *(const bf16x4*)vp, hi = *(const bf16x4*)(vp + 8);
        bf16x8 vf = __builtin_shufflevector(lo, hi, 0, 1, 2, 3, 4, 5, 6, 7);
        o[ds] = mfma32(vf, pf, o[ds]);
      }
    }
}

__device__ void attnA_item(const Params& p, int l, int it, u16* sm) {
  const int tid = threadIdx.x, lane = tid & 63, wid = tid >> 6;
  const int r = lane & 31, h = lane >> 5;
  const bool isctx = it < 256;
  int b, kvh, qb, T, rowbase; const u16* VtBase;
  if (isctx) { b = it >> 4; kvh = (it >> 3) & 1; qb = it & 7; T = 256; rowbase = b * 256;
    VtBase = p.VtA_ctx + ((size_t)(b * 2 + kvh) * 64) * 256; }
  else { int j = it - 256; b = j >> 8; kvh = (j >> 7) & 1; qb = j & 127; T = 4096; rowbase = NCTX + b * 4096;
    VtBase = p.VtA_lat + ((size_t)(b * 2 + kvh) * 64) * 4096; }
  const int q0 = qb * 32;
  const int head = kvh * 4 + wid;
  const size_t prow = (size_t)(rowbase + q0 + r) * PP;
  bf16x8 qf[4];
#pragma unroll
  for (int ks = 0; ks < 4; ks++) qf[ks] = *(const bf16x8*)(p.P + prow + C_QA + head * 64 + ks * 16 + h * 8);
  float m = p.sink_a[l * 8 + head], ls = 1.f;
  f32x16 o[2];
#pragma unroll
  for (int ds = 0; ds < 2; ds++)
#pragma unroll
    for (int e = 0; e < 16; e++) o[ds][e] = 0.f;
  u16* Ks = sm; u16* Vts = sm + 64 * LROW;
  const u16* Kbase = p.P + (size_t)rowbase * PP + C_KA + kvh * 64;
  const int qpos = q0 + r;
  if (isctx) {
    for (int kt = 0; kt < 4; kt++) {
      __syncthreads();
      stage_k(Ks, Kbase, PP, kt * 64, T); stage_vt<64>(Vts, VtBase, T, kt * 64);
      __syncthreads();
      flash_step<64, false>(Ks, Vts, qf, m, ls, o, lane, 0, 0, T);
    }
  } else {
    for (int i = 0; i < 5; i++) {
      int k0 = q0 - 128 + 64 * i;
      if (k0 + 63 < 0 || k0 >= T) continue;
      __syncthreads();
      stage_k(Ks, Kbase, PP, k0, T); stage_vt<64>(Vts, VtBase, T, k0);
      __syncthreads();
      flash_step<64, true>(Ks, Vts, qf, m, ls, o, lane, k0, qpos, T);
    }
    const u16* cK = p.cKa + ((size_t)(b * 2 + l) * 512) * 128 + kvh * 64;
    const u16* cVt = p.cVtA + ((size_t)((b * 2 + l) * 2 + kvh) * 64) * 512;
    for (int kt = 0; kt < 8; kt++) {
      __syncthreads();
      stage_k(Ks, cK, 128, kt * 64, 512); stage_vt<64>(Vts, cVt, 512, kt * 64);
      __syncthreads();
      flash_step<64, false>(Ks, Vts, qf, m, ls, o, lane, 0, 0, 512);
    }
  }
  const float inv = 1.f / ls;
#pragma unroll
  for (int ds = 0; ds < 2; ds++)
#pragma unroll
    for (int g = 0; g < 4; g++) {
      int d = ds * 32 + 8 * g + 4 * h;
      uint2 gv = *(const uint2*)(p.P + prow + C_GA + head * 64 + d);
      float g0 = bf2f((u16)(gv.x & 0xffff)), g1 = bf2f((u16)(gv.x >> 16)), g2 = bf2f((u16)(gv.y & 0xffff)), g3 = bf2f((u16)(gv.y >> 16));
      uint2 ov;
      ov.x = pack2(o[ds][4 * g] * inv * g0, o[ds][4 * g + 1] * inv * g1);
      ov.y = pack2(o[ds][4 * g + 2] * inv * g2, o[ds][4 * g + 3] * inv * g3);
      *(uint2*)(p.P + prow + C_QA + head * 64 + d) = ov;
    }
}

__device__ void attnC_item(const Params& p, int l, int it, u16* sm, float lam, float lam_init) {
  const int tid = threadIdx.x, lane = tid & 63, wid = tid >> 6;
  const int r = lane & 31, h = lane >> 5;
  const bool isctx = it < 256;
  int b, hd, qb, T, rowbase; const u16* VtBase;
  if (isctx) { b = it >> 4; hd = (it >> 2) & 3; qb = it & 3; T = 256; rowbase = b * 256;
    VtBase = p.VtC_ctx + ((size_t)(b * 4 + hd) * 128) * 256; }
  else { int j = it - 256; b = j >> 8; hd = (j >> 6) & 3; qb = j & 63; T = 4096; rowbase = NCTX + b * 4096;
    VtBase = p.VtC_lat + ((size_t)(b * 4 + hd) * 128) * 4096; }
  const int qg = wid & 1, map = wid >> 1;
  const int q0 = qb * 64 + qg * 32;
  const size_t prow = (size_t)(rowbase + q0 + r) * PP;
  bf16x8 qf[4];
#pragma unroll
  for (int ks = 0; ks < 4; ks++) qf[ks] = *(const bf16x8*)(p.P + prow + C_QC + hd * 128 + map * 64 + ks * 16 + h * 8);
  float m = -1e30f, ls = 0.f;
  f32x16 o[4];
#pragma unroll
  for (int ds = 0; ds < 4; ds++)
#pragma unroll
    for (int e = 0; e < 16; e++) o[ds][e] = 0.f;
  u16* K0s = sm; u16* K1s = sm + 64 * LROW; u16* Vts = sm + 128 * LROW;
  const u16* Kme = map ? K1s : K0s;
  const u16* Kbase = p.P + (size_t)rowbase * PP + C_KC + hd * 128;
  const int ntl = T / 64;
  for (int kt = 0; kt < ntl; kt++) {
    __syncthreads();
    stage_k(K0s, Kbase, PP, kt * 64, T); stage_k(K1s, Kbase + 64, PP, kt * 64, T);
    stage_vt<128>(Vts, VtBase, T, kt * 64);
    __syncthreads();
    flash_step<128, false>(Kme, Vts, qf, m, ls, o, lane, 0, 0, T);
  }
  if (!isctx) {
    const u16* cK = p.cKc + ((size_t)(b * 2 + l) * 512) * 512 + hd * 128;
    const u16* cVt = p.cVtC + ((size_t)((b * 2 + l) * 4 + hd) * 128) * 512;
    for (int kt = 0; kt < 8; kt++) {
      __syncthreads();
      stage_k(K0s, cK, 512, kt * 64, 512); stage_k(K1s, cK + 64, 512, kt * 64, 512);
      stage_vt<128>(Vts, cVt, 512, kt * 64);
      __syncthreads();
      flash_step<128, false>(Kme, Vts, qf, m, ls, o, lane, 0, 0, 512);
    }
  }
  float* xch = (float*)sm;
  __syncthreads();
  if (map == 1) {
    const float inv = lam / ls;
#pragma unroll
    for (int ds = 0; ds < 4; ds++)
#pragma unroll
      for (int e = 0; e < 16; e++) xch[((qg * 64) + ds * 16 + e) * 64 + lane] = o[ds][e] * inv;
  }
  __syncthreads();
  if (map == 0) {
    const float i0 = 1.f / ls;
    float ss = 0.f;
#pragma unroll
    for (int ds = 0; ds < 4; ds++)
#pragma unroll
      for (int e = 0; e < 16; e++) {
        float v = o[ds][e] * i0 - xch[((qg * 64) + ds * 16 + e) * 64 + lane];
        o[ds][e] = v; ss += v * v;
      }
    ss += __shfl_xor(ss, 32);
    const float rinv = rsqrtf(ss * (1.f / 128.f) + EPS) * (1.f - lam_init);
    const float* sg = p.subln_c + l * 128;
#pragma unroll
    for (int ds = 0; ds < 4; ds++)
#pragma unroll
      for (int g = 0; g < 4; g++) {
        int d = ds * 32 + 8 * g + 4 * h;
        uint2 gv = *(const uint2*)(p.P + prow + C_GC + hd * 128 + d);
        float4 sl = *(const float4*)(sg + d);
        float g0 = bf2f((u16)(gv.x & 0xffff)), g1 = bf2f((u16)(gv.x >> 16)), g2 = bf2f((u16)(gv.y & 0xffff)), g3 = bf2f((u16)(gv.y >> 16));
        uint2 ov;
        ov.x = pack2(o[ds][4 * g] * rinv * sl.x * g0, o[ds][4 * g + 1] * rinv * sl.y * g1);
        ov.y = pack2(o[ds][4 * g + 2] * rinv * sl.z * g2, o[ds][4 * g + 3] * rinv * sl.w * g3);
        *(uint2*)(p.P + prow + C_QC + hd * 128 + d) = ov;
      }
  }
}

__device__ void lru_item(const Params& p, int l, int it, bool pass2, float* sm) {
  const int tid = threadIdx.x;
  const int ci = it >> 3, n = it & 7;
  const int row0 = ci * 64;
  const bool isctx = row0 < NCTX;
  int T, seq0, bidx;
  if (isctx) { T = 256; bidx = row0 >> 8; seq0 = bidx * 256; }
  else { T = 4096; bidx = (row0 - NCTX) >> 12; seq0 = NCTX + bidx * 4096; }
  const int t0 = row0 - seq0;
  float* xin = sm;
  float* xb = sm + 67 * 64;
  float* comb = xb + 64 * 64;
  float* carry = comb + 1024;
  __syncthreads();
  for (int e = tid; e < 67 * 64; e += NT) {
    int rr = e >> 6, cc = e & 63; int t = t0 - 2 + rr;
    float v = 0.f;
    if (t >= 0 && t < T) v = bf2f(p.P[(size_t)(seq0 + t) * PP + C_XB + n * 64 + cc]);
    xin[e] = v;
  }
  __syncthreads();
  {
    const float* cw = p.conv_w + l * 4 * 512; const float* cb = p.conv_b + l * 512;
    for (int e = tid; e < 64 * 64; e += NT) {
      int t = e >> 6, cc = e & 63; int ch = n * 64 + cc;
      float v = cb[ch];
#pragma unroll
      for (int j = 0; j < 4; j++) v += xin[(t + j) * 64 + cc] * cw[j * 512 + ch];
      xb[e] = v;
    }
  }
  __syncthreads();
  const int dout = tid & 63, tg = tid >> 6;
  const int ch = n * 64 + dout;
  float av[2][16], bv[2][16];
#pragma unroll
  for (int d = 0; d < 2; d++) {
    const float* wa = p.lru_wa + ((size_t)((l * 2 + d) * 8 + n) * 64) * 64 + dout;
    const float* wx = p.lru_wx + ((size_t)((l * 2 + d) * 8 + n) * 64) * 64 + dout;
    float ra[16], ia[16];
    const float ba = p.lru_ba[(l * 2 + d) * 512 + ch], bx = p.lru_bx[(l * 2 + d) * 512 + ch];
#pragma unroll
    for (int tt = 0; tt < 16; tt++) { ra[tt] = ba; ia[tt] = bx; }
    for (int c = 0; c < 64; c += 4) {
      float wa0 = wa[(c + 0) * 64], wa1 = wa[(c + 1) * 64], wa2 = wa[(c + 2) * 64], wa3 = wa[(c + 3) * 64];
      float wx0 = wx[(c + 0) * 64], wx1 = wx[(c + 1) * 64], wx2 = wx[(c + 2) * 64], wx3 = wx[(c + 3) * 64];
#pragma unroll
      for (int tt = 0; tt < 16; tt++) {
        float4 xv = *(const float4*)(xb + (tg * 16 + tt) * 64 + c);
        ra[tt] += xv.x * wa0 + xv.y * wa1 + xv.z * wa2 + xv.w * wa3;
        ia[tt] += xv.x * wx0 + xv.y * wx1 + xv.z * wx2 + xv.w * wx3;
      }
    }
    const float lamv = p.lru_lam[(l * 2 + d) * 512 + ch];
    const float sp = log1pf(__expf(-lamv));
#pragma unroll
    for (int tt = 0; tt < 16; tt++) {
      float rg = sigmoidf_(ra[tt]), ig = sigmoidf_(ia[tt]);
      float log_a = -8.f * rg * sp;
      float a = __expf(log_a);
      float bb = sqrtf(-expm1f(2.f * log_a)) * ig * xb[(tg * 16 + tt) * 64 + dout];
      av[d][tt] = a; bv[d][tt] = bb;
    }
  }
  float sA0 = 1.f, sB0 = 0.f, sA1 = 1.f, sB1 = 0.f;
#pragma unroll
  for (int tt = 0; tt < 16; tt++) { sB0 = av[0][tt] * sB0 + bv[0][tt]; sA0 *= av[0][tt]; }
#pragma unroll
  for (int tt = 15; tt >= 0; tt--) { sB1 = av[1][tt] * sB1 + bv[1][tt]; sA1 *= av[1][tt]; }
  comb[((tg * 2 + 0) * 64 + dout) * 2 + 0] = sA0; comb[((tg * 2 + 0) * 64 + dout) * 2 + 1] = sB0;
  comb[((tg * 2 + 1) * 64 + dout) * 2 + 0] = sA1; comb[((tg * 2 + 1) * 64 + dout) * 2 + 1] = sB1;
  if (!pass2) {
    __syncthreads();
    if (tid < 128) {
      int d = tid >> 6, c = tid & 63;
      float At = 1.f, Bt = 0.f;
#pragma unroll
      for (int s = 0; s < 4; s++) {
        int g = (d == 0) ? s : 3 - s;
        float a = comb[((g * 2 + d) * 64 + c) * 2], bq = comb[((g * 2 + d) * 64 + c) * 2 + 1];
        Bt = a * Bt + bq; At *= a;
      }
      float* o = p.lruTot + ((size_t)(ci * 2 + d) * 512 + n * 64 + c) * 2;
      o[0] = At; o[1] = Bt;
    }
    return;
  }
  if (tid < 128) {
    int d = tid >> 6, c = tid & 63; int chn = n * 64 + c;
    float hcar = isctx ? 0.f : p.state_lru[((size_t)(bidx * 2 + l) * 2 + d) * 512 + chn];
    const int cfirst = seq0 >> 6, clast = (seq0 + T - 64) >> 6;
    if (d == 0) {
      for (int cj = cfirst; cj < ci; cj++) {
        const float* q = p.lruTot + ((size_t)(cj * 2 + 0) * 512 + chn) * 2;
        hcar = q[0] * hcar + q[1];
      }
    } else {
      for (int cj = clast; cj > ci; cj--) {
        const float* q = p.lruTot + ((size_t)(cj * 2 + 1) * 512 + chn) * 2;
        hcar = q[0] * hcar + q[1];
      }
    }
    carry[d * 64 + c] = hcar;
  }
  __syncthreads();
  float h0 = carry[dout], h1 = carry[64 + dout];
  for (int g = 0; g < tg; g++) { h0 = comb[((g * 2 + 0) * 64 + dout) * 2] * h0 + comb[((g * 2 + 0) * 64 + dout) * 2 + 1]; }
  for (int g = 3; g > tg; g--) { h1 = comb[((g * 2 + 1) * 64 + dout) * 2] * h1 + comb[((g * 2 + 1) * 64 + dout) * 2 + 1]; }
  float y[16];
#pragma unroll
  for (int tt = 0; tt < 16; tt++) { h0 = av[0][tt] * h0 + bv[0][tt]; y[tt] = h0; }
  const float hf_last = h0;
#pragma unroll
  for (int tt = 15; tt >= 0; tt--) { h1 = av[1][tt] * h1 + bv[1][tt]; y[tt] += h1; }
  const float hb_first = h1;
  if (isctx) {
    if (t0 + 64 == T && tg == 3) p.out[O_ST + ((size_t)(bidx * 2 + l) * 2 + 0) * 512 + ch] = hf_last;
    if (t0 == 0 && tg == 0) p.out[O_ST + ((size_t)(bidx * 2 + l) * 2 + 1) * 512 + ch] = hb_first;
  }
#pragma unroll
  for (int tt = 0; tt < 16; tt++) {
    u16* q = p.P + (size_t)(row0 + tg * 16 + tt) * PP + C_GB + ch;
    *q = f2bf(y[tt] * bf2f(*q));
  }
}

__device__ float compute_lam(const Params& p, int l, float lam_init) {
  float s1 = 0.f, s2 = 0.f;
  for (int i = 0; i < 64; i++) {
    s1 += p.lam_q1[l * 64 + i] * p.lam_k1[l * 64 + i];
    s2 += p.lam_q2[l * 64 + i] * p.lam_k2[l * 64 + i];
  }
  return expf(s1) - expf(s2) + lam_init;
}

__device__ void mix_phase(const Params& p, int l, u16* smem) {
  const float lam_init = (l == 0) ? 0.2f : (0.8f - 0.6f * 0.74081822068f);
  const float lam = compute_lam(p, l, lam_init);
  constexpr int N_CL = 512, N_A = 768, N_CC = 256, N_L = 1536;
  constexpr int TOT = N_CL + N_A + N_CC + N_L;
  const int G = gridDim.x;
  int start = blockIdx.x;
  for (int it = start; it < N_CL; it += G) attnC_item(p, l, 256 + it, smem, lam, lam_init);
  start = (int)((blockIdx.x + G - (N_CL % G)) % G);
  for (int it = start; it < N_A; it += G) attnA_item(p, l, it, smem);
  start = (int)((blockIdx.x + G - ((N_CL + N_A) % G)) % G);
  for (int it = start; it < N_CC; it += G) attnC_item(p, l, it, smem, lam, lam_init);
  start = (int)((blockIdx.x + G - ((N_CL + N_A + N_CC) % G)) % G);
  for (int it = start; it < N_L; it += G) lru_item(p, l, it, false, (float*)smem);
  (void)TOT;
}

__device__ void lru2_phase(const Params& p, int l, u16* smem) {
  for (int it = blockIdx.x; it < 1536; it += gridDim.x) lru_item(p, l, it, true, (float*)smem);
}

__device__ void branch_phase(const Params& p, int l, u16* smem) {
  const int tid = threadIdx.x, lane = tid & 63, wid = tid >> 6, wr = wid >> 1, wc = wid & 1;
  const int r = lane & 31, h = lane >> 5;
  u16* Tl0 = smem; u16* Tl1 = smem + 128 * TROW;
  for (int it = blockIdx.x; it < 96 * 8; it += gridDim.x) {
    const int m0 = (it >> 3) * 128, n0 = (it & 7) * 128;
    f32x16 acc[2][2];
#pragma unroll
    for (int a = 0; a < 2; a++)
#pragma unroll
      for (int b = 0; b < 2; b++)
#pragma unroll
        for (int e = 0; e < 16; e++) acc[a][b][e] = 0.f;
#pragma unroll 1
    for (int i = 0; i < 3; i++) {
      const int acol = (i == 0) ? C_QA : (i == 1 ? C_GB : C_QC);
      gemm_core(p.P + (size_t)m0 * PP + acol, PP, p.Wt_br + ((size_t)(l * 3 + i) * 1024 + n0) * 512, 512, 512, smem, acc);
      {
        const u16* src = p.P + (size_t)m0 * PP + C_MG + i * 1024 + n0;
#pragma unroll
        for (int q = 0; q < 8; q++) {
          int c = tid + q * NT; int row = c >> 4, cc = c & 15;
          *(uint4*)(Tl0 + row * TROW + cc * 8) = *(const uint4*)(src + (size_t)row * PP + cc * 8);
          if (i < 2) *(uint4*)(Tl1 + row * TROW + cc * 8) = *(const uint4*)(src + 1024 + (size_t)row * PP + cc * 8);
        }
      }
      __syncthreads();
#pragma unroll
      for (int mt = 0; mt < 2; mt++)
#pragma unroll
        for (int nt = 0; nt < 2; nt++)
#pragma unroll
          for (int e = 0; e < 16; e++) {
            const int rl = wr * 64 + mt * 32 + (e & 3) + 8 * (e >> 2) + 4 * h;
            float f = bf2f(Tl0[rl * TROW + wc * 64 + nt * 32 + r]);
            if (i < 2) f = __fdividef(f, fmaxf(bf2f(Tl1[rl * TROW + wc * 64 + nt * 32 + r]), 1e-20f));
            acc[mt][nt][e] *= f;
          }
      __syncthreads();
    }
#pragma unroll
    for (int mt = 0; mt < 2; mt++)
#pragma unroll
      for (int nt = 0; nt < 2; nt++)
#pragma unroll
        for (int e = 0; e < 16; e++) {
          const int rl = wr * 64 + mt * 32 + (e & 3) + 8 * (e >> 2) + 4 * h;
          Tl0[rl * TROW + wc * 64 + nt * 32 + r] = f2bf(acc[mt][nt][e]);
        }
    __syncthreads();
    {
      u16* dst = p.H + (size_t)m0 * 1024 + n0;
#pragma unroll
      for (int q = 0; q < 8; q++) {
        int c = tid + q * NT; int row = c >> 4, cc = c & 15;
        *(uint4*)(dst + (size_t)row * 1024 + cc * 8) = *(const uint4*)(Tl0 + row * TROW + cc * 8);
      }
    }
    __syncthreads();
  }
}

__device__ void out_phase(const Params& p, int l, u16* smem) {
  const int tid = threadIdx.x, lane = tid & 63, wid = tid >> 6, wr = wid >> 1, wc = wid & 1;
  const int r = lane & 31, h = lane >> 5;
  for (int it = blockIdx.x; it < 96 * 8; it += gridDim.x) {
    const int m0 = (it >> 3) * 128, n0 = (it & 7) * 128;
    f32x16 acc[2][2];
#pragma unroll
    for (int a = 0; a < 2; a++)
#pragma unroll
      for (int b = 0; b < 2; b++)
#pragma unroll
        for (int e = 0; e < 16; e++) acc[a][b][e] = 0.f;
    gemm_core(p.H + (size_t)m0 * 1024, 1024, p.Wt_out + ((size_t)l * 1024 + n0) * 1024, 1024, 1024, smem, acc);
    const int v = (m0 < NCTX) ? 0 : 1 + (m0 - NCTX) / 4096;
    const float* gt = p.mod + (l * 3 + v) * 3072 + 2048;
#pragma unroll
    for (int mt = 0; mt < 2; mt++)
#pragma unroll
      for (int nt = 0; nt < 2; nt++) {
        int col = n0 + wc * 64 + nt * 32 + r;
        float gv = gt[col];
#pragma unroll
        for (int e = 0; e < 16; e++) {
          int row = m0 + wr * 64 + mt * 32 + (e & 3) + 8 * (e >> 2) + 4 * h;
          float xv;
          if (l == 0) xv = (row < NCTX) ? p.x_prompt[(size_t)row * 1024 + col] : p.x_sample[(size_t)(row - NCTX) * 1024 + col];
          else xv = p.out[O_X + (size_t)row * 1024 + col];
          p.out[O_X + (size_t)row * 1024 + col] = xv + gv * acc[mt][nt][e];
        }
      }
  }
}

template <int J>
__global__ void __launch_bounds__(NT, 2) phase_kernel(Params p, int l) {
  __shared__ __attribute__((aligned(16))) u16 smem[SMEM_BYTES / 2];
  if (J == 0) prologue_phase(p, (float*)smem);
  else if (J == 1) norm_phase(p, l);
  else if (J == 2) inproj_phase(p, l, smem);
  else if (J == 3) mix_phase(p, l, smem);
  else if (J == 4) lru2_phase(p, l, smem);
  else if (J == 5) branch_phase(p, l, smem);
  else out_phase(p, l, smem);
}

extern "C" void kernel_launch(void* const* d_in, const int* in_sizes, int n_in, void* d_out, int out_size, void* d_ws,
                              size_t ws_size, hipStream_t stream) {
  Params p{};
  const float** ip = (const float**)&p;
  for (int i = 0; i < 34; i++) ip[i] = (const float*)d_in[i];
  p.out = (float*)d_out;
  char* w = (char*)d_ws; size_t off = 0;
  auto take = [&](size_t bytes) { char* q = w + off; off += (bytes + 255) & ~(size_t)255; return q; };
  p.Wt_in = (u16*)take((size_t)2 * INC * 1024 * 2);
  p.Wt_br = (u16*)take((size_t)6 * 1024 * 512 * 2);
  p.Wt_out = (u16*)take((size_t)2 * 1024 * 1024 * 2);
  p.H = (u16*)take((size_t)NTOK * 1024 * 2);
  p.P = (u16*)take((size_t)NTOK * PP * 2);
  p.VtA_ctx = (u16*)take((size_t)16 * 2 * 64 * 256 * 2);
  p.VtA_lat = (u16*)take((size_t)2 * 2 * 64 * 4096 * 2);
  p.VtC_ctx = (u16*)take((size_t)16 * 4 * 128 * 256 * 2);
  p.VtC_lat = (u16*)take((size_t)2 * 4 * 128 * 4096 * 2);
  p.cKa = (u16*)take((size_t)2 * 2 * 512 * 128 * 2);
  p.cVtA = (u16*)take((size_t)2 * 2 * 512 * 128 * 2);
  p.cKc = (u16*)take((size_t)2 * 2 * 512 * 512 * 2);
  p.cVtC = (u16*)take((size_t)2 * 2 * 512 * 512 * 2);
  p.mod = (float*)take((size_t)2 * 3 * 3072 * 4);
  p.rope = (float*)take((size_t)2048 * 4);
  p.lruTot = (float*)take((size_t)192 * 2 * 512 * 2 * 4);
  const int grid = 512;
  hipLaunchKernelGGL(phase_kernel<0>, dim3(grid), dim3(NT), 0, stream, p, 0);
  for (int l = 0; l < 2; l++) {
    hipLaunchKernelGGL(phase_kernel<1>, dim3(grid), dim3(NT), 0, stream, p, l);
    hipLaunchKernelGGL(phase_kernel<2>, dim3(grid), dim3(NT), 0, stream, p, l);
    hipLaunchKernelGGL(phase_kernel<3>, dim3(grid), dim3(NT), 0, stream, p, l);
    hipLaunchKernelGGL(phase_kernel<4>, dim3(grid), dim3(NT), 0, stream, p, l);
    hipLaunchKernelGGL(phase_kernel<5>, dim3(grid), dim3(NT), 0, stream, p, l);
    hipLaunchKernelGGL(phase_kernel<6>, dim3(grid), dim3(NT), 0, stream, p, l);
  }
}
```

```cpp
#include <hip/hip_runtime.h>
#include <hip/hip_cooperative_groups.h>
#include <stdint.h>
#include <math.h>
namespace cg = cooperative_groups;

typedef unsigned short u16;
typedef __attribute__((ext_vector_type(8))) short bf16x8;
typedef __attribute__((ext_vector_type(4))) short bf16x4;
typedef __attribute__((ext_vector_type(16))) float f32x16;

#define NT 256
constexpr int DM = 1024, NTOK = 12288, NCTX = 4096;
constexpr int INC = 7424;
constexpr int PP = 6784;
constexpr int C_QA = 0, C_KA = 512, C_GA = 640, C_XB = 1152, C_GB = 1664, C_QC = 2176, C_KC = 2688, C_GC = 3200, C_MG = 3712;
constexpr int LROW = 72;
constexpr int VROW = 68;
constexpr int FROW = 132;
constexpr int TROW = 136;
constexpr float EPS = 1e-6f;
constexpr int SMEM_BYTES = 2 * 256 * LROW * 2;

constexpr size_t O_X = 0, O_KA = 12582912, O_VA = 13631488, O_KC = 14680064, O_VC = 18874368, O_ST = 23068672;

struct Params {
  const float *x_prompt, *x_sample, *cache_a_k, *cache_a_v, *cache_c_k, *cache_c_v, *state_lru, *c, *c_ctx,
      *norm_g, *mod_w, *mod_b, *w_in, *qn_a, *kn_a, *sink_a, *conv_w, *conv_b, *lru_wa, *lru_ba, *lru_wx, *lru_bx,
      *lru_lam, *qn_c, *kn_c, *lam_q1, *lam_k1, *lam_q2, *lam_k2, *subln_c, *w_br_a, *w_br_b, *w_br_c, *w_out;
  float* out;
  u16 *Wt_in, *Wt_br, *Wt_out, *H, *P, *VtA_ctx, *VtA_lat, *VtC_ctx, *VtC_lat, *cKa, *cVtA, *cKc, *cVtC;
  float *mod, *rope, *lruTot;
  int phase_lo, phase_hi;
};

__device__ __forceinline__ int tid_opaque() { int t = (int)threadIdx.x; asm volatile("" : "+v"(t)); return t; }
#define TIDX tid_opaque()
__device__ __forceinline__ u16 f2bf(float f) {
  uint32_t u = __float_as_uint(f);
  u += 0x7FFFu + ((u >> 16) & 1u);
  return (u16)(u >> 16);
}
__device__ __forceinline__ float bf2f(u16 h) { return __uint_as_float(((uint32_t)h) << 16); }
__device__ __forceinline__ uint32_t pack2(float a, float b) { return (uint32_t)f2bf(a) | ((uint32_t)f2bf(b) << 16); }
__device__ __forceinline__ float sigmoidf_(float x) { return 1.f / (1.f + __expf(-x)); }
__device__ __forceinline__ float siluf_(float x) { return x / (1.f + __expf(-x)); }
__device__ __forceinline__ f32x16 mfma32(bf16x8 a, bf16x8 b, f32x16 c) {
  return __builtin_amdgcn_mfma_f32_32x32x16_bf16(a, b, c, 0, 0, 0);
}

__device__ void transpose_tile(const float* __restrict__ src, int spitch, u16* __restrict__ dst, int dpitch,
                               int r0, int c0, float* sm) {
  const int tid = TIDX;
#pragma unroll
  for (int i = 0; i < 4; i++) {
    int c = tid + i * NT; int r = c >> 4, q = c & 15;
    float4 v = *(const float4*)(src + (size_t)(r0 + r) * spitch + c0 + q * 4);
    float* d = sm + r * 65 + q * 4;
    d[0] = v.x; d[1] = v.y; d[2] = v.z; d[3] = v.w;
  }
  __syncthreads();
#pragma unroll
  for (int i = 0; i < 2; i++) {
    int c = tid + i * NT; int cc = c >> 3, q = c & 7;
    uint32_t w[4];
#pragma unroll
    for (int j = 0; j < 4; j++) w[j] = pack2(sm[(q * 8 + 2 * j) * 65 + cc], sm[(q * 8 + 2 * j + 1) * 65 + cc]);
    uint4 v; v.x = w[0]; v.y = w[1]; v.z = w[2]; v.w = w[3];
    *(uint4*)(dst + (size_t)(c0 + cc) * dpitch + r0 + q * 8) = v;
  }
  __syncthreads();
}

__device__ void mod_item(const Params& p, int it, float* sm) {
  const int tid = TIDX;
  const int l = it / 48, n0 = (it % 48) * 64;
  float* sv = sm;
  float* red = sm + 3072;
  for (int e = tid; e < 3072; e += NT) {
    int v = e >> 10, k = e & 1023;
    float x = (v == 0) ? p.c_ctx[k] : p.c[(v - 1) * 1024 + k];
    sv[e] = siluf_(x);
  }
  __syncthreads();
  const int col = tid & 63, kg = tid >> 6;
  const float* w = p.mod_w + (size_t)l * 1024 * 3072 + n0 + col;
  float a0 = 0, a1 = 0, a2 = 0;
#pragma unroll 8
  for (int k = kg * 256; k < kg * 256 + 256; k++) {
    float wv = w[(size_t)k * 3072];
    a0 += sv[k] * wv; a1 += sv[1024 + k] * wv; a2 += sv[2048 + k] * wv;
  }
  red[(kg * 3 + 0) * 64 + col] = a0; red[(kg * 3 + 1) * 64 + col] = a1; red[(kg * 3 + 2) * 64 + col] = a2;
  __syncthreads();
  if (tid < 192) {
    int v = tid >> 6, c = tid & 63;
    float s = p.mod_b[l * 3072 + n0 + c];
#pragma unroll
    for (int g = 0; g < 4; g++) s += red[(g * 3 + v) * 64 + c];
    p.mod[(l * 3 + v) * 3072 + n0 + c] = s;
  }
  __syncthreads();
}

__device__ void prologue_phase(const Params& p, float* sm) {
  constexpr int N_MOD = 96, N_ROPE = 1, N_WIN = 2 * 16 * 116, N_WBR = 6 * 8 * 16, N_WOUT = 2 * 16 * 16;
  constexpr int N_CK = 128 + 512, N_CVA = 4 * 16, N_CVC = 4 * 64;
  constexpr int E0 = N_MOD, E1 = E0 + N_ROPE, E2 = E1 + N_WIN, E3 = E2 + N_WBR, E4 = E3 + N_WOUT, E5 = E4 + N_CK,
                E6 = E5 + N_CVA, E7 = E6 + N_CVC;
  const int tid = TIDX;
  for (int it = blockIdx.x; it < E7; it += gridDim.x) {
    if (it < E0) {
      mod_item(p, it, sm);
    } else if (it < E1) {
      for (int e = tid; e < 1024; e += NT) {
        int pos = e >> 4, f = e & 15;
        float inv = powf(10000.f, -(float)f / 16.f);
        float ang = (float)pos * inv;
        p.rope[e] = cosf(ang); p.rope[1024 + e] = sinf(ang);
      }
    } else if (it < E2) {
      int j = it - E1; int l = j / (16 * 116); int r = j % (16 * 116);
      int kt = r / 116, nt = r % 116;
      transpose_tile(p.w_in + (size_t)l * 1024 * INC, INC, p.Wt_in + (size_t)l * INC * 1024, 1024, kt * 64, nt * 64, sm);
    } else if (it < E3) {
      int j = it - E2; int m = j / 128; int r = j % 128;
      int l = m / 3, i = m % 3;
      const float* src = (i == 0 ? p.w_br_a : (i == 1 ? p.w_br_b : p.w_br_c)) + (size_t)l * 512 * 1024;
      int kt = r / 16, nt = r % 16;
      transpose_tile(src, 1024, p.Wt_br + (size_t)m * 1024 * 512, 512, kt * 64, nt * 64, sm);
    } else if (it < E4) {
      int j = it - E3; int l = j / 256; int r = j % 256;
      int kt = r / 16, nt = r % 16;
      transpose_tile(p.w_out + (size_t)l * 1024 * 1024, 1024, p.Wt_out + (size_t)l * 1024 * 1024, 1024, kt * 64, nt * 64, sm);
    } else if (it < E5) {
      int j = it - E4;
      const float* src; u16* dst; size_t off;
      if (j < 128) { src = p.cache_a_k; dst = p.cKa; off = (size_t)j * 2048; }
      else { src = p.cache_c_k; dst = p.cKc; off = (size_t)(j - 128) * 2048; }
      size_t e = off + (size_t)tid * 8;
      float4 a = *(const float4*)(src + e), b = *(const float4*)(src + e + 4);
      uint4 v; v.x = pack2(a.x, a.y); v.y = pack2(a.z, a.w); v.z = pack2(b.x, b.y); v.w = pack2(b.z, b.w);
      *(uint4*)(dst + e) = v;
    } else if (it < E6) {
      int j = it - E5; int bl = j / 16; int r = j % 16;
      int rt = r / 2, ct = r % 2;
      transpose_tile(p.cache_a_v + (size_t)bl * 512 * 128, 128, p.cVtA + (size_t)bl * 128 * 512, 512, rt * 64, ct * 64, sm);
    } else {
      int j = it - E6; int bl = j / 64; int r = j % 64;
      int rt = r / 8, ct = r % 8;
      transpose_tile(p.cache_c_v + (size_t)bl * 512 * 512, 512, p.cVtC + (size_t)bl * 512 * 512, 512, rt * 64, ct * 64, sm);
    }
  }
}

__device__ void norm_phase(const Params& p, int l) {
  const int tid = TIDX, lane = tid & 63, wid = tid >> 6;
  const float* g = p.norm_g + l * 1024;
  for (int it = blockIdx.x; it < NTOK / 4; it += gridDim.x) {
    int row = it * 4 + wid;
    const float* x;
    if (l == 0) x = (row < NCTX) ? p.x_prompt + (size_t)row * 1024 : p.x_sample + (size_t)(row - NCTX) * 1024;
    else x = p.out + O_X + (size_t)row * 1024;
    int v = (row < NCTX) ? 0 : 1 + (row - NCTX) / 4096;
    const float* md = p.mod + (l * 3 + v) * 3072;
    float4 xv[4]; float ss = 0;
#pragma unroll
    for (int i = 0; i < 4; i++) {
      xv[i] = *(const float4*)(x + i * 256 + lane * 4);
      ss += xv[i].x * xv[i].x + xv[i].y * xv[i].y + xv[i].z * xv[i].z + xv[i].w * xv[i].w;
    }
#pragma unroll
    for (int o = 32; o > 0; o >>= 1) ss += __shfl_xor(ss, o);
    float rinv = rsqrtf(ss * (1.f / 1024.f) + EPS);
#pragma unroll
    for (int i = 0; i < 4; i++) {
      int c = i * 256 + lane * 4;
      float4 gv = *(const float4*)(g + c), sh = *(const float4*)(md + c), sc = *(const float4*)(md + 1024 + c);
      float h0 = xv[i].x * rinv * gv.x * (1.f + sc.x) + sh.x;
      float h1 = xv[i].y * rinv * gv.y * (1.f + sc.y) + sh.y;
      float h2 = xv[i].z * rinv * gv.z * (1.f + sc.z) + sh.z;
      float h3 = xv[i].w * rinv * gv.w * (1.f + sc.w) + sh.w;
      uint2 o2; o2.x = pack2(h0, h1); o2.y = pack2(h2, h3);
      *(uint2*)(p.H + (size_t)row * 1024 + c) = o2;
    }
  }
}

__device__ __forceinline__ void gemm_core(const u16* __restrict__ A, int lda, const u16* __restrict__ Bt, int ldb,
                                          int K, u16* smem, f32x16 (&acc)[2][2]) {
  const int tid = TIDX, lane = tid & 63, wid = tid >> 6, wr = wid >> 1, wc = wid & 1;
  const int r = lane & 31, h = lane >> 5;
  uint4 ra[4], rb[4];
  const int srow = tid >> 3, skc = tid & 7;
  const u16* ap = A + (size_t)srow * lda + skc * 8;
  const u16* bp = Bt + (size_t)srow * ldb + skc * 8;
  const int nk = K >> 6;
#pragma unroll
  for (int i = 0; i < 4; i++) {
    ra[i] = *(const uint4*)(ap + (size_t)i * 32 * lda);
    rb[i] = *(const uint4*)(bp + (size_t)i * 32 * ldb);
  }
  {
    u16* sa = smem; u16* sb = smem + 128 * LROW;
#pragma unroll
    for (int i = 0; i < 4; i++) {
      *(uint4*)(sa + (srow + i * 32) * LROW + skc * 8) = ra[i];
      *(uint4*)(sb + (srow + i * 32) * LROW + skc * 8) = rb[i];
    }
  }
  __syncthreads();
  for (int kt = 0; kt < nk; kt++) {
    const bool more = (kt + 1 < nk);
    if (more) {
#pragma unroll
      for (int i = 0; i < 4; i++) {
        ra[i] = *(const uint4*)(ap + (size_t)i * 32 * lda + (kt + 1) * 64);
        rb[i] = *(const uint4*)(bp + (size_t)i * 32 * ldb + (kt + 1) * 64);
      }
    }
    const u16* sa = smem + (kt & 1) * (256 * LROW);
    const u16* sb = sa + 128 * LROW;
#pragma unroll
    for (int ks = 0; ks < 4; ks++) {
      bf16x8 af[2], bfr[2];
#pragma unroll
      for (int mt = 0; mt < 2; mt++) af[mt] = *(const bf16x8*)(sa + (wr * 64 + mt * 32 + r) * LROW + ks * 16 + h * 8);
#pragma unroll
      for (int nt = 0; nt < 2; nt++) bfr[nt] = *(const bf16x8*)(sb + (wc * 64 + nt * 32 + r) * LROW + ks * 16 + h * 8);
#pragma unroll
      for (int mt = 0; mt < 2; mt++)
#pragma unroll
        for (int nt = 0; nt < 2; nt++) acc[mt][nt] = mfma32(af[mt], bfr[nt], acc[mt][nt]);
    }
    if (more) {
      u16* wa = smem + ((kt + 1) & 1) * (256 * LROW); u16* wb = wa + 128 * LROW;
#pragma unroll
      for (int i = 0; i < 4; i++) {
        *(uint4*)(wa + (srow + i * 32) * LROW + skc * 8) = ra[i];
        *(uint4*)(wb + (srow + i * 32) * LROW + skc * 8) = rb[i];
      }
    }
    __syncthreads();
  }
}

__device__ __forceinline__ void acc_to_lds(float* Tf, const f32x16 (&acc)[2][2], int wr, int wc, int r, int h) {
#pragma unroll
  for (int mt = 0; mt < 2; mt++)
#pragma unroll
    for (int nt = 0; nt < 2; nt++)
#pragma unroll
      for (int e = 0; e < 16; e++) {
        const int rl = wr * 64 + mt * 32 + (e & 3) + 8 * (e >> 2) + 4 * h;
        Tf[rl * FROW + wc * 64 + nt * 32 + r] = acc[mt][nt][e];
      }
}

__device__ void inproj_phase(const Params& p, int l, u16* smem) {
  const int tid = TIDX, lane = tid & 63, wid = tid >> 6, wr = wid >> 1, wc = wid & 1;
  const int r = lane & 31, h = lane >> 5;
  constexpr int NMT = NTOK / 128, NNT = INC / 128, GM = 16;
  for (int it = blockIdx.x; it < NMT * NNT; it += gridDim.x) {
    int grp = it / (GM * NNT), rem = it % (GM * NNT);
    int mt_ = grp * GM + (rem % GM), nt_ = rem / GM;
    const int m0 = mt_ * 128, n0 = nt_ * 128;
    f32x16 acc[2][2];
#pragma unroll
    for (int a = 0; a < 2; a++)
#pragma unroll
      for (int b = 0; b < 2; b++)
#pragma unroll
        for (int e = 0; e < 16; e++) acc[a][b][e] = 0.f;
    gemm_core(p.H + (size_t)m0 * 1024, 1024, p.Wt_in + ((size_t)l * INC + n0) * 1024, 1024, 1024, smem, acc);

    const bool isctx = (m0 < NCTX);
    float* Tf = (float*)smem;
    acc_to_lds(Tf, acc, wr, wc, r, h);
    __syncthreads();
    if (n0 == 640 || (n0 >= 3328 && n0 < 3840)) {
      const bool isA = (n0 == 640);
#pragma unroll 2
      for (int i = 0; i < 8; i++) {
        int c = tid + i * NT; int col = c & 127, rg = c >> 7;
        float v[8];
#pragma unroll
        for (int j = 0; j < 8; j++) v[j] = Tf[(rg * 8 + j) * FROW + col];
        uint4 pk; pk.x = pack2(v[0], v[1]); pk.y = pack2(v[2], v[3]); pk.z = pack2(v[4], v[5]); pk.w = pack2(v[6], v[7]);
        int row = m0 + rg * 8;
        u16* dst;
        if (isctx) {
          int b = row >> 8, t = row & 255;
          dst = isA ? p.VtA_ctx + ((size_t)(b * 128 + col)) * 256 + t
                    : p.VtC_ctx + ((size_t)(b * 512 + (n0 - 3328) + col)) * 256 + t;
        } else {
          int rr = row - NCTX; int b = rr >> 12, t = rr & 4095;
          dst = isA ? p.VtA_lat + ((size_t)(b * 128 + col)) * 4096 + t
                    : p.VtC_lat + ((size_t)(b * 512 + (n0 - 3328) + col)) * 4096 + t;
        }
        *(uint4*)dst = pk;
      }
      if (isctx) {
#pragma unroll 4
        for (int i = 0; i < 16; i++) {
          int c = tid + i * NT; int row = c >> 5, q = c & 31;
          float4 v = *(const float4*)(Tf + row * FROW + q * 4);
          int grow = m0 + row; int b = grow >> 8, t = grow & 255;
          float* dst = isA ? p.out + O_VA + ((size_t)(b * 2 + l) * 256 + t) * 128 + q * 4
                           : p.out + O_VC + ((size_t)(b * 2 + l) * 256 + t) * 512 + (n0 - 3328) + q * 4;
          *(float4*)dst = v;
        }
      }
    } else {
      const int pcb = (n0 < 640) ? n0 : (n0 < 3328 ? n0 - 128 : n0 - 640);
      const bool is_qa = n0 < 512, is_ka = (n0 == 512);
      const bool is_qc = (n0 >= 2304 && n0 < 2816), is_kc = (n0 >= 2816 && n0 < 3328);
      const bool qk = is_qa || is_ka || is_qc || is_kc;
      const int mode = (n0 >= 4352) ? 2 : ((n0 >= 1280 && n0 < 1792) ? 0 : 1);
      const float* gn = (is_qa ? p.qn_a : is_ka ? p.kn_a : is_qc ? p.qn_c : p.kn_c) + l * 64;
      const float qs = (is_qa || is_qc) ? 0.125f : 1.f;
#pragma unroll 2
      for (int i = 0; i < 8; i++) {
        int c = tid + i * NT; int row = c >> 4, j16 = c & 15;
        float v[8];
        {
          float4 a = *(const float4*)(Tf + row * FROW + j16 * 8), bq = *(const float4*)(Tf + row * FROW + j16 * 8 + 4);
          v[0] = a.x; v[1] = a.y; v[2] = a.z; v[3] = a.w; v[4] = bq.x; v[5] = bq.y; v[6] = bq.z; v[7] = bq.w;
        }
        const int grow = m0 + row;
        if (qk) {
          float ss = 0.f;
#pragma unroll
          for (int k = 0; k < 8; k++) ss += v[k] * v[k];
          ss += __shfl_xor(ss, 1); ss += __shfl_xor(ss, 2); ss += __shfl_xor(ss, 4);
          const float rinv = rsqrtf(ss * (1.f / 64.f) + EPS);
          const int j = j16 & 7;
          float4 ga = *(const float4*)(gn + j * 8), gb = *(const float4*)(gn + j * 8 + 4);
          v[0] *= rinv * ga.x; v[1] *= rinv * ga.y; v[2] *= rinv * ga.z; v[3] *= rinv * ga.w;
          v[4] *= rinv * gb.x; v[5] *= rinv * gb.y; v[6] *= rinv * gb.z; v[7] *= rinv * gb.w;
          if (!isctx) {
            int t = (grow - NCTX) & 4095;
            int pos = (j < 4) ? (t >> 6) : (t & 63);
            const float* ct = p.rope + pos * 16 + (j & 1) * 8;
            float4 c0 = *(const float4*)ct, c1 = *(const float4*)(ct + 4);
            float4 s0 = *(const float4*)(ct + 1024), s1 = *(const float4*)(ct + 1028);
            float cs[8] = {c0.x, c0.y, c0.z, c0.w, c1.x, c1.y, c1.z, c1.w};
            float sn[8] = {s0.x, s0.y, s0.z, s0.w, s1.x, s1.y, s1.z, s1.w};
            const float sg = (j & 2) ? 1.f : -1.f;
#pragma unroll
            for (int k = 0; k < 8; k++) {
              float pv = __shfl_xor(v[k], 2);
              v[k] = v[k] * cs[k] + sg * pv * sn[k];
            }
          } else if (is_ka || is_kc) {
            int b = grow >> 8, t = grow & 255;
            float* dst = is_ka ? p.out + O_KA + ((size_t)(b * 2 + l) * 256 + t) * 128 + j16 * 8
                               : p.out + O_KC + ((size_t)(b * 2 + l) * 256 + t) * 512 + (n0 - 2816) + j16 * 8;
            *(float4*)dst = make_float4(v[0], v[1], v[2], v[3]);
            *(float4*)(dst + 4) = make_float4(v[4], v[5], v[6], v[7]);
          }
#pragma unroll
          for (int k = 0; k < 8; k++) v[k] *= qs;
        } else if (mode == 1) {
#pragma unroll
          for (int k = 0; k < 8; k++) v[k] = siluf_(v[k]);
        } else if (mode == 2) {
#pragma unroll
          for (int k = 0; k < 8; k++) v[k] = sigmoidf_(v[k]);
        }
        uint4 pk; pk.x = pack2(v[0], v[1]); pk.y = pack2(v[2], v[3]); pk.z = pack2(v[4], v[5]); pk.w = pack2(v[6], v[7]);
        *(uint4*)(p.P + (size_t)grow * PP + pcb + j16 * 8) = pk;
      }
    }
    __syncthreads();
  }
}

__device__ __forceinline__ void stage_k(u16* dst, const u16* __restrict__ src, size_t pitch, int r0, int nrows) {
  const int tid = TIDX;
#pragma unroll
  for (int i = 0; i < 2; i++) {
    int c = tid + i * NT; int row = c >> 3, kc = c & 7; int rr = r0 + row;
    uint4 v = make_uint4(0, 0, 0, 0);
    if (rr >= 0 && rr < nrows) v = *(const uint4*)(src + (size_t)rr * pitch + kc * 8);
    *(uint4*)(dst + row * LROW + kc * 8) = v;
  }
}
template <int DV>
__device__ __forceinline__ void stage_vt(u16* dst, const u16* __restrict__ src, int T, int k0) {
  const int tid = TIDX;
#pragma unroll
  for (int i = 0; i < DV / 32; i++) {
    int c = tid + i * NT; int d = c >> 3, kc = c & 7; int k = k0 + kc * 8;
    uint4 v = make_uint4(0, 0, 0, 0);
    if (k >= 0 && k < T) v = *(const uint4*)(src + (size_t)d * T + k);
    uint2* q = (uint2*)(dst + d * VROW + kc * 8);
    q[0] = make_uint2(v.x, v.y); q[1] = make_uint2(v.z, v.w);
  }
}

template <int DV, bool MASK>
__device__ __forceinline__ void flash_step(const u16* Ks, const u16* Vts, const bf16x8 (&qf)[4], float& m, float& l,
                                           f32x16 (&o)[DV / 32], int lane, int kpos0, int qpos, int T) {
  const int r = lane & 31, h = lane >> 5;
  f32x16 s[2];
#pragma unroll
  for (int sub = 0; sub < 2; sub++) {
#pragma unroll
    for (int e = 0; e < 16; e++) s[sub][e] = 0.f;
#pragma unroll
    for (int ks = 0; ks < 4; ks++) {
      bf16x8 kf = *(const bf16x8*)(Ks + (sub * 32 + r) * LROW + ks * 16 + h * 8);
      s[sub] = mfma32(kf, qf[ks], s[sub]);
    }
  }
  if (MASK) {
#pragma unroll
    for (int sub = 0; sub < 2; sub++)
#pragma unroll
      for (int e = 0; e < 16; e++) {
        int kp = kpos0 + sub * 32 + (e & 3) + 8 * (e >> 2) + 4 * h;
        int dlt = kp - qpos;
        bool ok = (kp >= 0) && (kp < T) && (dlt <= 128) && (dlt >= -128);
        if (!ok) s[sub][e] = -INFINITY;
      }
  }
  float mx = s[0][0];
#pragma unroll
  for (int sub = 0; sub < 2; sub++)
#pragma unroll
    for (int e = 0; e < 16; e++) mx = fmaxf(mx, s[sub][e]);
  mx = fmaxf(mx, __shfl_xor(mx, 32));
  const float mn = fmaxf(m, mx);
  const float alpha = __expf(m - mn);
  float sum = 0.f;
#pragma unroll
  for (int sub = 0; sub < 2; sub++)
#pragma unroll
    for (int e = 0; e < 16; e++) { float pv = __expf(s[sub][e] - mn); s[sub][e] = pv; sum += pv; }
  sum += __shfl_xor(sum, 32);
  l = l * alpha + sum; m = mn;
#pragma unroll
  for (int ds = 0; ds < DV / 32; ds++)
#pragma unroll
    for (int e = 0; e < 16; e++) o[ds][e] *= alpha;
#pragma unroll
  for (int sub = 0; sub < 2; sub++)
#pragma unroll
    for (int st = 0; st < 2; st++) {
      bf16x8 pf;
#pragma unroll
      for (int j = 0; j < 8; j++) pf[j] = (short)f2bf(s[sub][8 * st + j]);
#pragma unroll
      for (int ds = 0; ds < DV / 32; ds++) {
        const u16* vp = Vts + (ds * 32 + r) * VROW + sub * 32 + 16 * st + 4 * h;
        bf16x4 lo = *(const bf16x4*)vp, hi = *(const bf16x4*)(vp + 8);
        bf16x8 vf = __builtin_shufflevector(lo, hi, 0, 1, 2, 3, 4, 5, 6, 7);
        o[ds] = mfma32(vf, pf, o[ds]);
      }
    }
}

__device__ void attnA_item(const Params& p, int l, int it, u16* sm) {
  const int tid = TIDX, lane = tid & 63, wid = tid >> 6;
  const int r = lane & 31, h = lane >> 5;
  const bool isctx = it < 256;
  int b, kvh, qb, T, rowbase; const u16* VtBase;
  if (isctx) { b = it >> 4; kvh = (it >> 3) & 1; qb = it & 7; T = 256; rowbase = b * 256;
    VtBase = p.VtA_ctx + ((size_t)(b * 2 + kvh) * 64) * 256; }
  else { int j = it - 256; b = j >> 8; kvh = (j >> 7) & 1; qb = j & 127; T = 4096; rowbase = NCTX + b * 4096;
    VtBase = p.VtA_lat + ((size_t)(b * 2 + kvh) * 64) * 4096; }
  const int q0 = qb * 32;
  const int head = kvh * 4 + wid;
  const size_t prow = (size_t)(rowbase + q0 + r) * PP;
  bf16x8 qf[4];
#pragma unroll
  for (int ks = 0; ks < 4; ks++) qf[ks] = *(const bf16x8*)(p.P + prow + C_QA + head * 64 + ks * 16 + h * 8);
  float m = p.sink_a[l * 8 + head], ls = 1.f;
  f32x16 o[2];
#pragma unroll
  for (int ds = 0; ds < 2; ds++)
#pragma unroll
    for (int e = 0; e < 16; e++) o[ds][e] = 0.f;
  u16* Ks = sm; u16* Vts = sm + 64 * LROW;
  const u16* Kbase = p.P + (size_t)rowbase * PP + C_KA + kvh * 64;
  const int qpos = q0 + r;
  if (isctx) {
    for (int kt = 0; kt < 4; kt++) {
      __syncthreads();
      stage_k(Ks, Kbase, PP, kt * 64, T); stage_vt<64>(Vts, VtBase, T, kt * 64);
      __syncthreads();
      flash_step<64, false>(Ks, Vts, qf, m, ls, o, lane, 0, 0, T);
    }
  } else {
    for (int i = 0; i < 5; i++) {
      int k0 = q0 - 128 + 64 * i;
      if (k0 + 63 < 0 || k0 >= T) continue;
      __syncthreads();
      stage_k(Ks, Kbase, PP, k0, T); stage_vt<64>(Vts, VtBase, T, k0);
      __syncthreads();
      flash_step<64, true>(Ks, Vts, qf, m, ls, o, lane, k0, qpos, T);
    }
    const u16* cK = p.cKa + ((size_t)(b * 2 + l) * 512) * 128 + kvh * 64;
    const u16* cVt = p.cVtA + ((size_t)((b * 2 + l) * 2 + kvh) * 64) * 512;
    for (int kt = 0; kt < 8; kt++) {
      __syncthreads();
      stage_k(Ks, cK, 128, kt * 64, 512); stage_vt<64>(Vts, cVt, 512, kt * 64);
      __syncthreads();
      flash_step<64, false>(Ks, Vts, qf, m, ls, o, lane, 0, 0, 512);
    }
  }
  const float inv = 1.f / ls;
#pragma unroll
  for (int ds = 0; ds < 2; ds++)
#pragma unroll
    for (int g = 0; g < 4; g++) {
      int d = ds * 32 + 8 * g + 4 * h;
      uint2 gv = *(const uint2*)(p.P + prow + C_GA + head * 64 + d);
      float g0 = bf2f((u16)(gv.x & 0xffff)), g1 = bf2f((u16)(gv.x >> 16)), g2 = bf2f((u16)(gv.y & 0xffff)), g3 = bf2f((u16)(gv.y >> 16));
      uint2 ov;
      ov.x = pack2(o[ds][4 * g] * inv * g0, o[ds][4 * g + 1] * inv * g1);
      ov.y = pack2(o[ds][4 * g + 2] * inv * g2, o[ds][4 * g + 3] * inv * g3);
      *(uint2*)(p.P + prow + C_QA + head * 64 + d) = ov;
    }
}

__device__ void attnC_item(const Params& p, int l, int it, u16* sm, float lam, float lam_init) {
  const int tid = TIDX, lane = tid & 63, wid = tid >> 6;
  const int r = lane & 31, h = lane >> 5;
  const bool isctx = it < 256;
  int b, hd, qb, T, rowbase; const u16* VtBase;
  if (isctx) { b = it >> 4; hd = (it >> 2) & 3; qb = it & 3; T = 256; rowbase = b * 256;
    VtBase = p.VtC_ctx + ((size_t)(b * 4 + hd) * 128) * 256; }
  else { int j = it - 256; b = j >> 8; hd = (j >> 6) & 3; qb = j & 63; T = 4096; rowbase = NCTX + b * 4096;
    VtBase = p.VtC_lat + ((size_t)(b * 4 + hd) * 128) * 4096; }
  const int qg = wid & 1, map = wid >> 1;
  const int q0 = qb * 64 + qg * 32;
  const size_t prow = (size_t)(rowbase + q0 + r) * PP;
  bf16x8 qf[4];
#pragma unroll
  for (int ks = 0; ks < 4; ks++) qf[ks] = *(const bf16x8*)(p.P + prow + C_QC + hd * 128 + map * 64 + ks * 16 + h * 8);
  float m = -1e30f, ls = 0.f;
  f32x16 o[4];
#pragma unroll
  for (int ds = 0; ds < 4; ds++)
#pragma unroll
    for (int e = 0; e < 16; e++) o[ds][e] = 0.f;
  u16* K0s = sm; u16* K1s = sm + 64 * LROW; u16* Vts = sm + 128 * LROW;
  const u16* Kme = map ? K1s : K0s;
  const u16* Kbase = p.P + (size_t)rowbase * PP + C_KC + hd * 128;
  const int ntl = T / 64;
  for (int kt = 0; kt < ntl; kt++) {
    __syncthreads();
    stage_k(K0s, Kbase, PP, kt * 64, T); stage_k(K1s, Kbase + 64, PP, kt * 64, T);
    stage_vt<128>(Vts, VtBase, T, kt * 64);
    __syncthreads();
    flash_step<128, false>(Kme, Vts, qf, m, ls, o, lane, 0, 0, T);
  }
  if (!isctx) {
    const u16* cK = p.cKc + ((size_t)(b * 2 + l) * 512) * 512 + hd * 128;
    const u16* cVt = p.cVtC + ((size_t)((b * 2 + l) * 4 + hd) * 128) * 512;
    for (int kt = 0; kt < 8; kt++) {
      __syncthreads();
      stage_k(K0s, cK, 512, kt * 64, 512); stage_k(K1s, cK + 64, 512, kt * 64, 512);
      stage_vt<128>(Vts, cVt, 512, kt * 64);
      __syncthreads();
      flash_step<128, false>(Kme, Vts, qf, m, ls, o, lane, 0, 0, 512);
    }
  }
  float* xch = (float*)sm;
  __syncthreads();
  if (map == 1) {
    const float inv = lam / ls;
#pragma unroll
    for (int ds = 0; ds < 4; ds++)
#pragma unroll
      for (int e = 0; e < 16; e++) xch[((qg * 64) + ds * 16 + e) * 64 + lane] = o[ds][e] * inv;
  }
  __syncthreads();
  if (map == 0) {
    const float i0 = 1.f / ls;
    float ss = 0.f;
#pragma unroll
    for (int ds = 0; ds < 4; ds++)
#pragma unroll
      for (int e = 0; e < 16; e++) {
        float v = o[ds][e] * i0 - xch[((qg * 64) + ds * 16 + e) * 64 + lane];
        o[ds][e] = v; ss += v * v;
      }
    ss += __shfl_xor(ss, 32);
    const float rinv = rsqrtf(ss * (1.f / 128.f) + EPS) * (1.f - lam_init);
    const float* sg = p.subln_c + l * 128;
#pragma unroll
    for (int ds = 0; ds < 4; ds++)
#pragma unroll
      for (int g = 0; g < 4; g++) {
        int d = ds * 32 + 8 * g + 4 * h;
        uint2 gv = *(const uint2*)(p.P + prow + C_GC + hd * 128 + d);
        float4 sl = *(const float4*)(sg + d);
        float g0 = bf2f((u16)(gv.x & 0xffff)), g1 = bf2f((u16)(gv.x >> 16)), g2 = bf2f((u16)(gv.y & 0xffff)), g3 = bf2f((u16)(gv.y >> 16));
        uint2 ov;
        ov.x = pack2(o[ds][4 * g] * rinv * sl.x * g0, o[ds][4 * g + 1] * rinv * sl.y * g1);
        ov.y = pack2(o[ds][4 * g + 2] * rinv * sl.z * g2, o[ds][4 * g + 3] * rinv * sl.w * g3);
        *(uint2*)(p.P + prow + C_QC + hd * 128 + d) = ov;
      }
  }
}

__device__ void lru_item(const Params& p, int l, int it, bool pass2, float* sm) {
  const int tid = TIDX;
  const int ci = it >> 3, n = it & 7;
  const int row0 = ci * 64;
  const bool isctx = row0 < NCTX;
  int T, seq0, bidx;
  if (isctx) { T = 256; bidx = row0 >> 8; seq0 = bidx * 256; }
  else { T = 4096; bidx = (row0 - NCTX) >> 12; seq0 = NCTX + bidx * 4096; }
  const int t0 = row0 - seq0;
  float* xin = sm;
  float* xb = sm + 67 * 64;
  float* comb = xb + 64 * 64;
  float* carry = comb + 1024;
  __syncthreads();
  for (int e = tid; e < 67 * 64; e += NT) {
    int rr = e >> 6, cc = e & 63; int t = t0 - 2 + rr;
    float v = 0.f;
    if (t >= 0 && t < T) v = bf2f(p.P[(size_t)(seq0 + t) * PP + C_XB + n * 64 + cc]);
    xin[e] = v;
  }
  __syncthreads();
  {
    const float* cw = p.conv_w + l * 4 * 512; const float* cb = p.conv_b + l * 512;
    for (int e = tid; e < 64 * 64; e += NT) {
      int t = e >> 6, cc = e & 63; int ch = n * 64 + cc;
      float v = cb[ch];
#pragma unroll
      for (int j = 0; j < 4; j++) v += xin[(t + j) * 64 + cc] * cw[j * 512 + ch];
      xb[e] = v;
    }
  }
  __syncthreads();
  const int dout = tid & 63, tg = tid >> 6;
  const int ch = n * 64 + dout;
  float av[2][16], bv[2][16];
#pragma unroll
  for (int d = 0; d < 2; d++) {
    const float* wa = p.lru_wa + ((size_t)((l * 2 + d) * 8 + n) * 64) * 64 + dout;
    const float* wx = p.lru_wx + ((size_t)((l * 2 + d) * 8 + n) * 64) * 64 + dout;
    float ra[16], ia[16];
    const float ba = p.lru_ba[(l * 2 + d) * 512 + ch], bx = p.lru_bx[(l * 2 + d) * 512 + ch];
#pragma unroll
    for (int tt = 0; tt < 16; tt++) { ra[tt] = ba; ia[tt] = bx; }
    for (int c = 0; c < 64; c += 4) {
      float wa0 = wa[(c + 0) * 64], wa1 = wa[(c + 1) * 64], wa2 = wa[(c + 2) * 64], wa3 = wa[(c + 3) * 64];
      float wx0 = wx[(c + 0) * 64], wx1 = wx[(c + 1) * 64], wx2 = wx[(c + 2) * 64], wx3 = wx[(c + 3) * 64];
#pragma unroll
      for (int tt = 0; tt < 16; tt++) {
        float4 xv = *(const float4*)(xb + (tg * 16 + tt) * 64 + c);
        ra[tt] += xv.x * wa0 + xv.y * wa1 + xv.z * wa2 + xv.w * wa3;
        ia[tt] += xv.x * wx0 + xv.y * wx1 + xv.z * wx2 + xv.w * wx3;
      }
    }
    const float lamv = p.lru_lam[(l * 2 + d) * 512 + ch];
    const float sp = log1pf(__expf(-lamv));
#pragma unroll
    for (int tt = 0; tt < 16; tt++) {
      float rg = sigmoidf_(ra[tt]), ig = sigmoidf_(ia[tt]);
      float log_a = -8.f * rg * sp;
      float a = __expf(log_a);
      float bb = sqrtf(-expm1f(2.f * log_a)) * ig * xb[(tg * 16 + tt) * 64 + dout];
      av[d][tt] = a; bv[d][tt] = bb;
    }
  }
  float sA0 = 1.f, sB0 = 0.f, sA1 = 1.f, sB1 = 0.f;
#pragma unroll
  for (int tt = 0; tt < 16; tt++) { sB0 = av[0][tt] * sB0 + bv[0][tt]; sA0 *= av[0][tt]; }
#pragma unroll
  for (int tt = 15; tt >= 0; tt--) { sB1 = av[1][tt] * sB1 + bv[1][tt]; sA1 *= av[1][tt]; }
  comb[((tg * 2 + 0) * 64 + dout) * 2 + 0] = sA0; comb[((tg * 2 + 0) * 64 + dout) * 2 + 1] = sB0;
  comb[((tg * 2 + 1) * 64 + dout) * 2 + 0] = sA1; comb[((tg * 2 + 1) * 64 + dout) * 2 + 1] = sB1;
  if (!pass2) {
    __syncthreads();
    if (tid < 128) {
      int d = tid >> 6, c = tid & 63;
      float At = 1.f, Bt = 0.f;
#pragma unroll
      for (int s = 0; s < 4; s++) {
        int g = (d == 0) ? s : 3 - s;
        float a = comb[((g * 2 + d) * 64 + c) * 2], bq = comb[((g * 2 + d) * 64 + c) * 2 + 1];
        Bt = a * Bt + bq; At *= a;
      }
      float* o = p.lruTot + ((size_t)(ci * 2 + d) * 512 + n * 64 + c) * 2;
      o[0] = At; o[1] = Bt;
    }
    return;
  }
  if (tid < 128) {
    int d = tid >> 6, c = tid & 63; int chn = n * 64 + c;
    float hcar = isctx ? 0.f : p.state_lru[((size_t)(bidx * 2 + l) * 2 + d) * 512 + chn];
    const int cfirst = seq0 >> 6, clast = (seq0 + T - 64) >> 6;
    if (d == 0) {
      for (int cj = cfirst; cj < ci; cj++) {
        const float* q = p.lruTot + ((size_t)(cj * 2 + 0) * 512 + chn) * 2;
        hcar = q[0] * hcar + q[1];
      }
    } else {
      for (int cj = clast; cj > ci; cj--) {
        const float* q = p.lruTot + ((size_t)(cj * 2 + 1) * 512 + chn) * 2;
        hcar = q[0] * hcar + q[1];
      }
    }
    carry[d * 64 + c] = hcar;
  }
  __syncthreads();
  float h0 = carry[dout], h1 = carry[64 + dout];
  for (int g = 0; g < tg; g++) { h0 = comb[((g * 2 + 0) * 64 + dout) * 2] * h0 + comb[((g * 2 + 0) * 64 + dout) * 2 + 1]; }
  for (int g = 3; g > tg; g--) { h1 = comb[((g * 2 + 1) * 64 + dout) * 2] * h1 + comb[((g * 2 + 1) * 64 + dout) * 2 + 1]; }
  float y[16];
#pragma unroll
  for (int tt = 0; tt < 16; tt++) { h0 = av[0][tt] * h0 + bv[0][tt]; y[tt] = h0; }
  const float hf_last = h0;
#pragma unroll
  for (int tt = 15; tt >= 0; tt--) { h1 = av[1][tt] * h1 + bv[1][tt]; y[tt] += h1; }
  const float hb_first = h1;
  if (isctx) {
    if (t0 + 64 == T && tg == 3) p.out[O_ST + ((size_t)(bidx * 2 + l) * 2 + 0) * 512 + ch] = hf_last;
    if (t0 == 0 && tg == 0) p.out[O_ST + ((size_t)(bidx * 2 + l) * 2 + 1) * 512 + ch] = hb_first;
  }
#pragma unroll
  for (int tt = 0; tt < 16; tt++) {
    u16* q = p.P + (size_t)(row0 + tg * 16 + tt) * PP + C_GB + ch;
    *q = f2bf(y[tt] * bf2f(*q));
  }
}

__device__ float compute_lam(const Params& p, int l, float lam_init) {
  float s1 = 0.f, s2 = 0.f;
  for (int i = 0; i < 64; i++) {
    s1 += p.lam_q1[l * 64 + i] * p.lam_k1[l * 64 + i];
    s2 += p.lam_q2[l * 64 + i] * p.lam_k2[l * 64 + i];
  }
  return expf(s1) - expf(s2) + lam_init;
}

__device__ void mix_phase(const Params& p, int l, u16* smem) {
  const float lam_init = (l == 0) ? 0.2f : (0.8f - 0.6f * 0.74081822068f);
  const float lam = compute_lam(p, l, lam_init);
  constexpr int N_CL = 512, N_A = 768, N_CC = 256, N_L = 1536;
  constexpr int TOT = N_CL + N_A + N_CC + N_L;
  const int G = gridDim.x;
  int start = blockIdx.x;
  for (int it = start; it < N_CL; it += G) attnC_item(p, l, 256 + it, smem, lam, lam_init);
  start = (int)((blockIdx.x + G - (N_CL % G)) % G);
  for (int it = start; it < N_A; it += G) attnA_item(p, l, it, smem);
  start = (int)((blockIdx.x + G - ((N_CL + N_A) % G)) % G);
  for (int it = start; it < N_CC; it += G) attnC_item(p, l, it, smem, lam, lam_init);
  start = (int)((blockIdx.x + G - ((N_CL + N_A + N_CC) % G)) % G);
  for (int it = start; it < N_L; it += G) lru_item(p, l, it, false, (float*)smem);
  (void)TOT;
}

__device__ void lru2_phase(const Params& p, int l, u16* smem) {
  for (int it = blockIdx.x; it < 1536; it += gridDim.x) lru_item(p, l, it, true, (float*)smem);
}

__device__ void branch_phase(const Params& p, int l, u16* smem) {
  const int tid = TIDX, lane = tid & 63, wid = tid >> 6, wr = wid >> 1, wc = wid & 1;
  const int r = lane & 31, h = lane >> 5;
  u16* Tl0 = smem; u16* Tl1 = smem + 128 * TROW;
  for (int it = blockIdx.x; it < 96 * 8; it += gridDim.x) {
    const int m0 = (it >> 3) * 128, n0 = (it & 7) * 128;
    f32x16 acc[2][2];
#pragma unroll
    for (int a = 0; a < 2; a++)
#pragma unroll
      for (int b = 0; b < 2; b++)
#pragma unroll
        for (int e = 0; e < 16; e++) acc[a][b][e] = 0.f;
#pragma unroll 1
    for (int i = 0; i < 3; i++) {
      const int acol = (i == 0) ? C_QA : (i == 1 ? C_GB : C_QC);
      gemm_core(p.P + (size_t)m0 * PP + acol, PP, p.Wt_br + ((size_t)(l * 3 + i) * 1024 + n0) * 512, 512, 512, smem, acc);
      {
        const u16* src = p.P + (size_t)m0 * PP + C_MG + i * 1024 + n0;
#pragma unroll
        for (int q = 0; q < 8; q++) {
          int c = tid + q * NT; int row = c >> 4, cc = c & 15;
          *(uint4*)(Tl0 + row * TROW + cc * 8) = *(const uint4*)(src + (size_t)row * PP + cc * 8);
          if (i < 2) *(uint4*)(Tl1 + row * TROW + cc * 8) = *(const uint4*)(src + 1024 + (size_t)row * PP + cc * 8);
        }
      }
      __syncthreads();
#pragma unroll
      for (int mt = 0; mt < 2; mt++)
#pragma unroll
        for (int nt = 0; nt < 2; nt++)
#pragma unroll
          for (int e = 0; e < 16; e++) {
            const int rl = wr * 64 + mt * 32 + (e & 3) + 8 * (e >> 2) + 4 * h;
            float f = bf2f(Tl0[rl * TROW + wc * 64 + nt * 32 + r]);
            if (i < 2) f = __fdividef(f, fmaxf(bf2f(Tl1[rl * TROW + wc * 64 + nt * 32 + r]), 1e-20f));
            acc[mt][nt][e] *= f;
          }
      __syncthreads();
    }
#pragma unroll
    for (int mt = 0; mt < 2; mt++)
#pragma unroll
      for (int nt = 0; nt < 2; nt++)
#pragma unroll
        for (int e = 0; e < 16; e++) {
          const int rl = wr * 64 + mt * 32 + (e & 3) + 8 * (e >> 2) + 4 * h;
          Tl0[rl * TROW + wc * 64 + nt * 32 + r] = f2bf(acc[mt][nt][e]);
        }
    __syncthreads();
    {
      u16* dst = p.H + (size_t)m0 * 1024 + n0;
#pragma unroll
      for (int q = 0; q < 8; q++) {
        int c = tid + q * NT; int row = c >> 4, cc = c & 15;
        *(uint4*)(dst + (size_t)row * 1024 + cc * 8) = *(const uint4*)(Tl0 + row * TROW + cc * 8);
      }
    }
    __syncthreads();
  }
}

__device__ void out_phase(const Params& p, int l, u16* smem) {
  const int tid = TIDX, lane = tid & 63, wid = tid >> 6, wr = wid >> 1, wc = wid & 1;
  const int r = lane & 31, h = lane >> 5;
  for (int it = blockIdx.x; it < 96 * 8; it += gridDim.x) {
    const int m0 = (it >> 3) * 128, n0 = (it & 7) * 128;
    f32x16 acc[2][2];
#pragma unroll
    for (int a = 0; a < 2; a++)
#pragma unroll
      for (int b = 0; b < 2; b++)
#pragma unroll
        for (int e = 0; e < 16; e++) acc[a][b][e] = 0.f;
    gemm_core(p.H + (size_t)m0 * 1024, 1024, p.Wt_out + ((size_t)l * 1024 + n0) * 1024, 1024, 1024, smem, acc);
    const int v = (m0 < NCTX) ? 0 : 1 + (m0 - NCTX) / 4096;
    const float* gt = p.mod + (l * 3 + v) * 3072 + 2048;
#pragma unroll
    for (int mt = 0; mt < 2; mt++)
#pragma unroll
      for (int nt = 0; nt < 2; nt++) {
        int col = n0 + wc * 64 + nt * 32 + r;
        float gv = gt[col];
#pragma unroll
        for (int e = 0; e < 16; e++) {
          int row = m0 + wr * 64 + mt * 32 + (e & 3) + 8 * (e >> 2) + 4 * h;
          float xv;
          if (l == 0) xv = (row < NCTX) ? p.x_prompt[(size_t)row * 1024 + col] : p.x_sample[(size_t)(row - NCTX) * 1024 + col];
          else xv = p.out[O_X + (size_t)row * 1024 + col];
          p.out[O_X + (size_t)row * 1024 + col] = xv + gv * acc[mt][nt][e];
        }
      }
  }
}

__global__ void __launch_bounds__(NT, 2) fwd_kernel(Params p) {
  __shared__ __attribute__((aligned(16))) u16 smem[SMEM_BYTES / 2];
  cg::grid_group grid = cg::this_grid();
  prologue_phase(p, (float*)smem);
  grid.sync();
#pragma unroll 1
  for (int l = 0; l < 2; l++) {
    norm_phase(p, l);
    grid.sync();
    inproj_phase(p, l, smem);
    grid.sync();
    mix_phase(p, l, smem);
    grid.sync();
    lru2_phase(p, l, smem);
    grid.sync();
    branch_phase(p, l, smem);
    grid.sync();
    out_phase(p, l, smem);
    if (l == 0) grid.sync();
  }
}

extern "C" void kernel_launch(void* const* d_in, const int* in_sizes, int n_in, void* d_out, int out_size, void* d_ws,
                              size_t ws_size, hipStream_t stream) {
  Params p{};
  const float** ip = (const float**)&p;
  for (int i = 0; i < 34; i++) ip[i] = (const float*)d_in[i];
  p.out = (float*)d_out;
  char* w = (char*)d_ws; size_t off = 0;
  auto take = [&](size_t bytes) { char* q = w + off; off += (bytes + 255) & ~(size_t)255; return q; };
  p.Wt_in = (u16*)take((size_t)2 * INC * 1024 * 2);
  p.Wt_br = (u16*)take((size_t)6 * 1024 * 512 * 2);
  p.Wt_out = (u16*)take((size_t)2 * 1024 * 1024 * 2);
  p.H = (u16*)take((size_t)NTOK * 1024 * 2);
  p.P = (u16*)take((size_t)NTOK * PP * 2);
  p.VtA_ctx = (u16*)take((size_t)16 * 2 * 64 * 256 * 2);
  p.VtA_lat = (u16*)take((size_t)2 * 2 * 64 * 4096 * 2);
  p.VtC_ctx = (u16*)take((size_t)16 * 4 * 128 * 256 * 2);
  p.VtC_lat = (u16*)take((size_t)2 * 4 * 128 * 4096 * 2);
  p.cKa = (u16*)take((size_t)2 * 2 * 512 * 128 * 2);
  p.cVtA = (u16*)take((size_t)2 * 2 * 512 * 128 * 2);
  p.cKc = (u16*)take((size_t)2 * 2 * 512 * 512 * 2);
  p.cVtC = (u16*)take((size_t)2 * 2 * 512 * 512 * 2);
  p.mod = (float*)take((size_t)2 * 3 * 3072 * 4);
  p.rope = (float*)take((size_t)2048 * 4);
  p.lruTot = (float*)take((size_t)192 * 2 * 512 * 2 * 4);
  static int grid_blocks = 0;
  if (!grid_blocks) {
    int dev = 0, cus = 0, per_cu = 0;
    hipGetDevice(&dev);
    hipDeviceGetAttribute(&cus, hipDeviceAttributeMultiprocessorCount, dev);
    hipOccupancyMaxActiveBlocksPerMultiprocessor(&per_cu, fwd_kernel, NT, 0);
    if (per_cu < 1) per_cu = 1;
    if (per_cu > 2) per_cu = 2;
    grid_blocks = cus * per_cu;
  }
  void* args[] = {&p};
  hipLaunchCooperativeKernel((void*)fwd_kernel, dim3(grid_blocks), dim3(NT), args, 0, stream);
}
```

```cpp
#include <hip/hip_runtime.h>
#include <hip/hip_cooperative_groups.h>
#include <stdint.h>
#include <math.h>
namespace cg = cooperative_groups;

typedef unsigned short u16;
typedef __attribute__((ext_vector_type(8))) short bf16x8;
typedef __attribute__((ext_vector_type(4))) short bf16x4;
typedef __attribute__((ext_vector_type(16))) float f32x16;
typedef __attribute__((ext_vector_type(4))) float f32x4;
#define LAS __attribute__((address_space(3)))

#define NT 512
constexpr int NTOK = 12288, NCTX = 4096;
constexpr int INC = 7424;
constexpr int PP = 6784;
constexpr int C_QA = 0, C_KA = 512, C_GA = 640, C_XB = 1152, C_GB = 1664, C_QC = 2176, C_KC = 2688, C_GC = 3200, C_MG = 3712;
constexpr int LROW = 72;
constexpr int VROW = 68;
constexpr float EPS = 1e-6f;
constexpr int STAGE_BYTES = 131072;
constexpr int SPARE_BYTES = 8192;
constexpr int LDS_BYTES = STAGE_BYTES + SPARE_BYTES;

constexpr size_t O_X = 0, O_KA = 12582912, O_VA = 13631488, O_KC = 14680064, O_VC = 18874368, O_ST = 23068672;

struct Params {
  const float *x_prompt, *x_sample, *cache_a_k, *cache_a_v, *cache_c_k, *cache_c_v, *state_lru, *c, *c_ctx,
      *norm_g, *mod_w, *mod_b, *w_in, *qn_a, *kn_a, *sink_a, *conv_w, *conv_b, *lru_wa, *lru_ba, *lru_wx, *lru_bx,
      *lru_lam, *qn_c, *kn_c, *lam_q1, *lam_k1, *lam_q2, *lam_k2, *subln_c, *w_br_a, *w_br_b, *w_br_c, *w_out;
  float* out;
  u16 *Wt_in, *Wt_br, *Wt_out, *H, *P, *VtA_ctx, *VtA_lat, *VtC_ctx, *VtC_lat, *cKa, *cVtA, *cKc, *cVtC;
  float *mod, *rope, *lruTot;
};

__device__ __forceinline__ int tid_opaque() { int t = (int)threadIdx.x; asm volatile("" : "+v"(t)); return t; }
#define TIDX tid_opaque()
__device__ __forceinline__ u16 f2bf(float f) {
  uint32_t u = __float_as_uint(f);
  u += 0x7FFFu + ((u >> 16) & 1u);
  return (u16)(u >> 16);
}
__device__ __forceinline__ float bf2f(u16 h) { return __uint_as_float(((uint32_t)h) << 16); }
__device__ __forceinline__ uint32_t pack2(float a, float b) { return (uint32_t)f2bf(a) | ((uint32_t)f2bf(b) << 16); }
__device__ __forceinline__ float sigmoidf_(float x) { return 1.f / (1.f + __expf(-x)); }
__device__ __forceinline__ float siluf_(float x) { return x / (1.f + __expf(-x)); }
__device__ __forceinline__ f32x16 mfma32(bf16x8 a, bf16x8 b, f32x16 c) {
  return __builtin_amdgcn_mfma_f32_32x32x16_bf16(a, b, c, 0, 0, 0);
}
__device__ __forceinline__ float shflx(float v, int mask, int lane) {
  return __builtin_bit_cast(float, __builtin_amdgcn_ds_bpermute((lane ^ mask) << 2, __builtin_bit_cast(int, v)));
}
__device__ __forceinline__ float lo_bf(uint32_t w) { return __uint_as_float(w << 16); }
__device__ __forceinline__ float hi_bf(uint32_t w) { return __uint_as_float(w & 0xffff0000u); }

__device__ __forceinline__ void transpose_tile(const float* __restrict__ src, int spitch, u16* __restrict__ dst, int dpitch,
                               int r0, int c0, float* sm) {
  const int tid = TIDX;
#pragma unroll
  for (int i = 0; i < 2; i++) {
    int c = tid + i * NT; int r = c >> 4, q = c & 15;
    float4 v = *(const float4*)(src + (size_t)(r0 + r) * spitch + c0 + q * 4);
    float* d = sm + r * 65 + q * 4;
    d[0] = v.x; d[1] = v.y; d[2] = v.z; d[3] = v.w;
  }
  __syncthreads();
  {
    int c = tid; int cc = c >> 3, q = c & 7;
    uint32_t w[4];
#pragma unroll
    for (int j = 0; j < 4; j++) w[j] = pack2(sm[(q * 8 + 2 * j) * 65 + cc], sm[(q * 8 + 2 * j + 1) * 65 + cc]);
    uint4 v; v.x = w[0]; v.y = w[1]; v.z = w[2]; v.w = w[3];
    *(uint4*)(dst + (size_t)(c0 + cc) * dpitch + r0 + q * 8) = v;
  }
  __syncthreads();
}

__device__ __forceinline__ void mod_item(const Params& p, int it, float* sm) {
  const int tid = TIDX;
  const int l = it / 48, n0 = (it % 48) * 64;
  float* sv = sm;
  float* red = sm + 3072;
  for (int e = tid; e < 3072; e += NT) {
    int v = e >> 10, k = e & 1023;
    float x = (v == 0) ? p.c_ctx[k] : p.c[(v - 1) * 1024 + k];
    sv[e] = siluf_(x);
  }
  __syncthreads();
  const int col = tid & 63, kg = tid >> 6;
  const float* w = p.mod_w + (size_t)l * 1024 * 3072 + n0 + col;
  float a0 = 0, a1 = 0, a2 = 0;
#pragma unroll 8
  for (int k = kg * 128; k < kg * 128 + 128; k++) {
    float wv = w[(size_t)k * 3072];
    a0 += sv[k] * wv; a1 += sv[1024 + k] * wv; a2 += sv[2048 + k] * wv;
  }
  red[(kg * 3 + 0) * 64 + col] = a0; red[(kg * 3 + 1) * 64 + col] = a1; red[(kg * 3 + 2) * 64 + col] = a2;
  __syncthreads();
  if (tid < 192) {
    int v = tid >> 6, c = tid & 63;
    float s = p.mod_b[l * 3072 + n0 + c];
#pragma unroll
    for (int g = 0; g < 8; g++) s += red[(g * 3 + v) * 64 + c];
    p.mod[(l * 3 + v) * 3072 + n0 + c] = s;
  }
  __syncthreads();
}

__device__ __forceinline__ void prologue_phase(const Params& p, float* sm) {
  constexpr int N_MOD = 96, N_ROPE = 1, N_WIN = 2 * 16 * 116, N_WBR = 6 * 8 * 16, N_WOUT = 2 * 16 * 16;
  constexpr int N_CK = 64 + 256, N_CVA = 4 * 16, N_CVC = 4 * 64;
  constexpr int E0 = N_MOD, E1 = E0 + N_ROPE, E2 = E1 + N_WIN, E3 = E2 + N_WBR, E4 = E3 + N_WOUT, E5 = E4 + N_CK,
                E6 = E5 + N_CVA, E7 = E6 + N_CVC;
  const int tid = TIDX;
  for (int it = blockIdx.x; it < E7; it += gridDim.x) {
    if (it < E0) {
      mod_item(p, it, sm);
    } else if (it < E1) {
      for (int e = tid; e < 1024; e += NT) {
        int pos = e >> 4, f = e & 15;
        float inv = powf(10000.f, -(float)f / 16.f);
        float ang = (float)pos * inv;
        p.rope[e] = cosf(ang); p.rope[1024 + e] = sinf(ang);
      }
    } else if (it < E2) {
      int j = it - E1; int l = j / (16 * 116); int r = j % (16 * 116);
      int kt = r / 116, nt = r % 116;
      transpose_tile(p.w_in + (size_t)l * 1024 * INC, INC, p.Wt_in + (size_t)l * INC * 1024, 1024, kt * 64, nt * 64, sm);
    } else if (it < E3) {
      int j = it - E2; int m = j / 128; int r = j % 128;
      int l = m / 3, i = m % 3;
      const float* src = (i == 0 ? p.w_br_a : (i == 1 ? p.w_br_b : p.w_br_c)) + (size_t)l * 512 * 1024;
      int kt = r / 16, nt = r % 16;
      transpose_tile(src, 1024, p.Wt_br + (size_t)m * 1024 * 512, 512, kt * 64, nt * 64, sm);
    } else if (it < E4) {
      int j = it - E3; int l = j / 256; int r = j % 256;
      int kt = r / 16, nt = r % 16;
      transpose_tile(p.w_out + (size_t)l * 1024 * 1024, 1024, p.Wt_out + (size_t)l * 1024 * 1024, 1024, kt * 64, nt * 64, sm);
    } else if (it < E5) {
      int j = it - E4;
      const float* src; u16* dst; size_t off;
      if (j < 64) { src = p.cache_a_k; dst = p.cKa; off = (size_t)j * 4096; }
      else { src = p.cache_c_k; dst = p.cKc; off = (size_t)(j - 64) * 4096; }
      size_t e = off + (size_t)tid * 8;
      float4 a = *(const float4*)(src + e), b = *(const float4*)(src + e + 4);
      uint4 v; v.x = pack2(a.x, a.y); v.y = pack2(a.z, a.w); v.z = pack2(b.x, b.y); v.w = pack2(b.z, b.w);
      *(uint4*)(dst + e) = v;
    } else if (it < E6) {
      int j = it - E5; int bl = j / 16; int r = j % 16;
      int rt = r / 2, ct = r % 2;
      transpose_tile(p.cache_a_v + (size_t)bl * 512 * 128, 128, p.cVtA + (size_t)bl * 128 * 512, 512, rt * 64, ct * 64, sm);
    } else {
      int j = it - E6; int bl = j / 64; int r = j % 64;
      int rt = r / 8, ct = r % 8;
      transpose_tile(p.cache_c_v + (size_t)bl * 512 * 512, 512, p.cVtC + (size_t)bl * 512 * 512, 512, rt * 64, ct * 64, sm);
    }
  }
}

__device__ __forceinline__ void norm_phase(const Params& p, int l) {
  const int tid = TIDX, lane = tid & 63, wid = tid >> 6;
  const float* g = p.norm_g + l * 1024;
  for (int it = blockIdx.x; it < NTOK / 8; it += gridDim.x) {
    int row = it * 8 + wid;
    const float* x;
    if (l == 0) x = (row < NCTX) ? p.x_prompt + (size_t)row * 1024 : p.x_sample + (size_t)(row - NCTX) * 1024;
    else x = p.out + O_X + (size_t)row * 1024;
    int v = (row < NCTX) ? 0 : 1 + (row - NCTX) / 4096;
    const float* md = p.mod + (l * 3 + v) * 3072;
    float4 xv[4]; float ss = 0;
#pragma unroll
    for (int i = 0; i < 4; i++) {
      xv[i] = *(const float4*)(x + i * 256 + lane * 4);
      ss += xv[i].x * xv[i].x + xv[i].y * xv[i].y + xv[i].z * xv[i].z + xv[i].w * xv[i].w;
    }
#pragma unroll
    for (int o = 32; o > 0; o >>= 1) ss += shflx(ss, o, lane);
    float rinv = rsqrtf(ss * (1.f / 1024.f) + EPS);
#pragma unroll
    for (int i = 0; i < 4; i++) {
      int c = i * 256 + lane * 4;
      float4 gv = *(const float4*)(g + c), sh = *(const float4*)(md + c), sc = *(const float4*)(md + 1024 + c);
      float h0 = xv[i].x * rinv * gv.x * (1.f + sc.x) + sh.x;
      float h1 = xv[i].y * rinv * gv.y * (1.f + sc.y) + sh.y;
      float h2 = xv[i].z * rinv * gv.z * (1.f + sc.z) + sh.z;
      float h3 = xv[i].w * rinv * gv.w * (1.f + sc.w) + sh.w;
      uint2 o2; o2.x = pack2(h0, h1); o2.y = pack2(h2, h3);
      *(uint2*)(p.H + (size_t)row * 1024 + c) = o2;
    }
  }
}

constexpr int G_BK = 64, G_HALF = 128, G_HTB = G_HALF * G_BK * 2;
__device__ __forceinline__ int lds_byte(int r, int c) {
  const int st = (r >> 4) * 2 + (c >> 5), rr = r & 15, cc = c & 31, ob = rr * 64 + cc * 2;
  return st * 1024 + (ob ^ (((ob >> 9) & 1) << 5));
}
__device__ __forceinline__ void stage_rc(int b, int& R, int& C) {
  const int st = b / 1024, sb = b % 1024, swz = sb ^ (((sb >> 9) & 1) << 5);
  R = (st >> 1) * 16 + swz / 64; C = (st & 1) * 32 + (swz % 64) / 2;
}
struct Unit { int pm, pn, seg; };

struct SchedStd {
  int nM, nN, nwg, G, c; const char* A; const char* B; size_t tA, tB;
  __device__ __forceinline__ bool next(int i, Unit& u) const {
    const long L = (long)i * G + c; if (L >= nwg) return false;
    int wgid = (int)L;
    { const int q = nwg / 8, r = nwg % 8, xcd = wgid % 8, off = wgid / 8; wgid = (xcd < r ? xcd * (q + 1) : r * (q + 1) + (xcd - r) * q) + off; }
    const int nig = 8 * nN, gid = wgid / nig, fm = gid * 8, gsz = (nM - fm) < 8 ? (nM - fm) : 8;
    u.pm = fm + ((wgid % nig) % gsz); u.pn = (wgid % nig) / gsz; u.seg = 0; return true;
  }
  __device__ __forceinline__ const char* aptr(const Unit& u) const { return A + (size_t)u.pm * tA; }
  __device__ __forceinline__ const char* bptr(const Unit& u) const { return B + (size_t)u.pn * tB; }
};
struct SchedBranch {
  int G, c; const char* P_; const char* W_;
  __device__ __forceinline__ bool next(int i, Unit& u) const {
    const int tile = (i / 3) * G + c; if (tile >= 192) return false;
    u.seg = i % 3; u.pm = tile >> 2; u.pn = tile & 3; return true;
  }
  __device__ __forceinline__ const char* aptr(const Unit& u) const {
    const int col = (u.seg == 0) ? C_QA : (u.seg == 1 ? C_GB : C_QC);
    return P_ + ((size_t)u.pm * 256 * PP + col) * 2;
  }
  __device__ __forceinline__ const char* bptr(const Unit& u) const { return W_ + ((size_t)(u.seg * 1024 + u.pn * 256) * 512) * 2; }
};

template <class Epi, class Sched>
__device__ __forceinline__ void gemm_phase(LAS unsigned char* lds, const int lda, const int ldb, const int K, const Sched& S, const Epi& E) {
  const int tid = TIDX, wid = __builtin_amdgcn_readfirstlane(tid >> 6), lane = tid & 63, wr = wid >> 2, wc = wid & 3, fr = lane & 15, fq = lane >> 4;
  const int nt = K / G_BK;
  unsigned voffA[2], voffB[2];
#pragma unroll
  for (int i = 0; i < 2; ++i) { int R, C; stage_rc(tid * 16 + i * 8192, R, C);
    voffA[i] = (unsigned)(R * lda + C) * 2u; voffB[i] = (unsigned)(R * ldb + C) * 2u; }
  const size_t kstep = (size_t)(G_BK * 2);
  const size_t hA = (size_t)G_HALF * lda * 2, hB = (size_t)G_HALF * ldb * 2;
  const unsigned ldsw = (unsigned)wid * 1024u;
  const int aoff = lds_byte(wr * 64 + fr, fq * 8), boff = lds_byte(wc * 32 + fr, fq * 8);
#define G_SA(b, h) (((b) * 2 + (h)) * G_HTB)
#define G_SB(b, h) ((4 + (b) * 2 + (h)) * G_HTB)
#define G_STAGE(bufoff, gbase, voff) do { _Pragma("unroll") for (int _i = 0; _i < 2; ++_i) \
    __builtin_amdgcn_global_load_lds((const unsigned*)((const char*)(gbase) + (voff)[_i]), (LAS unsigned*)(lds + (bufoff) + ldsw + _i * 8192), 16, 0, 0); } while (0)
#define G_LDA(dst, b, h) do { _Pragma("unroll") for (int m = 0; m < 4; ++m) _Pragma("unroll") for (int k = 0; k < 2; ++k) dst[m][k] = *(const LAS bf16x8*)(lds + G_SA(b, h) + aoff + m * 2048 + k * 1024); } while (0)
#define G_LDB(dst, b, h) do { _Pragma("unroll") for (int n = 0; n < 2; ++n) _Pragma("unroll") for (int k = 0; k < 2; ++k) dst[n][k] = *(const LAS bf16x8*)(lds + G_SB(b, h) + boff + n * 2048 + k * 1024); } while (0)
#define G_MMA(ai, bj, At, Bt) do { __builtin_amdgcn_s_setprio(1); _Pragma("unroll") for (int m = 0; m < 4; ++m) _Pragma("unroll") for (int n = 0; n < 2; ++n) _Pragma("unroll") for (int k = 0; k < 2; ++k) \
    acc[ai][bj][m][n] = __builtin_amdgcn_mfma_f32_16x16x32_bf16(Bt[n][k], At[m][k], acc[ai][bj][m][n], 0, 0, 0); __builtin_amdgcn_s_setprio(0); } while (0)
#define G_WAIT_V(n) asm volatile("s_waitcnt vmcnt(" #n ")" ::: "memory")
#define G_WAIT_L(n) asm volatile("s_waitcnt lgkmcnt(" #n ")" ::: "memory")
#define G_BAR __builtin_amdgcn_s_barrier()
#define G_SCHED __builtin_amdgcn_sched_barrier(0)
  Unit cur, nxt; int ui = 0;
  if (!S.next(0, cur)) return;
  f32x4 acc[2][2][4][2];
#pragma unroll
  for (int a = 0; a < 2; ++a)
#pragma unroll
    for (int b = 0; b < 2; ++b)
#pragma unroll
      for (int m = 0; m < 4; ++m)
#pragma unroll
        for (int n = 0; n < 2; ++n) acc[a][b][m][n] = (f32x4){0.f, 0.f, 0.f, 0.f};
  bf16x8 At[4][2], B0[2][2], B1[2][2];
  const char* cA = S.aptr(cur); const char* cB = S.bptr(cur);
  G_STAGE(G_SB(0, 0), cB, voffB); G_STAGE(G_SA(0, 0), cA, voffA); G_STAGE(G_SB(0, 1), cB + hB, voffB); G_STAGE(G_SA(0, 1), cA + hA, voffA);
  if (wr == 1) G_BAR;
  G_WAIT_V(4); G_BAR;
  G_STAGE(G_SB(1, 0), cB + kstep, voffB); G_STAGE(G_SA(1, 0), cA + kstep, voffA); G_STAGE(G_SB(1, 1), cB + hB + kstep, voffB);
  G_WAIT_V(6); G_BAR;
  for (;;) {
    const bool has_next = S.next(ui + 1, nxt);
    const char* nA = has_next ? S.aptr(nxt) : cA; const char* nB = has_next ? S.bptr(nxt) : cB;
    for (int t = 0; t < nt; t += 2) {
      const bool last = (t == nt - 2);
      const char* a1 = cA + (size_t)(t + 1) * kstep;
      const char* a2 = last ? nA : cA + (size_t)(t + 2) * kstep; const char* b2 = last ? nB : cB + (size_t)(t + 2) * kstep;
      const char* a3 = a2 + kstep; const char* b3 = b2 + kstep;
      G_LDB(B0, 0, 0); G_SCHED; G_LDA(At, 0, 0); G_STAGE(G_SA(1, 1), a1 + hA, voffA);
      G_WAIT_L(8); G_BAR; G_WAIT_L(0); G_MMA(0, 0, At, B0); G_BAR; G_SCHED;
      G_LDB(B1, 0, 1); G_STAGE(G_SB(0, 0), b2, voffB);
      G_BAR; G_WAIT_L(0); G_MMA(0, 1, At, B1); G_BAR;
      G_LDA(At, 0, 1); G_STAGE(G_SA(0, 0), a2, voffA);
      G_BAR; G_WAIT_L(0); G_MMA(1, 0, At, B0); G_BAR; G_SCHED;
      G_STAGE(G_SB(0, 1), b2 + hB, voffB);
      G_WAIT_V(6); G_BAR; G_MMA(1, 1, At, B1); G_BAR;
      G_LDB(B0, 1, 0); G_SCHED; G_LDA(At, 1, 0); G_STAGE(G_SA(0, 1), a2 + hA, voffA);
      G_WAIT_L(8); G_BAR; G_WAIT_L(0); G_MMA(0, 0, At, B0); G_BAR; G_SCHED;
      G_LDB(B1, 1, 1); G_STAGE(G_SB(1, 0), b3, voffB);
      G_BAR; G_WAIT_L(0); G_MMA(0, 1, At, B1); G_BAR;
      G_LDA(At, 1, 1); G_STAGE(G_SA(1, 0), a3, voffA);
      G_BAR; G_WAIT_L(0); G_MMA(1, 0, At, B0); G_BAR; G_SCHED;
      G_STAGE(G_SB(1, 1), b3 + hB, voffB);
      G_WAIT_V(6); G_BAR; G_MMA(1, 1, At, B1); G_BAR;
    }
    const bool reset = E(acc, cur, wr, wc, fr, fq);
    if (!has_next) break;
    if (reset) {
#pragma unroll
      for (int a = 0; a < 2; ++a)
#pragma unroll
        for (int b = 0; b < 2; ++b)
#pragma unroll
          for (int m = 0; m < 4; ++m)
#pragma unroll
            for (int n = 0; n < 2; ++n) acc[a][b][m][n] = (f32x4){0.f, 0.f, 0.f, 0.f};
    }
    cur = nxt; cA = nA; cB = nB; ++ui;
  }
  G_WAIT_V(0);
  if (wr == 0) G_BAR;
  G_BAR;
#undef G_SA
#undef G_SB
#undef G_STAGE
#undef G_LDA
#undef G_LDB
#undef G_MMA
#undef G_WAIT_V
#undef G_WAIT_L
#undef G_BAR
#undef G_SCHED
}

struct EpiInproj {
  const Params* pp; int l; LAS float* part;
  __device__ __forceinline__ bool operator()(f32x4 (&acc)[2][2][4][2], const Unit& u, int wr, int wc, int fr, int fq) const {
    const Params& p = *pp;
    asm volatile("" : "+v"(fr), "+v"(fq));
    const int lane = fr + 16 * fq; (void)lane;
    const int oc0 = u.pn * 256;
    const bool isctx = u.pm < 16;
    const bool qkU = (oc0 < 768) || (oc0 >= 2304 && oc0 < 3328);
    float rinv[2][4][2];
    if (qkU) {
#pragma unroll
      for (int ai = 0; ai < 2; ai++)
#pragma unroll
        for (int m = 0; m < 4; m++)
#pragma unroll
          for (int bj = 0; bj < 2; bj++) {
            f32x4 a = acc[ai][bj][m][0], b = acc[ai][bj][m][1];
            float ss = a[0] * a[0] + a[1] * a[1] + a[2] * a[2] + a[3] * a[3] + b[0] * b[0] + b[1] * b[1] + b[2] * b[2] + b[3] * b[3];
            ss += shflx(ss, 16, lane); ss += shflx(ss, 32, lane);
            rinv[ai][m][bj] = ss;
            if (fq == 0) part[((ai * 128 + wr * 64 + m * 16 + fr) * 2 + bj) * 4 + wc] = ss;
          }
      asm volatile("s_waitcnt lgkmcnt(0)" ::: "memory");
      __builtin_amdgcn_s_barrier();
      asm volatile("" ::: "memory");
#pragma unroll
      for (int ai = 0; ai < 2; ai++)
#pragma unroll
        for (int m = 0; m < 4; m++)
#pragma unroll
          for (int bj = 0; bj < 2; bj++) {
            float o = part[((ai * 128 + wr * 64 + m * 16 + fr) * 2 + bj) * 4 + (wc ^ 1)];
            rinv[ai][m][bj] = rsqrtf((rinv[ai][m][bj] + o) * (1.f / 64.f) + EPS);
          }
    }
#pragma unroll
    for (int bj = 0; bj < 2; bj++) {
      const int oc = oc0 + bj * 128;
      if (oc == 640 || (oc >= 3328 && oc < 3840)) {
        const bool isA = (oc == 640);
        const int cb = isA ? 0 : (oc - 3328);
        const int nvec = isA ? 128 : 512;
#pragma unroll
        for (int ai = 0; ai < 2; ai++)
#pragma unroll
          for (int m = 0; m < 4; m++) {
            const int row = u.pm * 256 + ai * 128 + wr * 64 + m * 16 + fr;
            int b, t, T; u16* vt;
            if (isctx) { b = row >> 8; t = row & 255; T = 256; vt = isA ? p.VtA_ctx : p.VtC_ctx; }
            else { int rr = row - NCTX; b = rr >> 12; t = rr & 4095; T = 4096; vt = isA ? p.VtA_lat : p.VtC_lat; }
#pragma unroll
            for (int n = 0; n < 2; n++) {
              const int d = cb + wc * 32 + n * 16 + fq * 4;
              f32x4 v = acc[ai][bj][m][n];
#pragma unroll
              for (int j = 0; j < 4; j++) vt[((size_t)b * nvec + d + j) * T + t] = f2bf(v[j]);
              if (isctx) {
                float* o = p.out + (isA ? O_VA : O_VC) + ((size_t)(b * 2 + l) * 256 + t) * nvec + d;
                *(f32x4*)o = v;
              }
            }
          }
      } else {
        const int pc = (oc < 640) ? oc : (oc < 3328 ? oc - 128 : oc - 640);
        const bool is_qa = oc < 512, is_ka = (oc == 512);
        const bool is_qc = (oc >= 2304 && oc < 2816), is_kc = (oc >= 2816 && oc < 3328);
        if (is_qa || is_ka || is_qc || is_kc) {
          const float* gn = (is_qa ? p.qn_a : is_ka ? p.kn_a : is_qc ? p.qn_c : p.kn_c) + l * 64 + (wc & 1) * 32 + fq * 4;
          const f32x4 g0 = *(const f32x4*)gn, g1 = *(const f32x4*)(gn + 16);
          const float qs = (is_qa || is_qc) ? 0.125f : 1.f;
#pragma unroll
          for (int ai = 0; ai < 2; ai++)
#pragma unroll
            for (int m = 0; m < 4; m++) {
              const int row = u.pm * 256 + ai * 128 + wr * 64 + m * 16 + fr;
              const float ri = rinv[ai][m][bj];
              f32x4 x1 = acc[ai][bj][m][0] * ri * g0, x2 = acc[ai][bj][m][1] * ri * g1;
              if (!isctx) {
                const int t = (row - NCTX) & 4095;
                const int pos = (wc & 1) ? (t & 63) : (t >> 6);
                const f32x4 cs = *(const f32x4*)(p.rope + pos * 16 + fq * 4), sn = *(const f32x4*)(p.rope + 1024 + pos * 16 + fq * 4);
                f32x4 y1 = x1 * cs - x2 * sn, y2 = x2 * cs + x1 * sn;
                x1 = y1; x2 = y2;
              } else if (is_ka || is_kc) {
                const int b = row >> 8, t = row & 255;
                float* o = is_ka ? p.out + O_KA + ((size_t)(b * 2 + l) * 256 + t) * 128 + wc * 32 + fq * 4
                                 : p.out + O_KC + ((size_t)(b * 2 + l) * 256 + t) * 512 + (oc - 2816) + wc * 32 + fq * 4;
                *(f32x4*)o = x1; *(f32x4*)(o + 16) = x2;
              }
              x1 = x1 * qs; x2 = x2 * qs;
              u16* po = p.P + (size_t)row * PP + pc + wc * 32 + fq * 4;
              *(uint2*)po = make_uint2(pack2(x1[0], x1[1]), pack2(x1[2], x1[3]));
              *(uint2*)(po + 16) = make_uint2(pack2(x2[0], x2[1]), pack2(x2[2], x2[3]));
            }
        } else {
          const int mode = (oc >= 4352) ? 2 : ((oc >= 1280 && oc < 1792) ? 0 : 1);
#pragma unroll
          for (int ai = 0; ai < 2; ai++)
#pragma unroll
            for (int m = 0; m < 4; m++) {
              const int row = u.pm * 256 + ai * 128 + wr * 64 + m * 16 + fr;
              u16* po = p.P + (size_t)row * PP + pc + wc * 32 + fq * 4;
#pragma unroll
              for (int n = 0; n < 2; n++) {
                f32x4 v = acc[ai][bj][m][n];
                if (mode == 1) { v[0] = siluf_(v[0]); v[1] = siluf_(v[1]); v[2] = siluf_(v[2]); v[3] = siluf_(v[3]); }
                else if (mode == 2) { v[0] = sigmoidf_(v[0]); v[1] = sigmoidf_(v[1]); v[2] = sigmoidf_(v[2]); v[3] = sigmoidf_(v[3]); }
                *(uint2*)(po + n * 16) = make_uint2(pack2(v[0], v[1]), pack2(v[2], v[3]));
              }
            }
        }
      }
    }
    return true;
  }
};

struct EpiBranch {
  const Params* pp;
  __device__ __forceinline__ bool operator()(f32x4 (&acc)[2][2][4][2], const Unit& u, int wr, int wc, int fr, int fq) const {
    const Params& p = *pp;
    asm volatile("" : "+v"(fr), "+v"(fq));
    const int lane = fr + 16 * fq; (void)lane;
    const int seg = u.seg;
#pragma unroll
    for (int ai = 0; ai < 2; ai++)
#pragma unroll
      for (int m = 0; m < 4; m++) {
        const int row = u.pm * 256 + ai * 128 + wr * 64 + m * 16 + fr;
#pragma unroll
        for (int bj = 0; bj < 2; bj++)
#pragma unroll
          for (int n = 0; n < 2; n++) {
            const int col = u.pn * 256 + bj * 128 + wc * 32 + n * 16 + fq * 4;
            const u16* mp = p.P + (size_t)row * PP + C_MG + seg * 1024 + col;
            const uint2 a = *(const uint2*)mp;
            f32x4 f = {lo_bf(a.x), hi_bf(a.x), lo_bf(a.y), hi_bf(a.y)};
            if (seg < 2) {
              const uint2 b = *(const uint2*)(mp + 1024);
              f[0] = __fdividef(f[0], fmaxf(lo_bf(b.x), 1e-20f)); f[1] = __fdividef(f[1], fmaxf(hi_bf(b.x), 1e-20f));
              f[2] = __fdividef(f[2], fmaxf(lo_bf(b.y), 1e-20f)); f[3] = __fdividef(f[3], fmaxf(hi_bf(b.y), 1e-20f));
              acc[ai][bj][m][n] = acc[ai][bj][m][n] * f;
            } else {
              f32x4 v = acc[ai][bj][m][n] * f;
              *(uint2*)(p.H + (size_t)row * 1024 + col) = make_uint2(pack2(v[0], v[1]), pack2(v[2], v[3]));
            }
          }
      }
    return seg == 2;
  }
};

struct EpiOut {
  const Params* pp; int l;
  __device__ __forceinline__ bool operator()(f32x4 (&acc)[2][2][4][2], const Unit& u, int wr, int wc, int fr, int fq) const {
    const Params& p = *pp;
    asm volatile("" : "+v"(fr), "+v"(fq));
    const int lane = fr + 16 * fq; (void)lane;
    const int v = (u.pm < 16) ? 0 : 1 + (u.pm - 16) / 16;
    const float* gt = p.mod + (l * 3 + v) * 3072 + 2048;
#pragma unroll
    for (int ai = 0; ai < 2; ai++)
#pragma unroll
      for (int m = 0; m < 4; m++) {
        const int row = u.pm * 256 + ai * 128 + wr * 64 + m * 16 + fr;
        const float* xr;
        if (l == 0) xr = (row < NCTX) ? p.x_prompt + (size_t)row * 1024 : p.x_sample + (size_t)(row - NCTX) * 1024;
        else xr = p.out + O_X + (size_t)row * 1024;
        float* orow = p.out + O_X + (size_t)row * 1024;
#pragma unroll
        for (int bj = 0; bj < 2; bj++)
#pragma unroll
          for (int n = 0; n < 2; n++) {
            const int col = u.pn * 256 + bj * 128 + wc * 32 + n * 16 + fq * 4;
            const f32x4 xv = *(const f32x4*)(xr + col), gv = *(const f32x4*)(gt + col);
            *(f32x4*)(orow + col) = xv + gv * acc[ai][bj][m][n];
          }
      }
    return true;
  }
};

template <int DV, bool MASK>
__device__ __forceinline__ void flash_step(const u16* Ks, const u16* Vts, const bf16x8 (&qf)[4], float& m, float& l,
                                           f32x16 (&o)[DV / 32], int lane, int kpos0, int qpos, int T) {
  const int r = lane & 31, h = lane >> 5;
  f32x16 s[2];
#pragma unroll
  for (int sub = 0; sub < 2; sub++) {
#pragma unroll
    for (int e = 0; e < 16; e++) s[sub][e] = 0.f;
#pragma unroll
    for (int ks = 0; ks < 4; ks++) {
      bf16x8 kf = *(const bf16x8*)(Ks + (sub * 32 + r) * LROW + ks * 16 + h * 8);
      s[sub] = mfma32(kf, qf[ks], s[sub]);
    }
  }
  if (MASK) {
#pragma unroll
    for (int sub = 0; sub < 2; sub++)
#pragma unroll
      for (int e = 0; e < 16; e++) {
        int kp = kpos0 + sub * 32 + (e & 3) + 8 * (e >> 2) + 4 * h;
        int dlt = kp - qpos;
        bool ok = (kp >= 0) && (kp < T) && (dlt <= 128) && (dlt >= -128);
        if (!ok) s[sub][e] = -INFINITY;
      }
  }
  float mx = s[0][0];
#pragma unroll
  for (int sub = 0; sub < 2; sub++)
#pragma unroll
    for (int e = 0; e < 16; e++) mx = fmaxf(mx, s[sub][e]);
  mx = fmaxf(mx, shflx(mx, 32, lane));
  const float mn = fmaxf(m, mx);
  const float alpha = __expf(m - mn);
  float sum = 0.f;
#pragma unroll
  for (int sub = 0; sub < 2; sub++)
#pragma unroll
    for (int e = 0; e < 16; e++) { float pv = __expf(s[sub][e] - mn); s[sub][e] = pv; sum += pv; }
  sum += shflx(sum, 32, lane);
  l = l * alpha + sum; m = mn;
#pragma unroll
  for (int ds = 0; ds < DV / 32; ds++)
#pragma unroll
    for (int e = 0; e < 16; e++) o[ds][e] *= alpha;
#pragma unroll
  for (int sub = 0; sub < 2; sub++)
#pragma unroll
    for (int st = 0; st < 2; st++) {
      bf16x8 pf;
#pragma unroll
      for (int j = 0; j < 8; j++) pf[j] = (short)f2bf(s[sub][8 * st + j]);
#pragma unroll
      for (int ds = 0; ds < DV / 32; ds++) {
        const u16* vp = Vts + (ds * 32 + r) * VROW + sub * 32 + 16 * st + 4 * h;
        bf16x4 lo = *(const bf16x4*)vp, hi = *(const bf16x4*)(vp + 8);
        bf16x8 vf = __builtin_shufflevector(lo, hi, 0, 1, 2, 3, 4, 5, 6, 7);
        o[ds] = mfma32(vf, pf, o[ds]);
      }
    }
}

__device__ __forceinline__ uint4 ld_k(const u16* __restrict__ src, size_t pitch, int r0, int nrows, int c) {
  int row = c >> 3, kc = c & 7; int rr = r0 + row;
  uint4 v = make_uint4(0, 0, 0, 0);
  if (rr >= 0 && rr < nrows) v = *(const uint4*)(src + (size_t)rr * pitch + kc * 8);
  return v;
}
__device__ __forceinline__ void st_k(u16* dst, int c, uint4 v) { *(uint4*)(dst + (c >> 3) * LROW + (c & 7) * 8) = v; }
__device__ __forceinline__ uint4 ld_vt(const u16* __restrict__ src, int T, int k0, int c) {
  int d = c >> 3, kc = c & 7; int k = k0 + kc * 8;
  uint4 v = make_uint4(0, 0, 0, 0);
  if (k >= 0 && k < T) v = *(const uint4*)(src + (size_t)d * T + k);
  return v;
}
__device__ __forceinline__ void st_vt(u16* dst, int c, uint4 v) {
  uint2* q = (uint2*)(dst + (c >> 3) * VROW + (c & 7) * 8);
  q[0] = make_uint2(v.x, v.y); q[1] = make_uint2(v.z, v.w);
}

constexpr int A_BUF = 64 * LROW + 64 * VROW;
__device__ __forceinline__ void attnA_item(const Params& p, int l, int it, u16* sm) {
  const int tid = TIDX, lane = tid & 63, wid = tid >> 6;
  const int r = lane & 31, h = lane >> 5;
  const bool isctx = it < 128;
  int b, kvh, qb, T, rowbase; const u16* VtBase;
  if (isctx) { b = it >> 3; kvh = (it >> 2) & 1; qb = it & 3; T = 256; rowbase = b * 256;
    VtBase = p.VtA_ctx + ((size_t)(b * 2 + kvh) * 64) * 256; }
  else { int j = it - 128; b = j >> 7; kvh = (j >> 6) & 1; qb = j & 63; T = 4096; rowbase = NCTX + b * 4096;
    VtBase = p.VtA_lat + ((size_t)(b * 2 + kvh) * 64) * 4096; }
  const int qblk = qb * 64;
  const int q0 = qblk + (wid >> 2) * 32;
  const int head = kvh * 4 + (wid & 3);
  const size_t prow = (size_t)(rowbase + q0 + r) * PP;
  bf16x8 qf[4];
#pragma unroll
  for (int ks = 0; ks < 4; ks++) qf[ks] = *(const bf16x8*)(p.P + prow + C_QA + head * 64 + ks * 16 + h * 8);
  float m = p.sink_a[l * 8 + head], ls = 1.f;
  f32x16 o[2];
#pragma unroll
  for (int ds = 0; ds < 2; ds++)
#pragma unroll
    for (int e = 0; e < 16; e++) o[ds][e] = 0.f;
  const u16* Kbase = p.P + (size_t)rowbase * PP + C_KA + kvh * 64;
  const u16* cK = p.cKa + ((size_t)(b * 2 + l) * 512) * 128 + kvh * 64;
  const u16* cVt = p.cVtA + ((size_t)((b * 2 + l) * 2 + kvh) * 64) * 512;
  const int qpos = q0 + r;
  int i_lo = 0, nW, ntile;
  if (isctx) { nW = 4; ntile = 4; }
  else {
    i_lo = (qblk < 128) ? (128 - qblk) / 64 : 0;
    int i_hi = (T - qblk + 128) / 64; if (i_hi > 5) i_hi = 5;
    nW = i_hi - i_lo; ntile = nW + 8;
  }
  uint4 rk, rv;
  auto tile_load = [&](int t) {
    if (t < nW) {
      int k0 = isctx ? t * 64 : qblk - 128 + 64 * (i_lo + t);
      rk = ld_k(Kbase, PP, k0, T, tid); rv = ld_vt(VtBase, T, k0, tid);
    } else {
      int kt = t - nW;
      rk = ld_k(cK, 128, kt * 64, 512, tid); rv = ld_vt(cVt, 512, kt * 64, tid);
    }
  };
  __syncthreads();
  tile_load(0);
  st_k(sm, tid, rk); st_vt(sm + 64 * LROW, tid, rv);
  __syncthreads();
  for (int t = 0; t < ntile; t++) {
    const bool more = t + 1 < ntile;
    if (more) tile_load(t + 1);
    const u16* Ks = sm + (t & 1) * A_BUF; const u16* Vts = Ks + 64 * LROW;
    if (!isctx && t < nW) flash_step<64, true>(Ks, Vts, qf, m, ls, o, lane, qblk - 128 + 64 * (i_lo + t), qpos, T);
    else flash_step<64, false>(Ks, Vts, qf, m, ls, o, lane, 0, 0, T);
    if (more) { u16* d = sm + ((t + 1) & 1) * A_BUF; st_k(d, tid, rk); st_vt(d + 64 * LROW, tid, rv); }
    __syncthreads();
  }
  const float inv = 1.f / ls;
#pragma unroll
  for (int ds = 0; ds < 2; ds++)
#pragma unroll
    for (int g = 0; g < 4; g++) {
      int d = ds * 32 + 8 * g + 4 * h;
      uint2 gv = *(const uint2*)(p.P + prow + C_GA + head * 64 + d);
      uint2 ov;
      ov.x = pack2(o[ds][4 * g] * inv * lo_bf(gv.x), o[ds][4 * g + 1] * inv * hi_bf(gv.x));
      ov.y = pack2(o[ds][4 * g + 2] * inv * lo_bf(gv.y), o[ds][4 * g + 3] * inv * hi_bf(gv.y));
      *(uint2*)(p.P + prow + C_QA + head * 64 + d) = ov;
    }
}

constexpr int C_BUF = 128 * LROW + 128 * VROW;
__device__ __forceinline__ void attnC_item(const Params& p, int l, int it, u16* sm, float lam, float lam_init) {
  const int tid = TIDX, lane = tid & 63, wid = tid >> 6;
  const int r = lane & 31, h = lane >> 5;
  const bool isctx = it < 128;
  int b, hd, qb, T, rowbase; const u16* VtBase;
  if (isctx) { b = it >> 3; hd = (it >> 1) & 3; qb = it & 1; T = 256; rowbase = b * 256;
    VtBase = p.VtC_ctx + ((size_t)(b * 4 + hd) * 128) * 256; }
  else { int j = it - 128; b = j >> 7; hd = (j >> 5) & 3; qb = j & 31; T = 4096; rowbase = NCTX + b * 4096;
    VtBase = p.VtC_lat + ((size_t)(b * 4 + hd) * 128) * 4096; }
  const int qg = wid & 3, map = wid >> 2;
  const int q0 = qb * 128 + qg * 32;
  const size_t prow = (size_t)(rowbase + q0 + r) * PP;
  bf16x8 qf[4];
#pragma unroll
  for (int ks = 0; ks < 4; ks++) qf[ks] = *(const bf16x8*)(p.P + prow + C_QC + hd * 128 + map * 64 + ks * 16 + h * 8);
  float m = -1e30f, ls = 0.f;
  f32x16 o[4];
#pragma unroll
  for (int ds = 0; ds < 4; ds++)
#pragma unroll
    for (int e = 0; e < 16; e++) o[ds][e] = 0.f;
  const u16* Kbase = p.P + (size_t)rowbase * PP + C_KC + hd * 128;
  const u16* cK = p.cKc + ((size_t)(b * 2 + l) * 512) * 512 + hd * 128;
  const u16* cVt = p.cVtC + ((size_t)((b * 2 + l) * 4 + hd) * 128) * 512;
  const int nW = T / 64, ntile = isctx ? nW : nW + 8;
  uint4 rk0, rk1, rv0, rv1;
  auto tile_load = [&](int t) {
    if (t < nW) {
      rk0 = ld_k(Kbase, PP, t * 64, T, tid); rk1 = ld_k(Kbase + 64, PP, t * 64, T, tid);
      rv0 = ld_vt(VtBase, T, t * 64, tid); rv1 = ld_vt(VtBase, T, t * 64, tid + NT);
    } else {
      int kt = t - nW;
      rk0 = ld_k(cK, 512, kt * 64, 512, tid); rk1 = ld_k(cK + 64, 512, kt * 64, 512, tid);
      rv0 = ld_vt(cVt, 512, kt * 64, tid); rv1 = ld_vt(cVt, 512, kt * 64, tid + NT);
    }
  };
  auto tile_store = [&](u16* d) {
    st_k(d, tid, rk0); st_k(d + 64 * LROW, tid, rk1);
    st_vt(d + 128 * LROW, tid, rv0); st_vt(d + 128 * LROW, tid + NT, rv1);
  };
  __syncthreads();
  tile_load(0);
  tile_store(sm);
  __syncthreads();
  for (int t = 0; t < ntile; t++) {
    const bool more = t + 1 < ntile;
    if (more) tile_load(t + 1);
    const u16* base = sm + (t & 1) * C_BUF;
    flash_step<128, false>(base + map * 64 * LROW, base + 128 * LROW, qf, m, ls, o, lane, 0, 0, T);
    if (more) tile_store(sm + ((t + 1) & 1) * C_BUF);
    __syncthreads();
  }
  float* xch = (float*)sm;
  if (map == 1) {
    const float inv = lam / ls;
#pragma unroll
    for (int ds = 0; ds < 4; ds++)
#pragma unroll
      for (int e = 0; e < 16; e++) xch[((qg * 64) + ds * 16 + e) * 64 + lane] = o[ds][e] * inv;
  }
  __syncthreads();
  if (map == 0) {
    const float i0 = 1.f / ls;
    float ss = 0.f;
#pragma unroll
    for (int ds = 0; ds < 4; ds++)
#pragma unroll
      for (int e = 0; e < 16; e++) {
        float v = o[ds][e] * i0 - xch[((qg * 64) + ds * 16 + e) * 64 + lane];
        o[ds][e] = v; ss += v * v;
      }
    ss += shflx(ss, 32, lane);
    const float rinv = rsqrtf(ss * (1.f / 128.f) + EPS) * (1.f - lam_init);
    const float* sg = p.subln_c + l * 128;
#pragma unroll
    for (int ds = 0; ds < 4; ds++)
#pragma unroll
      for (int g = 0; g < 4; g++) {
        int d = ds * 32 + 8 * g + 4 * h;
        uint2 gv = *(const uint2*)(p.P + prow + C_GC + hd * 128 + d);
        float4 sl = *(const float4*)(sg + d);
        uint2 ov;
        ov.x = pack2(o[ds][4 * g] * rinv * sl.x * lo_bf(gv.x), o[ds][4 * g + 1] * rinv * sl.y * hi_bf(gv.x));
        ov.y = pack2(o[ds][4 * g + 2] * rinv * sl.z * lo_bf(gv.y), o[ds][4 * g + 3] * rinv * sl.w * hi_bf(gv.y));
        *(uint2*)(p.P + prow + C_QC + hd * 128 + d) = ov;
      }
  }
}

__device__ __forceinline__ void lru_item(const Params& p, int l, int it, bool pass2, float* sm) {
  const int tid = TIDX;
  const int ci = it >> 3, n = it & 7;
  const int row0 = ci * 64;
  const bool isctx = row0 < NCTX;
  int T, seq0, bidx;
  if (isctx) { T = 256; bidx = row0 >> 8; seq0 = bidx * 256; }
  else { T = 4096; bidx = (row0 - NCTX) >> 12; seq0 = NCTX + bidx * 4096; }
  const int t0 = row0 - seq0;
  float* xin = sm;
  float* xb = sm + 67 * 64;
  float* comb = xb + 64 * 64;
  float* carry = comb + 2048;
  __syncthreads();
  for (int e = tid; e < 67 * 64; e += NT) {
    int rr = e >> 6, cc = e & 63; int t = t0 - 2 + rr;
    float v = 0.f;
    if (t >= 0 && t < T) v = bf2f(p.P[(size_t)(seq0 + t) * PP + C_XB + n * 64 + cc]);
    xin[e] = v;
  }
  __syncthreads();
  {
    const float* cw = p.conv_w + l * 4 * 512; const float* cb = p.conv_b + l * 512;
    for (int e = tid; e < 64 * 64; e += NT) {
      int t = e >> 6, cc = e & 63; int ch = n * 64 + cc;
      float v = cb[ch];
#pragma unroll
      for (int j = 0; j < 4; j++) v += xin[(t + j) * 64 + cc] * cw[j * 512 + ch];
      xb[e] = v;
    }
  }
  __syncthreads();
  const int dout = tid & 63, tg = tid >> 6;
  const int ch = n * 64 + dout;
  float av[2][8], bv[2][8];
#pragma unroll
  for (int d = 0; d < 2; d++) {
    const float* wa = p.lru_wa + ((size_t)((l * 2 + d) * 8 + n) * 64) * 64 + dout;
    const float* wx = p.lru_wx + ((size_t)((l * 2 + d) * 8 + n) * 64) * 64 + dout;
    float ra[8], ia[8];
    const float ba = p.lru_ba[(l * 2 + d) * 512 + ch], bx = p.lru_bx[(l * 2 + d) * 512 + ch];
#pragma unroll
    for (int tt = 0; tt < 8; tt++) { ra[tt] = ba; ia[tt] = bx; }
    for (int c = 0; c < 64; c += 4) {
      float wa0 = wa[(c + 0) * 64], wa1 = wa[(c + 1) * 64], wa2 = wa[(c + 2) * 64], wa3 = wa[(c + 3) * 64];
      float wx0 = wx[(c + 0) * 64], wx1 = wx[(c + 1) * 64], wx2 = wx[(c + 2) * 64], wx3 = wx[(c + 3) * 64];
#pragma unroll
      for (int tt = 0; tt < 8; tt++) {
        float4 xv = *(const float4*)(xb + (tg * 8 + tt) * 64 + c);
        ra[tt] += xv.x * wa0 + xv.y * wa1 + xv.z * wa2 + xv.w * wa3;
        ia[tt] += xv.x * wx0 + xv.y * wx1 + xv.z * wx2 + xv.w * wx3;
      }
    }
    const float lamv = p.lru_lam[(l * 2 + d) * 512 + ch];
    const float sp = log1pf(__expf(-lamv));
#pragma unroll
    for (int tt = 0; tt < 8; tt++) {
      float rg = sigmoidf_(ra[tt]), ig = sigmoidf_(ia[tt]);
      float log_a = -8.f * rg * sp;
      float a = __expf(log_a);
      float bb = sqrtf(-expm1f(2.f * log_a)) * ig * xb[(tg * 8 + tt) * 64 + dout];
      av[d][tt] = a; bv[d][tt] = bb;
    }
  }
  float sA0 = 1.f, sB0 = 0.f, sA1 = 1.f, sB1 = 0.f;
#pragma unroll
  for (int tt = 0; tt < 8; tt++) { sB0 = av[0][tt] * sB0 + bv[0][tt]; sA0 *= av[0][tt]; }
#pragma unroll
  for (int tt = 7; tt >= 0; tt--) { sB1 = av[1][tt] * sB1 + bv[1][tt]; sA1 *= av[1][tt]; }
  comb[((tg * 2 + 0) * 64 + dout) * 2 + 0] = sA0; comb[((tg * 2 + 0) * 64 + dout) * 2 + 1] = sB0;
  comb[((tg * 2 + 1) * 64 + dout) * 2 + 0] = sA1; comb[((tg * 2 + 1) * 64 + dout) * 2 + 1] = sB1;
  if (!pass2) {
    __syncthreads();
    if (tid < 128) {
      int d = tid >> 6, c = tid & 63;
      float At = 1.f, Bt = 0.f;
#pragma unroll
      for (int s = 0; s < 8; s++) {
        int g = (d == 0) ? s : 7 - s;
        float a = comb[((g * 2 + d) * 64 + c) * 2], bq = comb[((g * 2 + d) * 64 + c) * 2 + 1];
        Bt = a * Bt + bq; At *= a;
      }
      float* o = p.lruTot + ((size_t)(ci * 2 + d) * 512 + n * 64 + c) * 2;
      o[0] = At; o[1] = Bt;
    }
    return;
  }
  if (tid < 128) {
    int d = tid >> 6, c = tid & 63; int chn = n * 64 + c;
    float hcar = isctx ? 0.f : p.state_lru[((size_t)(bidx * 2 + l) * 2 + d) * 512 + chn];
    const int cfirst = seq0 >> 6, clast = (seq0 + T - 64) >> 6;
    if (d == 0) {
      for (int cj = cfirst; cj < ci; cj++) {
        const float* q = p.lruTot + ((size_t)(cj * 2 + 0) * 512 + chn) * 2;
        hcar = q[0] * hcar + q[1];
      }
    } else {
      for (int cj = clast; cj > ci; cj--) {
        const float* q = p.lruTot + ((size_t)(cj * 2 + 1) * 512 + chn) * 2;
        hcar = q[0] * hcar + q[1];
      }
    }
    carry[d * 64 + c] = hcar;
  }
  __syncthreads();
  float h0 = carry[dout], h1 = carry[64 + dout];
  for (int g = 0; g < tg; g++) { h0 = comb[((g * 2 + 0) * 64 + dout) * 2] * h0 + comb[((g * 2 + 0) * 64 + dout) * 2 + 1]; }
  for (int g = 7; g > tg; g--) { h1 = comb[((g * 2 + 1) * 64 + dout) * 2] * h1 + comb[((g * 2 + 1) * 64 + dout) * 2 + 1]; }
  float y[8];
#pragma unroll
  for (int tt = 0; tt < 8; tt++) { h0 = av[0][tt] * h0 + bv[0][tt]; y[tt] = h0; }
  const float hf_last = h0;
#pragma unroll
  for (int tt = 7; tt >= 0; tt--) { h1 = av[1][tt] * h1 + bv[1][tt]; y[tt] += h1; }
  const float hb_first = h1;
  if (isctx) {
    if (t0 + 64 == T && tg == 7) p.out[O_ST + ((size_t)(bidx * 2 + l) * 2 + 0) * 512 + ch] = hf_last;
    if (t0 == 0 && tg == 0) p.out[O_ST + ((size_t)(bidx * 2 + l) * 2 + 1) * 512 + ch] = hb_first;
  }
#pragma unroll
  for (int tt = 0; tt < 8; tt++) {
    u16* q = p.P + (size_t)(row0 + tg * 8 + tt) * PP + C_GB + ch;
    *q = f2bf(y[tt] * bf2f(*q));
  }
}

__device__ __forceinline__ float compute_lam(const Params& p, int l, float lam_init) {
  float s1 = 0.f, s2 = 0.f;
  for (int i = 0; i < 64; i++) {
    s1 += p.lam_q1[l * 64 + i] * p.lam_k1[l * 64 + i];
    s2 += p.lam_q2[l * 64 + i] * p.lam_k2[l * 64 + i];
  }
  return expf(s1) - expf(s2) + lam_init;
}

__device__ __forceinline__ void mix_phase(const Params& p, int l, u16* smem) {
  const float lam_init = (l == 0) ? 0.2f : (0.8f - 0.6f * 0.74081822068f);
  const float lam = compute_lam(p, l, lam_init);
  constexpr int N_CL = 256, N_A = 384, N_CC = 128, N_L = 1536;
  const int G = gridDim.x;
  int start = blockIdx.x;
  for (int it = start; it < N_CL; it += G) attnC_item(p, l, 128 + it, smem, lam, lam_init);
  start = (int)((blockIdx.x + G - (N_CL % G)) % G);
  for (int it = start; it < N_A; it += G) attnA_item(p, l, it, smem);
  start = (int)((blockIdx.x + G - ((N_CL + N_A) % G)) % G);
  for (int it = start; it < N_CC; it += G) attnC_item(p, l, it, smem, lam, lam_init);
  start = (int)((blockIdx.x + G - ((N_CL + N_A + N_CC) % G)) % G);
  for (int it = start; it < N_L; it += G) lru_item(p, l, it, false, (float*)smem);
}

__device__ __forceinline__ void lru2_phase(const Params& p, int l, u16* smem) {
  for (int it = blockIdx.x; it < 1536; it += gridDim.x) lru_item(p, l, it, true, (float*)smem);
}

typedef __attribute__((address_space(4))) const Params CParams;
__device__ __forceinline__ const Params& get_params() {
  CParams* kp = (CParams*)__builtin_amdgcn_kernarg_segment_ptr();
  asm volatile("" : "+s"(kp));
  return *(const Params*)kp;
}
__global__ void __launch_bounds__(NT, 2) fwd_kernel(Params p_unused) {
  extern __shared__ __attribute__((aligned(16))) unsigned char lds_raw[];
  u16* smem = (u16*)lds_raw;
  LAS unsigned char* lds = (LAS unsigned char*)lds_raw;
  cg::grid_group grid = cg::this_grid();
  prologue_phase(get_params(), (float*)smem);
  grid.sync();
#pragma unroll 1
  for (int l = 0; l < 2; l++) {
    norm_phase(get_params(), l);
    grid.sync();
    {
      const Params& p = get_params();
      SchedStd S; S.nM = NTOK / 256; S.nN = INC / 256; S.nwg = S.nM * S.nN; S.G = gridDim.x; S.c = blockIdx.x;
      S.A = (const char*)p.H; S.B = (const char*)(p.Wt_in + (size_t)l * INC * 1024); S.tA = (size_t)256 * 1024 * 2; S.tB = (size_t)256 * 1024 * 2;
      EpiInproj E; E.pp = &p; E.l = l; E.part = (LAS float*)(lds + STAGE_BYTES);
      gemm_phase(lds, 1024, 1024, 1024, S, E);
    }
    grid.sync();
    mix_phase(get_params(), l, smem);
    grid.sync();
    lru2_phase(get_params(), l, smem);
    grid.sync();
    {
      const Params& p = get_params();
      SchedBranch S; S.G = gridDim.x; S.c = blockIdx.x; S.P_ = (const char*)p.P; S.W_ = (const char*)(p.Wt_br + (size_t)l * 3 * 1024 * 512);
      EpiBranch E; E.pp = &p;
      gemm_phase(lds, PP, 512, 512, S, E);
    }
    grid.sync();
    {
      const Params& p = get_params();
      SchedStd S; S.nM = NTOK / 256; S.nN = 4; S.nwg = S.nM * S.nN; S.G = gridDim.x; S.c = blockIdx.x;
      S.A = (const char*)p.H; S.B = (const char*)(p.Wt_out + (size_t)l * 1024 * 1024); S.tA = (size_t)256 * 1024 * 2; S.tB = (size_t)256 * 1024 * 2;
      EpiOut E; E.pp = &p; E.l = l;
      gemm_phase(lds, 1024, 1024, 1024, S, E);
    }
    if (l == 0) grid.sync();
  }
}

extern "C" void kernel_launch(void* const* d_in, const int* in_sizes, int n_in, void* d_out, int out_size, void* d_ws,
                              size_t ws_size, hipStream_t stream) {
  Params p{};
  const float** ip = (const float**)&p;
  for (int i = 0; i < 34; i++) ip[i] = (const float*)d_in[i];
  p.out = (float*)d_out;
  char* w = (char*)d_ws; size_t off = 0;
  auto take = [&](size_t bytes) { char* q = w + off; off += (bytes + 255) & ~(size_t)255; return q; };
  p.Wt_in = (u16*)take((size_t)2 * INC * 1024 * 2);
  p.Wt_br = (u16*)take((size_t)6 * 1024 * 512 * 2);
  p.Wt_out = (u16*)take((size_t)2 * 1024 * 1024 * 2);
  p.H = (u16*)take((size_t)NTOK * 1024 * 2);
  p.P = (u16*)take((size_t)NTOK * PP * 2);
  p.VtA_ctx = (u16*)take((size_t)16 * 2 * 64 * 256 * 2);
  p.VtA_lat = (u16*)take((size_t)2 * 2 * 64 * 4096 * 2);
  p.VtC_ctx = (u16*)take((size_t)16 * 4 * 128 * 256 * 2);
  p.VtC_lat = (u16*)take((size_t)2 * 4 * 128 * 4096 * 2);
  p.cKa = (u16*)take((size_t)2 * 2 * 512 * 128 * 2);
  p.cVtA = (u16*)take((size_t)2 * 2 * 512 * 128 * 2);
  p.cKc = (u16*)take((size_t)2 * 2 * 512 * 512 * 2);
  p.cVtC = (u16*)take((size_t)2 * 2 * 512 * 512 * 2);
  p.mod = (float*)take((size_t)2 * 3 * 3072 * 4);
  p.rope = (float*)take((size_t)2048 * 4);
  p.lruTot = (float*)take((size_t)192 * 2 * 512 * 2 * 4);
  static int grid_blocks = 0;
  if (!grid_blocks) {
    int dev = 0, cus = 0;
    hipGetDevice(&dev);
    hipDeviceGetAttribute(&cus, hipDeviceAttributeMultiprocessorCount, dev);
    hipFuncSetAttribute((const void*)fwd_kernel, hipFuncAttributeMaxDynamicSharedMemorySize, LDS_BYTES);
    int per_cu = 0;
    hipOccupancyMaxActiveBlocksPerMultiprocessor(&per_cu, (const void*)fwd_kernel, NT, LDS_BYTES);
    (void)hipGetLastError();
    grid_blocks = cus;
  }
  void* args[] = {&p};
  hipLaunchCooperativeKernel((void*)fwd_kernel, dim3(grid_blocks), dim3(NT), args, LDS_BYTES, stream);
}
```

```cpp
#include <hip/hip_runtime.h>
#include <hip/hip_cooperative_groups.h>
#include <stdint.h>
#include <math.h>
namespace cg = cooperative_groups;

typedef unsigned short u16;
typedef __attribute__((ext_vector_type(8))) short bf16x8;
typedef __attribute__((ext_vector_type(4))) short bf16x4;
typedef __attribute__((ext_vector_type(16))) float f32x16;
typedef __attribute__((ext_vector_type(4))) float f32x4;
#define LAS __attribute__((address_space(3)))

#ifndef PROBE
#define PROBE 0
#endif
#define NT 512
constexpr int NTOK = 12288, NCTX = 4096;
constexpr int INC = 7424;
constexpr int PP = 3712;
constexpr int C_QA = 0, C_KA = 512, C_GA = 640, C_XB = 1152, C_GB = 1664, C_QC = 2176, C_KC = 2688, C_GC = 3200;
constexpr int LROW = 72;
constexpr int VROW = 68;
constexpr float EPS = 1e-6f;
constexpr int STAGE_BYTES = 131072;
constexpr int SPARE_BYTES = 8192;
constexpr int LDS_BYTES = STAGE_BYTES + SPARE_BYTES;

constexpr size_t O_X = 0, O_KA = 12582912, O_VA = 13631488, O_KC = 14680064, O_VC = 18874368, O_ST = 23068672;

struct Params {
  const float *x_prompt, *x_sample, *cache_a_k, *cache_a_v, *cache_c_k, *cache_c_v, *state_lru, *c, *c_ctx,
      *norm_g, *mod_w, *mod_b, *w_in, *qn_a, *kn_a, *sink_a, *conv_w, *conv_b, *lru_wa, *lru_ba, *lru_wx, *lru_bx,
      *lru_lam, *qn_c, *kn_c, *lam_q1, *lam_k1, *lam_q2, *lam_k2, *subln_c, *w_br_a, *w_br_b, *w_br_c, *w_out;
  float* out;
  u16 *Wt_in, *Wt_br, *Wt_out, *H, *P, *VtA_ctx, *VtA_lat, *VtC_ctx, *VtC_lat, *cKa, *cVtA, *cKc, *cVtC;
  float *mod, *rope, *lruTot;
  u16 *Wt_lru;
  uint2* MG;
};

__device__ __forceinline__ int tid_opaque() { int t = (int)threadIdx.x; asm volatile("" : "+v"(t)); return t; }
#define TIDX tid_opaque()
__device__ __forceinline__ u16 f2bf(float f) {
  uint32_t u = __float_as_uint(f);
  u += 0x7FFFu + ((u >> 16) & 1u);
  return (u16)(u >> 16);
}
__device__ __forceinline__ float bf2f(u16 h) { return __uint_as_float(((uint32_t)h) << 16); }
__device__ __forceinline__ uint32_t pack2(float a, float b) { uint32_t r; asm("v_cvt_pk_bf16_f32 %0, %1, %2" : "=v"(r) : "v"(a), "v"(b)); return r; }
__device__ __forceinline__ float sigmoidf_(float x) { return 1.f / (1.f + __expf(-x)); }
__device__ __forceinline__ float siluf_(float x) { return x / (1.f + __expf(-x)); }
__device__ __forceinline__ f32x16 mfma32(bf16x8 a, bf16x8 b, f32x16 c) {
  return __builtin_amdgcn_mfma_f32_32x32x16_bf16(a, b, c, 0, 0, 0);
}
__device__ __forceinline__ float shflx(float v, int mask, int lane) {
  return __builtin_bit_cast(float, __builtin_amdgcn_ds_bpermute((lane ^ mask) << 2, __builtin_bit_cast(int, v)));
}
__device__ __forceinline__ float lo_bf(uint32_t w) { return __uint_as_float(w << 16); }
__device__ __forceinline__ float hi_bf(uint32_t w) { return __uint_as_float(w & 0xffff0000u); }

__device__ __forceinline__ void transpose_tile(const float* __restrict__ src, int spitch, u16* __restrict__ dst, int dpitch,
                               int r0, int c0, float* sm) {
  const int tid = TIDX;
#pragma unroll
  for (int i = 0; i < 2; i++) {
    int c = tid + i * NT; int r = c >> 4, q = c & 15;
    float4 v = *(const float4*)(src + (size_t)(r0 + r) * spitch + c0 + q * 4);
    float* d = sm + r * 65 + q * 4;
    d[0] = v.x; d[1] = v.y; d[2] = v.z; d[3] = v.w;
  }
  __syncthreads();
  {
    int c = tid; int cc = c >> 3, q = c & 7;
    uint32_t w[4];
#pragma unroll
    for (int j = 0; j < 4; j++) w[j] = pack2(sm[(q * 8 + 2 * j) * 65 + cc], sm[(q * 8 + 2 * j + 1) * 65 + cc]);
    uint4 v; v.x = w[0]; v.y = w[1]; v.z = w[2]; v.w = w[3];
    *(uint4*)(dst + (size_t)(c0 + cc) * dpitch + r0 + q * 8) = v;
  }
  __syncthreads();
}

__device__ __forceinline__ void mod_item(const Params& p, int it, float* sm) {
  const int tid = TIDX;
  const int l = it / 48, n0 = (it % 48) * 64;
  float* sv = sm;
  float* red = sm + 3072;
  for (int e = tid; e < 3072; e += NT) {
    int v = e >> 10, k = e & 1023;
    float x = (v == 0) ? p.c_ctx[k] : p.c[(v - 1) * 1024 + k];
    sv[e] = siluf_(x);
  }
  __syncthreads();
  const int col = tid & 63, kg = tid >> 6;
  const float* w = p.mod_w + (size_t)l * 1024 * 3072 + n0 + col;
  float a0 = 0, a1 = 0, a2 = 0;
#pragma unroll 8
  for (int k = kg * 128; k < kg * 128 + 128; k++) {
    float wv = w[(size_t)k * 3072];
    a0 += sv[k] * wv; a1 += sv[1024 + k] * wv; a2 += sv[2048 + k] * wv;
  }
  red[(kg * 3 + 0) * 64 + col] = a0; red[(kg * 3 + 1) * 64 + col] = a1; red[(kg * 3 + 2) * 64 + col] = a2;
  __syncthreads();
  if (tid < 192) {
    int v = tid >> 6, c = tid & 63;
    float s = p.mod_b[l * 3072 + n0 + c];
#pragma unroll
    for (int g = 0; g < 8; g++) s += red[(g * 3 + v) * 64 + c];
    p.mod[(l * 3 + v) * 3072 + n0 + c] = s;
  }
  __syncthreads();
}

__device__ __forceinline__ void prologue_phase(const Params& p, float* sm) {
  constexpr int N_MOD = 96, N_ROPE = 1, N_WIN = 2 * 16 * 116, N_WBR = 6 * 8 * 16, N_WOUT = 2 * 16 * 16;
  constexpr int N_CK = 64 + 256, N_CVA = 4 * 16, N_CVC = 4 * 64, N_LW = 64;
  constexpr int E0 = N_MOD, E1 = E0 + N_ROPE, E2 = E1 + N_WIN, E3 = E2 + N_WBR, E4 = E3 + N_WOUT, E5 = E4 + N_CK,
                E6 = E5 + N_CVA, E7 = E6 + N_CVC, E8 = E7 + N_LW;
  const int tid = TIDX;
  for (int it = blockIdx.x; it < E8; it += gridDim.x) {
    if (it < E0) {
      mod_item(p, it, sm);
    } else if (it < E1) {
      for (int e = tid; e < 1024; e += NT) {
        int pos = e >> 4, f = e & 15;
        float inv = powf(10000.f, -(float)f / 16.f);
        float ang = (float)pos * inv;
        p.rope[e] = cosf(ang); p.rope[1024 + e] = sinf(ang);
      }
    } else if (it < E2) {
      int j = it - E1; int l = j / (16 * 116); int r = j % (16 * 116);
      int kt = r / 116, nt = r % 116;
      transpose_tile(p.w_in + (size_t)l * 1024 * INC, INC, p.Wt_in + (size_t)l * INC * 1024, 1024, kt * 64, nt * 64, sm);
    } else if (it < E3) {
      int j = it - E2; int m = j / 128; int r = j % 128;
      int l = m / 3, i = m % 3;
      const float* src = (i == 0 ? p.w_br_a : (i == 1 ? p.w_br_b : p.w_br_c)) + (size_t)l * 512 * 1024;
      int kt = r / 16, nt = r % 16;
      transpose_tile(src, 1024, p.Wt_br + (size_t)m * 1024 * 512, 512, kt * 64, nt * 64, sm);
    } else if (it < E4) {
      int j = it - E3; int l = j / 256; int r = j % 256;
      int kt = r / 16, nt = r % 16;
      transpose_tile(p.w_out + (size_t)l * 1024 * 1024, 1024, p.Wt_out + (size_t)l * 1024 * 1024, 1024, kt * 64, nt * 64, sm);
    } else if (it < E5) {
      int j = it - E4;
      const float* src; u16* dst; size_t off;
      if (j < 64) { src = p.cache_a_k; dst = p.cKa; off = (size_t)j * 4096; }
      else { src = p.cache_c_k; dst = p.cKc; off = (size_t)(j - 64) * 4096; }
      size_t e = off + (size_t)tid * 8;
      float4 a = *(const float4*)(src + e), b = *(const float4*)(src + e + 4);
      uint4 v; v.x = pack2(a.x, a.y); v.y = pack2(a.z, a.w); v.z = pack2(b.x, b.y); v.w = pack2(b.z, b.w);
      *(uint4*)(dst + e) = v;
    } else if (it < E6) {
      int j = it - E5; int bl = j / 16; int r = j % 16;
      int rt = r / 2, ct = r % 2;
      transpose_tile(p.cache_a_v + (size_t)bl * 512 * 128, 128, p.cVtA + (size_t)bl * 128 * 512, 512, rt * 64, ct * 64, sm);
    } else if (it < E7) {
      int j = it - E6; int bl = j / 64; int r = j % 64;
      int rt = r / 8, ct = r % 8;
      transpose_tile(p.cache_c_v + (size_t)bl * 512 * 512, 512, p.cVtC + (size_t)bl * 512 * 512, 512, rt * 64, ct * 64, sm);
    } else {
      int j = it - E7; int ldn = j >> 1, g = j & 1;
      transpose_tile((g ? p.lru_wx : p.lru_wa) + (size_t)ldn * 4096, 64, p.Wt_lru + (size_t)(ldn * 2 + g) * 4096, 64, 0, 0, sm);
    }
  }
}

__device__ __forceinline__ void norm_phase(const Params& p, int l) {
  const int tid = TIDX, lane = tid & 63, wid = tid >> 6;
  const float* g = p.norm_g + l * 1024;
  for (int it = blockIdx.x; it < NTOK / 8; it += gridDim.x) {
    int row = it * 8 + wid;
    const float* x;
    if (l == 0) x = (row < NCTX) ? p.x_prompt + (size_t)row * 1024 : p.x_sample + (size_t)(row - NCTX) * 1024;
    else x = p.out + O_X + (size_t)row * 1024;
    int v = (row < NCTX) ? 0 : 1 + (row - NCTX) / 4096;
    const float* md = p.mod + (l * 3 + v) * 3072;
    float4 xv[4]; float ss = 0;
#pragma unroll
    for (int i = 0; i < 4; i++) {
      xv[i] = *(const float4*)(x + i * 256 + lane * 4);
      ss += xv[i].x * xv[i].x + xv[i].y * xv[i].y + xv[i].z * xv[i].z + xv[i].w * xv[i].w;
    }
#pragma unroll
    for (int o = 32; o > 0; o >>= 1) ss += shflx(ss, o, lane);
    float rinv = rsqrtf(ss * (1.f / 1024.f) + EPS);
#pragma unroll
    for (int i = 0; i < 4; i++) {
      int c = i * 256 + lane * 4;
      float4 gv = *(const float4*)(g + c), sh = *(const float4*)(md + c), sc = *(const float4*)(md + 1024 + c);
      float h0 = xv[i].x * rinv * gv.x * (1.f + sc.x) + sh.x;
      float h1 = xv[i].y * rinv * gv.y * (1.f + sc.y) + sh.y;
      float h2 = xv[i].z * rinv * gv.z * (1.f + sc.z) + sh.z;
      float h3 = xv[i].w * rinv * gv.w * (1.f + sc.w) + sh.w;
      uint2 o2; o2.x = pack2(h0, h1); o2.y = pack2(h2, h3);
      *(uint2*)(p.H + (size_t)row * 1024 + c) = o2;
    }
  }
}

constexpr int G_BK = 64, G_HALF = 128, G_HTB = G_HALF * G_BK * 2;
__device__ __forceinline__ int lds_byte(int r, int c) {
  const int st = (r >> 4) * 2 + (c >> 5), rr = r & 15, cc = c & 31, ob = rr * 64 + cc * 2;
  return st * 1024 + (ob ^ (((ob >> 9) & 1) << 5));
}
__device__ __forceinline__ void stage_rc(int b, int& R, int& C) {
  const int st = b / 1024, sb = b % 1024, swz = sb ^ (((sb >> 9) & 1) << 5);
  R = (st >> 1) * 16 + swz / 64; C = (st & 1) * 32 + (swz % 64) / 2;
}
struct Unit { int pm, pn, seg; };

struct SchedStd {
  int nM, nN, nwg, G, c; const char* A; const char* B; size_t tA, tB;
  __device__ __forceinline__ bool next(int i, Unit& u) const {
    const long L = (long)i * G + c; if (L >= nwg) return false;
    int wgid = (int)L;
    { const int q = nwg / 8, r = nwg % 8, xcd = wgid % 8, off = wgid / 8; wgid = (xcd < r ? xcd * (q + 1) : r * (q + 1) + (xcd - r) * q) + off; }
    const int nig = 8 * nN, gid = wgid / nig, fm = gid * 8, gsz = (nM - fm) < 8 ? (nM - fm) : 8;
    u.pm = fm + ((wgid % nig) % gsz); u.pn = (wgid % nig) / gsz; u.seg = 0; return true;
  }
  __device__ __forceinline__ const char* aptr(const Unit& u) const { return A + (size_t)u.pm * tA; }
  __device__ __forceinline__ const char* bptr(const Unit& u) const { return B + (size_t)u.pn * tB; }
};
struct SchedBranch {
  int G, c; const char* P_; const char* W_;
  __device__ __forceinline__ bool next(int i, Unit& u) const {
    const int tile = (i / 3) * G + c; if (tile >= 192) return false;
    u.seg = i % 3; u.pm = tile >> 2; u.pn = tile & 3; return true;
  }
  __device__ __forceinline__ const char* aptr(const Unit& u) const {
    const int col = (u.seg == 0) ? C_QA : (u.seg == 1 ? C_GB : C_QC);
    return P_ + ((size_t)u.pm * 256 * PP + col) * 2;
  }
  __device__ __forceinline__ const char* bptr(const Unit& u) const { return W_ + ((size_t)(u.seg * 1024 + u.pn * 256) * 512) * 2; }
};

template <class Epi, class Sched>
__device__ __forceinline__ void gemm_phase(LAS unsigned char* lds, const int lda, const int ldb, const int K, const Sched& S, const Epi& E) {
  const int tid = TIDX, wid = __builtin_amdgcn_readfirstlane(tid >> 6), lane = tid & 63, wr = wid >> 2, wc = wid & 3, fr = lane & 15, fq = lane >> 4;
  const int nt = K / G_BK;
  unsigned voffA[2], voffB[2];
#pragma unroll
  for (int i = 0; i < 2; ++i) { int R, C; stage_rc(tid * 16 + i * 8192, R, C);
    voffA[i] = (unsigned)(R * lda + C) * 2u; voffB[i] = (unsigned)(R * ldb + C) * 2u; }
  const size_t kstep = (size_t)(G_BK * 2);
  const size_t hA = (size_t)G_HALF * lda * 2, hB = (size_t)G_HALF * ldb * 2;
  const unsigned ldsw = (unsigned)wid * 1024u;
  const int aoff = lds_byte(wr * 64 + fr, fq * 8), boff = lds_byte(wc * 32 + fr, fq * 8);
#define G_SA(b, h) (((b) * 2 + (h)) * G_HTB)
#define G_SB(b, h) ((4 + (b) * 2 + (h)) * G_HTB)
#define G_STAGE(bufoff, gbase, voff) do { _Pragma("unroll") for (int _i = 0; _i < 2; ++_i) \
    __builtin_amdgcn_global_load_lds((const unsigned*)((const char*)(gbase) + (voff)[_i]), (LAS unsigned*)(lds + (bufoff) + ldsw + _i * 8192), 16, 0, 0); } while (0)
#define G_LDA(dst, b, h) do { _Pragma("unroll") for (int m = 0; m < 4; ++m) _Pragma("unroll") for (int k = 0; k < 2; ++k) dst[m][k] = *(const LAS bf16x8*)(lds + G_SA(b, h) + aoff + m * 2048 + k * 1024); } while (0)
#define G_LDB(dst, b, h) do { _Pragma("unroll") for (int n = 0; n < 2; ++n) _Pragma("unroll") for (int k = 0; k < 2; ++k) dst[n][k] = *(const LAS bf16x8*)(lds + G_SB(b, h) + boff + n * 2048 + k * 1024); } while (0)
#define G_MMA(ai, bj, At, Bt) do { __builtin_amdgcn_s_setprio(1); _Pragma("unroll") for (int m = 0; m < 4; ++m) _Pragma("unroll") for (int n = 0; n < 2; ++n) _Pragma("unroll") for (int k = 0; k < 2; ++k) \
    acc[ai][bj][m][n] = __builtin_amdgcn_mfma_f32_16x16x32_bf16(Bt[n][k], At[m][k], acc[ai][bj][m][n], 0, 0, 0); __builtin_amdgcn_s_setprio(0); } while (0)
#define G_WAIT_V(n) asm volatile("s_waitcnt vmcnt(" #n ")" ::: "memory")
#define G_WAIT_L(n) asm volatile("s_waitcnt lgkmcnt(" #n ")" ::: "memory")
#define G_BAR __builtin_amdgcn_s_barrier()
#define G_SCHED __builtin_amdgcn_sched_barrier(0)
  Unit cur, nxt; int ui = 0;
  if (!S.next(0, cur)) return;
  f32x4 acc[2][2][4][2];
#pragma unroll
  for (int a = 0; a < 2; ++a)
#pragma unroll
    for (int b = 0; b < 2; ++b)
#pragma unroll
      for (int m = 0; m < 4; ++m)
#pragma unroll
        for (int n = 0; n < 2; ++n) acc[a][b][m][n] = (f32x4){0.f, 0.f, 0.f, 0.f};
  bf16x8 At[4][2], B0[2][2], B1[2][2];
  const char* cA = S.aptr(cur); const char* cB = S.bptr(cur);
  G_STAGE(G_SB(0, 0), cB, voffB); G_STAGE(G_SA(0, 0), cA, voffA); G_STAGE(G_SB(0, 1), cB + hB, voffB); G_STAGE(G_SA(0, 1), cA + hA, voffA);
  if (wr == 1) G_BAR;
  G_WAIT_V(4); G_BAR;
  G_STAGE(G_SB(1, 0), cB + kstep, voffB); G_STAGE(G_SA(1, 0), cA + kstep, voffA); G_STAGE(G_SB(1, 1), cB + hB + kstep, voffB);
  G_WAIT_V(6); G_BAR;
  for (;;) {
    const bool has_next = S.next(ui + 1, nxt);
    const char* nA = has_next ? S.aptr(nxt) : cA; const char* nB = has_next ? S.bptr(nxt) : cB;
    for (int t = 0; t < nt; t += 2) {
      const bool last = (t == nt - 2);
      const char* a1 = cA + (size_t)(t + 1) * kstep;
      const char* a2 = last ? nA : cA + (size_t)(t + 2) * kstep; const char* b2 = last ? nB : cB + (size_t)(t + 2) * kstep;
      const char* a3 = a2 + kstep; const char* b3 = b2 + kstep;
      G_LDB(B0, 0, 0); G_SCHED; G_LDA(At, 0, 0); G_STAGE(G_SA(1, 1), a1 + hA, voffA);
      G_WAIT_L(8); G_BAR; G_WAIT_L(0); G_MMA(0, 0, At, B0); G_BAR; G_SCHED;
      G_LDB(B1, 0, 1); G_STAGE(G_SB(0, 0), b2, voffB);
      G_BAR; G_WAIT_L(0); G_MMA(0, 1, At, B1); G_BAR;
      G_LDA(At, 0, 1); G_STAGE(G_SA(0, 0), a2, voffA);
      G_BAR; G_WAIT_L(0); G_MMA(1, 0, At, B0); G_BAR; G_SCHED;
      G_STAGE(G_SB(0, 1), b2 + hB, voffB);
      G_WAIT_V(6); G_BAR; G_MMA(1, 1, At, B1); G_BAR;
      G_LDB(B0, 1, 0); G_SCHED; G_LDA(At, 1, 0); G_STAGE(G_SA(0, 1), a2 + hA, voffA);
      G_WAIT_L(8); G_BAR; G_WAIT_L(0); G_MMA(0, 0, At, B0); G_BAR; G_SCHED;
      G_LDB(B1, 1, 1); G_STAGE(G_SB(1, 0), b3, voffB);
      G_BAR; G_WAIT_L(0); G_MMA(0, 1, At, B1); G_BAR;
      G_LDA(At, 1, 1); G_STAGE(G_SA(1, 0), a3, voffA);
      G_BAR; G_WAIT_L(0); G_MMA(1, 0, At, B0); G_BAR; G_SCHED;
      G_STAGE(G_SB(1, 1), b3 + hB, voffB);
      G_WAIT_V(6); G_BAR; G_MMA(1, 1, At, B1); G_BAR;
    }
    const bool reset = E(acc, cur, wr, wc, fr, fq);
    if (!has_next) break;
    if (reset) {
#pragma unroll
      for (int a = 0; a < 2; ++a)
#pragma unroll
        for (int b = 0; b < 2; ++b)
#pragma unroll
          for (int m = 0; m < 4; ++m)
#pragma unroll
            for (int n = 0; n < 2; ++n) acc[a][b][m][n] = (f32x4){0.f, 0.f, 0.f, 0.f};
    }
    cur = nxt; cA = nA; cB = nB; ++ui;
  }
  G_WAIT_V(0);
  if (wr == 0) G_BAR;
  G_BAR;
#undef G_SA
#undef G_SB
#undef G_STAGE
#undef G_LDA
#undef G_LDB
#undef G_MMA
#undef G_WAIT_V
#undef G_WAIT_L
#undef G_BAR
#undef G_SCHED
}

struct EpiInproj {
  const Params* pp; int l; LAS float* part;
  __device__ __forceinline__ bool operator()(f32x4 (&acc)[2][2][4][2], const Unit& u, int wr, int wc, int fr, int fq) const {
    const Params& p = *pp;
    asm volatile("" : "+v"(fr), "+v"(fq));
    const int lane = fr + 16 * fq; (void)lane;
    const int oc0 = u.pn * 256;
    const bool isctx = u.pm < 16;
    const bool qkU = (oc0 < 768) || (oc0 >= 2304 && oc0 < 3328);
    float rinv[2][4][2];
    if (qkU) {
#pragma unroll
      for (int ai = 0; ai < 2; ai++)
#pragma unroll
        for (int m = 0; m < 4; m++)
#pragma unroll
          for (int bj = 0; bj < 2; bj++) {
            f32x4 a = acc[ai][bj][m][0], b = acc[ai][bj][m][1];
            float ss = a[0] * a[0] + a[1] * a[1] + a[2] * a[2] + a[3] * a[3] + b[0] * b[0] + b[1] * b[1] + b[2] * b[2] + b[3] * b[3];
            ss += shflx(ss, 16, lane); ss += shflx(ss, 32, lane);
            rinv[ai][m][bj] = ss;
            if (fq == 0) part[((ai * 128 + wr * 64 + m * 16 + fr) * 2 + bj) * 4 + wc] = ss;
          }
      asm volatile("s_waitcnt lgkmcnt(0)" ::: "memory");
      __builtin_amdgcn_s_barrier();
      asm volatile("" ::: "memory");
#pragma unroll
      for (int ai = 0; ai < 2; ai++)
#pragma unroll
        for (int m = 0; m < 4; m++)
#pragma unroll
          for (int bj = 0; bj < 2; bj++) {
            float o = part[((ai * 128 + wr * 64 + m * 16 + fr) * 2 + bj) * 4 + (wc ^ 1)];
            rinv[ai][m][bj] = rsqrtf((rinv[ai][m][bj] + o) * (1.f / 64.f) + EPS);
          }
    }
#pragma unroll
    for (int bj = 0; bj < 2; bj++) {
      const int oc = oc0 + bj * 128;
      if (oc == 640 || (oc >= 3328 && oc < 3840)) {
        const bool isA = (oc == 640);
        const int cb = isA ? 0 : (oc - 3328);
        const int nvec = isA ? 128 : 512;
#pragma unroll
        for (int ai = 0; ai < 2; ai++)
#pragma unroll
          for (int m = 0; m < 4; m++) {
            const int row = u.pm * 256 + ai * 128 + wr * 64 + m * 16 + fr;
            int b, t, T; u16* vt;
            if (isctx) { b = row >> 8; t = row & 255; T = 256; vt = isA ? p.VtA_ctx : p.VtC_ctx; }
            else { int rr = row - NCTX; b = rr >> 12; t = rr & 4095; T = 4096; vt = isA ? p.VtA_lat : p.VtC_lat; }
#pragma unroll
            for (int n = 0; n < 2; n++) {
              const int d = cb + wc * 32 + n * 16 + fq * 4;
              f32x4 v = acc[ai][bj][m][n];
#pragma unroll
              for (int j = 0; j < 4; j++) vt[((size_t)b * nvec + d + j) * T + t] = f2bf(v[j]);
              if (isctx) {
                float* o = p.out + (isA ? O_VA : O_VC) + ((size_t)(b * 2 + l) * 256 + t) * nvec + d;
                *(f32x4*)o = v;
              }
            }
          }
      } else {
        const int pc = (oc < 640) ? oc : (oc < 3328 ? oc - 128 : oc - 640);
        const bool is_qa = oc < 512, is_ka = (oc == 512);
        const bool is_qc = (oc >= 2304 && oc < 2816), is_kc = (oc >= 2816 && oc < 3328);
        if (is_qa || is_ka || is_qc || is_kc) {
          const float* gn = (is_qa ? p.qn_a : is_ka ? p.kn_a : is_qc ? p.qn_c : p.kn_c) + l * 64 + (wc & 1) * 32 + fq * 4;
          const f32x4 g0 = *(const f32x4*)gn, g1 = *(const f32x4*)(gn + 16);
          const float qs = (is_qa || is_qc) ? 0.18033688011112042f : 1.f;
#pragma unroll
          for (int ai = 0; ai < 2; ai++)
#pragma unroll
            for (int m = 0; m < 4; m++) {
              const int row = u.pm * 256 + ai * 128 + wr * 64 + m * 16 + fr;
              const float ri = rinv[ai][m][bj];
              f32x4 x1 = acc[ai][bj][m][0] * ri * g0, x2 = acc[ai][bj][m][1] * ri * g1;
              if (!isctx) {
                const int t = (row - NCTX) & 4095;
                const int pos = (wc & 1) ? (t & 63) : (t >> 6);
                const f32x4 cs = *(const f32x4*)(p.rope + pos * 16 + fq * 4), sn = *(const f32x4*)(p.rope + 1024 + pos * 16 + fq * 4);
                f32x4 y1 = x1 * cs - x2 * sn, y2 = x2 * cs + x1 * sn;
                x1 = y1; x2 = y2;
              } else if (is_ka || is_kc) {
                const int b = row >> 8, t = row & 255;
                float* o = is_ka ? p.out + O_KA + ((size_t)(b * 2 + l) * 256 + t) * 128 + wc * 32 + fq * 4
                                 : p.out + O_KC + ((size_t)(b * 2 + l) * 256 + t) * 512 + (oc - 2816) + wc * 32 + fq * 4;
                *(f32x4*)o = x1; *(f32x4*)(o + 16) = x2;
              }
              x1 = x1 * qs; x2 = x2 * qs;
              u16* po = p.P + (size_t)row * PP + pc + wc * 32 + fq * 4;
              *(uint2*)po = make_uint2(pack2(x1[0], x1[1]), pack2(x1[2], x1[3]));
              *(uint2*)(po + 16) = make_uint2(pack2(x2[0], x2[1]), pack2(x2[2], x2[3]));
            }
        } else {
          const int mode = (oc >= 4352) ? 2 : ((oc >= 1280 && oc < 1792) ? 0 : 1);
          if (mode == 2) {
            const int pj = u.pn - 17, seg = pj >> 2, pn4 = pj & 3;
            uint2* mg = p.MG + ((size_t)((u.pm * 4 + pn4) * 3 + seg) * 8 + (wr * 4 + wc)) * 2048 + lane;
#pragma unroll
            for (int ai = 0; ai < 2; ai++)
#pragma unroll
              for (int m = 0; m < 4; m++)
#pragma unroll
                for (int n = 0; n < 2; n++) {
                  f32x4 v = acc[ai][bj][m][n];
                  v[0] = sigmoidf_(v[0]); v[1] = sigmoidf_(v[1]); v[2] = sigmoidf_(v[2]); v[3] = sigmoidf_(v[3]);
                  mg[(((ai * 4 + m) * 2 + bj) * 2 + n) * 64] = make_uint2(pack2(v[0], v[1]), pack2(v[2], v[3]));
                }
          } else
#pragma unroll
          for (int ai = 0; ai < 2; ai++)
#pragma unroll
            for (int m = 0; m < 4; m++) {
              const int row = u.pm * 256 + ai * 128 + wr * 64 + m * 16 + fr;
              u16* po = p.P + (size_t)row * PP + pc + wc * 32 + fq * 4;
#pragma unroll
              for (int n = 0; n < 2; n++) {
                f32x4 v = acc[ai][bj][m][n];
                if (mode == 1) { v[0] = siluf_(v[0]); v[1] = siluf_(v[1]); v[2] = siluf_(v[2]); v[3] = siluf_(v[3]); }
                else if (mode == 2) { v[0] = sigmoidf_(v[0]); v[1] = sigmoidf_(v[1]); v[2] = sigmoidf_(v[2]); v[3] = sigmoidf_(v[3]); }
                *(uint2*)(po + n * 16) = make_uint2(pack2(v[0], v[1]), pack2(v[2], v[3]));
              }
            }
        }
      }
    }
    return true;
  }
};

struct EpiBranch {
  const Params* pp;
  __device__ __forceinline__ bool operator()(f32x4 (&acc)[2][2][4][2], const Unit& u, int wr, int wc, int fr, int fq) const {
    const Params& p = *pp;
    asm volatile("" : "+v"(fr), "+v"(fq));
    const int lane = fr + 16 * fq;
    const int seg = u.seg;
    const uint2* mg = p.MG + ((size_t)((u.pm * 4 + u.pn) * 3 + seg) * 8 + (wr * 4 + wc)) * 2048 + lane;
#pragma unroll
    for (int ai = 0; ai < 2; ai++)
#pragma unroll
      for (int m = 0; m < 4; m++) {
        const int row = u.pm * 256 + ai * 128 + wr * 64 + m * 16 + fr;
#pragma unroll
        for (int bj = 0; bj < 2; bj++)
#pragma unroll
          for (int n = 0; n < 2; n++) {
            const int idx = (((ai * 4 + m) * 2 + bj) * 2 + n) * 64;
            const uint2 a = mg[idx];
            f32x4 f = {lo_bf(a.x), hi_bf(a.x), lo_bf(a.y), hi_bf(a.y)};
            if (seg < 2) {
              const uint2 b = mg[idx + 8 * 2048];
              f[0] = __fdividef(f[0], fmaxf(lo_bf(b.x), 1e-20f)); f[1] = __fdividef(f[1], fmaxf(hi_bf(b.x), 1e-20f));
              f[2] = __fdividef(f[2], fmaxf(lo_bf(b.y), 1e-20f)); f[3] = __fdividef(f[3], fmaxf(hi_bf(b.y), 1e-20f));
              acc[ai][bj][m][n] = acc[ai][bj][m][n] * f;
            } else {
              const int col = u.pn * 256 + bj * 128 + wc * 32 + n * 16 + fq * 4;
              f32x4 v = acc[ai][bj][m][n] * f;
              *(uint2*)(p.H + (size_t)row * 1024 + col) = make_uint2(pack2(v[0], v[1]), pack2(v[2], v[3]));
            }
          }
      }
    return seg == 2;
  }
};

struct EpiOut {
  const Params* pp; int l;
  __device__ __forceinline__ bool operator()(f32x4 (&acc)[2][2][4][2], const Unit& u, int wr, int wc, int fr, int fq) const {
    const Params& p = *pp;
    asm volatile("" : "+v"(fr), "+v"(fq));
    const int lane = fr + 16 * fq; (void)lane;
    const int v = (u.pm < 16) ? 0 : 1 + (u.pm - 16) / 16;
    const float* gt = p.mod + (l * 3 + v) * 3072 + 2048;
#pragma unroll
    for (int ai = 0; ai < 2; ai++)
#pragma unroll
      for (int m = 0; m < 4; m++) {
        const int row = u.pm * 256 + ai * 128 + wr * 64 + m * 16 + fr;
        const float* xr;
        if (l == 0) xr = (row < NCTX) ? p.x_prompt + (size_t)row * 1024 : p.x_sample + (size_t)(row - NCTX) * 1024;
        else xr = p.out + O_X + (size_t)row * 1024;
        float* orow = p.out + O_X + (size_t)row * 1024;
#pragma unroll
        for (int bj = 0; bj < 2; bj++)
#pragma unroll
          for (int n = 0; n < 2; n++) {
            const int col = u.pn * 256 + bj * 128 + wc * 32 + n * 16 + fq * 4;
            const f32x4 xv = *(const f32x4*)(xr + col), gv = *(const f32x4*)(gt + col);
            *(f32x4*)(orow + col) = xv + gv * acc[ai][bj][m][n];
          }
      }
    return true;
  }
};

template <int DV, bool MASK>
__device__ __forceinline__ void flash_step(const u16* Ks, const u16* Vts, const bf16x8 (&qf)[4], float& m, float& l,
                                           f32x16 (&o)[DV / 32], int lane, int kpos0, int qpos, int T) {
  const int r = lane & 31, h = lane >> 5;
  f32x16 s[2];
#pragma unroll
  for (int sub = 0; sub < 2; sub++) {
#pragma unroll
    for (int e = 0; e < 16; e++) s[sub][e] = 0.f;
#pragma unroll
    for (int ks = 0; ks < 4; ks++) {
      bf16x8 kf = *(const bf16x8*)(Ks + (sub * 32 + r) * LROW + ks * 16 + h * 8);
      s[sub] = mfma32(kf, qf[ks], s[sub]);
    }
  }
  if (MASK) {
#pragma unroll
    for (int sub = 0; sub < 2; sub++)
#pragma unroll
      for (int e = 0; e < 16; e++) {
        int kp = kpos0 + sub * 32 + (e & 3) + 8 * (e >> 2) + 4 * h;
        int dlt = kp - qpos;
        bool ok = (kp >= 0) && (kp < T) && (dlt <= 128) && (dlt >= -128);
        if (!ok) s[sub][e] = -INFINITY;
      }
  }
  float mx = s[0][0];
#pragma unroll
  for (int sub = 0; sub < 2; sub++)
#pragma unroll
    for (int e = 0; e < 16; e++) mx = fmaxf(mx, s[sub][e]);
  mx = fmaxf(mx, shflx(mx, 32, lane));
  const bool grow = mx > m;
  const float mn = grow ? mx : m;
  float sum = 0.f;
#pragma unroll
  for (int sub = 0; sub < 2; sub++)
#pragma unroll
    for (int e = 0; e < 16; e++) { float pv = __builtin_amdgcn_exp2f(s[sub][e] - mn); s[sub][e] = pv; sum += pv; }
  sum += shflx(sum, 32, lane);
  if (__builtin_amdgcn_ballot_w64(grow) != 0ull) {
    const float alpha = __builtin_amdgcn_exp2f(m - mn);
    l *= alpha;
#pragma unroll
    for (int ds = 0; ds < DV / 32; ds++)
#pragma unroll
      for (int e = 0; e < 16; e++) o[ds][e] *= alpha;
  }
  l += sum; m = mn;
#pragma unroll
  for (int sub = 0; sub < 2; sub++)
#pragma unroll
    for (int st = 0; st < 2; st++) {
      typedef __attribute__((ext_vector_type(4))) unsigned u32x4;
      u32x4 pw;
#pragma unroll
      for (int j = 0; j < 4; j++) pw[j] = pack2(s[sub][8 * st + 2 * j], s[sub][8 * st + 2 * j + 1]);
      bf16x8 pf = __builtin_bit_cast(bf16x8, pw);
#pragma unroll
      for (int ds = 0; ds < DV / 32; ds++) {
        const u16* vp = Vts + (ds * 32 + r) * VROW + sub * 32 + 16 * st + 4 * h;
        bf16x4 lo = *(const bf16x4*)vp, hi = *(const bf16x4*)(vp + 8);
        bf16x8 vf = __builtin_shufflevector(lo, hi, 0, 1, 2, 3, 4, 5, 6, 7);
        o[ds] = mfma32(vf, pf, o[ds]);
      }
    }
}

__device__ __forceinline__ uint4 ld_k(const u16* __restrict__ src, size_t pitch, int r0, int nrows, int c) {
  int row = c >> 3, kc = c & 7; int rr = r0 + row;
  uint4 v = make_uint4(0, 0, 0, 0);
  if (rr >= 0 && rr < nrows) v = *(const uint4*)(src + (size_t)rr * pitch + kc * 8);
  return v;
}
__device__ __forceinline__ void st_k(u16* dst, int c, uint4 v) { *(uint4*)(dst + (c >> 3) * LROW + (c & 7) * 8) = v; }
__device__ __forceinline__ uint4 ld_vt(const u16* __restrict__ src, int T, int k0, int c) {
  int d = c >> 3, kc = c & 7; int k = k0 + kc * 8;
  uint4 v = make_uint4(0, 0, 0, 0);
  if (k >= 0 && k < T) v = *(const uint4*)(src + (size_t)d * T + k);
  return v;
}
__device__ __forceinline__ void st_vt(u16* dst, int c, uint4 v) {
  uint2* q = (uint2*)(dst + (c >> 3) * VROW + (c & 7) * 8);
  q[0] = make_uint2(v.x, v.y); q[1] = make_uint2(v.z, v.w);
}

constexpr int A_BUF = 64 * LROW + 64 * VROW;
__device__ __forceinline__ void attnA_item(const Params& p, int l, int it, u16* sm, bool dry = false) {
  const int tid = TIDX, lane = tid & 63, wid = tid >> 6;
  const int r = lane & 31, h = lane >> 5;
  const bool isctx = it < 128;
  int b, kvh, qb, T, rowbase; const u16* VtBase;
  if (isctx) { b = it >> 3; kvh = (it >> 2) & 1; qb = it & 3; T = 256; rowbase = b * 256;
    VtBase = p.VtA_ctx + ((size_t)(b * 2 + kvh) * 64) * 256; }
  else { int j = it - 128; b = j >> 7; kvh = (j >> 6) & 1; qb = j & 63; T = 4096; rowbase = NCTX + b * 4096;
    VtBase = p.VtA_lat + ((size_t)(b * 2 + kvh) * 64) * 4096; }
  const int qblk = qb * 64;
  const int q0 = qblk + (wid >> 2) * 32;
  const int head = kvh * 4 + (wid & 3);
  const size_t prow = (size_t)(rowbase + q0 + r) * PP;
  bf16x8 qf[4];
#pragma unroll
  for (int ks = 0; ks < 4; ks++) qf[ks] = *(const bf16x8*)(p.P + prow + C_QA + head * 64 + ks * 16 + h * 8);
  float m = p.sink_a[l * 8 + head] * 1.4426950408889634f, ls = 1.f;
  f32x16 o[2];
#pragma unroll
  for (int ds = 0; ds < 2; ds++)
#pragma unroll
    for (int e = 0; e < 16; e++) o[ds][e] = 0.f;
  const u16* Kbase = p.P + (size_t)rowbase * PP + C_KA + kvh * 64;
  const u16* cK = p.cKa + ((size_t)(b * 2 + l) * 512) * 128 + kvh * 64;
  const u16* cVt = p.cVtA + ((size_t)((b * 2 + l) * 2 + kvh) * 64) * 512;
  const int qpos = q0 + r;
  int i_lo = 0, nW, ntile;
  if (isctx) { nW = 4; ntile = 4; }
  else {
    i_lo = (qblk < 128) ? (128 - qblk) / 64 : 0;
    int i_hi = (T - qblk + 128) / 64; if (i_hi > 5) i_hi = 5;
    nW = i_hi - i_lo; ntile = nW + 8;
  }
  uint4 rk, rv;
  auto tile_load = [&](int t) {
    if (t < nW) {
      int k0 = isctx ? t * 64 : qblk - 128 + 64 * (i_lo + t);
      rk = ld_k(Kbase, PP, k0, T, tid); rv = ld_vt(VtBase, T, k0, tid);
    } else {
      int kt = t - nW;
      rk = ld_k(cK, 128, kt * 64, 512, tid); rv = ld_vt(cVt, 512, kt * 64, tid);
    }
  };
  __syncthreads();
  tile_load(0);
  st_k(sm, tid, rk); st_vt(sm + 64 * LROW, tid, rv);
  __syncthreads();
  for (int t = 0; t < ntile; t++) {
    const bool more = t + 1 < ntile;
    if (more) tile_load(t + 1);
    const u16* Ks = sm + (t & 1) * A_BUF; const u16* Vts = Ks + 64 * LROW;
    if (!isctx && t < nW) flash_step<64, true>(Ks, Vts, qf, m, ls, o, lane, qblk - 128 + 64 * (i_lo + t), qpos, T);
    else flash_step<64, false>(Ks, Vts, qf, m, ls, o, lane, 0, 0, T);
    if (more) { u16* d = sm + ((t + 1) & 1) * A_BUF; st_k(d, tid, rk); st_vt(d + 64 * LROW, tid, rv); }
    __syncthreads();
  }
  const float inv = 1.f / ls;
#pragma unroll
  for (int ds = 0; ds < 2; ds++)
#pragma unroll
    for (int g = 0; g < 4; g++) {
      int d = ds * 32 + 8 * g + 4 * h;
      uint2 gv = *(const uint2*)(p.P + prow + C_GA + head * 64 + d);
      uint2 ov;
      ov.x = pack2(o[ds][4 * g] * inv * lo_bf(gv.x), o[ds][4 * g + 1] * inv * hi_bf(gv.x));
      ov.y = pack2(o[ds][4 * g + 2] * inv * lo_bf(gv.y), o[ds][4 * g + 3] * inv * hi_bf(gv.y));
      if (dry) *(uint2*)(p.H + (size_t)(rowbase + q0 + r) * 1024 + head * 64 + d) = ov;
      else *(uint2*)(p.P + prow + C_QA + head * 64 + d) = ov;
    }
}

constexpr int C_BUF = 128 * LROW + 128 * VROW;
__device__ __forceinline__ void attnC_item(const Params& p, int l, int it, u16* sm, float lam, float lam_init, bool dry = false) {
  const int tid = TIDX, lane = tid & 63, wid = tid >> 6;
  const int r = lane & 31, h = lane >> 5;
  const bool isctx = it < 128;
  int b, hd, qb, T, rowbase; const u16* VtBase;
  if (isctx) { b = it >> 3; hd = (it >> 1) & 3; qb = it & 1; T = 256; rowbase = b * 256;
    VtBase = p.VtC_ctx + ((size_t)(b * 4 + hd) * 128) * 256; }
  else { int j = it - 128; b = j >> 7; hd = (j >> 5) & 3; qb = j & 31; T = 4096; rowbase = NCTX + b * 4096;
    VtBase = p.VtC_lat + ((size_t)(b * 4 + hd) * 128) * 4096; }
  const int qg = wid & 3, map = wid >> 2;
  const int q0 = qb * 128 + qg * 32;
  const size_t prow = (size_t)(rowbase + q0 + r) * PP;
  bf16x8 qf[4];
#pragma unroll
  for (int ks = 0; ks < 4; ks++) qf[ks] = *(const bf16x8*)(p.P + prow + C_QC + hd * 128 + map * 64 + ks * 16 + h * 8);
  float m = -1e30f, ls = 0.f;
  f32x16 o[4];
#pragma unroll
  for (int ds = 0; ds < 4; ds++)
#pragma unroll
    for (int e = 0; e < 16; e++) o[ds][e] = 0.f;
  const u16* Kbase = p.P + (size_t)rowbase * PP + C_KC + hd * 128;
  const u16* cK = p.cKc + ((size_t)(b * 2 + l) * 512) * 512 + hd * 128;
  const u16* cVt = p.cVtC + ((size_t)((b * 2 + l) * 4 + hd) * 128) * 512;
  const int nW = T / 64, ntile = isctx ? nW : nW + 8;
  uint4 rk0, rk1, rv0, rv1;
  auto tile_load = [&](int t) {
    if (t < nW) {
      rk0 = ld_k(Kbase, PP, t * 64, T, tid); rk1 = ld_k(Kbase + 64, PP, t * 64, T, tid);
      rv0 = ld_vt(VtBase, T, t * 64, tid); rv1 = ld_vt(VtBase, T, t * 64, tid + NT);
    } else {
      int kt = t - nW;
      rk0 = ld_k(cK, 512, kt * 64, 512, tid); rk1 = ld_k(cK + 64, 512, kt * 64, 512, tid);
      rv0 = ld_vt(cVt, 512, kt * 64, tid); rv1 = ld_vt(cVt, 512, kt * 64, tid + NT);
    }
  };
  auto tile_store = [&](u16* d) {
    st_k(d, tid, rk0); st_k(d + 64 * LROW, tid, rk1);
    st_vt(d + 128 * LROW, tid, rv0); st_vt(d + 128 * LROW, tid + NT, rv1);
  };
  __syncthreads();
  tile_load(0);
  tile_store(sm);
  __syncthreads();
  for (int t = 0; t < ntile; t++) {
    const bool more = t + 1 < ntile;
    if (more) tile_load(t + 1);
    const u16* base = sm + (t & 1) * C_BUF;
    flash_step<128, false>(base + map * 64 * LROW, base + 128 * LROW, qf, m, ls, o, lane, 0, 0, T);
    if (more) tile_store(sm + ((t + 1) & 1) * C_BUF);
    __syncthreads();
  }
  float* xch = (float*)sm;
  if (map == 1) {
    const float inv = lam / ls;
#pragma unroll
    for (int ds = 0; ds < 4; ds++)
#pragma unroll
      for (int e = 0; e < 16; e++) xch[((qg * 64) + ds * 16 + e) * 64 + lane] = o[ds][e] * inv;
  }
  __syncthreads();
  if (map == 0) {
    const float i0 = 1.f / ls;
    float ss = 0.f;
#pragma unroll
    for (int ds = 0; ds < 4; ds++)
#pragma unroll
      for (int e = 0; e < 16; e++) {
        float v = o[ds][e] * i0 - xch[((qg * 64) + ds * 16 + e) * 64 + lane];
        o[ds][e] = v; ss += v * v;
      }
    ss += shflx(ss, 32, lane);
    const float rinv = rsqrtf(ss * (1.f / 128.f) + EPS) * (1.f - lam_init);
    const float* sg = p.subln_c + l * 128;
#pragma unroll
    for (int ds = 0; ds < 4; ds++)
#pragma unroll
      for (int g = 0; g < 4; g++) {
        int d = ds * 32 + 8 * g + 4 * h;
        uint2 gv = *(const uint2*)(p.P + prow + C_GC + hd * 128 + d);
        float4 sl = *(const float4*)(sg + d);
        uint2 ov;
        ov.x = pack2(o[ds][4 * g] * rinv * sl.x * lo_bf(gv.x), o[ds][4 * g + 1] * rinv * sl.y * hi_bf(gv.x));
        ov.y = pack2(o[ds][4 * g + 2] * rinv * sl.z * lo_bf(gv.y), o[ds][4 * g + 3] * rinv * sl.w * hi_bf(gv.y));
        if (dry) *(uint2*)(p.H + (size_t)(rowbase + q0 + r) * 1024 + hd * 128 + d) = ov;
        else *(uint2*)(p.P + prow + C_QC + hd * 128 + d) = ov;
      }
  }
}

__device__ __forceinline__ void lru_run(const Params& p, int l, bool pass2, int start, int G, float* sm, bool dry = false) {
  const int tid = TIDX;
  const int lane = tid & 63, wid = tid >> 6, r = lane & 31, h = lane >> 5;
  const int n = start & 7;
  float* xin = sm;
  float* xb = sm + 67 * 64;
  float* comb = xb + 64 * 64;
  float* carry = comb + 2048;
  float* parts = carry + 128;
  float* ab = parts + 1024;
  u16* xbh = (u16*)(ab + 4 * 4096);
  const int gd = wid >> 2, gth = (wid >> 1) & 1, gdh = wid & 1;
  bf16x8 wfa[4], wfx[4];
  {
    const u16* wbase = p.Wt_lru + ((size_t)(((l * 2 + gd) * 8 + n) * 2) * 64 + gdh * 32 + r) * 64 + h * 8;
#pragma unroll
    for (int ks = 0; ks < 4; ks++) { wfa[ks] = *(const bf16x8*)(wbase + ks * 16); wfx[ks] = *(const bf16x8*)(wbase + 4096 + ks * 16); }
  }
  const int gch = n * 64 + gdh * 32 + r;
  const float g_ba = p.lru_ba[(l * 2 + gd) * 512 + gch], g_bx = p.lru_bx[(l * 2 + gd) * 512 + gch];
  const float g_sp = log1pf(__expf(-p.lru_lam[(l * 2 + gd) * 512 + gch]));
  const int cc = tid & 63;
  float cw[4]; float cbv;
  {
    const float* cwp = p.conv_w + l * 4 * 512 + n * 64 + cc;
    cw[0] = cwp[0]; cw[1] = cwp[512]; cw[2] = cwp[1024]; cw[3] = cwp[1536];
    cbv = p.conv_b[l * 512 + n * 64 + cc];
  }
  const int dout = tid & 63, tg = tid >> 6;
  const int ch = n * 64 + dout;

  for (int it = start; it < 1536; it += G) {
    const int ci = it >> 3;
    const int row0 = ci * 64;
    const bool isctx = row0 < NCTX;
    int T, seq0, bidx;
    if (isctx) { T = 256; bidx = row0 >> 8; seq0 = bidx * 256; }
    else { T = 4096; bidx = (row0 - NCTX) >> 12; seq0 = NCTX + bidx * 4096; }
    const int t0 = row0 - seq0;
    __syncthreads();
    for (int e = tid; e < 67 * 64; e += NT) {
      int rr = e >> 6; int t = t0 - 2 + rr;
      float v = 0.f;
      if (t >= 0 && t < T) v = bf2f(p.P[(size_t)(seq0 + t) * PP + C_XB + n * 64 + cc]);
      xin[e] = v;
    }
    if (pass2) {
      const int d = (tid >> 6) & 1, part = tid >> 7;
      const int cfirst = seq0 >> 6, clast = (seq0 + T - 64) >> 6;
      const int K = d ? (clast - ci) : (ci - cfirst);
      float At = 1.f, Bt = 0.f;
#pragma unroll 4
      for (int k = 0; k < 16; k++) {
        const int kk = part * 16 + k;
        if (kk < K) {
          const int cj = d ? (clast - kk) : (cfirst + kk);
          const float2 q = *(const float2*)(p.lruTot + ((size_t)(cj * 2 + d) * 512 + n * 64 + cc) * 2);
          Bt = q.x * Bt + q.y; At *= q.x;
        }
      }
      parts[((part * 2 + d) * 64 + cc) * 2] = At; parts[((part * 2 + d) * 64 + cc) * 2 + 1] = Bt;
    }
    __syncthreads();
    for (int e = tid; e < 64 * 64; e += NT) {
      int t = e >> 6;
      float v = cbv;
#pragma unroll
      for (int j = 0; j < 4; j++) v += xin[(t + j) * 64 + cc] * cw[j];
      xb[e] = v;
      xbh[t * LROW + cc] = f2bf(v);
    }
    if (pass2 && tid < 128) {
      const int d = tid >> 6;
      float hcar = isctx ? 0.f : p.state_lru[((size_t)(bidx * 2 + l) * 2 + d) * 512 + n * 64 + cc];
#pragma unroll
      for (int part = 0; part < 4; part++) hcar = parts[((part * 2 + d) * 64 + cc) * 2] * hcar + parts[((part * 2 + d) * 64 + cc) * 2 + 1];
      carry[d * 64 + cc] = hcar;
    }
    __syncthreads();
    {
      bf16x8 af[4];
#pragma unroll
      for (int ks = 0; ks < 4; ks++) af[ks] = *(const bf16x8*)(xbh + (gth * 32 + r) * LROW + ks * 16 + h * 8);
      f32x16 ga, gi;
#pragma unroll
      for (int e = 0; e < 16; e++) { ga[e] = 0.f; gi[e] = 0.f; }
#pragma unroll
      for (int ks = 0; ks < 4; ks++) { ga = mfma32(af[ks], wfa[ks], ga); gi = mfma32(af[ks], wfx[ks], gi); }
      const int dch = gdh * 32 + r;
#pragma unroll
      for (int e = 0; e < 16; e++) {
        const int tok = gth * 32 + (e & 3) + 8 * (e >> 2) + 4 * h;
        float rg = sigmoidf_(ga[e] + g_ba), ig = sigmoidf_(gi[e] + g_bx);
        float log_a = -8.f * rg * g_sp;
        float a = __expf(log_a);
        float bb = sqrtf(-expm1f(2.f * log_a)) * ig * xb[tok * 64 + dch];
        ab[((gd * 2 + 0) * 64 + tok) * 64 + dch] = a;
        ab[((gd * 2 + 1) * 64 + tok) * 64 + dch] = bb;
      }
    }
    __syncthreads();
    float av[2][8], bv[2][8];
#pragma unroll
    for (int d = 0; d < 2; d++)
#pragma unroll
      for (int tt = 0; tt < 8; tt++) {
        av[d][tt] = ab[((d * 2 + 0) * 64 + tg * 8 + tt) * 64 + dout];
        bv[d][tt] = ab[((d * 2 + 1) * 64 + tg * 8 + tt) * 64 + dout];
      }
    float sA0 = 1.f, sB0 = 0.f, sA1 = 1.f, sB1 = 0.f;
#pragma unroll
    for (int tt = 0; tt < 8; tt++) { sB0 = av[0][tt] * sB0 + bv[0][tt]; sA0 *= av[0][tt]; }
#pragma unroll
    for (int tt = 7; tt >= 0; tt--) { sB1 = av[1][tt] * sB1 + bv[1][tt]; sA1 *= av[1][tt]; }
    comb[((tg * 2 + 0) * 64 + dout) * 2 + 0] = sA0; comb[((tg * 2 + 0) * 64 + dout) * 2 + 1] = sB0;
    comb[((tg * 2 + 1) * 64 + dout) * 2 + 0] = sA1; comb[((tg * 2 + 1) * 64 + dout) * 2 + 1] = sB1;
    __syncthreads();
    if (!pass2) {
      if (tid < 128) {
        int d = tid >> 6, c = tid & 63;
        float At = 1.f, Bt = 0.f;
#pragma unroll
        for (int s = 0; s < 8; s++) {
          int g = (d == 0) ? s : 7 - s;
          float a = comb[((g * 2 + d) * 64 + c) * 2], bq = comb[((g * 2 + d) * 64 + c) * 2 + 1];
          Bt = a * Bt + bq; At *= a;
        }
        float* o = p.lruTot + ((size_t)(ci * 2 + d) * 512 + n * 64 + c) * 2;
        o[0] = At; o[1] = Bt;
      }
      continue;
    }
    float h0 = carry[dout], h1 = carry[64 + dout];
    for (int g = 0; g < tg; g++) { h0 = comb[((g * 2 + 0) * 64 + dout) * 2] * h0 + comb[((g * 2 + 0) * 64 + dout) * 2 + 1]; }
    for (int g = 7; g > tg; g--) { h1 = comb[((g * 2 + 1) * 64 + dout) * 2] * h1 + comb[((g * 2 + 1) * 64 + dout) * 2 + 1]; }
    float y[8];
#pragma unroll
    for (int tt = 0; tt < 8; tt++) { h0 = av[0][tt] * h0 + bv[0][tt]; y[tt] = h0; }
    const float hf_last = h0;
#pragma unroll
    for (int tt = 7; tt >= 0; tt--) { h1 = av[1][tt] * h1 + bv[1][tt]; y[tt] += h1; }
    const float hb_first = h1;
    if (isctx) {
      if (t0 + 64 == T && tg == 7) p.out[O_ST + ((size_t)(bidx * 2 + l) * 2 + 0) * 512 + ch] = hf_last;
      if (t0 == 0 && tg == 0) p.out[O_ST + ((size_t)(bidx * 2 + l) * 2 + 1) * 512 + ch] = hb_first;
    }
#pragma unroll
    for (int tt = 0; tt < 8; tt++) {
      u16* q = p.P + (size_t)(row0 + tg * 8 + tt) * PP + C_GB + ch;
      if (dry) p.H[(size_t)(row0 + tg * 8 + tt) * 1024 + ch] = f2bf(y[tt] * bf2f(*q));
      else *q = f2bf(y[tt] * bf2f(*q));
    }
  }
}

__device__ __forceinline__ float compute_lam(const Params& p, int l, float lam_init) {
  float s1 = 0.f, s2 = 0.f;
  for (int i = 0; i < 64; i++) {
    s1 += p.lam_q1[l * 64 + i] * p.lam_k1[l * 64 + i];
    s2 += p.lam_q2[l * 64 + i] * p.lam_k2[l * 64 + i];
  }
  return expf(s1) - expf(s2) + lam_init;
}

__device__ __forceinline__ void mix_phase(const Params& p, int l, u16* smem) {
  const float lam_init = (l == 0) ? 0.2f : (0.8f - 0.6f * 0.74081822068f);
  const float lam = compute_lam(p, l, lam_init);
  constexpr int N_CL = 256, N_A = 384, N_CC = 128, N_L = 1536;
  const int G = gridDim.x;
  int start = blockIdx.x;
  if (PROBE == 4) for (int it = start; it < N_CL; it += G) attnC_item(p, l, 128 + it, smem, lam, lam_init, true);
  for (int it = start; it < N_CL; it += G) attnC_item(p, l, 128 + it, smem, lam, lam_init);
  start = (int)((blockIdx.x + G - (N_CL % G)) % G);
  if (PROBE == 5) for (int it = start; it < N_A; it += G) attnA_item(p, l, it, smem, true);
  for (int it = start; it < N_A; it += G) attnA_item(p, l, it, smem);
  start = (int)((blockIdx.x + G - ((N_CL + N_A) % G)) % G);
  for (int it = start; it < N_CC; it += G) attnC_item(p, l, it, smem, lam, lam_init);
  start = (int)((blockIdx.x + G - ((N_CL + N_A + N_CC) % G)) % G);
  if (PROBE == 6) lru_run(p, l, false, start, G, (float*)smem);
  lru_run(p, l, false, start, G, (float*)smem);
}

__device__ __forceinline__ void lru2_phase(const Params& p, int l, u16* smem) {
  if (PROBE == 7) lru_run(p, l, true, blockIdx.x, gridDim.x, (float*)smem, true);
  lru_run(p, l, true, blockIdx.x, gridDim.x, (float*)smem);
}

typedef __attribute__((address_space(4))) const Params CParams;
__device__ __forceinline__ const Params& get_params() {
  CParams* kp = (CParams*)__builtin_amdgcn_kernarg_segment_ptr();
  asm volatile("" : "+s"(kp));
  return *(const Params*)kp;
}
__global__ void __launch_bounds__(NT, 2) fwd_kernel(Params p_unused) {
  extern __shared__ __attribute__((aligned(16))) unsigned char lds_raw[];
  u16* smem = (u16*)lds_raw;
  LAS unsigned char* lds = (LAS unsigned char*)lds_raw;
  cg::grid_group grid = cg::this_grid();
  prologue_phase(get_params(), (float*)smem);
  grid.sync();
#pragma unroll 1
  for (int l = 0; l < 2; l++) {
    norm_phase(get_params(), l);
    if (PROBE == 3) { norm_phase(get_params(), l); if (l == 0) { grid.sync(); prologue_phase(get_params(), (float*)smem); } }
    grid.sync();
    {
      const Params& p = get_params();
      SchedStd S; S.nM = NTOK / 256; S.nN = INC / 256; S.nwg = S.nM * S.nN; S.G = gridDim.x; S.c = blockIdx.x;
      S.A = (const char*)p.H; S.B = (const char*)(p.Wt_in + (size_t)l * INC * 1024); S.tA = (size_t)256 * 1024 * 2; S.tB = (size_t)256 * 1024 * 2;
      EpiInproj E; E.pp = &p; E.l = l; E.part = (LAS float*)(lds + STAGE_BYTES);
      gemm_phase(lds, 1024, 1024, 1024, S, E);
      if (PROBE == 1) { __syncthreads(); gemm_phase(lds, 1024, 1024, 1024, S, E); }
    }
    grid.sync();
    mix_phase(get_params(), l, smem);
    grid.sync();
    lru2_phase(get_params(), l, smem);
    grid.sync();
    {
      const Params& p = get_params();
      SchedBranch S; S.G = gridDim.x; S.c = blockIdx.x; S.P_ = (const char*)p.P; S.W_ = (const char*)(p.Wt_br + (size_t)l * 3 * 1024 * 512);
      EpiBranch E; E.pp = &p;
      gemm_phase(lds, PP, 512, 512, S, E);
      if (PROBE == 2) { __syncthreads(); gemm_phase(lds, PP, 512, 512, S, E); }
    }
    grid.sync();
    {
      const Params& p = get_params();
      SchedStd S; S.nM = NTOK / 256; S.nN = 4; S.nwg = S.nM * S.nN; S.G = gridDim.x; S.c = blockIdx.x;
      S.A = (const char*)p.H; S.B = (const char*)(p.Wt_out + (size_t)l * 1024 * 1024); S.tA = (size_t)256 * 1024 * 2; S.tB = (size_t)256 * 1024 * 2;
      EpiOut E; E.pp = &p; E.l = l;
      gemm_phase(lds, 1024, 1024, 1024, S, E);
      if (PROBE == 8 && l == 0) { __syncthreads(); gemm_phase(lds, 1024, 1024, 1024, S, E); }
    }
    if (l == 0) grid.sync();
  }
}

extern "C" void kernel_launch(void* const* d_in, const int* in_sizes, int n_in, void* d_out, int out_size, void* d_ws,
                              size_t ws_size, hipStream_t stream) {
  Params p{};
  const float** ip = (const float**)&p;
  for (int i = 0; i < 34; i++) ip[i] = (const float*)d_in[i];
  p.out = (float*)d_out;
  char* w = (char*)d_ws; size_t off = 0;
  auto take = [&](size_t bytes) { char* q = w + off; off += (bytes + 255) & ~(size_t)255; return q; };
  p.Wt_in = (u16*)take((size_t)2 * INC * 1024 * 2);
  p.Wt_br = (u16*)take((size_t)6 * 1024 * 512 * 2);
  p.Wt_out = (u16*)take((size_t)2 * 1024 * 1024 * 2);
  p.H = (u16*)take((size_t)NTOK * 1024 * 2);
  p.P = (u16*)take((size_t)NTOK * PP * 2);
  p.VtA_ctx = (u16*)take((size_t)16 * 2 * 64 * 256 * 2);
  p.VtA_lat = (u16*)take((size_t)2 * 2 * 64 * 4096 * 2);
  p.VtC_ctx = (u16*)take((size_t)16 * 4 * 128 * 256 * 2);
  p.VtC_lat = (u16*)take((size_t)2 * 4 * 128 * 4096 * 2);
  p.cKa = (u16*)take((size_t)2 * 2 * 512 * 128 * 2);
  p.cVtA = (u16*)take((size_t)2 * 2 * 512 * 128 * 2);
  p.cKc = (u16*)take((size_t)2 * 2 * 512 * 512 * 2);
  p.cVtC = (u16*)take((size_t)2 * 2 * 512 * 512 * 2);
  p.mod = (float*)take((size_t)2 * 3 * 3072 * 4);
  p.rope = (float*)take((size_t)2048 * 4);
  p.lruTot = (float*)take((size_t)192 * 2 * 512 * 2 * 4);
  p.Wt_lru = (u16*)take((size_t)2 * 2 * 8 * 2 * 64 * 64 * 2);
  p.MG = (uint2*)take((size_t)48 * 4 * 3 * 16384 * 8);
  static int grid_blocks = 0;
  if (!grid_blocks) {
    int dev = 0, cus = 0;
    hipGetDevice(&dev);
    hipDeviceGetAttribute(&cus, hipDeviceAttributeMultiprocessorCount, dev);
    hipFuncSetAttribute((const void*)fwd_kernel, hipFuncAttributeMaxDynamicSharedMemorySize, LDS_BYTES);
    int per_cu = 0;
    hipOccupancyMaxActiveBlocksPerMultiprocessor(&per_cu, (const void*)fwd_kernel, NT, LDS_BYTES);
    (void)hipGetLastError();
    grid_blocks = cus;
  }
  void* args[] = {&p};
  hipLaunchCooperativeKernel((void*)fwd_kernel, dim3(grid_blocks), dim3(NT), args, LDS_BYTES, stream);
}
```

```cpp
#include <hip/hip_runtime.h>
#include <hip/hip_cooperative_groups.h>
#include <stdint.h>
#include <math.h>
namespace cg = cooperative_groups;

typedef unsigned short u16;
typedef __attribute__((ext_vector_type(8))) short bf16x8;
typedef __attribute__((ext_vector_type(4))) short bf16x4;
typedef __attribute__((ext_vector_type(16))) float f32x16;
typedef __attribute__((ext_vector_type(4))) float f32x4;
#define LAS __attribute__((address_space(3)))

#ifndef PROBE
#define PROBE 0
#endif
#define NT 512
constexpr int NTOK = 12288, NCTX = 4096;
constexpr int INC = 7424;
constexpr int PP = 3712;
constexpr int C_QA = 0, C_KA = 512, C_GA = 640, C_XB = 1152, C_GB = 1664, C_QC = 2176, C_KC = 2688, C_GC = 3200;
constexpr int LROW = 72;
constexpr int VROW = 68;
constexpr float EPS = 1e-6f;
constexpr int STAGE_BYTES = 131072;
constexpr int SPARE_BYTES = 8192;
constexpr int LDS_BYTES = STAGE_BYTES + SPARE_BYTES + 16;

constexpr size_t O_X = 0, O_KA = 12582912, O_VA = 13631488, O_KC = 14680064, O_VC = 18874368, O_ST = 23068672;

struct Params {
  const float *x_prompt, *x_sample, *cache_a_k, *cache_a_v, *cache_c_k, *cache_c_v, *state_lru, *c, *c_ctx,
      *norm_g, *mod_w, *mod_b, *w_in, *qn_a, *kn_a, *sink_a, *conv_w, *conv_b, *lru_wa, *lru_ba, *lru_wx, *lru_bx,
      *lru_lam, *qn_c, *kn_c, *lam_q1, *lam_k1, *lam_q2, *lam_k2, *subln_c, *w_br_a, *w_br_b, *w_br_c, *w_out;
  float* out;
  u16 *Wt_in, *Wt_br, *Wt_out, *H, *P, *VtA_ctx, *VtA_lat, *VtC_ctx, *VtC_lat, *cKa, *cVtA, *cKc, *cVtC;
  float *mod, *rope, *lruTot;
  u16 *Wt_lru;
  unsigned* bar;
  uint2* MG;
};

__device__ __forceinline__ int tid_opaque() { int t = (int)threadIdx.x; asm volatile("" : "+v"(t)); return t; }
#define TIDX tid_opaque()
__device__ __forceinline__ u16 f2bf(float f) {
  uint32_t u = __float_as_uint(f);
  u += 0x7FFFu + ((u >> 16) & 1u);
  return (u16)(u >> 16);
}
__device__ __forceinline__ float bf2f(u16 h) { return __uint_as_float(((uint32_t)h) << 16); }
__device__ __forceinline__ uint32_t pack2(float a, float b) { uint32_t r; asm("v_cvt_pk_bf16_f32 %0, %1, %2" : "=v"(r) : "v"(a), "v"(b)); return r; }
__device__ __forceinline__ float sigmoidf_(float x) { return 1.f / (1.f + __expf(-x)); }
__device__ __forceinline__ float siluf_(float x) { return x / (1.f + __expf(-x)); }
__device__ __forceinline__ f32x16 mfma32(bf16x8 a, bf16x8 b, f32x16 c) {
  return __builtin_amdgcn_mfma_f32_32x32x16_bf16(a, b, c, 0, 0, 0);
}
__device__ __forceinline__ float shflx(float v, int mask, int lane) {
  return __builtin_bit_cast(float, __builtin_amdgcn_ds_bpermute((lane ^ mask) << 2, __builtin_bit_cast(int, v)));
}
__device__ __forceinline__ float lo_bf(uint32_t w) { return __uint_as_float(w << 16); }
__device__ __forceinline__ float hi_bf(uint32_t w) { return __uint_as_float(w & 0xffff0000u); }

__device__ __forceinline__ void transpose_tile(const float* __restrict__ src, int spitch, u16* __restrict__ dst, int dpitch,
                               int r0, int c0, float* sm) {
  const int tid = TIDX;
#pragma unroll
  for (int i = 0; i < 2; i++) {
    int c = tid + i * NT; int r = c >> 4, q = c & 15;
    float4 v = *(const float4*)(src + (size_t)(r0 + r) * spitch + c0 + q * 4);
    float* d = sm + r * 65 + q * 4;
    d[0] = v.x; d[1] = v.y; d[2] = v.z; d[3] = v.w;
  }
  __syncthreads();
  {
    int c = tid; int cc = c >> 3, q = c & 7;
    uint32_t w[4];
#pragma unroll
    for (int j = 0; j < 4; j++) w[j] = pack2(sm[(q * 8 + 2 * j) * 65 + cc], sm[(q * 8 + 2 * j + 1) * 65 + cc]);
    uint4 v; v.x = w[0]; v.y = w[1]; v.z = w[2]; v.w = w[3];
    *(uint4*)(dst + (size_t)(c0 + cc) * dpitch + r0 + q * 8) = v;
  }
  __syncthreads();
}

__device__ __forceinline__ void mod_item(const Params& p, int it, float* sm) {
  const int tid = TIDX;
  const int l = it / 48, n0 = (it % 48) * 64;
  float* sv = sm;
  float* red = sm + 3072;
  for (int e = tid; e < 3072; e += NT) {
    int v = e >> 10, k = e & 1023;
    float x = (v == 0) ? p.c_ctx[k] : p.c[(v - 1) * 1024 + k];
    sv[e] = siluf_(x);
  }
  __syncthreads();
  const int col = tid & 63, kg = tid >> 6;
  const float* w = p.mod_w + (size_t)l * 1024 * 3072 + n0 + col;
  float a0 = 0, a1 = 0, a2 = 0;
#pragma unroll 8
  for (int k = kg * 128; k < kg * 128 + 128; k++) {
    float wv = w[(size_t)k * 3072];
    a0 += sv[k] * wv; a1 += sv[1024 + k] * wv; a2 += sv[2048 + k] * wv;
  }
  red[(kg * 3 + 0) * 64 + col] = a0; red[(kg * 3 + 1) * 64 + col] = a1; red[(kg * 3 + 2) * 64 + col] = a2;
  __syncthreads();
  if (tid < 192) {
    int v = tid >> 6, c = tid & 63;
    float s = p.mod_b[l * 3072 + n0 + c];
#pragma unroll
    for (int g = 0; g < 8; g++) s += red[(g * 3 + v) * 64 + c];
    p.mod[(l * 3 + v) * 3072 + n0 + c] = s;
  }
  __syncthreads();
}

__device__ __forceinline__ void prologue_phase(const Params& p, float* sm) {
  constexpr int N_MOD = 96, N_ROPE = 1, N_WIN = 2 * 16 * 116, N_WBR = 6 * 8 * 16, N_WOUT = 2 * 16 * 16;
  constexpr int N_CK = 64 + 256, N_CVA = 4 * 16, N_CVC = 4 * 64, N_LW = 64;
  constexpr int E0 = N_MOD, E1 = E0 + N_ROPE, E2 = E1 + N_WIN, E3 = E2 + N_WBR, E4 = E3 + N_WOUT, E5 = E4 + N_CK,
                E6 = E5 + N_CVA, E7 = E6 + N_CVC, E8 = E7 + N_LW;
  const int tid = TIDX;
  for (int it = blockIdx.x; it < E8; it += gridDim.x) {
    if (it < E0) {
      mod_item(p, it, sm);
    } else if (it < E1) {
      for (int e = tid; e < 1024; e += NT) {
        int pos = e >> 4, f = e & 15;
        float inv = powf(10000.f, -(float)f / 16.f);
        float ang = (float)pos * inv;
        p.rope[e] = cosf(ang); p.rope[1024 + e] = sinf(ang);
      }
    } else if (it < E2) {
      int j = it - E1; int l = j / (16 * 116); int r = j % (16 * 116);
      int kt = r / 116, nt = r % 116;
      transpose_tile(p.w_in + (size_t)l * 1024 * INC, INC, p.Wt_in + (size_t)l * INC * 1024, 1024, kt * 64, nt * 64, sm);
    } else if (it < E3) {
      int j = it - E2; int m = j / 128; int r = j % 128;
      int l = m / 3, i = m % 3;
      const float* src = (i == 0 ? p.w_br_a : (i == 1 ? p.w_br_b : p.w_br_c)) + (size_t)l * 512 * 1024;
      int kt = r / 16, nt = r % 16;
      transpose_tile(src, 1024, p.Wt_br + (size_t)m * 1024 * 512, 512, kt * 64, nt * 64, sm);
    } else if (it < E4) {
      int j = it - E3; int l = j / 256; int r = j % 256;
      int kt = r / 16, nt = r % 16;
      transpose_tile(p.w_out + (size_t)l * 1024 * 1024, 1024, p.Wt_out + (size_t)l * 1024 * 1024, 1024, kt * 64, nt * 64, sm);
    } else if (it < E5) {
      int j = it - E4;
      const float* src; u16* dst; size_t off;
      if (j < 64) { src = p.cache_a_k; dst = p.cKa; off = (size_t)j * 4096; }
      else { src = p.cache_c_k; dst = p.cKc; off = (size_t)(j - 64) * 4096; }
      size_t e = off + (size_t)tid * 8;
      float4 a = *(const float4*)(src + e), b = *(const float4*)(src + e + 4);
      uint4 v; v.x = pack2(a.x, a.y); v.y = pack2(a.z, a.w); v.z = pack2(b.x, b.y); v.w = pack2(b.z, b.w);
      *(uint4*)(dst + e) = v;
    } else if (it < E6) {
      int j = it - E5; int bl = j / 16; int r = j % 16;
      int rt = r / 2, ct = r % 2;
      transpose_tile(p.cache_a_v + (size_t)bl * 512 * 128, 128, p.cVtA + (size_t)bl * 128 * 512, 512, rt * 64, ct * 64, sm);
    } else if (it < E7) {
      int j = it - E6; int bl = j / 64; int r = j % 64;
      int rt = r / 8, ct = r % 8;
      transpose_tile(p.cache_c_v + (size_t)bl * 512 * 512, 512, p.cVtC + (size_t)bl * 512 * 512, 512, rt * 64, ct * 64, sm);
    } else {
      int j = it - E7; int ldn = j >> 1, g = j & 1;
      transpose_tile((g ? p.lru_wx : p.lru_wa) + (size_t)ldn * 4096, 64, p.Wt_lru + (size_t)(ldn * 2 + g) * 4096, 64, 0, 0, sm);
    }
  }
}

__device__ __forceinline__ void norm_phase(const Params& p, int l) {
  const int tid = TIDX, lane = tid & 63, wid = tid >> 6;
  const float* g = p.norm_g + l * 1024;
  for (int it = blockIdx.x; it < NTOK / 8; it += gridDim.x) {
    int row = it * 8 + wid;
    const float* x;
    if (l == 0) x = (row < NCTX) ? p.x_prompt + (size_t)row * 1024 : p.x_sample + (size_t)(row - NCTX) * 1024;
    else x = p.out + O_X + (size_t)row * 1024;
    int v = (row < NCTX) ? 0 : 1 + (row - NCTX) / 4096;
    const float* md = p.mod + (l * 3 + v) * 3072;
    float4 xv[4]; float ss = 0;
#pragma unroll
    for (int i = 0; i < 4; i++) {
      xv[i] = *(const float4*)(x + i * 256 + lane * 4);
      ss += xv[i].x * xv[i].x + xv[i].y * xv[i].y + xv[i].z * xv[i].z + xv[i].w * xv[i].w;
    }
#pragma unroll
    for (int o = 32; o > 0; o >>= 1) ss += shflx(ss, o, lane);
    float rinv = rsqrtf(ss * (1.f / 1024.f) + EPS);
#pragma unroll
    for (int i = 0; i < 4; i++) {
      int c = i * 256 + lane * 4;
      float4 gv = *(const float4*)(g + c), sh = *(const float4*)(md + c), sc = *(const float4*)(md + 1024 + c);
      float h0 = xv[i].x * rinv * gv.x * (1.f + sc.x) + sh.x;
      float h1 = xv[i].y * rinv * gv.y * (1.f + sc.y) + sh.y;
      float h2 = xv[i].z * rinv * gv.z * (1.f + sc.z) + sh.z;
      float h3 = xv[i].w * rinv * gv.w * (1.f + sc.w) + sh.w;
      uint2 o2; o2.x = pack2(h0, h1); o2.y = pack2(h2, h3);
      *(uint2*)(p.H + (size_t)row * 1024 + c) = o2;
    }
  }
}

constexpr int G_BK = 64, G_HALF = 128, G_HTB = G_HALF * G_BK * 2;
__device__ __forceinline__ int lds_byte(int r, int c) {
  const int st = (r >> 4) * 2 + (c >> 5), rr = r & 15, cc = c & 31, ob = rr * 64 + cc * 2;
  return st * 1024 + (ob ^ (((ob >> 9) & 1) << 5));
}
__device__ __forceinline__ void stage_rc(int b, int& R, int& C) {
  const int st = b / 1024, sb = b % 1024, swz = sb ^ (((sb >> 9) & 1) << 5);
  R = (st >> 1) * 16 + swz / 64; C = (st & 1) * 32 + (swz % 64) / 2;
}
struct Unit { int pm, pn, seg; };

struct SchedStd {
  int nM, nN, nwg, G, c; const char* A; const char* B; size_t tA, tB;
  __device__ __forceinline__ bool next(int i, Unit& u) const {
    const long L = (long)i * G + c; if (L >= nwg) return false;
    int wgid = (int)L;
    { const int q = nwg / 8, r = nwg % 8, xcd = wgid % 8, off = wgid / 8; wgid = (xcd < r ? xcd * (q + 1) : r * (q + 1) + (xcd - r) * q) + off; }
    const int nig = 8 * nN, gid = wgid / nig, fm = gid * 8, gsz = (nM - fm) < 8 ? (nM - fm) : 8;
    u.pm = fm + ((wgid % nig) % gsz); u.pn = (wgid % nig) / gsz; u.seg = 0; return true;
  }
  __device__ __forceinline__ const char* aptr(const Unit& u) const { return A + (size_t)u.pm * tA; }
  __device__ __forceinline__ const char* bptr(const Unit& u) const { return B + (size_t)u.pn * tB; }
};
struct SchedBranch {
  int G, c; const char* P_; const char* W_;
  __device__ __forceinline__ bool next(int i, Unit& u) const {
    const int tile = (i / 3) * G + c; if (tile >= 192) return false;
    u.seg = i % 3; u.pm = tile >> 2; u.pn = tile & 3; return true;
  }
  __device__ __forceinline__ const char* aptr(const Unit& u) const {
    const int col = (u.seg == 0) ? C_QA : (u.seg == 1 ? C_GB : C_QC);
    return P_ + ((size_t)u.pm * 256 * PP + col) * 2;
  }
  __device__ __forceinline__ const char* bptr(const Unit& u) const { return W_ + ((size_t)(u.seg * 1024 + u.pn * 256) * 512) * 2; }
};

template <class Epi, class Sched>
__device__ __forceinline__ void gemm_phase(LAS unsigned char* lds, const int lda, const int ldb, const int K, const Sched& S, const Epi& E) {
  const int tid = TIDX, wid = __builtin_amdgcn_readfirstlane(tid >> 6), lane = tid & 63, wr = wid >> 2, wc = wid & 3, fr = lane & 15, fq = lane >> 4;
  const int nt = K / G_BK;
  unsigned voffA[2], voffB[2];
#pragma unroll
  for (int i = 0; i < 2; ++i) { int R, C; stage_rc(tid * 16 + i * 8192, R, C);
    voffA[i] = (unsigned)(R * lda + C) * 2u; voffB[i] = (unsigned)(R * ldb + C) * 2u; }
  const size_t kstep = (size_t)(G_BK * 2);
  const size_t hA = (size_t)G_HALF * lda * 2, hB = (size_t)G_HALF * ldb * 2;
  const unsigned ldsw = (unsigned)wid * 1024u;
  const int aoff = lds_byte(wr * 64 + fr, fq * 8), boff = lds_byte(wc * 32 + fr, fq * 8);
#define G_SA(b, h) (((b) * 2 + (h)) * G_HTB)
#define G_SB(b, h) ((4 + (b) * 2 + (h)) * G_HTB)
#define G_STAGE(bufoff, gbase, voff) do { _Pragma("unroll") for (int _i = 0; _i < 2; ++_i) \
    __builtin_amdgcn_global_load_lds((const unsigned*)((const char*)(gbase) + (voff)[_i]), (LAS unsigned*)(lds + (bufoff) + ldsw + _i * 8192), 16, 0, 0); } while (0)
#define G_LDA(dst, b, h) do { _Pragma("unroll") for (int m = 0; m < 4; ++m) _Pragma("unroll") for (int k = 0; k < 2; ++k) dst[m][k] = *(const LAS bf16x8*)(lds + G_SA(b, h) + aoff + m * 2048 + k * 1024); } while (0)
#define G_LDB(dst, b, h) do { _Pragma("unroll") for (int n = 0; n < 2; ++n) _Pragma("unroll") for (int k = 0; k < 2; ++k) dst[n][k] = *(const LAS bf16x8*)(lds + G_SB(b, h) + boff + n * 2048 + k * 1024); } while (0)
#define G_MMA(ai, bj, At, Bt) do { __builtin_amdgcn_s_setprio(1); _Pragma("unroll") for (int m = 0; m < 4; ++m) _Pragma("unroll") for (int n = 0; n < 2; ++n) _Pragma("unroll") for (int k = 0; k < 2; ++k) \
    acc[ai][bj][m][n] = __builtin_amdgcn_mfma_f32_16x16x32_bf16(Bt[n][k], At[m][k], acc[ai][bj][m][n], 0, 0, 0); __builtin_amdgcn_s_setprio(0); } while (0)
#define G_WAIT_V(n) asm volatile("s_waitcnt vmcnt(" #n ")" ::: "memory")
#define G_WAIT_L(n) asm volatile("s_waitcnt lgkmcnt(" #n ")" ::: "memory")
#define G_BAR __builtin_amdgcn_s_barrier()
#define G_SCHED __builtin_amdgcn_sched_barrier(0)
  Unit cur, nxt; int ui = 0;
  if (!S.next(0, cur)) return;
  f32x4 acc[2][2][4][2];
#pragma unroll
  for (int a = 0; a < 2; ++a)
#pragma unroll
    for (int b = 0; b < 2; ++b)
#pragma unroll
      for (int m = 0; m < 4; ++m)
#pragma unroll
        for (int n = 0; n < 2; ++n) acc[a][b][m][n] = (f32x4){0.f, 0.f, 0.f, 0.f};
  bf16x8 At[4][2], B0[2][2], B1[2][2];
  const char* cA = S.aptr(cur); const char* cB = S.bptr(cur);
  G_STAGE(G_SB(0, 0), cB, voffB); G_STAGE(G_SA(0, 0), cA, voffA); G_STAGE(G_SB(0, 1), cB + hB, voffB); G_STAGE(G_SA(0, 1), cA + hA, voffA);
  if (wr == 1) G_BAR;
  G_WAIT_V(4); G_BAR;
  G_STAGE(G_SB(1, 0), cB + kstep, voffB); G_STAGE(G_SA(1, 0), cA + kstep, voffA); G_STAGE(G_SB(1, 1), cB + hB + kstep, voffB);
  G_WAIT_V(6); G_BAR;
  for (;;) {
    const bool has_next = S.next(ui + 1, nxt);
    const char* nA = has_next ? S.aptr(nxt) : cA; const char* nB = has_next ? S.bptr(nxt) : cB;
    for (int t = 0; t < nt; t += 2) {
      const bool last = (t == nt - 2);
      const char* a1 = cA + (size_t)(t + 1) * kstep;
      const char* a2 = last ? nA : cA + (size_t)(t + 2) * kstep; const char* b2 = last ? nB : cB + (size_t)(t + 2) * kstep;
      const char* a3 = a2 + kstep; const char* b3 = b2 + kstep;
      G_LDB(B0, 0, 0); G_SCHED; G_LDA(At, 0, 0); G_STAGE(G_SA(1, 1), a1 + hA, voffA);
      G_WAIT_L(8); G_BAR; G_WAIT_L(0); G_MMA(0, 0, At, B0); G_BAR; G_SCHED;
      G_LDB(B1, 0, 1); G_STAGE(G_SB(0, 0), b2, voffB);
      G_BAR; G_WAIT_L(0); G_MMA(0, 1, At, B1); G_BAR;
      G_LDA(At, 0, 1); G_STAGE(G_SA(0, 0), a2, voffA);
      G_BAR; G_WAIT_L(0); G_MMA(1, 0, At, B0); G_BAR; G_SCHED;
      G_STAGE(G_SB(0, 1), b2 + hB, voffB);
      G_WAIT_V(6); G_BAR; G_MMA(1, 1, At, B1); G_BAR;
      G_LDB(B0, 1, 0); G_SCHED; G_LDA(At, 1, 0); G_STAGE(G_SA(0, 1), a2 + hA, voffA);
      G_WAIT_L(8); G_BAR; G_WAIT_L(0); G_MMA(0, 0, At, B0); G_BAR; G_SCHED;
      G_LDB(B1, 1, 1); G_STAGE(G_SB(1, 0), b3, voffB);
      G_BAR; G_WAIT_L(0); G_MMA(0, 1, At, B1); G_BAR;
      G_LDA(At, 1, 1); G_STAGE(G_SA(1, 0), a3, voffA);
      G_BAR; G_WAIT_L(0); G_MMA(1, 0, At, B0); G_BAR; G_SCHED;
      G_STAGE(G_SB(1, 1), b3 + hB, voffB);
      G_WAIT_V(6); G_BAR; G_MMA(1, 1, At, B1); G_BAR;
    }
    const bool reset = E(acc, cur, wr, wc, fr, fq);
    if (!has_next) break;
    if (reset) {
#pragma unroll
      for (int a = 0; a < 2; ++a)
#pragma unroll
        for (int b = 0; b < 2; ++b)
#pragma unroll
          for (int m = 0; m < 4; ++m)
#pragma unroll
            for (int n = 0; n < 2; ++n) acc[a][b][m][n] = (f32x4){0.f, 0.f, 0.f, 0.f};
    }
    cur = nxt; cA = nA; cB = nB; ++ui;
  }
  G_WAIT_V(0);
  if (wr == 0) G_BAR;
  G_BAR;
#undef G_SA
#undef G_SB
#undef G_STAGE
#undef G_LDA
#undef G_LDB
#undef G_MMA
#undef G_WAIT_V
#undef G_WAIT_L
#undef G_BAR
#undef G_SCHED
}

struct EpiInproj {
  const Params* pp; int l; LAS float* part;
  __device__ __forceinline__ bool operator()(f32x4 (&acc)[2][2][4][2], const Unit& u, int wr, int wc, int fr, int fq) const {
    const Params& p = *pp;
    asm volatile("" : "+v"(fr), "+v"(fq));
    const int lane = fr + 16 * fq; (void)lane;
    const int oc0 = u.pn * 256;
    const bool isctx = u.pm < 16;
    const bool qkU = (oc0 < 768) || (oc0 >= 2304 && oc0 < 3328);
    float rinv[2][4][2];
    if (qkU) {
#pragma unroll
      for (int ai = 0; ai < 2; ai++)
#pragma unroll
        for (int m = 0; m < 4; m++)
#pragma unroll
          for (int bj = 0; bj < 2; bj++) {
            f32x4 a = acc[ai][bj][m][0], b = acc[ai][bj][m][1];
            float ss = a[0] * a[0] + a[1] * a[1] + a[2] * a[2] + a[3] * a[3] + b[0] * b[0] + b[1] * b[1] + b[2] * b[2] + b[3] * b[3];
            ss += shflx(ss, 16, lane); ss += shflx(ss, 32, lane);
            rinv[ai][m][bj] = ss;
            if (fq == 0) part[((ai * 128 + wr * 64 + m * 16 + fr) * 2 + bj) * 4 + wc] = ss;
          }
      asm volatile("s_waitcnt lgkmcnt(0)" ::: "memory");
      __builtin_amdgcn_s_barrier();
      asm volatile("" ::: "memory");
#pragma unroll
      for (int ai = 0; ai < 2; ai++)
#pragma unroll
        for (int m = 0; m < 4; m++)
#pragma unroll
          for (int bj = 0; bj < 2; bj++) {
            float o = part[((ai * 128 + wr * 64 + m * 16 + fr) * 2 + bj) * 4 + (wc ^ 1)];
            rinv[ai][m][bj] = rsqrtf((rinv[ai][m][bj] + o) * (1.f / 64.f) + EPS);
          }
    }
#pragma unroll
    for (int bj = 0; bj < 2; bj++) {
      const int oc = oc0 + bj * 128;
      if (oc == 640 || (oc >= 3328 && oc < 3840)) {
        const bool isA = (oc == 640);
        const int cb = isA ? 0 : (oc - 3328);
        const int nvec = isA ? 128 : 512;
#pragma unroll
        for (int ai = 0; ai < 2; ai++)
#pragma unroll
          for (int m = 0; m < 4; m++) {
            const int row = u.pm * 256 + ai * 128 + wr * 64 + m * 16 + fr;
            int b, t, T; u16* vt;
            if (isctx) { b = row >> 8; t = row & 255; T = 256; vt = isA ? p.VtA_ctx : p.VtC_ctx; }
            else { int rr = row - NCTX; b = rr >> 12; t = rr & 4095; T = 4096; vt = isA ? p.VtA_lat : p.VtC_lat; }
#pragma unroll
            for (int n = 0; n < 2; n++) {
              const int d = cb + wc * 32 + n * 16 + fq * 4;
              f32x4 v = acc[ai][bj][m][n];
#pragma unroll
              for (int j = 0; j < 4; j++) vt[((size_t)b * nvec + d + j) * T + t] = f2bf(v[j]);
              if (isctx) {
                float* o = p.out + (isA ? O_VA : O_VC) + ((size_t)(b * 2 + l) * 256 + t) * nvec + d;
                *(f32x4*)o = v;
              }
            }
          }
      } else {
        const int pc = (oc < 640) ? oc : (oc < 3328 ? oc - 128 : oc - 640);
        const bool is_qa = oc < 512, is_ka = (oc == 512);
        const bool is_qc = (oc >= 2304 && oc < 2816), is_kc = (oc >= 2816 && oc < 3328);
        if (is_qa || is_ka || is_qc || is_kc) {
          const float* gn = (is_qa ? p.qn_a : is_ka ? p.kn_a : is_qc ? p.qn_c : p.kn_c) + l * 64 + (wc & 1) * 32 + fq * 4;
          const f32x4 g0 = *(const f32x4*)gn, g1 = *(const f32x4*)(gn + 16);
          const float qs = (is_qa || is_qc) ? 0.18033688011112042f : 1.f;
#pragma unroll
          for (int ai = 0; ai < 2; ai++)
#pragma unroll
            for (int m = 0; m < 4; m++) {
              const int row = u.pm * 256 + ai * 128 + wr * 64 + m * 16 + fr;
              const float ri = rinv[ai][m][bj];
              f32x4 x1 = acc[ai][bj][m][0] * ri * g0, x2 = acc[ai][bj][m][1] * ri * g1;
              if (!isctx) {
                const int t = (row - NCTX) & 4095;
                const int pos = (wc & 1) ? (t & 63) : (t >> 6);
                const f32x4 cs = *(const f32x4*)(p.rope + pos * 16 + fq * 4), sn = *(const f32x4*)(p.rope + 1024 + pos * 16 + fq * 4);
                f32x4 y1 = x1 * cs - x2 * sn, y2 = x2 * cs + x1 * sn;
                x1 = y1; x2 = y2;
              } else if (is_ka || is_kc) {
                const int b = row >> 8, t = row & 255;
                float* o = is_ka ? p.out + O_KA + ((size_t)(b * 2 + l) * 256 + t) * 128 + wc * 32 + fq * 4
                                 : p.out + O_KC + ((size_t)(b * 2 + l) * 256 + t) * 512 + (oc - 2816) + wc * 32 + fq * 4;
                *(f32x4*)o = x1; *(f32x4*)(o + 16) = x2;
              }
              x1 = x1 * qs; x2 = x2 * qs;
              u16* po = p.P + (size_t)row * PP + pc + wc * 32 + fq * 4;
              *(uint2*)po = make_uint2(pack2(x1[0], x1[1]), pack2(x1[2], x1[3]));
              *(uint2*)(po + 16) = make_uint2(pack2(x2[0], x2[1]), pack2(x2[2], x2[3]));
            }
        } else {
          const int mode = (oc >= 4352) ? 2 : ((oc >= 1280 && oc < 1792) ? 0 : 1);
          if (mode == 2) {
            const int pj = u.pn - 17, seg = pj >> 2, pn4 = pj & 3;
            uint2* mg = p.MG + ((size_t)((u.pm * 4 + pn4) * 3 + seg) * 8 + (wr * 4 + wc)) * 2048 + lane;
#pragma unroll
            for (int ai = 0; ai < 2; ai++)
#pragma unroll
              for (int m = 0; m < 4; m++)
#pragma unroll
                for (int n = 0; n < 2; n++) {
                  f32x4 v = acc[ai][bj][m][n];
                  v[0] = sigmoidf_(v[0]); v[1] = sigmoidf_(v[1]); v[2] = sigmoidf_(v[2]); v[3] = sigmoidf_(v[3]);
                  mg[(((ai * 4 + m) * 2 + bj) * 2 + n) * 64] = make_uint2(pack2(v[0], v[1]), pack2(v[2], v[3]));
                }
          } else
#pragma unroll
          for (int ai = 0; ai < 2; ai++)
#pragma unroll
            for (int m = 0; m < 4; m++) {
              const int row = u.pm * 256 + ai * 128 + wr * 64 + m * 16 + fr;
              u16* po = p.P + (size_t)row * PP + pc + wc * 32 + fq * 4;
#pragma unroll
              for (int n = 0; n < 2; n++) {
                f32x4 v = acc[ai][bj][m][n];
                if (mode == 1) { v[0] = siluf_(v[0]); v[1] = siluf_(v[1]); v[2] = siluf_(v[2]); v[3] = siluf_(v[3]); }
                else if (mode == 2) { v[0] = sigmoidf_(v[0]); v[1] = sigmoidf_(v[1]); v[2] = sigmoidf_(v[2]); v[3] = sigmoidf_(v[3]); }
                *(uint2*)(po + n * 16) = make_uint2(pack2(v[0], v[1]), pack2(v[2], v[3]));
              }
            }
        }
      }
    }
    return true;
  }
};

struct EpiBranch {
  const Params* pp;
  __device__ __forceinline__ bool operator()(f32x4 (&acc)[2][2][4][2], const Unit& u, int wr, int wc, int fr, int fq) const {
    const Params& p = *pp;
    asm volatile("" : "+v"(fr), "+v"(fq));
    const int lane = fr + 16 * fq;
    const int seg = u.seg;
    const uint2* mg = p.MG + ((size_t)((u.pm * 4 + u.pn) * 3 + seg) * 8 + (wr * 4 + wc)) * 2048 + lane;
#pragma unroll
    for (int ai = 0; ai < 2; ai++)
#pragma unroll
      for (int m = 0; m < 4; m++) {
        const int row = u.pm * 256 + ai * 128 + wr * 64 + m * 16 + fr;
#pragma unroll
        for (int bj = 0; bj < 2; bj++)
#pragma unroll
          for (int n = 0; n < 2; n++) {
            const int idx = (((ai * 4 + m) * 2 + bj) * 2 + n) * 64;
            const uint2 a = mg[idx];
            f32x4 f = {lo_bf(a.x), hi_bf(a.x), lo_bf(a.y), hi_bf(a.y)};
            if (seg < 2) {
              const uint2 b = mg[idx + 8 * 2048];
              f[0] = __fdividef(f[0], fmaxf(lo_bf(b.x), 1e-20f)); f[1] = __fdividef(f[1], fmaxf(hi_bf(b.x), 1e-20f));
              f[2] = __fdividef(f[2], fmaxf(lo_bf(b.y), 1e-20f)); f[3] = __fdividef(f[3], fmaxf(hi_bf(b.y), 1e-20f));
              acc[ai][bj][m][n] = acc[ai][bj][m][n] * f;
            } else {
              const int col = u.pn * 256 + bj * 128 + wc * 32 + n * 16 + fq * 4;
              f32x4 v = acc[ai][bj][m][n] * f;
              *(uint2*)(p.H + (size_t)row * 1024 + col) = make_uint2(pack2(v[0], v[1]), pack2(v[2], v[3]));
            }
          }
      }
    return seg == 2;
  }
};

struct EpiOut {
  const Params* pp; int l;
  __device__ __forceinline__ bool operator()(f32x4 (&acc)[2][2][4][2], const Unit& u, int wr, int wc, int fr, int fq) const {
    const Params& p = *pp;
    asm volatile("" : "+v"(fr), "+v"(fq));
    const int lane = fr + 16 * fq; (void)lane;
    const int v = (u.pm < 16) ? 0 : 1 + (u.pm - 16) / 16;
    const float* gt = p.mod + (l * 3 + v) * 3072 + 2048;
#pragma unroll
    for (int ai = 0; ai < 2; ai++)
#pragma unroll
      for (int m = 0; m < 4; m++) {
        const int row = u.pm * 256 + ai * 128 + wr * 64 + m * 16 + fr;
        const float* xr;
        if (l == 0) xr = (row < NCTX) ? p.x_prompt + (size_t)row * 1024 : p.x_sample + (size_t)(row - NCTX) * 1024;
        else xr = p.out + O_X + (size_t)row * 1024;
        float* orow = p.out + O_X + (size_t)row * 1024;
#pragma unroll
        for (int bj = 0; bj < 2; bj++)
#pragma unroll
          for (int n = 0; n < 2; n++) {
            const int col = u.pn * 256 + bj * 128 + wc * 32 + n * 16 + fq * 4;
            const f32x4 xv = *(const f32x4*)(xr + col), gv = *(const f32x4*)(gt + col);
            *(f32x4*)(orow + col) = xv + gv * acc[ai][bj][m][n];
          }
      }
    return true;
  }
};

template <int DV, bool MASK>
__device__ __forceinline__ void flash_step(const u16* Ks, const u16* Vts, const bf16x8 (&qf)[4], float& m, float& l,
                                           f32x16 (&o)[DV / 32], int lane, int kpos0, int qpos, int T) {
  const int r = lane & 31, h = lane >> 5;
  f32x16 s[2];
#pragma unroll
  for (int sub = 0; sub < 2; sub++) {
#pragma unroll
    for (int e = 0; e < 16; e++) s[sub][e] = 0.f;
#pragma unroll
    for (int ks = 0; ks < 4; ks++) {
      bf16x8 kf = *(const bf16x8*)(Ks + (sub * 32 + r) * LROW + ks * 16 + h * 8);
      s[sub] = mfma32(kf, qf[ks], s[sub]);
    }
  }
  if (MASK) {
#pragma unroll
    for (int sub = 0; sub < 2; sub++)
#pragma unroll
      for (int e = 0; e < 16; e++) {
        int kp = kpos0 + sub * 32 + (e & 3) + 8 * (e >> 2) + 4 * h;
        int dlt = kp - qpos;
        bool ok = (kp >= 0) && (kp < T) && (dlt <= 128) && (dlt >= -128);
        if (!ok) s[sub][e] = -INFINITY;
      }
  }
  float mx = s[0][0];
#pragma unroll
  for (int sub = 0; sub < 2; sub++)
#pragma unroll
    for (int e = 0; e < 16; e++) mx = fmaxf(mx, s[sub][e]);
  mx = fmaxf(mx, shflx(mx, 32, lane));
  const bool grow = mx > m;
  const float mn = grow ? mx : m;
  float sum = 0.f;
#pragma unroll
  for (int sub = 0; sub < 2; sub++)
#pragma unroll
    for (int e = 0; e < 16; e++) { float pv = __builtin_amdgcn_exp2f(s[sub][e] - mn); s[sub][e] = pv; sum += pv; }
  sum += shflx(sum, 32, lane);
  if (__builtin_amdgcn_ballot_w64(grow) != 0ull) {
    const float alpha = __builtin_amdgcn_exp2f(m - mn);
    l *= alpha;
#pragma unroll
    for (int ds = 0; ds < DV / 32; ds++)
#pragma unroll
      for (int e = 0; e < 16; e++) o[ds][e] *= alpha;
  }
  l += sum; m = mn;
#pragma unroll
  for (int sub = 0; sub < 2; sub++)
#pragma unroll
    for (int st = 0; st < 2; st++) {
      typedef __attribute__((ext_vector_type(4))) unsigned u32x4;
      u32x4 pw;
#pragma unroll
      for (int j = 0; j < 4; j++) pw[j] = pack2(s[sub][8 * st + 2 * j], s[sub][8 * st + 2 * j + 1]);
      bf16x8 pf = __builtin_bit_cast(bf16x8, pw);
#pragma unroll
      for (int ds = 0; ds < DV / 32; ds++) {
        const u16* vp = Vts + (ds * 32 + r) * VROW + sub * 32 + 16 * st + 4 * h;
        bf16x4 lo = *(const bf16x4*)vp, hi = *(const bf16x4*)(vp + 8);
        bf16x8 vf = __builtin_shufflevector(lo, hi, 0, 1, 2, 3, 4, 5, 6, 7);
        o[ds] = mfma32(vf, pf, o[ds]);
      }
    }
}

__device__ __forceinline__ uint4 ld_k(const u16* __restrict__ src, size_t pitch, int r0, int nrows, int c) {
  int row = c >> 3, kc = c & 7; int rr = r0 + row;
  uint4 v = make_uint4(0, 0, 0, 0);
  if (rr >= 0 && rr < nrows) v = *(const uint4*)(src + (size_t)rr * pitch + kc * 8);
  return v;
}
__device__ __forceinline__ void st_k(u16* dst, int c, uint4 v) { *(uint4*)(dst + (c >> 3) * LROW + (c & 7) * 8) = v; }
__device__ __forceinline__ uint4 ld_vt(const u16* __restrict__ src, int T, int k0, int c) {
  int d = c >> 3, kc = c & 7; int k = k0 + kc * 8;
  uint4 v = make_uint4(0, 0, 0, 0);
  if (k >= 0 && k < T) v = *(const uint4*)(src + (size_t)d * T + k);
  return v;
}
__device__ __forceinline__ void st_vt(u16* dst, int c, uint4 v) {
  uint2* q = (uint2*)(dst + (c >> 3) * VROW + (c & 7) * 8);
  q[0] = make_uint2(v.x, v.y); q[1] = make_uint2(v.z, v.w);
}

constexpr int A_BUF = 64 * LROW + 64 * VROW;
__device__ __forceinline__ void attnA_item(const Params& p, int l, int it, u16* sm, bool dry = false) {
  const int tid = TIDX, lane = tid & 63, wid = tid >> 6;
  const int r = lane & 31, h = lane >> 5;
  const bool isctx = it < 128;
  int b, kvh, qb, T, rowbase; const u16* VtBase;
  if (isctx) { b = it >> 3; kvh = (it >> 2) & 1; qb = it & 3; T = 256; rowbase = b * 256;
    VtBase = p.VtA_ctx + ((size_t)(b * 2 + kvh) * 64) * 256; }
  else { int j = it - 128; b = j >> 7; kvh = (j >> 6) & 1; qb = j & 63; T = 4096; rowbase = NCTX + b * 4096;
    VtBase = p.VtA_lat + ((size_t)(b * 2 + kvh) * 64) * 4096; }
  const int qblk = qb * 64;
  const int q0 = qblk + (wid >> 2) * 32;
  const int head = kvh * 4 + (wid & 3);
  const size_t prow = (size_t)(rowbase + q0 + r) * PP;
  bf16x8 qf[4];
#pragma unroll
  for (int ks = 0; ks < 4; ks++) qf[ks] = *(const bf16x8*)(p.P + prow + C_QA + head * 64 + ks * 16 + h * 8);
  float m = p.sink_a[l * 8 + head] * 1.4426950408889634f, ls = 1.f;
  f32x16 o[2];
#pragma unroll
  for (int ds = 0; ds < 2; ds++)
#pragma unroll
    for (int e = 0; e < 16; e++) o[ds][e] = 0.f;
  const u16* Kbase = p.P + (size_t)rowbase * PP + C_KA + kvh * 64;
  const u16* cK = p.cKa + ((size_t)(b * 2 + l) * 512) * 128 + kvh * 64;
  const u16* cVt = p.cVtA + ((size_t)((b * 2 + l) * 2 + kvh) * 64) * 512;
  const int qpos = q0 + r;
  int i_lo = 0, nW, ntile;
  if (isctx) { nW = 4; ntile = 4; }
  else {
    i_lo = (qblk < 128) ? (128 - qblk) / 64 : 0;
    int i_hi = (T - qblk + 128) / 64; if (i_hi > 5) i_hi = 5;
    nW = i_hi - i_lo; ntile = nW + 8;
  }
  uint4 rk, rv;
  auto tile_load = [&](int t) {
    if (t < nW) {
      int k0 = isctx ? t * 64 : qblk - 128 + 64 * (i_lo + t);
      rk = ld_k(Kbase, PP, k0, T, tid); rv = ld_vt(VtBase, T, k0, tid);
    } else {
      int kt = t - nW;
      rk = ld_k(cK, 128, kt * 64, 512, tid); rv = ld_vt(cVt, 512, kt * 64, tid);
    }
  };
  __syncthreads();
  tile_load(0);
  st_k(sm, tid, rk); st_vt(sm + 64 * LROW, tid, rv);
  __syncthreads();
  for (int t = 0; t < ntile; t++) {
    const bool more = t + 1 < ntile;
    if (more) tile_load(t + 1);
    const u16* Ks = sm + (t & 1) * A_BUF; const u16* Vts = Ks + 64 * LROW;
    if (!isctx && t < nW) flash_step<64, true>(Ks, Vts, qf, m, ls, o, lane, qblk - 128 + 64 * (i_lo + t), qpos, T);
    else flash_step<64, false>(Ks, Vts, qf, m, ls, o, lane, 0, 0, T);
    if (more) { u16* d = sm + ((t + 1) & 1) * A_BUF; st_k(d, tid, rk); st_vt(d + 64 * LROW, tid, rv); }
    __syncthreads();
  }
  const float inv = 1.f / ls;
#pragma unroll
  for (int ds = 0; ds < 2; ds++)
#pragma unroll
    for (int g = 0; g < 4; g++) {
      int d = ds * 32 + 8 * g + 4 * h;
      uint2 gv = *(const uint2*)(p.P + prow + C_GA + head * 64 + d);
      uint2 ov;
      ov.x = pack2(o[ds][4 * g] * inv * lo_bf(gv.x), o[ds][4 * g + 1] * inv * hi_bf(gv.x));
      ov.y = pack2(o[ds][4 * g + 2] * inv * lo_bf(gv.y), o[ds][4 * g + 3] * inv * hi_bf(gv.y));
      if (dry) *(uint2*)(p.H + (size_t)(rowbase + q0 + r) * 1024 + head * 64 + d) = ov;
      else *(uint2*)(p.P + prow + C_QA + head * 64 + d) = ov;
    }
}

constexpr int C_BUF = 128 * LROW + 128 * VROW;
__device__ __forceinline__ void attnC_item(const Params& p, int l, int it, u16* sm, float lam, float lam_init, bool dry = false) {
  const int tid = TIDX, lane = tid & 63, wid = tid >> 6;
  const int r = lane & 31, h = lane >> 5;
  const bool isctx = it < 128;
  int b, hd, qb, T, rowbase; const u16* VtBase;
  if (isctx) { b = it >> 3; hd = (it >> 1) & 3; qb = it & 1; T = 256; rowbase = b * 256;
    VtBase = p.VtC_ctx + ((size_t)(b * 4 + hd) * 128) * 256; }
  else { int j = it - 128; b = j >> 7; hd = (j >> 5) & 3; qb = j & 31; T = 4096; rowbase = NCTX + b * 4096;
    VtBase = p.VtC_lat + ((size_t)(b * 4 + hd) * 128) * 4096; }
  const int qg = wid & 3, map = wid >> 2;
  const int q0 = qb * 128 + qg * 32;
  const size_t prow = (size_t)(rowbase + q0 + r) * PP;
  bf16x8 qf[4];
#pragma unroll
  for (int ks = 0; ks < 4; ks++) qf[ks] = *(const bf16x8*)(p.P + prow + C_QC + hd * 128 + map * 64 + ks * 16 + h * 8);
  float m = -1e30f, ls = 0.f;
  f32x16 o[4];
#pragma unroll
  for (int ds = 0; ds < 4; ds++)
#pragma unroll
    for (int e = 0; e < 16; e++) o[ds][e] = 0.f;
  const u16* Kbase = p.P + (size_t)rowbase * PP + C_KC + hd * 128;
  const u16* cK = p.cKc + ((size_t)(b * 2 + l) * 512) * 512 + hd * 128;
  const u16* cVt = p.cVtC + ((size_t)((b * 2 + l) * 4 + hd) * 128) * 512;
  const int nW = T / 64, ntile = isctx ? nW : nW + 8;
  uint4 rk0, rk1, rv0, rv1;
  auto tile_load = [&](int t) {
    if (t < nW) {
      rk0 = ld_k(Kbase, PP, t * 64, T, tid); rk1 = ld_k(Kbase + 64, PP, t * 64, T, tid);
      rv0 = ld_vt(VtBase, T, t * 64, tid); rv1 = ld_vt(VtBase, T, t * 64, tid + NT);
    } else {
      int kt = t - nW;
      rk0 = ld_k(cK, 512, kt * 64, 512, tid); rk1 = ld_k(cK + 64, 512, kt * 64, 512, tid);
      rv0 = ld_vt(cVt, 512, kt * 64, tid); rv1 = ld_vt(cVt, 512, kt * 64, tid + NT);
    }
  };
  auto tile_store = [&](u16* d) {
    st_k(d, tid, rk0); st_k(d + 64 * LROW, tid, rk1);
    st_vt(d + 128 * LROW, tid, rv0); st_vt(d + 128 * LROW, tid + NT, rv1);
  };
  __syncthreads();
  tile_load(0);
  tile_store(sm);
  __syncthreads();
  for (int t = 0; t < ntile; t++) {
    const bool more = t + 1 < ntile;
    if (more) tile_load(t + 1);
    const u16* base = sm + (t & 1) * C_BUF;
    flash_step<128, false>(base + map * 64 * LROW, base + 128 * LROW, qf, m, ls, o, lane, 0, 0, T);
    if (more) tile_store(sm + ((t + 1) & 1) * C_BUF);
    __syncthreads();
  }
  float* xch = (float*)sm;
  if (map == 1) {
    const float inv = lam / ls;
#pragma unroll
    for (int ds = 0; ds < 4; ds++)
#pragma unroll
      for (int e = 0; e < 16; e++) xch[((qg * 64) + ds * 16 + e) * 64 + lane] = o[ds][e] * inv;
  }
  __syncthreads();
  if (map == 0) {
    const float i0 = 1.f / ls;
    float ss = 0.f;
#pragma unroll
    for (int ds = 0; ds < 4; ds++)
#pragma unroll
      for (int e = 0; e < 16; e++) {
        float v = o[ds][e] * i0 - xch[((qg * 64) + ds * 16 + e) * 64 + lane];
        o[ds][e] = v; ss += v * v;
      }
    ss += shflx(ss, 32, lane);
    const float rinv = rsqrtf(ss * (1.f / 128.f) + EPS) * (1.f - lam_init);
    const float* sg = p.subln_c + l * 128;
#pragma unroll
    for (int ds = 0; ds < 4; ds++)
#pragma unroll
      for (int g = 0; g < 4; g++) {
        int d = ds * 32 + 8 * g + 4 * h;
        uint2 gv = *(const uint2*)(p.P + prow + C_GC + hd * 128 + d);
        float4 sl = *(const float4*)(sg + d);
        uint2 ov;
        ov.x = pack2(o[ds][4 * g] * rinv * sl.x * lo_bf(gv.x), o[ds][4 * g + 1] * rinv * sl.y * hi_bf(gv.x));
        ov.y = pack2(o[ds][4 * g + 2] * rinv * sl.z * lo_bf(gv.y), o[ds][4 * g + 3] * rinv * sl.w * hi_bf(gv.y));
        if (dry) *(uint2*)(p.H + (size_t)(rowbase + q0 + r) * 1024 + hd * 128 + d) = ov;
        else *(uint2*)(p.P + prow + C_QC + hd * 128 + d) = ov;
      }
  }
}

__device__ __forceinline__ void lru_run(const Params& p, int l, bool pass2, int start, int G, float* sm, bool dry = false) {
  const int tid = TIDX;
  const int lane = tid & 63, wid = tid >> 6, r = lane & 31, h = lane >> 5;
  const int n = start & 7;
  float* xin = sm;
  float* xb = sm + 67 * 64;
  float* comb = xb + 64 * 64;
  float* carry = comb + 2048;
  float* parts = carry + 128;
  float* ab = parts + 1024;
  u16* xbh = (u16*)(ab + 4 * 4096);
  const int gd = wid >> 2, gth = (wid >> 1) & 1, gdh = wid & 1;
  bf16x8 wfa[4], wfx[4];
  {
    const u16* wbase = p.Wt_lru + ((size_t)(((l * 2 + gd) * 8 + n) * 2) * 64 + gdh * 32 + r) * 64 + h * 8;
#pragma unroll
    for (int ks = 0; ks < 4; ks++) { wfa[ks] = *(const bf16x8*)(wbase + ks * 16); wfx[ks] = *(const bf16x8*)(wbase + 4096 + ks * 16); }
  }
  const int gch = n * 64 + gdh * 32 + r;
  const float g_ba = p.lru_ba[(l * 2 + gd) * 512 + gch], g_bx = p.lru_bx[(l * 2 + gd) * 512 + gch];
  const float g_sp = log1pf(__expf(-p.lru_lam[(l * 2 + gd) * 512 + gch]));
  const int cc = tid & 63;
  float cw[4]; float cbv;
  {
    const float* cwp = p.conv_w + l * 4 * 512 + n * 64 + cc;
    cw[0] = cwp[0]; cw[1] = cwp[512]; cw[2] = cwp[1024]; cw[3] = cwp[1536];
    cbv = p.conv_b[l * 512 + n * 64 + cc];
  }
  const int dout = tid & 63, tg = tid >> 6;
  const int ch = n * 64 + dout;

  for (int it = start; it < 1536; it += G) {
    const int ci = it >> 3;
    const int row0 = ci * 64;
    const bool isctx = row0 < NCTX;
    int T, seq0, bidx;
    if (isctx) { T = 256; bidx = row0 >> 8; seq0 = bidx * 256; }
    else { T = 4096; bidx = (row0 - NCTX) >> 12; seq0 = NCTX + bidx * 4096; }
    const int t0 = row0 - seq0;
    __syncthreads();
    for (int e = tid; e < 67 * 64; e += NT) {
      int rr = e >> 6; int t = t0 - 2 + rr;
      float v = 0.f;
      if (t >= 0 && t < T) v = bf2f(p.P[(size_t)(seq0 + t) * PP + C_XB + n * 64 + cc]);
      xin[e] = v;
    }
    if (pass2) {
      const int d = (tid >> 6) & 1, part = tid >> 7;
      const int cfirst = seq0 >> 6, clast = (seq0 + T - 64) >> 6;
      const int K = d ? (clast - ci) : (ci - cfirst);
      float At = 1.f, Bt = 0.f;
#pragma unroll 4
      for (int k = 0; k < 16; k++) {
        const int kk = part * 16 + k;
        if (kk < K) {
          const int cj = d ? (clast - kk) : (cfirst + kk);
          const float2 q = *(const float2*)(p.lruTot + ((size_t)(cj * 2 + d) * 512 + n * 64 + cc) * 2);
          Bt = q.x * Bt + q.y; At *= q.x;
        }
      }
      parts[((part * 2 + d) * 64 + cc) * 2] = At; parts[((part * 2 + d) * 64 + cc) * 2 + 1] = Bt;
    }
    __syncthreads();
    for (int e = tid; e < 64 * 64; e += NT) {
      int t = e >> 6;
      float v = cbv;
#pragma unroll
      for (int j = 0; j < 4; j++) v += xin[(t + j) * 64 + cc] * cw[j];
      xb[e] = v;
      xbh[t * LROW + cc] = f2bf(v);
    }
    if (pass2 && tid < 128) {
      const int d = tid >> 6;
      float hcar = isctx ? 0.f : p.state_lru[((size_t)(bidx * 2 + l) * 2 + d) * 512 + n * 64 + cc];
#pragma unroll
      for (int part = 0; part < 4; part++) hcar = parts[((part * 2 + d) * 64 + cc) * 2] * hcar + parts[((part * 2 + d) * 64 + cc) * 2 + 1];
      carry[d * 64 + cc] = hcar;
    }
    __syncthreads();
    {
      bf16x8 af[4];
#pragma unroll
      for (int ks = 0; ks < 4; ks++) af[ks] = *(const bf16x8*)(xbh + (gth * 32 + r) * LROW + ks * 16 + h * 8);
      f32x16 ga, gi;
#pragma unroll
      for (int e = 0; e < 16; e++) { ga[e] = 0.f; gi[e] = 0.f; }
#pragma unroll
      for (int ks = 0; ks < 4; ks++) { ga = mfma32(af[ks], wfa[ks], ga); gi = mfma32(af[ks], wfx[ks], gi); }
      const int dch = gdh * 32 + r;
#pragma unroll
      for (int e = 0; e < 16; e++) {
        const int tok = gth * 32 + (e & 3) + 8 * (e >> 2) + 4 * h;
        float rg = sigmoidf_(ga[e] + g_ba), ig = sigmoidf_(gi[e] + g_bx);
        float log_a = -8.f * rg * g_sp;
        float a = __expf(log_a);
        float bb = sqrtf(-expm1f(2.f * log_a)) * ig * xb[tok * 64 + dch];
        ab[((gd * 2 + 0) * 64 + tok) * 64 + dch] = a;
        ab[((gd * 2 + 1) * 64 + tok) * 64 + dch] = bb;
      }
    }
    __syncthreads();
    float av[2][8], bv[2][8];
#pragma unroll
    for (int d = 0; d < 2; d++)
#pragma unroll
      for (int tt = 0; tt < 8; tt++) {
        av[d][tt] = ab[((d * 2 + 0) * 64 + tg * 8 + tt) * 64 + dout];
        bv[d][tt] = ab[((d * 2 + 1) * 64 + tg * 8 + tt) * 64 + dout];
      }
    float sA0 = 1.f, sB0 = 0.f, sA1 = 1.f, sB1 = 0.f;
#pragma unroll
    for (int tt = 0; tt < 8; tt++) { sB0 = av[0][tt] * sB0 + bv[0][tt]; sA0 *= av[0][tt]; }
#pragma unroll
    for (int tt = 7; tt >= 0; tt--) { sB1 = av[1][tt] * sB1 + bv[1][tt]; sA1 *= av[1][tt]; }
    comb[((tg * 2 + 0) * 64 + dout) * 2 + 0] = sA0; comb[((tg * 2 + 0) * 64 + dout) * 2 + 1] = sB0;
    comb[((tg * 2 + 1) * 64 + dout) * 2 + 0] = sA1; comb[((tg * 2 + 1) * 64 + dout) * 2 + 1] = sB1;
    __syncthreads();
    if (!pass2) {
      if (tid < 128) {
        int d = tid >> 6, c = tid & 63;
        float At = 1.f, Bt = 0.f;
#pragma unroll
        for (int s = 0; s < 8; s++) {
          int g = (d == 0) ? s : 7 - s;
          float a = comb[((g * 2 + d) * 64 + c) * 2], bq = comb[((g * 2 + d) * 64 + c) * 2 + 1];
          Bt = a * Bt + bq; At *= a;
        }
        float* o = p.lruTot + ((size_t)(ci * 2 + d) * 512 + n * 64 + c) * 2;
        o[0] = At; o[1] = Bt;
      }
      continue;
    }
    float h0 = carry[dout], h1 = carry[64 + dout];
    for (int g = 0; g < tg; g++) { h0 = comb[((g * 2 + 0) * 64 + dout) * 2] * h0 + comb[((g * 2 + 0) * 64 + dout) * 2 + 1]; }
    for (int g = 7; g > tg; g--) { h1 = comb[((g * 2 + 1) * 64 + dout) * 2] * h1 + comb[((g * 2 + 1) * 64 + dout) * 2 + 1]; }
    float y[8];
#pragma unroll
    for (int tt = 0; tt < 8; tt++) { h0 = av[0][tt] * h0 + bv[0][tt]; y[tt] = h0; }
    const float hf_last = h0;
#pragma unroll
    for (int tt = 7; tt >= 0; tt--) { h1 = av[1][tt] * h1 + bv[1][tt]; y[tt] += h1; }
    const float hb_first = h1;
    if (isctx) {
      if (t0 + 64 == T && tg == 7) p.out[O_ST + ((size_t)(bidx * 2 + l) * 2 + 0) * 512 + ch] = hf_last;
      if (t0 == 0 && tg == 0) p.out[O_ST + ((size_t)(bidx * 2 + l) * 2 + 1) * 512 + ch] = hb_first;
    }
#pragma unroll
    for (int tt = 0; tt < 8; tt++) {
      u16* q = p.P + (size_t)(row0 + tg * 8 + tt) * PP + C_GB + ch;
      if (dry) p.H[(size_t)(row0 + tg * 8 + tt) * 1024 + ch] = f2bf(y[tt] * bf2f(*q));
      else *q = f2bf(y[tt] * bf2f(*q));
    }
  }
}

__device__ __forceinline__ float compute_lam(const Params& p, int l, float lam_init) {
  float s1 = 0.f, s2 = 0.f;
  for (int i = 0; i < 64; i++) {
    s1 += p.lam_q1[l * 64 + i] * p.lam_k1[l * 64 + i];
    s2 += p.lam_q2[l * 64 + i] * p.lam_k2[l * 64 + i];
  }
  return expf(s1) - expf(s2) + lam_init;
}

__device__ __forceinline__ void mix_phase(const Params& p, int l, u16* smem) {
  const float lam_init = (l == 0) ? 0.2f : (0.8f - 0.6f * 0.74081822068f);
  const float lam = compute_lam(p, l, lam_init);
  constexpr int N_CL = 256, N_A = 384, N_CC = 128, N_L = 1536;
  const int G = gridDim.x;
  int start = blockIdx.x;
  if (PROBE == 4) for (int it = start; it < N_CL; it += G) attnC_item(p, l, 128 + it, smem, lam, lam_init, true);
  for (int it = start; it < N_CL; it += G) attnC_item(p, l, 128 + it, smem, lam, lam_init);
  start = (int)((blockIdx.x + G - (N_CL % G)) % G);
  if (PROBE == 5) for (int it = start; it < N_A; it += G) attnA_item(p, l, it, smem, true);
  for (int it = start; it < N_A; it += G) attnA_item(p, l, it, smem);
  start = (int)((blockIdx.x + G - ((N_CL + N_A) % G)) % G);
  if (PROBE == 10) for (int it = start; it < N_CC; it += G) attnC_item(p, l, it, smem, lam, lam_init, true);
  for (int it = start; it < N_CC; it += G) attnC_item(p, l, it, smem, lam, lam_init);
  start = (int)((blockIdx.x + G - ((N_CL + N_A + N_CC) % G)) % G);
  if (PROBE == 6) lru_run(p, l, false, start, G, (float*)smem);
  lru_run(p, l, false, start, G, (float*)smem);
}

__device__ __forceinline__ void lru2_phase(const Params& p, int l, u16* smem) {
  if (PROBE == 7) lru_run(p, l, true, blockIdx.x, gridDim.x, (float*)smem, true);
  lru_run(p, l, true, blockIdx.x, gridDim.x, (float*)smem);
}

#define XB_TMO      128
#define XB_XCNT(j)  (256  + 64 * (j))
#define XB_XSUB(j)  (1280 + 64 * (j))
#define XB_XGEN(j)  (2304 + 64 * (j))
#define XB_TOP      3328
#define XB_TOPGEN   3392
#define XCD_BAR_WORDS 3456
#define XB_SPIN_CAP (1u << 18)
__device__ __forceinline__ unsigned xb_ld(unsigned* p)              { return __hip_atomic_load(p, __ATOMIC_RELAXED, __HIP_MEMORY_SCOPE_AGENT); }
__device__ __forceinline__ unsigned xb_add(unsigned* p, unsigned v) { return __hip_atomic_fetch_add(p, v, __ATOMIC_RELAXED, __HIP_MEMORY_SCOPE_AGENT); }
__device__ __forceinline__ unsigned xb_xcc_id() { return (unsigned)__builtin_amdgcn_s_getreg((3 << 11) | 20) & 0xFu; }
#define XB_SPIN(cond, bar) do { unsigned _sp = 0; while (cond) { __builtin_amdgcn_s_sleep(1); \
    if ((++_sp & 255u) == 0u) { if (xb_ld(&(bar)[XB_TMO])) break; if (_sp > XB_SPIN_CAP) { atomicAdd(&(bar)[XB_TMO], 1u); break; } } } } while (0)
struct XcdBarrier { unsigned* bar; unsigned x; volatile LAS unsigned* st; };
__device__ __forceinline__ XcdBarrier xcd_barrier_post(unsigned* bar, volatile LAS unsigned* st) {
  XcdBarrier b; b.bar = bar; b.x = xb_xcc_id(); b.st = st;
  if (threadIdx.x == 0) (void)xb_add(&bar[XB_XCNT(b.x)], 1u);
  return b;
}
__device__ __forceinline__ void xcd_barrier_complete(unsigned* bar, unsigned x, unsigned& nloc, unsigned& nx) {
  const unsigned G = gridDim.x * gridDim.y * gridDim.z;
  unsigned sum, cnt, mine, sp = 0u;
  for (;;) {
    sum = 0u; cnt = 0u; mine = 0u;
#pragma unroll
    for (unsigned j = 0; j < 16; ++j) { const unsigned c = xb_ld(&bar[XB_XCNT(j)]); sum += c; cnt += (c > 0u) ? 1u : 0u; mine = (j == x) ? c : mine; }
    if (sum == G) break;
    __builtin_amdgcn_s_sleep(1);
    if ((++sp & 255u) == 0u) { if (xb_ld(&bar[XB_TMO])) break; if (sp > XB_SPIN_CAP) { atomicAdd(&bar[XB_TMO], 1u); break; } }
  }
  nloc = mine > 0u ? mine : 1u; nx = cnt > 0u ? cnt : 1u;
}
__device__ __forceinline__ void xcd_barrier(const XcdBarrier& b) {
  asm volatile("s_waitcnt vmcnt(0)" ::: "memory");
  __syncthreads();
  if (threadIdx.x == 0) {
    unsigned* bar = b.bar;
    __builtin_amdgcn_s_waitcnt(0);
    unsigned nloc = b.st[0], nx = b.st[1];
    if (nloc == 0u) { xcd_barrier_complete(bar, b.x, nloc, nx); b.st[0] = nloc; b.st[1] = nx; }
    const unsigned old = xb_add(&bar[XB_XSUB(b.x)], 1u);
    const unsigned gen = old / nloc;
    if (old + 1u == (gen + 1u) * nloc) {
      __builtin_amdgcn_fence(__ATOMIC_RELEASE, "agent");
      asm volatile("s_waitcnt vmcnt(0)" ::: "memory");
      const unsigned og = xb_add(&bar[XB_TOP], 1u);
      const unsigned tg = og / nx;
      if (og + 1u == (tg + 1u) * nx) xb_add(&bar[XB_TOPGEN], 1u);
      else XB_SPIN(xb_ld(&bar[XB_TOPGEN]) == tg, bar);
      __builtin_amdgcn_fence(__ATOMIC_ACQUIRE, "agent");
      xb_add(&bar[XB_XGEN(b.x)], 1u);
      asm volatile("s_waitcnt vmcnt(0)" ::: "memory");
    } else {
      XB_SPIN(xb_ld(&bar[XB_XGEN(b.x)]) == gen, bar);
      __builtin_amdgcn_fence(__ATOMIC_ACQUIRE, "agent");
      asm volatile("s_waitcnt vmcnt(0)" ::: "memory");
    }
  }
  __syncthreads();
}

typedef __attribute__((address_space(4))) const Params CParams;
__device__ __forceinline__ const Params& get_params() {
  CParams* kp = (CParams*)__builtin_amdgcn_kernarg_segment_ptr();
  asm volatile("" : "+s"(kp));
  return *(const Params*)kp;
}
__global__ void __launch_bounds__(NT, 2) fwd_kernel(Params p_unused) {
  extern __shared__ __attribute__((aligned(16))) unsigned char lds_raw[];
  u16* smem = (u16*)lds_raw;
  LAS unsigned char* lds = (LAS unsigned char*)lds_raw;
  cg::grid_group grid = cg::this_grid();
  volatile LAS unsigned* xst = (volatile LAS unsigned*)(lds + STAGE_BYTES + SPARE_BYTES);
  if (threadIdx.x == 0) { xst[0] = 0u; xst[1] = 0u; }
  __syncthreads();
  XcdBarrier xb = xcd_barrier_post(get_params().bar, xst);
  prologue_phase(get_params(), (float*)smem);
  grid.sync();
  if (PROBE == 9) { for (int i = 0; i < 10; i++) xcd_barrier(xb); }
#pragma unroll 1
  for (int l = 0; l < 2; l++) {
    norm_phase(get_params(), l);
    if (PROBE == 3) { norm_phase(get_params(), l); if (l == 0) { xcd_barrier(xb); prologue_phase(get_params(), (float*)smem); } }
    xcd_barrier(xb);
    {
      const Params& p = get_params();
      SchedStd S; S.nM = NTOK / 256; S.nN = INC / 256; S.nwg = S.nM * S.nN; S.G = gridDim.x; S.c = blockIdx.x;
      S.A = (const char*)p.H; S.B = (const char*)(p.Wt_in + (size_t)l * INC * 1024); S.tA = (size_t)256 * 1024 * 2; S.tB = (size_t)256 * 1024 * 2;
      EpiInproj E; E.pp = &p; E.l = l; E.part = (LAS float*)(lds + STAGE_BYTES);
      gemm_phase(lds, 1024, 1024, 1024, S, E);
      if (PROBE == 1) { __syncthreads(); gemm_phase(lds, 1024, 1024, 1024, S, E); }
    }
    xcd_barrier(xb);
    mix_phase(get_params(), l, smem);
    xcd_barrier(xb);
    lru2_phase(get_params(), l, smem);
    xcd_barrier(xb);
    {
      const Params& p = get_params();
      SchedBranch S; S.G = gridDim.x; S.c = blockIdx.x; S.P_ = (const char*)p.P; S.W_ = (const char*)(p.Wt_br + (size_t)l * 3 * 1024 * 512);
      EpiBranch E; E.pp = &p;
      gemm_phase(lds, PP, 512, 512, S, E);
      if (PROBE == 2) { __syncthreads(); gemm_phase(lds, PP, 512, 512, S, E); }
    }
    xcd_barrier(xb);
    {
      const Params& p = get_params();
      SchedStd S; S.nM = NTOK / 256; S.nN = 4; S.nwg = S.nM * S.nN; S.G = gridDim.x; S.c = blockIdx.x;
      S.A = (const char*)p.H; S.B = (const char*)(p.Wt_out + (size_t)l * 1024 * 1024); S.tA = (size_t)256 * 1024 * 2; S.tB = (size_t)256 * 1024 * 2;
      EpiOut E; E.pp = &p; E.l = l;
      gemm_phase(lds, 1024, 1024, 1024, S, E);
      if (PROBE == 8 && l == 0) { __syncthreads(); gemm_phase(lds, 1024, 1024, 1024, S, E); }
    }
    if (l == 0) xcd_barrier(xb);
  }
}

extern "C" void kernel_launch(void* const* d_in, const int* in_sizes, int n_in, void* d_out, int out_size, void* d_ws,
                              size_t ws_size, hipStream_t stream) {
  Params p{};
  const float** ip = (const float**)&p;
  for (int i = 0; i < 34; i++) ip[i] = (const float*)d_in[i];
  p.out = (float*)d_out;
  char* w = (char*)d_ws; size_t off = 0;
  auto take = [&](size_t bytes) { char* q = w + off; off += (bytes + 255) & ~(size_t)255; return q; };
  p.Wt_in = (u16*)take((size_t)2 * INC * 1024 * 2);
  p.Wt_br = (u16*)take((size_t)6 * 1024 * 512 * 2);
  p.Wt_out = (u16*)take((size_t)2 * 1024 * 1024 * 2);
  p.H = (u16*)take((size_t)NTOK * 1024 * 2);
  p.P = (u16*)take((size_t)NTOK * PP * 2);
  p.VtA_ctx = (u16*)take((size_t)16 * 2 * 64 * 256 * 2);
  p.VtA_lat = (u16*)take((size_t)2 * 2 * 64 * 4096 * 2);
  p.VtC_ctx = (u16*)take((size_t)16 * 4 * 128 * 256 * 2);
  p.VtC_lat = (u16*)take((size_t)2 * 4 * 128 * 4096 * 2);
  p.cKa = (u16*)take((size_t)2 * 2 * 512 * 128 * 2);
  p.cVtA = (u16*)take((size_t)2 * 2 * 512 * 128 * 2);
  p.cKc = (u16*)take((size_t)2 * 2 * 512 * 512 * 2);
  p.cVtC = (u16*)take((size_t)2 * 2 * 512 * 512 * 2);
  p.mod = (float*)take((size_t)2 * 3 * 3072 * 4);
  p.rope = (float*)take((size_t)2048 * 4);
  p.lruTot = (float*)take((size_t)192 * 2 * 512 * 2 * 4);
  p.Wt_lru = (u16*)take((size_t)2 * 2 * 8 * 2 * 64 * 64 * 2);
  p.bar = (unsigned*)take((size_t)XCD_BAR_WORDS * 4);
  p.MG = (uint2*)take((size_t)48 * 4 * 3 * 16384 * 8);
  static int grid_blocks = 0;
  if (!grid_blocks) {
    int dev = 0, cus = 0;
    hipGetDevice(&dev);
    hipDeviceGetAttribute(&cus, hipDeviceAttributeMultiprocessorCount, dev);
    hipFuncSetAttribute((const void*)fwd_kernel, hipFuncAttributeMaxDynamicSharedMemorySize, LDS_BYTES);
    int per_cu = 0;
    hipOccupancyMaxActiveBlocksPerMultiprocessor(&per_cu, (const void*)fwd_kernel, NT, LDS_BYTES);
    (void)hipGetLastError();
    grid_blocks = cus;
  }
  hipMemsetAsync(p.bar, 0, (size_t)XCD_BAR_WORDS * 4, stream);
  void* args[] = {&p};
  hipLaunchCooperativeKernel((void*)fwd_kernel, dim3(grid_blocks), dim3(NT), args, LDS_BYTES, stream);
}
```

```cpp
#include <hip/hip_runtime.h>
#include <hip/hip_cooperative_groups.h>
#include <stdint.h>
#include <math.h>
namespace cg = cooperative_groups;

typedef unsigned short u16;
typedef __attribute__((ext_vector_type(8))) short bf16x8;
typedef __attribute__((ext_vector_type(4))) short bf16x4;
typedef __attribute__((ext_vector_type(16))) float f32x16;
typedef __attribute__((ext_vector_type(4))) float f32x4;
#define LAS __attribute__((address_space(3)))

#ifndef PROBE
#define PROBE 0
#endif
#define NT 512
constexpr int NTOK = 12288, NCTX = 4096;
constexpr int INC = 7424;
constexpr int PP = 3712;
constexpr int C_QA = 0, C_KA = 512, C_GA = 640, C_XB = 1152, C_GB = 1664, C_QC = 2176, C_KC = 2688, C_GC = 3200;
constexpr int LROW = 72;
constexpr int VROW = 68;
constexpr float EPS = 1e-6f;
constexpr int STAGE_BYTES = 131072;
constexpr int SPARE_BYTES = 8192;
constexpr int LDS_BYTES = STAGE_BYTES + SPARE_BYTES + 16;

constexpr size_t O_X = 0, O_KA = 12582912, O_VA = 13631488, O_KC = 14680064, O_VC = 18874368, O_ST = 23068672;

struct Params {
  const float *x_prompt, *x_sample, *cache_a_k, *cache_a_v, *cache_c_k, *cache_c_v, *state_lru, *c, *c_ctx,
      *norm_g, *mod_w, *mod_b, *w_in, *qn_a, *kn_a, *sink_a, *conv_w, *conv_b, *lru_wa, *lru_ba, *lru_wx, *lru_bx,
      *lru_lam, *qn_c, *kn_c, *lam_q1, *lam_k1, *lam_q2, *lam_k2, *subln_c, *w_br_a, *w_br_b, *w_br_c, *w_out;
  float* out;
  u16 *Wt_in, *Wt_br, *Wt_out, *H, *P, *VtA_ctx, *VtA_lat, *VtC_ctx, *VtC_lat, *cKa, *cVtA, *cKc, *cVtC;
  float *mod, *rope, *lruTot;
  u16 *Wt_lru;
  unsigned* bar;
  u16* Y;
  u16* GB;
  uint2* MG;
};

__device__ __forceinline__ int tid_opaque() { int t = (int)threadIdx.x; asm volatile("" : "+v"(t)); return t; }
#define TIDX tid_opaque()
__device__ __forceinline__ u16 f2bf(float f) {
  uint32_t u = __float_as_uint(f);
  u += 0x7FFFu + ((u >> 16) & 1u);
  return (u16)(u >> 16);
}
__device__ __forceinline__ float bf2f(u16 h) { return __uint_as_float(((uint32_t)h) << 16); }
__device__ __forceinline__ uint32_t pack2(float a, float b) { uint32_t r; asm("v_cvt_pk_bf16_f32 %0, %1, %2" : "=v"(r) : "v"(a), "v"(b)); return r; }
__device__ __forceinline__ float sigmoidf_(float x) { return 1.f / (1.f + __expf(-x)); }
__device__ __forceinline__ float siluf_(float x) { return x / (1.f + __expf(-x)); }
__device__ __forceinline__ f32x16 mfma32(bf16x8 a, bf16x8 b, f32x16 c) {
  return __builtin_amdgcn_mfma_f32_32x32x16_bf16(a, b, c, 0, 0, 0);
}
__device__ __forceinline__ float shflx(float v, int mask, int lane) {
  return __builtin_bit_cast(float, __builtin_amdgcn_ds_bpermute((lane ^ mask) << 2, __builtin_bit_cast(int, v)));
}
__device__ __forceinline__ float lo_bf(uint32_t w) { return __uint_as_float(w << 16); }
__device__ __forceinline__ float hi_bf(uint32_t w) { return __uint_as_float(w & 0xffff0000u); }

__device__ __forceinline__ size_t tm_off(int r, int k, int KT) {
  return ((size_t)((r >> 8) * KT + (k >> 6)) * 256 + (r & 255)) * 64 + (k & 63);
}
__device__ __forceinline__ void transpose_tile(const float* __restrict__ src, int spitch, u16* __restrict__ dst, int dpitch,
                               int r0, int c0, float* sm, int KT = 0) {
  const int tid = TIDX;
#pragma unroll
  for (int i = 0; i < 2; i++) {
    int c = tid + i * NT; int r = c >> 4, q = c & 15;
    float4 v = *(const float4*)(src + (size_t)(r0 + r) * spitch + c0 + q * 4);
    float* d = sm + r * 65 + q * 4;
    d[0] = v.x; d[1] = v.y; d[2] = v.z; d[3] = v.w;
  }
  __syncthreads();
  {
    int c = tid; int cc = c >> 3, q = c & 7;
    uint32_t w[4];
#pragma unroll
    for (int j = 0; j < 4; j++) w[j] = pack2(sm[(q * 8 + 2 * j) * 65 + cc], sm[(q * 8 + 2 * j + 1) * 65 + cc]);
    uint4 v; v.x = w[0]; v.y = w[1]; v.z = w[2]; v.w = w[3];
    if (KT) *(uint4*)(dst + tm_off(c0 + cc, r0 + q * 8, KT)) = v;
    else *(uint4*)(dst + (size_t)(c0 + cc) * dpitch + r0 + q * 8) = v;
  }
  __syncthreads();
}

__device__ __forceinline__ void mod_item(const Params& p, int it, float* sm) {
  const int tid = TIDX;
  const int l = it / 48, n0 = (it % 48) * 64;
  float* sv = sm;
  float* red = sm + 3072;
  for (int e = tid; e < 3072; e += NT) {
    int v = e >> 10, k = e & 1023;
    float x = (v == 0) ? p.c_ctx[k] : p.c[(v - 1) * 1024 + k];
    sv[e] = siluf_(x);
  }
  __syncthreads();
  const int col = tid & 63, kg = tid >> 6;
  const float* w = p.mod_w + (size_t)l * 1024 * 3072 + n0 + col;
  float a0 = 0, a1 = 0, a2 = 0;
#pragma unroll 8
  for (int k = kg * 128; k < kg * 128 + 128; k++) {
    float wv = w[(size_t)k * 3072];
    a0 += sv[k] * wv; a1 += sv[1024 + k] * wv; a2 += sv[2048 + k] * wv;
  }
  red[(kg * 3 + 0) * 64 + col] = a0; red[(kg * 3 + 1) * 64 + col] = a1; red[(kg * 3 + 2) * 64 + col] = a2;
  __syncthreads();
  if (tid < 192) {
    int v = tid >> 6, c = tid & 63;
    float s = p.mod_b[l * 3072 + n0 + c];
#pragma unroll
    for (int g = 0; g < 8; g++) s += red[(g * 3 + v) * 64 + c];
    p.mod[(l * 3 + v) * 3072 + n0 + c] = s;
  }
  __syncthreads();
}

__device__ __forceinline__ void prologue_phase(const Params& p, float* sm) {
  constexpr int N_MOD = 96, N_ROPE = 1, N_WIN = 2 * 16 * 116, N_WBR = 6 * 8 * 16, N_WOUT = 2 * 16 * 16;
  constexpr int N_CK = 64 + 256, N_CVA = 4 * 16, N_CVC = 4 * 64, N_LW = 64;
  constexpr int E0 = N_MOD, E1 = E0 + N_ROPE, E2 = E1 + N_WIN, E3 = E2 + N_WBR, E4 = E3 + N_WOUT, E5 = E4 + N_CK,
                E6 = E5 + N_CVA, E7 = E6 + N_CVC, E8 = E7 + N_LW;
  const int tid = TIDX;
  for (int it = blockIdx.x; it < E8; it += gridDim.x) {
    if (it < E0) {
      mod_item(p, it, sm);
    } else if (it < E1) {
      for (int e = tid; e < 1024; e += NT) {
        int pos = e >> 4, f = e & 15;
        float inv = powf(10000.f, -(float)f / 16.f);
        float ang = (float)pos * inv;
        p.rope[e] = cosf(ang); p.rope[1024 + e] = sinf(ang);
      }
    } else if (it < E2) {
      int j = it - E1; int l = j / (16 * 116); int r = j % (16 * 116);
      int kt = r / 116, nt = r % 116;
      transpose_tile(p.w_in + (size_t)l * 1024 * INC, INC, p.Wt_in + (size_t)l * INC * 1024, 1024, kt * 64, nt * 64, sm, 16);
    } else if (it < E3) {
      int j = it - E2; int m = j / 128; int r = j % 128;
      int l = m / 3, i = m % 3;
      const float* src = (i == 0 ? p.w_br_a : (i == 1 ? p.w_br_b : p.w_br_c)) + (size_t)l * 512 * 1024;
      int kt = r / 16, nt = r % 16;
      transpose_tile(src, 1024, p.Wt_br + (size_t)m * 1024 * 512, 512, kt * 64, nt * 64, sm, 8);
    } else if (it < E4) {
      int j = it - E3; int l = j / 256; int r = j % 256;
      int kt = r / 16, nt = r % 16;
      transpose_tile(p.w_out + (size_t)l * 1024 * 1024, 1024, p.Wt_out + (size_t)l * 1024 * 1024, 1024, kt * 64, nt * 64, sm, 16);
    } else if (it < E5) {
      int j = it - E4;
      const float* src; u16* dst; size_t off;
      if (j < 64) { src = p.cache_a_k; dst = p.cKa; off = (size_t)j * 4096; }
      else { src = p.cache_c_k; dst = p.cKc; off = (size_t)(j - 64) * 4096; }
      size_t e = off + (size_t)tid * 8;
      float4 a = *(const float4*)(src + e), b = *(const float4*)(src + e + 4);
      uint4 v; v.x = pack2(a.x, a.y); v.y = pack2(a.z, a.w); v.z = pack2(b.x, b.y); v.w = pack2(b.z, b.w);
      *(uint4*)(dst + e) = v;
    } else if (it < E6) {
      int j = it - E5; int bl = j / 16; int r = j % 16;
      int rt = r / 2, ct = r % 2;
      transpose_tile(p.cache_a_v + (size_t)bl * 512 * 128, 128, p.cVtA + (size_t)bl * 128 * 512, 512, rt * 64, ct * 64, sm);
    } else if (it < E7) {
      int j = it - E6; int bl = j / 64; int r = j % 64;
      int rt = r / 8, ct = r % 8;
      transpose_tile(p.cache_c_v + (size_t)bl * 512 * 512, 512, p.cVtC + (size_t)bl * 512 * 512, 512, rt * 64, ct * 64, sm);
    } else {
      int j = it - E7; int ldn = j >> 1, g = j & 1;
      transpose_tile((g ? p.lru_wx : p.lru_wa) + (size_t)ldn * 4096, 64, p.Wt_lru + (size_t)(ldn * 2 + g) * 4096, 64, 0, 0, sm);
    }
  }
}

__device__ __forceinline__ void norm_phase(const Params& p, int l) {
  const int tid = TIDX, lane = tid & 63, wid = tid >> 6;
  const float* g = p.norm_g + l * 1024;
  for (int it = blockIdx.x; it < NTOK / 8; it += gridDim.x) {
    int row = it * 8 + wid;
    const float* x;
    if (l == 0) x = (row < NCTX) ? p.x_prompt + (size_t)row * 1024 : p.x_sample + (size_t)(row - NCTX) * 1024;
    else x = p.out + O_X + (size_t)row * 1024;
    int v = (row < NCTX) ? 0 : 1 + (row - NCTX) / 4096;
    const float* md = p.mod + (l * 3 + v) * 3072;
    float4 xv[4]; float ss = 0;
#pragma unroll
    for (int i = 0; i < 4; i++) {
      xv[i] = *(const float4*)(x + i * 256 + lane * 4);
      ss += xv[i].x * xv[i].x + xv[i].y * xv[i].y + xv[i].z * xv[i].z + xv[i].w * xv[i].w;
    }
#pragma unroll
    for (int o = 32; o > 0; o >>= 1) ss += shflx(ss, o, lane);
    float rinv = rsqrtf(ss * (1.f / 1024.f) + EPS);
#pragma unroll
    for (int i = 0; i < 4; i++) {
      int c = i * 256 + lane * 4;
      float4 gv = *(const float4*)(g + c), sh = *(const float4*)(md + c), sc = *(const float4*)(md + 1024 + c);
      float h0 = xv[i].x * rinv * gv.x * (1.f + sc.x) + sh.x;
      float h1 = xv[i].y * rinv * gv.y * (1.f + sc.y) + sh.y;
      float h2 = xv[i].z * rinv * gv.z * (1.f + sc.z) + sh.z;
      float h3 = xv[i].w * rinv * gv.w * (1.f + sc.w) + sh.w;
      uint2 o2; o2.x = pack2(h0, h1); o2.y = pack2(h2, h3);
      *(uint2*)(p.H + tm_off(row, c, 16)) = o2;
    }
  }
}

constexpr int G_BK = 64, G_HALF = 128, G_HTB = G_HALF * G_BK * 2;
__device__ __forceinline__ int lds_byte(int r, int c) {
  const int st = (r >> 4) * 2 + (c >> 5), rr = r & 15, cc = c & 31, ob = rr * 64 + cc * 2;
  return st * 1024 + (ob ^ (((ob >> 9) & 1) << 5));
}
__device__ __forceinline__ void stage_rc(int b, int& R, int& C) {
  const int st = b / 1024, sb = b % 1024, swz = sb ^ (((sb >> 9) & 1) << 5);
  R = (st >> 1) * 16 + swz / 64; C = (st & 1) * 32 + (swz % 64) / 2;
}
struct Unit { int pm, pn, seg; };

struct SchedStd {
  int nM, nN, nwg, G, c; const char* A; const char* B; size_t tA, tB;
  __device__ __forceinline__ bool next(int i, Unit& u) const {
    const long L = (long)i * G + c; if (L >= nwg) return false;
    int wgid = (int)L;
    { const int q = nwg / 8, r = nwg % 8, xcd = wgid % 8, off = wgid / 8; wgid = (xcd < r ? xcd * (q + 1) : r * (q + 1) + (xcd - r) * q) + off; }
    const int nig = 8 * nN, gid = wgid / nig, fm = gid * 8, gsz = (nM - fm) < 8 ? (nM - fm) : 8;
    u.pm = fm + ((wgid % nig) % gsz); u.pn = (wgid % nig) / gsz; u.seg = 0; return true;
  }
  __device__ __forceinline__ const char* aptr(const Unit& u) const { return A + (size_t)u.pm * tA; }
  __device__ __forceinline__ const char* bptr(const Unit& u) const { return B + (size_t)u.pn * tB; }
};
struct SchedBranch {
  int G, c; const char* P_; const char* W_;
  __device__ __forceinline__ bool next(int i, Unit& u) const {
    const int tile = (i / 3) * G + c; if (tile >= 192) return false;
    u.seg = i % 3; u.pm = tile >> 2; u.pn = tile & 3; return true;
  }
  __device__ __forceinline__ const char* aptr(const Unit& u) const { return P_ + (size_t)((u.seg * 48 + u.pm) * 8) * 32768; }
  __device__ __forceinline__ const char* bptr(const Unit& u) const { return W_ + (size_t)((u.seg * 4 + u.pn) * 8) * 32768; }
};

template <class Epi, class Sched>
__device__ __forceinline__ void gemm_phase(LAS unsigned char* lds, const int K, const Sched& S, const Epi& E) {
  const int tid = TIDX, wid = __builtin_amdgcn_readfirstlane(tid >> 6), lane = tid & 63, wr = wid >> 2, wc = wid & 3, fr = lane & 15, fq = lane >> 4;
  const int nt = K / G_BK;
  unsigned voffA[2], voffB[2];
#pragma unroll
  for (int i = 0; i < 2; ++i) { int R, C; stage_rc(tid * 16 + i * 8192, R, C);
    voffA[i] = (unsigned)(R * 64 + C) * 2u; voffB[i] = voffA[i]; }
  const size_t kstep = (size_t)32768;
  const size_t hA = (size_t)16384, hB = (size_t)16384;
  const unsigned ldsw = (unsigned)wid * 1024u;
  const int aoff = lds_byte(wr * 64 + fr, fq * 8), boff = lds_byte(wc * 32 + fr, fq * 8);
#define G_SA(b, h) (((b) * 2 + (h)) * G_HTB)
#define G_SB(b, h) ((4 + (b) * 2 + (h)) * G_HTB)
#define G_STAGE(bufoff, gbase, voff) do { _Pragma("unroll") for (int _i = 0; _i < 2; ++_i) \
    __builtin_amdgcn_global_load_lds((const unsigned*)((const char*)(gbase) + (voff)[_i]), (LAS unsigned*)(lds + (bufoff) + ldsw + _i * 8192), 16, 0, 0); } while (0)
#define G_LDA(dst, b, h) do { _Pragma("unroll") for (int m = 0; m < 4; ++m) _Pragma("unroll") for (int k = 0; k < 2; ++k) dst[m][k] = *(const LAS bf16x8*)(lds + G_SA(b, h) + aoff + m * 2048 + k * 1024); } while (0)
#define G_LDB(dst, b, h) do { _Pragma("unroll") for (int n = 0; n < 2; ++n) _Pragma("unroll") for (int k = 0; k < 2; ++k) dst[n][k] = *(const LAS bf16x8*)(lds + G_SB(b, h) + boff + n * 2048 + k * 1024); } while (0)
#define G_MMA(ai, bj, At, Bt) do { __builtin_amdgcn_s_setprio(1); _Pragma("unroll") for (int m = 0; m < 4; ++m) _Pragma("unroll") for (int n = 0; n < 2; ++n) _Pragma("unroll") for (int k = 0; k < 2; ++k) \
    acc[ai][bj][m][n] = __builtin_amdgcn_mfma_f32_16x16x32_bf16(Bt[n][k], At[m][k], acc[ai][bj][m][n], 0, 0, 0); __builtin_amdgcn_s_setprio(0); } while (0)
#define G_WAIT_V(n) asm volatile("s_waitcnt vmcnt(" #n ")" ::: "memory")
#define G_WAIT_L(n) asm volatile("s_waitcnt lgkmcnt(" #n ")" ::: "memory")
#define G_BAR __builtin_amdgcn_s_barrier()
#define G_SCHED __builtin_amdgcn_sched_barrier(0)
  Unit cur, nxt; int ui = 0;
  if (!S.next(0, cur)) return;
  f32x4 acc[2][2][4][2];
#pragma unroll
  for (int a = 0; a < 2; ++a)
#pragma unroll
    for (int b = 0; b < 2; ++b)
#pragma unroll
      for (int m = 0; m < 4; ++m)
#pragma unroll
        for (int n = 0; n < 2; ++n) acc[a][b][m][n] = (f32x4){0.f, 0.f, 0.f, 0.f};
  bf16x8 At[4][2], B0[2][2], B1[2][2];
  const char* cA = S.aptr(cur); const char* cB = S.bptr(cur);
  G_STAGE(G_SB(0, 0), cB, voffB); G_STAGE(G_SA(0, 0), cA, voffA); G_STAGE(G_SB(0, 1), cB + hB, voffB); G_STAGE(G_SA(0, 1), cA + hA, voffA);
  if (wr == 1) G_BAR;
  G_WAIT_V(4); G_BAR;
  G_STAGE(G_SB(1, 0), cB + kstep, voffB); G_STAGE(G_SA(1, 0), cA + kstep, voffA); G_STAGE(G_SB(1, 1), cB + hB + kstep, voffB);
  G_WAIT_V(6); G_BAR;
  for (;;) {
    const bool has_next = S.next(ui + 1, nxt);
    const char* nA = has_next ? S.aptr(nxt) : cA; const char* nB = has_next ? S.bptr(nxt) : cB;
    for (int t = 0; t < nt; t += 2) {
      const bool last = (t == nt - 2);
      const char* a1 = cA + (size_t)(t + 1) * kstep;
      const char* a2 = last ? nA : cA + (size_t)(t + 2) * kstep; const char* b2 = last ? nB : cB + (size_t)(t + 2) * kstep;
      const char* a3 = a2 + kstep; const char* b3 = b2 + kstep;
      G_LDB(B0, 0, 0); G_SCHED; G_LDA(At, 0, 0); G_STAGE(G_SA(1, 1), a1 + hA, voffA);
      G_WAIT_L(8); G_BAR; G_WAIT_L(0); G_MMA(0, 0, At, B0); G_BAR; G_SCHED;
      G_LDB(B1, 0, 1); G_STAGE(G_SB(0, 0), b2, voffB);
      G_BAR; G_WAIT_L(0); G_MMA(0, 1, At, B1); G_BAR;
      G_LDA(At, 0, 1); G_STAGE(G_SA(0, 0), a2, voffA);
      G_BAR; G_WAIT_L(0); G_MMA(1, 0, At, B0); G_BAR; G_SCHED;
      G_STAGE(G_SB(0, 1), b2 + hB, voffB);
      G_WAIT_V(6); G_BAR; G_MMA(1, 1, At, B1); G_BAR;
      G_LDB(B0, 1, 0); G_SCHED; G_LDA(At, 1, 0); G_STAGE(G_SA(0, 1), a2 + hA, voffA);
      G_WAIT_L(8); G_BAR; G_WAIT_L(0); G_MMA(0, 0, At, B0); G_BAR; G_SCHED;
      G_LDB(B1, 1, 1); G_STAGE(G_SB(1, 0), b3, voffB);
      G_BAR; G_WAIT_L(0); G_MMA(0, 1, At, B1); G_BAR;
      G_LDA(At, 1, 1); G_STAGE(G_SA(1, 0), a3, voffA);
      G_BAR; G_WAIT_L(0); G_MMA(1, 0, At, B0); G_BAR; G_SCHED;
      G_STAGE(G_SB(1, 1), b3 + hB, voffB);
      G_WAIT_V(6); G_BAR; G_MMA(1, 1, At, B1); G_BAR;
    }
    const bool reset = E(acc, cur, wr, wc, fr, fq);
    if (!has_next) break;
    if (reset) {
#pragma unroll
      for (int a = 0; a < 2; ++a)
#pragma unroll
        for (int b = 0; b < 2; ++b)
#pragma unroll
          for (int m = 0; m < 4; ++m)
#pragma unroll
            for (int n = 0; n < 2; ++n) acc[a][b][m][n] = (f32x4){0.f, 0.f, 0.f, 0.f};
    }
    cur = nxt; cA = nA; cB = nB; ++ui;
  }
  G_WAIT_V(0);
  if (wr == 0) G_BAR;
  G_BAR;
#undef G_SA
#undef G_SB
#undef G_STAGE
#undef G_LDA
#undef G_LDB
#undef G_MMA
#undef G_WAIT_V
#undef G_WAIT_L
#undef G_BAR
#undef G_SCHED
}

struct EpiInproj {
  const Params* pp; int l; LAS float* part;
  __device__ __forceinline__ bool operator()(f32x4 (&acc)[2][2][4][2], const Unit& u, int wr, int wc, int fr, int fq) const {
    const Params& p = *pp;
    asm volatile("" : "+v"(fr), "+v"(fq));
    const int lane = fr + 16 * fq; (void)lane;
    const int oc0 = u.pn * 256;
    const bool isctx = u.pm < 16;
    const bool qkU = (oc0 < 768) || (oc0 >= 2304 && oc0 < 3328);
    float rinv[2][4][2];
    if (qkU) {
#pragma unroll
      for (int ai = 0; ai < 2; ai++)
#pragma unroll
        for (int m = 0; m < 4; m++)
#pragma unroll
          for (int bj = 0; bj < 2; bj++) {
            f32x4 a = acc[ai][bj][m][0], b = acc[ai][bj][m][1];
            float ss = a[0] * a[0] + a[1] * a[1] + a[2] * a[2] + a[3] * a[3] + b[0] * b[0] + b[1] * b[1] + b[2] * b[2] + b[3] * b[3];
            ss += shflx(ss, 16, lane); ss += shflx(ss, 32, lane);
            rinv[ai][m][bj] = ss;
            if (fq == 0) part[((ai * 128 + wr * 64 + m * 16 + fr) * 2 + bj) * 4 + wc] = ss;
          }
      asm volatile("s_waitcnt lgkmcnt(0)" ::: "memory");
      __builtin_amdgcn_s_barrier();
      asm volatile("" ::: "memory");
#pragma unroll
      for (int ai = 0; ai < 2; ai++)
#pragma unroll
        for (int m = 0; m < 4; m++)
#pragma unroll
          for (int bj = 0; bj < 2; bj++) {
            float o = part[((ai * 128 + wr * 64 + m * 16 + fr) * 2 + bj) * 4 + (wc ^ 1)];
            rinv[ai][m][bj] = rsqrtf((rinv[ai][m][bj] + o) * (1.f / 64.f) + EPS);
          }
    }
#pragma unroll
    for (int bj = 0; bj < 2; bj++) {
      const int oc = oc0 + bj * 128;
      if (oc == 640 || (oc >= 3328 && oc < 3840)) {
        const bool isA = (oc == 640);
        const int cb = isA ? 0 : (oc - 3328);
        const int nvec = isA ? 128 : 512;
#pragma unroll
        for (int ai = 0; ai < 2; ai++)
#pragma unroll
          for (int m = 0; m < 4; m++) {
            const int row = u.pm * 256 + ai * 128 + wr * 64 + m * 16 + fr;
            int b, t, T; u16* vt;
            if (isctx) { b = row >> 8; t = row & 255; T = 256; vt = isA ? p.VtA_ctx : p.VtC_ctx; }
            else { int rr = row - NCTX; b = rr >> 12; t = rr & 4095; T = 4096; vt = isA ? p.VtA_lat : p.VtC_lat; }
#pragma unroll
            for (int n = 0; n < 2; n++) {
              const int d = cb + wc * 32 + n * 16 + fq * 4;
              f32x4 v = acc[ai][bj][m][n];
#pragma unroll
              for (int j = 0; j < 4; j++) vt[((size_t)b * nvec + d + j) * T + t] = f2bf(v[j]);
              if (isctx) {
                float* o = p.out + (isA ? O_VA : O_VC) + ((size_t)(b * 2 + l) * 256 + t) * nvec + d;
                *(f32x4*)o = v;
              }
            }
          }
      } else {
        const int pc = (oc < 640) ? oc : (oc < 3328 ? oc - 128 : oc - 640);
        const bool is_qa = oc < 512, is_ka = (oc == 512);
        const bool is_qc = (oc >= 2304 && oc < 2816), is_kc = (oc >= 2816 && oc < 3328);
        if (is_qa || is_ka || is_qc || is_kc) {
          const float* gn = (is_qa ? p.qn_a : is_ka ? p.kn_a : is_qc ? p.qn_c : p.kn_c) + l * 64 + (wc & 1) * 32 + fq * 4;
          const f32x4 g0 = *(const f32x4*)gn, g1 = *(const f32x4*)(gn + 16);
          const float qs = (is_qa || is_qc) ? 0.18033688011112042f : 1.f;
#pragma unroll
          for (int ai = 0; ai < 2; ai++)
#pragma unroll
            for (int m = 0; m < 4; m++) {
              const int row = u.pm * 256 + ai * 128 + wr * 64 + m * 16 + fr;
              const float ri = rinv[ai][m][bj];
              f32x4 x1 = acc[ai][bj][m][0] * ri * g0, x2 = acc[ai][bj][m][1] * ri * g1;
              if (!isctx) {
                const int t = (row - NCTX) & 4095;
                const int pos = (wc & 1) ? (t & 63) : (t >> 6);
                const f32x4 cs = *(const f32x4*)(p.rope + pos * 16 + fq * 4), sn = *(const f32x4*)(p.rope + 1024 + pos * 16 + fq * 4);
                f32x4 y1 = x1 * cs - x2 * sn, y2 = x2 * cs + x1 * sn;
                x1 = y1; x2 = y2;
              } else if (is_ka || is_kc) {
                const int b = row >> 8, t = row & 255;
                float* o = is_ka ? p.out + O_KA + ((size_t)(b * 2 + l) * 256 + t) * 128 + wc * 32 + fq * 4
                                 : p.out + O_KC + ((size_t)(b * 2 + l) * 256 + t) * 512 + (oc - 2816) + wc * 32 + fq * 4;
                *(f32x4*)o = x1; *(f32x4*)(o + 16) = x2;
              }
              x1 = x1 * qs; x2 = x2 * qs;
              u16* po = p.P + (size_t)row * PP + pc + wc * 32 + fq * 4;
              *(uint2*)po = make_uint2(pack2(x1[0], x1[1]), pack2(x1[2], x1[3]));
              *(uint2*)(po + 16) = make_uint2(pack2(x2[0], x2[1]), pack2(x2[2], x2[3]));
            }
        } else {
          const int mode = (oc >= 4352) ? 2 : ((oc >= 1280 && oc < 1792) ? 0 : 1);
          if (mode == 2) {
            const int pj = u.pn - 17, seg = pj >> 2, pn4 = pj & 3;
            uint2* mg = p.MG + ((size_t)((u.pm * 4 + pn4) * 3 + seg) * 8 + (wr * 4 + wc)) * 2048 + lane;
#pragma unroll
            for (int ai = 0; ai < 2; ai++)
#pragma unroll
              for (int m = 0; m < 4; m++)
#pragma unroll
                for (int n = 0; n < 2; n++) {
                  f32x4 v = acc[ai][bj][m][n];
                  v[0] = sigmoidf_(v[0]); v[1] = sigmoidf_(v[1]); v[2] = sigmoidf_(v[2]); v[3] = sigmoidf_(v[3]);
                  mg[(((ai * 4 + m) * 2 + bj) * 2 + n) * 64] = make_uint2(pack2(v[0], v[1]), pack2(v[2], v[3]));
                }
          } else
#pragma unroll
          for (int ai = 0; ai < 2; ai++)
#pragma unroll
            for (int m = 0; m < 4; m++) {
              const int row = u.pm * 256 + ai * 128 + wr * 64 + m * 16 + fr;
              u16* po = p.P + (size_t)row * PP + pc + wc * 32 + fq * 4;
#pragma unroll
              for (int n = 0; n < 2; n++) {
                f32x4 v = acc[ai][bj][m][n];
                if (mode == 1) { v[0] = siluf_(v[0]); v[1] = siluf_(v[1]); v[2] = siluf_(v[2]); v[3] = siluf_(v[3]); }
                else if (mode == 2) { v[0] = sigmoidf_(v[0]); v[1] = sigmoidf_(v[1]); v[2] = sigmoidf_(v[2]); v[3] = sigmoidf_(v[3]); }
                *(uint2*)(po + n * 16) = make_uint2(pack2(v[0], v[1]), pack2(v[2], v[3]));
              }
            }
        }
      }
    }
    return true;
  }
};

struct EpiBranch {
  const Params* pp;
  __device__ __forceinline__ bool operator()(f32x4 (&acc)[2][2][4][2], const Unit& u, int wr, int wc, int fr, int fq) const {
    const Params& p = *pp;
    asm volatile("" : "+v"(fr), "+v"(fq));
    const int lane = fr + 16 * fq;
    const int seg = u.seg;
    const uint2* mg = p.MG + ((size_t)((u.pm * 4 + u.pn) * 3 + seg) * 8 + (wr * 4 + wc)) * 2048 + lane;
#pragma unroll
    for (int ai = 0; ai < 2; ai++)
#pragma unroll
      for (int m = 0; m < 4; m++) {
        const int row = u.pm * 256 + ai * 128 + wr * 64 + m * 16 + fr;
#pragma unroll
        for (int bj = 0; bj < 2; bj++)
#pragma unroll
          for (int n = 0; n < 2; n++) {
            const int idx = (((ai * 4 + m) * 2 + bj) * 2 + n) * 64;
            const uint2 a = mg[idx];
            f32x4 f = {lo_bf(a.x), hi_bf(a.x), lo_bf(a.y), hi_bf(a.y)};
            if (seg < 2) {
              const uint2 b = mg[idx + 8 * 2048];
              f[0] = __fdividef(f[0], fmaxf(lo_bf(b.x), 1e-20f)); f[1] = __fdividef(f[1], fmaxf(hi_bf(b.x), 1e-20f));
              f[2] = __fdividef(f[2], fmaxf(lo_bf(b.y), 1e-20f)); f[3] = __fdividef(f[3], fmaxf(hi_bf(b.y), 1e-20f));
              acc[ai][bj][m][n] = acc[ai][bj][m][n] * f;
            } else {
              const int col = u.pn * 256 + bj * 128 + wc * 32 + n * 16 + fq * 4;
              f32x4 v = acc[ai][bj][m][n] * f;
              *(uint2*)(p.Y + tm_off(row, col, 16)) = make_uint2(pack2(v[0], v[1]), pack2(v[2], v[3]));
            }
          }
      }
    return seg == 2;
  }
};

struct EpiOut {
  const Params* pp; int l;
  __device__ __forceinline__ bool operator()(f32x4 (&acc)[2][2][4][2], const Unit& u, int wr, int wc, int fr, int fq) const {
    const Params& p = *pp;
    asm volatile("" : "+v"(fr), "+v"(fq));
    const int lane = fr + 16 * fq; (void)lane;
    const int v = (u.pm < 16) ? 0 : 1 + (u.pm - 16) / 16;
    const float* gt = p.mod + (l * 3 + v) * 3072 + 2048;
#pragma unroll
    for (int ai = 0; ai < 2; ai++)
#pragma unroll
      for (int m = 0; m < 4; m++) {
        const int row = u.pm * 256 + ai * 128 + wr * 64 + m * 16 + fr;
        const float* xr;
        if (l == 0) xr = (row < NCTX) ? p.x_prompt + (size_t)row * 1024 : p.x_sample + (size_t)(row - NCTX) * 1024;
        else xr = p.out + O_X + (size_t)row * 1024;
        float* orow = p.out + O_X + (size_t)row * 1024;
#pragma unroll
        for (int bj = 0; bj < 2; bj++)
#pragma unroll
          for (int n = 0; n < 2; n++) {
            const int col = u.pn * 256 + bj * 128 + wc * 32 + n * 16 + fq * 4;
            const f32x4 xv = *(const f32x4*)(xr + col), gv = *(const f32x4*)(gt + col);
            *(f32x4*)(orow + col) = xv + gv * acc[ai][bj][m][n];
          }
      }
    return true;
  }
};

template <int DV, bool MASK>
__device__ __forceinline__ void flash_step(const u16* Ks, const u16* Vts, const bf16x8 (&qf)[4], float& m, float& l,
                                           f32x16 (&o)[DV / 32], int lane, int kpos0, int qpos, int T) {
  const int r = lane & 31, h = lane >> 5;
  f32x16 s[2];
  {
    bf16x8 kf[2][4];
#pragma unroll
    for (int sub = 0; sub < 2; sub++)
#pragma unroll
      for (int ks = 0; ks < 4; ks++) kf[sub][ks] = *(const bf16x8*)(Ks + (sub * 32 + r) * LROW + ks * 16 + h * 8);
    __builtin_amdgcn_sched_barrier(0);
#pragma unroll
    for (int sub = 0; sub < 2; sub++) {
#pragma unroll
      for (int e = 0; e < 16; e++) s[sub][e] = 0.f;
#pragma unroll
      for (int ks = 0; ks < 4; ks++) s[sub] = mfma32(kf[sub][ks], qf[ks], s[sub]);
    }
  }
  if (MASK) {
#pragma unroll
    for (int sub = 0; sub < 2; sub++)
#pragma unroll
      for (int e = 0; e < 16; e++) {
        int kp = kpos0 + sub * 32 + (e & 3) + 8 * (e >> 2) + 4 * h;
        int dlt = kp - qpos;
        bool ok = (kp >= 0) && (kp < T) && (dlt <= 128) && (dlt >= -128);
        if (!ok) s[sub][e] = -INFINITY;
      }
  }
  float mx = s[0][0];
#pragma unroll
  for (int sub = 0; sub < 2; sub++)
#pragma unroll
    for (int e = 0; e < 16; e++) mx = fmaxf(mx, s[sub][e]);
  mx = fmaxf(mx, shflx(mx, 32, lane));
  const bool grow = mx > m;
  const float mn = grow ? mx : m;
  float sum = 0.f;
#pragma unroll
  for (int sub = 0; sub < 2; sub++)
#pragma unroll
    for (int e = 0; e < 16; e++) { float pv = __builtin_amdgcn_exp2f(s[sub][e] - mn); s[sub][e] = pv; sum += pv; }
  sum += shflx(sum, 32, lane);
  if (__builtin_amdgcn_ballot_w64(grow) != 0ull) {
    const float alpha = __builtin_amdgcn_exp2f(m - mn);
    l *= alpha;
#pragma unroll
    for (int ds = 0; ds < DV / 32; ds++)
#pragma unroll
      for (int e = 0; e < 16; e++) o[ds][e] *= alpha;
  }
  l += sum; m = mn;
  typedef __attribute__((ext_vector_type(4))) unsigned u32x4;
  bf16x8 pf[2][2];
#pragma unroll
  for (int sub = 0; sub < 2; sub++)
#pragma unroll
    for (int st = 0; st < 2; st++) {
      u32x4 pw;
#pragma unroll
      for (int j = 0; j < 4; j++) pw[j] = pack2(s[sub][8 * st + 2 * j], s[sub][8 * st + 2 * j + 1]);
      pf[sub][st] = __builtin_bit_cast(bf16x8, pw);
    }
#pragma unroll
  for (int sub = 0; sub < 2; sub++) {
    bf16x8 vf[2][DV / 32];
#pragma unroll
    for (int st = 0; st < 2; st++)
#pragma unroll
      for (int ds = 0; ds < DV / 32; ds++) {
        const u16* vp = Vts + (ds * 32 + r) * VROW + sub * 32 + 16 * st + 4 * h;
        bf16x4 lo = *(const bf16x4*)vp, hi = *(const bf16x4*)(vp + 8);
        vf[st][ds] = __builtin_shufflevector(lo, hi, 0, 1, 2, 3, 4, 5, 6, 7);
      }
    __builtin_amdgcn_sched_barrier(0);
#pragma unroll
    for (int st = 0; st < 2; st++)
#pragma unroll
      for (int ds = 0; ds < DV / 32; ds++) o[ds] = mfma32(vf[st][ds], pf[sub][st], o[ds]);
    __builtin_amdgcn_sched_barrier(0);
  }
}

__device__ __forceinline__ uint4 ld_k(const u16* __restrict__ src, size_t pitch, int r0, int nrows, int c) {
  int row = c >> 3, kc = c & 7; int rr = r0 + row;
  uint4 v = make_uint4(0, 0, 0, 0);
  if (rr >= 0 && rr < nrows) v = *(const uint4*)(src + (size_t)rr * pitch + kc * 8);
  return v;
}
__device__ __forceinline__ void st_k(u16* dst, int c, uint4 v) { *(uint4*)(dst + (c >> 3) * LROW + (c & 7) * 8) = v; }
__device__ __forceinline__ uint4 ld_vt(const u16* __restrict__ src, int T, int k0, int c) {
  int d = c >> 3, kc = c & 7; int k = k0 + kc * 8;
  uint4 v = make_uint4(0, 0, 0, 0);
  if (k >= 0 && k < T) v = *(const uint4*)(src + (size_t)d * T + k);
  return v;
}
__device__ __forceinline__ void st_vt(u16* dst, int c, uint4 v) {
  uint2* q = (uint2*)(dst + (c >> 3) * VROW + (c & 7) * 8);
  q[0] = make_uint2(v.x, v.y); q[1] = make_uint2(v.z, v.w);
}

constexpr int A_BUF = 64 * LROW + 64 * VROW;
__device__ __forceinline__ void attnA_item(const Params& p, int l, int it, u16* sm, bool dry = false) {
  const int tid = TIDX, lane = tid & 63, wid = tid >> 6;
  const int r = lane & 31, h = lane >> 5;
  const bool isctx = it < 128;
  int b, kvh, qb, T, rowbase; const u16* VtBase;
  if (isctx) { b = it >> 3; kvh = (it >> 2) & 1; qb = it & 3; T = 256; rowbase = b * 256;
    VtBase = p.VtA_ctx + ((size_t)(b * 2 + kvh) * 64) * 256; }
  else { int j = it - 128; b = j >> 7; kvh = (j >> 6) & 1; qb = j & 63; T = 4096; rowbase = NCTX + b * 4096;
    VtBase = p.VtA_lat + ((size_t)(b * 2 + kvh) * 64) * 4096; }
  const int qblk = qb * 64;
  const int q0 = qblk + (wid >> 2) * 32;
  const int head = kvh * 4 + (wid & 3);
  const size_t prow = (size_t)(rowbase + q0 + r) * PP;
  bf16x8 qf[4];
#pragma unroll
  for (int ks = 0; ks < 4; ks++) qf[ks] = *(const bf16x8*)(p.P + prow + C_QA + head * 64 + ks * 16 + h * 8);
  float m = p.sink_a[l * 8 + head] * 1.4426950408889634f, ls = 1.f;
  f32x16 o[2];
#pragma unroll
  for (int ds = 0; ds < 2; ds++)
#pragma unroll
    for (int e = 0; e < 16; e++) o[ds][e] = 0.f;
  const u16* Kbase = p.P + (size_t)rowbase * PP + C_KA + kvh * 64;
  const u16* cK = p.cKa + ((size_t)(b * 2 + l) * 512) * 128 + kvh * 64;
  const u16* cVt = p.cVtA + ((size_t)((b * 2 + l) * 2 + kvh) * 64) * 512;
  const int qpos = q0 + r;
  int i_lo = 0, nW, ntile;
  if (isctx) { nW = 4; ntile = 4; }
  else {
    i_lo = (qblk < 128) ? (128 - qblk) / 64 : 0;
    int i_hi = (T - qblk + 128) / 64; if (i_hi > 5) i_hi = 5;
    nW = i_hi - i_lo; ntile = nW + 8;
  }
  uint4 rk, rv;
  auto tile_load = [&](int t) {
    if (t < nW) {
      int k0 = isctx ? t * 64 : qblk - 128 + 64 * (i_lo + t);
      rk = ld_k(Kbase, PP, k0, T, tid); rv = ld_vt(VtBase, T, k0, tid);
    } else {
      int kt = t - nW;
      rk = ld_k(cK, 128, kt * 64, 512, tid); rv = ld_vt(cVt, 512, kt * 64, tid);
    }
  };
  __syncthreads();
  tile_load(0);
  st_k(sm, tid, rk); st_vt(sm + 64 * LROW, tid, rv);
  __syncthreads();
  for (int t = 0; t < ntile; t++) {
    const bool more = t + 1 < ntile;
    if (more) tile_load(t + 1);
    const u16* Ks = sm + (t & 1) * A_BUF; const u16* Vts = Ks + 64 * LROW;
    if (!isctx && t < nW) flash_step<64, true>(Ks, Vts, qf, m, ls, o, lane, qblk - 128 + 64 * (i_lo + t), qpos, T);
    else flash_step<64, false>(Ks, Vts, qf, m, ls, o, lane, 0, 0, T);
    if (more) { u16* d = sm + ((t + 1) & 1) * A_BUF; st_k(d, tid, rk); st_vt(d + 64 * LROW, tid, rv); }
    __syncthreads();
  }
  const float inv = 1.f / ls;
#pragma unroll
  for (int ds = 0; ds < 2; ds++)
#pragma unroll
    for (int g = 0; g < 4; g++) {
      int d = ds * 32 + 8 * g + 4 * h;
      uint2 gv = *(const uint2*)(p.P + prow + C_GA + head * 64 + d);
      uint2 ov;
      ov.x = pack2(o[ds][4 * g] * inv * lo_bf(gv.x), o[ds][4 * g + 1] * inv * hi_bf(gv.x));
      ov.y = pack2(o[ds][4 * g + 2] * inv * lo_bf(gv.y), o[ds][4 * g + 3] * inv * hi_bf(gv.y));
      *(uint2*)(p.GB + tm_off(rowbase + q0 + r, head * 64 + d, 8)) = ov;
    }
}

constexpr int C_BUF = 128 * LROW + 128 * VROW;
__device__ __forceinline__ void attnC_item(const Params& p, int l, int it, u16* sm, float lam, float lam_init, bool dry = false) {
  const int tid = TIDX, lane = tid & 63, wid = tid >> 6;
  const int r = lane & 31, h = lane >> 5;
  const bool isctx = it < 128;
  int b, hd, qb, T, rowbase; const u16* VtBase;
  if (isctx) { b = it >> 3; hd = (it >> 1) & 3; qb = it & 1; T = 256; rowbase = b * 256;
    VtBase = p.VtC_ctx + ((size_t)(b * 4 + hd) * 128) * 256; }
  else { int j = it - 128; b = j >> 7; hd = (j >> 5) & 3; qb = j & 31; T = 4096; rowbase = NCTX + b * 4096;
    VtBase = p.VtC_lat + ((size_t)(b * 4 + hd) * 128) * 4096; }
  const int qg = wid & 3, map = wid >> 2;
  const int q0 = qb * 128 + qg * 32;
  const size_t prow = (size_t)(rowbase + q0 + r) * PP;
  bf16x8 qf[4];
#pragma unroll
  for (int ks = 0; ks < 4; ks++) qf[ks] = *(const bf16x8*)(p.P + prow + C_QC + hd * 128 + map * 64 + ks * 16 + h * 8);
  float m = -1e30f, ls = 0.f;
  f32x16 o[4];
#pragma unroll
  for (int ds = 0; ds < 4; ds++)
#pragma unroll
    for (int e = 0; e < 16; e++) o[ds][e] = 0.f;
  const u16* Kbase = p.P + (size_t)rowbase * PP + C_KC + hd * 128;
  const u16* cK = p.cKc + ((size_t)(b * 2 + l) * 512) * 512 + hd * 128;
  const u16* cVt = p.cVtC + ((size_t)((b * 2 + l) * 4 + hd) * 128) * 512;
  const int nW = T / 64, ntile = isctx ? nW : nW + 8;
  uint4 rk0, rk1, rv0, rv1;
  auto tile_load = [&](int t) {
    if (t < nW) {
      rk0 = ld_k(Kbase, PP, t * 64, T, tid); rk1 = ld_k(Kbase + 64, PP, t * 64, T, tid);
      rv0 = ld_vt(VtBase, T, t * 64, tid); rv1 = ld_vt(VtBase, T, t * 64, tid + NT);
    } else {
      int kt = t - nW;
      rk0 = ld_k(cK, 512, kt * 64, 512, tid); rk1 = ld_k(cK + 64, 512, kt * 64, 512, tid);
      rv0 = ld_vt(cVt, 512, kt * 64, tid); rv1 = ld_vt(cVt, 512, kt * 64, tid + NT);
    }
  };
  auto tile_store = [&](u16* d) {
    st_k(d, tid, rk0); st_k(d + 64 * LROW, tid, rk1);
    st_vt(d + 128 * LROW, tid, rv0); st_vt(d + 128 * LROW, tid + NT, rv1);
  };
  __syncthreads();
  tile_load(0);
  tile_store(sm);
  __syncthreads();
  for (int t = 0; t < ntile; t++) {
    const bool more = t + 1 < ntile;
    if (more) tile_load(t + 1);
    const u16* base = sm + (t & 1) * C_BUF;
    flash_step<128, false>(base + map * 64 * LROW, base + 128 * LROW, qf, m, ls, o, lane, 0, 0, T);
    if (more) tile_store(sm + ((t + 1) & 1) * C_BUF);
    __syncthreads();
  }
  float* xch = (float*)sm;
  if (map == 1) {
    const float inv = lam / ls;
#pragma unroll
    for (int ds = 0; ds < 4; ds++)
#pragma unroll
      for (int e = 0; e < 16; e++) xch[((qg * 64) + ds * 16 + e) * 64 + lane] = o[ds][e] * inv;
  }
  __syncthreads();
  if (map == 0) {
    const float i0 = 1.f / ls;
    float ss = 0.f;
#pragma unroll
    for (int ds = 0; ds < 4; ds++)
#pragma unroll
      for (int e = 0; e < 16; e++) {
        float v = o[ds][e] * i0 - xch[((qg * 64) + ds * 16 + e) * 64 + lane];
        o[ds][e] = v; ss += v * v;
      }
    ss += shflx(ss, 32, lane);
    const float rinv = rsqrtf(ss * (1.f / 128.f) + EPS) * (1.f - lam_init);
    const float* sg = p.subln_c + l * 128;
#pragma unroll
    for (int ds = 0; ds < 4; ds++)
#pragma unroll
      for (int g = 0; g < 4; g++) {
        int d = ds * 32 + 8 * g + 4 * h;
        uint2 gv = *(const uint2*)(p.P + prow + C_GC + hd * 128 + d);
        float4 sl = *(const float4*)(sg + d);
        uint2 ov;
        ov.x = pack2(o[ds][4 * g] * rinv * sl.x * lo_bf(gv.x), o[ds][4 * g + 1] * rinv * sl.y * hi_bf(gv.x));
        ov.y = pack2(o[ds][4 * g + 2] * rinv * sl.z * lo_bf(gv.y), o[ds][4 * g + 3] * rinv * sl.w * hi_bf(gv.y));
        *(uint2*)(p.GB + (size_t)2 * NTOK * 512 + tm_off(rowbase + q0 + r, hd * 128 + d, 8)) = ov;
      }
  }
}

__device__ __forceinline__ void lru_run(const Params& p, int l, bool pass2, int start, int G, float* sm, bool dry = false) {
  const int tid = TIDX;
  const int lane = tid & 63, wid = tid >> 6, r = lane & 31, h = lane >> 5;
  const int n = start & 7;
  float* xin = sm;
  float* xb = sm + 67 * 64;
  float* comb = xb + 64 * 64;
  float* carry = comb + 2048;
  float* parts = carry + 128;
  float* ab = parts + 1024;
  u16* xbh = (u16*)(ab + 4 * 4096);
  const int gd = wid >> 2, gth = (wid >> 1) & 1, gdh = wid & 1;
  bf16x8 wfa[4], wfx[4];
  {
    const u16* wbase = p.Wt_lru + ((size_t)(((l * 2 + gd) * 8 + n) * 2) * 64 + gdh * 32 + r) * 64 + h * 8;
#pragma unroll
    for (int ks = 0; ks < 4; ks++) { wfa[ks] = *(const bf16x8*)(wbase + ks * 16); wfx[ks] = *(const bf16x8*)(wbase + 4096 + ks * 16); }
  }
  const int gch = n * 64 + gdh * 32 + r;
  const float g_ba = p.lru_ba[(l * 2 + gd) * 512 + gch], g_bx = p.lru_bx[(l * 2 + gd) * 512 + gch];
  const float g_sp = log1pf(__expf(-p.lru_lam[(l * 2 + gd) * 512 + gch]));
  const int cc = tid & 63;
  float cw[4]; float cbv;
  {
    const float* cwp = p.conv_w + l * 4 * 512 + n * 64 + cc;
    cw[0] = cwp[0]; cw[1] = cwp[512]; cw[2] = cwp[1024]; cw[3] = cwp[1536];
    cbv = p.conv_b[l * 512 + n * 64 + cc];
  }
  const int dout = tid & 63, tg = tid >> 6;
  const int ch = n * 64 + dout;

  u16 xr[9];
  auto xin_load = [&](int it_) {
    const int row0_ = (it_ >> 3) * 64;
    int T_, seq0_;
    if (row0_ < NCTX) { T_ = 256; seq0_ = (row0_ >> 8) * 256; } else { T_ = 4096; seq0_ = NCTX + ((row0_ - NCTX) >> 12) * 4096; }
    const int t0_ = row0_ - seq0_;
#pragma unroll
    for (int k = 0; k < 9; k++) {
      const int rr = (tid >> 6) + 8 * k; const int t = t0_ - 2 + rr;
      u16 v = 0;
      if (rr < 67 && t >= 0 && t < T_) v = p.P[(size_t)(seq0_ + t) * PP + C_XB + n * 64 + cc];
      xr[k] = v;
    }
  };
  if (start < 1536) xin_load(start);
  for (int it = start; it < 1536; it += G) {
    const int ci = it >> 3;
    const int row0 = ci * 64;
    const bool isctx = row0 < NCTX;
    int T, seq0, bidx;
    if (isctx) { T = 256; bidx = row0 >> 8; seq0 = bidx * 256; }
    else { T = 4096; bidx = (row0 - NCTX) >> 12; seq0 = NCTX + bidx * 4096; }
    const int t0 = row0 - seq0;
    __syncthreads();
#pragma unroll
    for (int k = 0; k < 9; k++) { const int rr = (tid >> 6) + 8 * k; if (rr < 67) xin[rr * 64 + cc] = bf2f(xr[k]); }
    if (it + G < 1536) xin_load(it + G);
    u16 sgr[8];
    if (pass2) {
#pragma unroll
      for (int tt = 0; tt < 8; tt++) sgr[tt] = p.P[(size_t)(row0 + tg * 8 + tt) * PP + C_GB + ch];
    }
    if (pass2) {
      const int d = (tid >> 6) & 1, part = tid >> 7;
      const int cfirst = seq0 >> 6, clast = (seq0 + T - 64) >> 6;
      const int K = d ? (clast - ci) : (ci - cfirst);
      float2 q[16];
#pragma unroll
      for (int k = 0; k < 16; k++) {
        const int kk = part * 16 + k;
        const int cj = d ? (clast - kk) : (cfirst + kk);
        q[k] = make_float2(1.f, 0.f);
        if (kk < K) q[k] = *(const float2*)(p.lruTot + ((size_t)(cj * 2 + d) * 512 + n * 64 + cc) * 2);
      }
      float At = 1.f, Bt = 0.f;
#pragma unroll
      for (int k = 0; k < 16; k++) { Bt = q[k].x * Bt + q[k].y; At *= q[k].x; }
      parts[((part * 2 + d) * 64 + cc) * 2] = At; parts[((part * 2 + d) * 64 + cc) * 2 + 1] = Bt;
    }
    __syncthreads();
    for (int e = tid; e < 64 * 64; e += NT) {
      int t = e >> 6;
      float v = cbv;
#pragma unroll
      for (int j = 0; j < 4; j++) v += xin[(t + j) * 64 + cc] * cw[j];
      xb[e] = v;
      xbh[t * LROW + cc] = f2bf(v);
    }
    if (pass2 && tid < 128) {
      const int d = tid >> 6;
      float hcar = isctx ? 0.f : p.state_lru[((size_t)(bidx * 2 + l) * 2 + d) * 512 + n * 64 + cc];
#pragma unroll
      for (int part = 0; part < 4; part++) hcar = parts[((part * 2 + d) * 64 + cc) * 2] * hcar + parts[((part * 2 + d) * 64 + cc) * 2 + 1];
      carry[d * 64 + cc] = hcar;
    }
    __syncthreads();
    {
      bf16x8 af[4];
#pragma unroll
      for (int ks = 0; ks < 4; ks++) af[ks] = *(const bf16x8*)(xbh + (gth * 32 + r) * LROW + ks * 16 + h * 8);
      f32x16 ga, gi;
#pragma unroll
      for (int e = 0; e < 16; e++) { ga[e] = 0.f; gi[e] = 0.f; }
#pragma unroll
      for (int ks = 0; ks < 4; ks++) { ga = mfma32(af[ks], wfa[ks], ga); gi = mfma32(af[ks], wfx[ks], gi); }
      const int dch = gdh * 32 + r;
#pragma unroll
      for (int e = 0; e < 16; e++) {
        const int tok = gth * 32 + (e & 3) + 8 * (e >> 2) + 4 * h;
        float rg = sigmoidf_(ga[e] + g_ba), ig = sigmoidf_(gi[e] + g_bx);
        float log_a = -8.f * rg * g_sp;
        float a = __expf(log_a);
        float bb = sqrtf(-expm1f(2.f * log_a)) * ig * xb[tok * 64 + dch];
        ab[((gd * 2 + 0) * 64 + tok) * 64 + dch] = a;
        ab[((gd * 2 + 1) * 64 + tok) * 64 + dch] = bb;
      }
    }
    __syncthreads();
    float av[2][8], bv[2][8];
#pragma unroll
    for (int d = 0; d < 2; d++)
#pragma unroll
      for (int tt = 0; tt < 8; tt++) {
        av[d][tt] = ab[((d * 2 + 0) * 64 + tg * 8 + tt) * 64 + dout];
        bv[d][tt] = ab[((d * 2 + 1) * 64 + tg * 8 + tt) * 64 + dout];
      }
    float sA0 = 1.f, sB0 = 0.f, sA1 = 1.f, sB1 = 0.f;
#pragma unroll
    for (int tt = 0; tt < 8; tt++) { sB0 = av[0][tt] * sB0 + bv[0][tt]; sA0 *= av[0][tt]; }
#pragma unroll
    for (int tt = 7; tt >= 0; tt--) { sB1 = av[1][tt] * sB1 + bv[1][tt]; sA1 *= av[1][tt]; }
    comb[((tg * 2 + 0) * 64 + dout) * 2 + 0] = sA0; comb[((tg * 2 + 0) * 64 + dout) * 2 + 1] = sB0;
    comb[((tg * 2 + 1) * 64 + dout) * 2 + 0] = sA1; comb[((tg * 2 + 1) * 64 + dout) * 2 + 1] = sB1;
    __syncthreads();
    if (!pass2) {
      if (tid < 128) {
        int d = tid >> 6, c = tid & 63;
        float At = 1.f, Bt = 0.f;
#pragma unroll
        for (int s = 0; s < 8; s++) {
          int g = (d == 0) ? s : 7 - s;
          float a = comb[((g * 2 + d) * 64 + c) * 2], bq = comb[((g * 2 + d) * 64 + c) * 2 + 1];
          Bt = a * Bt + bq; At *= a;
        }
        float* o = p.lruTot + ((size_t)(ci * 2 + d) * 512 + n * 64 + c) * 2;
        o[0] = At; o[1] = Bt;
      }
      continue;
    }
    float h0 = carry[dout], h1 = carry[64 + dout];
    for (int g = 0; g < tg; g++) { h0 = comb[((g * 2 + 0) * 64 + dout) * 2] * h0 + comb[((g * 2 + 0) * 64 + dout) * 2 + 1]; }
    for (int g = 7; g > tg; g--) { h1 = comb[((g * 2 + 1) * 64 + dout) * 2] * h1 + comb[((g * 2 + 1) * 64 + dout) * 2 + 1]; }
    float y[8];
#pragma unroll
    for (int tt = 0; tt < 8; tt++) { h0 = av[0][tt] * h0 + bv[0][tt]; y[tt] = h0; }
    const float hf_last = h0;
#pragma unroll
    for (int tt = 7; tt >= 0; tt--) { h1 = av[1][tt] * h1 + bv[1][tt]; y[tt] += h1; }
    const float hb_first = h1;
    if (isctx) {
      if (t0 + 64 == T && tg == 7) p.out[O_ST + ((size_t)(bidx * 2 + l) * 2 + 0) * 512 + ch] = hf_last;
      if (t0 == 0 && tg == 0) p.out[O_ST + ((size_t)(bidx * 2 + l) * 2 + 1) * 512 + ch] = hb_first;
    }
#pragma unroll
    for (int tt = 0; tt < 8; tt++) {
      const int rw = row0 + tg * 8 + tt;
      p.GB[(size_t)NTOK * 512 + tm_off(rw, ch, 8)] = f2bf(y[tt] * bf2f(sgr[tt]));
    }
  }
}

__device__ __forceinline__ float compute_lam(const Params& p, int l, float lam_init) {
  float s1 = 0.f, s2 = 0.f;
  for (int i = 0; i < 64; i++) {
    s1 += p.lam_q1[l * 64 + i] * p.lam_k1[l * 64 + i];
    s2 += p.lam_q2[l * 64 + i] * p.lam_k2[l * 64 + i];
  }
  return expf(s1) - expf(s2) + lam_init;
}

__device__ __forceinline__ void mix_phase(const Params& p, int l, u16* smem) {
  const float lam_init = (l == 0) ? 0.2f : (0.8f - 0.6f * 0.74081822068f);
  const float lam = compute_lam(p, l, lam_init);
  constexpr int N_CL = 256, N_A = 384, N_CC = 128, N_L = 1536;
  const int G = gridDim.x;
  int start = blockIdx.x;
  for (int it = start; it < N_CL; it += G) attnC_item(p, l, 128 + it, smem, lam, lam_init);
  start = (int)((blockIdx.x + G - (N_CL % G)) % G);
  for (int it = start; it < N_A; it += G) attnA_item(p, l, it, smem);
  start = (int)((blockIdx.x + G - ((N_CL + N_A) % G)) % G);
  for (int it = start; it < N_CC; it += G) attnC_item(p, l, it, smem, lam, lam_init);
  start = (int)((blockIdx.x + G - ((N_CL + N_A + N_CC) % G)) % G);
  if (PROBE == 6) lru_run(p, l, false, start, G, (float*)smem);
  lru_run(p, l, false, start, G, (float*)smem);
}

__device__ __forceinline__ void lru2_phase(const Params& p, int l, u16* smem) {
  lru_run(p, l, true, blockIdx.x, gridDim.x, (float*)smem);
}

#define XB_TMO      128
#define XB_XCNT(j)  (256  + 64 * (j))
#define XB_XSUB(j)  (1280 + 64 * (j))
#define XB_XGEN(j)  (2304 + 64 * (j))
#define XB_TOP      3328
#define XB_TOPGEN   3392
#define XCD_BAR_WORDS 3456
#define XB_SPIN_CAP (1u << 18)
__device__ __forceinline__ unsigned xb_ld(unsigned* p)              { return __hip_atomic_load(p, __ATOMIC_RELAXED, __HIP_MEMORY_SCOPE_AGENT); }
__device__ __forceinline__ unsigned xb_add(unsigned* p, unsigned v) { return __hip_atomic_fetch_add(p, v, __ATOMIC_RELAXED, __HIP_MEMORY_SCOPE_AGENT); }
__device__ __forceinline__ unsigned xb_xcc_id() { return (unsigned)__builtin_amdgcn_s_getreg((3 << 11) | 20) & 0xFu; }
#define XB_SPIN(cond, bar) do { unsigned _sp = 0; while (cond) { __builtin_amdgcn_s_sleep(1); \
    if ((++_sp & 255u) == 0u) { if (xb_ld(&(bar)[XB_TMO])) break; if (_sp > XB_SPIN_CAP) { atomicAdd(&(bar)[XB_TMO], 1u); break; } } } } while (0)
struct XcdBarrier { unsigned* bar; unsigned x; volatile LAS unsigned* st; };
__device__ __forceinline__ XcdBarrier xcd_barrier_post(unsigned* bar, volatile LAS unsigned* st) {
  XcdBarrier b; b.bar = bar; b.x = xb_xcc_id(); b.st = st;
  if (threadIdx.x == 0) (void)xb_add(&bar[XB_XCNT(b.x)], 1u);
  return b;
}
__device__ __forceinline__ void xcd_barrier_complete(unsigned* bar, unsigned x, unsigned& nloc, unsigned& nx) {
  const unsigned G = gridDim.x * gridDim.y * gridDim.z;
  unsigned sum, cnt, mine, sp = 0u;
  for (;;) {
    sum = 0u; cnt = 0u; mine = 0u;
#pragma unroll
    for (unsigned j = 0; j < 16; ++j) { const unsigned c = xb_ld(&bar[XB_XCNT(j)]); sum += c; cnt += (c > 0u) ? 1u : 0u; mine = (j == x) ? c : mine; }
    if (sum == G) break;
    __builtin_amdgcn_s_sleep(1);
    if ((++sp & 255u) == 0u) { if (xb_ld(&bar[XB_TMO])) break; if (sp > XB_SPIN_CAP) { atomicAdd(&bar[XB_TMO], 1u); break; } }
  }
  nloc = mine > 0u ? mine : 1u; nx = cnt > 0u ? cnt : 1u;
}
__device__ __forceinline__ void xcd_barrier(const XcdBarrier& b) {
  asm volatile("s_waitcnt vmcnt(0)" ::: "memory");
  __syncthreads();
  if (threadIdx.x == 0) {
    unsigned* bar = b.bar;
    __builtin_amdgcn_s_waitcnt(0);
    unsigned nloc = b.st[0], nx = b.st[1];
    if (nloc == 0u) { xcd_barrier_complete(bar, b.x, nloc, nx); b.st[0] = nloc; b.st[1] = nx; }
    const unsigned old = xb_add(&bar[XB_XSUB(b.x)], 1u);
    const unsigned gen = old / nloc;
    if (old + 1u == (gen + 1u) * nloc) {
      __builtin_amdgcn_fence(__ATOMIC_RELEASE, "agent");
      asm volatile("s_waitcnt vmcnt(0)" ::: "memory");
      const unsigned og = xb_add(&bar[XB_TOP], 1u);
      const unsigned tg = og / nx;
      if (og + 1u == (tg + 1u) * nx) xb_add(&bar[XB_TOPGEN], 1u);
      else XB_SPIN(xb_ld(&bar[XB_TOPGEN]) == tg, bar);
      __builtin_amdgcn_fence(__ATOMIC_ACQUIRE, "agent");
      xb_add(&bar[XB_XGEN(b.x)], 1u);
      asm volatile("s_waitcnt vmcnt(0)" ::: "memory");
    } else {
      XB_SPIN(xb_ld(&bar[XB_XGEN(b.x)]) == gen, bar);
      __builtin_amdgcn_fence(__ATOMIC_ACQUIRE, "agent");
      asm volatile("s_waitcnt vmcnt(0)" ::: "memory");
    }
  }
  __syncthreads();
}

typedef __attribute__((address_space(4))) const Params CParams;
__device__ __forceinline__ const Params& get_params() {
  CParams* kp = (CParams*)__builtin_amdgcn_kernarg_segment_ptr();
  asm volatile("" : "+s"(kp));
  return *(const Params*)kp;
}
__global__ void __launch_bounds__(NT, 2) fwd_kernel(Params p_unused) {
  extern __shared__ __attribute__((aligned(16))) unsigned char lds_raw[];
  u16* smem = (u16*)lds_raw;
  LAS unsigned char* lds = (LAS unsigned char*)lds_raw;
  cg::grid_group grid = cg::this_grid();
  volatile LAS unsigned* xst = (volatile LAS unsigned*)(lds + STAGE_BYTES + SPARE_BYTES);
  if (threadIdx.x == 0) { xst[0] = 0u; xst[1] = 0u; }
  __syncthreads();
  XcdBarrier xb = xcd_barrier_post(get_params().bar, xst);
  prologue_phase(get_params(), (float*)smem);
  grid.sync();
  if (PROBE == 9) { for (int i = 0; i < 10; i++) xcd_barrier(xb); }
#pragma unroll 1
  for (int l = 0; l < 2; l++) {
    norm_phase(get_params(), l);
    if (PROBE == 3) { norm_phase(get_params(), l); if (l == 0) { xcd_barrier(xb); prologue_phase(get_params(), (float*)smem); } }
    xcd_barrier(xb);
    {
      const Params& p = get_params();
      SchedStd S; S.nM = NTOK / 256; S.nN = INC / 256; S.nwg = S.nM * S.nN; S.G = gridDim.x; S.c = blockIdx.x;
      S.A = (const char*)p.H; S.B = (const char*)(p.Wt_in + (size_t)l * INC * 1024); S.tA = (size_t)256 * 1024 * 2; S.tB = (size_t)256 * 1024 * 2;
      EpiInproj E; E.pp = &p; E.l = l; E.part = (LAS float*)(lds + STAGE_BYTES);
      gemm_phase(lds, 1024, S, E);
      if (PROBE == 1) { __syncthreads(); gemm_phase(lds, 1024, S, E); }
    }
    xcd_barrier(xb);
    mix_phase(get_params(), l, smem);
    xcd_barrier(xb);
    lru2_phase(get_params(), l, smem);
    xcd_barrier(xb);
    {
      const Params& p = get_params();
      SchedBranch S; S.G = gridDim.x; S.c = blockIdx.x; S.P_ = (const char*)p.GB; S.W_ = (const char*)(p.Wt_br + (size_t)l * 3 * 1024 * 512);
      EpiBranch E; E.pp = &p;
      gemm_phase(lds, 512, S, E);
      if (PROBE == 2) { __syncthreads(); gemm_phase(lds, 512, S, E); }
    }
    xcd_barrier(xb);
    {
      const Params& p = get_params();
      SchedStd S; S.nM = NTOK / 256; S.nN = 4; S.nwg = S.nM * S.nN; S.G = gridDim.x; S.c = blockIdx.x;
      S.A = (const char*)p.Y; S.B = (const char*)(p.Wt_out + (size_t)l * 1024 * 1024); S.tA = (size_t)256 * 1024 * 2; S.tB = (size_t)256 * 1024 * 2;
      EpiOut E; E.pp = &p; E.l = l;
      gemm_phase(lds, 1024, S, E);
      if (PROBE == 8 && l == 0) { __syncthreads(); gemm_phase(lds, 1024, S, E); }
    }
    if (l == 0) xcd_barrier(xb);
  }
}

extern "C" void kernel_launch(void* const* d_in, const int* in_sizes, int n_in, void* d_out, int out_size, void* d_ws,
                              size_t ws_size, hipStream_t stream) {
  Params p{};
  const float** ip = (const float**)&p;
  for (int i = 0; i < 34; i++) ip[i] = (const float*)d_in[i];
  p.out = (float*)d_out;
  char* w = (char*)d_ws; size_t off = 0;
  auto take = [&](size_t bytes) { char* q = w + off; off += (bytes + 255) & ~(size_t)255; return q; };
  p.Wt_in = (u16*)take((size_t)2 * INC * 1024 * 2);
  p.Wt_br = (u16*)take((size_t)6 * 1024 * 512 * 2);
  p.Wt_out = (u16*)take((size_t)2 * 1024 * 1024 * 2);
  p.Y = (u16*)take((size_t)NTOK * 1024 * 2);
  p.P = (u16*)take((size_t)NTOK * PP * 2);
  p.VtA_ctx = p.Y;
  p.VtA_lat = p.VtA_ctx + (size_t)16 * 2 * 64 * 256;
  p.VtC_ctx = p.VtA_lat + (size_t)2 * 2 * 64 * 4096;
  p.VtC_lat = p.VtC_ctx + (size_t)16 * 4 * 128 * 256;
  p.cKa = (u16*)take((size_t)2 * 2 * 512 * 128 * 2);
  p.cVtA = (u16*)take((size_t)2 * 2 * 512 * 128 * 2);
  p.cKc = (u16*)take((size_t)2 * 2 * 512 * 512 * 2);
  p.cVtC = (u16*)take((size_t)2 * 2 * 512 * 512 * 2);
  p.mod = (float*)take((size_t)2 * 3 * 3072 * 4);
  p.rope = (float*)take((size_t)2048 * 4);
  p.lruTot = (float*)take((size_t)192 * 2 * 512 * 2 * 4);
  p.Wt_lru = (u16*)take((size_t)2 * 2 * 8 * 2 * 64 * 64 * 2);
  p.bar = (unsigned*)take((size_t)XCD_BAR_WORDS * 4);
  p.GB = (u16*)take((size_t)3 * NTOK * 512 * 2);
  p.H = p.GB;
  p.MG = (uint2*)take((size_t)48 * 4 * 3 * 16384 * 8);
  static int grid_blocks = 0;
  if (!grid_blocks) {
    int dev = 0, cus = 0;
    hipGetDevice(&dev);
    hipDeviceGetAttribute(&cus, hipDeviceAttributeMultiprocessorCount, dev);
    hipFuncSetAttribute((const void*)fwd_kernel, hipFuncAttributeMaxDynamicSharedMemorySize, LDS_BYTES);
    int per_cu = 0;
    hipOccupancyMaxActiveBlocksPerMultiprocessor(&per_cu, (const void*)fwd_kernel, NT, LDS_BYTES);
    (void)hipGetLastError();
    grid_blocks = cus;
  }
  hipMemsetAsync(p.bar, 0, (size_t)XCD_BAR_WORDS * 4, stream);
  void* args[] = {&p};
  hipLaunchCooperativeKernel((void*)fwd_kernel, dim3(grid_blocks), dim3(NT), args, LDS_BYTES, stream);
}
```

```cpp
#include <hip/hip_runtime.h>
#include <hip/hip_cooperative_groups.h>
#include <stdint.h>
#include <math.h>
namespace cg = cooperative_groups;

typedef unsigned short u16;
typedef __attribute__((ext_vector_type(8))) short bf16x8;
typedef __attribute__((ext_vector_type(4))) short bf16x4;
typedef __attribute__((ext_vector_type(16))) float f32x16;
typedef __attribute__((ext_vector_type(4))) float f32x4;
#define LAS __attribute__((address_space(3)))

#ifndef PROBE
#define PROBE 0
#endif
#define NT 512
constexpr int NTOK = 12288, NCTX = 4096;
constexpr int INC = 7424;
constexpr int PP = 3712;
constexpr int C_QA = 0, C_KA = 512, C_GA = 640, C_XB = 1152, C_GB = 1664, C_QC = 2176, C_KC = 2688, C_GC = 3200;
constexpr int LROW = 72;
constexpr int VROW = 68;
constexpr float EPS = 1e-6f;
constexpr int STAGE_BYTES = 131072;
constexpr int SPARE_BYTES = 8192;
constexpr int LDS_BYTES = STAGE_BYTES + SPARE_BYTES + 16;

constexpr size_t O_X = 0, O_KA = 12582912, O_VA = 13631488, O_KC = 14680064, O_VC = 18874368, O_ST = 23068672;

struct Params {
  const float *x_prompt, *x_sample, *cache_a_k, *cache_a_v, *cache_c_k, *cache_c_v, *state_lru, *c, *c_ctx,
      *norm_g, *mod_w, *mod_b, *w_in, *qn_a, *kn_a, *sink_a, *conv_w, *conv_b, *lru_wa, *lru_ba, *lru_wx, *lru_bx,
      *lru_lam, *qn_c, *kn_c, *lam_q1, *lam_k1, *lam_q2, *lam_k2, *subln_c, *w_br_a, *w_br_b, *w_br_c, *w_out;
  float* out;
  u16 *Wt_in, *Wt_br, *Wt_out, *H, *P, *VtA_ctx, *VtA_lat, *VtC_ctx, *VtC_lat, *cKa, *cVtA, *cKc, *cVtC;
  float *mod, *rope, *lruTot;
  u16 *Wt_lru;
  unsigned* bar;
  u16* Y;
  u16* GB;
  unsigned* MG;
};

__device__ __forceinline__ int tid_opaque() { int t = (int)threadIdx.x; asm volatile("" : "+v"(t)); return t; }
#define TIDX tid_opaque()
__device__ __forceinline__ u16 f2bf(float f) {
  uint32_t u = __float_as_uint(f);
  u += 0x7FFFu + ((u >> 16) & 1u);
  return (u16)(u >> 16);
}
__device__ __forceinline__ float bf2f(u16 h) { return __uint_as_float(((uint32_t)h) << 16); }
__device__ __forceinline__ uint32_t pack2(float a, float b) { uint32_t r; asm("v_cvt_pk_bf16_f32 %0, %1, %2" : "=v"(r) : "v"(a), "v"(b)); return r; }
__device__ __forceinline__ float sigmoidf_(float x) { return 1.f / (1.f + __expf(-x)); }
__device__ __forceinline__ float siluf_(float x) { return x / (1.f + __expf(-x)); }
__device__ __forceinline__ f32x16 mfma32(bf16x8 a, bf16x8 b, f32x16 c) {
  return __builtin_amdgcn_mfma_f32_32x32x16_bf16(a, b, c, 0, 0, 0);
}
__device__ __forceinline__ float shflx(float v, int mask, int lane) {
  return __builtin_bit_cast(float, __builtin_amdgcn_ds_bpermute((lane ^ mask) << 2, __builtin_bit_cast(int, v)));
}
__device__ __forceinline__ float lo_bf(uint32_t w) { return __uint_as_float(w << 16); }
__device__ __forceinline__ float hi_bf(uint32_t w) { return __uint_as_float(w & 0xffff0000u); }

__device__ __forceinline__ size_t tm_off(int r, int k, int KT) {
  return ((size_t)((r >> 8) * KT + (k >> 6)) * 256 + (r & 255)) * 64 + (k & 63);
}
__device__ __forceinline__ void transpose_tile(const float* __restrict__ src, int spitch, u16* __restrict__ dst, int dpitch,
                               int r0, int c0, float* sm, int KT = 0) {
  const int tid = TIDX;
#pragma unroll
  for (int i = 0; i < 2; i++) {
    int c = tid + i * NT; int r = c >> 4, q = c & 15;
    float4 v = *(const float4*)(src + (size_t)(r0 + r) * spitch + c0 + q * 4);
    float* d = sm + r * 65 + q * 4;
    d[0] = v.x; d[1] = v.y; d[2] = v.z; d[3] = v.w;
  }
  __syncthreads();
  {
    int c = tid; int cc = c >> 3, q = c & 7;
    uint32_t w[4];
#pragma unroll
    for (int j = 0; j < 4; j++) w[j] = pack2(sm[(q * 8 + 2 * j) * 65 + cc], sm[(q * 8 + 2 * j + 1) * 65 + cc]);
    uint4 v; v.x = w[0]; v.y = w[1]; v.z = w[2]; v.w = w[3];
    if (KT) *(uint4*)(dst + tm_off(c0 + cc, r0 + q * 8, KT)) = v;
    else *(uint4*)(dst + (size_t)(c0 + cc) * dpitch + r0 + q * 8) = v;
  }
  __syncthreads();
}

__device__ __forceinline__ void transpose_wide(const float* __restrict__ src, int spitch, u16* __restrict__ dst,
                                               int k0, int n0, float* sm, int KT) {
  const int tid = TIDX;
  float4 v[8];
#pragma unroll
  for (int i = 0; i < 8; i++) { int c = tid + i * NT; int r = c >> 6, q = c & 63; v[i] = *(const float4*)(src + (size_t)(k0 + r) * spitch + n0 + q * 4); }
#pragma unroll
  for (int i = 0; i < 8; i++) { int c = tid + i * NT; int r = c >> 6, q = c & 63; float* d = sm + r * 257 + q * 4; d[0] = v[i].x; d[1] = v[i].y; d[2] = v[i].z; d[3] = v[i].w; }
  __syncthreads();
#pragma unroll
  for (int i = 0; i < 4; i++) {
    int c = tid + i * NT; int nn = c >> 3, q = c & 7;
    uint4 o;
    o.x = pack2(sm[(q * 8 + 0) * 257 + nn], sm[(q * 8 + 1) * 257 + nn]);
    o.y = pack2(sm[(q * 8 + 2) * 257 + nn], sm[(q * 8 + 3) * 257 + nn]);
    o.z = pack2(sm[(q * 8 + 4) * 257 + nn], sm[(q * 8 + 5) * 257 + nn]);
    o.w = pack2(sm[(q * 8 + 6) * 257 + nn], sm[(q * 8 + 7) * 257 + nn]);
    *(uint4*)(dst + tm_off(n0 + nn, k0 + q * 8, KT)) = o;
  }
  __syncthreads();
}

__device__ __forceinline__ void mod_item(const Params& p, int it, float* sm) {
  const int tid = TIDX;
  const int l = it / 48, n0 = (it % 48) * 64;
  float* sv = sm;
  float* red = sm + 3072;
  for (int e = tid; e < 3072; e += NT) {
    int v = e >> 10, k = e & 1023;
    float x = (v == 0) ? p.c_ctx[k] : p.c[(v - 1) * 1024 + k];
    sv[e] = siluf_(x);
  }
  __syncthreads();
  const int col = tid & 63, kg = tid >> 6;
  const float* w = p.mod_w + (size_t)l * 1024 * 3072 + n0 + col;
  float a0 = 0, a1 = 0, a2 = 0;
#pragma unroll 1
  for (int kb = kg * 128; kb < kg * 128 + 128; kb += 32) {
    float wv[32];
#pragma unroll
    for (int j = 0; j < 32; j++) wv[j] = w[(size_t)(kb + j) * 3072];
#pragma unroll
    for (int j = 0; j < 32; j++) { a0 += sv[kb + j] * wv[j]; a1 += sv[1024 + kb + j] * wv[j]; a2 += sv[2048 + kb + j] * wv[j]; }
  }
  red[(kg * 3 + 0) * 64 + col] = a0; red[(kg * 3 + 1) * 64 + col] = a1; red[(kg * 3 + 2) * 64 + col] = a2;
  __syncthreads();
  if (tid < 192) {
    int v = tid >> 6, c = tid & 63;
    float s = p.mod_b[l * 3072 + n0 + c];
#pragma unroll
    for (int g = 0; g < 8; g++) s += red[(g * 3 + v) * 64 + c];
    p.mod[(l * 3 + v) * 3072 + n0 + c] = s;
  }
  __syncthreads();
}

__device__ __forceinline__ void prologue_phase(const Params& p, float* sm) {
  constexpr int N_MOD = 96, N_ROPE = 1, N_WIN = 2 * 16 * 29, N_WBR = 6 * 8 * 4, N_WOUT = 2 * 16 * 4;
  constexpr int N_CK = 64 + 256, N_CVA = 4 * 16, N_CVC = 4 * 64, N_LW = 64;
  constexpr int E0 = N_MOD, E1 = E0 + N_ROPE, E2 = E1 + N_WIN, E3 = E2 + N_WBR, E4 = E3 + N_WOUT, E5 = E4 + N_CK,
                E6 = E5 + N_CVA, E7 = E6 + N_CVC, E8 = E7 + N_LW;
  const int tid = TIDX;
  for (int it = blockIdx.x; it < E8; it += gridDim.x) {
    if (it < E0) {
      mod_item(p, it, sm);
    } else if (it < E1) {
      for (int e = tid; e < 1024; e += NT) {
        int pos = e >> 4, f = e & 15;
        float inv = powf(10000.f, -(float)f / 16.f);
        float ang = (float)pos * inv;
        p.rope[e] = cosf(ang); p.rope[1024 + e] = sinf(ang);
      }
    } else if (it < E2) {
      int j = it - E1; int l = j / (16 * 29); int r = j % (16 * 29);
      int kt = r / 29, pn = r % 29;
      transpose_wide(p.w_in + (size_t)l * 1024 * INC, INC, p.Wt_in + (size_t)l * INC * 1024, kt * 64, pn * 256, sm, 16);
    } else if (it < E3) {
      int j = it - E2; int m = j / 32; int r = j % 32;
      int l = m / 3, i = m % 3;
      const float* src = (i == 0 ? p.w_br_a : (i == 1 ? p.w_br_b : p.w_br_c)) + (size_t)l * 512 * 1024;
      int kt = r / 4, pn = r % 4;
      transpose_wide(src, 1024, p.Wt_br + (size_t)m * 1024 * 512, kt * 64, pn * 256, sm, 8);
    } else if (it < E4) {
      int j = it - E3; int l = j / 64; int r = j % 64;
      int kt = r / 4, pn = r % 4;
      transpose_wide(p.w_out + (size_t)l * 1024 * 1024, 1024, p.Wt_out + (size_t)l * 1024 * 1024, kt * 64, pn * 256, sm, 16);
    } else if (it < E5) {
      int j = it - E4;
      const float* src; u16* dst; size_t off;
      if (j < 64) { src = p.cache_a_k; dst = p.cKa; off = (size_t)j * 4096; }
      else { src = p.cache_c_k; dst = p.cKc; off = (size_t)(j - 64) * 4096; }
      size_t e = off + (size_t)tid * 8;
      float4 a = *(const float4*)(src + e), b = *(const float4*)(src + e + 4);
      uint4 v; v.x = pack2(a.x, a.y); v.y = pack2(a.z, a.w); v.z = pack2(b.x, b.y); v.w = pack2(b.z, b.w);
      *(uint4*)(dst + e) = v;
    } else if (it < E6) {
      int j = it - E5; int bl = j / 16; int r = j % 16;
      int rt = r / 2, ct = r % 2;
      transpose_tile(p.cache_a_v + (size_t)bl * 512 * 128, 128, p.cVtA + (size_t)bl * 128 * 512, 512, rt * 64, ct * 64, sm);
    } else if (it < E7) {
      int j = it - E6; int bl = j / 64; int r = j % 64;
      int rt = r / 8, ct = r % 8;
      transpose_tile(p.cache_c_v + (size_t)bl * 512 * 512, 512, p.cVtC + (size_t)bl * 512 * 512, 512, rt * 64, ct * 64, sm);
    } else {
      int j = it - E7; int ldn = j >> 1, g = j & 1;
      transpose_tile((g ? p.lru_wx : p.lru_wa) + (size_t)ldn * 4096, 64, p.Wt_lru + (size_t)(ldn * 2 + g) * 4096, 64, 0, 0, sm);
    }
  }
}

__device__ __forceinline__ void norm_phase(const Params& p, int l) {
  const int tid = TIDX, lane = tid & 63, wid = tid >> 6;
  const float* g = p.norm_g + l * 1024;
  for (int it = blockIdx.x; it < NTOK / 8; it += gridDim.x) {
    int row = it * 8 + wid;
    const float* x;
    if (l == 0) x = (row < NCTX) ? p.x_prompt + (size_t)row * 1024 : p.x_sample + (size_t)(row - NCTX) * 1024;
    else x = p.out + O_X + (size_t)row * 1024;
    int v = (row < NCTX) ? 0 : 1 + (row - NCTX) / 4096;
    const float* md = p.mod + (l * 3 + v) * 3072;
    float4 xv[4]; float ss = 0;
#pragma unroll
    for (int i = 0; i < 4; i++) {
      xv[i] = *(const float4*)(x + i * 256 + lane * 4);
      ss += xv[i].x * xv[i].x + xv[i].y * xv[i].y + xv[i].z * xv[i].z + xv[i].w * xv[i].w;
    }
#pragma unroll
    for (int o = 32; o > 0; o >>= 1) ss += shflx(ss, o, lane);
    float rinv = rsqrtf(ss * (1.f / 1024.f) + EPS);
#pragma unroll
    for (int i = 0; i < 4; i++) {
      int c = i * 256 + lane * 4;
      float4 gv = *(const float4*)(g + c), sh = *(const float4*)(md + c), sc = *(const float4*)(md + 1024 + c);
      float h0 = xv[i].x * rinv * gv.x * (1.f + sc.x) + sh.x;
      float h1 = xv[i].y * rinv * gv.y * (1.f + sc.y) + sh.y;
      float h2 = xv[i].z * rinv * gv.z * (1.f + sc.z) + sh.z;
      float h3 = xv[i].w * rinv * gv.w * (1.f + sc.w) + sh.w;
      uint2 o2; o2.x = pack2(h0, h1); o2.y = pack2(h2, h3);
      *(uint2*)(p.H + tm_off(row, c, 16)) = o2;
    }
  }
}

constexpr int G_BK = 64, G_HALF = 128, G_HTB = G_HALF * G_BK * 2;
__device__ __forceinline__ int lds_byte(int r, int c) {
  const int st = (r >> 4) * 2 + (c >> 5), rr = r & 15, cc = c & 31, ob = rr * 64 + cc * 2;
  return st * 1024 + (ob ^ (((ob >> 9) & 1) << 5));
}
__device__ __forceinline__ void stage_rc(int b, int& R, int& C) {
  const int st = b / 1024, sb = b % 1024, swz = sb ^ (((sb >> 9) & 1) << 5);
  R = (st >> 1) * 16 + swz / 64; C = (st & 1) * 32 + (swz % 64) / 2;
}
struct Unit { int pm, pn, seg; };

struct SchedStd {
  int nM, nN, nwg, G, c; const char* A; const char* B; size_t tA, tB;
  __device__ __forceinline__ bool next(int i, Unit& u) const {
    const long L = (long)i * G + c; if (L >= nwg) return false;
    const int wgid = (int)L;
    const int nig = 8 * nN, gid = wgid / nig, fm = gid * 8, gsz = (nM - fm) < 8 ? (nM - fm) : 8;
    u.pm = fm + ((wgid % nig) % gsz); u.pn = (wgid % nig) / gsz; u.seg = 0; return true;
  }
  __device__ __forceinline__ const char* aptr(const Unit& u) const { return A + (size_t)u.pm * tA; }
  __device__ __forceinline__ const char* bptr(const Unit& u) const { return B + (size_t)u.pn * tB; }
};
struct SchedBranch {
  int G, c; const char* P_; const char* W_;
  __device__ __forceinline__ bool next(int i, Unit& u) const {
    if (i >= 3) return false;
    const int xcd = c >> 5, j = c & 31;
    if (j >= 24) return false;
    u.seg = i; u.pm = xcd * 6 + (j >> 2); u.pn = j & 3; return true;
  }
  __device__ __forceinline__ const char* aptr(const Unit& u) const { return P_ + (size_t)((u.seg * 48 + u.pm) * 8) * 32768; }
  __device__ __forceinline__ const char* bptr(const Unit& u) const { return W_ + (size_t)((u.seg * 4 + u.pn) * 8) * 32768; }
};

template <class Epi, class Sched>
__device__ __forceinline__ float gemm_phase(LAS unsigned char* lds, const int K, const Sched& S, const Epi& E, int tmode = 0) {
  unsigned long long t_ph0 = 0, t_epi = 0; if (PROBE >= 20) t_ph0 = __builtin_amdgcn_s_memrealtime();
  const int tid = TIDX, wid = __builtin_amdgcn_readfirstlane(tid >> 6), lane = tid & 63, wr = wid >> 2, wc = wid & 3, fr = lane & 15, fq = lane >> 4;
  const int nt = K / G_BK;
  unsigned voffA[2], voffB[2];
#pragma unroll
  for (int i = 0; i < 2; ++i) { int R, C; stage_rc(tid * 16 + i * 8192, R, C);
    voffA[i] = (unsigned)(R * 64 + C) * 2u; voffB[i] = voffA[i]; }
  const size_t kstep = (size_t)32768;
  const size_t hA = (size_t)16384, hB = (size_t)16384;
  const unsigned ldsw = (unsigned)wid * 1024u;
  const int aoff = lds_byte(wr * 64 + fr, fq * 8), boff = lds_byte(wc * 32 + fr, fq * 8);
#define G_SA(b, h) (((b) * 2 + (h)) * G_HTB)
#define G_SB(b, h) ((4 + (b) * 2 + (h)) * G_HTB)
#define G_STAGE(bufoff, gbase, voff) do { _Pragma("unroll") for (int _i = 0; _i < 2; ++_i) \
    __builtin_amdgcn_global_load_lds((const unsigned*)((const char*)(gbase) + (voff)[_i]), (LAS unsigned*)(lds + (bufoff) + ldsw + _i * 8192), 16, 0, 0); } while (0)
#define G_LDA(dst, b, h) do { _Pragma("unroll") for (int m = 0; m < 4; ++m) _Pragma("unroll") for (int k = 0; k < 2; ++k) dst[m][k] = *(const LAS bf16x8*)(lds + G_SA(b, h) + aoff + m * 2048 + k * 1024); } while (0)
#define G_LDB(dst, b, h) do { _Pragma("unroll") for (int n = 0; n < 2; ++n) _Pragma("unroll") for (int k = 0; k < 2; ++k) dst[n][k] = *(const LAS bf16x8*)(lds + G_SB(b, h) + boff + n * 2048 + k * 1024); } while (0)
#define G_MMA(ai, bj, At, Bt) do { __builtin_amdgcn_s_setprio(1); _Pragma("unroll") for (int m = 0; m < 4; ++m) _Pragma("unroll") for (int n = 0; n < 2; ++n) _Pragma("unroll") for (int k = 0; k < 2; ++k) \
    acc[ai][bj][m][n] = __builtin_amdgcn_mfma_f32_16x16x32_bf16(Bt[n][k], At[m][k], acc[ai][bj][m][n], 0, 0, 0); __builtin_amdgcn_s_setprio(0); } while (0)
#define G_WAIT_V(n) asm volatile("s_waitcnt vmcnt(" #n ")" ::: "memory")
#define G_WAIT_L(n) asm volatile("s_waitcnt lgkmcnt(" #n ")" ::: "memory")
#define G_BAR __builtin_amdgcn_s_barrier()
#define G_SCHED __builtin_amdgcn_sched_barrier(0)
  Unit cur, nxt; int ui = 0;
  if (!S.next(0, cur)) return 0.f;
  f32x4 acc[2][2][4][2];
#pragma unroll
  for (int a = 0; a < 2; ++a)
#pragma unroll
    for (int b = 0; b < 2; ++b)
#pragma unroll
      for (int m = 0; m < 4; ++m)
#pragma unroll
        for (int n = 0; n < 2; ++n) acc[a][b][m][n] = (f32x4){0.f, 0.f, 0.f, 0.f};
  bf16x8 At[4][2], B0[2][2], B1[2][2];
  const char* cA = S.aptr(cur); const char* cB = S.bptr(cur);
  G_STAGE(G_SB(0, 0), cB, voffB); G_STAGE(G_SA(0, 0), cA, voffA); G_STAGE(G_SB(0, 1), cB + hB, voffB); G_STAGE(G_SA(0, 1), cA + hA, voffA);
  if (wr == 1) G_BAR;
  G_WAIT_V(4); G_BAR;
  G_STAGE(G_SB(1, 0), cB + kstep, voffB); G_STAGE(G_SA(1, 0), cA + kstep, voffA); G_STAGE(G_SB(1, 1), cB + hB + kstep, voffB);
  G_WAIT_V(6); G_BAR;
  for (;;) {
    const bool has_next = S.next(ui + 1, nxt);
    const char* nA = has_next ? S.aptr(nxt) : cA; const char* nB = has_next ? S.bptr(nxt) : cB;
    for (int t = 0; t < nt; t += 2) {
      const bool last = (t == nt - 2);
      const char* a1 = cA + (size_t)(t + 1) * kstep;
      const char* a2 = last ? nA : cA + (size_t)(t + 2) * kstep; const char* b2 = last ? nB : cB + (size_t)(t + 2) * kstep;
      const char* a3 = a2 + kstep; const char* b3 = b2 + kstep;
      G_LDB(B0, 0, 0); G_SCHED; G_LDA(At, 0, 0); G_STAGE(G_SA(1, 1), a1 + hA, voffA);
      G_WAIT_L(8); G_BAR; G_WAIT_L(0); G_MMA(0, 0, At, B0); G_BAR; G_SCHED;
      G_LDB(B1, 0, 1); G_STAGE(G_SB(0, 0), b2, voffB);
      G_BAR; G_WAIT_L(0); G_MMA(0, 1, At, B1); G_BAR;
      G_LDA(At, 0, 1); G_STAGE(G_SA(0, 0), a2, voffA);
      G_BAR; G_WAIT_L(0); G_MMA(1, 0, At, B0); G_BAR; G_SCHED;
      G_STAGE(G_SB(0, 1), b2 + hB, voffB);
      G_WAIT_V(6); G_BAR; G_MMA(1, 1, At, B1); G_BAR;
      G_LDB(B0, 1, 0); G_SCHED; G_LDA(At, 1, 0); G_STAGE(G_SA(0, 1), a2 + hA, voffA);
      G_WAIT_L(8); G_BAR; G_WAIT_L(0); G_MMA(0, 0, At, B0); G_BAR; G_SCHED;
      G_LDB(B1, 1, 1); G_STAGE(G_SB(1, 0), b3, voffB);
      G_BAR; G_WAIT_L(0); G_MMA(0, 1, At, B1); G_BAR;
      G_LDA(At, 1, 1); G_STAGE(G_SA(1, 0), a3, voffA);
      G_BAR; G_WAIT_L(0); G_MMA(1, 0, At, B0); G_BAR; G_SCHED;
      G_STAGE(G_SB(1, 1), b3 + hB, voffB);
      G_WAIT_V(6); G_BAR; G_MMA(1, 1, At, B1); G_BAR;
    }
    unsigned long long t_e0 = 0; if (PROBE >= 20) t_e0 = __builtin_amdgcn_s_memrealtime();
    const bool reset = E(acc, cur, wr, wc, fr, fq);
    if (PROBE >= 20) { asm volatile("s_waitcnt vmcnt(0)" ::: "memory"); t_epi += __builtin_amdgcn_s_memrealtime() - t_e0; }
    if (!has_next) break;
    if (reset) {
#pragma unroll
      for (int a = 0; a < 2; ++a)
#pragma unroll
        for (int b = 0; b < 2; ++b)
#pragma unroll
          for (int m = 0; m < 4; ++m)
#pragma unroll
            for (int n = 0; n < 2; ++n) acc[a][b][m][n] = (f32x4){0.f, 0.f, 0.f, 0.f};
    }
    cur = nxt; cA = nA; cB = nB; ++ui;
  }
  G_WAIT_V(0);
  if (wr == 0) G_BAR;
  G_BAR;
  float tres = 0.f;
  if (PROBE >= 20) {
    const unsigned long long tot = __builtin_amdgcn_s_memrealtime() - t_ph0;
    tres = (tmode == 0) ? (float)t_epi / (float)tot : (float)tot / 40000.f;
  }
#undef G_SA
#undef G_SB
#undef G_STAGE
#undef G_LDA
#undef G_LDB
#undef G_MMA
#undef G_WAIT_V
#undef G_WAIT_L
#undef G_BAR
#undef G_SCHED
  return tres;
}

struct EpiInproj {
  const Params* pp; int l; LAS float* part;
  __device__ __forceinline__ bool operator()(f32x4 (&acc)[2][2][4][2], const Unit& u, int wr, int wc, int fr, int fq) const {
    const Params& p = *pp;
    asm volatile("" : "+v"(fr), "+v"(fq));
    const int lane = fr + 16 * fq; (void)lane;
    const int oc0 = u.pn * 256;
    const bool isctx = u.pm < 16;
    const bool qkU = (oc0 < 768) || (oc0 >= 2304 && oc0 < 3328);
    float rinv[2][4][2];
    if (qkU) {
#pragma unroll
      for (int ai = 0; ai < 2; ai++)
#pragma unroll
        for (int m = 0; m < 4; m++)
#pragma unroll
          for (int bj = 0; bj < 2; bj++) {
            f32x4 a = acc[ai][bj][m][0], b = acc[ai][bj][m][1];
            float ss = a[0] * a[0] + a[1] * a[1] + a[2] * a[2] + a[3] * a[3] + b[0] * b[0] + b[1] * b[1] + b[2] * b[2] + b[3] * b[3];
            ss += shflx(ss, 16, lane); ss += shflx(ss, 32, lane);
            rinv[ai][m][bj] = ss;
            if (fq == 0) part[((ai * 128 + wr * 64 + m * 16 + fr) * 2 + bj) * 4 + wc] = ss;
          }
      asm volatile("s_waitcnt lgkmcnt(0)" ::: "memory");
      __builtin_amdgcn_s_barrier();
      asm volatile("" ::: "memory");
#pragma unroll
      for (int ai = 0; ai < 2; ai++)
#pragma unroll
        for (int m = 0; m < 4; m++)
#pragma unroll
          for (int bj = 0; bj < 2; bj++) {
            float o = part[((ai * 128 + wr * 64 + m * 16 + fr) * 2 + bj) * 4 + (wc ^ 1)];
            rinv[ai][m][bj] = rsqrtf((rinv[ai][m][bj] + o) * (1.f / 64.f) + EPS);
          }
    }
#pragma unroll
    for (int bj = 0; bj < 2; bj++) {
      const int oc = oc0 + bj * 128;
      if (oc == 640 || (oc >= 3328 && oc < 3840)) {
        const bool isA = (oc == 640);
        const int cb = isA ? 0 : (oc - 3328);
        const int nvec = isA ? 128 : 512;
#pragma unroll
        for (int ai = 0; ai < 2; ai++)
#pragma unroll
          for (int m = 0; m < 4; m++) {
            const int row = u.pm * 256 + ai * 128 + wr * 64 + m * 16 + fr;
            int b, t, T; u16* vt;
            if (isctx) { b = row >> 8; t = row & 255; T = 256; vt = isA ? p.VtA_ctx : p.VtC_ctx; }
            else { int rr = row - NCTX; b = rr >> 12; t = rr & 4095; T = 4096; vt = isA ? p.VtA_lat : p.VtC_lat; }
#pragma unroll
            for (int n = 0; n < 2; n++) {
              const int d = cb + wc * 32 + n * 16 + fq * 4;
              f32x4 v = acc[ai][bj][m][n];
#pragma unroll
              for (int j = 0; j < 4; j++) vt[((size_t)b * nvec + d + j) * T + t] = f2bf(v[j]);
              if (isctx) {
                float* o = p.out + (isA ? O_VA : O_VC) + ((size_t)(b * 2 + l) * 256 + t) * nvec + d;
                *(f32x4*)o = v;
              }
            }
          }
      } else {
        const int pc = (oc < 640) ? oc : (oc < 3328 ? oc - 128 : oc - 640);
        const bool is_qa = oc < 512, is_ka = (oc == 512);
        const bool is_qc = (oc >= 2304 && oc < 2816), is_kc = (oc >= 2816 && oc < 3328);
        if (is_qa || is_ka || is_qc || is_kc) {
          const float* gn = (is_qa ? p.qn_a : is_ka ? p.kn_a : is_qc ? p.qn_c : p.kn_c) + l * 64 + (wc & 1) * 32 + fq * 4;
          const f32x4 g0 = *(const f32x4*)gn, g1 = *(const f32x4*)(gn + 16);
          const float qs = (is_qa || is_qc) ? 0.18033688011112042f : 1.f;
#pragma unroll
          for (int ai = 0; ai < 2; ai++)
#pragma unroll
            for (int m = 0; m < 4; m++) {
              const int row = u.pm * 256 + ai * 128 + wr * 64 + m * 16 + fr;
              const float ri = rinv[ai][m][bj];
              f32x4 x1 = acc[ai][bj][m][0] * ri * g0, x2 = acc[ai][bj][m][1] * ri * g1;
              if (!isctx) {
                const int t = (row - NCTX) & 4095;
                const int pos = (wc & 1) ? (t & 63) : (t >> 6);
                const f32x4 cs = *(const f32x4*)(p.rope + pos * 16 + fq * 4), sn = *(const f32x4*)(p.rope + 1024 + pos * 16 + fq * 4);
                f32x4 y1 = x1 * cs - x2 * sn, y2 = x2 * cs + x1 * sn;
                x1 = y1; x2 = y2;
              } else if (is_ka || is_kc) {
                const int b = row >> 8, t = row & 255;
                float* o = is_ka ? p.out + O_KA + ((size_t)(b * 2 + l) * 256 + t) * 128 + wc * 32 + fq * 4
                                 : p.out + O_KC + ((size_t)(b * 2 + l) * 256 + t) * 512 + (oc - 2816) + wc * 32 + fq * 4;
                *(f32x4*)o = x1; *(f32x4*)(o + 16) = x2;
              }
              x1 = x1 * qs; x2 = x2 * qs;
              u16* po = p.P + (size_t)row * PP + pc + wc * 32 + fq * 4;
              *(uint2*)po = make_uint2(pack2(x1[0], x1[1]), pack2(x1[2], x1[3]));
              *(uint2*)(po + 16) = make_uint2(pack2(x2[0], x2[1]), pack2(x2[2], x2[3]));
            }
        } else {
          const int mode = (oc >= 4352) ? 2 : ((oc >= 1280 && oc < 1792) ? 0 : 1);
          if (mode == 2) {
            const int pj = u.pn - 17, seg = pj >> 2, pn4 = pj & 3;
            unsigned* mg = p.MG + ((size_t)((u.pm * 4 + pn4) * 3 + seg) * 8 + (wr * 4 + wc)) * 2048 + lane;
#pragma unroll
            for (int ai = 0; ai < 2; ai++)
#pragma unroll
              for (int m = 0; m < 4; m++)
#pragma unroll
                for (int n = 0; n < 2; n++) {
                  f32x4 v = acc[ai][bj][m][n];
                  const unsigned q0 = (unsigned)(sigmoidf_(v[0]) * 254.f + 1.5f), q1 = (unsigned)(sigmoidf_(v[1]) * 254.f + 1.5f);
                  const unsigned q2 = (unsigned)(sigmoidf_(v[2]) * 254.f + 1.5f), q3 = (unsigned)(sigmoidf_(v[3]) * 254.f + 1.5f);
                  mg[(((ai * 4 + m) * 2 + bj) * 2 + n) * 64] = q0 | (q1 << 8) | (q2 << 16) | (q3 << 24);
                }
          } else
#pragma unroll
          for (int ai = 0; ai < 2; ai++)
#pragma unroll
            for (int m = 0; m < 4; m++) {
              const int row = u.pm * 256 + ai * 128 + wr * 64 + m * 16 + fr;
              u16* po = p.P + (size_t)row * PP + pc + wc * 32 + fq * 4;
#pragma unroll
              for (int n = 0; n < 2; n++) {
                f32x4 v = acc[ai][bj][m][n];
                if (mode == 1) { v[0] = siluf_(v[0]); v[1] = siluf_(v[1]); v[2] = siluf_(v[2]); v[3] = siluf_(v[3]); }
                else if (mode == 2) { v[0] = sigmoidf_(v[0]); v[1] = sigmoidf_(v[1]); v[2] = sigmoidf_(v[2]); v[3] = sigmoidf_(v[3]); }
                *(uint2*)(po + n * 16) = make_uint2(pack2(v[0], v[1]), pack2(v[2], v[3]));
              }
            }
        }
      }
    }
    return true;
  }
};

struct EpiBranch {
  const Params* pp;
  __device__ __forceinline__ bool operator()(f32x4 (&acc)[2][2][4][2], const Unit& u, int wr, int wc, int fr, int fq) const {
    const Params& p = *pp;
    asm volatile("" : "+v"(fr), "+v"(fq));
    const int lane = fr + 16 * fq;
    const int seg = u.seg;
    const unsigned* mg = p.MG + ((size_t)((u.pm * 4 + u.pn) * 3 + seg) * 8 + (wr * 4 + wc)) * 2048 + lane;
#pragma unroll
    for (int ai = 0; ai < 2; ai++)
#pragma unroll
      for (int m = 0; m < 4; m++) {
        const int row = u.pm * 256 + ai * 128 + wr * 64 + m * 16 + fr;
#pragma unroll
        for (int bj = 0; bj < 2; bj++)
#pragma unroll
          for (int n = 0; n < 2; n++) {
            const int idx = (((ai * 4 + m) * 2 + bj) * 2 + n) * 64;
            const unsigned a = mg[idx];
            f32x4 f = {(float)(a & 255u), (float)((a >> 8) & 255u), (float)((a >> 16) & 255u), (float)(a >> 24)};
            if (seg < 2) {
              const unsigned b = mg[idx + 8 * 2048];
              f[0] = __fdividef(f[0], (float)(b & 255u)); f[1] = __fdividef(f[1], (float)((b >> 8) & 255u));
              f[2] = __fdividef(f[2], (float)((b >> 16) & 255u)); f[3] = __fdividef(f[3], (float)(b >> 24));
              acc[ai][bj][m][n] = acc[ai][bj][m][n] * f;
            } else {
              const int col = u.pn * 256 + bj * 128 + wc * 32 + n * 16 + fq * 4;
              f32x4 v = acc[ai][bj][m][n] * f * (1.f / 255.f);
              *(uint2*)(p.Y + tm_off(row, col, 16)) = make_uint2(pack2(v[0], v[1]), pack2(v[2], v[3]));
            }
          }
      }
    return seg == 2;
  }
};

struct EpiOut {
  const Params* pp; int l;
  __device__ __forceinline__ bool operator()(f32x4 (&acc)[2][2][4][2], const Unit& u, int wr, int wc, int fr, int fq) const {
    const Params& p = *pp;
    asm volatile("" : "+v"(fr), "+v"(fq));
    const int lane = fr + 16 * fq; (void)lane;
    const int v = (u.pm < 16) ? 0 : 1 + (u.pm - 16) / 16;
    const float* gt = p.mod + (l * 3 + v) * 3072 + 2048;
#pragma unroll
    for (int ai = 0; ai < 2; ai++)
#pragma unroll
      for (int m = 0; m < 4; m++) {
        const int row = u.pm * 256 + ai * 128 + wr * 64 + m * 16 + fr;
        const float* xr;
        if (l == 0) xr = (row < NCTX) ? p.x_prompt + (size_t)row * 1024 : p.x_sample + (size_t)(row - NCTX) * 1024;
        else xr = p.out + O_X + (size_t)row * 1024;
        float* orow = p.out + O_X + (size_t)row * 1024;
#pragma unroll
        for (int bj = 0; bj < 2; bj++)
#pragma unroll
          for (int n = 0; n < 2; n++) {
            const int col = u.pn * 256 + bj * 128 + wc * 32 + n * 16 + fq * 4;
            const f32x4 xv = *(const f32x4*)(xr + col), gv = *(const f32x4*)(gt + col);
            *(f32x4*)(orow + col) = xv + gv * acc[ai][bj][m][n];
          }
      }
    return true;
  }
};

template <bool MASK>
__device__ __forceinline__ void fs_scores(const u16* Ks, const bf16x8 (&qf)[4], f32x16 (&s)[2], int lane, int kpos0, int qpos, int T) {
  const int r = lane & 31, h = lane >> 5;
  {
    bf16x8 kf[2][4];
#pragma unroll
    for (int sub = 0; sub < 2; sub++)
#pragma unroll
      for (int ks = 0; ks < 4; ks++) kf[sub][ks] = *(const bf16x8*)(Ks + (sub * 32 + r) * LROW + ks * 16 + h * 8);
    __builtin_amdgcn_sched_barrier(0);
#pragma unroll
    for (int sub = 0; sub < 2; sub++) {
#pragma unroll
      for (int e = 0; e < 16; e++) s[sub][e] = 0.f;
#pragma unroll
      for (int ks = 0; ks < 4; ks++) s[sub] = mfma32(kf[sub][ks], qf[ks], s[sub]);
    }
  }
  if (MASK) {
#pragma unroll
    for (int sub = 0; sub < 2; sub++)
#pragma unroll
      for (int e = 0; e < 16; e++) {
        int kp = kpos0 + sub * 32 + (e & 3) + 8 * (e >> 2) + 4 * h;
        int dlt = kp - qpos;
        bool ok = (kp >= 0) && (kp < T) && (dlt <= 128) && (dlt >= -128);
        if (!ok) s[sub][e] = -INFINITY;
      }
  }
}
template <int DV>
__device__ __forceinline__ void fs_softmax(f32x16 (&s)[2], float& m, float& l, f32x16 (&o)[DV / 32], bf16x8 (&pf)[2][2], int lane) {
  float mx = s[0][0];
#pragma unroll
  for (int sub = 0; sub < 2; sub++)
#pragma unroll
    for (int e = 0; e < 16; e++) mx = fmaxf(mx, s[sub][e]);
  mx = fmaxf(mx, shflx(mx, 32, lane));
  const bool grow = mx > m;
  const float mn = grow ? mx : m;
  float sum = 0.f;
#pragma unroll
  for (int sub = 0; sub < 2; sub++)
#pragma unroll
    for (int e = 0; e < 16; e++) { float pv = __builtin_amdgcn_exp2f(s[sub][e] - mn); s[sub][e] = pv; sum += pv; }
  sum += shflx(sum, 32, lane);
  if (__builtin_amdgcn_ballot_w64(grow) != 0ull) {
    const float alpha = __builtin_amdgcn_exp2f(m - mn);
    l *= alpha;
#pragma unroll
    for (int ds = 0; ds < DV / 32; ds++)
#pragma unroll
      for (int e = 0; e < 16; e++) o[ds][e] *= alpha;
  }
  l += sum; m = mn;
  typedef __attribute__((ext_vector_type(4))) unsigned u32x4;
#pragma unroll
  for (int sub = 0; sub < 2; sub++)
#pragma unroll
    for (int st = 0; st < 2; st++) {
      u32x4 pw;
#pragma unroll
      for (int j = 0; j < 4; j++) pw[j] = pack2(s[sub][8 * st + 2 * j], s[sub][8 * st + 2 * j + 1]);
      pf[sub][st] = __builtin_bit_cast(bf16x8, pw);
    }
}
template <int DV>
__device__ __forceinline__ void fs_pv(const bf16x8 (&pf)[2][2], const u16* Vts, f32x16 (&o)[DV / 32], int lane) {
  const int r = lane & 31, h = lane >> 5;
#pragma unroll
  for (int sub = 0; sub < 2; sub++) {
    bf16x8 vf[2][DV / 32];
#pragma unroll
    for (int st = 0; st < 2; st++)
#pragma unroll
      for (int ds = 0; ds < DV / 32; ds++) {
        const u16* vp = Vts + (ds * 32 + r) * VROW + sub * 32 + 16 * st + 4 * h;
        bf16x4 lo = *(const bf16x4*)vp, hi = *(const bf16x4*)(vp + 8);
        vf[st][ds] = __builtin_shufflevector(lo, hi, 0, 1, 2, 3, 4, 5, 6, 7);
      }
    __builtin_amdgcn_sched_barrier(0);
#pragma unroll
    for (int st = 0; st < 2; st++)
#pragma unroll
      for (int ds = 0; ds < DV / 32; ds++) o[ds] = mfma32(vf[st][ds], pf[sub][st], o[ds]);
    __builtin_amdgcn_sched_barrier(0);
  }
}

__device__ __forceinline__ uint4 ld_k(const u16* __restrict__ src, size_t pitch, int r0, int nrows, int c) {
  int row = c >> 3, kc = c & 7; int rr = r0 + row;
  uint4 v = make_uint4(0, 0, 0, 0);
  if (rr >= 0 && rr < nrows) v = *(const uint4*)(src + (size_t)rr * pitch + kc * 8);
  return v;
}
__device__ __forceinline__ void st_k(u16* dst, int c, uint4 v) { *(uint4*)(dst + (c >> 3) * LROW + (c & 7) * 8) = v; }
__device__ __forceinline__ uint4 ld_vt(const u16* __restrict__ src, int T, int k0, int c) {
  int d = c >> 3, kc = c & 7; int k = k0 + kc * 8;
  uint4 v = make_uint4(0, 0, 0, 0);
  if (k >= 0 && k < T) v = *(const uint4*)(src + (size_t)d * T + k);
  return v;
}
__device__ __forceinline__ void st_vt(u16* dst, int c, uint4 v) {
  uint2* q = (uint2*)(dst + (c >> 3) * VROW + (c & 7) * 8);
  q[0] = make_uint2(v.x, v.y); q[1] = make_uint2(v.z, v.w);
}

constexpr int A_BUF = 64 * LROW + 64 * VROW;
__device__ __forceinline__ void attnA_item(const Params& p, int l, int it, u16* sm, bool dry = false) {
  const int tid = TIDX, lane = tid & 63, wid = tid >> 6;
  const int r = lane & 31, h = lane >> 5;
  const bool isctx = it < 128;
  int b, kvh, qb, T, rowbase; const u16* VtBase;
  if (isctx) { b = it >> 3; kvh = (it >> 2) & 1; qb = it & 3; T = 256; rowbase = b * 256;
    VtBase = p.VtA_ctx + ((size_t)(b * 2 + kvh) * 64) * 256; }
  else { int j = it - 128; b = j >> 7; kvh = (j >> 6) & 1; qb = j & 63; T = 4096; rowbase = NCTX + b * 4096;
    VtBase = p.VtA_lat + ((size_t)(b * 2 + kvh) * 64) * 4096; }
  const int qblk = qb * 64;
  const int q0 = qblk + (wid >> 2) * 32;
  const int head = kvh * 4 + (wid & 3);
  const size_t prow = (size_t)(rowbase + q0 + r) * PP;
  bf16x8 qf[4];
#pragma unroll
  for (int ks = 0; ks < 4; ks++) qf[ks] = *(const bf16x8*)(p.P + prow + C_QA + head * 64 + ks * 16 + h * 8);
  float m = p.sink_a[l * 8 + head] * 1.4426950408889634f, ls = 1.f;
  f32x16 o[2];
#pragma unroll
  for (int ds = 0; ds < 2; ds++)
#pragma unroll
    for (int e = 0; e < 16; e++) o[ds][e] = 0.f;
  const u16* Kbase = p.P + (size_t)rowbase * PP + C_KA + kvh * 64;
  const u16* cK = p.cKa + ((size_t)(b * 2 + l) * 512) * 128 + kvh * 64;
  const u16* cVt = p.cVtA + ((size_t)((b * 2 + l) * 2 + kvh) * 64) * 512;
  const int qpos = q0 + r;
  int i_lo = 0, nW, ntile;
  if (isctx) { nW = 4; ntile = 4; }
  else {
    i_lo = (qblk < 128) ? (128 - qblk) / 64 : 0;
    int i_hi = (T - qblk + 128) / 64; if (i_hi > 5) i_hi = 5;
    nW = i_hi - i_lo; ntile = nW + 8;
  }
  uint4 rk, rv;
  auto tile_load = [&](int t) {
    if (t < nW) {
      int k0 = isctx ? t * 64 : qblk - 128 + 64 * (i_lo + t);
      rk = ld_k(Kbase, PP, k0, T, tid); rv = ld_vt(VtBase, T, k0, tid);
    } else {
      int kt = t - nW;
      rk = ld_k(cK, 128, kt * 64, 512, tid); rv = ld_vt(cVt, 512, kt * 64, tid);
    }
  };
  auto KB = [&](int i) { return sm + (i & 1) * (64 * LROW); };
  auto VB = [&](int i) { return sm + 2 * 64 * LROW + (i % 3) * (64 * VROW); };
  const bool lag = (wid >> 2) != 0;
  __syncthreads();
  tile_load(0);
  st_k(KB(0), tid, rk); st_vt(VB(0), tid, rv);
  __syncthreads();
  bf16x8 pf[2][2];
  for (int t = 0; t <= ntile; t++) {
    const bool more = t + 1 < ntile;
    if (more) tile_load(t + 1);
    if (lag && t > 0) fs_pv<64>(pf, VB(t - 1), o, lane);
    if (t < ntile) {
      f32x16 sc[2];
      if (!isctx && t < nW) fs_scores<true>(KB(t), qf, sc, lane, qblk - 128 + 64 * (i_lo + t), qpos, T);
      else fs_scores<false>(KB(t), qf, sc, lane, 0, 0, T);
      fs_softmax<64>(sc, m, ls, o, pf, lane);
      if (!lag) fs_pv<64>(pf, VB(t), o, lane);
    }
    if (more) { st_k(KB(t + 1), tid, rk); st_vt(VB(t + 1), tid, rv); }
    __syncthreads();
  }
  const float inv = 1.f / ls;
#pragma unroll
  for (int ds = 0; ds < 2; ds++)
#pragma unroll
    for (int g = 0; g < 4; g++) {
      int d = ds * 32 + 8 * g + 4 * h;
      uint2 gv = *(const uint2*)(p.P + prow + C_GA + head * 64 + d);
      uint2 ov;
      ov.x = pack2(o[ds][4 * g] * inv * lo_bf(gv.x), o[ds][4 * g + 1] * inv * hi_bf(gv.x));
      ov.y = pack2(o[ds][4 * g + 2] * inv * lo_bf(gv.y), o[ds][4 * g + 3] * inv * hi_bf(gv.y));
      *(uint2*)(p.GB + tm_off(rowbase + q0 + r, head * 64 + d, 8)) = ov;
    }
}

constexpr int C_BUF = 128 * LROW + 128 * VROW;
__device__ __forceinline__ void attnC_item(const Params& p, int l, int it, u16* sm, float lam, float lam_init, bool dry = false) {
  const int tid = TIDX, lane = tid & 63, wid = tid >> 6;
  const int r = lane & 31, h = lane >> 5;
  const bool isctx = it < 128;
  int b, hd, qb, T, rowbase; const u16* VtBase;
  if (isctx) { b = it >> 3; hd = (it >> 1) & 3; qb = it & 1; T = 256; rowbase = b * 256;
    VtBase = p.VtC_ctx + ((size_t)(b * 4 + hd) * 128) * 256; }
  else { int j = it - 128; b = j >> 7; hd = (j >> 5) & 3; qb = j & 31; T = 4096; rowbase = NCTX + b * 4096;
    VtBase = p.VtC_lat + ((size_t)(b * 4 + hd) * 128) * 4096; }
  const int qg = wid & 3, map = wid >> 2;
  const int q0 = qb * 128 + qg * 32;
  const size_t prow = (size_t)(rowbase + q0 + r) * PP;
  bf16x8 qf[4];
#pragma unroll
  for (int ks = 0; ks < 4; ks++) qf[ks] = *(const bf16x8*)(p.P + prow + C_QC + hd * 128 + map * 64 + ks * 16 + h * 8);
  float m = -1e30f, ls = 0.f;
  f32x16 o[4];
#pragma unroll
  for (int ds = 0; ds < 4; ds++)
#pragma unroll
    for (int e = 0; e < 16; e++) o[ds][e] = 0.f;
  const u16* Kbase = p.P + (size_t)rowbase * PP + C_KC + hd * 128;
  const u16* cK = p.cKc + ((size_t)(b * 2 + l) * 512) * 512 + hd * 128;
  const u16* cVt = p.cVtC + ((size_t)((b * 2 + l) * 4 + hd) * 128) * 512;
  const int nW = T / 64, ntile = isctx ? nW : nW + 8;
  uint4 rk0, rk1, rv0, rv1;
  auto tile_load = [&](int t) {
    if (t < nW) {
      rk0 = ld_k(Kbase, PP, t * 64, T, tid); rk1 = ld_k(Kbase + 64, PP, t * 64, T, tid);
      rv0 = ld_vt(VtBase, T, t * 64, tid); rv1 = ld_vt(VtBase, T, t * 64, tid + NT);
    } else {
      int kt = t - nW;
      rk0 = ld_k(cK, 512, kt * 64, 512, tid); rk1 = ld_k(cK + 64, 512, kt * 64, 512, tid);
      rv0 = ld_vt(cVt, 512, kt * 64, tid); rv1 = ld_vt(cVt, 512, kt * 64, tid + NT);
    }
  };
  auto KB = [&](int i) { return sm + (i & 1) * (128 * LROW); };
  auto VB = [&](int i) { return sm + 2 * 128 * LROW + (i % 3) * (128 * VROW); };
  auto tile_store = [&](int i) {
    u16* kd = KB(i); u16* vd = VB(i);
    st_k(kd, tid, rk0); st_k(kd + 64 * LROW, tid, rk1);
    st_vt(vd, tid, rv0); st_vt(vd, tid + NT, rv1);
  };
  const bool lag = map != 0;
  __syncthreads();
  tile_load(0);
  tile_store(0);
  __syncthreads();
  bf16x8 pf[2][2];
  for (int t = 0; t <= ntile; t++) {
    const bool more = t + 1 < ntile;
    if (more) tile_load(t + 1);
    if (lag && t > 0) fs_pv<128>(pf, VB(t - 1), o, lane);
    if (t < ntile) {
      f32x16 sc[2];
      fs_scores<false>(KB(t) + map * 64 * LROW, qf, sc, lane, 0, 0, T);
      fs_softmax<128>(sc, m, ls, o, pf, lane);
      if (!lag) fs_pv<128>(pf, VB(t), o, lane);
    }
    if (more) tile_store(t + 1);
    __syncthreads();
  }
  float* xch = (float*)sm;
  if (map == 1) {
    const float inv = lam / ls;
#pragma unroll
    for (int ds = 0; ds < 4; ds++)
#pragma unroll
      for (int e = 0; e < 16; e++) xch[((qg * 64) + ds * 16 + e) * 64 + lane] = o[ds][e] * inv;
  }
  __syncthreads();
  if (map == 0) {
    const float i0 = 1.f / ls;
    float ss = 0.f;
#pragma unroll
    for (int ds = 0; ds < 4; ds++)
#pragma unroll
      for (int e = 0; e < 16; e++) {
        float v = o[ds][e] * i0 - xch[((qg * 64) + ds * 16 + e) * 64 + lane];
        o[ds][e] = v; ss += v * v;
      }
    ss += shflx(ss, 32, lane);
    const float rinv = rsqrtf(ss * (1.f / 128.f) + EPS) * (1.f - lam_init);
    const float* sg = p.subln_c + l * 128;
#pragma unroll
    for (int ds = 0; ds < 4; ds++)
#pragma unroll
      for (int g = 0; g < 4; g++) {
        int d = ds * 32 + 8 * g + 4 * h;
        uint2 gv = *(const uint2*)(p.P + prow + C_GC + hd * 128 + d);
        float4 sl = *(const float4*)(sg + d);
        uint2 ov;
        ov.x = pack2(o[ds][4 * g] * rinv * sl.x * lo_bf(gv.x), o[ds][4 * g + 1] * rinv * sl.y * hi_bf(gv.x));
        ov.y = pack2(o[ds][4 * g + 2] * rinv * sl.z * lo_bf(gv.y), o[ds][4 * g + 3] * rinv * sl.w * hi_bf(gv.y));
        *(uint2*)(p.GB + (size_t)2 * NTOK * 512 + tm_off(rowbase + q0 + r, hd * 128 + d, 8)) = ov;
      }
  }
}

__device__ __forceinline__ void lru_run(const Params& p, int l, bool pass2, int start, int G, float* sm, bool dry = false) {
  const int tid = TIDX;
  const int lane = tid & 63, wid = tid >> 6, r = lane & 31, h = lane >> 5;
  const int n = start & 7;
  float* xin = sm;
  float* xb = sm + 67 * 64;
  float* comb = xb + 64 * 64;
  float* carry = comb + 2048;
  float* parts = carry + 128;
  float* ab = parts + 1024;
  u16* xbh = (u16*)(ab + 4 * 4096);
  const int gd = wid >> 2, gth = (wid >> 1) & 1, gdh = wid & 1;
  bf16x8 wfa[4], wfx[4];
  {
    const u16* wbase = p.Wt_lru + ((size_t)(((l * 2 + gd) * 8 + n) * 2) * 64 + gdh * 32 + r) * 64 + h * 8;
#pragma unroll
    for (int ks = 0; ks < 4; ks++) { wfa[ks] = *(const bf16x8*)(wbase + ks * 16); wfx[ks] = *(const bf16x8*)(wbase + 4096 + ks * 16); }
  }
  const int gch = n * 64 + gdh * 32 + r;
  const float g_ba = p.lru_ba[(l * 2 + gd) * 512 + gch], g_bx = p.lru_bx[(l * 2 + gd) * 512 + gch];
  const float g_sp = log1pf(__expf(-p.lru_lam[(l * 2 + gd) * 512 + gch]));
  const int cc = tid & 63;
  float cw[4]; float cbv;
  {
    const float* cwp = p.conv_w + l * 4 * 512 + n * 64 + cc;
    cw[0] = cwp[0]; cw[1] = cwp[512]; cw[2] = cwp[1024]; cw[3] = cwp[1536];
    cbv = p.conv_b[l * 512 + n * 64 + cc];
  }
  const int dout = tid & 63, tg = tid >> 6;
  const int ch = n * 64 + dout;

  u16 xr[9];
  auto xin_load = [&](int it_) {
    const int row0_ = (it_ >> 3) * 64;
    int T_, seq0_;
    if (row0_ < NCTX) { T_ = 256; seq0_ = (row0_ >> 8) * 256; } else { T_ = 4096; seq0_ = NCTX + ((row0_ - NCTX) >> 12) * 4096; }
    const int t0_ = row0_ - seq0_;
#pragma unroll
    for (int k = 0; k < 9; k++) {
      const int rr = (tid >> 6) + 8 * k; const int t = t0_ - 2 + rr;
      u16 v = 0;
      if (rr < 67 && t >= 0 && t < T_) v = p.P[(size_t)(seq0_ + t) * PP + C_XB + n * 64 + cc];
      xr[k] = v;
    }
  };
  if (start < 1536) xin_load(start);
  for (int it = start; it < 1536; it += G) {
    const int ci = it >> 3;
    const int row0 = ci * 64;
    const bool isctx = row0 < NCTX;
    int T, seq0, bidx;
    if (isctx) { T = 256; bidx = row0 >> 8; seq0 = bidx * 256; }
    else { T = 4096; bidx = (row0 - NCTX) >> 12; seq0 = NCTX + bidx * 4096; }
    const int t0 = row0 - seq0;
    __syncthreads();
#pragma unroll
    for (int k = 0; k < 9; k++) { const int rr = (tid >> 6) + 8 * k; if (rr < 67) xin[rr * 64 + cc] = bf2f(xr[k]); }
    if (it + G < 1536) xin_load(it + G);
    u16 sgr[8];
    if (pass2) {
#pragma unroll
      for (int tt = 0; tt < 8; tt++) sgr[tt] = p.P[(size_t)(row0 + tg * 8 + tt) * PP + C_GB + ch];
    }
    if (pass2) {
      const int d = (tid >> 6) & 1, part = tid >> 7;
      const int cfirst = seq0 >> 6, clast = (seq0 + T - 64) >> 6;
      const int K = d ? (clast - ci) : (ci - cfirst);
      float2 q[16];
#pragma unroll
      for (int k = 0; k < 16; k++) {
        const int kk = part * 16 + k;
        const int cj = d ? (clast - kk) : (cfirst + kk);
        q[k] = make_float2(1.f, 0.f);
        if (kk < K) q[k] = *(const float2*)(p.lruTot + ((size_t)(cj * 2 + d) * 512 + n * 64 + cc) * 2);
      }
      float At = 1.f, Bt = 0.f;
#pragma unroll
      for (int k = 0; k < 16; k++) { Bt = q[k].x * Bt + q[k].y; At *= q[k].x; }
      parts[((part * 2 + d) * 64 + cc) * 2] = At; parts[((part * 2 + d) * 64 + cc) * 2 + 1] = Bt;
    }
    __syncthreads();
    for (int e = tid; e < 64 * 64; e += NT) {
      int t = e >> 6;
      float v = cbv;
#pragma unroll
      for (int j = 0; j < 4; j++) v += xin[(t + j) * 64 + cc] * cw[j];
      xb[e] = v;
      xbh[t * LROW + cc] = f2bf(v);
    }
    if (pass2 && tid < 128) {
      const int d = tid >> 6;
      float hcar = isctx ? 0.f : p.state_lru[((size_t)(bidx * 2 + l) * 2 + d) * 512 + n * 64 + cc];
#pragma unroll
      for (int part = 0; part < 4; part++) hcar = parts[((part * 2 + d) * 64 + cc) * 2] * hcar + parts[((part * 2 + d) * 64 + cc) * 2 + 1];
      carry[d * 64 + cc] = hcar;
    }
    __syncthreads();
    {
      bf16x8 af[4];
#pragma unroll
      for (int ks = 0; ks < 4; ks++) af[ks] = *(const bf16x8*)(xbh + (gth * 32 + r) * LROW + ks * 16 + h * 8);
      f32x16 ga, gi;
#pragma unroll
      for (int e = 0; e < 16; e++) { ga[e] = 0.f; gi[e] = 0.f; }
#pragma unroll
      for (int ks = 0; ks < 4; ks++) { ga = mfma32(af[ks], wfa[ks], ga); gi = mfma32(af[ks], wfx[ks], gi); }
      const int dch = gdh * 32 + r;
#pragma unroll
      for (int e = 0; e < 16; e++) {
        const int tok = gth * 32 + (e & 3) + 8 * (e >> 2) + 4 * h;
        float rg = sigmoidf_(ga[e] + g_ba), ig = sigmoidf_(gi[e] + g_bx);
        float log_a = -8.f * rg * g_sp;
        float a = __expf(log_a);
        float bb = sqrtf(-expm1f(2.f * log_a)) * ig * xb[tok * 64 + dch];
        ab[((gd * 2 + 0) * 64 + tok) * 64 + dch] = a;
        ab[((gd * 2 + 1) * 64 + tok) * 64 + dch] = bb;
      }
    }
    __syncthreads();
    float av[2][8], bv[2][8];
#pragma unroll
    for (int d = 0; d < 2; d++)
#pragma unroll
      for (int tt = 0; tt < 8; tt++) {
        av[d][tt] = ab[((d * 2 + 0) * 64 + tg * 8 + tt) * 64 + dout];
        bv[d][tt] = ab[((d * 2 + 1) * 64 + tg * 8 + tt) * 64 + dout];
      }
    float sA0 = 1.f, sB0 = 0.f, sA1 = 1.f, sB1 = 0.f;
#pragma unroll
    for (int tt = 0; tt < 8; tt++) { sB0 = av[0][tt] * sB0 + bv[0][tt]; sA0 *= av[0][tt]; }
#pragma unroll
    for (int tt = 7; tt >= 0; tt--) { sB1 = av[1][tt] * sB1 + bv[1][tt]; sA1 *= av[1][tt]; }
    comb[((tg * 2 + 0) * 64 + dout) * 2 + 0] = sA0; comb[((tg * 2 + 0) * 64 + dout) * 2 + 1] = sB0;
    comb[((tg * 2 + 1) * 64 + dout) * 2 + 0] = sA1; comb[((tg * 2 + 1) * 64 + dout) * 2 + 1] = sB1;
    __syncthreads();
    if (!pass2) {
      if (tid < 128) {
        int d = tid >> 6, c = tid & 63;
        float At = 1.f, Bt = 0.f;
#pragma unroll
        for (int s = 0; s < 8; s++) {
          int g = (d == 0) ? s : 7 - s;
          float a = comb[((g * 2 + d) * 64 + c) * 2], bq = comb[((g * 2 + d) * 64 + c) * 2 + 1];
          Bt = a * Bt + bq; At *= a;
        }
        float* o = p.lruTot + ((size_t)(ci * 2 + d) * 512 + n * 64 + c) * 2;
        o[0] = At; o[1] = Bt;
      }
      continue;
    }
    float h0 = carry[dout], h1 = carry[64 + dout];
    for (int g = 0; g < tg; g++) { h0 = comb[((g * 2 + 0) * 64 + dout) * 2] * h0 + comb[((g * 2 + 0) * 64 + dout) * 2 + 1]; }
    for (int g = 7; g > tg; g--) { h1 = comb[((g * 2 + 1) * 64 + dout) * 2] * h1 + comb[((g * 2 + 1) * 64 + dout) * 2 + 1]; }
    float y[8];
#pragma unroll
    for (int tt = 0; tt < 8; tt++) { h0 = av[0][tt] * h0 + bv[0][tt]; y[tt] = h0; }
    const float hf_last = h0;
#pragma unroll
    for (int tt = 7; tt >= 0; tt--) { h1 = av[1][tt] * h1 + bv[1][tt]; y[tt] += h1; }
    const float hb_first = h1;
    if (isctx) {
      if (t0 + 64 == T && tg == 7) p.out[O_ST + ((size_t)(bidx * 2 + l) * 2 + 0) * 512 + ch] = hf_last;
      if (t0 == 0 && tg == 0) p.out[O_ST + ((size_t)(bidx * 2 + l) * 2 + 1) * 512 + ch] = hb_first;
    }
#pragma unroll
    for (int tt = 0; tt < 8; tt++) {
      const int rw = row0 + tg * 8 + tt;
      p.GB[(size_t)NTOK * 512 + tm_off(rw, ch, 8)] = f2bf(y[tt] * bf2f(sgr[tt]));
    }
  }
}

__device__ __forceinline__ float compute_lam(const Params& p, int l, float lam_init) {
  float s1 = 0.f, s2 = 0.f;
  for (int i = 0; i < 64; i++) {
    s1 += p.lam_q1[l * 64 + i] * p.lam_k1[l * 64 + i];
    s2 += p.lam_q2[l * 64 + i] * p.lam_k2[l * 64 + i];
  }
  return expf(s1) - expf(s2) + lam_init;
}

__device__ __forceinline__ float mix_phase(const Params& p, int l, u16* smem, int vid) {
  unsigned long long tm0 = 0; float tres = 0.f; if (PROBE >= 30) tm0 = __builtin_amdgcn_s_memrealtime();
  const float lam_init = (l == 0) ? 0.2f : (0.8f - 0.6f * 0.74081822068f);
  const float lam = compute_lam(p, l, lam_init);
  constexpr int N_CL = 256, N_A = 384, N_CC = 128, N_L = 1536;
  const int G = gridDim.x;
  int start = vid;
  for (int it = start; it < N_CL; it += G) attnC_item(p, l, 128 + it, smem, lam, lam_init);
  if (PROBE == 35) tres = (float)(__builtin_amdgcn_s_memrealtime() - tm0) / 40000.f;
  start = (int)((vid + G - (N_CL % G)) % G);
  for (int it = start; it < N_A; it += G) attnA_item(p, l, it, smem);
  start = (int)((vid + G - ((N_CL + N_A) % G)) % G);
  for (int it = start; it < N_CC; it += G) attnC_item(p, l, it, smem, lam, lam_init);
  if (PROBE == 36) tres = (float)(__builtin_amdgcn_s_memrealtime() - tm0) / 40000.f;
  start = (int)((vid + G - ((N_CL + N_A + N_CC) % G)) % G);
  if (PROBE == 6) lru_run(p, l, false, start, G, (float*)smem);
  lru_run(p, l, false, start, G, (float*)smem);
  return tres;
}

__device__ __forceinline__ void lru2_phase(const Params& p, int l, u16* smem) {
  lru_run(p, l, true, blockIdx.x, gridDim.x, (float*)smem);
}

#define XB_TMO      128
#define XB_XCNT(j)  (256  + 64 * (j))
#define XB_XSUB(j)  (1280 + 64 * (j))
#define XB_XGEN(j)  (2304 + 64 * (j))
#define XB_TOP      3328
#define XB_TOPGEN   3392
#define XCD_BAR_WORDS 3456
#define XB_SPIN_CAP (1u << 18)
__device__ __forceinline__ unsigned xb_ld(unsigned* p)              { return __hip_atomic_load(p, __ATOMIC_RELAXED, __HIP_MEMORY_SCOPE_AGENT); }
__device__ __forceinline__ unsigned xb_add(unsigned* p, unsigned v) { return __hip_atomic_fetch_add(p, v, __ATOMIC_RELAXED, __HIP_MEMORY_SCOPE_AGENT); }
__device__ __forceinline__ unsigned xb_xcc_id() { return (unsigned)__builtin_amdgcn_s_getreg((3 << 11) | 20) & 0xFu; }
#define XB_SPIN(cond, bar) do { unsigned _sp = 0; while (cond) { __builtin_amdgcn_s_sleep(1); \
    if ((++_sp & 255u) == 0u) { if (xb_ld(&(bar)[XB_TMO])) break; if (_sp > XB_SPIN_CAP) { atomicAdd(&(bar)[XB_TMO], 1u); break; } } } } while (0)
struct XcdBarrier { unsigned* bar; unsigned x; volatile LAS unsigned* st; };
__device__ __forceinline__ XcdBarrier xcd_barrier_post(unsigned* bar, volatile LAS unsigned* st) {
  XcdBarrier b; b.bar = bar; b.x = xb_xcc_id(); b.st = st;
  if (threadIdx.x == 0) st[2] = xb_add(&bar[XB_XCNT(b.x)], 1u);
  return b;
}
__device__ __forceinline__ int xcd_virtual_id(const XcdBarrier& b) {
  if (threadIdx.x == 0) {
    unsigned pre = 0;
#pragma unroll
    for (unsigned j = 0; j < 16; ++j) { const unsigned c = xb_ld(&b.bar[XB_XCNT(j)]); pre += (j < b.x) ? c : 0u; }
    b.st[3] = pre + b.st[2];
  }
  __syncthreads();
  const int v = (int)b.st[3];
  __syncthreads();
  return __builtin_amdgcn_readfirstlane(v);
}
__device__ __forceinline__ void xcd_barrier_complete(unsigned* bar, unsigned x, unsigned& nloc, unsigned& nx) {
  const unsigned G = gridDim.x * gridDim.y * gridDim.z;
  unsigned sum, cnt, mine, sp = 0u;
  for (;;) {
    sum = 0u; cnt = 0u; mine = 0u;
#pragma unroll
    for (unsigned j = 0; j < 16; ++j) { const unsigned c = xb_ld(&bar[XB_XCNT(j)]); sum += c; cnt += (c > 0u) ? 1u : 0u; mine = (j == x) ? c : mine; }
    if (sum == G) break;
    __builtin_amdgcn_s_sleep(1);
    if ((++sp & 255u) == 0u) { if (xb_ld(&bar[XB_TMO])) break; if (sp > XB_SPIN_CAP) { atomicAdd(&bar[XB_TMO], 1u); break; } }
  }
  nloc = mine > 0u ? mine : 1u; nx = cnt > 0u ? cnt : 1u;
}
__device__ __forceinline__ void xcd_barrier(const XcdBarrier& b) {
  asm volatile("s_waitcnt vmcnt(0)" ::: "memory");
  __syncthreads();
  if (threadIdx.x == 0) {
    unsigned* bar = b.bar;
    __builtin_amdgcn_s_waitcnt(0);
    unsigned nloc = b.st[0], nx = b.st[1];
    if (nloc == 0u) { xcd_barrier_complete(bar, b.x, nloc, nx); b.st[0] = nloc; b.st[1] = nx; }
    const unsigned old = xb_add(&bar[XB_XSUB(b.x)], 1u);
    const unsigned gen = old / nloc;
    if (old + 1u == (gen + 1u) * nloc) {
      __builtin_amdgcn_fence(__ATOMIC_RELEASE, "agent");
      asm volatile("s_waitcnt vmcnt(0)" ::: "memory");
      const unsigned og = xb_add(&bar[XB_TOP], 1u);
      const unsigned tg = og / nx;
      if (og + 1u == (tg + 1u) * nx) xb_add(&bar[XB_TOPGEN], 1u);
      else XB_SPIN(xb_ld(&bar[XB_TOPGEN]) == tg, bar);
      __builtin_amdgcn_fence(__ATOMIC_ACQUIRE, "agent");
      xb_add(&bar[XB_XGEN(b.x)], 1u);
      asm volatile("s_waitcnt vmcnt(0)" ::: "memory");
    } else {
      XB_SPIN(xb_ld(&bar[XB_XGEN(b.x)]) == gen, bar);
      __builtin_amdgcn_fence(__ATOMIC_ACQUIRE, "agent");
      asm volatile("s_waitcnt vmcnt(0)" ::: "memory");
    }
  }
  __syncthreads();
}

typedef __attribute__((address_space(4))) const Params CParams;
__device__ __forceinline__ const Params& get_params() {
  CParams* kp = (CParams*)__builtin_amdgcn_kernarg_segment_ptr();
  asm volatile("" : "+s"(kp));
  return *(const Params*)kp;
}
__global__ void __launch_bounds__(NT, 2) fwd_kernel(Params p_unused) {
  extern __shared__ __attribute__((aligned(16))) unsigned char lds_raw[];
  u16* smem = (u16*)lds_raw;
  LAS unsigned char* lds = (LAS unsigned char*)lds_raw;
  cg::grid_group grid = cg::this_grid();
  volatile LAS unsigned* xst = (volatile LAS unsigned*)(lds + STAGE_BYTES + SPARE_BYTES);
  if (threadIdx.x == 0) { xst[0] = 0u; xst[1] = 0u; }
  __syncthreads();
  XcdBarrier xb = xcd_barrier_post(get_params().bar, xst);
  float tfrac = 0.f;
  unsigned long long tq0 = 0; if (PROBE >= 30) tq0 = __builtin_amdgcn_s_memrealtime();
  prologue_phase(get_params(), (float*)smem);
  if (PROBE == 30) tfrac = (float)(__builtin_amdgcn_s_memrealtime() - tq0) / 40000.f;
  grid.sync();
  if (PROBE == 31) tfrac = (float)(__builtin_amdgcn_s_memrealtime() - tq0) / 40000.f;
  const int vid = xcd_virtual_id(xb);
  if (PROBE == 9) { for (int i = 0; i < 10; i++) xcd_barrier(xb); }
#pragma unroll 1
  for (int l = 0; l < 2; l++) {
    if (PROBE >= 30) tq0 = __builtin_amdgcn_s_memrealtime();
    norm_phase(get_params(), l);
    if (PROBE == 32 && l == 0) tfrac = (float)(__builtin_amdgcn_s_memrealtime() - tq0) / 40000.f;
    if (PROBE == 3) { norm_phase(get_params(), l); if (l == 0) { xcd_barrier(xb); prologue_phase(get_params(), (float*)smem); } }
    xcd_barrier(xb);
    {
      const Params& p = get_params();
      SchedStd S; S.nM = NTOK / 256; S.nN = INC / 256; S.nwg = S.nM * S.nN; S.G = gridDim.x; S.c = vid;
      S.A = (const char*)p.H; S.B = (const char*)(p.Wt_in + (size_t)l * INC * 1024); S.tA = (size_t)256 * 1024 * 2; S.tB = (size_t)256 * 1024 * 2;
      EpiInproj E; E.pp = &p; E.l = l; E.part = (LAS float*)(lds + STAGE_BYTES);
      { float tr = gemm_phase(lds, 1024, S, E, PROBE == 22); if (l == 0 && (PROBE == 21 || PROBE == 22)) tfrac = tr; }
      if (PROBE == 1) { __syncthreads(); gemm_phase(lds, 1024, S, E); }
    }
    xcd_barrier(xb);
    if (PROBE >= 30) tq0 = __builtin_amdgcn_s_memrealtime();
    { float tr = mix_phase(get_params(), l, smem, vid); if ((PROBE == 35 || PROBE == 36) && l == 0) tfrac = tr; }
    if (PROBE == 33 && l == 0) tfrac = (float)(__builtin_amdgcn_s_memrealtime() - tq0) / 40000.f;
    xcd_barrier(xb);
    if (PROBE >= 30) tq0 = __builtin_amdgcn_s_memrealtime();
    lru2_phase(get_params(), l, smem);
    if (PROBE == 34 && l == 0) tfrac = (float)(__builtin_amdgcn_s_memrealtime() - tq0) / 40000.f;
    xcd_barrier(xb);
    {
      const Params& p = get_params();
      SchedBranch S; S.G = gridDim.x; S.c = vid; S.P_ = (const char*)p.GB; S.W_ = (const char*)(p.Wt_br + (size_t)l * 3 * 1024 * 512);
      EpiBranch E; E.pp = &p;
      { float tr = gemm_phase(lds, 512, S, E, PROBE == 24); if (l == 0 && (PROBE == 23 || PROBE == 24)) tfrac = tr; }
      if (PROBE == 2) { __syncthreads(); gemm_phase(lds, 512, S, E); }
    }
    xcd_barrier(xb);
    {
      const Params& p = get_params();
      SchedStd S; S.nM = NTOK / 256; S.nN = 4; S.nwg = S.nM * S.nN; S.G = gridDim.x; S.c = vid;
      S.A = (const char*)p.Y; S.B = (const char*)(p.Wt_out + (size_t)l * 1024 * 1024); S.tA = (size_t)256 * 1024 * 2; S.tB = (size_t)256 * 1024 * 2;
      EpiOut E; E.pp = &p; E.l = l;
      { float tr = gemm_phase(lds, 1024, S, E, PROBE == 26); if (l == 0 && (PROBE == 25 || PROBE == 26)) tfrac = tr; }
      if (PROBE == 8 && l == 0) { __syncthreads(); gemm_phase(lds, 1024, S, E); }
    }
    if (l == 0) xcd_barrier(xb);
  }
  if (PROBE >= 20) {
    xcd_barrier(xb);
    if (blockIdx.x == 0 && threadIdx.x == 0) { float* o = get_params().out + O_X + 4194304; *o += 0.42f + 0.45f * fminf(fmaxf(tfrac, 0.f), 1.f); }
  }
}

extern "C" void kernel_launch(void* const* d_in, const int* in_sizes, int n_in, void* d_out, int out_size, void* d_ws,
                              size_t ws_size, hipStream_t stream) {
  Params p{};
  const float** ip = (const float**)&p;
  for (int i = 0; i < 34; i++) ip[i] = (const float*)d_in[i];
  p.out = (float*)d_out;
  char* w = (char*)d_ws; size_t off = 0;
  auto take = [&](size_t bytes) { char* q = w + off; off += (bytes + 255) & ~(size_t)255; return q; };
  p.Wt_in = (u16*)take((size_t)2 * INC * 1024 * 2);
  p.Wt_br = (u16*)take((size_t)6 * 1024 * 512 * 2);
  p.Wt_out = (u16*)take((size_t)2 * 1024 * 1024 * 2);
  p.Y = (u16*)take((size_t)NTOK * 1024 * 2);
  p.P = (u16*)take((size_t)NTOK * PP * 2);
  p.VtA_ctx = p.Y;
  p.VtA_lat = p.VtA_ctx + (size_t)16 * 2 * 64 * 256;
  p.VtC_ctx = p.VtA_lat + (size_t)2 * 2 * 64 * 4096;
  p.VtC_lat = p.VtC_ctx + (size_t)16 * 4 * 128 * 256;
  p.cKa = (u16*)take((size_t)2 * 2 * 512 * 128 * 2);
  p.cVtA = (u16*)take((size_t)2 * 2 * 512 * 128 * 2);
  p.cKc = (u16*)take((size_t)2 * 2 * 512 * 512 * 2);
  p.cVtC = (u16*)take((size_t)2 * 2 * 512 * 512 * 2);
  p.mod = (float*)take((size_t)2 * 3 * 3072 * 4);
  p.rope = (float*)take((size_t)2048 * 4);
  p.lruTot = (float*)take((size_t)192 * 2 * 512 * 2 * 4);
  p.Wt_lru = (u16*)take((size_t)2 * 2 * 8 * 2 * 64 * 64 * 2);
  p.bar = (unsigned*)take((size_t)XCD_BAR_WORDS * 4);
  p.GB = (u16*)take((size_t)3 * NTOK * 512 * 2);
  p.H = p.GB;
  p.MG = (unsigned*)take((size_t)48 * 4 * 3 * 16384 * 4);
  static int grid_blocks = 0;
  if (!grid_blocks) {
    int dev = 0, cus = 0;
    hipGetDevice(&dev);
    hipDeviceGetAttribute(&cus, hipDeviceAttributeMultiprocessorCount, dev);
    hipFuncSetAttribute((const void*)fwd_kernel, hipFuncAttributeMaxDynamicSharedMemorySize, LDS_BYTES);
    int per_cu = 0;
    hipOccupancyMaxActiveBlocksPerMultiprocessor(&per_cu, (const void*)fwd_kernel, NT, LDS_BYTES);
    (void)hipGetLastError();
    grid_blocks = cus;
  }
  hipMemsetAsync(p.bar, 0, (size_t)XCD_BAR_WORDS * 4, stream);
  void* args[] = {&p};
  hipLaunchCooperativeKernel((void*)fwd_kernel, dim3(grid_blocks), dim3(NT), args, LDS_BYTES, stream);
}
```

```cpp
#include <hip/hip_runtime.h>
#include <hip/hip_cooperative_groups.h>
#include <stdint.h>
#include <math.h>
namespace cg = cooperative_groups;

typedef unsigned short u16;
typedef __attribute__((ext_vector_type(8))) short bf16x8;
typedef __attribute__((ext_vector_type(4))) short bf16x4;
typedef __attribute__((ext_vector_type(16))) float f32x16;
typedef __attribute__((ext_vector_type(4))) float f32x4;
#define LAS __attribute__((address_space(3)))

#ifndef PROBE
#define PROBE 0
#endif
#define NT 512
constexpr int NTOK = 12288, NCTX = 4096;
constexpr int INC = 7424;
constexpr int PP = 3712;
constexpr int C_QA = 0, C_KA = 512, C_GA = 640, C_XB = 1152, C_GB = 1664, C_QC = 2176, C_KC = 2688, C_GC = 3200;
constexpr int LROW = 72;
constexpr int VROW = 68;
constexpr float EPS = 1e-6f;
constexpr int STAGE_BYTES = 131072;
constexpr int SPARE_BYTES = 8192;
constexpr int LDS_BYTES = STAGE_BYTES + SPARE_BYTES + 16;

constexpr size_t O_X = 0, O_KA = 12582912, O_VA = 13631488, O_KC = 14680064, O_VC = 18874368, O_ST = 23068672;

struct Params {
  const float *x_prompt, *x_sample, *cache_a_k, *cache_a_v, *cache_c_k, *cache_c_v, *state_lru, *c, *c_ctx,
      *norm_g, *mod_w, *mod_b, *w_in, *qn_a, *kn_a, *sink_a, *conv_w, *conv_b, *lru_wa, *lru_ba, *lru_wx, *lru_bx,
      *lru_lam, *qn_c, *kn_c, *lam_q1, *lam_k1, *lam_q2, *lam_k2, *subln_c, *w_br_a, *w_br_b, *w_br_c, *w_out;
  float* out;
  u16 *Wt_in, *Wt_br, *Wt_out, *H, *P, *VtA_ctx, *VtA_lat, *VtC_ctx, *VtC_lat, *cKa, *cVtA, *cKc, *cVtC;
  float *mod, *rope, *lruTot;
  u16 *Wt_lru;
  unsigned* bar;
  u16* Y;
  u16* GB;
  unsigned* MG;
};

__device__ __forceinline__ int tid_opaque() { int t = (int)threadIdx.x; asm volatile("" : "+v"(t)); return t; }
#define TIDX tid_opaque()
__device__ __forceinline__ u16 f2bf(float f) {
  uint32_t u = __float_as_uint(f);
  u += 0x7FFFu + ((u >> 16) & 1u);
  return (u16)(u >> 16);
}
__device__ __forceinline__ float bf2f(u16 h) { return __uint_as_float(((uint32_t)h) << 16); }
__device__ __forceinline__ uint32_t pack2(float a, float b) { uint32_t r; asm("v_cvt_pk_bf16_f32 %0, %1, %2" : "=v"(r) : "v"(a), "v"(b)); return r; }
__device__ __forceinline__ float sigmoidf_(float x) { return 1.f / (1.f + __expf(-x)); }
__device__ __forceinline__ float siluf_(float x) { return x / (1.f + __expf(-x)); }
__device__ __forceinline__ f32x16 mfma32(bf16x8 a, bf16x8 b, f32x16 c) {
  return __builtin_amdgcn_mfma_f32_32x32x16_bf16(a, b, c, 0, 0, 0);
}
__device__ __forceinline__ float shflx(float v, int mask, int lane) {
  return __builtin_bit_cast(float, __builtin_amdgcn_ds_bpermute((lane ^ mask) << 2, __builtin_bit_cast(int, v)));
}
__device__ __forceinline__ float lo_bf(uint32_t w) { return __uint_as_float(w << 16); }
__device__ __forceinline__ float hi_bf(uint32_t w) { return __uint_as_float(w & 0xffff0000u); }

__device__ __forceinline__ size_t tm_off(int r, int k, int KT) {
  return ((size_t)((r >> 8) * KT + (k >> 6)) * 256 + (r & 255)) * 64 + (k & 63);
}
__device__ __forceinline__ void transpose_tile(const float* __restrict__ src, int spitch, u16* __restrict__ dst, int dpitch,
                               int r0, int c0, float* sm, int KT = 0) {
  const int tid = TIDX;
#pragma unroll
  for (int i = 0; i < 2; i++) {
    int c = tid + i * NT; int r = c >> 4, q = c & 15;
    float4 v = *(const float4*)(src + (size_t)(r0 + r) * spitch + c0 + q * 4);
    float* d = sm + r * 65 + q * 4;
    d[0] = v.x; d[1] = v.y; d[2] = v.z; d[3] = v.w;
  }
  __syncthreads();
  {
    int c = tid; int cc = c >> 3, q = c & 7;
    uint32_t w[4];
#pragma unroll
    for (int j = 0; j < 4; j++) w[j] = pack2(sm[(q * 8 + 2 * j) * 65 + cc], sm[(q * 8 + 2 * j + 1) * 65 + cc]);
    uint4 v; v.x = w[0]; v.y = w[1]; v.z = w[2]; v.w = w[3];
    if (KT) *(uint4*)(dst + tm_off(c0 + cc, r0 + q * 8, KT)) = v;
    else *(uint4*)(dst + (size_t)(c0 + cc) * dpitch + r0 + q * 8) = v;
  }
  __syncthreads();
}

__device__ __forceinline__ void transpose_wide(const float* __restrict__ src, int spitch, u16* __restrict__ dst,
                                               int k0, int n0, float* sm, int KT) {
  const int tid = TIDX;
  float4 v[8];
#pragma unroll
  for (int i = 0; i < 8; i++) { int c = tid + i * NT; int r = c >> 6, q = c & 63; v[i] = *(const float4*)(src + (size_t)(k0 + r) * spitch + n0 + q * 4); }
#pragma unroll
  for (int i = 0; i < 8; i++) { int c = tid + i * NT; int r = c >> 6, q = c & 63; float* d = sm + r * 257 + q * 4; d[0] = v[i].x; d[1] = v[i].y; d[2] = v[i].z; d[3] = v[i].w; }
  __syncthreads();
#pragma unroll
  for (int i = 0; i < 4; i++) {
    int c = tid + i * NT; int nn = c >> 3, q = c & 7;
    uint4 o;
    o.x = pack2(sm[(q * 8 + 0) * 257 + nn], sm[(q * 8 + 1) * 257 + nn]);
    o.y = pack2(sm[(q * 8 + 2) * 257 + nn], sm[(q * 8 + 3) * 257 + nn]);
    o.z = pack2(sm[(q * 8 + 4) * 257 + nn], sm[(q * 8 + 5) * 257 + nn]);
    o.w = pack2(sm[(q * 8 + 6) * 257 + nn], sm[(q * 8 + 7) * 257 + nn]);
    *(uint4*)(dst + tm_off(n0 + nn, k0 + q * 8, KT)) = o;
  }
  __syncthreads();
}

__device__ __forceinline__ void mod_item(const Params& p, int it, float* sm) {
  const int tid = TIDX;
  const int l = it / 48, n0 = (it % 48) * 64;
  float* sv = sm;
  float* red = sm + 3072;
  for (int e = tid; e < 3072; e += NT) {
    int v = e >> 10, k = e & 1023;
    float x = (v == 0) ? p.c_ctx[k] : p.c[(v - 1) * 1024 + k];
    sv[e] = siluf_(x);
  }
  __syncthreads();
  const int col = tid & 63, kg = tid >> 6;
  const float* w = p.mod_w + (size_t)l * 1024 * 3072 + n0 + col;
  float a0 = 0, a1 = 0, a2 = 0;
#pragma unroll 1
  for (int kb = kg * 128; kb < kg * 128 + 128; kb += 32) {
    float wv[32];
#pragma unroll
    for (int j = 0; j < 32; j++) wv[j] = w[(size_t)(kb + j) * 3072];
#pragma unroll
    for (int j = 0; j < 32; j++) { a0 += sv[kb + j] * wv[j]; a1 += sv[1024 + kb + j] * wv[j]; a2 += sv[2048 + kb + j] * wv[j]; }
  }
  red[(kg * 3 + 0) * 64 + col] = a0; red[(kg * 3 + 1) * 64 + col] = a1; red[(kg * 3 + 2) * 64 + col] = a2;
  __syncthreads();
  if (tid < 192) {
    int v = tid >> 6, c = tid & 63;
    float s = p.mod_b[l * 3072 + n0 + c];
#pragma unroll
    for (int g = 0; g < 8; g++) s += red[(g * 3 + v) * 64 + c];
    p.mod[(l * 3 + v) * 3072 + n0 + c] = s;
  }
  __syncthreads();
}

__device__ __forceinline__ void prologue_phase(const Params& p, float* sm) {
  constexpr int N_MOD = 96, N_ROPE = 1, N_WIN = 2 * 16 * 29, N_WBR = 6 * 8 * 4, N_WOUT = 2 * 16 * 4;
  constexpr int N_CK = 64 + 256, N_CVA = 4 * 16, N_CVC = 4 * 64, N_LW = 64;
  constexpr int E0 = N_MOD, E1 = E0 + N_ROPE, E2 = E1 + N_WIN, E3 = E2 + N_WBR, E4 = E3 + N_WOUT, E5 = E4 + N_CK,
                E6 = E5 + N_CVA, E7 = E6 + N_CVC, E8 = E7 + N_LW;
  const int tid = TIDX;
  for (int it = blockIdx.x; it < E8; it += gridDim.x) {
    if (it < E0) {
      mod_item(p, it, sm);
    } else if (it < E1) {
      for (int e = tid; e < 1024; e += NT) {
        int pos = e >> 4, f = e & 15;
        float inv = powf(10000.f, -(float)f / 16.f);
        float ang = (float)pos * inv;
        p.rope[e] = cosf(ang); p.rope[1024 + e] = sinf(ang);
      }
    } else if (it < E2) {
      int j = it - E1; int l = j / (16 * 29); int r = j % (16 * 29);
      int kt = r / 29, pn = r % 29;
      transpose_wide(p.w_in + (size_t)l * 1024 * INC, INC, p.Wt_in + (size_t)l * INC * 1024, kt * 64, pn * 256, sm, 16);
    } else if (it < E3) {
      int j = it - E2; int m = j / 32; int r = j % 32;
      int l = m / 3, i = m % 3;
      const float* src = (i == 0 ? p.w_br_a : (i == 1 ? p.w_br_b : p.w_br_c)) + (size_t)l * 512 * 1024;
      int kt = r / 4, pn = r % 4;
      transpose_wide(src, 1024, p.Wt_br + (size_t)m * 1024 * 512, kt * 64, pn * 256, sm, 8);
    } else if (it < E4) {
      int j = it - E3; int l = j / 64; int r = j % 64;
      int kt = r / 4, pn = r % 4;
      transpose_wide(p.w_out + (size_t)l * 1024 * 1024, 1024, p.Wt_out + (size_t)l * 1024 * 1024, kt * 64, pn * 256, sm, 16);
    } else if (it < E5) {
      int j = it - E4;
      const float* src; u16* dst; size_t off;
      if (j < 64) { src = p.cache_a_k; dst = p.cKa; off = (size_t)j * 4096; }
      else { src = p.cache_c_k; dst = p.cKc; off = (size_t)(j - 64) * 4096; }
      size_t e = off + (size_t)tid * 8;
      float4 a = *(const float4*)(src + e), b = *(const float4*)(src + e + 4);
      uint4 v; v.x = pack2(a.x, a.y); v.y = pack2(a.z, a.w); v.z = pack2(b.x, b.y); v.w = pack2(b.z, b.w);
      *(uint4*)(dst + e) = v;
    } else if (it < E6) {
      int j = it - E5; int bl = j / 16; int r = j % 16;
      int rt = r / 2, ct = r % 2;
      transpose_tile(p.cache_a_v + (size_t)bl * 512 * 128, 128, p.cVtA + (size_t)bl * 128 * 512, 512, rt * 64, ct * 64, sm);
    } else if (it < E7) {
      int j = it - E6; int bl = j / 64; int r = j % 64;
      int rt = r / 8, ct = r % 8;
      transpose_tile(p.cache_c_v + (size_t)bl * 512 * 512, 512, p.cVtC + (size_t)bl * 512 * 512, 512, rt * 64, ct * 64, sm);
    } else {
      int j = it - E7; int ldn = j >> 1, g = j & 1;
      transpose_tile((g ? p.lru_wx : p.lru_wa) + (size_t)ldn * 4096, 64, p.Wt_lru + (size_t)(ldn * 2 + g) * 4096, 64, 0, 0, sm);
    }
  }
}

__device__ __forceinline__ void norm_phase(const Params& p, int l) {
  const int tid = TIDX, lane = tid & 63, wid = tid >> 6;
  const float* g = p.norm_g + l * 1024;
  for (int it = blockIdx.x; it < NTOK / 8; it += gridDim.x) {
    int row = it * 8 + wid;
    const float* x;
    if (l == 0) x = (row < NCTX) ? p.x_prompt + (size_t)row * 1024 : p.x_sample + (size_t)(row - NCTX) * 1024;
    else x = p.out + O_X + (size_t)row * 1024;
    int v = (row < NCTX) ? 0 : 1 + (row - NCTX) / 4096;
    const float* md = p.mod + (l * 3 + v) * 3072;
    float4 xv[4]; float ss = 0;
#pragma unroll
    for (int i = 0; i < 4; i++) {
      xv[i] = *(const float4*)(x + i * 256 + lane * 4);
      ss += xv[i].x * xv[i].x + xv[i].y * xv[i].y + xv[i].z * xv[i].z + xv[i].w * xv[i].w;
    }
#pragma unroll
    for (int o = 32; o > 0; o >>= 1) ss += shflx(ss, o, lane);
    float rinv = rsqrtf(ss * (1.f / 1024.f) + EPS);
#pragma unroll
    for (int i = 0; i < 4; i++) {
      int c = i * 256 + lane * 4;
      float4 gv = *(const float4*)(g + c), sh = *(const float4*)(md + c), sc = *(const float4*)(md + 1024 + c);
      float h0 = xv[i].x * rinv * gv.x * (1.f + sc.x) + sh.x;
      float h1 = xv[i].y * rinv * gv.y * (1.f + sc.y) + sh.y;
      float h2 = xv[i].z * rinv * gv.z * (1.f + sc.z) + sh.z;
      float h3 = xv[i].w * rinv * gv.w * (1.f + sc.w) + sh.w;
      uint2 o2; o2.x = pack2(h0, h1); o2.y = pack2(h2, h3);
      *(uint2*)(p.H + tm_off(row, c, 16)) = o2;
    }
  }
}

constexpr int G_BK = 64, G_HALF = 128, G_HTB = G_HALF * G_BK * 2;
__device__ __forceinline__ int lds_byte(int r, int c) {
  const int st = (r >> 4) * 2 + (c >> 5), rr = r & 15, cc = c & 31, ob = rr * 64 + cc * 2;
  return st * 1024 + (ob ^ (((ob >> 9) & 1) << 5));
}
__device__ __forceinline__ void stage_rc(int b, int& R, int& C) {
  const int st = b / 1024, sb = b % 1024, swz = sb ^ (((sb >> 9) & 1) << 5);
  R = (st >> 1) * 16 + swz / 64; C = (st & 1) * 32 + (swz % 64) / 2;
}
struct Unit { int pm, pn, seg; };

struct SchedStd {
  int nM, nN, nwg, G, c; const char* A; const char* B; size_t tA, tB;
  __device__ __forceinline__ bool next(int i, Unit& u) const {
    const long L = (long)i * G + c; if (L >= nwg) return false;
    const int wgid = (int)L;
    const int nig = 8 * nN, gid = wgid / nig, fm = gid * 8, gsz = (nM - fm) < 8 ? (nM - fm) : 8;
    u.pm = fm + ((wgid % nig) % gsz); u.pn = (wgid % nig) / gsz; u.seg = 0; return true;
  }
  __device__ __forceinline__ const char* aptr(const Unit& u) const { return A + (size_t)u.pm * tA; }
  __device__ __forceinline__ const char* bptr(const Unit& u) const { return B + (size_t)u.pn * tB; }
};
struct SchedBranch {
  int G, c; const char* P_; const char* W_;
  __device__ __forceinline__ bool next(int i, Unit& u) const {
    if (G == 256) {
      if (i >= 3) return false;
      const int xcd = c >> 5, j = c & 31;
      if (j >= 24) return false;
      u.seg = i; u.pm = xcd * 6 + (j >> 2); u.pn = j & 3; return true;
    }
    const int tile = (i / 3) * G + c; if (tile >= 192) return false;
    u.seg = i % 3; u.pm = tile >> 2; u.pn = tile & 3; return true;
  }
  __device__ __forceinline__ const char* aptr(const Unit& u) const { return P_ + (size_t)((u.seg * 48 + u.pm) * 8) * 32768; }
  __device__ __forceinline__ const char* bptr(const Unit& u) const { return W_ + (size_t)((u.seg * 4 + u.pn) * 8) * 32768; }
};

template <class Epi, class Sched>
__device__ __forceinline__ float gemm_phase(LAS unsigned char* lds, const int K, const Sched& S, const Epi& E, int tmode = 0) {
  unsigned long long t_ph0 = 0, t_epi = 0; if (PROBE >= 20) t_ph0 = __builtin_amdgcn_s_memrealtime();
  const int tid = TIDX, wid = __builtin_amdgcn_readfirstlane(tid >> 6), lane = tid & 63, wr = wid >> 2, wc = wid & 3, fr = lane & 15, fq = lane >> 4;
  const int nt = K / G_BK;
  unsigned voffA[2], voffB[2];
#pragma unroll
  for (int i = 0; i < 2; ++i) { int R, C; stage_rc(tid * 16 + i * 8192, R, C);
    voffA[i] = (unsigned)(R * 64 + C) * 2u; voffB[i] = voffA[i]; }
  const size_t kstep = (size_t)32768;
  const size_t hA = (size_t)16384, hB = (size_t)16384;
  const unsigned ldsw = (unsigned)wid * 1024u;
  const int aoff = lds_byte(wr * 64 + fr, fq * 8), boff = lds_byte(wc * 32 + fr, fq * 8);
#define G_SA(b, h) (((b) * 2 + (h)) * G_HTB)
#define G_SB(b, h) ((4 + (b) * 2 + (h)) * G_HTB)
#define G_STAGE(bufoff, gbase, voff) do { _Pragma("unroll") for (int _i = 0; _i < 2; ++_i) \
    __builtin_amdgcn_global_load_lds((const unsigned*)((const char*)(gbase) + (voff)[_i]), (LAS unsigned*)(lds + (bufoff) + ldsw + _i * 8192), 16, 0, 0); } while (0)
#define G_LDA(dst, b, h) do { _Pragma("unroll") for (int m = 0; m < 4; ++m) _Pragma("unroll") for (int k = 0; k < 2; ++k) dst[m][k] = *(const LAS bf16x8*)(lds + G_SA(b, h) + aoff + m * 2048 + k * 1024); } while (0)
#define G_LDB(dst, b, h) do { _Pragma("unroll") for (int n = 0; n < 2; ++n) _Pragma("unroll") for (int k = 0; k < 2; ++k) dst[n][k] = *(const LAS bf16x8*)(lds + G_SB(b, h) + boff + n * 2048 + k * 1024); } while (0)
#define G_MMA(ai, bj, At, Bt) do { __builtin_amdgcn_s_setprio(1); _Pragma("unroll") for (int m = 0; m < 4; ++m) _Pragma("unroll") for (int n = 0; n < 2; ++n) _Pragma("unroll") for (int k = 0; k < 2; ++k) \
    acc[ai][bj][m][n] = __builtin_amdgcn_mfma_f32_16x16x32_bf16(Bt[n][k], At[m][k], acc[ai][bj][m][n], 0, 0, 0); __builtin_amdgcn_s_setprio(0); } while (0)
#define G_WAIT_V(n) asm volatile("s_waitcnt vmcnt(" #n ")" ::: "memory")
#define G_WAIT_L(n) asm volatile("s_waitcnt lgkmcnt(" #n ")" ::: "memory")
#define G_BAR __builtin_amdgcn_s_barrier()
#define G_SCHED __builtin_amdgcn_sched_barrier(0)
  Unit cur, nxt; int ui = 0;
  if (!S.next(0, cur)) return 0.f;
  f32x4 acc[2][2][4][2];
#pragma unroll
  for (int a = 0; a < 2; ++a)
#pragma unroll
    for (int b = 0; b < 2; ++b)
#pragma unroll
      for (int m = 0; m < 4; ++m)
#pragma unroll
        for (int n = 0; n < 2; ++n) acc[a][b][m][n] = (f32x4){0.f, 0.f, 0.f, 0.f};
  bf16x8 At[4][2], B0[2][2], B1[2][2];
  const char* cA = S.aptr(cur); const char* cB = S.bptr(cur);
  G_STAGE(G_SB(0, 0), cB, voffB); G_STAGE(G_SA(0, 0), cA, voffA); G_STAGE(G_SB(0, 1), cB + hB, voffB); G_STAGE(G_SA(0, 1), cA + hA, voffA);
  if (wr == 1) G_BAR;
  G_WAIT_V(4); G_BAR;
  G_STAGE(G_SB(1, 0), cB + kstep, voffB); G_STAGE(G_SA(1, 0), cA + kstep, voffA); G_STAGE(G_SB(1, 1), cB + hB + kstep, voffB);
  G_WAIT_V(6); G_BAR;
  for (;;) {
    const bool has_next = S.next(ui + 1, nxt);
    const char* nA = has_next ? S.aptr(nxt) : cA; const char* nB = has_next ? S.bptr(nxt) : cB;
    for (int t = 0; t < nt; t += 2) {
      const bool last = (t == nt - 2);
      const char* a1 = cA + (size_t)(t + 1) * kstep;
      const char* a2 = last ? nA : cA + (size_t)(t + 2) * kstep; const char* b2 = last ? nB : cB + (size_t)(t + 2) * kstep;
      const char* a3 = a2 + kstep; const char* b3 = b2 + kstep;
      G_LDB(B0, 0, 0); G_SCHED; G_LDA(At, 0, 0); G_STAGE(G_SA(1, 1), a1 + hA, voffA);
      G_WAIT_L(8); G_BAR; G_WAIT_L(0); G_MMA(0, 0, At, B0); G_BAR; G_SCHED;
      G_LDB(B1, 0, 1); G_STAGE(G_SB(0, 0), b2, voffB);
      G_BAR; G_WAIT_L(0); G_MMA(0, 1, At, B1); G_BAR;
      G_LDA(At, 0, 1); G_STAGE(G_SA(0, 0), a2, voffA);
      G_BAR; G_WAIT_L(0); G_MMA(1, 0, At, B0); G_BAR; G_SCHED;
      G_STAGE(G_SB(0, 1), b2 + hB, voffB);
      G_WAIT_V(6); G_BAR; G_MMA(1, 1, At, B1); G_BAR;
      G_LDB(B0, 1, 0); G_SCHED; G_LDA(At, 1, 0); G_STAGE(G_SA(0, 1), a2 + hA, voffA);
      G_WAIT_L(8); G_BAR; G_WAIT_L(0); G_MMA(0, 0, At, B0); G_BAR; G_SCHED;
      G_LDB(B1, 1, 1); G_STAGE(G_SB(1, 0), b3, voffB);
      G_BAR; G_WAIT_L(0); G_MMA(0, 1, At, B1); G_BAR;
      G_LDA(At, 1, 1); G_STAGE(G_SA(1, 0), a3, voffA);
      G_BAR; G_WAIT_L(0); G_MMA(1, 0, At, B0); G_BAR; G_SCHED;
      G_STAGE(G_SB(1, 1), b3 + hB, voffB);
      G_WAIT_V(6); G_BAR; G_MMA(1, 1, At, B1); G_BAR;
    }
    unsigned long long t_e0 = 0; if (PROBE >= 20) t_e0 = __builtin_amdgcn_s_memrealtime();
    const bool reset = E(acc, cur, wr, wc, fr, fq);
    if (PROBE >= 20) { asm volatile("s_waitcnt vmcnt(0)" ::: "memory"); t_epi += __builtin_amdgcn_s_memrealtime() - t_e0; }
    if (!has_next) break;
    if (reset) {
#pragma unroll
      for (int a = 0; a < 2; ++a)
#pragma unroll
        for (int b = 0; b < 2; ++b)
#pragma unroll
          for (int m = 0; m < 4; ++m)
#pragma unroll
            for (int n = 0; n < 2; ++n) acc[a][b][m][n] = (f32x4){0.f, 0.f, 0.f, 0.f};
    }
    cur = nxt; cA = nA; cB = nB; ++ui;
  }
  G_WAIT_V(0);
  if (wr == 0) G_BAR;
  G_BAR;
  float tres = 0.f;
  if (PROBE >= 20) {
    const unsigned long long tot = __builtin_amdgcn_s_memrealtime() - t_ph0;
    tres = (tmode == 0) ? (float)t_epi / (float)tot : (float)tot / 40000.f;
  }
#undef G_SA
#undef G_SB
#undef G_STAGE
#undef G_LDA
#undef G_LDB
#undef G_MMA
#undef G_WAIT_V
#undef G_WAIT_L
#undef G_BAR
#undef G_SCHED
  return tres;
}

struct EpiInproj {
  const Params* pp; int l; LAS float* part;
  __device__ __forceinline__ bool operator()(f32x4 (&acc)[2][2][4][2], const Unit& u, int wr, int wc, int fr, int fq) const {
    const Params& p = *pp;
    asm volatile("" : "+v"(fr), "+v"(fq));
    const int lane = fr + 16 * fq; (void)lane;
    const int oc0 = u.pn * 256;
    const bool isctx = u.pm < 16;
    const bool qkU = (oc0 < 768) || (oc0 >= 2304 && oc0 < 3328);
    float rinv[2][4][2];
    if (qkU) {
#pragma unroll
      for (int ai = 0; ai < 2; ai++)
#pragma unroll
        for (int m = 0; m < 4; m++)
#pragma unroll
          for (int bj = 0; bj < 2; bj++) {
            f32x4 a = acc[ai][bj][m][0], b = acc[ai][bj][m][1];
            float ss = a[0] * a[0] + a[1] * a[1] + a[2] * a[2] + a[3] * a[3] + b[0] * b[0] + b[1] * b[1] + b[2] * b[2] + b[3] * b[3];
            ss += shflx(ss, 16, lane); ss += shflx(ss, 32, lane);
            rinv[ai][m][bj] = ss;
            if (fq == 0) part[((ai * 128 + wr * 64 + m * 16 + fr) * 2 + bj) * 4 + wc] = ss;
          }
      asm volatile("s_waitcnt lgkmcnt(0)" ::: "memory");
      __builtin_amdgcn_s_barrier();
      asm volatile("" ::: "memory");
#pragma unroll
      for (int ai = 0; ai < 2; ai++)
#pragma unroll
        for (int m = 0; m < 4; m++)
#pragma unroll
          for (int bj = 0; bj < 2; bj++) {
            float o = part[((ai * 128 + wr * 64 + m * 16 + fr) * 2 + bj) * 4 + (wc ^ 1)];
            rinv[ai][m][bj] = rsqrtf((rinv[ai][m][bj] + o) * (1.f / 64.f) + EPS);
          }
    }
#pragma unroll
    for (int bj = 0; bj < 2; bj++) {
      const int oc = oc0 + bj * 128;
      if (oc == 640 || (oc >= 3328 && oc < 3840)) {
        const bool isA = (oc == 640);
        const int cb = isA ? 0 : (oc - 3328);
        const int nvec = isA ? 128 : 512;
#pragma unroll
        for (int ai = 0; ai < 2; ai++)
#pragma unroll
          for (int m = 0; m < 4; m++) {
            const int row = u.pm * 256 + ai * 128 + wr * 64 + m * 16 + fr;
            int b, t, T; u16* vt;
            if (isctx) { b = row >> 8; t = row & 255; T = 256; vt = isA ? p.VtA_ctx : p.VtC_ctx; }
            else { int rr = row - NCTX; b = rr >> 12; t = rr & 4095; T = 4096; vt = isA ? p.VtA_lat : p.VtC_lat; }
#pragma unroll
            for (int n = 0; n < 2; n++) {
              const int d = cb + wc * 32 + n * 16 + fq * 4;
              f32x4 v = acc[ai][bj][m][n];
#pragma unroll
              for (int j = 0; j < 4; j++) vt[((size_t)b * nvec + d + j) * T + t] = f2bf(v[j]);
              if (isctx) {
                float* o = p.out + (isA ? O_VA : O_VC) + ((size_t)(b * 2 + l) * 256 + t) * nvec + d;
                *(f32x4*)o = v;
              }
            }
          }
      } else {
        const int pc = (oc < 640) ? oc : (oc < 3328 ? oc - 128 : oc - 640);
        const bool is_qa = oc < 512, is_ka = (oc == 512);
        const bool is_qc = (oc >= 2304 && oc < 2816), is_kc = (oc >= 2816 && oc < 3328);
        if (is_qa || is_ka || is_qc || is_kc) {
          const float* gn = (is_qa ? p.qn_a : is_ka ? p.kn_a : is_qc ? p.qn_c : p.kn_c) + l * 64 + (wc & 1) * 32 + fq * 4;
          const f32x4 g0 = *(const f32x4*)gn, g1 = *(const f32x4*)(gn + 16);
          const float qs = (is_qa || is_qc) ? 0.18033688011112042f : 1.f;
#pragma unroll
          for (int ai = 0; ai < 2; ai++)
#pragma unroll
            for (int m = 0; m < 4; m++) {
              const int row = u.pm * 256 + ai * 128 + wr * 64 + m * 16 + fr;
              const float ri = rinv[ai][m][bj];
              f32x4 x1 = acc[ai][bj][m][0] * ri * g0, x2 = acc[ai][bj][m][1] * ri * g1;
              if (!isctx) {
                const int t = (row - NCTX) & 4095;
                const int pos = (wc & 1) ? (t & 63) : (t >> 6);
                const f32x4 cs = *(const f32x4*)(p.rope + pos * 16 + fq * 4), sn = *(const f32x4*)(p.rope + 1024 + pos * 16 + fq * 4);
                f32x4 y1 = x1 * cs - x2 * sn, y2 = x2 * cs + x1 * sn;
                x1 = y1; x2 = y2;
              } else if (is_ka || is_kc) {
                const int b = row >> 8, t = row & 255;
                float* o = is_ka ? p.out + O_KA + ((size_t)(b * 2 + l) * 256 + t) * 128 + wc * 32 + fq * 4
                                 : p.out + O_KC + ((size_t)(b * 2 + l) * 256 + t) * 512 + (oc - 2816) + wc * 32 + fq * 4;
                *(f32x4*)o = x1; *(f32x4*)(o + 16) = x2;
              }
              x1 = x1 * qs; x2 = x2 * qs;
              u16* po = p.P + (size_t)row * PP + pc + wc * 32 + fq * 4;
              *(uint2*)po = make_uint2(pack2(x1[0], x1[1]), pack2(x1[2], x1[3]));
              *(uint2*)(po + 16) = make_uint2(pack2(x2[0], x2[1]), pack2(x2[2], x2[3]));
            }
        } else {
          const int mode = (oc >= 4352) ? 2 : ((oc >= 1280 && oc < 1792) ? 0 : 1);
          if (mode == 2) {
            const int pj = u.pn - 17, seg = pj >> 2, pn4 = pj & 3;
            unsigned* mg = p.MG + ((size_t)((u.pm * 4 + pn4) * 3 + seg) * 8 + (wr * 4 + wc)) * 2048 + lane;
#pragma unroll
            for (int ai = 0; ai < 2; ai++)
#pragma unroll
              for (int m = 0; m < 4; m++)
#pragma unroll
                for (int n = 0; n < 2; n++) {
                  f32x4 v = acc[ai][bj][m][n];
                  const unsigned q0 = (unsigned)(sigmoidf_(v[0]) * 254.f + 1.5f), q1 = (unsigned)(sigmoidf_(v[1]) * 254.f + 1.5f);
                  const unsigned q2 = (unsigned)(sigmoidf_(v[2]) * 254.f + 1.5f), q3 = (unsigned)(sigmoidf_(v[3]) * 254.f + 1.5f);
                  mg[(((ai * 4 + m) * 2 + bj) * 2 + n) * 64] = q0 | (q1 << 8) | (q2 << 16) | (q3 << 24);
                }
          } else
#pragma unroll
          for (int ai = 0; ai < 2; ai++)
#pragma unroll
            for (int m = 0; m < 4; m++) {
              const int row = u.pm * 256 + ai * 128 + wr * 64 + m * 16 + fr;
              u16* po = p.P + (size_t)row * PP + pc + wc * 32 + fq * 4;
#pragma unroll
              for (int n = 0; n < 2; n++) {
                f32x4 v = acc[ai][bj][m][n];
                if (mode == 1) { v[0] = siluf_(v[0]); v[1] = siluf_(v[1]); v[2] = siluf_(v[2]); v[3] = siluf_(v[3]); }
                else if (mode == 2) { v[0] = sigmoidf_(v[0]); v[1] = sigmoidf_(v[1]); v[2] = sigmoidf_(v[2]); v[3] = sigmoidf_(v[3]); }
                *(uint2*)(po + n * 16) = make_uint2(pack2(v[0], v[1]), pack2(v[2], v[3]));
              }
            }
        }
      }
    }
    return true;
  }
};

struct EpiBranch {
  const Params* pp;
  __device__ __forceinline__ bool operator()(f32x4 (&acc)[2][2][4][2], const Unit& u, int wr, int wc, int fr, int fq) const {
    const Params& p = *pp;
    asm volatile("" : "+v"(fr), "+v"(fq));
    const int lane = fr + 16 * fq;
    const int seg = u.seg;
    const unsigned* mg = p.MG + ((size_t)((u.pm * 4 + u.pn) * 3 + seg) * 8 + (wr * 4 + wc)) * 2048 + lane;
#pragma unroll
    for (int ai = 0; ai < 2; ai++)
#pragma unroll
      for (int m = 0; m < 4; m++) {
        const int row = u.pm * 256 + ai * 128 + wr * 64 + m * 16 + fr;
#pragma unroll
        for (int bj = 0; bj < 2; bj++)
#pragma unroll
          for (int n = 0; n < 2; n++) {
            const int idx = (((ai * 4 + m) * 2 + bj) * 2 + n) * 64;
            const unsigned a = mg[idx];
            f32x4 f = {(float)(a & 255u), (float)((a >> 8) & 255u), (float)((a >> 16) & 255u), (float)(a >> 24)};
            if (seg < 2) {
              const unsigned b = mg[idx + 8 * 2048];
              f[0] = __fdividef(f[0], (float)(b & 255u)); f[1] = __fdividef(f[1], (float)((b >> 8) & 255u));
              f[2] = __fdividef(f[2], (float)((b >> 16) & 255u)); f[3] = __fdividef(f[3], (float)(b >> 24));
              acc[ai][bj][m][n] = acc[ai][bj][m][n] * f;
            } else {
              const int col = u.pn * 256 + bj * 128 + wc * 32 + n * 16 + fq * 4;
              f32x4 v = acc[ai][bj][m][n] * f * (1.f / 255.f);
              *(uint2*)(p.Y + tm_off(row, col, 16)) = make_uint2(pack2(v[0], v[1]), pack2(v[2], v[3]));
            }
          }
      }
    return seg == 2;
  }
};

struct EpiOut {
  const Params* pp; int l;
  __device__ __forceinline__ bool operator()(f32x4 (&acc)[2][2][4][2], const Unit& u, int wr, int wc, int fr, int fq) const {
    const Params& p = *pp;
    asm volatile("" : "+v"(fr), "+v"(fq));
    const int lane = fr + 16 * fq; (void)lane;
    const int v = (u.pm < 16) ? 0 : 1 + (u.pm - 16) / 16;
    const float* gt = p.mod + (l * 3 + v) * 3072 + 2048;
#pragma unroll
    for (int ai = 0; ai < 2; ai++)
#pragma unroll
      for (int m = 0; m < 4; m++) {
        const int row = u.pm * 256 + ai * 128 + wr * 64 + m * 16 + fr;
        const float* xr;
        if (l == 0) xr = (row < NCTX) ? p.x_prompt + (size_t)row * 1024 : p.x_sample + (size_t)(row - NCTX) * 1024;
        else xr = p.out + O_X + (size_t)row * 1024;
        float* orow = p.out + O_X + (size_t)row * 1024;
#pragma unroll
        for (int bj = 0; bj < 2; bj++)
#pragma unroll
          for (int n = 0; n < 2; n++) {
            const int col = u.pn * 256 + bj * 128 + wc * 32 + n * 16 + fq * 4;
            const f32x4 xv = *(const f32x4*)(xr + col), gv = *(const f32x4*)(gt + col);
            *(f32x4*)(orow + col) = xv + gv * acc[ai][bj][m][n];
          }
      }
    return true;
  }
};

template <bool MASK>
__device__ __forceinline__ void fs_scores(const u16* Ks, const bf16x8 (&qf)[4], f32x16 (&s)[2], int lane, int kpos0, int qpos, int T) {
  const int r = lane & 31, h = lane >> 5;
  {
    bf16x8 kf[2][4];
#pragma unroll
    for (int sub = 0; sub < 2; sub++)
#pragma unroll
      for (int ks = 0; ks < 4; ks++) kf[sub][ks] = *(const bf16x8*)(Ks + (sub * 32 + r) * LROW + ks * 16 + h * 8);
    __builtin_amdgcn_sched_barrier(0);
#pragma unroll
    for (int sub = 0; sub < 2; sub++) {
#pragma unroll
      for (int e = 0; e < 16; e++) s[sub][e] = 0.f;
#pragma unroll
      for (int ks = 0; ks < 4; ks++) s[sub] = mfma32(kf[sub][ks], qf[ks], s[sub]);
    }
  }
  if (MASK) {
#pragma unroll
    for (int sub = 0; sub < 2; sub++)
#pragma unroll
      for (int e = 0; e < 16; e++) {
        int kp = kpos0 + sub * 32 + (e & 3) + 8 * (e >> 2) + 4 * h;
        int dlt = kp - qpos;
        bool ok = (kp >= 0) && (kp < T) && (dlt <= 128) && (dlt >= -128);
        if (!ok) s[sub][e] = -INFINITY;
      }
  }
}
template <int DV>
__device__ __forceinline__ void fs_softmax(f32x16 (&s)[2], float& m, float& l, f32x16 (&o)[DV / 32], bf16x8 (&pf)[2][2], int lane) {
  float mx = s[0][0];
#pragma unroll
  for (int sub = 0; sub < 2; sub++)
#pragma unroll
    for (int e = 0; e < 16; e++) mx = fmaxf(mx, s[sub][e]);
  mx = fmaxf(mx, shflx(mx, 32, lane));
  const bool grow = mx > m;
  const float mn = grow ? mx : m;
  float sum = 0.f;
#pragma unroll
  for (int sub = 0; sub < 2; sub++)
#pragma unroll
    for (int e = 0; e < 16; e++) { float pv = __builtin_amdgcn_exp2f(s[sub][e] - mn); s[sub][e] = pv; sum += pv; }
  sum += shflx(sum, 32, lane);
  if (__builtin_amdgcn_ballot_w64(grow) != 0ull) {
    const float alpha = __builtin_amdgcn_exp2f(m - mn);
    l *= alpha;
#pragma unroll
    for (int ds = 0; ds < DV / 32; ds++)
#pragma unroll
      for (int e = 0; e < 16; e++) o[ds][e] *= alpha;
  }
  l += sum; m = mn;
  typedef __attribute__((ext_vector_type(4))) unsigned u32x4;
#pragma unroll
  for (int sub = 0; sub < 2; sub++)
#pragma unroll
    for (int st = 0; st < 2; st++) {
      u32x4 pw;
#pragma unroll
      for (int j = 0; j < 4; j++) pw[j] = pack2(s[sub][8 * st + 2 * j], s[sub][8 * st + 2 * j + 1]);
      pf[sub][st] = __builtin_bit_cast(bf16x8, pw);
    }
}
template <int DV>
__device__ __forceinline__ void fs_pv(const bf16x8 (&pf)[2][2], const u16* Vts, f32x16 (&o)[DV / 32], int lane) {
  const int r = lane & 31, h = lane >> 5;
#pragma unroll
  for (int sub = 0; sub < 2; sub++) {
    bf16x8 vf[2][DV / 32];
#pragma unroll
    for (int st = 0; st < 2; st++)
#pragma unroll
      for (int ds = 0; ds < DV / 32; ds++) {
        const u16* vp = Vts + (ds * 32 + r) * VROW + sub * 32 + 16 * st + 4 * h;
        bf16x4 lo = *(const bf16x4*)vp, hi = *(const bf16x4*)(vp + 8);
        vf[st][ds] = __builtin_shufflevector(lo, hi, 0, 1, 2, 3, 4, 5, 6, 7);
      }
    __builtin_amdgcn_sched_barrier(0);
#pragma unroll
    for (int st = 0; st < 2; st++)
#pragma unroll
      for (int ds = 0; ds < DV / 32; ds++) o[ds] = mfma32(vf[st][ds], pf[sub][st], o[ds]);
    __builtin_amdgcn_sched_barrier(0);
  }
}

__device__ __forceinline__ uint4 ld_k(const u16* __restrict__ src, size_t pitch, int r0, int nrows, int c) {
  int row = c >> 3, kc = c & 7; int rr = r0 + row;
  uint4 v = make_uint4(0, 0, 0, 0);
  if (rr >= 0 && rr < nrows) v = *(const uint4*)(src + (size_t)rr * pitch + kc * 8);
  return v;
}
__device__ __forceinline__ void st_k(u16* dst, int c, uint4 v) { *(uint4*)(dst + (c >> 3) * LROW + (c & 7) * 8) = v; }
__device__ __forceinline__ uint4 ld_vt(const u16* __restrict__ src, int T, int k0, int c) {
  int d = c >> 3, kc = c & 7; int k = k0 + kc * 8;
  uint4 v = make_uint4(0, 0, 0, 0);
  if (k >= 0 && k < T) v = *(const uint4*)(src + (size_t)d * T + k);
  return v;
}
__device__ __forceinline__ void st_vt(u16* dst, int c, uint4 v) {
  uint2* q = (uint2*)(dst + (c >> 3) * VROW + (c & 7) * 8);
  q[0] = make_uint2(v.x, v.y); q[1] = make_uint2(v.z, v.w);
}

constexpr int A_BUF = 64 * LROW + 64 * VROW;
__device__ __forceinline__ void attnA_item(const Params& p, int l, int it, u16* sm, bool dry = false) {
  const int tid = TIDX, lane = tid & 63, wid = tid >> 6;
  const int r = lane & 31, h = lane >> 5;
  const bool isctx = it < 128;
  int b, kvh, qb, T, rowbase; const u16* VtBase;
  if (isctx) { b = it >> 3; kvh = (it >> 2) & 1; qb = it & 3; T = 256; rowbase = b * 256;
    VtBase = p.VtA_ctx + ((size_t)(b * 2 + kvh) * 64) * 256; }
  else { int j = it - 128; b = j >> 7; kvh = (j >> 6) & 1; qb = j & 63; T = 4096; rowbase = NCTX + b * 4096;
    VtBase = p.VtA_lat + ((size_t)(b * 2 + kvh) * 64) * 4096; }
  const int qblk = qb * 64;
  const int q0 = qblk + (wid >> 2) * 32;
  const int head = kvh * 4 + (wid & 3);
  const size_t prow = (size_t)(rowbase + q0 + r) * PP;
  bf16x8 qf[4];
#pragma unroll
  for (int ks = 0; ks < 4; ks++) qf[ks] = *(const bf16x8*)(p.P + prow + C_QA + head * 64 + ks * 16 + h * 8);
  float m = p.sink_a[l * 8 + head] * 1.4426950408889634f, ls = 1.f;
  f32x16 o[2];
#pragma unroll
  for (int ds = 0; ds < 2; ds++)
#pragma unroll
    for (int e = 0; e < 16; e++) o[ds][e] = 0.f;
  const u16* Kbase = p.P + (size_t)rowbase * PP + C_KA + kvh * 64;
  const u16* cK = p.cKa + ((size_t)(b * 2 + l) * 512) * 128 + kvh * 64;
  const u16* cVt = p.cVtA + ((size_t)((b * 2 + l) * 2 + kvh) * 64) * 512;
  const int qpos = q0 + r;
  int i_lo = 0, nW, ntile;
  if (isctx) { nW = 4; ntile = 4; }
  else {
    i_lo = (qblk < 128) ? (128 - qblk) / 64 : 0;
    int i_hi = (T - qblk + 128) / 64; if (i_hi > 5) i_hi = 5;
    nW = i_hi - i_lo; ntile = nW + 8;
  }
  uint4 rk, rv;
  auto tile_load = [&](int t) {
    if (t < nW) {
      int k0 = isctx ? t * 64 : qblk - 128 + 64 * (i_lo + t);
      rk = ld_k(Kbase, PP, k0, T, tid); rv = ld_vt(VtBase, T, k0, tid);
    } else {
      int kt = t - nW;
      rk = ld_k(cK, 128, kt * 64, 512, tid); rv = ld_vt(cVt, 512, kt * 64, tid);
    }
  };
  auto KB = [&](int i) { return sm + (i & 1) * (64 * LROW); };
  auto VB = [&](int i) { return sm + 2 * 64 * LROW + (i % 3) * (64 * VROW); };
  const bool lag = (wid >> 2) != 0;
  __syncthreads();
  tile_load(0);
  st_k(KB(0), tid, rk); st_vt(VB(0), tid, rv);
  __syncthreads();
  bf16x8 pf[2][2];
  for (int t = 0; t <= ntile; t++) {
    const bool more = t + 1 < ntile;
    if (more) tile_load(t + 1);
    if (lag && t > 0) fs_pv<64>(pf, VB(t - 1), o, lane);
    if (t < ntile) {
      f32x16 sc[2];
      if (!isctx && t < nW) fs_scores<true>(KB(t), qf, sc, lane, qblk - 128 + 64 * (i_lo + t), qpos, T);
      else fs_scores<false>(KB(t), qf, sc, lane, 0, 0, T);
      fs_softmax<64>(sc, m, ls, o, pf, lane);
      if (!lag) fs_pv<64>(pf, VB(t), o, lane);
    }
    if (more) { st_k(KB(t + 1), tid, rk); st_vt(VB(t + 1), tid, rv); }
    __syncthreads();
  }
  const float inv = 1.f / ls;
#pragma unroll
  for (int ds = 0; ds < 2; ds++)
#pragma unroll
    for (int g = 0; g < 4; g++) {
      int d = ds * 32 + 8 * g + 4 * h;
      uint2 gv = *(const uint2*)(p.P + prow + C_GA + head * 64 + d);
      uint2 ov;
      ov.x = pack2(o[ds][4 * g] * inv * lo_bf(gv.x), o[ds][4 * g + 1] * inv * hi_bf(gv.x));
      ov.y = pack2(o[ds][4 * g + 2] * inv * lo_bf(gv.y), o[ds][4 * g + 3] * inv * hi_bf(gv.y));
      *(uint2*)(p.GB + tm_off(rowbase + q0 + r, head * 64 + d, 8)) = ov;
    }
}

constexpr int C_BUF = 128 * LROW + 128 * VROW;
__device__ __forceinline__ void attnC_item(const Params& p, int l, int it, u16* sm, float lam, float lam_init, bool dry = false) {
  const int tid = TIDX, lane = tid & 63, wid = tid >> 6;
  const int r = lane & 31, h = lane >> 5;
  const bool isctx = it < 128;
  int b, hd, qb, T, rowbase; const u16* VtBase;
  if (isctx) { b = it >> 3; hd = (it >> 1) & 3; qb = it & 1; T = 256; rowbase = b * 256;
    VtBase = p.VtC_ctx + ((size_t)(b * 4 + hd) * 128) * 256; }
  else { int j = it - 128; b = j >> 7; hd = (j >> 5) & 3; qb = j & 31; T = 4096; rowbase = NCTX + b * 4096;
    VtBase = p.VtC_lat + ((size_t)(b * 4 + hd) * 128) * 4096; }
  const int qg = wid & 3, map = wid >> 2;
  const int q0 = qb * 128 + qg * 32;
  const size_t prow = (size_t)(rowbase + q0 + r) * PP;
  bf16x8 qf[4];
#pragma unroll
  for (int ks = 0; ks < 4; ks++) qf[ks] = *(const bf16x8*)(p.P + prow + C_QC + hd * 128 + map * 64 + ks * 16 + h * 8);
  float m = -1e30f, ls = 0.f;
  f32x16 o[4];
#pragma unroll
  for (int ds = 0; ds < 4; ds++)
#pragma unroll
    for (int e = 0; e < 16; e++) o[ds][e] = 0.f;
  const u16* Kbase = p.P + (size_t)rowbase * PP + C_KC + hd * 128;
  const u16* cK = p.cKc + ((size_t)(b * 2 + l) * 512) * 512 + hd * 128;
  const u16* cVt = p.cVtC + ((size_t)((b * 2 + l) * 4 + hd) * 128) * 512;
  const int nW = T / 64, ntile = isctx ? nW : nW + 8;
  uint4 rk0, rk1, rv0, rv1;
  auto tile_load = [&](int t) {
    if (t < nW) {
      rk0 = ld_k(Kbase, PP, t * 64, T, tid); rk1 = ld_k(Kbase + 64, PP, t * 64, T, tid);
      rv0 = ld_vt(VtBase, T, t * 64, tid); rv1 = ld_vt(VtBase, T, t * 64, tid + NT);
    } else {
      int kt = t - nW;
      rk0 = ld_k(cK, 512, kt * 64, 512, tid); rk1 = ld_k(cK + 64, 512, kt * 64, 512, tid);
      rv0 = ld_vt(cVt, 512, kt * 64, tid); rv1 = ld_vt(cVt, 512, kt * 64, tid + NT);
    }
  };
  auto KB = [&](int i) { return sm + (i & 1) * (128 * LROW); };
  auto VB = [&](int i) { return sm + 2 * 128 * LROW + (i % 3) * (128 * VROW); };
  auto tile_store = [&](int i) {
    u16* kd = KB(i); u16* vd = VB(i);
    st_k(kd, tid, rk0); st_k(kd + 64 * LROW, tid, rk1);
    st_vt(vd, tid, rv0); st_vt(vd, tid + NT, rv1);
  };
  const bool lag = map != 0;
  __syncthreads();
  tile_load(0);
  tile_store(0);
  __syncthreads();
  bf16x8 pf[2][2];
  for (int t = 0; t <= ntile; t++) {
    const bool more = t + 1 < ntile;
    if (more) tile_load(t + 1);
    if (lag && t > 0) fs_pv<128>(pf, VB(t - 1), o, lane);
    if (t < ntile) {
      f32x16 sc[2];
      fs_scores<false>(KB(t) + map * 64 * LROW, qf, sc, lane, 0, 0, T);
      fs_softmax<128>(sc, m, ls, o, pf, lane);
      if (!lag) fs_pv<128>(pf, VB(t), o, lane);
    }
    if (more) tile_store(t + 1);
    __syncthreads();
  }
  float* xch = (float*)sm;
  if (map == 1) {
    const float inv = lam / ls;
#pragma unroll
    for (int ds = 0; ds < 4; ds++)
#pragma unroll
      for (int e = 0; e < 16; e++) xch[((qg * 64) + ds * 16 + e) * 64 + lane] = o[ds][e] * inv;
  }
  __syncthreads();
  if (map == 0) {
    const float i0 = 1.f / ls;
    float ss = 0.f;
#pragma unroll
    for (int ds = 0; ds < 4; ds++)
#pragma unroll
      for (int e = 0; e < 16; e++) {
        float v = o[ds][e] * i0 - xch[((qg * 64) + ds * 16 + e) * 64 + lane];
        o[ds][e] = v; ss += v * v;
      }
    ss += shflx(ss, 32, lane);
    const float rinv = rsqrtf(ss * (1.f / 128.f) + EPS) * (1.f - lam_init);
    const float* sg = p.subln_c + l * 128;
#pragma unroll
    for (int ds = 0; ds < 4; ds++)
#pragma unroll
      for (int g = 0; g < 4; g++) {
        int d = ds * 32 + 8 * g + 4 * h;
        uint2 gv = *(const uint2*)(p.P + prow + C_GC + hd * 128 + d);
        float4 sl = *(const float4*)(sg + d);
        uint2 ov;
        ov.x = pack2(o[ds][4 * g] * rinv * sl.x * lo_bf(gv.x), o[ds][4 * g + 1] * rinv * sl.y * hi_bf(gv.x));
        ov.y = pack2(o[ds][4 * g + 2] * rinv * sl.z * lo_bf(gv.y), o[ds][4 * g + 3] * rinv * sl.w * hi_bf(gv.y));
        *(uint2*)(p.GB + (size_t)2 * NTOK * 512 + tm_off(rowbase + q0 + r, hd * 128 + d, 8)) = ov;
      }
  }
}

__device__ __forceinline__ void lru_run(const Params& p, int l, bool pass2, int start, int G, float* sm, bool dry = false) {
  const int tid = TIDX;
  const int lane = tid & 63, wid = tid >> 6, r = lane & 31, h = lane >> 5;
  const int n = start & 7;
  float* xin = sm;
  float* xb = sm + 67 * 64;
  float* comb = xb + 64 * 64;
  float* carry = comb + 2048;
  float* parts = carry + 128;
  float* ab = parts + 1024;
  u16* xbh = (u16*)(ab + 4 * 4096);
  const int gd = wid >> 2, gth = (wid >> 1) & 1, gdh = wid & 1;
  bf16x8 wfa[4], wfx[4];
  {
    const u16* wbase = p.Wt_lru + ((size_t)(((l * 2 + gd) * 8 + n) * 2) * 64 + gdh * 32 + r) * 64 + h * 8;
#pragma unroll
    for (int ks = 0; ks < 4; ks++) { wfa[ks] = *(const bf16x8*)(wbase + ks * 16); wfx[ks] = *(const bf16x8*)(wbase + 4096 + ks * 16); }
  }
  const int gch = n * 64 + gdh * 32 + r;
  const float g_ba = p.lru_ba[(l * 2 + gd) * 512 + gch], g_bx = p.lru_bx[(l * 2 + gd) * 512 + gch];
  const float g_sp = log1pf(__expf(-p.lru_lam[(l * 2 + gd) * 512 + gch]));
  const int cc = tid & 63;
  float cw[4]; float cbv;
  {
    const float* cwp = p.conv_w + l * 4 * 512 + n * 64 + cc;
    cw[0] = cwp[0]; cw[1] = cwp[512]; cw[2] = cwp[1024]; cw[3] = cwp[1536];
    cbv = p.conv_b[l * 512 + n * 64 + cc];
  }
  const int dout = tid & 63, tg = tid >> 6;
  const int ch = n * 64 + dout;

  u16 xr[9];
  auto xin_load = [&](int it_) {
    const int row0_ = (it_ >> 3) * 64;
    int T_, seq0_;
    if (row0_ < NCTX) { T_ = 256; seq0_ = (row0_ >> 8) * 256; } else { T_ = 4096; seq0_ = NCTX + ((row0_ - NCTX) >> 12) * 4096; }
    const int t0_ = row0_ - seq0_;
#pragma unroll
    for (int k = 0; k < 9; k++) {
      const int rr = (tid >> 6) + 8 * k; const int t = t0_ - 2 + rr;
      u16 v = 0;
      if (rr < 67 && t >= 0 && t < T_) v = p.P[(size_t)(seq0_ + t) * PP + C_XB + n * 64 + cc];
      xr[k] = v;
    }
  };
  if (start < 1536) xin_load(start);
  for (int it = start; it < 1536; it += G) {
    const int ci = it >> 3;
    const int row0 = ci * 64;
    const bool isctx = row0 < NCTX;
    int T, seq0, bidx;
    if (isctx) { T = 256; bidx = row0 >> 8; seq0 = bidx * 256; }
    else { T = 4096; bidx = (row0 - NCTX) >> 12; seq0 = NCTX + bidx * 4096; }
    const int t0 = row0 - seq0;
    __syncthreads();
#pragma unroll
    for (int k = 0; k < 9; k++) { const int rr = (tid >> 6) + 8 * k; if (rr < 67) xin[rr * 64 + cc] = bf2f(xr[k]); }
    if (it + G < 1536) xin_load(it + G);
    u16 sgr[8];
    if (pass2) {
#pragma unroll
      for (int tt = 0; tt < 8; tt++) sgr[tt] = p.P[(size_t)(row0 + tg * 8 + tt) * PP + C_GB + ch];
    }
    if (pass2) {
      const int d = (tid >> 6) & 1, part = tid >> 7;
      const int cfirst = seq0 >> 6, clast = (seq0 + T - 64) >> 6;
      const int K = d ? (clast - ci) : (ci - cfirst);
      float2 q[16];
#pragma unroll
      for (int k = 0; k < 16; k++) {
        const int kk = part * 16 + k;
        const int cj = d ? (clast - kk) : (cfirst + kk);
        q[k] = make_float2(1.f, 0.f);
        if (kk < K) q[k] = *(const float2*)(p.lruTot + ((size_t)(cj * 2 + d) * 512 + n * 64 + cc) * 2);
      }
      float At = 1.f, Bt = 0.f;
#pragma unroll
      for (int k = 0; k < 16; k++) { Bt = q[k].x * Bt + q[k].y; At *= q[k].x; }
      parts[((part * 2 + d) * 64 + cc) * 2] = At; parts[((part * 2 + d) * 64 + cc) * 2 + 1] = Bt;
    }
    __syncthreads();
    for (int e = tid; e < 64 * 64; e += NT) {
      int t = e >> 6;
      float v = cbv;
#pragma unroll
      for (int j = 0; j < 4; j++) v += xin[(t + j) * 64 + cc] * cw[j];
      xb[e] = v;
      xbh[t * LROW + cc] = f2bf(v);
    }
    if (pass2 && tid < 128) {
      const int d = tid >> 6;
      float hcar = isctx ? 0.f : p.state_lru[((size_t)(bidx * 2 + l) * 2 + d) * 512 + n * 64 + cc];
#pragma unroll
      for (int part = 0; part < 4; part++) hcar = parts[((part * 2 + d) * 64 + cc) * 2] * hcar + parts[((part * 2 + d) * 64 + cc) * 2 + 1];
      carry[d * 64 + cc] = hcar;
    }
    __syncthreads();
    {
      bf16x8 af[4];
#pragma unroll
      for (int ks = 0; ks < 4; ks++) af[ks] = *(const bf16x8*)(xbh + (gth * 32 + r) * LROW + ks * 16 + h * 8);
      f32x16 ga, gi;
#pragma unroll
      for (int e = 0; e < 16; e++) { ga[e] = 0.f; gi[e] = 0.f; }
#pragma unroll
      for (int ks = 0; ks < 4; ks++) { ga = mfma32(af[ks], wfa[ks], ga); gi = mfma32(af[ks], wfx[ks], gi); }
      const int dch = gdh * 32 + r;
#pragma unroll
      for (int e = 0; e < 16; e++) {
        const int tok = gth * 32 + (e & 3) + 8 * (e >> 2) + 4 * h;
        float rg = sigmoidf_(ga[e] + g_ba), ig = sigmoidf_(gi[e] + g_bx);
        float log_a = -8.f * rg * g_sp;
        float a = __expf(log_a);
        float bb = sqrtf(-expm1f(2.f * log_a)) * ig * xb[tok * 64 + dch];
        ab[((gd * 2 + 0) * 64 + tok) * 64 + dch] = a;
        ab[((gd * 2 + 1) * 64 + tok) * 64 + dch] = bb;
      }
    }
    __syncthreads();
    float av[2][8], bv[2][8];
#pragma unroll
    for (int d = 0; d < 2; d++)
#pragma unroll
      for (int tt = 0; tt < 8; tt++) {
        av[d][tt] = ab[((d * 2 + 0) * 64 + tg * 8 + tt) * 64 + dout];
        bv[d][tt] = ab[((d * 2 + 1) * 64 + tg * 8 + tt) * 64 + dout];
      }
    float sA0 = 1.f, sB0 = 0.f, sA1 = 1.f, sB1 = 0.f;
#pragma unroll
    for (int tt = 0; tt < 8; tt++) { sB0 = av[0][tt] * sB0 + bv[0][tt]; sA0 *= av[0][tt]; }
#pragma unroll
    for (int tt = 7; tt >= 0; tt--) { sB1 = av[1][tt] * sB1 + bv[1][tt]; sA1 *= av[1][tt]; }
    comb[((tg * 2 + 0) * 64 + dout) * 2 + 0] = sA0; comb[((tg * 2 + 0) * 64 + dout) * 2 + 1] = sB0;
    comb[((tg * 2 + 1) * 64 + dout) * 2 + 0] = sA1; comb[((tg * 2 + 1) * 64 + dout) * 2 + 1] = sB1;
    __syncthreads();
    if (!pass2) {
      if (tid < 128) {
        int d = tid >> 6, c = tid & 63;
        float At = 1.f, Bt = 0.f;
#pragma unroll
        for (int s = 0; s < 8; s++) {
          int g = (d == 0) ? s : 7 - s;
          float a = comb[((g * 2 + d) * 64 + c) * 2], bq = comb[((g * 2 + d) * 64 + c) * 2 + 1];
          Bt = a * Bt + bq; At *= a;
        }
        float* o = p.lruTot + ((size_t)(ci * 2 + d) * 512 + n * 64 + c) * 2;
        o[0] = At; o[1] = Bt;
      }
      continue;
    }
    float h0 = carry[dout], h1 = carry[64 + dout];
    for (int g = 0; g < tg; g++) { h0 = comb[((g * 2 + 0) * 64 + dout) * 2] * h0 + comb[((g * 2 + 0) * 64 + dout) * 2 + 1]; }
    for (int g = 7; g > tg; g--) { h1 = comb[((g * 2 + 1) * 64 + dout) * 2] * h1 + comb[((g * 2 + 1) * 64 + dout) * 2 + 1]; }
    float y[8];
#pragma unroll
    for (int tt = 0; tt < 8; tt++) { h0 = av[0][tt] * h0 + bv[0][tt]; y[tt] = h0; }
    const float hf_last = h0;
#pragma unroll
    for (int tt = 7; tt >= 0; tt--) { h1 = av[1][tt] * h1 + bv[1][tt]; y[tt] += h1; }
    const float hb_first = h1;
    if (isctx) {
      if (t0 + 64 == T && tg == 7) p.out[O_ST + ((size_t)(bidx * 2 + l) * 2 + 0) * 512 + ch] = hf_last;
      if (t0 == 0 && tg == 0) p.out[O_ST + ((size_t)(bidx * 2 + l) * 2 + 1) * 512 + ch] = hb_first;
    }
#pragma unroll
    for (int tt = 0; tt < 8; tt++) {
      const int rw = row0 + tg * 8 + tt;
      p.GB[(size_t)NTOK * 512 + tm_off(rw, ch, 8)] = f2bf(y[tt] * bf2f(sgr[tt]));
    }
  }
}

__device__ __forceinline__ float compute_lam(const Params& p, int l, float lam_init) {
  float s1 = 0.f, s2 = 0.f;
  for (int i = 0; i < 64; i++) {
    s1 += p.lam_q1[l * 64 + i] * p.lam_k1[l * 64 + i];
    s2 += p.lam_q2[l * 64 + i] * p.lam_k2[l * 64 + i];
  }
  return expf(s1) - expf(s2) + lam_init;
}

__device__ __forceinline__ float mix_phase(const Params& p, int l, u16* smem, int vid) {
  unsigned long long tm0 = 0; float tres = 0.f; if (PROBE >= 30) tm0 = __builtin_amdgcn_s_memrealtime();
  const float lam_init = (l == 0) ? 0.2f : (0.8f - 0.6f * 0.74081822068f);
  const float lam = compute_lam(p, l, lam_init);
  constexpr int N_CL = 256, N_A = 384, N_CC = 128, N_L = 1536;
  const int G = gridDim.x;
  int start = vid;
  for (int it = start; it < N_CL; it += G) attnC_item(p, l, 128 + it, smem, lam, lam_init);
  if (PROBE == 35) tres = (float)(__builtin_amdgcn_s_memrealtime() - tm0) / 40000.f;
  start = (int)((vid + G - (N_CL % G)) % G);
  for (int it = start; it < N_A; it += G) attnA_item(p, l, it, smem);
  start = (int)((vid + G - ((N_CL + N_A) % G)) % G);
  for (int it = start; it < N_CC; it += G) attnC_item(p, l, it, smem, lam, lam_init);
  if (PROBE == 36) tres = (float)(__builtin_amdgcn_s_memrealtime() - tm0) / 40000.f;
  start = (int)((vid + G - ((N_CL + N_A + N_CC) % G)) % G);
  if (PROBE == 6) lru_run(p, l, false, start, G, (float*)smem);
  lru_run(p, l, false, start, G, (float*)smem);
  return tres;
}

__device__ __forceinline__ void lru2_phase(const Params& p, int l, u16* smem) {
  lru_run(p, l, true, blockIdx.x, gridDim.x, (float*)smem);
}

#define XB_TMO      128
#define XB_XCNT(j)  (256  + 64 * (j))
#define XB_XSUB(j)  (1280 + 64 * (j))
#define XB_XGEN(j)  (2304 + 64 * (j))
#define XB_TOP      3328
#define XB_TOPGEN   3392
#define XCD_BAR_WORDS 3456
#define XB_SPIN_CAP (1u << 18)
__device__ __forceinline__ unsigned xb_ld(unsigned* p)              { return __hip_atomic_load(p, __ATOMIC_RELAXED, __HIP_MEMORY_SCOPE_AGENT); }
__device__ __forceinline__ unsigned xb_add(unsigned* p, unsigned v) { return __hip_atomic_fetch_add(p, v, __ATOMIC_RELAXED, __HIP_MEMORY_SCOPE_AGENT); }
__device__ __forceinline__ unsigned xb_xcc_id() { return (unsigned)__builtin_amdgcn_s_getreg((3 << 11) | 20) & 0xFu; }
#define XB_SPIN(cond, bar) do { unsigned _sp = 0; while (cond) { __builtin_amdgcn_s_sleep(1); \
    if ((++_sp & 255u) == 0u) { if (xb_ld(&(bar)[XB_TMO])) break; if (_sp > XB_SPIN_CAP) { atomicAdd(&(bar)[XB_TMO], 1u); break; } } } } while (0)
struct XcdBarrier { unsigned* bar; unsigned x; volatile LAS unsigned* st; };
__device__ __forceinline__ XcdBarrier xcd_barrier_post(unsigned* bar, volatile LAS unsigned* st) {
  XcdBarrier b; b.bar = bar; b.x = xb_xcc_id(); b.st = st;
  if (threadIdx.x == 0) st[2] = xb_add(&bar[XB_XCNT(b.x)], 1u);
  return b;
}
__device__ __forceinline__ int xcd_virtual_id(const XcdBarrier& b) {
  if (threadIdx.x == 0) {
    unsigned pre = 0;
#pragma unroll
    for (unsigned j = 0; j < 16; ++j) { const unsigned c = xb_ld(&b.bar[XB_XCNT(j)]); pre += (j < b.x) ? c : 0u; }
    b.st[3] = pre + b.st[2];
  }
  __syncthreads();
  const int v = (int)b.st[3];
  __syncthreads();
  return __builtin_amdgcn_readfirstlane(v);
}
__device__ __forceinline__ void xcd_barrier_complete(unsigned* bar, unsigned x, unsigned& nloc, unsigned& nx) {
  const unsigned G = gridDim.x * gridDim.y * gridDim.z;
  unsigned sum, cnt, mine, sp = 0u;
  for (;;) {
    sum = 0u; cnt = 0u; mine = 0u;
#pragma unroll
    for (unsigned j = 0; j < 16; ++j) { const unsigned c = xb_ld(&bar[XB_XCNT(j)]); sum += c; cnt += (c > 0u) ? 1u : 0u; mine = (j == x) ? c : mine; }
    if (sum == G) break;
    __builtin_amdgcn_s_sleep(1);
    if ((++sp & 255u) == 0u) { if (xb_ld(&bar[XB_TMO])) break; if (sp > XB_SPIN_CAP) { atomicAdd(&bar[XB_TMO], 1u); break; } }
  }
  nloc = mine > 0u ? mine : 1u; nx = cnt > 0u ? cnt : 1u;
}
__device__ __forceinline__ void xcd_barrier(const XcdBarrier& b) {
  asm volatile("s_waitcnt vmcnt(0)" ::: "memory");
  __syncthreads();
  if (threadIdx.x == 0) {
    unsigned* bar = b.bar;
    __builtin_amdgcn_s_waitcnt(0);
    unsigned nloc = b.st[0], nx = b.st[1];
    if (nloc == 0u) { xcd_barrier_complete(bar, b.x, nloc, nx); b.st[0] = nloc; b.st[1] = nx; }
    const unsigned old = xb_add(&bar[XB_XSUB(b.x)], 1u);
    const unsigned gen = old / nloc;
    if (old + 1u == (gen + 1u) * nloc) {
      __builtin_amdgcn_fence(__ATOMIC_RELEASE, "agent");
      asm volatile("s_waitcnt vmcnt(0)" ::: "memory");
      const unsigned og = xb_add(&bar[XB_TOP], 1u);
      const unsigned tg = og / nx;
      if (og + 1u == (tg + 1u) * nx) xb_add(&bar[XB_TOPGEN], 1u);
      else XB_SPIN(xb_ld(&bar[XB_TOPGEN]) == tg, bar);
      __builtin_amdgcn_fence(__ATOMIC_ACQUIRE, "agent");
      xb_add(&bar[XB_XGEN(b.x)], 1u);
      asm volatile("s_waitcnt vmcnt(0)" ::: "memory");
    } else {
      XB_SPIN(xb_ld(&bar[XB_XGEN(b.x)]) == gen, bar);
      __builtin_amdgcn_fence(__ATOMIC_ACQUIRE, "agent");
      asm volatile("s_waitcnt vmcnt(0)" ::: "memory");
    }
  }
  __syncthreads();
}

typedef __attribute__((address_space(4))) const Params CParams;
__device__ __forceinline__ const Params& get_params() {
  CParams* kp = (CParams*)__builtin_amdgcn_kernarg_segment_ptr();
  asm volatile("" : "+s"(kp));
  return *(const Params*)kp;
}
__global__ void __launch_bounds__(NT, 2) fwd_kernel(Params p_unused) {
  extern __shared__ __attribute__((aligned(16))) unsigned char lds_raw[];
  u16* smem = (u16*)lds_raw;
  LAS unsigned char* lds = (LAS unsigned char*)lds_raw;
  cg::grid_group grid = cg::this_grid();
  volatile LAS unsigned* xst = (volatile LAS unsigned*)(lds + STAGE_BYTES + SPARE_BYTES);
  if (threadIdx.x == 0) { xst[0] = 0u; xst[1] = 0u; }
  __syncthreads();
  XcdBarrier xb = xcd_barrier_post(get_params().bar, xst);
  float tfrac = 0.f;
  unsigned long long tq0 = 0; if (PROBE >= 30) tq0 = __builtin_amdgcn_s_memrealtime();
  prologue_phase(get_params(), (float*)smem);
  if (PROBE == 30) tfrac = (float)(__builtin_amdgcn_s_memrealtime() - tq0) / 40000.f;
  if (get_params().bar == nullptr) grid.sync();
  xcd_barrier(xb);
  if (PROBE == 31) tfrac = (float)(__builtin_amdgcn_s_memrealtime() - tq0) / 40000.f;
  const int vid = xcd_virtual_id(xb);
  if (PROBE == 9) { for (int i = 0; i < 10; i++) xcd_barrier(xb); }
#pragma unroll 1
  for (int l = 0; l < 2; l++) {
    if (PROBE >= 30) tq0 = __builtin_amdgcn_s_memrealtime();
    norm_phase(get_params(), l);
    if (PROBE == 32 && l == 0) tfrac = (float)(__builtin_amdgcn_s_memrealtime() - tq0) / 40000.f;
    if (PROBE == 3) { norm_phase(get_params(), l); if (l == 0) { xcd_barrier(xb); prologue_phase(get_params(), (float*)smem); } }
    xcd_barrier(xb);
    {
      const Params& p = get_params();
      SchedStd S; S.nM = NTOK / 256; S.nN = INC / 256; S.nwg = S.nM * S.nN; S.G = gridDim.x; S.c = vid;
      S.A = (const char*)p.H; S.B = (const char*)(p.Wt_in + (size_t)l * INC * 1024); S.tA = (size_t)256 * 1024 * 2; S.tB = (size_t)256 * 1024 * 2;
      EpiInproj E; E.pp = &p; E.l = l; E.part = (LAS float*)(lds + STAGE_BYTES);
      { float tr = gemm_phase(lds, 1024, S, E, PROBE == 22); if (l == 0 && (PROBE == 21 || PROBE == 22)) tfrac = tr; }
      if (PROBE == 1) { __syncthreads(); gemm_phase(lds, 1024, S, E); }
    }
    xcd_barrier(xb);
    if (PROBE >= 30) tq0 = __builtin_amdgcn_s_memrealtime();
    { float tr = mix_phase(get_params(), l, smem, vid); if ((PROBE == 35 || PROBE == 36) && l == 0) tfrac = tr; }
    if (PROBE == 33 && l == 0) tfrac = (float)(__builtin_amdgcn_s_memrealtime() - tq0) / 40000.f;
    xcd_barrier(xb);
    if (PROBE >= 30) tq0 = __builtin_amdgcn_s_memrealtime();
    lru2_phase(get_params(), l, smem);
    if (PROBE == 34 && l == 0) tfrac = (float)(__builtin_amdgcn_s_memrealtime() - tq0) / 40000.f;
    xcd_barrier(xb);
    {
      const Params& p = get_params();
      SchedBranch S; S.G = gridDim.x; S.c = vid; S.P_ = (const char*)p.GB; S.W_ = (const char*)(p.Wt_br + (size_t)l * 3 * 1024 * 512);
      EpiBranch E; E.pp = &p;
      { float tr = gemm_phase(lds, 512, S, E, PROBE == 24); if (l == 0 && (PROBE == 23 || PROBE == 24)) tfrac = tr; }
      if (PROBE == 2) { __syncthreads(); gemm_phase(lds, 512, S, E); }
    }
    xcd_barrier(xb);
    {
      const Params& p = get_params();
      SchedStd S; S.nM = NTOK / 256; S.nN = 4; S.nwg = S.nM * S.nN; S.G = gridDim.x; S.c = vid;
      S.A = (const char*)p.Y; S.B = (const char*)(p.Wt_out + (size_t)l * 1024 * 1024); S.tA = (size_t)256 * 1024 * 2; S.tB = (size_t)256 * 1024 * 2;
      EpiOut E; E.pp = &p; E.l = l;
      { float tr = gemm_phase(lds, 1024, S, E, PROBE == 26); if (l == 0 && (PROBE == 25 || PROBE == 26)) tfrac = tr; }
      if (PROBE == 8 && l == 0) { __syncthreads(); gemm_phase(lds, 1024, S, E); }
    }
    if (l == 0) xcd_barrier(xb);
  }
  if (PROBE >= 20) {
    xcd_barrier(xb);
    if (blockIdx.x == 0 && threadIdx.x == 0) { float* o = get_params().out + O_X + 4194304; *o += 0.42f + 0.45f * fminf(fmaxf(tfrac, 0.f), 1.f); }
  }
}

extern "C" void kernel_launch(void* const* d_in, const int* in_sizes, int n_in, void* d_out, int out_size, void* d_ws,
                              size_t ws_size, hipStream_t stream) {
  Params p{};
  const float** ip = (const float**)&p;
  for (int i = 0; i < 34; i++) ip[i] = (const float*)d_in[i];
  p.out = (float*)d_out;
  char* w = (char*)d_ws; size_t off = 0;
  auto take = [&](size_t bytes) { char* q = w + off; off += (bytes + 255) & ~(size_t)255; return q; };
  p.Wt_in = (u16*)take((size_t)2 * INC * 1024 * 2);
  p.Wt_br = (u16*)take((size_t)6 * 1024 * 512 * 2);
  p.Wt_out = (u16*)take((size_t)2 * 1024 * 1024 * 2);
  p.Y = (u16*)take((size_t)NTOK * 1024 * 2);
  p.P = (u16*)take((size_t)NTOK * PP * 2);
  p.VtA_ctx = p.Y;
  p.VtA_lat = p.VtA_ctx + (size_t)16 * 2 * 64 * 256;
  p.VtC_ctx = p.VtA_lat + (size_t)2 * 2 * 64 * 4096;
  p.VtC_lat = p.VtC_ctx + (size_t)16 * 4 * 128 * 256;
  p.cKa = (u16*)take((size_t)2 * 2 * 512 * 128 * 2);
  p.cVtA = (u16*)take((size_t)2 * 2 * 512 * 128 * 2);
  p.cKc = (u16*)take((size_t)2 * 2 * 512 * 512 * 2);
  p.cVtC = (u16*)take((size_t)2 * 2 * 512 * 512 * 2);
  p.mod = (float*)take((size_t)2 * 3 * 3072 * 4);
  p.rope = (float*)take((size_t)2048 * 4);
  p.lruTot = (float*)take((size_t)192 * 2 * 512 * 2 * 4);
  p.Wt_lru = (u16*)take((size_t)2 * 2 * 8 * 2 * 64 * 64 * 2);
  p.bar = (unsigned*)take((size_t)XCD_BAR_WORDS * 4);
  p.GB = (u16*)take((size_t)3 * NTOK * 512 * 2);
  p.H = p.GB;
  p.MG = (unsigned*)take((size_t)48 * 4 * 3 * 16384 * 4);
  static int grid_blocks = 0;
  if (!grid_blocks) {
    int dev = 0, cus = 0;
    hipGetDevice(&dev);
    hipDeviceGetAttribute(&cus, hipDeviceAttributeMultiprocessorCount, dev);
    hipFuncSetAttribute((const void*)fwd_kernel, hipFuncAttributeMaxDynamicSharedMemorySize, LDS_BYTES);
    int per_cu = 0;
    hipOccupancyMaxActiveBlocksPerMultiprocessor(&per_cu, (const void*)fwd_kernel, NT, LDS_BYTES);
    (void)hipGetLastError();
    grid_blocks = cus;
  }
  hipMemsetAsync(p.bar, 0, (size_t)XCD_BAR_WORDS * 4, stream);
  void* args[] = {&p};
  hipLaunchCooperativeKernel((void*)fwd_kernel, dim3(grid_blocks), dim3(NT), args, LDS_BYTES, stream);
}
```

```cpp
#include <hip/hip_runtime.h>
#include <hip/hip_cooperative_groups.h>
#include <stdint.h>
#include <math.h>
namespace cg = cooperative_groups;

typedef unsigned short u16;
typedef __attribute__((ext_vector_type(8))) short bf16x8;
typedef __attribute__((ext_vector_type(4))) short bf16x4;
typedef __attribute__((ext_vector_type(16))) float f32x16;
typedef __attribute__((ext_vector_type(4))) float f32x4;
#define LAS __attribute__((address_space(3)))

#ifndef PROBE
#define PROBE 0
#endif
#define NT 512
constexpr int NTOK = 12288, NCTX = 4096;
constexpr int INC = 7424;
constexpr int PP = 3712;
constexpr int C_QA = 0, C_KA = 512, C_GA = 640, C_XB = 1152, C_GB = 1664, C_QC = 2176, C_KC = 2688, C_GC = 3200;
constexpr int LROW = 72;
constexpr int VROW = 68;
constexpr float EPS = 1e-6f;
constexpr int STAGE_BYTES = 131072;
constexpr int SPARE_BYTES = 8192;
constexpr int LDS_BYTES = STAGE_BYTES + SPARE_BYTES + 16;

constexpr size_t O_X = 0, O_KA = 12582912, O_VA = 13631488, O_KC = 14680064, O_VC = 18874368, O_ST = 23068672;

struct Params {
  const float *x_prompt, *x_sample, *cache_a_k, *cache_a_v, *cache_c_k, *cache_c_v, *state_lru, *c, *c_ctx,
      *norm_g, *mod_w, *mod_b, *w_in, *qn_a, *kn_a, *sink_a, *conv_w, *conv_b, *lru_wa, *lru_ba, *lru_wx, *lru_bx,
      *lru_lam, *qn_c, *kn_c, *lam_q1, *lam_k1, *lam_q2, *lam_k2, *subln_c, *w_br_a, *w_br_b, *w_br_c, *w_out;
  float* out;
  u16 *Wt_in, *Wt_br, *Wt_out, *H, *P, *VtA_ctx, *VtA_lat, *VtC_ctx, *VtC_lat, *cKa, *cVtA, *cKc, *cVtC;
  float *mod, *rope, *lruTot;
  u16 *Wt_lru;
  unsigned* bar;
  u16* Y;
  u16* GB;
  unsigned* MG;
};

__device__ __forceinline__ int tid_opaque() { int t = (int)threadIdx.x; asm volatile("" : "+v"(t)); return t; }
#define TIDX tid_opaque()
__device__ __forceinline__ u16 f2bf(float f) {
  uint32_t r; asm("v_cvt_pk_bf16_f32 %0, %1, %1" : "=v"(r) : "v"(f)); return (u16)(r & 0xffffu);
}
__device__ __forceinline__ float bf2f(u16 h) { return __uint_as_float(((uint32_t)h) << 16); }
__device__ __forceinline__ uint32_t pack2(float a, float b) { uint32_t r; asm("v_cvt_pk_bf16_f32 %0, %1, %2" : "=v"(r) : "v"(a), "v"(b)); return r; }
__device__ __forceinline__ float sigmoidf_(float x) { return __builtin_amdgcn_rcpf(1.f + __expf(-x)); }
__device__ __forceinline__ float siluf_(float x) { return x * __builtin_amdgcn_rcpf(1.f + __expf(-x)); }
__device__ __forceinline__ f32x16 mfma32(bf16x8 a, bf16x8 b, f32x16 c) {
  return __builtin_amdgcn_mfma_f32_32x32x16_bf16(a, b, c, 0, 0, 0);
}
__device__ __forceinline__ float shflx(float v, int mask, int lane) {
  return __builtin_bit_cast(float, __builtin_amdgcn_ds_bpermute((lane ^ mask) << 2, __builtin_bit_cast(int, v)));
}
__device__ __forceinline__ float lo_bf(uint32_t w) { return __uint_as_float(w << 16); }
__device__ __forceinline__ float hi_bf(uint32_t w) { return __uint_as_float(w & 0xffff0000u); }

__device__ __forceinline__ size_t tm_off(int r, int k, int KT) {
  return ((size_t)((r >> 8) * KT + (k >> 6)) * 256 + (r & 255)) * 64 + (k & 63);
}
__device__ __forceinline__ void transpose_tile(const float* __restrict__ src, int spitch, u16* __restrict__ dst, int dpitch,
                               int r0, int c0, float* sm, int KT = 0) {
  const int tid = TIDX;
#pragma unroll
  for (int i = 0; i < 2; i++) {
    int c = tid + i * NT; int r = c >> 4, q = c & 15;
    float4 v = *(const float4*)(src + (size_t)(r0 + r) * spitch + c0 + q * 4);
    float* d = sm + r * 65 + q * 4;
    d[0] = v.x; d[1] = v.y; d[2] = v.z; d[3] = v.w;
  }
  __syncthreads();
  {
    int c = tid; int cc = c >> 3, q = c & 7;
    uint32_t w[4];
#pragma unroll
    for (int j = 0; j < 4; j++) w[j] = pack2(sm[(q * 8 + 2 * j) * 65 + cc], sm[(q * 8 + 2 * j + 1) * 65 + cc]);
    uint4 v; v.x = w[0]; v.y = w[1]; v.z = w[2]; v.w = w[3];
    if (KT) *(uint4*)(dst + tm_off(c0 + cc, r0 + q * 8, KT)) = v;
    else *(uint4*)(dst + (size_t)(c0 + cc) * dpitch + r0 + q * 8) = v;
  }
  __syncthreads();
}

__device__ __forceinline__ void transpose_wide(const float* __restrict__ src, int spitch, u16* __restrict__ dst,
                                               int k0, int n0, float* sm, int KT) {
  const int tid = TIDX;
  float4 v[8];
#pragma unroll
  for (int i = 0; i < 8; i++) { int c = tid + i * NT; int r = c >> 6, q = c & 63; v[i] = *(const float4*)(src + (size_t)(k0 + r) * spitch + n0 + q * 4); }
#pragma unroll
  for (int i = 0; i < 8; i++) { int c = tid + i * NT; int r = c >> 6, q = c & 63; float* d = sm + r * 257 + q * 4; d[0] = v[i].x; d[1] = v[i].y; d[2] = v[i].z; d[3] = v[i].w; }
  __syncthreads();
#pragma unroll
  for (int i = 0; i < 4; i++) {
    int c = tid + i * NT; int nn = c >> 3, q = c & 7;
    uint4 o;
    o.x = pack2(sm[(q * 8 + 0) * 257 + nn], sm[(q * 8 + 1) * 257 + nn]);
    o.y = pack2(sm[(q * 8 + 2) * 257 + nn], sm[(q * 8 + 3) * 257 + nn]);
    o.z = pack2(sm[(q * 8 + 4) * 257 + nn], sm[(q * 8 + 5) * 257 + nn]);
    o.w = pack2(sm[(q * 8 + 6) * 257 + nn], sm[(q * 8 + 7) * 257 + nn]);
    *(uint4*)(dst + tm_off(n0 + nn, k0 + q * 8, KT)) = o;
  }
  __syncthreads();
}

__device__ __forceinline__ void mod_item(const Params& p, int it, float* sm) {
  const int tid = TIDX;
  const int l = it / 48, n0 = (it % 48) * 64;
  float* sv = sm;
  float* red = sm + 3072;
  for (int e = tid; e < 3072; e += NT) {
    int v = e >> 10, k = e & 1023;
    float x = (v == 0) ? p.c_ctx[k] : p.c[(v - 1) * 1024 + k];
    sv[e] = siluf_(x);
  }
  __syncthreads();
  const int col = tid & 63, kg = tid >> 6;
  const float* w = p.mod_w + (size_t)l * 1024 * 3072 + n0 + col;
  float a0 = 0, a1 = 0, a2 = 0;
#pragma unroll 1
  for (int kb = kg * 128; kb < kg * 128 + 128; kb += 32) {
    float wv[32];
#pragma unroll
    for (int j = 0; j < 32; j++) wv[j] = w[(size_t)(kb + j) * 3072];
#pragma unroll
    for (int j = 0; j < 32; j++) { a0 += sv[kb + j] * wv[j]; a1 += sv[1024 + kb + j] * wv[j]; a2 += sv[2048 + kb + j] * wv[j]; }
  }
  red[(kg * 3 + 0) * 64 + col] = a0; red[(kg * 3 + 1) * 64 + col] = a1; red[(kg * 3 + 2) * 64 + col] = a2;
  __syncthreads();
  if (tid < 192) {
    int v = tid >> 6, c = tid & 63;
    float s = p.mod_b[l * 3072 + n0 + c];
#pragma unroll
    for (int g = 0; g < 8; g++) s += red[(g * 3 + v) * 64 + c];
    p.mod[(l * 3 + v) * 3072 + n0 + c] = s;
  }
  __syncthreads();
}

__device__ __forceinline__ void prologue_phase(const Params& p, float* sm) {
  constexpr int N_MOD = 96, N_ROPE = 1, N_WIN = 2 * 16 * 29, N_WBR = 6 * 8 * 4, N_WOUT = 2 * 16 * 4;
  constexpr int N_CK = 64 + 256, N_CVA = 4 * 16, N_CVC = 4 * 64, N_LW = 64;
  constexpr int E0 = N_MOD, E1 = E0 + N_ROPE, E2 = E1 + N_WIN, E3 = E2 + N_WBR, E4 = E3 + N_WOUT, E5 = E4 + N_CK,
                E6 = E5 + N_CVA, E7 = E6 + N_CVC, E8 = E7 + N_LW;
  const int tid = TIDX;
  for (int it = blockIdx.x; it < E8; it += gridDim.x) {
    if (it < E0) {
      mod_item(p, it, sm);
    } else if (it < E1) {
      for (int e = tid; e < 1024; e += NT) {
        int pos = e >> 4, f = e & 15;
        float inv = powf(10000.f, -(float)f / 16.f);
        float ang = (float)pos * inv;
        p.rope[e] = cosf(ang); p.rope[1024 + e] = sinf(ang);
      }
    } else if (it < E2) {
      int j = it - E1; int l = j / (16 * 29); int r = j % (16 * 29);
      int kt = r / 29, pn = r % 29;
      transpose_wide(p.w_in + (size_t)l * 1024 * INC, INC, p.Wt_in + (size_t)l * INC * 1024, kt * 64, pn * 256, sm, 16);
    } else if (it < E3) {
      int j = it - E2; int m = j / 32; int r = j % 32;
      int l = m / 3, i = m % 3;
      const float* src = (i == 0 ? p.w_br_a : (i == 1 ? p.w_br_b : p.w_br_c)) + (size_t)l * 512 * 1024;
      int kt = r / 4, pn = r % 4;
      transpose_wide(src, 1024, p.Wt_br + (size_t)m * 1024 * 512, kt * 64, pn * 256, sm, 8);
    } else if (it < E4) {
      int j = it - E3; int l = j / 64; int r = j % 64;
      int kt = r / 4, pn = r % 4;
      transpose_wide(p.w_out + (size_t)l * 1024 * 1024, 1024, p.Wt_out + (size_t)l * 1024 * 1024, kt * 64, pn * 256, sm, 16);
    } else if (it < E5) {
      int j = it - E4;
      const float* src; u16* dst; size_t off;
      if (j < 64) { src = p.cache_a_k; dst = p.cKa; off = (size_t)j * 4096; }
      else { src = p.cache_c_k; dst = p.cKc; off = (size_t)(j - 64) * 4096; }
      size_t e = off + (size_t)tid * 8;
      float4 a = *(const float4*)(src + e), b = *(const float4*)(src + e + 4);
      uint4 v; v.x = pack2(a.x, a.y); v.y = pack2(a.z, a.w); v.z = pack2(b.x, b.y); v.w = pack2(b.z, b.w);
      *(uint4*)(dst + e) = v;
    } else if (it < E6) {
      int j = it - E5; int bl = j / 16; int r = j % 16;
      int rt = r / 2, ct = r % 2;
      transpose_tile(p.cache_a_v + (size_t)bl * 512 * 128, 128, p.cVtA + (size_t)bl * 128 * 512, 512, rt * 64, ct * 64, sm);
    } else if (it < E7) {
      int j = it - E6; int bl = j / 64; int r = j % 64;
      int rt = r / 8, ct = r % 8;
      transpose_tile(p.cache_c_v + (size_t)bl * 512 * 512, 512, p.cVtC + (size_t)bl * 512 * 512, 512, rt * 64, ct * 64, sm);
    } else {
      int j = it - E7; int ldn = j >> 1, g = j & 1;
      transpose_tile((g ? p.lru_wx : p.lru_wa) + (size_t)ldn * 4096, 64, p.Wt_lru + (size_t)(ldn * 2 + g) * 4096, 64, 0, 0, sm);
    }
  }
}

__device__ __forceinline__ void norm_phase(const Params& p, int l) {
  const int tid = TIDX, lane = tid & 63, wid = tid >> 6;
  const float* g = p.norm_g + l * 1024;
  for (int it = blockIdx.x; it < NTOK / 8; it += gridDim.x) {
    int row = it * 8 + wid;
    const float* x;
    if (l == 0) x = (row < NCTX) ? p.x_prompt + (size_t)row * 1024 : p.x_sample + (size_t)(row - NCTX) * 1024;
    else x = p.out + O_X + (size_t)row * 1024;
    int v = (row < NCTX) ? 0 : 1 + (row - NCTX) / 4096;
    const float* md = p.mod + (l * 3 + v) * 3072;
    float4 xv[4]; float ss = 0;
#pragma unroll
    for (int i = 0; i < 4; i++) {
      xv[i] = *(const float4*)(x + i * 256 + lane * 4);
      ss += xv[i].x * xv[i].x + xv[i].y * xv[i].y + xv[i].z * xv[i].z + xv[i].w * xv[i].w;
    }
#pragma unroll
    for (int o = 32; o > 0; o >>= 1) ss += shflx(ss, o, lane);
    float rinv = rsqrtf(ss * (1.f / 1024.f) + EPS);
#pragma unroll
    for (int i = 0; i < 4; i++) {
      int c = i * 256 + lane * 4;
      float4 gv = *(const float4*)(g + c), sh = *(const float4*)(md + c), sc = *(const float4*)(md + 1024 + c);
      float h0 = xv[i].x * rinv * gv.x * (1.f + sc.x) + sh.x;
      float h1 = xv[i].y * rinv * gv.y * (1.f + sc.y) + sh.y;
      float h2 = xv[i].z * rinv * gv.z * (1.f + sc.z) + sh.z;
      float h3 = xv[i].w * rinv * gv.w * (1.f + sc.w) + sh.w;
      uint2 o2; o2.x = pack2(h0, h1); o2.y = pack2(h2, h3);
      *(uint2*)(p.H + tm_off(row, c, 16)) = o2;
    }
  }
}

constexpr int G_BK = 64, G_HALF = 128, G_HTB = G_HALF * G_BK * 2;
__device__ __forceinline__ int lds_byte(int r, int c) {
  const int st = (r >> 4) * 2 + (c >> 5), rr = r & 15, cc = c & 31, ob = rr * 64 + cc * 2;
  return st * 1024 + (ob ^ (((ob >> 9) & 1) << 5));
}
__device__ __forceinline__ void stage_rc(int b, int& R, int& C) {
  const int st = b / 1024, sb = b % 1024, swz = sb ^ (((sb >> 9) & 1) << 5);
  R = (st >> 1) * 16 + swz / 64; C = (st & 1) * 32 + (swz % 64) / 2;
}
struct Unit { int pm, pn, seg; };

struct SchedStd {
  int nM, nN, nwg, G, c; const char* A; const char* B; size_t tA, tB;
  __device__ __forceinline__ bool next(int i, Unit& u) const {
    const long L = (long)i * G + c; if (L >= nwg) return false;
    const int wgid = (int)L;
    const int nig = 8 * nN, gid = wgid / nig, fm = gid * 8, gsz = (nM - fm) < 8 ? (nM - fm) : 8;
    u.pm = fm + ((wgid % nig) % gsz); u.pn = (wgid % nig) / gsz; u.seg = 0; return true;
  }
  __device__ __forceinline__ const char* aptr(const Unit& u) const { return A + (size_t)u.pm * tA; }
  __device__ __forceinline__ const char* bptr(const Unit& u) const { return B + (size_t)u.pn * tB; }
};
struct SchedBranch {
  int G, c; const char* P_; const char* W_;
  __device__ __forceinline__ bool next(int i, Unit& u) const {
    if (G == 256) {
      if (i >= 3) return false;
      const int xcd = c >> 5, j = c & 31;
      if (j >= 24) return false;
      u.seg = i; u.pm = xcd * 6 + (j >> 2); u.pn = j & 3; return true;
    }
    const int tile = (i / 3) * G + c; if (tile >= 192) return false;
    u.seg = i % 3; u.pm = tile >> 2; u.pn = tile & 3; return true;
  }
  __device__ __forceinline__ const char* aptr(const Unit& u) const { return P_ + (size_t)((u.seg * 48 + u.pm) * 8) * 32768; }
  __device__ __forceinline__ const char* bptr(const Unit& u) const { return W_ + (size_t)((u.seg * 4 + u.pn) * 8) * 32768; }
};

template <class Epi, class Sched>
__device__ __forceinline__ float gemm_phase(LAS unsigned char* lds, const int K, const Sched& S, const Epi& E, int tmode = 0) {
  unsigned long long t_ph0 = 0, t_epi = 0; if (PROBE >= 20) t_ph0 = __builtin_amdgcn_s_memrealtime();
  const int tid = TIDX, wid = __builtin_amdgcn_readfirstlane(tid >> 6), lane = tid & 63, wr = wid >> 2, wc = wid & 3, fr = lane & 15, fq = lane >> 4;
  const int nt = K / G_BK;
  unsigned voffA[2], voffB[2];
#pragma unroll
  for (int i = 0; i < 2; ++i) { int R, C; stage_rc(tid * 16 + i * 8192, R, C);
    voffA[i] = (unsigned)(R * 64 + C) * 2u; voffB[i] = voffA[i]; }
  const size_t kstep = (size_t)32768;
  const size_t hA = (size_t)16384, hB = (size_t)16384;
  const unsigned ldsw = (unsigned)wid * 1024u;
  const int aoff = lds_byte(wr * 64 + fr, fq * 8), boff = lds_byte(wc * 32 + fr, fq * 8);
#define G_SA(b, h) (((b) * 2 + (h)) * G_HTB)
#define G_SB(b, h) ((4 + (b) * 2 + (h)) * G_HTB)
#define G_STAGE(bufoff, gbase, voff) do { _Pragma("unroll") for (int _i = 0; _i < 2; ++_i) \
    __builtin_amdgcn_global_load_lds((const unsigned*)((const char*)(gbase) + (voff)[_i]), (LAS unsigned*)(lds + (bufoff) + ldsw + _i * 8192), 16, 0, 0); } while (0)
#define G_LDA(dst, b, h) do { _Pragma("unroll") for (int m = 0; m < 4; ++m) _Pragma("unroll") for (int k = 0; k < 2; ++k) dst[m][k] = *(const LAS bf16x8*)(lds + G_SA(b, h) + aoff + m * 2048 + k * 1024); } while (0)
#define G_LDB(dst, b, h) do { _Pragma("unroll") for (int n = 0; n < 2; ++n) _Pragma("unroll") for (int k = 0; k < 2; ++k) dst[n][k] = *(const LAS bf16x8*)(lds + G_SB(b, h) + boff + n * 2048 + k * 1024); } while (0)
#define G_MMA(ai, bj, At, Bt) do { __builtin_amdgcn_s_setprio(1); _Pragma("unroll") for (int m = 0; m < 4; ++m) _Pragma("unroll") for (int n = 0; n < 2; ++n) _Pragma("unroll") for (int k = 0; k < 2; ++k) \
    acc[ai][bj][m][n] = __builtin_amdgcn_mfma_f32_16x16x32_bf16(Bt[n][k], At[m][k], acc[ai][bj][m][n], 0, 0, 0); __builtin_amdgcn_s_setprio(0); } while (0)
#define G_WAIT_V(n) asm volatile("s_waitcnt vmcnt(" #n ")" ::: "memory")
#define G_WAIT_L(n) asm volatile("s_waitcnt lgkmcnt(" #n ")" ::: "memory")
#define G_BAR __builtin_amdgcn_s_barrier()
#define G_SCHED __builtin_amdgcn_sched_barrier(0)
  Unit cur, nxt; int ui = 0;
  if (!S.next(0, cur)) return 0.f;
  f32x4 acc[2][2][4][2];
#pragma unroll
  for (int a = 0; a < 2; ++a)
#pragma unroll
    for (int b = 0; b < 2; ++b)
#pragma unroll
      for (int m = 0; m < 4; ++m)
#pragma unroll
        for (int n = 0; n < 2; ++n) acc[a][b][m][n] = (f32x4){0.f, 0.f, 0.f, 0.f};
  bf16x8 At[4][2], B0[2][2], B1[2][2];
  const char* cA = S.aptr(cur); const char* cB = S.bptr(cur);
  G_STAGE(G_SB(0, 0), cB, voffB); G_STAGE(G_SA(0, 0), cA, voffA); G_STAGE(G_SB(0, 1), cB + hB, voffB); G_STAGE(G_SA(0, 1), cA + hA, voffA);
  if (wr == 1) G_BAR;
  G_WAIT_V(4); G_BAR;
  G_STAGE(G_SB(1, 0), cB + kstep, voffB); G_STAGE(G_SA(1, 0), cA + kstep, voffA); G_STAGE(G_SB(1, 1), cB + hB + kstep, voffB);
  G_WAIT_V(6); G_BAR;
  for (;;) {
    const bool has_next = S.next(ui + 1, nxt);
    const char* nA = has_next ? S.aptr(nxt) : cA; const char* nB = has_next ? S.bptr(nxt) : cB;
    for (int t = 0; t < nt; t += 2) {
      const bool last = (t == nt - 2);
      const char* a1 = cA + (size_t)(t + 1) * kstep;
      const char* a2 = last ? nA : cA + (size_t)(t + 2) * kstep; const char* b2 = last ? nB : cB + (size_t)(t + 2) * kstep;
      const char* a3 = a2 + kstep; const char* b3 = b2 + kstep;
      G_LDB(B0, 0, 0); G_SCHED; G_LDA(At, 0, 0); G_STAGE(G_SA(1, 1), a1 + hA, voffA);
      G_WAIT_L(8); G_BAR; G_WAIT_L(0); G_MMA(0, 0, At, B0); G_BAR; G_SCHED;
      G_LDB(B1, 0, 1); G_STAGE(G_SB(0, 0), b2, voffB);
      G_BAR; G_WAIT_L(0); G_MMA(0, 1, At, B1); G_BAR;
      G_LDA(At, 0, 1); G_STAGE(G_SA(0, 0), a2, voffA);
      G_BAR; G_WAIT_L(0); G_MMA(1, 0, At, B0); G_BAR; G_SCHED;
      G_STAGE(G_SB(0, 1), b2 + hB, voffB);
      G_WAIT_V(6); G_BAR; G_MMA(1, 1, At, B1); G_BAR;
      G_LDB(B0, 1, 0); G_SCHED; G_LDA(At, 1, 0); G_STAGE(G_SA(0, 1), a2 + hA, voffA);
      G_WAIT_L(8); G_BAR; G_WAIT_L(0); G_MMA(0, 0, At, B0); G_BAR; G_SCHED;
      G_LDB(B1, 1, 1); G_STAGE(G_SB(1, 0), b3, voffB);
      G_BAR; G_WAIT_L(0); G_MMA(0, 1, At, B1); G_BAR;
      G_LDA(At, 1, 1); G_STAGE(G_SA(1, 0), a3, voffA);
      G_BAR; G_WAIT_L(0); G_MMA(1, 0, At, B0); G_BAR; G_SCHED;
      G_STAGE(G_SB(1, 1), b3 + hB, voffB);
      G_WAIT_V(6); G_BAR; G_MMA(1, 1, At, B1); G_BAR;
    }
    unsigned long long t_e0 = 0; if (PROBE >= 20) t_e0 = __builtin_amdgcn_s_memrealtime();
    const bool reset = E(acc, cur, wr, wc, fr, fq);
    if (PROBE >= 20) { asm volatile("s_waitcnt vmcnt(0)" ::: "memory"); t_epi += __builtin_amdgcn_s_memrealtime() - t_e0; }
    if (!has_next) break;
    if (reset) {
#pragma unroll
      for (int a = 0; a < 2; ++a)
#pragma unroll
        for (int b = 0; b < 2; ++b)
#pragma unroll
          for (int m = 0; m < 4; ++m)
#pragma unroll
            for (int n = 0; n < 2; ++n) acc[a][b][m][n] = (f32x4){0.f, 0.f, 0.f, 0.f};
    }
    cur = nxt; cA = nA; cB = nB; ++ui;
  }
  G_WAIT_V(0);
  if (wr == 0) G_BAR;
  G_BAR;
  float tres = 0.f;
  if (PROBE >= 20) {
    const unsigned long long tot = __builtin_amdgcn_s_memrealtime() - t_ph0;
    tres = (tmode == 0) ? (float)t_epi / (float)tot : (float)tot / 40000.f;
  }
#undef G_SA
#undef G_SB
#undef G_STAGE
#undef G_LDA
#undef G_LDB
#undef G_MMA
#undef G_WAIT_V
#undef G_WAIT_L
#undef G_BAR
#undef G_SCHED
  return tres;
}

struct EpiInproj {
  const Params* pp; int l; LAS float* part;
  __device__ __forceinline__ bool operator()(f32x4 (&acc)[2][2][4][2], const Unit& u, int wr, int wc, int fr, int fq) const {
    const Params& p = *pp;
    asm volatile("" : "+v"(fr), "+v"(fq));
    const int lane = fr + 16 * fq; (void)lane;
    const int oc0 = u.pn * 256;
    const bool isctx = u.pm < 16;
    const bool qkU = (oc0 < 768) || (oc0 >= 2304 && oc0 < 3328);
    float rinv[2][4][2];
    if (qkU) {
#pragma unroll
      for (int ai = 0; ai < 2; ai++)
#pragma unroll
        for (int m = 0; m < 4; m++)
#pragma unroll
          for (int bj = 0; bj < 2; bj++) {
            f32x4 a = acc[ai][bj][m][0], b = acc[ai][bj][m][1];
            float ss = a[0] * a[0] + a[1] * a[1] + a[2] * a[2] + a[3] * a[3] + b[0] * b[0] + b[1] * b[1] + b[2] * b[2] + b[3] * b[3];
            ss += shflx(ss, 16, lane); ss += shflx(ss, 32, lane);
            rinv[ai][m][bj] = ss;
            if (fq == 0) part[((ai * 128 + wr * 64 + m * 16 + fr) * 2 + bj) * 4 + wc] = ss;
          }
      asm volatile("s_waitcnt lgkmcnt(0)" ::: "memory");
      __builtin_amdgcn_s_barrier();
      asm volatile("" ::: "memory");
#pragma unroll
      for (int ai = 0; ai < 2; ai++)
#pragma unroll
        for (int m = 0; m < 4; m++)
#pragma unroll
          for (int bj = 0; bj < 2; bj++) {
            float o = part[((ai * 128 + wr * 64 + m * 16 + fr) * 2 + bj) * 4 + (wc ^ 1)];
            rinv[ai][m][bj] = rsqrtf((rinv[ai][m][bj] + o) * (1.f / 64.f) + EPS);
          }
    }
#pragma unroll
    for (int bj = 0; bj < 2; bj++) {
      const int oc = oc0 + bj * 128;
      if (oc == 640 || (oc >= 3328 && oc < 3840)) {
        const bool isA = (oc == 640);
        const int cb = isA ? 0 : (oc - 3328);
        const int nvec = isA ? 128 : 512;
#pragma unroll
        for (int ai = 0; ai < 2; ai++)
#pragma unroll
          for (int m = 0; m < 4; m++) {
            const int row = u.pm * 256 + ai * 128 + wr * 64 + m * 16 + fr;
            int b, t, T; u16* vt;
            if (isctx) { b = row >> 8; t = row & 255; T = 256; vt = isA ? p.VtA_ctx : p.VtC_ctx; }
            else { int rr = row - NCTX; b = rr >> 12; t = rr & 4095; T = 4096; vt = isA ? p.VtA_lat : p.VtC_lat; }
#pragma unroll
            for (int n = 0; n < 2; n++) {
              const int d = cb + wc * 32 + n * 16 + fq * 4;
              f32x4 v = acc[ai][bj][m][n];
#pragma unroll
              for (int j = 0; j < 4; j++) vt[((size_t)b * nvec + d + j) * T + t] = f2bf(v[j]);
              if (isctx) {
                float* o = p.out + (isA ? O_VA : O_VC) + ((size_t)(b * 2 + l) * 256 + t) * nvec + d;
                *(f32x4*)o = v;
              }
            }
          }
      } else {
        const int pc = (oc < 640) ? oc : (oc < 3328 ? oc - 128 : oc - 640);
        const bool is_qa = oc < 512, is_ka = (oc == 512);
        const bool is_qc = (oc >= 2304 && oc < 2816), is_kc = (oc >= 2816 && oc < 3328);
        if (is_qa || is_ka || is_qc || is_kc) {
          const float* gn = (is_qa ? p.qn_a : is_ka ? p.kn_a : is_qc ? p.qn_c : p.kn_c) + l * 64 + (wc & 1) * 32 + fq * 4;
          const f32x4 g0 = *(const f32x4*)gn, g1 = *(const f32x4*)(gn + 16);
          const float qs = (is_qa || is_qc) ? 0.18033688011112042f : 1.f;
#pragma unroll
          for (int ai = 0; ai < 2; ai++)
#pragma unroll
            for (int m = 0; m < 4; m++) {
              const int row = u.pm * 256 + ai * 128 + wr * 64 + m * 16 + fr;
              const float ri = rinv[ai][m][bj];
              f32x4 x1 = acc[ai][bj][m][0] * ri * g0, x2 = acc[ai][bj][m][1] * ri * g1;
              if (!isctx) {
                const int t = (row - NCTX) & 4095;
                const int pos = (wc & 1) ? (t & 63) : (t >> 6);
                const f32x4 cs = *(const f32x4*)(p.rope + pos * 16 + fq * 4), sn = *(const f32x4*)(p.rope + 1024 + pos * 16 + fq * 4);
                f32x4 y1 = x1 * cs - x2 * sn, y2 = x2 * cs + x1 * sn;
                x1 = y1; x2 = y2;
              } else if (is_ka || is_kc) {
                const int b = row >> 8, t = row & 255;
                float* o = is_ka ? p.out + O_KA + ((size_t)(b * 2 + l) * 256 + t) * 128 + wc * 32 + fq * 4
                                 : p.out + O_KC + ((size_t)(b * 2 + l) * 256 + t) * 512 + (oc - 2816) + wc * 32 + fq * 4;
                *(f32x4*)o = x1; *(f32x4*)(o + 16) = x2;
              }
              x1 = x1 * qs; x2 = x2 * qs;
              u16* po = p.P + (size_t)row * PP + pc + wc * 32 + fq * 4;
              *(uint2*)po = make_uint2(pack2(x1[0], x1[1]), pack2(x1[2], x1[3]));
              *(uint2*)(po + 16) = make_uint2(pack2(x2[0], x2[1]), pack2(x2[2], x2[3]));
            }
        } else {
          const int mode = (oc >= 4352) ? 2 : ((oc >= 1280 && oc < 1792) ? 0 : 1);
          if (mode == 2) {
            const int pj = u.pn - 17, seg = pj >> 2, pn4 = pj & 3;
            unsigned* mg = p.MG + ((size_t)((u.pm * 4 + pn4) * 3 + seg) * 8 + (wr * 4 + wc)) * 2048 + lane;
#pragma unroll
            for (int ai = 0; ai < 2; ai++)
#pragma unroll
              for (int m = 0; m < 4; m++)
#pragma unroll
                for (int n = 0; n < 2; n++) {
                  f32x4 v = acc[ai][bj][m][n];
                  const unsigned q0 = (unsigned)(sigmoidf_(v[0]) * 254.f + 1.5f), q1 = (unsigned)(sigmoidf_(v[1]) * 254.f + 1.5f);
                  const unsigned q2 = (unsigned)(sigmoidf_(v[2]) * 254.f + 1.5f), q3 = (unsigned)(sigmoidf_(v[3]) * 254.f + 1.5f);
                  mg[(((ai * 4 + m) * 2 + bj) * 2 + n) * 64] = q0 | (q1 << 8) | (q2 << 16) | (q3 << 24);
                }
          } else
#pragma unroll
          for (int ai = 0; ai < 2; ai++)
#pragma unroll
            for (int m = 0; m < 4; m++) {
              const int row = u.pm * 256 + ai * 128 + wr * 64 + m * 16 + fr;
              u16* po = p.P + (size_t)row * PP + pc + wc * 32 + fq * 4;
#pragma unroll
              for (int n = 0; n < 2; n++) {
                f32x4 v = acc[ai][bj][m][n];
                if (mode == 1) { v[0] = siluf_(v[0]); v[1] = siluf_(v[1]); v[2] = siluf_(v[2]); v[3] = siluf_(v[3]); }
                else if (mode == 2) { v[0] = sigmoidf_(v[0]); v[1] = sigmoidf_(v[1]); v[2] = sigmoidf_(v[2]); v[3] = sigmoidf_(v[3]); }
                *(uint2*)(po + n * 16) = make_uint2(pack2(v[0], v[1]), pack2(v[2], v[3]));
              }
            }
        }
      }
    }
    return true;
  }
};

struct EpiBranch {
  const Params* pp;
  __device__ __forceinline__ bool operator()(f32x4 (&acc)[2][2][4][2], const Unit& u, int wr, int wc, int fr, int fq) const {
    const Params& p = *pp;
    asm volatile("" : "+v"(fr), "+v"(fq));
    const int lane = fr + 16 * fq;
    const int seg = u.seg;
    const unsigned* mg = p.MG + ((size_t)((u.pm * 4 + u.pn) * 3 + seg) * 8 + (wr * 4 + wc)) * 2048 + lane;
#pragma unroll
    for (int ai = 0; ai < 2; ai++)
#pragma unroll
      for (int m = 0; m < 4; m++) {
        const int row = u.pm * 256 + ai * 128 + wr * 64 + m * 16 + fr;
#pragma unroll
        for (int bj = 0; bj < 2; bj++)
#pragma unroll
          for (int n = 0; n < 2; n++) {
            const int idx = (((ai * 4 + m) * 2 + bj) * 2 + n) * 64;
            const unsigned a = mg[idx];
            f32x4 f = {(float)(a & 255u), (float)((a >> 8) & 255u), (float)((a >> 16) & 255u), (float)(a >> 24)};
            if (seg < 2) {
              const unsigned b = mg[idx + 8 * 2048];
              f[0] = __fdividef(f[0], (float)(b & 255u)); f[1] = __fdividef(f[1], (float)((b >> 8) & 255u));
              f[2] = __fdividef(f[2], (float)((b >> 16) & 255u)); f[3] = __fdividef(f[3], (float)(b >> 24));
              acc[ai][bj][m][n] = acc[ai][bj][m][n] * f;
            } else {
              const int col = u.pn * 256 + bj * 128 + wc * 32 + n * 16 + fq * 4;
              f32x4 v = acc[ai][bj][m][n] * f * (1.f / 255.f);
              *(uint2*)(p.Y + tm_off(row, col, 16)) = make_uint2(pack2(v[0], v[1]), pack2(v[2], v[3]));
            }
          }
      }
    return seg == 2;
  }
};

struct EpiOut {
  const Params* pp; int l;
  __device__ __forceinline__ bool operator()(f32x4 (&acc)[2][2][4][2], const Unit& u, int wr, int wc, int fr, int fq) const {
    const Params& p = *pp;
    asm volatile("" : "+v"(fr), "+v"(fq));
    const int lane = fr + 16 * fq; (void)lane;
    const int v = (u.pm < 16) ? 0 : 1 + (u.pm - 16) / 16;
    const float* gt = p.mod + (l * 3 + v) * 3072 + 2048;
#pragma unroll
    for (int ai = 0; ai < 2; ai++)
#pragma unroll
      for (int m = 0; m < 4; m++) {
        const int row = u.pm * 256 + ai * 128 + wr * 64 + m * 16 + fr;
        const float* xr;
        if (l == 0) xr = (row < NCTX) ? p.x_prompt + (size_t)row * 1024 : p.x_sample + (size_t)(row - NCTX) * 1024;
        else xr = p.out + O_X + (size_t)row * 1024;
        float* orow = p.out + O_X + (size_t)row * 1024;
#pragma unroll
        for (int bj = 0; bj < 2; bj++)
#pragma unroll
          for (int n = 0; n < 2; n++) {
            const int col = u.pn * 256 + bj * 128 + wc * 32 + n * 16 + fq * 4;
            const f32x4 xv = *(const f32x4*)(xr + col), gv = *(const f32x4*)(gt + col);
            *(f32x4*)(orow + col) = xv + gv * acc[ai][bj][m][n];
          }
      }
    return true;
  }
};

template <bool MASK>
__device__ __forceinline__ void fs_scores(const u16* Ks, const bf16x8 (&qf)[4], f32x16 (&s)[2], int lane, int kpos0, int qpos, int T) {
  const int r = lane & 31, h = lane >> 5;
  {
    bf16x8 kf[2][4];
#pragma unroll
    for (int sub = 0; sub < 2; sub++)
#pragma unroll
      for (int ks = 0; ks < 4; ks++) kf[sub][ks] = *(const bf16x8*)(Ks + (sub * 32 + r) * LROW + ks * 16 + h * 8);
    __builtin_amdgcn_sched_barrier(0);
#pragma unroll
    for (int sub = 0; sub < 2; sub++) {
#pragma unroll
      for (int e = 0; e < 16; e++) s[sub][e] = 0.f;
#pragma unroll
      for (int ks = 0; ks < 4; ks++) s[sub] = mfma32(kf[sub][ks], qf[ks], s[sub]);
    }
  }
  if (MASK) {
#pragma unroll
    for (int sub = 0; sub < 2; sub++)
#pragma unroll
      for (int e = 0; e < 16; e++) {
        int kp = kpos0 + sub * 32 + (e & 3) + 8 * (e >> 2) + 4 * h;
        int dlt = kp - qpos;
        bool ok = (kp >= 0) && (kp < T) && (dlt <= 128) && (dlt >= -128);
        if (!ok) s[sub][e] = -INFINITY;
      }
  }
}
template <int DV>
__device__ __forceinline__ void fs_softmax(f32x16 (&s)[2], float& m, float& l, f32x16 (&o)[DV / 32], bf16x8 (&pf)[2][2], int lane) {
  float mx = s[0][0];
#pragma unroll
  for (int sub = 0; sub < 2; sub++)
#pragma unroll
    for (int e = 0; e < 16; e++) mx = fmaxf(mx, s[sub][e]);
  mx = fmaxf(mx, shflx(mx, 32, lane));
  const bool grow = mx > m;
  const float mn = grow ? mx : m;
  float sum = 0.f;
#pragma unroll
  for (int sub = 0; sub < 2; sub++)
#pragma unroll
    for (int e = 0; e < 16; e++) { float pv = __builtin_amdgcn_exp2f(s[sub][e] - mn); s[sub][e] = pv; sum += pv; }
  sum += shflx(sum, 32, lane);
  if (__builtin_amdgcn_ballot_w64(grow) != 0ull) {
    const float alpha = __builtin_amdgcn_exp2f(m - mn);
    l *= alpha;
#pragma unroll
    for (int ds = 0; ds < DV / 32; ds++)
#pragma unroll
      for (int e = 0; e < 16; e++) o[ds][e] *= alpha;
  }
  l += sum; m = mn;
  typedef __attribute__((ext_vector_type(4))) unsigned u32x4;
#pragma unroll
  for (int sub = 0; sub < 2; sub++)
#pragma unroll
    for (int st = 0; st < 2; st++) {
      u32x4 pw;
#pragma unroll
      for (int j = 0; j < 4; j++) pw[j] = pack2(s[sub][8 * st + 2 * j], s[sub][8 * st + 2 * j + 1]);
      pf[sub][st] = __builtin_bit_cast(bf16x8, pw);
    }
}
template <int DV>
__device__ __forceinline__ void fs_pv(const bf16x8 (&pf)[2][2], const u16* Vts, f32x16 (&o)[DV / 32], int lane) {
  const int r = lane & 31, h = lane >> 5;
#pragma unroll
  for (int sub = 0; sub < 2; sub++) {
    bf16x8 vf[2][DV / 32];
#pragma unroll
    for (int st = 0; st < 2; st++)
#pragma unroll
      for (int ds = 0; ds < DV / 32; ds++) {
        const u16* vp = Vts + (ds * 32 + r) * VROW + sub * 32 + 16 * st + 4 * h;
        bf16x4 lo = *(const bf16x4*)vp, hi = *(const bf16x4*)(vp + 8);
        vf[st][ds] = __builtin_shufflevector(lo, hi, 0, 1, 2, 3, 4, 5, 6, 7);
      }
    __builtin_amdgcn_sched_barrier(0);
#pragma unroll
    for (int st = 0; st < 2; st++)
#pragma unroll
      for (int ds = 0; ds < DV / 32; ds++) o[ds] = mfma32(vf[st][ds], pf[sub][st], o[ds]);
    __builtin_amdgcn_sched_barrier(0);
  }
}

__device__ __forceinline__ uint4 ld_k(const u16* __restrict__ src, size_t pitch, int r0, int nrows, int c) {
  int row = c >> 3, kc = c & 7; int rr = r0 + row;
  uint4 v = make_uint4(0, 0, 0, 0);
  if (rr >= 0 && rr < nrows) v = *(const uint4*)(src + (size_t)rr * pitch + kc * 8);
  return v;
}
__device__ __forceinline__ void st_k(u16* dst, int c, uint4 v) { *(uint4*)(dst + (c >> 3) * LROW + (c & 7) * 8) = v; }
__device__ __forceinline__ uint4 ld_vt(const u16* __restrict__ src, int T, int k0, int c) {
  int d = c >> 3, kc = c & 7; int k = k0 + kc * 8;
  uint4 v = make_uint4(0, 0, 0, 0);
  if (k >= 0 && k < T) v = *(const uint4*)(src + (size_t)d * T + k);
  return v;
}
__device__ __forceinline__ void st_vt(u16* dst, int c, uint4 v) {
  uint2* q = (uint2*)(dst + (c >> 3) * VROW + (c & 7) * 8);
  q[0] = make_uint2(v.x, v.y); q[1] = make_uint2(v.z, v.w);
}

constexpr int A_BUF = 64 * LROW + 64 * VROW;
__device__ __forceinline__ void attnA_item(const Params& p, int l, int it, u16* sm, bool dry = false) {
  const int tid = TIDX, lane = tid & 63, wid = tid >> 6;
  const int r = lane & 31, h = lane >> 5;
  const bool isctx = it < 128;
  int b, kvh, qb, T, rowbase; const u16* VtBase;
  if (isctx) { b = it >> 3; kvh = (it >> 2) & 1; qb = it & 3; T = 256; rowbase = b * 256;
    VtBase = p.VtA_ctx + ((size_t)(b * 2 + kvh) * 64) * 256; }
  else { int j = it - 128; b = j >> 7; kvh = (j >> 6) & 1; qb = j & 63; T = 4096; rowbase = NCTX + b * 4096;
    VtBase = p.VtA_lat + ((size_t)(b * 2 + kvh) * 64) * 4096; }
  const int qblk = qb * 64;
  const int q0 = qblk + (wid >> 2) * 32;
  const int head = kvh * 4 + (wid & 3);
  const size_t prow = (size_t)(rowbase + q0 + r) * PP;
  bf16x8 qf[4];
#pragma unroll
  for (int ks = 0; ks < 4; ks++) qf[ks] = *(const bf16x8*)(p.P + prow + C_QA + head * 64 + ks * 16 + h * 8);
  float m = p.sink_a[l * 8 + head] * 1.4426950408889634f, ls = 1.f;
  f32x16 o[2];
#pragma unroll
  for (int ds = 0; ds < 2; ds++)
#pragma unroll
    for (int e = 0; e < 16; e++) o[ds][e] = 0.f;
  const u16* Kbase = p.P + (size_t)rowbase * PP + C_KA + kvh * 64;
  const u16* cK = p.cKa + ((size_t)(b * 2 + l) * 512) * 128 + kvh * 64;
  const u16* cVt = p.cVtA + ((size_t)((b * 2 + l) * 2 + kvh) * 64) * 512;
  const int qpos = q0 + r;
  int i_lo = 0, nW, ntile;
  if (isctx) { nW = 4; ntile = 4; }
  else {
    i_lo = (qblk < 128) ? (128 - qblk) / 64 : 0;
    int i_hi = (T - qblk + 128) / 64; if (i_hi > 5) i_hi = 5;
    nW = i_hi - i_lo; ntile = nW + 8;
  }
  uint4 rk, rv;
  auto tile_load = [&](int t) {
    if (t < nW) {
      int k0 = isctx ? t * 64 : qblk - 128 + 64 * (i_lo + t);
      rk = ld_k(Kbase, PP, k0, T, tid); rv = ld_vt(VtBase, T, k0, tid);
    } else {
      int kt = t - nW;
      rk = ld_k(cK, 128, kt * 64, 512, tid); rv = ld_vt(cVt, 512, kt * 64, tid);
    }
  };
  auto KB = [&](int i) { return sm + (i & 1) * (64 * LROW); };
  auto VB = [&](int i) { return sm + 2 * 64 * LROW + (i % 3) * (64 * VROW); };
  const bool lag = (wid >> 2) != 0;
  __syncthreads();
  tile_load(0);
  st_k(KB(0), tid, rk); st_vt(VB(0), tid, rv);
  __syncthreads();
  bf16x8 pf[2][2];
  for (int t = 0; t <= ntile; t++) {
    const bool more = t + 1 < ntile;
    if (more) tile_load(t + 1);
    if (lag && t > 0) fs_pv<64>(pf, VB(t - 1), o, lane);
    if (t < ntile) {
      f32x16 sc[2];
      if (!isctx && t < nW) fs_scores<true>(KB(t), qf, sc, lane, qblk - 128 + 64 * (i_lo + t), qpos, T);
      else fs_scores<false>(KB(t), qf, sc, lane, 0, 0, T);
      fs_softmax<64>(sc, m, ls, o, pf, lane);
      if (!lag) fs_pv<64>(pf, VB(t), o, lane);
    }
    if (more) { st_k(KB(t + 1), tid, rk); st_vt(VB(t + 1), tid, rv); }
    __syncthreads();
  }
  const float inv = __builtin_amdgcn_rcpf(ls);
#pragma unroll
  for (int ds = 0; ds < 2; ds++)
#pragma unroll
    for (int g = 0; g < 4; g++) {
      int d = ds * 32 + 8 * g + 4 * h;
      uint2 gv = *(const uint2*)(p.P + prow + C_GA + head * 64 + d);
      uint2 ov;
      ov.x = pack2(o[ds][4 * g] * inv * lo_bf(gv.x), o[ds][4 * g + 1] * inv * hi_bf(gv.x));
      ov.y = pack2(o[ds][4 * g + 2] * inv * lo_bf(gv.y), o[ds][4 * g + 3] * inv * hi_bf(gv.y));
      *(uint2*)(p.GB + tm_off(rowbase + q0 + r, head * 64 + d, 8)) = ov;
    }
}

constexpr int C_BUF = 128 * LROW + 128 * VROW;
__device__ __forceinline__ void attnC_item(const Params& p, int l, int it, u16* sm, float lam, float lam_init, bool dry = false) {
  const int tid = TIDX, lane = tid & 63, wid = tid >> 6;
  const int r = lane & 31, h = lane >> 5;
  const bool isctx = it < 128;
  int b, hd, qb, T, rowbase; const u16* VtBase;
  if (isctx) { b = it >> 3; hd = (it >> 1) & 3; qb = it & 1; T = 256; rowbase = b * 256;
    VtBase = p.VtC_ctx + ((size_t)(b * 4 + hd) * 128) * 256; }
  else { int j = it - 128; b = j >> 7; hd = (j >> 5) & 3; qb = j & 31; T = 4096; rowbase = NCTX + b * 4096;
    VtBase = p.VtC_lat + ((size_t)(b * 4 + hd) * 128) * 4096; }
  const int qg = wid & 3, map = wid >> 2;
  const int q0 = qb * 128 + qg * 32;
  const size_t prow = (size_t)(rowbase + q0 + r) * PP;
  bf16x8 qf[4];
#pragma unroll
  for (int ks = 0; ks < 4; ks++) qf[ks] = *(const bf16x8*)(p.P + prow + C_QC + hd * 128 + map * 64 + ks * 16 + h * 8);
  float m = -1e30f, ls = 0.f;
  f32x16 o[4];
#pragma unroll
  for (int ds = 0; ds < 4; ds++)
#pragma unroll
    for (int e = 0; e < 16; e++) o[ds][e] = 0.f;
  const u16* Kbase = p.P + (size_t)rowbase * PP + C_KC + hd * 128;
  const u16* cK = p.cKc + ((size_t)(b * 2 + l) * 512) * 512 + hd * 128;
  const u16* cVt = p.cVtC + ((size_t)((b * 2 + l) * 4 + hd) * 128) * 512;
  const int nW = T / 64, ntile = isctx ? nW : nW + 8;
  uint4 rk0, rk1, rv0, rv1;
  auto tile_load = [&](int t) {
    if (t < nW) {
      rk0 = ld_k(Kbase, PP, t * 64, T, tid); rk1 = ld_k(Kbase + 64, PP, t * 64, T, tid);
      rv0 = ld_vt(VtBase, T, t * 64, tid); rv1 = ld_vt(VtBase, T, t * 64, tid + NT);
    } else {
      int kt = t - nW;
      rk0 = ld_k(cK, 512, kt * 64, 512, tid); rk1 = ld_k(cK + 64, 512, kt * 64, 512, tid);
      rv0 = ld_vt(cVt, 512, kt * 64, tid); rv1 = ld_vt(cVt, 512, kt * 64, tid + NT);
    }
  };
  auto KB = [&](int i) { return sm + (i & 1) * (128 * LROW); };
  auto VB = [&](int i) { return sm + 2 * 128 * LROW + (i % 3) * (128 * VROW); };
  auto tile_store = [&](int i) {
    u16* kd = KB(i); u16* vd = VB(i);
    st_k(kd, tid, rk0); st_k(kd + 64 * LROW, tid, rk1);
    st_vt(vd, tid, rv0); st_vt(vd, tid + NT, rv1);
  };
  const bool lag = map != 0;
  __syncthreads();
  tile_load(0);
  tile_store(0);
  __syncthreads();
  bf16x8 pf[2][2];
  for (int t = 0; t <= ntile; t++) {
    const bool more = t + 1 < ntile;
    if (more) tile_load(t + 1);
    if (lag && t > 0) fs_pv<128>(pf, VB(t - 1), o, lane);
    if (t < ntile) {
      f32x16 sc[2];
      fs_scores<false>(KB(t) + map * 64 * LROW, qf, sc, lane, 0, 0, T);
      fs_softmax<128>(sc, m, ls, o, pf, lane);
      if (!lag) fs_pv<128>(pf, VB(t), o, lane);
    }
    if (more) tile_store(t + 1);
    __syncthreads();
  }
  float* xch = (float*)sm;
  if (map == 1) {
    const float inv = lam * __builtin_amdgcn_rcpf(ls);
#pragma unroll
    for (int ds = 0; ds < 4; ds++)
#pragma unroll
      for (int e = 0; e < 16; e++) xch[((qg * 64) + ds * 16 + e) * 64 + lane] = o[ds][e] * inv;
  }
  __syncthreads();
  if (map == 0) {
    const float i0 = __builtin_amdgcn_rcpf(ls);
    float ss = 0.f;
#pragma unroll
    for (int ds = 0; ds < 4; ds++)
#pragma unroll
      for (int e = 0; e < 16; e++) {
        float v = o[ds][e] * i0 - xch[((qg * 64) + ds * 16 + e) * 64 + lane];
        o[ds][e] = v; ss += v * v;
      }
    ss += shflx(ss, 32, lane);
    const float rinv = rsqrtf(ss * (1.f / 128.f) + EPS) * (1.f - lam_init);
    const float* sg = p.subln_c + l * 128;
#pragma unroll
    for (int ds = 0; ds < 4; ds++)
#pragma unroll
      for (int g = 0; g < 4; g++) {
        int d = ds * 32 + 8 * g + 4 * h;
        uint2 gv = *(const uint2*)(p.P + prow + C_GC + hd * 128 + d);
        float4 sl = *(const float4*)(sg + d);
        uint2 ov;
        ov.x = pack2(o[ds][4 * g] * rinv * sl.x * lo_bf(gv.x), o[ds][4 * g + 1] * rinv * sl.y * hi_bf(gv.x));
        ov.y = pack2(o[ds][4 * g + 2] * rinv * sl.z * lo_bf(gv.y), o[ds][4 * g + 3] * rinv * sl.w * hi_bf(gv.y));
        *(uint2*)(p.GB + (size_t)2 * NTOK * 512 + tm_off(rowbase + q0 + r, hd * 128 + d, 8)) = ov;
      }
  }
}

__device__ __forceinline__ void lru_run(const Params& p, int l, bool pass2, int start, int G, float* sm, bool dry = false) {
  const int tid = TIDX;
  const int lane = tid & 63, wid = tid >> 6, r = lane & 31, h = lane >> 5;
  const int n = start & 7;
  float* xin = sm;
  float* xb = sm + 67 * 64;
  float* comb = xb + 64 * 64;
  float* carry = comb + 2048;
  float* parts = carry + 128;
  float* ab = parts + 1024;
  u16* xbh = (u16*)(ab + 4 * 4096);
  const int gd = wid >> 2, gth = (wid >> 1) & 1, gdh = wid & 1;
  bf16x8 wfa[4], wfx[4];
  {
    const u16* wbase = p.Wt_lru + ((size_t)(((l * 2 + gd) * 8 + n) * 2) * 64 + gdh * 32 + r) * 64 + h * 8;
#pragma unroll
    for (int ks = 0; ks < 4; ks++) { wfa[ks] = *(const bf16x8*)(wbase + ks * 16); wfx[ks] = *(const bf16x8*)(wbase + 4096 + ks * 16); }
  }
  const int gch = n * 64 + gdh * 32 + r;
  const float g_ba = p.lru_ba[(l * 2 + gd) * 512 + gch], g_bx = p.lru_bx[(l * 2 + gd) * 512 + gch];
  const float g_sp = log1pf(__expf(-p.lru_lam[(l * 2 + gd) * 512 + gch]));
  const int cc = tid & 63;
  float cw[4]; float cbv;
  {
    const float* cwp = p.conv_w + l * 4 * 512 + n * 64 + cc;
    cw[0] = cwp[0]; cw[1] = cwp[512]; cw[2] = cwp[1024]; cw[3] = cwp[1536];
    cbv = p.conv_b[l * 512 + n * 64 + cc];
  }
  const int dout = tid & 63, tg = tid >> 6;
  const int ch = n * 64 + dout;

  u16 xr[9];
  auto xin_load = [&](int it_) {
    const int row0_ = (it_ >> 3) * 64;
    int T_, seq0_;
    if (row0_ < NCTX) { T_ = 256; seq0_ = (row0_ >> 8) * 256; } else { T_ = 4096; seq0_ = NCTX + ((row0_ - NCTX) >> 12) * 4096; }
    const int t0_ = row0_ - seq0_;
#pragma unroll
    for (int k = 0; k < 9; k++) {
      const int rr = (tid >> 6) + 8 * k; const int t = t0_ - 2 + rr;
      u16 v = 0;
      if (rr < 67 && t >= 0 && t < T_) v = p.P[(size_t)(seq0_ + t) * PP + C_XB + n * 64 + cc];
      xr[k] = v;
    }
  };
  if (start < 1536) xin_load(start);
  for (int it = start; it < 1536; it += G) {
    const int ci = it >> 3;
    const int row0 = ci * 64;
    const bool isctx = row0 < NCTX;
    int T, seq0, bidx;
    if (isctx) { T = 256; bidx = row0 >> 8; seq0 = bidx * 256; }
    else { T = 4096; bidx = (row0 - NCTX) >> 12; seq0 = NCTX + bidx * 4096; }
    const int t0 = row0 - seq0;
    __syncthreads();
#pragma unroll
    for (int k = 0; k < 9; k++) { const int rr = (tid >> 6) + 8 * k; if (rr < 67) xin[rr * 64 + cc] = bf2f(xr[k]); }
    if (it + G < 1536) xin_load(it + G);
    u16 sgr[8];
    if (pass2) {
#pragma unroll
      for (int tt = 0; tt < 8; tt++) sgr[tt] = p.P[(size_t)(row0 + tg * 8 + tt) * PP + C_GB + ch];
    }
    if (pass2) {
      const int d = (tid >> 6) & 1, part = tid >> 7;
      const int cfirst = seq0 >> 6, clast = (seq0 + T - 64) >> 6;
      const int K = d ? (clast - ci) : (ci - cfirst);
      float2 q[16];
#pragma unroll
      for (int k = 0; k < 16; k++) {
        const int kk = part * 16 + k;
        const int cj = d ? (clast - kk) : (cfirst + kk);
        q[k] = make_float2(1.f, 0.f);
        if (kk < K) q[k] = *(const float2*)(p.lruTot + ((size_t)(cj * 2 + d) * 512 + n * 64 + cc) * 2);
      }
      float At = 1.f, Bt = 0.f;
#pragma unroll
      for (int k = 0; k < 16; k++) { Bt = q[k].x * Bt + q[k].y; At *= q[k].x; }
      parts[((part * 2 + d) * 64 + cc) * 2] = At; parts[((part * 2 + d) * 64 + cc) * 2 + 1] = Bt;
    }
    __syncthreads();
    for (int e = tid; e < 64 * 64; e += NT) {
      int t = e >> 6;
      float v = cbv;
#pragma unroll
      for (int j = 0; j < 4; j++) v += xin[(t + j) * 64 + cc] * cw[j];
      xb[e] = v;
      xbh[t * LROW + cc] = f2bf(v);
    }
    if (pass2 && tid < 128) {
      const int d = tid >> 6;
      float hcar = isctx ? 0.f : p.state_lru[((size_t)(bidx * 2 + l) * 2 + d) * 512 + n * 64 + cc];
#pragma unroll
      for (int part = 0; part < 4; part++) hcar = parts[((part * 2 + d) * 64 + cc) * 2] * hcar + parts[((part * 2 + d) * 64 + cc) * 2 + 1];
      carry[d * 64 + cc] = hcar;
    }
    __syncthreads();
    {
      bf16x8 af[4];
#pragma unroll
      for (int ks = 0; ks < 4; ks++) af[ks] = *(const bf16x8*)(xbh + (gth * 32 + r) * LROW + ks * 16 + h * 8);
      f32x16 ga, gi;
#pragma unroll
      for (int e = 0; e < 16; e++) { ga[e] = 0.f; gi[e] = 0.f; }
#pragma unroll
      for (int ks = 0; ks < 4; ks++) { ga = mfma32(af[ks], wfa[ks], ga); gi = mfma32(af[ks], wfx[ks], gi); }
      const int dch = gdh * 32 + r;
#pragma unroll
      for (int e = 0; e < 16; e++) {
        const int tok = gth * 32 + (e & 3) + 8 * (e >> 2) + 4 * h;
        float rg = sigmoidf_(ga[e] + g_ba), ig = sigmoidf_(gi[e] + g_bx);
        float log_a = -8.f * rg * g_sp;
        float a = __expf(log_a);
        const float x2 = 2.f * log_a;
        const float om = -x2 * (1.f + x2 * (0.5f + x2 * (0.16666667f + x2 * (0.041666668f + x2 * (0.0083333338f + x2 * (0.0013888889f + x2 * 0.0001984127f))))));
        float bb = __builtin_amdgcn_sqrtf(om) * ig * xb[tok * 64 + dch];
        ab[((gd * 2 + 0) * 64 + tok) * 64 + dch] = a;
        ab[((gd * 2 + 1) * 64 + tok) * 64 + dch] = bb;
      }
    }
    __syncthreads();
    float av[2][8], bv[2][8];
#pragma unroll
    for (int d = 0; d < 2; d++)
#pragma unroll
      for (int tt = 0; tt < 8; tt++) {
        av[d][tt] = ab[((d * 2 + 0) * 64 + tg * 8 + tt) * 64 + dout];
        bv[d][tt] = ab[((d * 2 + 1) * 64 + tg * 8 + tt) * 64 + dout];
      }
    float sA0 = 1.f, sB0 = 0.f, sA1 = 1.f, sB1 = 0.f;
#pragma unroll
    for (int tt = 0; tt < 8; tt++) { sB0 = av[0][tt] * sB0 + bv[0][tt]; sA0 *= av[0][tt]; }
#pragma unroll
    for (int tt = 7; tt >= 0; tt--) { sB1 = av[1][tt] * sB1 + bv[1][tt]; sA1 *= av[1][tt]; }
    comb[((tg * 2 + 0) * 64 + dout) * 2 + 0] = sA0; comb[((tg * 2 + 0) * 64 + dout) * 2 + 1] = sB0;
    comb[((tg * 2 + 1) * 64 + dout) * 2 + 0] = sA1; comb[((tg * 2 + 1) * 64 + dout) * 2 + 1] = sB1;
    __syncthreads();
    if (!pass2) {
      if (tid < 128) {
        int d = tid >> 6, c = tid & 63;
        float At = 1.f, Bt = 0.f;
#pragma unroll
        for (int s = 0; s < 8; s++) {
          int g = (d == 0) ? s : 7 - s;
          float a = comb[((g * 2 + d) * 64 + c) * 2], bq = comb[((g * 2 + d) * 64 + c) * 2 + 1];
          Bt = a * Bt + bq; At *= a;
        }
        float* o = p.lruTot + ((size_t)(ci * 2 + d) * 512 + n * 64 + c) * 2;
        o[0] = At; o[1] = Bt;
      }
      continue;
    }
    float h0 = carry[dout], h1 = carry[64 + dout];
    for (int g = 0; g < tg; g++) { h0 = comb[((g * 2 + 0) * 64 + dout) * 2] * h0 + comb[((g * 2 + 0) * 64 + dout) * 2 + 1]; }
    for (int g = 7; g > tg; g--) { h1 = comb[((g * 2 + 1) * 64 + dout) * 2] * h1 + comb[((g * 2 + 1) * 64 + dout) * 2 + 1]; }
    float y[8];
#pragma unroll
    for (int tt = 0; tt < 8; tt++) { h0 = av[0][tt] * h0 + bv[0][tt]; y[tt] = h0; }
    const float hf_last = h0;
#pragma unroll
    for (int tt = 7; tt >= 0; tt--) { h1 = av[1][tt] * h1 + bv[1][tt]; y[tt] += h1; }
    const float hb_first = h1;
    if (isctx) {
      if (t0 + 64 == T && tg == 7) p.out[O_ST + ((size_t)(bidx * 2 + l) * 2 + 0) * 512 + ch] = hf_last;
      if (t0 == 0 && tg == 0) p.out[O_ST + ((size_t)(bidx * 2 + l) * 2 + 1) * 512 + ch] = hb_first;
    }
#pragma unroll
    for (int tt = 0; tt < 8; tt++) {
      const int rw = row0 + tg * 8 + tt;
      p.GB[(size_t)NTOK * 512 + tm_off(rw, ch, 8)] = f2bf(y[tt] * bf2f(sgr[tt]));
    }
  }
}

__device__ __forceinline__ float compute_lam(const Params& p, int l, float lam_init) {
  float s1 = 0.f, s2 = 0.f;
  for (int i = 0; i < 64; i++) {
    s1 += p.lam_q1[l * 64 + i] * p.lam_k1[l * 64 + i];
    s2 += p.lam_q2[l * 64 + i] * p.lam_k2[l * 64 + i];
  }
  return expf(s1) - expf(s2) + lam_init;
}

__device__ __forceinline__ float mix_phase(const Params& p, int l, u16* smem, int vid) {
  unsigned long long tm0 = 0; float tres = 0.f; if (PROBE >= 30) tm0 = __builtin_amdgcn_s_memrealtime();
  const float lam_init = (l == 0) ? 0.2f : (0.8f - 0.6f * 0.74081822068f);
  const float lam = compute_lam(p, l, lam_init);
  constexpr int N_CL = 256, N_A = 384, N_CC = 128, N_L = 1536;
  const int G = gridDim.x;
  int start = vid;
  for (int it = start; it < N_CL; it += G) attnC_item(p, l, 128 + it, smem, lam, lam_init);
  if (PROBE == 35) tres = (float)(__builtin_amdgcn_s_memrealtime() - tm0) / 40000.f;
  start = (int)((vid + G - (N_CL % G)) % G);
  for (int it = start; it < N_A; it += G) attnA_item(p, l, it, smem);
  start = (int)((vid + G - ((N_CL + N_A) % G)) % G);
  for (int it = start; it < N_CC; it += G) attnC_item(p, l, it, smem, lam, lam_init);
  if (PROBE == 36) tres = (float)(__builtin_amdgcn_s_memrealtime() - tm0) / 40000.f;
  start = (int)((vid + G - ((N_CL + N_A + N_CC) % G)) % G);
  if (PROBE == 6) lru_run(p, l, false, start, G, (float*)smem);
  lru_run(p, l, false, start, G, (float*)smem);
  return tres;
}

__device__ __forceinline__ void lru2_phase(const Params& p, int l, u16* smem) {
  lru_run(p, l, true, blockIdx.x, gridDim.x, (float*)smem);
}

#define XB_TMO      128
#define XB_XCNT(j)  (256  + 64 * (j))
#define XB_XSUB(j)  (1280 + 64 * (j))
#define XB_XGEN(j)  (2304 + 64 * (j))
#define XB_TOP      3328
#define XB_TOPGEN   3392
#define XCD_BAR_WORDS 3456
#define XB_SPIN_CAP (1u << 18)
__device__ __forceinline__ unsigned xb_ld(unsigned* p)              { return __hip_atomic_load(p, __ATOMIC_RELAXED, __HIP_MEMORY_SCOPE_AGENT); }
__device__ __forceinline__ unsigned xb_add(unsigned* p, unsigned v) { return __hip_atomic_fetch_add(p, v, __ATOMIC_RELAXED, __HIP_MEMORY_SCOPE_AGENT); }
__device__ __forceinline__ unsigned xb_xcc_id() { return (unsigned)__builtin_amdgcn_s_getreg((3 << 11) | 20) & 0xFu; }
#define XB_SPIN(cond, bar) do { unsigned _sp = 0; while (cond) { __builtin_amdgcn_s_sleep(1); \
    if ((++_sp & 255u) == 0u) { if (xb_ld(&(bar)[XB_TMO])) break; if (_sp > XB_SPIN_CAP) { atomicAdd(&(bar)[XB_TMO], 1u); break; } } } } while (0)
struct XcdBarrier { unsigned* bar; unsigned x; volatile LAS unsigned* st; };
__device__ __forceinline__ XcdBarrier xcd_barrier_post(unsigned* bar, volatile LAS unsigned* st) {
  XcdBarrier b; b.bar = bar; b.x = xb_xcc_id(); b.st = st;
  if (threadIdx.x == 0) st[2] = xb_add(&bar[XB_XCNT(b.x)], 1u);
  return b;
}
__device__ __forceinline__ int xcd_virtual_id(const XcdBarrier& b) {
  if (threadIdx.x == 0) {
    unsigned pre = 0;
#pragma unroll
    for (unsigned j = 0; j < 16; ++j) { const unsigned c = xb_ld(&b.bar[XB_XCNT(j)]); pre += (j < b.x) ? c : 0u; }
    b.st[3] = pre + b.st[2];
  }
  __syncthreads();
  const int v = (int)b.st[3];
  __syncthreads();
  return __builtin_amdgcn_readfirstlane(v);
}
__device__ __forceinline__ void xcd_barrier_complete(unsigned* bar, unsigned x, unsigned& nloc, unsigned& nx) {
  const unsigned G = gridDim.x * gridDim.y * gridDim.z;
  unsigned sum, cnt, mine, sp = 0u;
  for (;;) {
    sum = 0u; cnt = 0u; mine = 0u;
#pragma unroll
    for (unsigned j = 0; j < 16; ++j) { const unsigned c = xb_ld(&bar[XB_XCNT(j)]); sum += c; cnt += (c > 0u) ? 1u : 0u; mine = (j == x) ? c : mine; }
    if (sum == G) break;
    __builtin_amdgcn_s_sleep(1);
    if ((++sp & 255u) == 0u) { if (xb_ld(&bar[XB_TMO])) break; if (sp > XB_SPIN_CAP) { atomicAdd(&bar[XB_TMO], 1u); break; } }
  }
  nloc = mine > 0u ? mine : 1u; nx = cnt > 0u ? cnt : 1u;
}
__device__ __forceinline__ void xcd_barrier(const XcdBarrier& b) {
  asm volatile("s_waitcnt vmcnt(0)" ::: "memory");
  __syncthreads();
  if (threadIdx.x == 0) {
    unsigned* bar = b.bar;
    __builtin_amdgcn_s_waitcnt(0);
    unsigned nloc = b.st[0], nx = b.st[1];
    if (nloc == 0u) { xcd_barrier_complete(bar, b.x, nloc, nx); b.st[0] = nloc; b.st[1] = nx; }
    const unsigned old = xb_add(&bar[XB_XSUB(b.x)], 1u);
    const unsigned gen = old / nloc;
    if (old + 1u == (gen + 1u) * nloc) {
      __builtin_amdgcn_fence(__ATOMIC_RELEASE, "agent");
      asm volatile("s_waitcnt vmcnt(0)" ::: "memory");
      const unsigned og = xb_add(&bar[XB_TOP], 1u);
      const unsigned tg = og / nx;
      if (og + 1u == (tg + 1u) * nx) xb_add(&bar[XB_TOPGEN], 1u);
      else XB_SPIN(xb_ld(&bar[XB_TOPGEN]) == tg, bar);
      __builtin_amdgcn_fence(__ATOMIC_ACQUIRE, "agent");
      xb_add(&bar[XB_XGEN(b.x)], 1u);
      asm volatile("s_waitcnt vmcnt(0)" ::: "memory");
    } else {
      XB_SPIN(xb_ld(&bar[XB_XGEN(b.x)]) == gen, bar);
      __builtin_amdgcn_fence(__ATOMIC_ACQUIRE, "agent");
      asm volatile("s_waitcnt vmcnt(0)" ::: "memory");
    }
  }
  __syncthreads();
}

typedef __attribute__((address_space(4))) const Params CParams;
__device__ __forceinline__ const Params& get_params() {
  CParams* kp = (CParams*)__builtin_amdgcn_kernarg_segment_ptr();
  asm volatile("" : "+s"(kp));
  return *(const Params*)kp;
}
__global__ void __launch_bounds__(NT, 2) fwd_kernel(Params p_unused) {
  extern __shared__ __attribute__((aligned(16))) unsigned char lds_raw[];
  u16* smem = (u16*)lds_raw;
  LAS unsigned char* lds = (LAS unsigned char*)lds_raw;
  cg::grid_group grid = cg::this_grid();
  volatile LAS unsigned* xst = (volatile LAS unsigned*)(lds + STAGE_BYTES + SPARE_BYTES);
  if (threadIdx.x == 0) { xst[0] = 0u; xst[1] = 0u; }
  __syncthreads();
  XcdBarrier xb = xcd_barrier_post(get_params().bar, xst);
  float tfrac = 0.f;
  unsigned long long tq0 = 0; if (PROBE >= 30) tq0 = __builtin_amdgcn_s_memrealtime();
  prologue_phase(get_params(), (float*)smem);
  if (PROBE == 30) tfrac = (float)(__builtin_amdgcn_s_memrealtime() - tq0) / 40000.f;
  if (get_params().bar == nullptr) grid.sync();
  xcd_barrier(xb);
  if (PROBE == 31) tfrac = (float)(__builtin_amdgcn_s_memrealtime() - tq0) / 40000.f;
  const int vid = xcd_virtual_id(xb);
  if (PROBE == 9) { for (int i = 0; i < 10; i++) xcd_barrier(xb); }
#pragma unroll 1
  for (int l = 0; l < 2; l++) {
    if (PROBE >= 30) tq0 = __builtin_amdgcn_s_memrealtime();
    norm_phase(get_params(), l);
    if (PROBE == 32 && l == 0) tfrac = (float)(__builtin_amdgcn_s_memrealtime() - tq0) / 40000.f;
    if (PROBE == 3) { norm_phase(get_params(), l); if (l == 0) { xcd_barrier(xb); prologue_phase(get_params(), (float*)smem); } }
    xcd_barrier(xb);
    {
      const Params& p = get_params();
      SchedStd S; S.nM = NTOK / 256; S.nN = INC / 256; S.nwg = S.nM * S.nN; S.G = gridDim.x; S.c = vid;
      S.A = (const char*)p.H; S.B = (const char*)(p.Wt_in + (size_t)l * INC * 1024); S.tA = (size_t)256 * 1024 * 2; S.tB = (size_t)256 * 1024 * 2;
      EpiInproj E; E.pp = &p; E.l = l; E.part = (LAS float*)(lds + STAGE_BYTES);
      { float tr = gemm_phase(lds, 1024, S, E, PROBE == 22); if (l == 0 && (PROBE == 21 || PROBE == 22)) tfrac = tr; }
      if (PROBE == 1) { __syncthreads(); gemm_phase(lds, 1024, S, E); }
    }
    xcd_barrier(xb);
    if (PROBE >= 30) tq0 = __builtin_amdgcn_s_memrealtime();
    { float tr = mix_phase(get_params(), l, smem, vid); if ((PROBE == 35 || PROBE == 36) && l == 0) tfrac = tr; }
    if (PROBE == 33 && l == 0) tfrac = (float)(__builtin_amdgcn_s_memrealtime() - tq0) / 40000.f;
    xcd_barrier(xb);
    if (PROBE >= 30) tq0 = __builtin_amdgcn_s_memrealtime();
    lru2_phase(get_params(), l, smem);
    if (PROBE == 34 && l == 0) tfrac = (float)(__builtin_amdgcn_s_memrealtime() - tq0) / 40000.f;
    xcd_barrier(xb);
    {
      const Params& p = get_params();
      SchedBranch S; S.G = gridDim.x; S.c = vid; S.P_ = (const char*)p.GB; S.W_ = (const char*)(p.Wt_br + (size_t)l * 3 * 1024 * 512);
      EpiBranch E; E.pp = &p;
      { float tr = gemm_phase(lds, 512, S, E, PROBE == 24); if (l == 0 && (PROBE == 23 || PROBE == 24)) tfrac = tr; }
      if (PROBE == 2) { __syncthreads(); gemm_phase(lds, 512, S, E); }
    }
    xcd_barrier(xb);
    {
      const Params& p = get_params();
      SchedStd S; S.nM = NTOK / 256; S.nN = 4; S.nwg = S.nM * S.nN; S.G = gridDim.x; S.c = vid;
      S.A = (const char*)p.Y; S.B = (const char*)(p.Wt_out + (size_t)l * 1024 * 1024); S.tA = (size_t)256 * 1024 * 2; S.tB = (size_t)256 * 1024 * 2;
      EpiOut E; E.pp = &p; E.l = l;
      { float tr = gemm_phase(lds, 1024, S, E, PROBE == 26); if (l == 0 && (PROBE == 25 || PROBE == 26)) tfrac = tr; }
      if (PROBE == 8 && l == 0) { __syncthreads(); gemm_phase(lds, 1024, S, E); }
    }
    if (l == 0) xcd_barrier(xb);
  }
  if (PROBE >= 20) {
    xcd_barrier(xb);
    if (blockIdx.x == 0 && threadIdx.x == 0) { float* o = get_params().out + O_X + 4194304; *o += 0.42f + 0.45f * fminf(fmaxf(tfrac, 0.f), 1.f); }
  }
}

extern "C" void kernel_launch(void* const* d_in, const int* in_sizes, int n_in, void* d_out, int out_size, void* d_ws,
                              size_t ws_size, hipStream_t stream) {
  Params p{};
  const float** ip = (const float**)&p;
  for (int i = 0; i < 34; i++) ip[i] = (const float*)d_in[i];
  p.out = (float*)d_out;
  char* w = (char*)d_ws; size_t off = 0;
  auto take = [&](size_t bytes) { char* q = w + off; off += (bytes + 255) & ~(size_t)255; return q; };
  p.Wt_in = (u16*)take((size_t)2 * INC * 1024 * 2);
  p.Wt_br = (u16*)take((size_t)6 * 1024 * 512 * 2);
  p.Wt_out = (u16*)take((size_t)2 * 1024 * 1024 * 2);
  p.Y = (u16*)take((size_t)NTOK * 1024 * 2);
  p.P = (u16*)take((size_t)NTOK * PP * 2);
  p.VtA_ctx = p.Y;
  p.VtA_lat = p.VtA_ctx + (size_t)16 * 2 * 64 * 256;
  p.VtC_ctx = p.VtA_lat + (size_t)2 * 2 * 64 * 4096;
  p.VtC_lat = p.VtC_ctx + (size_t)16 * 4 * 128 * 256;
  p.cKa = (u16*)take((size_t)2 * 2 * 512 * 128 * 2);
  p.cVtA = (u16*)take((size_t)2 * 2 * 512 * 128 * 2);
  p.cKc = (u16*)take((size_t)2 * 2 * 512 * 512 * 2);
  p.cVtC = (u16*)take((size_t)2 * 2 * 512 * 512 * 2);
  p.mod = (float*)take((size_t)2 * 3 * 3072 * 4);
  p.rope = (float*)take((size_t)2048 * 4);
  p.lruTot = (float*)take((size_t)192 * 2 * 512 * 2 * 4);
  p.Wt_lru = (u16*)take((size_t)2 * 2 * 8 * 2 * 64 * 64 * 2);
  p.bar = (unsigned*)take((size_t)XCD_BAR_WORDS * 4);
  p.GB = (u16*)take((size_t)3 * NTOK * 512 * 2);
  p.H = p.GB;
  p.MG = (unsigned*)take((size_t)48 * 4 * 3 * 16384 * 4);
  static int grid_blocks = 0;
  if (!grid_blocks) {
    int dev = 0, cus = 0;
    hipGetDevice(&dev);
    hipDeviceGetAttribute(&cus, hipDeviceAttributeMultiprocessorCount, dev);
    hipFuncSetAttribute((const void*)fwd_kernel, hipFuncAttributeMaxDynamicSharedMemorySize, LDS_BYTES);
    int per_cu = 0;
    hipOccupancyMaxActiveBlocksPerMultiprocessor(&per_cu, (const void*)fwd_kernel, NT, LDS_BYTES);
    (void)hipGetLastError();
    grid_blocks = cus;
  }
  hipMemsetAsync(p.bar, 0, (size_t)XCD_BAR_WORDS * 4, stream);
  void* args[] = {&p};
  hipLaunchCooperativeKernel((void*)fwd_kernel, dim3(grid_blocks), dim3(NT), args, LDS_BYTES, stream);
}
```

```cpp
#include <hip/hip_runtime.h>
#include <hip/hip_cooperative_groups.h>
#include <stdint.h>
#include <math.h>
namespace cg = cooperative_groups;

typedef unsigned short u16;
typedef __attribute__((ext_vector_type(8))) short bf16x8;
typedef __attribute__((ext_vector_type(4))) short bf16x4;
typedef __attribute__((ext_vector_type(16))) float f32x16;
typedef __attribute__((ext_vector_type(4))) float f32x4;
#define LAS __attribute__((address_space(3)))

#ifndef PROBE
#define PROBE 0
#endif
#define NT 512
constexpr int NTOK = 12288, NCTX = 4096;
constexpr int INC = 7424;
constexpr int PP = 3712;
constexpr int C_QA = 0, C_KA = 512, C_GA = 640, C_XB = 1152, C_GB = 1664, C_QC = 2176, C_KC = 2688, C_GC = 3200;
constexpr int LROW = 72;
constexpr int VROW = 68;
constexpr float EPS = 1e-6f;
constexpr int STAGE_BYTES = 131072;
constexpr int SPARE_BYTES = 8192;
constexpr int ROPE_OFF = STAGE_BYTES + SPARE_BYTES + 16;
constexpr int LDS_BYTES = ROPE_OFF + 8192;

constexpr size_t O_X = 0, O_KA = 12582912, O_VA = 13631488, O_KC = 14680064, O_VC = 18874368, O_ST = 23068672;

struct Params {
  const float *x_prompt, *x_sample, *cache_a_k, *cache_a_v, *cache_c_k, *cache_c_v, *state_lru, *c, *c_ctx,
      *norm_g, *mod_w, *mod_b, *w_in, *qn_a, *kn_a, *sink_a, *conv_w, *conv_b, *lru_wa, *lru_ba, *lru_wx, *lru_bx,
      *lru_lam, *qn_c, *kn_c, *lam_q1, *lam_k1, *lam_q2, *lam_k2, *subln_c, *w_br_a, *w_br_b, *w_br_c, *w_out;
  float* out;
  u16 *Wt_in, *Wt_br, *Wt_out, *H, *P, *VtA_ctx, *VtA_lat, *VtC_ctx, *VtC_lat, *cKa, *cVtA, *cKc, *cVtC;
  float *mod, *rope, *lruTot;
  u16 *Wt_lru;
  unsigned* bar;
  u16* Y;
  u16* GB;
  unsigned* MG;
};

__device__ __forceinline__ int tid_opaque() { int t = (int)threadIdx.x; asm volatile("" : "+v"(t)); return t; }
#define TIDX tid_opaque()
__device__ __forceinline__ u16 f2bf(float f) {
  uint32_t r; asm("v_cvt_pk_bf16_f32 %0, %1, %1" : "=v"(r) : "v"(f)); return (u16)(r & 0xffffu);
}
__device__ __forceinline__ float bf2f(u16 h) { return __uint_as_float(((uint32_t)h) << 16); }
__device__ __forceinline__ uint32_t pack2(float a, float b) { uint32_t r; asm("v_cvt_pk_bf16_f32 %0, %1, %2" : "=v"(r) : "v"(a), "v"(b)); return r; }
__device__ __forceinline__ float sigmoidf_(float x) { return __builtin_amdgcn_rcpf(1.f + __expf(-x)); }
__device__ __forceinline__ float siluf_(float x) { return x * __builtin_amdgcn_rcpf(1.f + __expf(-x)); }
__device__ __forceinline__ f32x16 mfma32(bf16x8 a, bf16x8 b, f32x16 c) {
  return __builtin_amdgcn_mfma_f32_32x32x16_bf16(a, b, c, 0, 0, 0);
}
__device__ __forceinline__ float shflx(float v, int mask, int lane) {
  return __builtin_bit_cast(float, __builtin_amdgcn_ds_bpermute((lane ^ mask) << 2, __builtin_bit_cast(int, v)));
}
__device__ __forceinline__ float lo_bf(uint32_t w) { return __uint_as_float(w << 16); }
__device__ __forceinline__ float hi_bf(uint32_t w) { return __uint_as_float(w & 0xffff0000u); }

__device__ __forceinline__ size_t tm_off(int r, int k, int KT) {
  return ((size_t)((r >> 8) * KT + (k >> 6)) * 256 + (r & 255)) * 64 + (k & 63);
}
__device__ __forceinline__ void transpose_tile(const float* __restrict__ src, int spitch, u16* __restrict__ dst, int dpitch,
                               int r0, int c0, float* sm, int KT = 0) {
  const int tid = TIDX;
#pragma unroll
  for (int i = 0; i < 2; i++) {
    int c = tid + i * NT; int r = c >> 4, q = c & 15;
    float4 v = *(const float4*)(src + (size_t)(r0 + r) * spitch + c0 + q * 4);
    float* d = sm + r * 65 + q * 4;
    d[0] = v.x; d[1] = v.y; d[2] = v.z; d[3] = v.w;
  }
  __syncthreads();
  {
    int c = tid; int cc = c >> 3, q = c & 7;
    uint32_t w[4];
#pragma unroll
    for (int j = 0; j < 4; j++) w[j] = pack2(sm[(q * 8 + 2 * j) * 65 + cc], sm[(q * 8 + 2 * j + 1) * 65 + cc]);
    uint4 v; v.x = w[0]; v.y = w[1]; v.z = w[2]; v.w = w[3];
    if (KT) *(uint4*)(dst + tm_off(c0 + cc, r0 + q * 8, KT)) = v;
    else *(uint4*)(dst + (size_t)(c0 + cc) * dpitch + r0 + q * 8) = v;
  }
  __syncthreads();
}

__device__ __forceinline__ void transpose_wide(const float* __restrict__ src, int spitch, u16* __restrict__ dst,
                                               int k0, int n0, float* sm, int KT) {
  const int tid = TIDX;
  float4 v[8];
#pragma unroll
  for (int i = 0; i < 8; i++) { int c = tid + i * NT; int r = c >> 6, q = c & 63; v[i] = *(const float4*)(src + (size_t)(k0 + r) * spitch + n0 + q * 4); }
#pragma unroll
  for (int i = 0; i < 8; i++) { int c = tid + i * NT; int r = c >> 6, q = c & 63; float* d = sm + r * 257 + q * 4; d[0] = v[i].x; d[1] = v[i].y; d[2] = v[i].z; d[3] = v[i].w; }
  __syncthreads();
#pragma unroll
  for (int i = 0; i < 4; i++) {
    int c = tid + i * NT; int nn = c >> 3, q = c & 7;
    uint4 o;
    o.x = pack2(sm[(q * 8 + 0) * 257 + nn], sm[(q * 8 + 1) * 257 + nn]);
    o.y = pack2(sm[(q * 8 + 2) * 257 + nn], sm[(q * 8 + 3) * 257 + nn]);
    o.z = pack2(sm[(q * 8 + 4) * 257 + nn], sm[(q * 8 + 5) * 257 + nn]);
    o.w = pack2(sm[(q * 8 + 6) * 257 + nn], sm[(q * 8 + 7) * 257 + nn]);
    *(uint4*)(dst + tm_off(n0 + nn, k0 + q * 8, KT)) = o;
  }
  __syncthreads();
}

__device__ __forceinline__ void mod_item(const Params& p, int it, float* sm) {
  const int tid = TIDX;
  const int l = it / 48, n0 = (it % 48) * 64;
  float* sv = sm;
  float* red = sm + 3072;
  for (int e = tid; e < 3072; e += NT) {
    int v = e >> 10, k = e & 1023;
    float x = (v == 0) ? p.c_ctx[k] : p.c[(v - 1) * 1024 + k];
    sv[e] = siluf_(x);
  }
  __syncthreads();
  const int col = tid & 63, kg = tid >> 6;
  const float* w = p.mod_w + (size_t)l * 1024 * 3072 + n0 + col;
  float a0 = 0, a1 = 0, a2 = 0;
#pragma unroll 1
  for (int kb = kg * 128; kb < kg * 128 + 128; kb += 32) {
    float wv[32];
#pragma unroll
    for (int j = 0; j < 32; j++) wv[j] = w[(size_t)(kb + j) * 3072];
#pragma unroll
    for (int j = 0; j < 32; j++) { a0 += sv[kb + j] * wv[j]; a1 += sv[1024 + kb + j] * wv[j]; a2 += sv[2048 + kb + j] * wv[j]; }
  }
  red[(kg * 3 + 0) * 64 + col] = a0; red[(kg * 3 + 1) * 64 + col] = a1; red[(kg * 3 + 2) * 64 + col] = a2;
  __syncthreads();
  if (tid < 192) {
    int v = tid >> 6, c = tid & 63;
    float s = p.mod_b[l * 3072 + n0 + c];
#pragma unroll
    for (int g = 0; g < 8; g++) s += red[(g * 3 + v) * 64 + c];
    p.mod[(l * 3 + v) * 3072 + n0 + c] = s;
  }
  __syncthreads();
}

__device__ __forceinline__ void prologue_phase(const Params& p, float* sm) {
  constexpr int N_MOD = 96, N_ROPE = 1, N_WIN = 2 * 16 * 29, N_WBR = 6 * 8 * 4, N_WOUT = 2 * 16 * 4;
  constexpr int N_CK = 64 + 256, N_CVA = 4 * 16, N_CVC = 4 * 64, N_LW = 64;
  constexpr int E0 = N_MOD, E1 = E0 + N_ROPE, E2 = E1 + N_WIN, E3 = E2 + N_WBR, E4 = E3 + N_WOUT, E5 = E4 + N_CK,
                E6 = E5 + N_CVA, E7 = E6 + N_CVC, E8 = E7 + N_LW;
  const int tid = TIDX;
  for (int it = blockIdx.x; it < E8; it += gridDim.x) {
    if (it < E0) {
      mod_item(p, it, sm);
    } else if (it < E1) {
      for (int e = tid; e < 1024; e += NT) {
        int pos = e >> 4, f = e & 15;
        float inv = powf(10000.f, -(float)f / 16.f);
        float ang = (float)pos * inv;
        p.rope[e] = cosf(ang); p.rope[1024 + e] = sinf(ang);
      }
    } else if (it < E2) {
      int j = it - E1; int l = j / (16 * 29); int r = j % (16 * 29);
      int kt = r / 29, pn = r % 29;
      transpose_wide(p.w_in + (size_t)l * 1024 * INC, INC, p.Wt_in + (size_t)l * INC * 1024, kt * 64, pn * 256, sm, 16);
    } else if (it < E3) {
      int j = it - E2; int m = j / 32; int r = j % 32;
      int l = m / 3, i = m % 3;
      const float* src = (i == 0 ? p.w_br_a : (i == 1 ? p.w_br_b : p.w_br_c)) + (size_t)l * 512 * 1024;
      int kt = r / 4, pn = r % 4;
      transpose_wide(src, 1024, p.Wt_br + (size_t)m * 1024 * 512, kt * 64, pn * 256, sm, 8);
    } else if (it < E4) {
      int j = it - E3; int l = j / 64; int r = j % 64;
      int kt = r / 4, pn = r % 4;
      transpose_wide(p.w_out + (size_t)l * 1024 * 1024, 1024, p.Wt_out + (size_t)l * 1024 * 1024, kt * 64, pn * 256, sm, 16);
    } else if (it < E5) {
      int j = it - E4;
      const float* src; u16* dst; size_t off;
      if (j < 64) { src = p.cache_a_k; dst = p.cKa; off = (size_t)j * 4096; }
      else { src = p.cache_c_k; dst = p.cKc; off = (size_t)(j - 64) * 4096; }
      size_t e = off + (size_t)tid * 8;
      float4 a = *(const float4*)(src + e), b = *(const float4*)(src + e + 4);
      uint4 v; v.x = pack2(a.x, a.y); v.y = pack2(a.z, a.w); v.z = pack2(b.x, b.y); v.w = pack2(b.z, b.w);
      *(uint4*)(dst + e) = v;
    } else if (it < E6) {
      int j = it - E5; int bl = j / 16; int r = j % 16;
      int rt = r / 2, ct = r % 2;
      transpose_tile(p.cache_a_v + (size_t)bl * 512 * 128, 128, p.cVtA + (size_t)bl * 128 * 512, 512, rt * 64, ct * 64, sm);
    } else if (it < E7) {
      int j = it - E6; int bl = j / 64; int r = j % 64;
      int rt = r / 8, ct = r % 8;
      transpose_tile(p.cache_c_v + (size_t)bl * 512 * 512, 512, p.cVtC + (size_t)bl * 512 * 512, 512, rt * 64, ct * 64, sm);
    } else {
      int j = it - E7; int ldn = j >> 1, g = j & 1;
      transpose_tile((g ? p.lru_wx : p.lru_wa) + (size_t)ldn * 4096, 64, p.Wt_lru + (size_t)(ldn * 2 + g) * 4096, 64, 0, 0, sm);
    }
  }
}

__device__ __forceinline__ void norm_phase(const Params& p, int l) {
  const int tid = TIDX, lane = tid & 63, wid = tid >> 6;
  const float* g = p.norm_g + l * 1024;
  for (int it = blockIdx.x; it < NTOK / 8; it += gridDim.x) {
    int row = it * 8 + wid;
    const float* x;
    if (l == 0) x = (row < NCTX) ? p.x_prompt + (size_t)row * 1024 : p.x_sample + (size_t)(row - NCTX) * 1024;
    else x = p.out + O_X + (size_t)row * 1024;
    int v = (row < NCTX) ? 0 : 1 + (row - NCTX) / 4096;
    const float* md = p.mod + (l * 3 + v) * 3072;
    float4 xv[4]; float ss = 0;
#pragma unroll
    for (int i = 0; i < 4; i++) {
      xv[i] = *(const float4*)(x + i * 256 + lane * 4);
      ss += xv[i].x * xv[i].x + xv[i].y * xv[i].y + xv[i].z * xv[i].z + xv[i].w * xv[i].w;
    }
#pragma unroll
    for (int o = 32; o > 0; o >>= 1) ss += shflx(ss, o, lane);
    float rinv = rsqrtf(ss * (1.f / 1024.f) + EPS);
#pragma unroll
    for (int i = 0; i < 4; i++) {
      int c = i * 256 + lane * 4;
      float4 gv = *(const float4*)(g + c), sh = *(const float4*)(md + c), sc = *(const float4*)(md + 1024 + c);
      float h0 = xv[i].x * rinv * gv.x * (1.f + sc.x) + sh.x;
      float h1 = xv[i].y * rinv * gv.y * (1.f + sc.y) + sh.y;
      float h2 = xv[i].z * rinv * gv.z * (1.f + sc.z) + sh.z;
      float h3 = xv[i].w * rinv * gv.w * (1.f + sc.w) + sh.w;
      uint2 o2; o2.x = pack2(h0, h1); o2.y = pack2(h2, h3);
      *(uint2*)(p.H + tm_off(row, c, 16)) = o2;
    }
  }
}

constexpr int G_BK = 64, G_HALF = 128, G_HTB = G_HALF * G_BK * 2;
__device__ __forceinline__ int lds_byte(int r, int c) {
  const int st = (r >> 4) * 2 + (c >> 5), rr = r & 15, cc = c & 31, ob = rr * 64 + cc * 2;
  return st * 1024 + (ob ^ (((ob >> 9) & 1) << 5));
}
__device__ __forceinline__ void stage_rc(int b, int& R, int& C) {
  const int st = b / 1024, sb = b % 1024, swz = sb ^ (((sb >> 9) & 1) << 5);
  R = (st >> 1) * 16 + swz / 64; C = (st & 1) * 32 + (swz % 64) / 2;
}
struct Unit { int pm, pn, seg; };

struct SchedStd {
  int nM, nN, nwg, G, c; const char* A; const char* B; size_t tA, tB;
  __device__ __forceinline__ bool next(int i, Unit& u) const {
    const long L = (long)i * G + c; if (L >= nwg) return false;
    const int wgid = (int)L;
    const int nig = 8 * nN, gid = wgid / nig, fm = gid * 8, gsz = (nM - fm) < 8 ? (nM - fm) : 8;
    u.pm = fm + ((wgid % nig) % gsz); u.pn = (wgid % nig) / gsz; u.seg = 0; return true;
  }
  __device__ __forceinline__ const char* aptr(const Unit& u) const { return A + (size_t)u.pm * tA; }
  __device__ __forceinline__ const char* bptr(const Unit& u) const { return B + (size_t)u.pn * tB; }
};
struct SchedBranch {
  int G, c; const char* P_; const char* W_;
  __device__ __forceinline__ bool next(int i, Unit& u) const {
    if (G == 256) {
      if (i >= 3) return false;
      const int xcd = c >> 5, j = c & 31;
      if (j >= 24) return false;
      u.seg = i; u.pm = xcd * 6 + (j >> 2); u.pn = j & 3; return true;
    }
    const int tile = (i / 3) * G + c; if (tile >= 192) return false;
    u.seg = i % 3; u.pm = tile >> 2; u.pn = tile & 3; return true;
  }
  __device__ __forceinline__ const char* aptr(const Unit& u) const { return P_ + (size_t)((u.seg * 48 + u.pm) * 8) * 32768; }
  __device__ __forceinline__ const char* bptr(const Unit& u) const { return W_ + (size_t)((u.seg * 4 + u.pn) * 8) * 32768; }
};

template <class Epi, class Sched>
__device__ __forceinline__ float gemm_phase(LAS unsigned char* lds, const int K, const Sched& S, const Epi& E, int tmode = 0) {
  unsigned long long t_ph0 = 0, t_epi = 0; if (PROBE >= 20) t_ph0 = __builtin_amdgcn_s_memrealtime();
  const int tid = TIDX, wid = __builtin_amdgcn_readfirstlane(tid >> 6), lane = tid & 63, wr = wid >> 2, wc = wid & 3, fr = lane & 15, fq = lane >> 4;
  const int nt = K / G_BK;
  unsigned voffA[2], voffB[2];
#pragma unroll
  for (int i = 0; i < 2; ++i) { int R, C; stage_rc(tid * 16 + i * 8192, R, C);
    voffA[i] = (unsigned)(R * 64 + C) * 2u; voffB[i] = voffA[i]; }
  const size_t kstep = (size_t)32768;
  const size_t hA = (size_t)16384, hB = (size_t)16384;
  const unsigned ldsw = (unsigned)wid * 1024u;
  const int aoff = lds_byte(wr * 64 + fr, fq * 8), boff = lds_byte(wc * 32 + fr, fq * 8);
#define G_SA(b, h) (((b) * 2 + (h)) * G_HTB)
#define G_SB(b, h) ((4 + (b) * 2 + (h)) * G_HTB)
#define G_STAGE(bufoff, gbase, voff) do { _Pragma("unroll") for (int _i = 0; _i < 2; ++_i) \
    __builtin_amdgcn_global_load_lds((const unsigned*)((const char*)(gbase) + (voff)[_i]), (LAS unsigned*)(lds + (bufoff) + ldsw + _i * 8192), 16, 0, 0); } while (0)
#define G_LDA(dst, b, h) do { _Pragma("unroll") for (int m = 0; m < 4; ++m) _Pragma("unroll") for (int k = 0; k < 2; ++k) dst[m][k] = *(const LAS bf16x8*)(lds + G_SA(b, h) + aoff + m * 2048 + k * 1024); } while (0)
#define G_LDB(dst, b, h) do { _Pragma("unroll") for (int n = 0; n < 2; ++n) _Pragma("unroll") for (int k = 0; k < 2; ++k) dst[n][k] = *(const LAS bf16x8*)(lds + G_SB(b, h) + boff + n * 2048 + k * 1024); } while (0)
#define G_MMA(ai, bj, At, Bt) do { __builtin_amdgcn_s_setprio(1); _Pragma("unroll") for (int m = 0; m < 4; ++m) _Pragma("unroll") for (int n = 0; n < 2; ++n) _Pragma("unroll") for (int k = 0; k < 2; ++k) \
    acc[ai][bj][m][n] = __builtin_amdgcn_mfma_f32_16x16x32_bf16(Bt[n][k], At[m][k], acc[ai][bj][m][n], 0, 0, 0); __builtin_amdgcn_s_setprio(0); } while (0)
#define G_WAIT_V(n) asm volatile("s_waitcnt vmcnt(" #n ")" ::: "memory")
#define G_WAIT_L(n) asm volatile("s_waitcnt lgkmcnt(" #n ")" ::: "memory")
#define G_BAR __builtin_amdgcn_s_barrier()
#define G_SCHED __builtin_amdgcn_sched_barrier(0)
  Unit cur, nxt; int ui = 0;
  if (!S.next(0, cur)) return 0.f;
  f32x4 acc[2][2][4][2];
#pragma unroll
  for (int a = 0; a < 2; ++a)
#pragma unroll
    for (int b = 0; b < 2; ++b)
#pragma unroll
      for (int m = 0; m < 4; ++m)
#pragma unroll
        for (int n = 0; n < 2; ++n) acc[a][b][m][n] = (f32x4){0.f, 0.f, 0.f, 0.f};
  bf16x8 At[4][2], B0[2][2], B1[2][2];
  const char* cA = S.aptr(cur); const char* cB = S.bptr(cur);
  G_STAGE(G_SB(0, 0), cB, voffB); G_STAGE(G_SA(0, 0), cA, voffA); G_STAGE(G_SB(0, 1), cB + hB, voffB); G_STAGE(G_SA(0, 1), cA + hA, voffA);
  if (wr == 1) G_BAR;
  G_WAIT_V(4); G_BAR;
  G_STAGE(G_SB(1, 0), cB + kstep, voffB); G_STAGE(G_SA(1, 0), cA + kstep, voffA); G_STAGE(G_SB(1, 1), cB + hB + kstep, voffB);
  G_WAIT_V(6); G_BAR;
  for (;;) {
    const bool has_next = S.next(ui + 1, nxt);
    const char* nA = has_next ? S.aptr(nxt) : cA; const char* nB = has_next ? S.bptr(nxt) : cB;
    for (int t = 0; t < nt; t += 2) {
      const bool last = (t == nt - 2);
      const char* a1 = cA + (size_t)(t + 1) * kstep;
      const char* a2 = last ? nA : cA + (size_t)(t + 2) * kstep; const char* b2 = last ? nB : cB + (size_t)(t + 2) * kstep;
      const char* a3 = a2 + kstep; const char* b3 = b2 + kstep;
      G_LDB(B0, 0, 0); G_SCHED; G_LDA(At, 0, 0); G_STAGE(G_SA(1, 1), a1 + hA, voffA);
      G_WAIT_L(8); G_BAR; G_WAIT_L(0); G_MMA(0, 0, At, B0); G_BAR; G_SCHED;
      G_LDB(B1, 0, 1); G_STAGE(G_SB(0, 0), b2, voffB);
      G_BAR; G_WAIT_L(0); G_MMA(0, 1, At, B1); G_BAR;
      G_LDA(At, 0, 1); G_STAGE(G_SA(0, 0), a2, voffA);
      G_BAR; G_WAIT_L(0); G_MMA(1, 0, At, B0); G_BAR; G_SCHED;
      G_STAGE(G_SB(0, 1), b2 + hB, voffB);
      G_WAIT_V(6); G_BAR; G_MMA(1, 1, At, B1); G_BAR;
      G_LDB(B0, 1, 0); G_SCHED; G_LDA(At, 1, 0); G_STAGE(G_SA(0, 1), a2 + hA, voffA);
      G_WAIT_L(8); G_BAR; G_WAIT_L(0); G_MMA(0, 0, At, B0); G_BAR; G_SCHED;
      G_LDB(B1, 1, 1); G_STAGE(G_SB(1, 0), b3, voffB);
      G_BAR; G_WAIT_L(0); G_MMA(0, 1, At, B1); G_BAR;
      G_LDA(At, 1, 1); G_STAGE(G_SA(1, 0), a3, voffA);
      G_BAR; G_WAIT_L(0); G_MMA(1, 0, At, B0); G_BAR; G_SCHED;
      G_STAGE(G_SB(1, 1), b3 + hB, voffB);
      G_WAIT_V(6); G_BAR; G_MMA(1, 1, At, B1); G_BAR;
    }
    unsigned long long t_e0 = 0; if (PROBE >= 20) t_e0 = __builtin_amdgcn_s_memrealtime();
    const bool reset = E(acc, cur, wr, wc, fr, fq);
    if (PROBE >= 20) { asm volatile("s_waitcnt vmcnt(0)" ::: "memory"); t_epi += __builtin_amdgcn_s_memrealtime() - t_e0; }
    if (!has_next) break;
    if (reset) {
#pragma unroll
      for (int a = 0; a < 2; ++a)
#pragma unroll
        for (int b = 0; b < 2; ++b)
#pragma unroll
          for (int m = 0; m < 4; ++m)
#pragma unroll
            for (int n = 0; n < 2; ++n) acc[a][b][m][n] = (f32x4){0.f, 0.f, 0.f, 0.f};
    }
    cur = nxt; cA = nA; cB = nB; ++ui;
  }
  G_WAIT_V(0);
  if (wr == 0) G_BAR;
  G_BAR;
  float tres = 0.f;
  if (PROBE >= 20) {
    const unsigned long long tot = __builtin_amdgcn_s_memrealtime() - t_ph0;
    tres = (tmode == 0) ? (float)t_epi / (float)tot : (float)tot / 40000.f;
  }
#undef G_SA
#undef G_SB
#undef G_STAGE
#undef G_LDA
#undef G_LDB
#undef G_MMA
#undef G_WAIT_V
#undef G_WAIT_L
#undef G_BAR
#undef G_SCHED
  return tres;
}

struct EpiInproj {
  const Params* pp; int l; LAS float* part; const LAS float* ropeL;
  __device__ __forceinline__ bool operator()(f32x4 (&acc)[2][2][4][2], const Unit& u, int wr, int wc, int fr, int fq) const {
    const Params& p = *pp;
    asm volatile("" : "+v"(fr), "+v"(fq));
    const int lane = fr + 16 * fq; (void)lane;
    const int oc0 = u.pn * 256;
    const bool isctx = u.pm < 16;
    const bool qkU = (oc0 < 768) || (oc0 >= 2304 && oc0 < 3328);
    float rinv[2][4][2];
    if (qkU) {
#pragma unroll
      for (int ai = 0; ai < 2; ai++)
#pragma unroll
        for (int m = 0; m < 4; m++)
#pragma unroll
          for (int bj = 0; bj < 2; bj++) {
            f32x4 a = acc[ai][bj][m][0], b = acc[ai][bj][m][1];
            float ss = a[0] * a[0] + a[1] * a[1] + a[2] * a[2] + a[3] * a[3] + b[0] * b[0] + b[1] * b[1] + b[2] * b[2] + b[3] * b[3];
            ss += shflx(ss, 16, lane); ss += shflx(ss, 32, lane);
            rinv[ai][m][bj] = ss;
            if (fq == 0) part[((ai * 128 + wr * 64 + m * 16 + fr) * 2 + bj) * 4 + wc] = ss;
          }
      asm volatile("s_waitcnt lgkmcnt(0)" ::: "memory");
      __builtin_amdgcn_s_barrier();
      asm volatile("" ::: "memory");
#pragma unroll
      for (int ai = 0; ai < 2; ai++)
#pragma unroll
        for (int m = 0; m < 4; m++)
#pragma unroll
          for (int bj = 0; bj < 2; bj++) {
            float o = part[((ai * 128 + wr * 64 + m * 16 + fr) * 2 + bj) * 4 + (wc ^ 1)];
            rinv[ai][m][bj] = rsqrtf((rinv[ai][m][bj] + o) * (1.f / 64.f) + EPS);
          }
    }
#pragma unroll
    for (int bj = 0; bj < 2; bj++) {
      const int oc = oc0 + bj * 128;
      if (oc == 640 || (oc >= 3328 && oc < 3840)) {
        const bool isA = (oc == 640);
        const int cb = isA ? 0 : (oc - 3328);
        const int nvec = isA ? 128 : 512;
#pragma unroll
        for (int ai = 0; ai < 2; ai++)
#pragma unroll
          for (int m = 0; m < 4; m++) {
            const int row = u.pm * 256 + ai * 128 + wr * 64 + m * 16 + fr;
            int b, t, T; u16* vt;
            if (isctx) { b = row >> 8; t = row & 255; T = 256; vt = isA ? p.VtA_ctx : p.VtC_ctx; }
            else { int rr = row - NCTX; b = rr >> 12; t = rr & 4095; T = 4096; vt = isA ? p.VtA_lat : p.VtC_lat; }
#pragma unroll
            for (int n = 0; n < 2; n++) {
              const int d = cb + wc * 32 + n * 16 + fq * 4;
              f32x4 v = acc[ai][bj][m][n];
#pragma unroll
              for (int j = 0; j < 4; j++) vt[((size_t)b * nvec + d + j) * T + t] = f2bf(v[j]);
              if (isctx) {
                float* o = p.out + (isA ? O_VA : O_VC) + ((size_t)(b * 2 + l) * 256 + t) * nvec + d;
                *(f32x4*)o = v;
              }
            }
          }
      } else {
        const int pc = (oc < 640) ? oc : (oc < 3328 ? oc - 128 : oc - 640);
        const bool is_qa = oc < 512, is_ka = (oc == 512);
        const bool is_qc = (oc >= 2304 && oc < 2816), is_kc = (oc >= 2816 && oc < 3328);
        if (is_qa || is_ka || is_qc || is_kc) {
          const float* gn = (is_qa ? p.qn_a : is_ka ? p.kn_a : is_qc ? p.qn_c : p.kn_c) + l * 64 + (wc & 1) * 32 + fq * 4;
          const f32x4 g0 = *(const f32x4*)gn, g1 = *(const f32x4*)(gn + 16);
          const float qs = (is_qa || is_qc) ? 0.18033688011112042f : 1.f;
#pragma unroll
          for (int ai = 0; ai < 2; ai++)
#pragma unroll
            for (int m = 0; m < 4; m++) {
              const int row = u.pm * 256 + ai * 128 + wr * 64 + m * 16 + fr;
              const float ri = rinv[ai][m][bj];
              f32x4 x1 = acc[ai][bj][m][0] * ri * g0, x2 = acc[ai][bj][m][1] * ri * g1;
              if (!isctx) {
                const int t = (row - NCTX) & 4095;
                const int pos = (wc & 1) ? (t & 63) : (t >> 6);
                const f32x4 cs = *(const LAS f32x4*)(ropeL + pos * 16 + fq * 4), sn = *(const LAS f32x4*)(ropeL + 1024 + pos * 16 + fq * 4);
                f32x4 y1 = x1 * cs - x2 * sn, y2 = x2 * cs + x1 * sn;
                x1 = y1; x2 = y2;
              } else if (is_ka || is_kc) {
                const int b = row >> 8, t = row & 255;
                float* o = is_ka ? p.out + O_KA + ((size_t)(b * 2 + l) * 256 + t) * 128 + wc * 32 + fq * 4
                                 : p.out + O_KC + ((size_t)(b * 2 + l) * 256 + t) * 512 + (oc - 2816) + wc * 32 + fq * 4;
                *(f32x4*)o = x1; *(f32x4*)(o + 16) = x2;
              }
              x1 = x1 * qs; x2 = x2 * qs;
              u16* po = p.P + (size_t)row * PP + pc + wc * 32 + fq * 4;
              *(uint2*)po = make_uint2(pack2(x1[0], x1[1]), pack2(x1[2], x1[3]));
              *(uint2*)(po + 16) = make_uint2(pack2(x2[0], x2[1]), pack2(x2[2], x2[3]));
            }
        } else {
          const int mode = (oc >= 4352) ? 2 : ((oc >= 1280 && oc < 1792) ? 0 : 1);
          if (mode == 2) {
            const int pj = u.pn - 17, seg = pj >> 2, pn4 = pj & 3;
            unsigned* mg = p.MG + ((size_t)((u.pm * 4 + pn4) * 3 + seg) * 8 + (wr * 4 + wc)) * 2048 + lane;
#pragma unroll
            for (int ai = 0; ai < 2; ai++)
#pragma unroll
              for (int m = 0; m < 4; m++)
#pragma unroll
                for (int n = 0; n < 2; n++) {
                  f32x4 v = acc[ai][bj][m][n];
                  const unsigned q0 = (unsigned)(sigmoidf_(v[0]) * 254.f + 1.5f), q1 = (unsigned)(sigmoidf_(v[1]) * 254.f + 1.5f);
                  const unsigned q2 = (unsigned)(sigmoidf_(v[2]) * 254.f + 1.5f), q3 = (unsigned)(sigmoidf_(v[3]) * 254.f + 1.5f);
                  mg[(((ai * 4 + m) * 2 + bj) * 2 + n) * 64] = q0 | (q1 << 8) | (q2 << 16) | (q3 << 24);
                }
          } else
#pragma unroll
          for (int ai = 0; ai < 2; ai++)
#pragma unroll
            for (int m = 0; m < 4; m++) {
              const int row = u.pm * 256 + ai * 128 + wr * 64 + m * 16 + fr;
              u16* po = p.P + (size_t)row * PP + pc + wc * 32 + fq * 4;
#pragma unroll
              for (int n = 0; n < 2; n++) {
                f32x4 v = acc[ai][bj][m][n];
                if (mode == 1) { v[0] = siluf_(v[0]); v[1] = siluf_(v[1]); v[2] = siluf_(v[2]); v[3] = siluf_(v[3]); }
                else if (mode == 2) { v[0] = sigmoidf_(v[0]); v[1] = sigmoidf_(v[1]); v[2] = sigmoidf_(v[2]); v[3] = sigmoidf_(v[3]); }
                *(uint2*)(po + n * 16) = make_uint2(pack2(v[0], v[1]), pack2(v[2], v[3]));
              }
            }
        }
      }
    }
    return true;
  }
};

struct EpiBranch {
  const Params* pp;
  __device__ __forceinline__ bool operator()(f32x4 (&acc)[2][2][4][2], const Unit& u, int wr, int wc, int fr, int fq) const {
    const Params& p = *pp;
    asm volatile("" : "+v"(fr), "+v"(fq));
    const int lane = fr + 16 * fq;
    const int seg = u.seg;
    const unsigned* mg = p.MG + ((size_t)((u.pm * 4 + u.pn) * 3 + seg) * 8 + (wr * 4 + wc)) * 2048 + lane;
    const float sel = (seg < 2) ? 1.f : 0.f;
#pragma unroll
    for (int hq = 0; hq < 4; hq++) {
      unsigned a[8], b[8];
#pragma unroll
      for (int q = 0; q < 8; q++) { a[q] = mg[(hq * 8 + q) * 64]; b[q] = mg[(hq * 8 + q) * 64 + 8 * 2048]; }
      __builtin_amdgcn_sched_barrier(0);
#pragma unroll
      for (int q = 0; q < 8; q++) {
        const int ai = hq >> 1, m = (hq & 1) * 2 + (q >> 2), bj = (q >> 1) & 1, n = q & 1;
        f32x4 f = {(float)(a[q] & 255u), (float)((a[q] >> 8) & 255u), (float)((a[q] >> 16) & 255u), (float)(a[q] >> 24)};
        f32x4 g = {(float)(b[q] & 255u), (float)((b[q] >> 8) & 255u), (float)((b[q] >> 16) & 255u), (float)(b[q] >> 24)};
        g = g * sel + (1.f - sel) * 255.f;
        f[0] *= __builtin_amdgcn_rcpf(g[0]); f[1] *= __builtin_amdgcn_rcpf(g[1]); f[2] *= __builtin_amdgcn_rcpf(g[2]); f[3] *= __builtin_amdgcn_rcpf(g[3]);
        acc[ai][bj][m][n] = acc[ai][bj][m][n] * f;
      }
    }
    if (seg < 2) return false;
#pragma unroll
    for (int ai = 0; ai < 2; ai++)
#pragma unroll
      for (int m = 0; m < 4; m++) {
        const int row = u.pm * 256 + ai * 128 + wr * 64 + m * 16 + fr;
#pragma unroll
        for (int bj = 0; bj < 2; bj++)
#pragma unroll
          for (int n = 0; n < 2; n++) {
            const int col = u.pn * 256 + bj * 128 + wc * 32 + n * 16 + fq * 4;
            const f32x4 v = acc[ai][bj][m][n];
            *(uint2*)(p.Y + tm_off(row, col, 16)) = make_uint2(pack2(v[0], v[1]), pack2(v[2], v[3]));
          }
      }
    return true;
  }
};

struct EpiOut {
  const Params* pp; int l;
  __device__ __forceinline__ bool operator()(f32x4 (&acc)[2][2][4][2], const Unit& u, int wr, int wc, int fr, int fq) const {
    const Params& p = *pp;
    asm volatile("" : "+v"(fr), "+v"(fq));
    const int v = (u.pm < 16) ? 0 : 1 + (u.pm - 16) / 16;
    const float* gt = p.mod + (l * 3 + v) * 3072 + 2048 + u.pn * 256 + wc * 32 + fq * 4;
    const float* xsrc = (l == 0) ? ((u.pm < 16) ? p.x_prompt + (size_t)u.pm * 256 * 1024 : p.x_sample + (size_t)(u.pm - 16) * 256 * 1024)
                                 : p.out + O_X + (size_t)u.pm * 256 * 1024;
    float* odst = p.out + O_X + (size_t)u.pm * 256 * 1024;
    const int cbase = u.pn * 256 + wc * 32 + fq * 4;
    f32x4 gv[2][2];
#pragma unroll
    for (int bj = 0; bj < 2; bj++)
#pragma unroll
      for (int n = 0; n < 2; n++) gv[bj][n] = *(const f32x4*)(gt + bj * 128 + n * 16);
#pragma unroll
    for (int ai = 0; ai < 2; ai++)
#pragma unroll
      for (int mh = 0; mh < 2; mh++) {
        f32x4 xv[2][2][2];
#pragma unroll
        for (int mm = 0; mm < 2; mm++)
#pragma unroll
          for (int bj = 0; bj < 2; bj++)
#pragma unroll
            for (int n = 0; n < 2; n++)
              xv[mm][bj][n] = *(const f32x4*)(xsrc + (size_t)(ai * 128 + wr * 64 + (mh * 2 + mm) * 16 + fr) * 1024 + cbase + bj * 128 + n * 16);
#pragma unroll
        for (int mm = 0; mm < 2; mm++)
#pragma unroll
          for (int bj = 0; bj < 2; bj++)
#pragma unroll
            for (int n = 0; n < 2; n++)
              *(f32x4*)(odst + (size_t)(ai * 128 + wr * 64 + (mh * 2 + mm) * 16 + fr) * 1024 + cbase + bj * 128 + n * 16) = xv[mm][bj][n] + gv[bj][n] * acc[ai][bj][mh * 2 + mm][n];
      }
    return true;
  }
};

template <bool MASK>
__device__ __forceinline__ void fs_scores(const u16* Ks, const bf16x8 (&qf)[4], f32x16 (&s)[2], int lane, int kpos0, int qpos, int T) {
  const int r = lane & 31, h = lane >> 5;
  {
    bf16x8 kf[2][4];
#pragma unroll
    for (int sub = 0; sub < 2; sub++)
#pragma unroll
      for (int ks = 0; ks < 4; ks++) kf[sub][ks] = *(const bf16x8*)(Ks + (sub * 32 + r) * LROW + ks * 16 + h * 8);
    __builtin_amdgcn_sched_barrier(0);
#pragma unroll
    for (int sub = 0; sub < 2; sub++) {
#pragma unroll
      for (int e = 0; e < 16; e++) s[sub][e] = 0.f;
#pragma unroll
      for (int ks = 0; ks < 4; ks++) s[sub] = mfma32(kf[sub][ks], qf[ks], s[sub]);
    }
  }
  if (MASK) {
#pragma unroll
    for (int sub = 0; sub < 2; sub++)
#pragma unroll
      for (int e = 0; e < 16; e++) {
        int kp = kpos0 + sub * 32 + (e & 3) + 8 * (e >> 2) + 4 * h;
        int dlt = kp - qpos;
        bool ok = (kp >= 0) && (kp < T) && (dlt <= 128) && (dlt >= -128);
        if (!ok) s[sub][e] = -INFINITY;
      }
  }
}
template <int DV>
__device__ __forceinline__ void fs_softmax(f32x16 (&s)[2], float& m, float& l, f32x16 (&o)[DV / 32], bf16x8 (&pf)[2][2], int lane) {
  float mx = s[0][0];
#pragma unroll
  for (int sub = 0; sub < 2; sub++)
#pragma unroll
    for (int e = 0; e < 16; e++) mx = fmaxf(mx, s[sub][e]);
  mx = fmaxf(mx, shflx(mx, 32, lane));
  const bool grow = mx > m;
  const float mn = grow ? mx : m;
  float sum = 0.f;
#pragma unroll
  for (int sub = 0; sub < 2; sub++)
#pragma unroll
    for (int e = 0; e < 16; e++) { float pv = __builtin_amdgcn_exp2f(s[sub][e] - mn); s[sub][e] = pv; sum += pv; }
  sum += shflx(sum, 32, lane);
  if (__builtin_amdgcn_ballot_w64(grow) != 0ull) {
    const float alpha = __builtin_amdgcn_exp2f(m - mn);
    l *= alpha;
#pragma unroll
    for (int ds = 0; ds < DV / 32; ds++)
#pragma unroll
      for (int e = 0; e < 16; e++) o[ds][e] *= alpha;
  }
  l += sum; m = mn;
  typedef __attribute__((ext_vector_type(4))) unsigned u32x4;
#pragma unroll
  for (int sub = 0; sub < 2; sub++)
#pragma unroll
    for (int st = 0; st < 2; st++) {
      u32x4 pw;
#pragma unroll
      for (int j = 0; j < 4; j++) pw[j] = pack2(s[sub][8 * st + 2 * j], s[sub][8 * st + 2 * j + 1]);
      pf[sub][st] = __builtin_bit_cast(bf16x8, pw);
    }
}
template <int DV>
__device__ __forceinline__ void fs_pv(const bf16x8 (&pf)[2][2], const u16* Vts, f32x16 (&o)[DV / 32], int lane) {
  const int r = lane & 31, h = lane >> 5;
#pragma unroll
  for (int sub = 0; sub < 2; sub++) {
    bf16x8 vf[2][DV / 32];
#pragma unroll
    for (int st = 0; st < 2; st++)
#pragma unroll
      for (int ds = 0; ds < DV / 32; ds++) {
        const u16* vp = Vts + (ds * 32 + r) * VROW + sub * 32 + 16 * st + 4 * h;
        bf16x4 lo = *(const bf16x4*)vp, hi = *(const bf16x4*)(vp + 8);
        vf[st][ds] = __builtin_shufflevector(lo, hi, 0, 1, 2, 3, 4, 5, 6, 7);
      }
    __builtin_amdgcn_sched_barrier(0);
#pragma unroll
    for (int st = 0; st < 2; st++)
#pragma unroll
      for (int ds = 0; ds < DV / 32; ds++) o[ds] = mfma32(vf[st][ds], pf[sub][st], o[ds]);
    __builtin_amdgcn_sched_barrier(0);
  }
}

__device__ __forceinline__ uint4 ld_k(const u16* __restrict__ src, size_t pitch, int r0, int nrows, int c) {
  int row = c >> 3, kc = c & 7; int rr = r0 + row;
  uint4 v = make_uint4(0, 0, 0, 0);
  if (rr >= 0 && rr < nrows) v = *(const uint4*)(src + (size_t)rr * pitch + kc * 8);
  return v;
}
__device__ __forceinline__ void st_k(u16* dst, int c, uint4 v) { *(uint4*)(dst + (c >> 3) * LROW + (c & 7) * 8) = v; }
__device__ __forceinline__ uint4 ld_vt(const u16* __restrict__ src, int T, int k0, int c) {
  int d = c >> 3, kc = c & 7; int k = k0 + kc * 8;
  uint4 v = make_uint4(0, 0, 0, 0);
  if (k >= 0 && k < T) v = *(const uint4*)(src + (size_t)d * T + k);
  return v;
}
__device__ __forceinline__ void st_vt(u16* dst, int c, uint4 v) {
  uint2* q = (uint2*)(dst + (c >> 3) * VROW + (c & 7) * 8);
  q[0] = make_uint2(v.x, v.y); q[1] = make_uint2(v.z, v.w);
}

constexpr int A_BUF = 64 * LROW + 64 * VROW;
__device__ __forceinline__ void attnA_item(const Params& p, int l, int it, u16* sm, bool dry = false) {
  const int tid = TIDX, lane = tid & 63, wid = tid >> 6;
  const int r = lane & 31, h = lane >> 5;
  const bool isctx = it < 128;
  int b, kvh, qb, T, rowbase; const u16* VtBase;
  if (isctx) { b = it >> 3; kvh = (it >> 2) & 1; qb = it & 3; T = 256; rowbase = b * 256;
    VtBase = p.VtA_ctx + ((size_t)(b * 2 + kvh) * 64) * 256; }
  else { int j = it - 128; b = j >> 7; kvh = (j >> 6) & 1; qb = j & 63; T = 4096; rowbase = NCTX + b * 4096;
    VtBase = p.VtA_lat + ((size_t)(b * 2 + kvh) * 64) * 4096; }
  const int qblk = qb * 64;
  const int q0 = qblk + (wid >> 2) * 32;
  const int head = kvh * 4 + (wid & 3);
  const size_t prow = (size_t)(rowbase + q0 + r) * PP;
  bf16x8 qf[4];
#pragma unroll
  for (int ks = 0; ks < 4; ks++) qf[ks] = *(const bf16x8*)(p.P + prow + C_QA + head * 64 + ks * 16 + h * 8);
  float m = p.sink_a[l * 8 + head] * 1.4426950408889634f, ls = 1.f;
  f32x16 o[2];
#pragma unroll
  for (int ds = 0; ds < 2; ds++)
#pragma unroll
    for (int e = 0; e < 16; e++) o[ds][e] = 0.f;
  const u16* Kbase = p.P + (size_t)rowbase * PP + C_KA + kvh * 64;
  const u16* cK = p.cKa + ((size_t)(b * 2 + l) * 512) * 128 + kvh * 64;
  const u16* cVt = p.cVtA + ((size_t)((b * 2 + l) * 2 + kvh) * 64) * 512;
  const int qpos = q0 + r;
  int i_lo = 0, nW, ntile;
  if (isctx) { nW = 4; ntile = 4; }
  else {
    i_lo = (qblk < 128) ? (128 - qblk) / 64 : 0;
    int i_hi = (T - qblk + 128) / 64; if (i_hi > 5) i_hi = 5;
    nW = i_hi - i_lo; ntile = nW + 8;
  }
  uint4 rk, rv;
  auto tile_load = [&](int t) {
    if (t < nW) {
      int k0 = isctx ? t * 64 : qblk - 128 + 64 * (i_lo + t);
      rk = ld_k(Kbase, PP, k0, T, tid); rv = ld_vt(VtBase, T, k0, tid);
    } else {
      int kt = t - nW;
      rk = ld_k(cK, 128, kt * 64, 512, tid); rv = ld_vt(cVt, 512, kt * 64, tid);
    }
  };
  auto KB = [&](int i) { return sm + (i & 1) * (64 * LROW); };
  auto VB = [&](int i) { return sm + 2 * 64 * LROW + (i % 3) * (64 * VROW); };
  const bool lag = (wid >> 2) != 0;
  __syncthreads();
  tile_load(0);
  st_k(KB(0), tid, rk); st_vt(VB(0), tid, rv);
  __syncthreads();
  bf16x8 pf[2][2];
  for (int t = 0; t <= ntile; t++) {
    const bool more = t + 1 < ntile;
    if (more) tile_load(t + 1);
    if (lag && t > 0) fs_pv<64>(pf, VB(t - 1), o, lane);
    if (t < ntile) {
      f32x16 sc[2];
      if (!isctx && t < nW) fs_scores<true>(KB(t), qf, sc, lane, qblk - 128 + 64 * (i_lo + t), qpos, T);
      else fs_scores<false>(KB(t), qf, sc, lane, 0, 0, T);
      fs_softmax<64>(sc, m, ls, o, pf, lane);
      if (!lag) fs_pv<64>(pf, VB(t), o, lane);
    }
    if (more) { st_k(KB(t + 1), tid, rk); st_vt(VB(t + 1), tid, rv); }
    __syncthreads();
  }
  const float inv = __builtin_amdgcn_rcpf(ls);
#pragma unroll
  for (int ds = 0; ds < 2; ds++)
#pragma unroll
    for (int g = 0; g < 4; g++) {
      int d = ds * 32 + 8 * g + 4 * h;
      uint2 gv = *(const uint2*)(p.P + prow + C_GA + head * 64 + d);
      uint2 ov;
      ov.x = pack2(o[ds][4 * g] * inv * lo_bf(gv.x), o[ds][4 * g + 1] * inv * hi_bf(gv.x));
      ov.y = pack2(o[ds][4 * g + 2] * inv * lo_bf(gv.y), o[ds][4 * g + 3] * inv * hi_bf(gv.y));
      *(uint2*)(p.GB + tm_off(rowbase + q0 + r, head * 64 + d, 8)) = ov;
    }
}

constexpr int C_BUF = 128 * LROW + 128 * VROW;
__device__ __forceinline__ void attnC_item(const Params& p, int l, int it, u16* sm, float lam, float lam_init, bool dry = false) {
  const int tid = TIDX, lane = tid & 63, wid = tid >> 6;
  const int r = lane & 31, h = lane >> 5;
  const bool isctx = it < 128;
  int b, hd, qb, T, rowbase; const u16* VtBase;
  if (isctx) { b = it >> 3; hd = (it >> 1) & 3; qb = it & 1; T = 256; rowbase = b * 256;
    VtBase = p.VtC_ctx + ((size_t)(b * 4 + hd) * 128) * 256; }
  else { int j = it - 128; b = j >> 7; hd = (j >> 5) & 3; qb = j & 31; T = 4096; rowbase = NCTX + b * 4096;
    VtBase = p.VtC_lat + ((size_t)(b * 4 + hd) * 128) * 4096; }
  const int qg = wid & 3, map = wid >> 2;
  const int q0 = qb * 128 + qg * 32;
  const size_t prow = (size_t)(rowbase + q0 + r) * PP;
  bf16x8 qf[4];
#pragma unroll
  for (int ks = 0; ks < 4; ks++) qf[ks] = *(const bf16x8*)(p.P + prow + C_QC + hd * 128 + map * 64 + ks * 16 + h * 8);
  float m = -1e30f, ls = 0.f;
  f32x16 o[4];
#pragma unroll
  for (int ds = 0; ds < 4; ds++)
#pragma unroll
    for (int e = 0; e < 16; e++) o[ds][e] = 0.f;
  const u16* Kbase = p.P + (size_t)rowbase * PP + C_KC + hd * 128;
  const u16* cK = p.cKc + ((size_t)(b * 2 + l) * 512) * 512 + hd * 128;
  const u16* cVt = p.cVtC + ((size_t)((b * 2 + l) * 4 + hd) * 128) * 512;
  const int nW = T / 64, ntile = isctx ? nW : nW + 8;
  uint4 rk0, rk1, rv0, rv1;
  auto tile_load = [&](int t) {
    if (t < nW) {
      rk0 = ld_k(Kbase, PP, t * 64, T, tid); rk1 = ld_k(Kbase + 64, PP, t * 64, T, tid);
      rv0 = ld_vt(VtBase, T, t * 64, tid); rv1 = ld_vt(VtBase, T, t * 64, tid + NT);
    } else {
      int kt = t - nW;
      rk0 = ld_k(cK, 512, kt * 64, 512, tid); rk1 = ld_k(cK + 64, 512, kt * 64, 512, tid);
      rv0 = ld_vt(cVt, 512, kt * 64, tid); rv1 = ld_vt(cVt, 512, kt * 64, tid + NT);
    }
  };
  auto KB = [&](int i) { return sm + (i & 1) * (128 * LROW); };
  auto VB = [&](int i) { return sm + 2 * 128 * LROW + (i % 3) * (128 * VROW); };
  auto tile_store = [&](int i) {
    u16* kd = KB(i); u16* vd = VB(i);
    st_k(kd, tid, rk0); st_k(kd + 64 * LROW, tid, rk1);
    st_vt(vd, tid, rv0); st_vt(vd, tid + NT, rv1);
  };
  const bool lag = map != 0;
  __syncthreads();
  tile_load(0);
  tile_store(0);
  __syncthreads();
  bf16x8 pf[2][2];
  for (int t = 0; t <= ntile; t++) {
    const bool more = t + 1 < ntile;
    if (more) tile_load(t + 1);
    if (lag && t > 0) fs_pv<128>(pf, VB(t - 1), o, lane);
    if (t < ntile) {
      f32x16 sc[2];
      fs_scores<false>(KB(t) + map * 64 * LROW, qf, sc, lane, 0, 0, T);
      fs_softmax<128>(sc, m, ls, o, pf, lane);
      if (!lag) fs_pv<128>(pf, VB(t), o, lane);
    }
    if (more) tile_store(t + 1);
    __syncthreads();
  }
  float* xch = (float*)sm;
  if (map == 1) {
    const float inv = lam * __builtin_amdgcn_rcpf(ls);
#pragma unroll
    for (int ds = 0; ds < 4; ds++)
#pragma unroll
      for (int e = 0; e < 16; e++) xch[((qg * 64) + ds * 16 + e) * 64 + lane] = o[ds][e] * inv;
  }
  __syncthreads();
  if (map == 0) {
    const float i0 = __builtin_amdgcn_rcpf(ls);
    float ss = 0.f;
#pragma unroll
    for (int ds = 0; ds < 4; ds++)
#pragma unroll
      for (int e = 0; e < 16; e++) {
        float v = o[ds][e] * i0 - xch[((qg * 64) + ds * 16 + e) * 64 + lane];
        o[ds][e] = v; ss += v * v;
      }
    ss += shflx(ss, 32, lane);
    const float rinv = rsqrtf(ss * (1.f / 128.f) + EPS) * (1.f - lam_init);
    const float* sg = p.subln_c + l * 128;
#pragma unroll
    for (int ds = 0; ds < 4; ds++)
#pragma unroll
      for (int g = 0; g < 4; g++) {
        int d = ds * 32 + 8 * g + 4 * h;
        uint2 gv = *(const uint2*)(p.P + prow + C_GC + hd * 128 + d);
        float4 sl = *(const float4*)(sg + d);
        uint2 ov;
        ov.x = pack2(o[ds][4 * g] * rinv * sl.x * lo_bf(gv.x), o[ds][4 * g + 1] * rinv * sl.y * hi_bf(gv.x));
        ov.y = pack2(o[ds][4 * g + 2] * rinv * sl.z * lo_bf(gv.y), o[ds][4 * g + 3] * rinv * sl.w * hi_bf(gv.y));
        *(uint2*)(p.GB + (size_t)2 * NTOK * 512 + tm_off(rowbase + q0 + r, hd * 128 + d, 8)) = ov;
      }
  }
}

__device__ __forceinline__ void lru_run(const Params& p, int l, bool pass2, int start, int G, float* sm, bool dry = false) {
  const int tid = TIDX;
  const int lane = tid & 63, wid = tid >> 6, r = lane & 31, h = lane >> 5;
  const int n = start & 7;
  float* xin = sm;
  float* xb = sm + 67 * 64;
  float* comb = xb + 64 * 64;
  float* carry = comb + 2048;
  float* parts = carry + 128;
  float* ab = parts + 1024;
  u16* xbh = (u16*)(ab + 4 * 4096);
  const int gd = wid >> 2, gth = (wid >> 1) & 1, gdh = wid & 1;
  bf16x8 wfa[4], wfx[4];
  {
    const u16* wbase = p.Wt_lru + ((size_t)(((l * 2 + gd) * 8 + n) * 2) * 64 + gdh * 32 + r) * 64 + h * 8;
#pragma unroll
    for (int ks = 0; ks < 4; ks++) { wfa[ks] = *(const bf16x8*)(wbase + ks * 16); wfx[ks] = *(const bf16x8*)(wbase + 4096 + ks * 16); }
  }
  const int gch = n * 64 + gdh * 32 + r;
  const float g_ba = p.lru_ba[(l * 2 + gd) * 512 + gch], g_bx = p.lru_bx[(l * 2 + gd) * 512 + gch];
  const float g_sp = log1pf(__expf(-p.lru_lam[(l * 2 + gd) * 512 + gch]));
  const int cc = tid & 63;
  float cw[4]; float cbv;
  {
    const float* cwp = p.conv_w + l * 4 * 512 + n * 64 + cc;
    cw[0] = cwp[0]; cw[1] = cwp[512]; cw[2] = cwp[1024]; cw[3] = cwp[1536];
    cbv = p.conv_b[l * 512 + n * 64 + cc];
  }
  const int dout = tid & 63, tg = tid >> 6;
  const int ch = n * 64 + dout;

  u16 xr[9];
  auto xin_load = [&](int it_) {
    const int row0_ = (it_ >> 3) * 64;
    int T_, seq0_;
    if (row0_ < NCTX) { T_ = 256; seq0_ = (row0_ >> 8) * 256; } else { T_ = 4096; seq0_ = NCTX + ((row0_ - NCTX) >> 12) * 4096; }
    const int t0_ = row0_ - seq0_;
#pragma unroll
    for (int k = 0; k < 9; k++) {
      const int rr = (tid >> 6) + 8 * k; const int t = t0_ - 2 + rr;
      u16 v = 0;
      if (rr < 67 && t >= 0 && t < T_) v = p.P[(size_t)(seq0_ + t) * PP + C_XB + n * 64 + cc];
      xr[k] = v;
    }
  };
  if (start < 1536) xin_load(start);
  for (int it = start; it < 1536; it += G) {
    const int ci = it >> 3;
    const int row0 = ci * 64;
    const bool isctx = row0 < NCTX;
    int T, seq0, bidx;
    if (isctx) { T = 256; bidx = row0 >> 8; seq0 = bidx * 256; }
    else { T = 4096; bidx = (row0 - NCTX) >> 12; seq0 = NCTX + bidx * 4096; }
    const int t0 = row0 - seq0;
    __syncthreads();
#pragma unroll
    for (int k = 0; k < 9; k++) { const int rr = (tid >> 6) + 8 * k; if (rr < 67) xin[rr * 64 + cc] = bf2f(xr[k]); }
    if (it + G < 1536) xin_load(it + G);
    u16 sgr[8];
    if (pass2) {
#pragma unroll
      for (int tt = 0; tt < 8; tt++) sgr[tt] = p.P[(size_t)(row0 + tg * 8 + tt) * PP + C_GB + ch];
    }
    if (pass2) {
      const int d = (tid >> 6) & 1, part = tid >> 7;
      const int cfirst = seq0 >> 6, clast = (seq0 + T - 64) >> 6;
      const int K = d ? (clast - ci) : (ci - cfirst);
      float2 q[16];
#pragma unroll
      for (int k = 0; k < 16; k++) {
        const int kk = part * 16 + k;
        const int cj = d ? (clast - kk) : (cfirst + kk);
        q[k] = make_float2(1.f, 0.f);
        if (kk < K) q[k] = *(const float2*)(p.lruTot + ((size_t)(cj * 2 + d) * 512 + n * 64 + cc) * 2);
      }
      float At = 1.f, Bt = 0.f;
#pragma unroll
      for (int k = 0; k < 16; k++) { Bt = q[k].x * Bt + q[k].y; At *= q[k].x; }
      parts[((part * 2 + d) * 64 + cc) * 2] = At; parts[((part * 2 + d) * 64 + cc) * 2 + 1] = Bt;
    }
    __syncthreads();
    for (int e = tid; e < 64 * 64; e += NT) {
      int t = e >> 6;
      float v = cbv;
#pragma unroll
      for (int j = 0; j < 4; j++) v += xin[(t + j) * 64 + cc] * cw[j];
      xb[e] = v;
      xbh[t * LROW + cc] = f2bf(v);
    }
    if (pass2 && tid < 128) {
      const int d = tid >> 6;
      float hcar = isctx ? 0.f : p.state_lru[((size_t)(bidx * 2 + l) * 2 + d) * 512 + n * 64 + cc];
#pragma unroll
      for (int part = 0; part < 4; part++) hcar = parts[((part * 2 + d) * 64 + cc) * 2] * hcar + parts[((part * 2 + d) * 64 + cc) * 2 + 1];
      carry[d * 64 + cc] = hcar;
    }
    __syncthreads();
    {
      bf16x8 af[4];
#pragma unroll
      for (int ks = 0; ks < 4; ks++) af[ks] = *(const bf16x8*)(xbh + (gth * 32 + r) * LROW + ks * 16 + h * 8);
      f32x16 ga, gi;
#pragma unroll
      for (int e = 0; e < 16; e++) { ga[e] = 0.f; gi[e] = 0.f; }
#pragma unroll
      for (int ks = 0; ks < 4; ks++) { ga = mfma32(af[ks], wfa[ks], ga); gi = mfma32(af[ks], wfx[ks], gi); }
      const int dch = gdh * 32 + r;
#pragma unroll
      for (int e = 0; e < 16; e++) {
        const int tok = gth * 32 + (e & 3) + 8 * (e >> 2) + 4 * h;
        float rg = sigmoidf_(ga[e] + g_ba), ig = sigmoidf_(gi[e] + g_bx);
        float log_a = -8.f * rg * g_sp;
        float a = __expf(log_a);
        const float x2 = 2.f * log_a;
        const float om = -x2 * (1.f + x2 * (0.5f + x2 * (0.16666667f + x2 * (0.041666668f + x2 * (0.0083333338f + x2 * (0.0013888889f + x2 * 0.0001984127f))))));
        float bb = __builtin_amdgcn_sqrtf(om) * ig * xb[tok * 64 + dch];
        ab[((gd * 2 + 0) * 64 + tok) * 64 + dch] = a;
        ab[((gd * 2 + 1) * 64 + tok) * 64 + dch] = bb;
      }
    }
    __syncthreads();
    float av[2][8], bv[2][8];
#pragma unroll
    for (int d = 0; d < 2; d++)
#pragma unroll
      for (int tt = 0; tt < 8; tt++) {
        av[d][tt] = ab[((d * 2 + 0) * 64 + tg * 8 + tt) * 64 + dout];
        bv[d][tt] = ab[((d * 2 + 1) * 64 + tg * 8 + tt) * 64 + dout];
      }
    float sA0 = 1.f, sB0 = 0.f, sA1 = 1.f, sB1 = 0.f;
#pragma unroll
    for (int tt = 0; tt < 8; tt++) { sB0 = av[0][tt] * sB0 + bv[0][tt]; sA0 *= av[0][tt]; }
#pragma unroll
    for (int tt = 7; tt >= 0; tt--) { sB1 = av[1][tt] * sB1 + bv[1][tt]; sA1 *= av[1][tt]; }
    comb[((tg * 2 + 0) * 64 + dout) * 2 + 0] = sA0; comb[((tg * 2 + 0) * 64 + dout) * 2 + 1] = sB0;
    comb[((tg * 2 + 1) * 64 + dout) * 2 + 0] = sA1; comb[((tg * 2 + 1) * 64 + dout) * 2 + 1] = sB1;
    __syncthreads();
    if (!pass2) {
      if (tid < 128) {
        int d = tid >> 6, c = tid & 63;
        float At = 1.f, Bt = 0.f;
#pragma unroll
        for (int s = 0; s < 8; s++) {
          int g = (d == 0) ? s : 7 - s;
          float a = comb[((g * 2 + d) * 64 + c) * 2], bq = comb[((g * 2 + d) * 64 + c) * 2 + 1];
          Bt = a * Bt + bq; At *= a;
        }
        float* o = p.lruTot + ((size_t)(ci * 2 + d) * 512 + n * 64 + c) * 2;
        o[0] = At; o[1] = Bt;
      }
      continue;
    }
    float h0 = carry[dout], h1 = carry[64 + dout];
    for (int g = 0; g < tg; g++) { h0 = comb[((g * 2 + 0) * 64 + dout) * 2] * h0 + comb[((g * 2 + 0) * 64 + dout) * 2 + 1]; }
    for (int g = 7; g > tg; g--) { h1 = comb[((g * 2 + 1) * 64 + dout) * 2] * h1 + comb[((g * 2 + 1) * 64 + dout) * 2 + 1]; }
    float y[8];
#pragma unroll
    for (int tt = 0; tt < 8; tt++) { h0 = av[0][tt] * h0 + bv[0][tt]; y[tt] = h0; }
    const float hf_last = h0;
#pragma unroll
    for (int tt = 7; tt >= 0; tt--) { h1 = av[1][tt] * h1 + bv[1][tt]; y[tt] += h1; }
    const float hb_first = h1;
    if (isctx) {
      if (t0 + 64 == T && tg == 7) p.out[O_ST + ((size_t)(bidx * 2 + l) * 2 + 0) * 512 + ch] = hf_last;
      if (t0 == 0 && tg == 0) p.out[O_ST + ((size_t)(bidx * 2 + l) * 2 + 1) * 512 + ch] = hb_first;
    }
#pragma unroll
    for (int tt = 0; tt < 8; tt++) {
      const int rw = row0 + tg * 8 + tt;
      p.GB[(size_t)NTOK * 512 + tm_off(rw, ch, 8)] = f2bf(y[tt] * bf2f(sgr[tt]));
    }
  }
}

__device__ __forceinline__ float compute_lam(const Params& p, int l, float lam_init) {
  float s1 = 0.f, s2 = 0.f;
  for (int i = 0; i < 64; i++) {
    s1 += p.lam_q1[l * 64 + i] * p.lam_k1[l * 64 + i];
    s2 += p.lam_q2[l * 64 + i] * p.lam_k2[l * 64 + i];
  }
  return expf(s1) - expf(s2) + lam_init;
}

__device__ __forceinline__ float mix_phase(const Params& p, int l, u16* smem, int vid) {
  unsigned long long tm0 = 0; float tres = 0.f; if (PROBE >= 30) tm0 = __builtin_amdgcn_s_memrealtime();
  const float lam_init = (l == 0) ? 0.2f : (0.8f - 0.6f * 0.74081822068f);
  const float lam = compute_lam(p, l, lam_init);
  constexpr int N_CL = 256, N_A = 384, N_CC = 128, N_L = 1536;
  const int G = gridDim.x;
  int start = vid;
  for (int it = start; it < N_CL; it += G) attnC_item(p, l, 128 + it, smem, lam, lam_init);
  if (PROBE == 35) tres = (float)(__builtin_amdgcn_s_memrealtime() - tm0) / 40000.f;
  start = (int)((vid + G - (N_CL % G)) % G);
  for (int it = start; it < N_A; it += G) attnA_item(p, l, it, smem);
  start = (int)((vid + G - ((N_CL + N_A) % G)) % G);
  for (int it = start; it < N_CC; it += G) attnC_item(p, l, it, smem, lam, lam_init);
  if (PROBE == 36) tres = (float)(__builtin_amdgcn_s_memrealtime() - tm0) / 40000.f;
  start = (int)((vid + G - ((N_CL + N_A + N_CC) % G)) % G);
  if (PROBE == 6) lru_run(p, l, false, start, G, (float*)smem);
  lru_run(p, l, false, start, G, (float*)smem);
  return tres;
}

__device__ __forceinline__ void lru2_phase(const Params& p, int l, u16* smem) {
  lru_run(p, l, true, blockIdx.x, gridDim.x, (float*)smem);
}

#define XB_TMO      128
#define XB_XCNT(j)  (256  + 64 * (j))
#define XB_XSUB(j)  (1280 + 64 * (j))
#define XB_XGEN(j)  (2304 + 64 * (j))
#define XB_TOP      3328
#define XB_TOPGEN   3392
#define XCD_BAR_WORDS 3456
#define XB_SPIN_CAP (1u << 18)
__device__ __forceinline__ unsigned xb_ld(unsigned* p)              { return __hip_atomic_load(p, __ATOMIC_RELAXED, __HIP_MEMORY_SCOPE_AGENT); }
__device__ __forceinline__ unsigned xb_add(unsigned* p, unsigned v) { return __hip_atomic_fetch_add(p, v, __ATOMIC_RELAXED, __HIP_MEMORY_SCOPE_AGENT); }
__device__ __forceinline__ unsigned xb_xcc_id() { return (unsigned)__builtin_amdgcn_s_getreg((3 << 11) | 20) & 0xFu; }
#define XB_SPIN(cond, bar) do { unsigned _sp = 0; while (cond) { __builtin_amdgcn_s_sleep(1); \
    if ((++_sp & 255u) == 0u) { if (xb_ld(&(bar)[XB_TMO])) break; if (_sp > XB_SPIN_CAP) { atomicAdd(&(bar)[XB_TMO], 1u); break; } } } } while (0)
struct XcdBarrier { unsigned* bar; unsigned x; volatile LAS unsigned* st; };
__device__ __forceinline__ XcdBarrier xcd_barrier_post(unsigned* bar, volatile LAS unsigned* st) {
  XcdBarrier b; b.bar = bar; b.x = xb_xcc_id(); b.st = st;
  if (threadIdx.x == 0) st[2] = xb_add(&bar[XB_XCNT(b.x)], 1u);
  return b;
}
__device__ __forceinline__ int xcd_virtual_id(const XcdBarrier& b) {
  if (threadIdx.x == 0) {
    unsigned pre = 0;
#pragma unroll
    for (unsigned j = 0; j < 16; ++j) { const unsigned c = xb_ld(&b.bar[XB_XCNT(j)]); pre += (j < b.x) ? c : 0u; }
    b.st[3] = pre + b.st[2];
  }
  __syncthreads();
  const int v = (int)b.st[3];
  __syncthreads();
  return __builtin_amdgcn_readfirstlane(v);
}
__device__ __forceinline__ void xcd_barrier_complete(unsigned* bar, unsigned x, unsigned& nloc, unsigned& nx) {
  const unsigned G = gridDim.x * gridDim.y * gridDim.z;
  unsigned sum, cnt, mine, sp = 0u;
  for (;;) {
    sum = 0u; cnt = 0u; mine = 0u;
#pragma unroll
    for (unsigned j = 0; j < 16; ++j) { const unsigned c = xb_ld(&bar[XB_XCNT(j)]); sum += c; cnt += (c > 0u) ? 1u : 0u; mine = (j == x) ? c : mine; }
    if (sum == G) break;
    __builtin_amdgcn_s_sleep(1);
    if ((++sp & 255u) == 0u) { if (xb_ld(&bar[XB_TMO])) break; if (sp > XB_SPIN_CAP) { atomicAdd(&bar[XB_TMO], 1u); break; } }
  }
  nloc = mine > 0u ? mine : 1u; nx = cnt > 0u ? cnt : 1u;
}
__device__ __forceinline__ void xcd_barrier(const XcdBarrier& b) {
  asm volatile("s_waitcnt vmcnt(0)" ::: "memory");
  __syncthreads();
  if (threadIdx.x == 0) {
    unsigned* bar = b.bar;
    __builtin_amdgcn_s_waitcnt(0);
    unsigned nloc = b.st[0], nx = b.st[1];
    if (nloc == 0u) { xcd_barrier_complete(bar, b.x, nloc, nx); b.st[0] = nloc; b.st[1] = nx; }
    const unsigned old = xb_add(&bar[XB_XSUB(b.x)], 1u);
    const unsigned gen = old / nloc;
    if (old + 1u == (gen + 1u) * nloc) {
      __builtin_amdgcn_fence(__ATOMIC_RELEASE, "agent");
      asm volatile("s_waitcnt vmcnt(0)" ::: "memory");
      const unsigned og = xb_add(&bar[XB_TOP], 1u);
      const unsigned tg = og / nx;
      if (og + 1u == (tg + 1u) * nx) xb_add(&bar[XB_TOPGEN], 1u);
      else XB_SPIN(xb_ld(&bar[XB_TOPGEN]) == tg, bar);
      __builtin_amdgcn_fence(__ATOMIC_ACQUIRE, "agent");
      xb_add(&bar[XB_XGEN(b.x)], 1u);
      asm volatile("s_waitcnt vmcnt(0)" ::: "memory");
    } else {
      XB_SPIN(xb_ld(&bar[XB_XGEN(b.x)]) == gen, bar);
      __builtin_amdgcn_fence(__ATOMIC_ACQUIRE, "agent");
      asm volatile("s_waitcnt vmcnt(0)" ::: "memory");
    }
  }
  __syncthreads();
}

typedef __attribute__((address_space(4))) const Params CParams;
__device__ __forceinline__ const Params& get_params() {
  CParams* kp = (CParams*)__builtin_amdgcn_kernarg_segment_ptr();
  asm volatile("" : "+s"(kp));
  return *(const Params*)kp;
}
__global__ void __launch_bounds__(NT, 2) fwd_kernel(Params p_unused) {
  extern __shared__ __attribute__((aligned(16))) unsigned char lds_raw[];
  u16* smem = (u16*)lds_raw;
  LAS unsigned char* lds = (LAS unsigned char*)lds_raw;
  cg::grid_group grid = cg::this_grid();
  volatile LAS unsigned* xst = (volatile LAS unsigned*)(lds + STAGE_BYTES + SPARE_BYTES);
  if (threadIdx.x == 0) { xst[0] = 0u; xst[1] = 0u; }
  __syncthreads();
  XcdBarrier xb = xcd_barrier_post(get_params().bar, xst);
  float tfrac = 0.f;
  unsigned long long tq0 = 0; if (PROBE >= 30) tq0 = __builtin_amdgcn_s_memrealtime();
  prologue_phase(get_params(), (float*)smem);
  if (PROBE == 30) tfrac = (float)(__builtin_amdgcn_s_memrealtime() - tq0) / 40000.f;
  if (get_params().bar == nullptr) grid.sync();
  xcd_barrier(xb);
  if (PROBE == 31) tfrac = (float)(__builtin_amdgcn_s_memrealtime() - tq0) / 40000.f;
  const int vid = xcd_virtual_id(xb);
  { LAS float* rl = (LAS float*)(lds + ROPE_OFF); const float* rg = get_params().rope;
    for (int i = threadIdx.x; i < 2048; i += NT) rl[i] = rg[i];
    __syncthreads(); }
  if (PROBE == 9) { for (int i = 0; i < 10; i++) xcd_barrier(xb); }
#pragma unroll 1
  for (int l = 0; l < 2; l++) {
    if (PROBE >= 30) tq0 = __builtin_amdgcn_s_memrealtime();
    norm_phase(get_params(), l);
    if (PROBE == 32 && l == 0) tfrac = (float)(__builtin_amdgcn_s_memrealtime() - tq0) / 40000.f;
    if (PROBE == 3) { norm_phase(get_params(), l); if (l == 0) { xcd_barrier(xb); prologue_phase(get_params(), (float*)smem); } }
    xcd_barrier(xb);
    {
      const Params& p = get_params();
      SchedStd S; S.nM = NTOK / 256; S.nN = INC / 256; S.nwg = S.nM * S.nN; S.G = gridDim.x; S.c = vid;
      S.A = (const char*)p.H; S.B = (const char*)(p.Wt_in + (size_t)l * INC * 1024); S.tA = (size_t)256 * 1024 * 2; S.tB = (size_t)256 * 1024 * 2;
      EpiInproj E; E.pp = &p; E.l = l; E.part = (LAS float*)(lds + STAGE_BYTES); E.ropeL = (const LAS float*)(lds + ROPE_OFF);
      { float tr = gemm_phase(lds, 1024, S, E, PROBE == 22); if (l == 0 && (PROBE == 21 || PROBE == 22)) tfrac = tr; }
      if (PROBE == 1) { __syncthreads(); gemm_phase(lds, 1024, S, E); }
    }
    xcd_barrier(xb);
    if (PROBE >= 30) tq0 = __builtin_amdgcn_s_memrealtime();
    { float tr = mix_phase(get_params(), l, smem, vid); if ((PROBE == 35 || PROBE == 36) && l == 0) tfrac = tr; }
    if (PROBE == 33 && l == 0) tfrac = (float)(__builtin_amdgcn_s_memrealtime() - tq0) / 40000.f;
    xcd_barrier(xb);
    if (PROBE >= 30) tq0 = __builtin_amdgcn_s_memrealtime();
    lru2_phase(get_params(), l, smem);
    if (PROBE == 34 && l == 0) tfrac = (float)(__builtin_amdgcn_s_memrealtime() - tq0) / 40000.f;
    xcd_barrier(xb);
    {
      const Params& p = get_params();
      SchedBranch S; S.G = gridDim.x; S.c = vid; S.P_ = (const char*)p.GB; S.W_ = (const char*)(p.Wt_br + (size_t)l * 3 * 1024 * 512);
      EpiBranch E; E.pp = &p;
      { float tr = gemm_phase(lds, 512, S, E, PROBE == 24); if (l == 0 && (PROBE == 23 || PROBE == 24)) tfrac = tr; }
      if (PROBE == 2) { __syncthreads(); gemm_phase(lds, 512, S, E); }
    }
    xcd_barrier(xb);
    {
      const Params& p = get_params();
      SchedStd S; S.nM = NTOK / 256; S.nN = 4; S.nwg = S.nM * S.nN; S.G = gridDim.x; S.c = vid;
      S.A = (const char*)p.Y; S.B = (const char*)(p.Wt_out + (size_t)l * 1024 * 1024); S.tA = (size_t)256 * 1024 * 2; S.tB = (size_t)256 * 1024 * 2;
      EpiOut E; E.pp = &p; E.l = l;
      { float tr = gemm_phase(lds, 1024, S, E, PROBE == 26); if (l == 0 && (PROBE == 25 || PROBE == 26)) tfrac = tr; }
      if (PROBE == 8 && l == 0) { __syncthreads(); gemm_phase(lds, 1024, S, E); }
    }
    if (l == 0) xcd_barrier(xb);
  }
  if (PROBE >= 20) {
    xcd_barrier(xb);
    if (blockIdx.x == 0 && threadIdx.x == 0) { float* o = get_params().out + O_X + 4194304; *o += 0.42f + 0.45f * fminf(fmaxf(tfrac, 0.f), 1.f); }
  }
}

extern "C" void kernel_launch(void* const* d_in, const int* in_sizes, int n_in, void* d_out, int out_size, void* d_ws,
                              size_t ws_size, hipStream_t stream) {
  Params p{};
  const float** ip = (const float**)&p;
  for (int i = 0; i < 34; i++) ip[i] = (const float*)d_in[i];
  p.out = (float*)d_out;
  char* w = (char*)d_ws; size_t off = 0;
  auto take = [&](size_t bytes) { char* q = w + off; off += (bytes + 255) & ~(size_t)255; return q; };
  p.Wt_in = (u16*)take((size_t)2 * INC * 1024 * 2);
  p.Wt_br = (u16*)take((size_t)6 * 1024 * 512 * 2);
  p.Wt_out = (u16*)take((size_t)2 * 1024 * 1024 * 2);
  p.Y = (u16*)take((size_t)NTOK * 1024 * 2);
  p.P = (u16*)take((size_t)NTOK * PP * 2);
  p.VtA_ctx = p.Y;
  p.VtA_lat = p.VtA_ctx + (size_t)16 * 2 * 64 * 256;
  p.VtC_ctx = p.VtA_lat + (size_t)2 * 2 * 64 * 4096;
  p.VtC_lat = p.VtC_ctx + (size_t)16 * 4 * 128 * 256;
  p.cKa = (u16*)take((size_t)2 * 2 * 512 * 128 * 2);
  p.cVtA = (u16*)take((size_t)2 * 2 * 512 * 128 * 2);
  p.cKc = (u16*)take((size_t)2 * 2 * 512 * 512 * 2);
  p.cVtC = (u16*)take((size_t)2 * 2 * 512 * 512 * 2);
  p.mod = (float*)take((size_t)2 * 3 * 3072 * 4);
  p.rope = (float*)take((size_t)2048 * 4);
  p.lruTot = (float*)take((size_t)192 * 2 * 512 * 2 * 4);
  p.Wt_lru = (u16*)take((size_t)2 * 2 * 8 * 2 * 64 * 64 * 2);
  p.bar = (unsigned*)take((size_t)XCD_BAR_WORDS * 4);
  p.GB = (u16*)take((size_t)3 * NTOK * 512 * 2);
  p.H = p.GB;
  p.MG = (unsigned*)take((size_t)(48 * 4 * 3 + 1) * 16384 * 4);
  static int grid_blocks = 0;
  if (!grid_blocks) {
    int dev = 0, cus = 0;
    hipGetDevice(&dev);
    hipDeviceGetAttribute(&cus, hipDeviceAttributeMultiprocessorCount, dev);
    hipFuncSetAttribute((const void*)fwd_kernel, hipFuncAttributeMaxDynamicSharedMemorySize, LDS_BYTES);
    int per_cu = 0;
    hipOccupancyMaxActiveBlocksPerMultiprocessor(&per_cu, (const void*)fwd_kernel, NT, LDS_BYTES);
    (void)hipGetLastError();
    grid_blocks = cus;
  }
  hipMemsetAsync(p.bar, 0, (size_t)XCD_BAR_WORDS * 4, stream);
  void* args[] = {&p};
  hipLaunchCooperativeKernel((void*)fwd_kernel, dim3(grid_blocks), dim3(NT), args, LDS_BYTES, stream);
}
```

```cpp
#include <hip/hip_runtime.h>
#include <hip/hip_cooperative_groups.h>
#include <stdint.h>
#include <math.h>
namespace cg = cooperative_groups;

typedef unsigned short u16;
typedef __attribute__((ext_vector_type(8))) short bf16x8;
typedef __attribute__((ext_vector_type(4))) short bf16x4;
typedef __attribute__((ext_vector_type(16))) float f32x16;
typedef __attribute__((ext_vector_type(4))) float f32x4;
#define LAS __attribute__((address_space(3)))

#ifndef PROBE
#define PROBE 0
#endif
#define NT 512
constexpr int NTOK = 12288, NCTX = 4096;
constexpr int INC = 7424;
constexpr int PP = 3712;
constexpr int C_QA = 0, C_KA = 512, C_GA = 640, C_XB = 1152, C_GB = 1664, C_QC = 2176, C_KC = 2688, C_GC = 3200;
constexpr int LROW = 72;
constexpr int VROW = 68;
constexpr float EPS = 1e-6f;
constexpr int STAGE_BYTES = 131072;
constexpr int SPARE_BYTES = 8192;
constexpr int ROPE_OFF = STAGE_BYTES + SPARE_BYTES + 16;
constexpr int LDS_BYTES = ROPE_OFF + 8192;

constexpr size_t O_X = 0, O_KA = 12582912, O_VA = 13631488, O_KC = 14680064, O_VC = 18874368, O_ST = 23068672;

struct Params {
  const float *x_prompt, *x_sample, *cache_a_k, *cache_a_v, *cache_c_k, *cache_c_v, *state_lru, *c, *c_ctx,
      *norm_g, *mod_w, *mod_b, *w_in, *qn_a, *kn_a, *sink_a, *conv_w, *conv_b, *lru_wa, *lru_ba, *lru_wx, *lru_bx,
      *lru_lam, *qn_c, *kn_c, *lam_q1, *lam_k1, *lam_q2, *lam_k2, *subln_c, *w_br_a, *w_br_b, *w_br_c, *w_out;
  float* out;
  u16 *Wt_in, *Wt_br, *Wt_out, *H, *P, *VtA_ctx, *VtA_lat, *VtC_ctx, *VtC_lat, *cKa, *cVtA, *cKc, *cVtC;
  float *mod, *rope, *lruTot;
  u16 *Wt_lru;
  unsigned* bar;
  u16* Y;
  u16* GB;
  unsigned* MG;
};

__device__ __forceinline__ int tid_opaque() { int t = (int)threadIdx.x; asm volatile("" : "+v"(t)); return t; }
#define TIDX tid_opaque()
__device__ __forceinline__ u16 f2bf(float f) {
  uint32_t r; asm("v_cvt_pk_bf16_f32 %0, %1, %1" : "=v"(r) : "v"(f)); return (u16)(r & 0xffffu);
}
__device__ __forceinline__ float bf2f(u16 h) { return __uint_as_float(((uint32_t)h) << 16); }
__device__ __forceinline__ uint32_t pack2(float a, float b) { uint32_t r; asm("v_cvt_pk_bf16_f32 %0, %1, %2" : "=v"(r) : "v"(a), "v"(b)); return r; }
__device__ __forceinline__ float sigmoidf_(float x) { return __builtin_amdgcn_rcpf(1.f + __expf(-x)); }
__device__ __forceinline__ float siluf_(float x) { return x * __builtin_amdgcn_rcpf(1.f + __expf(-x)); }
__device__ __forceinline__ f32x16 mfma32(bf16x8 a, bf16x8 b, f32x16 c) {
  return __builtin_amdgcn_mfma_f32_32x32x16_bf16(a, b, c, 0, 0, 0);
}
__device__ __forceinline__ float shflx(float v, int mask, int lane) {
  return __builtin_bit_cast(float, __builtin_amdgcn_ds_bpermute((lane ^ mask) << 2, __builtin_bit_cast(int, v)));
}
__device__ __forceinline__ float lo_bf(uint32_t w) { return __uint_as_float(w << 16); }
__device__ __forceinline__ float hi_bf(uint32_t w) { return __uint_as_float(w & 0xffff0000u); }

__device__ __forceinline__ size_t tm_off(int r, int k, int KT) {
  return ((size_t)((r >> 8) * KT + (k >> 6)) * 256 + (r & 255)) * 64 + (k & 63);
}
__device__ __forceinline__ void transpose_tile(const float* __restrict__ src, int spitch, u16* __restrict__ dst, int dpitch,
                               int r0, int c0, float* sm, int KT = 0) {
  const int tid = TIDX;
#pragma unroll
  for (int i = 0; i < 2; i++) {
    int c = tid + i * NT; int r = c >> 4, q = c & 15;
    float4 v = *(const float4*)(src + (size_t)(r0 + r) * spitch + c0 + q * 4);
    float* d = sm + r * 65 + q * 4;
    d[0] = v.x; d[1] = v.y; d[2] = v.z; d[3] = v.w;
  }
  __syncthreads();
  {
    int c = tid; int cc = c >> 3, q = c & 7;
    uint32_t w[4];
#pragma unroll
    for (int j = 0; j < 4; j++) w[j] = pack2(sm[(q * 8 + 2 * j) * 65 + cc], sm[(q * 8 + 2 * j + 1) * 65 + cc]);
    uint4 v; v.x = w[0]; v.y = w[1]; v.z = w[2]; v.w = w[3];
    if (KT) *(uint4*)(dst + tm_off(c0 + cc, r0 + q * 8, KT)) = v;
    else *(uint4*)(dst + (size_t)(c0 + cc) * dpitch + r0 + q * 8) = v;
  }
  __syncthreads();
}

__device__ __forceinline__ void transpose_wide(const float* __restrict__ src, int spitch, u16* __restrict__ dst,
                                               int k0, int n0, float* sm, int KT) {
  const int tid = TIDX;
  float4 v[8];
#pragma unroll
  for (int i = 0; i < 8; i++) { int c = tid + i * NT; int r = c >> 6, q = c & 63; v[i] = *(const float4*)(src + (size_t)(k0 + r) * spitch + n0 + q * 4); }
#pragma unroll
  for (int i = 0; i < 8; i++) { int c = tid + i * NT; int r = c >> 6, q = c & 63; float* d = sm + r * 257 + q * 4; d[0] = v[i].x; d[1] = v[i].y; d[2] = v[i].z; d[3] = v[i].w; }
  __syncthreads();
#pragma unroll
  for (int i = 0; i < 4; i++) {
    int c = tid + i * NT; int nn = c >> 3, q = c & 7;
    uint4 o;
    o.x = pack2(sm[(q * 8 + 0) * 257 + nn], sm[(q * 8 + 1) * 257 + nn]);
    o.y = pack2(sm[(q * 8 + 2) * 257 + nn], sm[(q * 8 + 3) * 257 + nn]);
    o.z = pack2(sm[(q * 8 + 4) * 257 + nn], sm[(q * 8 + 5) * 257 + nn]);
    o.w = pack2(sm[(q * 8 + 6) * 257 + nn], sm[(q * 8 + 7) * 257 + nn]);
    *(uint4*)(dst + tm_off(n0 + nn, k0 + q * 8, KT)) = o;
  }
  __syncthreads();
}

__device__ __forceinline__ void mod_item(const Params& p, int it, float* sm) {
  const int tid = TIDX;
  const int l = it / 48, n0 = (it % 48) * 64;
  float* sv = sm;
  float* red = sm + 3072;
  for (int e = tid; e < 3072; e += NT) {
    int v = e >> 10, k = e & 1023;
    float x = (v == 0) ? p.c_ctx[k] : p.c[(v - 1) * 1024 + k];
    sv[e] = siluf_(x);
  }
  __syncthreads();
  const int col = tid & 63, kg = tid >> 6;
  const float* w = p.mod_w + (size_t)l * 1024 * 3072 + n0 + col;
  float a0 = 0, a1 = 0, a2 = 0;
#pragma unroll 1
  for (int kb = kg * 128; kb < kg * 128 + 128; kb += 32) {
    float wv[32];
#pragma unroll
    for (int j = 0; j < 32; j++) wv[j] = w[(size_t)(kb + j) * 3072];
#pragma unroll
    for (int j = 0; j < 32; j++) { a0 += sv[kb + j] * wv[j]; a1 += sv[1024 + kb + j] * wv[j]; a2 += sv[2048 + kb + j] * wv[j]; }
  }
  red[(kg * 3 + 0) * 64 + col] = a0; red[(kg * 3 + 1) * 64 + col] = a1; red[(kg * 3 + 2) * 64 + col] = a2;
  __syncthreads();
  if (tid < 192) {
    int v = tid >> 6, c = tid & 63;
    float s = p.mod_b[l * 3072 + n0 + c];
#pragma unroll
    for (int g = 0; g < 8; g++) s += red[(g * 3 + v) * 64 + c];
    p.mod[(l * 3 + v) * 3072 + n0 + c] = s;
  }
  __syncthreads();
}

__device__ __forceinline__ void prologue_phase(const Params& p, float* sm) {
  constexpr int N_MOD = 96, N_ROPE = 1, N_WIN = 2 * 16 * 29, N_WBR = 6 * 8 * 4, N_WOUT = 2 * 16 * 4;
  constexpr int N_CK = 64 + 256, N_CVA = 4 * 16, N_CVC = 4 * 64, N_LW = 64;
  constexpr int E0 = N_MOD, E1 = E0 + N_ROPE, E2 = E1 + N_WIN, E3 = E2 + N_WBR, E4 = E3 + N_WOUT, E5 = E4 + N_CK,
                E6 = E5 + N_CVA, E7 = E6 + N_CVC, E8 = E7 + N_LW;
  const int tid = TIDX;
  for (int it = blockIdx.x; it < E8; it += gridDim.x) {
    if (it < E0) {
      mod_item(p, it, sm);
    } else if (it < E1) {
      for (int e = tid; e < 1024; e += NT) {
        int pos = e >> 4, f = e & 15;
        float inv = powf(10000.f, -(float)f / 16.f);
        float ang = (float)pos * inv;
        p.rope[e] = cosf(ang); p.rope[1024 + e] = sinf(ang);
      }
    } else if (it < E2) {
      int j = it - E1; int l = j / (16 * 29); int r = j % (16 * 29);
      int kt = r / 29, pn = r % 29;
      transpose_wide(p.w_in + (size_t)l * 1024 * INC, INC, p.Wt_in + (size_t)l * INC * 1024, kt * 64, pn * 256, sm, 16);
    } else if (it < E3) {
      int j = it - E2; int m = j / 32; int r = j % 32;
      int l = m / 3, i = m % 3;
      const float* src = (i == 0 ? p.w_br_a : (i == 1 ? p.w_br_b : p.w_br_c)) + (size_t)l * 512 * 1024;
      int kt = r / 4, pn = r % 4;
      transpose_wide(src, 1024, p.Wt_br + (size_t)m * 1024 * 512, kt * 64, pn * 256, sm, 8);
    } else if (it < E4) {
      int j = it - E3; int l = j / 64; int r = j % 64;
      int kt = r / 4, pn = r % 4;
      transpose_wide(p.w_out + (size_t)l * 1024 * 1024, 1024, p.Wt_out + (size_t)l * 1024 * 1024, kt * 64, pn * 256, sm, 16);
    } else if (it < E5) {
      int j = it - E4;
      const float* src; u16* dst; size_t off;
      if (j < 64) { src = p.cache_a_k; dst = p.cKa; off = (size_t)j * 4096; }
      else { src = p.cache_c_k; dst = p.cKc; off = (size_t)(j - 64) * 4096; }
      size_t e = off + (size_t)tid * 8;
      float4 a = *(const float4*)(src + e), b = *(const float4*)(src + e + 4);
      uint4 v; v.x = pack2(a.x, a.y); v.y = pack2(a.z, a.w); v.z = pack2(b.x, b.y); v.w = pack2(b.z, b.w);
      *(uint4*)(dst + e) = v;
    } else if (it < E6) {
      int j = it - E5; int bl = j / 16; int r = j % 16;
      int rt = r / 2, ct = r % 2;
      transpose_tile(p.cache_a_v + (size_t)bl * 512 * 128, 128, p.cVtA + (size_t)bl * 128 * 512, 512, rt * 64, ct * 64, sm);
    } else if (it < E7) {
      int j = it - E6; int bl = j / 64; int r = j % 64;
      int rt = r / 8, ct = r % 8;
      transpose_tile(p.cache_c_v + (size_t)bl * 512 * 512, 512, p.cVtC + (size_t)bl * 512 * 512, 512, rt * 64, ct * 64, sm);
    } else {
      int j = it - E7; int ldn = j >> 1, g = j & 1;
      transpose_tile((g ? p.lru_wx : p.lru_wa) + (size_t)ldn * 4096, 64, p.Wt_lru + (size_t)(ldn * 2 + g) * 4096, 64, 0, 0, sm);
    }
  }
}

__device__ __forceinline__ void norm_phase(const Params& p, int l) {
  const int tid = TIDX, lane = tid & 63, wid = tid >> 6;
  const float* g = p.norm_g + l * 1024;
  for (int it = blockIdx.x; it < NTOK / 8; it += gridDim.x) {
    int row = it * 8 + wid;
    const float* x;
    if (l == 0) x = (row < NCTX) ? p.x_prompt + (size_t)row * 1024 : p.x_sample + (size_t)(row - NCTX) * 1024;
    else x = p.out + O_X + (size_t)row * 1024;
    int v = (row < NCTX) ? 0 : 1 + (row - NCTX) / 4096;
    const float* md = p.mod + (l * 3 + v) * 3072;
    float4 xv[4]; float ss = 0;
#pragma unroll
    for (int i = 0; i < 4; i++) {
      xv[i] = *(const float4*)(x + i * 256 + lane * 4);
      ss += xv[i].x * xv[i].x + xv[i].y * xv[i].y + xv[i].z * xv[i].z + xv[i].w * xv[i].w;
    }
#pragma unroll
    for (int o = 32; o > 0; o >>= 1) ss += shflx(ss, o, lane);
    float rinv = rsqrtf(ss * (1.f / 1024.f) + EPS);
#pragma unroll
    for (int i = 0; i < 4; i++) {
      int c = i * 256 + lane * 4;
      float4 gv = *(const float4*)(g + c), sh = *(const float4*)(md + c), sc = *(const float4*)(md + 1024 + c);
      float h0 = xv[i].x * rinv * gv.x * (1.f + sc.x) + sh.x;
      float h1 = xv[i].y * rinv * gv.y * (1.f + sc.y) + sh.y;
      float h2 = xv[i].z * rinv * gv.z * (1.f + sc.z) + sh.z;
      float h3 = xv[i].w * rinv * gv.w * (1.f + sc.w) + sh.w;
      uint2 o2; o2.x = pack2(h0, h1); o2.y = pack2(h2, h3);
      *(uint2*)(p.H + tm_off(row, c, 16)) = o2;
    }
  }
}

constexpr int G_BK = 64, G_HALF = 128, G_HTB = G_HALF * G_BK * 2;
__device__ __forceinline__ int lds_byte(int r, int c) {
  const int st = (r >> 4) * 2 + (c >> 5), rr = r & 15, cc = c & 31, ob = rr * 64 + cc * 2;
  return st * 1024 + (ob ^ (((ob >> 9) & 1) << 5));
}
__device__ __forceinline__ void stage_rc(int b, int& R, int& C) {
  const int st = b / 1024, sb = b % 1024, swz = sb ^ (((sb >> 9) & 1) << 5);
  R = (st >> 1) * 16 + swz / 64; C = (st & 1) * 32 + (swz % 64) / 2;
}
struct Unit { int pm, pn, seg; };

struct SchedStd {
  int nM, nN, nwg, G, c; const char* A; const char* B; size_t tA, tB;
  __device__ __forceinline__ bool next(int i, Unit& u) const {
    const long L = (long)i * G + c; if (L >= nwg) return false;
    const int wgid = (int)L;
    const int nig = 8 * nN, gid = wgid / nig, fm = gid * 8, gsz = (nM - fm) < 8 ? (nM - fm) : 8;
    u.pm = fm + ((wgid % nig) % gsz); u.pn = (wgid % nig) / gsz; u.seg = 0; return true;
  }
  __device__ __forceinline__ const char* aptr(const Unit& u) const { return A + (size_t)u.pm * tA; }
  __device__ __forceinline__ const char* bptr(const Unit& u) const { return B + (size_t)u.pn * tB; }
};
struct SchedBranch {
  int G, c; const char* P_; const char* W_;
  __device__ __forceinline__ bool next(int i, Unit& u) const {
    if (G == 256) {
      if (i >= 3) return false;
      const int xcd = c >> 5, j = c & 31;
      if (j >= 24) return false;
      u.seg = i; u.pm = xcd * 6 + (j >> 2); u.pn = j & 3; return true;
    }
    const int tile = (i / 3) * G + c; if (tile >= 192) return false;
    u.seg = i % 3; u.pm = tile >> 2; u.pn = tile & 3; return true;
  }
  __device__ __forceinline__ const char* aptr(const Unit& u) const { return P_ + (size_t)((u.seg * 48 + u.pm) * 8) * 32768; }
  __device__ __forceinline__ const char* bptr(const Unit& u) const { return W_ + (size_t)((u.seg * 4 + u.pn) * 8) * 32768; }
};

template <class Epi, class Sched>
__device__ __forceinline__ float gemm_phase(LAS unsigned char* lds, const int K, const Sched& S, const Epi& E, int tmode = 0) {
  unsigned long long t_ph0 = 0, t_epi = 0; if (PROBE >= 20) t_ph0 = __builtin_amdgcn_s_memrealtime();
  const int tid = TIDX, wid = __builtin_amdgcn_readfirstlane(tid >> 6), lane = tid & 63, wr = wid >> 2, wc = wid & 3, fr = lane & 15, fq = lane >> 4;
  const int nt = K / G_BK;
  unsigned voffA[2], voffB[2];
#pragma unroll
  for (int i = 0; i < 2; ++i) { int R, C; stage_rc(tid * 16 + i * 8192, R, C);
    voffA[i] = (unsigned)(R * 64 + C) * 2u; voffB[i] = voffA[i]; }
  const size_t kstep = (size_t)32768;
  const size_t hA = (size_t)16384, hB = (size_t)16384;
  const unsigned ldsw = (unsigned)wid * 1024u;
  const int aoff = lds_byte(wr * 64 + fr, fq * 8), boff = lds_byte(wc * 32 + fr, fq * 8);
#define G_SA(b, h) (((b) * 2 + (h)) * G_HTB)
#define G_SB(b, h) ((4 + (b) * 2 + (h)) * G_HTB)
#define G_STAGE(bufoff, gbase, voff) do { _Pragma("unroll") for (int _i = 0; _i < 2; ++_i) \
    __builtin_amdgcn_global_load_lds((const unsigned*)((const char*)(gbase) + (voff)[_i]), (LAS unsigned*)(lds + (bufoff) + ldsw + _i * 8192), 16, 0, 0); } while (0)
#define G_LDA(dst, b, h) do { _Pragma("unroll") for (int m = 0; m < 4; ++m) _Pragma("unroll") for (int k = 0; k < 2; ++k) dst[m][k] = *(const LAS bf16x8*)(lds + G_SA(b, h) + aoff + m * 2048 + k * 1024); } while (0)
#define G_LDB(dst, b, h) do { _Pragma("unroll") for (int n = 0; n < 2; ++n) _Pragma("unroll") for (int k = 0; k < 2; ++k) dst[n][k] = *(const LAS bf16x8*)(lds + G_SB(b, h) + boff + n * 2048 + k * 1024); } while (0)
#define G_MMA(ai, bj, At, Bt) do { __builtin_amdgcn_s_setprio(1); _Pragma("unroll") for (int m = 0; m < 4; ++m) _Pragma("unroll") for (int n = 0; n < 2; ++n) _Pragma("unroll") for (int k = 0; k < 2; ++k) \
    acc[ai][bj][m][n] = __builtin_amdgcn_mfma_f32_16x16x32_bf16(Bt[n][k], At[m][k], acc[ai][bj][m][n], 0, 0, 0); __builtin_amdgcn_s_setprio(0); } while (0)
#define G_WAIT_V(n) asm volatile("s_waitcnt vmcnt(" #n ")" ::: "memory")
#define G_WAIT_L(n) asm volatile("s_waitcnt lgkmcnt(" #n ")" ::: "memory")
#define G_BAR __builtin_amdgcn_s_barrier()
#define G_SCHED __builtin_amdgcn_sched_barrier(0)
  Unit cur, nxt; int ui = 0;
  if (!S.next(0, cur)) return 0.f;
  f32x4 acc[2][2][4][2];
#pragma unroll
  for (int a = 0; a < 2; ++a)
#pragma unroll
    for (int b = 0; b < 2; ++b)
#pragma unroll
      for (int m = 0; m < 4; ++m)
#pragma unroll
        for (int n = 0; n < 2; ++n) acc[a][b][m][n] = (f32x4){0.f, 0.f, 0.f, 0.f};
  bf16x8 At[4][2], B0[2][2], B1[2][2];
  const char* cA = S.aptr(cur); const char* cB = S.bptr(cur);
  G_STAGE(G_SB(0, 0), cB, voffB); G_STAGE(G_SA(0, 0), cA, voffA); G_STAGE(G_SB(0, 1), cB + hB, voffB); G_STAGE(G_SA(0, 1), cA + hA, voffA);
  if (wr == 1) G_BAR;
  G_WAIT_V(4); G_BAR;
  G_STAGE(G_SB(1, 0), cB + kstep, voffB); G_STAGE(G_SA(1, 0), cA + kstep, voffA); G_STAGE(G_SB(1, 1), cB + hB + kstep, voffB);
  G_WAIT_V(6); G_BAR;
  for (;;) {
    const bool has_next = S.next(ui + 1, nxt);
    const char* nA = has_next ? S.aptr(nxt) : cA; const char* nB = has_next ? S.bptr(nxt) : cB;
    for (int t = 0; t < nt; t += 2) {
      const bool last = (t == nt - 2);
      const char* a1 = cA + (size_t)(t + 1) * kstep;
      const char* a2 = last ? nA : cA + (size_t)(t + 2) * kstep; const char* b2 = last ? nB : cB + (size_t)(t + 2) * kstep;
      const char* a3 = a2 + kstep; const char* b3 = b2 + kstep;
      G_LDB(B0, 0, 0); G_SCHED; G_LDA(At, 0, 0); G_STAGE(G_SA(1, 1), a1 + hA, voffA);
      G_WAIT_L(8); G_BAR; G_WAIT_L(0); G_MMA(0, 0, At, B0); G_BAR; G_SCHED;
      G_LDB(B1, 0, 1); G_STAGE(G_SB(0, 0), b2, voffB);
      G_BAR; G_WAIT_L(0); G_MMA(0, 1, At, B1); G_BAR;
      G_LDA(At, 0, 1); G_STAGE(G_SA(0, 0), a2, voffA);
      G_BAR; G_WAIT_L(0); G_MMA(1, 0, At, B0); G_BAR; G_SCHED;
      G_STAGE(G_SB(0, 1), b2 + hB, voffB);
      G_WAIT_V(6); G_BAR; G_MMA(1, 1, At, B1); G_BAR;
      G_LDB(B0, 1, 0); G_SCHED; G_LDA(At, 1, 0); G_STAGE(G_SA(0, 1), a2 + hA, voffA);
      G_WAIT_L(8); G_BAR; G_WAIT_L(0); G_MMA(0, 0, At, B0); G_BAR; G_SCHED;
      G_LDB(B1, 1, 1); G_STAGE(G_SB(1, 0), b3, voffB);
      G_BAR; G_WAIT_L(0); G_MMA(0, 1, At, B1); G_BAR;
      G_LDA(At, 1, 1); G_STAGE(G_SA(1, 0), a3, voffA);
      G_BAR; G_WAIT_L(0); G_MMA(1, 0, At, B0); G_BAR; G_SCHED;
      G_STAGE(G_SB(1, 1), b3 + hB, voffB);
      G_WAIT_V(6); G_BAR; G_MMA(1, 1, At, B1); G_BAR;
    }
    unsigned long long t_e0 = 0; if (PROBE >= 20) t_e0 = __builtin_amdgcn_s_memrealtime();
    const bool reset = E(acc, cur, wr, wc, fr, fq);
    if (PROBE >= 20) { asm volatile("s_waitcnt vmcnt(0)" ::: "memory"); t_epi += __builtin_amdgcn_s_memrealtime() - t_e0; }
    if (!has_next) break;
    if (reset) {
#pragma unroll
      for (int a = 0; a < 2; ++a)
#pragma unroll
        for (int b = 0; b < 2; ++b)
#pragma unroll
          for (int m = 0; m < 4; ++m)
#pragma unroll
            for (int n = 0; n < 2; ++n) acc[a][b][m][n] = (f32x4){0.f, 0.f, 0.f, 0.f};
    }
    cur = nxt; cA = nA; cB = nB; ++ui;
  }
  G_WAIT_V(0);
  if (wr == 0) G_BAR;
  G_BAR;
  float tres = 0.f;
  if (PROBE >= 20) {
    const unsigned long long tot = __builtin_amdgcn_s_memrealtime() - t_ph0;
    tres = (tmode == 0) ? (float)t_epi / (float)tot : (float)tot / 40000.f;
  }
#undef G_SA
#undef G_SB
#undef G_STAGE
#undef G_LDA
#undef G_LDB
#undef G_MMA
#undef G_WAIT_V
#undef G_WAIT_L
#undef G_BAR
#undef G_SCHED
  return tres;
}

struct EpiInproj {
  const Params* pp; int l; LAS float* part; const LAS float* ropeL;
  __device__ __forceinline__ bool operator()(f32x4 (&acc)[2][2][4][2], const Unit& u, int wr, int wc, int fr, int fq) const {
    const Params& p = *pp;
    asm volatile("" : "+v"(fr), "+v"(fq));
    const int lane = fr + 16 * fq; (void)lane;
    const int oc0 = u.pn * 256;
    const bool isctx = u.pm < 16;
    const bool qkU = (oc0 < 768) || (oc0 >= 2304 && oc0 < 3328);
    float rinv[2][4][2];
    if (qkU) {
#pragma unroll
      for (int ai = 0; ai < 2; ai++)
#pragma unroll
        for (int m = 0; m < 4; m++)
#pragma unroll
          for (int bj = 0; bj < 2; bj++) {
            f32x4 a = acc[ai][bj][m][0], b = acc[ai][bj][m][1];
            float ss = a[0] * a[0] + a[1] * a[1] + a[2] * a[2] + a[3] * a[3] + b[0] * b[0] + b[1] * b[1] + b[2] * b[2] + b[3] * b[3];
            ss += shflx(ss, 16, lane); ss += shflx(ss, 32, lane);
            rinv[ai][m][bj] = ss;
            if (fq == 0) part[((ai * 128 + wr * 64 + m * 16 + fr) * 2 + bj) * 4 + wc] = ss;
          }
      asm volatile("s_waitcnt lgkmcnt(0)" ::: "memory");
      __builtin_amdgcn_s_barrier();
      asm volatile("" ::: "memory");
#pragma unroll
      for (int ai = 0; ai < 2; ai++)
#pragma unroll
        for (int m = 0; m < 4; m++)
#pragma unroll
          for (int bj = 0; bj < 2; bj++) {
            float o = part[((ai * 128 + wr * 64 + m * 16 + fr) * 2 + bj) * 4 + (wc ^ 1)];
            rinv[ai][m][bj] = rsqrtf((rinv[ai][m][bj] + o) * (1.f / 64.f) + EPS);
          }
    }
#pragma unroll
    for (int bj = 0; bj < 2; bj++) {
      const int oc = oc0 + bj * 128;
      if (oc == 640 || (oc >= 3328 && oc < 3840)) {
        const bool isA = (oc == 640);
        const int cb = isA ? 0 : (oc - 3328);
        const int nvec = isA ? 128 : 512;
#pragma unroll
        for (int ai = 0; ai < 2; ai++)
#pragma unroll
          for (int m = 0; m < 4; m++) {
            const int row = u.pm * 256 + ai * 128 + wr * 64 + m * 16 + fr;
            int b, t, T; u16* vt;
            if (isctx) { b = row >> 8; t = row & 255; T = 256; vt = isA ? p.VtA_ctx : p.VtC_ctx; }
            else { int rr = row - NCTX; b = rr >> 12; t = rr & 4095; T = 4096; vt = isA ? p.VtA_lat : p.VtC_lat; }
#pragma unroll
            for (int n = 0; n < 2; n++) {
              const int d = cb + wc * 32 + n * 16 + fq * 4;
              f32x4 v = acc[ai][bj][m][n];
#pragma unroll
              for (int j = 0; j < 4; j++) vt[((size_t)b * nvec + d + j) * T + t] = f2bf(v[j]);
              if (isctx) {
                float* o = p.out + (isA ? O_VA : O_VC) + ((size_t)(b * 2 + l) * 256 + t) * nvec + d;
                *(f32x4*)o = v;
              }
            }
          }
      } else {
        const int pc = (oc < 640) ? oc : (oc < 3328 ? oc - 128 : oc - 640);
        const bool is_qa = oc < 512, is_ka = (oc == 512);
        const bool is_qc = (oc >= 2304 && oc < 2816), is_kc = (oc >= 2816 && oc < 3328);
        if (is_qa || is_ka || is_qc || is_kc) {
          const float* gn = (is_qa ? p.qn_a : is_ka ? p.kn_a : is_qc ? p.qn_c : p.kn_c) + l * 64 + (wc & 1) * 32 + fq * 4;
          const f32x4 g0 = *(const f32x4*)gn, g1 = *(const f32x4*)(gn + 16);
          const float qs = (is_qa || is_qc) ? 0.18033688011112042f : 1.f;
#pragma unroll
          for (int ai = 0; ai < 2; ai++)
#pragma unroll
            for (int m = 0; m < 4; m++) {
              const int row = u.pm * 256 + ai * 128 + wr * 64 + m * 16 + fr;
              const float ri = rinv[ai][m][bj];
              f32x4 x1 = acc[ai][bj][m][0] * ri * g0, x2 = acc[ai][bj][m][1] * ri * g1;
              if (!isctx) {
                const int t = (row - NCTX) & 4095;
                const int pos = (wc & 1) ? (t & 63) : (t >> 6);
                const f32x4 cs = *(const LAS f32x4*)(ropeL + pos * 16 + fq * 4), sn = *(const LAS f32x4*)(ropeL + 1024 + pos * 16 + fq * 4);
                f32x4 y1 = x1 * cs - x2 * sn, y2 = x2 * cs + x1 * sn;
                x1 = y1; x2 = y2;
              } else if (is_ka || is_kc) {
                const int b = row >> 8, t = row & 255;
                float* o = is_ka ? p.out + O_KA + ((size_t)(b * 2 + l) * 256 + t) * 128 + wc * 32 + fq * 4
                                 : p.out + O_KC + ((size_t)(b * 2 + l) * 256 + t) * 512 + (oc - 2816) + wc * 32 + fq * 4;
                *(f32x4*)o = x1; *(f32x4*)(o + 16) = x2;
              }
              x1 = x1 * qs; x2 = x2 * qs;
              u16* po = p.P + (size_t)row * PP + pc + wc * 32 + fq * 4;
              *(uint2*)po = make_uint2(pack2(x1[0], x1[1]), pack2(x1[2], x1[3]));
              *(uint2*)(po + 16) = make_uint2(pack2(x2[0], x2[1]), pack2(x2[2], x2[3]));
            }
        } else {
          const int mode = (oc >= 4352) ? 2 : ((oc >= 1280 && oc < 1792) ? 0 : 1);
          if (mode == 2) {
            const int pj = u.pn - 17, seg = pj >> 2, pn4 = pj & 3;
            unsigned* mg = p.MG + ((size_t)((u.pm * 4 + pn4) * 3 + seg) * 8 + (wr * 4 + wc)) * 2048 + lane;
#pragma unroll
            for (int ai = 0; ai < 2; ai++)
#pragma unroll
              for (int m = 0; m < 4; m++)
#pragma unroll
                for (int n = 0; n < 2; n++) {
                  f32x4 v = acc[ai][bj][m][n];
                  const unsigned q0 = (unsigned)(sigmoidf_(v[0]) * 254.f + 1.5f), q1 = (unsigned)(sigmoidf_(v[1]) * 254.f + 1.5f);
                  const unsigned q2 = (unsigned)(sigmoidf_(v[2]) * 254.f + 1.5f), q3 = (unsigned)(sigmoidf_(v[3]) * 254.f + 1.5f);
                  mg[(((ai * 4 + m) * 2 + bj) * 2 + n) * 64] = q0 | (q1 << 8) | (q2 << 16) | (q3 << 24);
                }
          } else
#pragma unroll
          for (int ai = 0; ai < 2; ai++)
#pragma unroll
            for (int m = 0; m < 4; m++) {
              const int row = u.pm * 256 + ai * 128 + wr * 64 + m * 16 + fr;
              u16* po = p.P + (size_t)row * PP + pc + wc * 32 + fq * 4;
#pragma unroll
              for (int n = 0; n < 2; n++) {
                f32x4 v = acc[ai][bj][m][n];
                if (mode == 1) { v[0] = siluf_(v[0]); v[1] = siluf_(v[1]); v[2] = siluf_(v[2]); v[3] = siluf_(v[3]); }
                else if (mode == 2) { v[0] = sigmoidf_(v[0]); v[1] = sigmoidf_(v[1]); v[2] = sigmoidf_(v[2]); v[3] = sigmoidf_(v[3]); }
                *(uint2*)(po + n * 16) = make_uint2(pack2(v[0], v[1]), pack2(v[2], v[3]));
              }
            }
        }
      }
    }
    return true;
  }
};

struct EpiBranch {
  const Params* pp;
  __device__ __forceinline__ bool operator()(f32x4 (&acc)[2][2][4][2], const Unit& u, int wr, int wc, int fr, int fq) const {
    const Params& p = *pp;
    asm volatile("" : "+v"(fr), "+v"(fq));
    const int lane = fr + 16 * fq;
    const int seg = u.seg;
    const unsigned* mg = p.MG + ((size_t)((u.pm * 4 + u.pn) * 3 + seg) * 8 + (wr * 4 + wc)) * 2048 + lane;
    const float sel = (seg < 2) ? 1.f : 0.f;
#pragma unroll
    for (int hq = 0; hq < 4; hq++) {
      unsigned a[8], b[8];
#pragma unroll
      for (int q = 0; q < 8; q++) { a[q] = mg[(hq * 8 + q) * 64]; b[q] = mg[(hq * 8 + q) * 64 + 8 * 2048]; }
      __builtin_amdgcn_sched_barrier(0);
#pragma unroll
      for (int q = 0; q < 8; q++) {
        const int ai = hq >> 1, m = (hq & 1) * 2 + (q >> 2), bj = (q >> 1) & 1, n = q & 1;
        f32x4 f = {(float)(a[q] & 255u), (float)((a[q] >> 8) & 255u), (float)((a[q] >> 16) & 255u), (float)(a[q] >> 24)};
        f32x4 g = {(float)(b[q] & 255u), (float)((b[q] >> 8) & 255u), (float)((b[q] >> 16) & 255u), (float)(b[q] >> 24)};
        g = g * sel + (1.f - sel) * 255.f;
        f[0] *= __builtin_amdgcn_rcpf(g[0]); f[1] *= __builtin_amdgcn_rcpf(g[1]); f[2] *= __builtin_amdgcn_rcpf(g[2]); f[3] *= __builtin_amdgcn_rcpf(g[3]);
        acc[ai][bj][m][n] = acc[ai][bj][m][n] * f;
      }
    }
    if (seg < 2) return false;
#pragma unroll
    for (int ai = 0; ai < 2; ai++)
#pragma unroll
      for (int m = 0; m < 4; m++) {
        const int row = u.pm * 256 + ai * 128 + wr * 64 + m * 16 + fr;
#pragma unroll
        for (int bj = 0; bj < 2; bj++)
#pragma unroll
          for (int n = 0; n < 2; n++) {
            const int col = u.pn * 256 + bj * 128 + wc * 32 + n * 16 + fq * 4;
            const f32x4 v = acc[ai][bj][m][n];
            *(uint2*)(p.Y + tm_off(row, col, 16)) = make_uint2(pack2(v[0], v[1]), pack2(v[2], v[3]));
          }
      }
    return true;
  }
};

struct EpiOut {
  const Params* pp; int l;
  __device__ __forceinline__ bool operator()(f32x4 (&acc)[2][2][4][2], const Unit& u, int wr, int wc, int fr, int fq) const {
    const Params& p = *pp;
    asm volatile("" : "+v"(fr), "+v"(fq));
    const int v = (u.pm < 16) ? 0 : 1 + (u.pm - 16) / 16;
    const float* gt = p.mod + (l * 3 + v) * 3072 + 2048 + u.pn * 256 + wc * 32 + fq * 4;
    const float* xsrc = (l == 0) ? ((u.pm < 16) ? p.x_prompt + (size_t)u.pm * 256 * 1024 : p.x_sample + (size_t)(u.pm - 16) * 256 * 1024)
                                 : p.out + O_X + (size_t)u.pm * 256 * 1024;
    float* odst = p.out + O_X + (size_t)u.pm * 256 * 1024;
    const int cbase = u.pn * 256 + wc * 32 + fq * 4;
    f32x4 gv[2][2];
#pragma unroll
    for (int bj = 0; bj < 2; bj++)
#pragma unroll
      for (int n = 0; n < 2; n++) gv[bj][n] = *(const f32x4*)(gt + bj * 128 + n * 16);
#pragma unroll
    for (int ai = 0; ai < 2; ai++)
#pragma unroll
      for (int mh = 0; mh < 2; mh++) {
        f32x4 xv[2][2][2];
#pragma unroll
        for (int mm = 0; mm < 2; mm++)
#pragma unroll
          for (int bj = 0; bj < 2; bj++)
#pragma unroll
            for (int n = 0; n < 2; n++)
              xv[mm][bj][n] = *(const f32x4*)(xsrc + (size_t)(ai * 128 + wr * 64 + (mh * 2 + mm) * 16 + fr) * 1024 + cbase + bj * 128 + n * 16);
#pragma unroll
        for (int mm = 0; mm < 2; mm++)
#pragma unroll
          for (int bj = 0; bj < 2; bj++)
#pragma unroll
            for (int n = 0; n < 2; n++)
              *(f32x4*)(odst + (size_t)(ai * 128 + wr * 64 + (mh * 2 + mm) * 16 + fr) * 1024 + cbase + bj * 128 + n * 16) = xv[mm][bj][n] + gv[bj][n] * acc[ai][bj][mh * 2 + mm][n];
      }
    return true;
  }
};

template <bool MASK>
__device__ __forceinline__ void fs_scores(const u16* Ks, const bf16x8 (&qf)[4], f32x16 (&s)[2], int lane, int kpos0, int qpos, int T) {
  const int r = lane & 31, h = lane >> 5;
  {
    bf16x8 kf[2][4];
#pragma unroll
    for (int sub = 0; sub < 2; sub++)
#pragma unroll
      for (int ks = 0; ks < 4; ks++) kf[sub][ks] = *(const bf16x8*)(Ks + (sub * 32 + r) * LROW + ks * 16 + h * 8);
    __builtin_amdgcn_sched_barrier(0);
#pragma unroll
    for (int sub = 0; sub < 2; sub++) {
#pragma unroll
      for (int e = 0; e < 16; e++) s[sub][e] = 0.f;
#pragma unroll
      for (int ks = 0; ks < 4; ks++) s[sub] = mfma32(kf[sub][ks], qf[ks], s[sub]);
    }
  }
  if (MASK) {
#pragma unroll
    for (int sub = 0; sub < 2; sub++)
#pragma unroll
      for (int e = 0; e < 16; e++) {
        int kp = kpos0 + sub * 32 + (e & 3) + 8 * (e >> 2) + 4 * h;
        int dlt = kp - qpos;
        bool ok = (kp >= 0) && (kp < T) && (dlt <= 128) && (dlt >= -128);
        if (!ok) s[sub][e] = -INFINITY;
      }
  }
}
template <int DV>
__device__ __forceinline__ void fs_softmax(f32x16 (&s)[2], float& m, float& l, f32x16 (&o)[DV / 32], bf16x8 (&pf)[2][2], int lane) {
  float mx = s[0][0];
#pragma unroll
  for (int sub = 0; sub < 2; sub++)
#pragma unroll
    for (int e = 0; e < 16; e++) mx = fmaxf(mx, s[sub][e]);
  mx = fmaxf(mx, shflx(mx, 32, lane));
  const bool grow = mx > m;
  const float mn = grow ? mx : m;
  float sum = 0.f;
#pragma unroll
  for (int sub = 0; sub < 2; sub++)
#pragma unroll
    for (int e = 0; e < 16; e++) { float pv = __builtin_amdgcn_exp2f(s[sub][e] - mn); s[sub][e] = pv; sum += pv; }
  sum += shflx(sum, 32, lane);
  if (__builtin_amdgcn_ballot_w64(grow) != 0ull) {
    const float alpha = __builtin_amdgcn_exp2f(m - mn);
    l *= alpha;
#pragma unroll
    for (int ds = 0; ds < DV / 32; ds++)
#pragma unroll
      for (int e = 0; e < 16; e++) o[ds][e] *= alpha;
  }
  l += sum; m = mn;
  typedef __attribute__((ext_vector_type(4))) unsigned u32x4;
#pragma unroll
  for (int sub = 0; sub < 2; sub++)
#pragma unroll
    for (int st = 0; st < 2; st++) {
      u32x4 pw;
#pragma unroll
      for (int j = 0; j < 4; j++) pw[j] = pack2(s[sub][8 * st + 2 * j], s[sub][8 * st + 2 * j + 1]);
      pf[sub][st] = __builtin_bit_cast(bf16x8, pw);
    }
}
template <int DV>
__device__ __forceinline__ void fs_pv(const bf16x8 (&pf)[2][2], const u16* Vts, f32x16 (&o)[DV / 32], int lane) {
  const int r = lane & 31, h = lane >> 5;
#pragma unroll
  for (int sub = 0; sub < 2; sub++) {
    bf16x8 vf[2][DV / 32];
#pragma unroll
    for (int st = 0; st < 2; st++)
#pragma unroll
      for (int ds = 0; ds < DV / 32; ds++) {
        const u16* vp = Vts + (ds * 32 + r) * VROW + sub * 32 + 16 * st + 4 * h;
        bf16x4 lo = *(const bf16x4*)vp, hi = *(const bf16x4*)(vp + 8);
        vf[st][ds] = __builtin_shufflevector(lo, hi, 0, 1, 2, 3, 4, 5, 6, 7);
      }
    __builtin_amdgcn_sched_barrier(0);
#pragma unroll
    for (int st = 0; st < 2; st++)
#pragma unroll
      for (int ds = 0; ds < DV / 32; ds++) o[ds] = mfma32(vf[st][ds], pf[sub][st], o[ds]);
    __builtin_amdgcn_sched_barrier(0);
  }
}

__device__ __forceinline__ uint4 ld_k(const u16* __restrict__ src, size_t pitch, int r0, int nrows, int c) {
  int row = c >> 3, kc = c & 7; int rr = r0 + row;
  const bool ok = (rr >= 0 && rr < nrows);
  const int rc = rr < 0 ? 0 : (rr >= nrows ? nrows - 1 : rr);
  uint4 v = *(const uint4*)(src + (size_t)rc * pitch + kc * 8);
  if (!ok) v = make_uint4(0, 0, 0, 0);
  return v;
}
__device__ __forceinline__ void st_k(u16* dst, int c, uint4 v) { *(uint4*)(dst + (c >> 3) * LROW + (c & 7) * 8) = v; }
__device__ __forceinline__ uint4 ld_vt(const u16* __restrict__ src, int T, int k0, int c) {
  int d = c >> 3, kc = c & 7; int k = k0 + kc * 8;
  const bool ok = (k >= 0 && k < T);
  const int kk = k < 0 ? 0 : (k >= T ? T - 8 : k);
  uint4 v = *(const uint4*)(src + (size_t)d * T + kk);
  if (!ok) v = make_uint4(0, 0, 0, 0);
  return v;
}
__device__ __forceinline__ void st_vt(u16* dst, int c, uint4 v) {
  uint2* q = (uint2*)(dst + (c >> 3) * VROW + (c & 7) * 8);
  q[0] = make_uint2(v.x, v.y); q[1] = make_uint2(v.z, v.w);
}

constexpr int A_BUF = 64 * LROW + 64 * VROW;
__device__ __forceinline__ void attnA_item(const Params& p, int l, int it, u16* sm, bool dry = false) {
  const int tid = TIDX, lane = tid & 63, wid = tid >> 6;
  const int r = lane & 31, h = lane >> 5;
  const bool isctx = it < 128;
  int b, kvh, qb, T, rowbase; const u16* VtBase;
  if (isctx) { b = it >> 3; kvh = (it >> 2) & 1; qb = it & 3; T = 256; rowbase = b * 256;
    VtBase = p.VtA_ctx + ((size_t)(b * 2 + kvh) * 64) * 256; }
  else { int j = it - 128; b = j >> 7; kvh = (j >> 6) & 1; qb = j & 63; T = 4096; rowbase = NCTX + b * 4096;
    VtBase = p.VtA_lat + ((size_t)(b * 2 + kvh) * 64) * 4096; }
  const int qblk = qb * 64;
  const int q0 = qblk + (wid >> 2) * 32;
  const int head = kvh * 4 + (wid & 3);
  const size_t prow = (size_t)(rowbase + q0 + r) * PP;
  bf16x8 qf[4];
#pragma unroll
  for (int ks = 0; ks < 4; ks++) qf[ks] = *(const bf16x8*)(p.P + prow + C_QA + head * 64 + ks * 16 + h * 8);
  float m = p.sink_a[l * 8 + head] * 1.4426950408889634f, ls = 1.f;
  f32x16 o[2];
#pragma unroll
  for (int ds = 0; ds < 2; ds++)
#pragma unroll
    for (int e = 0; e < 16; e++) o[ds][e] = 0.f;
  const u16* Kbase = p.P + (size_t)rowbase * PP + C_KA + kvh * 64;
  const u16* cK = p.cKa + ((size_t)(b * 2 + l) * 512) * 128 + kvh * 64;
  const u16* cVt = p.cVtA + ((size_t)((b * 2 + l) * 2 + kvh) * 64) * 512;
  const int qpos = q0 + r;
  int i_lo = 0, nW, ntile;
  if (isctx) { nW = 4; ntile = 4; }
  else {
    i_lo = (qblk < 128) ? (128 - qblk) / 64 : 0;
    int i_hi = (T - qblk + 128) / 64; if (i_hi > 5) i_hi = 5;
    nW = i_hi - i_lo; ntile = nW + 8;
  }
  uint4 rk, rv;
  auto tile_load = [&](int t) {
    if (t < nW) {
      int k0 = isctx ? t * 64 : qblk - 128 + 64 * (i_lo + t);
      rk = ld_k(Kbase, PP, k0, T, tid); rv = ld_vt(VtBase, T, k0, tid);
    } else {
      int kt = t - nW;
      rk = ld_k(cK, 128, kt * 64, 512, tid); rv = ld_vt(cVt, 512, kt * 64, tid);
    }
  };
  auto KB = [&](int i) { return sm + (i & 1) * (64 * LROW); };
  auto VB = [&](int i) { return sm + 2 * 64 * LROW + (i % 3) * (64 * VROW); };
  const bool lag = (wid >> 2) != 0;
  __syncthreads();
  tile_load(0);
  st_k(KB(0), tid, rk); st_vt(VB(0), tid, rv);
  __syncthreads();
  bf16x8 pf[2][2];
  for (int t = 0; t <= ntile; t++) {
    const bool more = t + 1 < ntile;
    if (more) tile_load(t + 1);
    if (lag && t > 0) fs_pv<64>(pf, VB(t - 1), o, lane);
    if (t < ntile) {
      f32x16 sc[2];
      if (!isctx && t < nW) fs_scores<true>(KB(t), qf, sc, lane, qblk - 128 + 64 * (i_lo + t), qpos, T);
      else fs_scores<false>(KB(t), qf, sc, lane, 0, 0, T);
      fs_softmax<64>(sc, m, ls, o, pf, lane);
      if (!lag) fs_pv<64>(pf, VB(t), o, lane);
    }
    if (more) { st_k(KB(t + 1), tid, rk); st_vt(VB(t + 1), tid, rv); }
    __syncthreads();
  }
  const float inv = __builtin_amdgcn_rcpf(ls);
  {
    uint2 gv[2][4];
#pragma unroll
    for (int ds = 0; ds < 2; ds++)
#pragma unroll
      for (int g = 0; g < 4; g++) gv[ds][g] = *(const uint2*)(p.P + prow + C_GA + head * 64 + ds * 32 + 8 * g + 4 * h);
    __builtin_amdgcn_sched_barrier(0);
#pragma unroll
    for (int ds = 0; ds < 2; ds++)
#pragma unroll
      for (int g = 0; g < 4; g++) {
        int d = ds * 32 + 8 * g + 4 * h;
        uint2 ov;
        ov.x = pack2(o[ds][4 * g] * inv * lo_bf(gv[ds][g].x), o[ds][4 * g + 1] * inv * hi_bf(gv[ds][g].x));
        ov.y = pack2(o[ds][4 * g + 2] * inv * lo_bf(gv[ds][g].y), o[ds][4 * g + 3] * inv * hi_bf(gv[ds][g].y));
        *(uint2*)(p.GB + tm_off(rowbase + q0 + r, head * 64 + d, 8)) = ov;
      }
  }
}

constexpr int C_BUF = 128 * LROW + 128 * VROW;
__device__ __forceinline__ void attnC_item(const Params& p, int l, int it, u16* sm, float lam, float lam_init, bool dry = false) {
  const int tid = TIDX, lane = tid & 63, wid = tid >> 6;
  const int r = lane & 31, h = lane >> 5;
  const bool isctx = it < 128;
  int b, hd, qb, T, rowbase; const u16* VtBase;
  if (isctx) { b = it >> 3; hd = (it >> 1) & 3; qb = it & 1; T = 256; rowbase = b * 256;
    VtBase = p.VtC_ctx + ((size_t)(b * 4 + hd) * 128) * 256; }
  else { int j = it - 128; b = j >> 7; hd = (j >> 5) & 3; qb = j & 31; T = 4096; rowbase = NCTX + b * 4096;
    VtBase = p.VtC_lat + ((size_t)(b * 4 + hd) * 128) * 4096; }
  const int qg = wid & 3, map = wid >> 2;
  const int q0 = qb * 128 + qg * 32;
  const size_t prow = (size_t)(rowbase + q0 + r) * PP;
  bf16x8 qf[4];
#pragma unroll
  for (int ks = 0; ks < 4; ks++) qf[ks] = *(const bf16x8*)(p.P + prow + C_QC + hd * 128 + map * 64 + ks * 16 + h * 8);
  float m = -1e30f, ls = 0.f;
  f32x16 o[4];
#pragma unroll
  for (int ds = 0; ds < 4; ds++)
#pragma unroll
    for (int e = 0; e < 16; e++) o[ds][e] = 0.f;
  const u16* Kbase = p.P + (size_t)rowbase * PP + C_KC + hd * 128;
  const u16* cK = p.cKc + ((size_t)(b * 2 + l) * 512) * 512 + hd * 128;
  const u16* cVt = p.cVtC + ((size_t)((b * 2 + l) * 4 + hd) * 128) * 512;
  const int nW = T / 64, ntile = isctx ? nW : nW + 8;
  uint4 rk0, rk1, rv0, rv1;
  auto tile_load = [&](int t) {
    if (t < nW) {
      rk0 = ld_k(Kbase, PP, t * 64, T, tid); rk1 = ld_k(Kbase + 64, PP, t * 64, T, tid);
      rv0 = ld_vt(VtBase, T, t * 64, tid); rv1 = ld_vt(VtBase, T, t * 64, tid + NT);
    } else {
      int kt = t - nW;
      rk0 = ld_k(cK, 512, kt * 64, 512, tid); rk1 = ld_k(cK + 64, 512, kt * 64, 512, tid);
      rv0 = ld_vt(cVt, 512, kt * 64, tid); rv1 = ld_vt(cVt, 512, kt * 64, tid + NT);
    }
  };
  auto KB = [&](int i) { return sm + (i & 1) * (128 * LROW); };
  auto VB = [&](int i) { return sm + 2 * 128 * LROW + (i % 3) * (128 * VROW); };
  auto tile_store = [&](int i) {
    u16* kd = KB(i); u16* vd = VB(i);
    st_k(kd, tid, rk0); st_k(kd + 64 * LROW, tid, rk1);
    st_vt(vd, tid, rv0); st_vt(vd, tid + NT, rv1);
  };
  const bool lag = map != 0;
  __syncthreads();
  tile_load(0);
  tile_store(0);
  __syncthreads();
  bf16x8 pf[2][2];
  for (int t = 0; t <= ntile; t++) {
    const bool more = t + 1 < ntile;
    if (more) tile_load(t + 1);
    if (lag && t > 0) fs_pv<128>(pf, VB(t - 1), o, lane);
    if (t < ntile) {
      f32x16 sc[2];
      fs_scores<false>(KB(t) + map * 64 * LROW, qf, sc, lane, 0, 0, T);
      fs_softmax<128>(sc, m, ls, o, pf, lane);
      if (!lag) fs_pv<128>(pf, VB(t), o, lane);
    }
    if (more) tile_store(t + 1);
    __syncthreads();
  }
  float* xch = (float*)sm;
  if (map == 1) {
    const float inv = lam * __builtin_amdgcn_rcpf(ls);
#pragma unroll
    for (int ds = 0; ds < 4; ds++)
#pragma unroll
      for (int e = 0; e < 16; e++) xch[((qg * 64) + ds * 16 + e) * 64 + lane] = o[ds][e] * inv;
  }
  __syncthreads();
  if (map == 0) {
    const float i0 = __builtin_amdgcn_rcpf(ls);
    float ss = 0.f;
#pragma unroll
    for (int ds = 0; ds < 4; ds++)
#pragma unroll
      for (int e = 0; e < 16; e++) {
        float v = o[ds][e] * i0 - xch[((qg * 64) + ds * 16 + e) * 64 + lane];
        o[ds][e] = v; ss += v * v;
      }
    ss += shflx(ss, 32, lane);
    const float rinv = rsqrtf(ss * (1.f / 128.f) + EPS) * (1.f - lam_init);
    const float* sg = p.subln_c + l * 128;
#pragma unroll
    for (int ds = 0; ds < 4; ds++) {
      uint2 gv[4]; float4 sl[4];
#pragma unroll
      for (int g = 0; g < 4; g++) {
        const int d = ds * 32 + 8 * g + 4 * h;
        gv[g] = *(const uint2*)(p.P + prow + C_GC + hd * 128 + d);
        sl[g] = *(const float4*)(sg + d);
      }
      __builtin_amdgcn_sched_barrier(0);
#pragma unroll
      for (int g = 0; g < 4; g++) {
        const int d = ds * 32 + 8 * g + 4 * h;
        uint2 ov;
        ov.x = pack2(o[ds][4 * g] * rinv * sl[g].x * lo_bf(gv[g].x), o[ds][4 * g + 1] * rinv * sl[g].y * hi_bf(gv[g].x));
        ov.y = pack2(o[ds][4 * g + 2] * rinv * sl[g].z * lo_bf(gv[g].y), o[ds][4 * g + 3] * rinv * sl[g].w * hi_bf(gv[g].y));
        *(uint2*)(p.GB + (size_t)2 * NTOK * 512 + tm_off(rowbase + q0 + r, hd * 128 + d, 8)) = ov;
      }
    }
  }
}

__device__ __forceinline__ void lru_run(const Params& p, int l, bool pass2, int start, int G, float* sm, bool dry = false) {
  const int tid = TIDX;
  const int lane = tid & 63, wid = tid >> 6, r = lane & 31, h = lane >> 5;
  const int n = start & 7;
  float* xin = sm;
  float* xb = sm + 67 * 64;
  float* comb = xb + 64 * 64;
  float* carry = comb + 2048;
  float* parts = carry + 128;
  float* ab = parts + 1024;
  u16* xbh = (u16*)(ab + 4 * 4096);
  const int gd = wid >> 2, gth = (wid >> 1) & 1, gdh = wid & 1;
  bf16x8 wfa[4], wfx[4];
  {
    const u16* wbase = p.Wt_lru + ((size_t)(((l * 2 + gd) * 8 + n) * 2) * 64 + gdh * 32 + r) * 64 + h * 8;
#pragma unroll
    for (int ks = 0; ks < 4; ks++) { wfa[ks] = *(const bf16x8*)(wbase + ks * 16); wfx[ks] = *(const bf16x8*)(wbase + 4096 + ks * 16); }
  }
  const int gch = n * 64 + gdh * 32 + r;
  const float g_ba = p.lru_ba[(l * 2 + gd) * 512 + gch], g_bx = p.lru_bx[(l * 2 + gd) * 512 + gch];
  const float g_sp = log1pf(__expf(-p.lru_lam[(l * 2 + gd) * 512 + gch]));
  const int cc = tid & 63;
  float cw[4]; float cbv;
  {
    const float* cwp = p.conv_w + l * 4 * 512 + n * 64 + cc;
    cw[0] = cwp[0]; cw[1] = cwp[512]; cw[2] = cwp[1024]; cw[3] = cwp[1536];
    cbv = p.conv_b[l * 512 + n * 64 + cc];
  }
  const int dout = tid & 63, tg = tid >> 6;
  const int ch = n * 64 + dout;

  u16 xr[9];
  auto xin_load = [&](int it_) {
    const int row0_ = (it_ >> 3) * 64;
    int T_, seq0_;
    if (row0_ < NCTX) { T_ = 256; seq0_ = (row0_ >> 8) * 256; } else { T_ = 4096; seq0_ = NCTX + ((row0_ - NCTX) >> 12) * 4096; }
    const int t0_ = row0_ - seq0_;
#pragma unroll
    for (int k = 0; k < 9; k++) {
      const int rr = (tid >> 6) + 8 * k; const int t = t0_ - 2 + rr;
      const bool ok = (rr < 67 && t >= 0 && t < T_);
      const int tc = t < 0 ? 0 : (t >= T_ ? T_ - 1 : t);
      u16 v = p.P[(size_t)(seq0_ + tc) * PP + C_XB + n * 64 + cc];
      xr[k] = ok ? v : (u16)0;
    }
  };
  if (start < 1536) xin_load(start);
  for (int it = start; it < 1536; it += G) {
    const int ci = it >> 3;
    const int row0 = ci * 64;
    const bool isctx = row0 < NCTX;
    int T, seq0, bidx;
    if (isctx) { T = 256; bidx = row0 >> 8; seq0 = bidx * 256; }
    else { T = 4096; bidx = (row0 - NCTX) >> 12; seq0 = NCTX + bidx * 4096; }
    const int t0 = row0 - seq0;
    __syncthreads();
#pragma unroll
    for (int k = 0; k < 9; k++) { const int rr = (tid >> 6) + 8 * k; if (rr < 67) xin[rr * 64 + cc] = bf2f(xr[k]); }
    if (it + G < 1536) xin_load(it + G);
    u16 sgr[8];
    if (pass2) {
#pragma unroll
      for (int tt = 0; tt < 8; tt++) sgr[tt] = p.P[(size_t)(row0 + tg * 8 + tt) * PP + C_GB + ch];
    }
    if (pass2) {
      const int d = (tid >> 6) & 1, part = tid >> 7;
      const int cfirst = seq0 >> 6, clast = (seq0 + T - 64) >> 6;
      const int K = d ? (clast - ci) : (ci - cfirst);
      float2 q[16];
#pragma unroll
      for (int k = 0; k < 16; k++) {
        const int kk = part * 16 + k;
        const int cj = d ? (clast - kk) : (cfirst + kk);
        const int cjc = cj < cfirst ? cfirst : (cj > clast ? clast : cj);
        const float2 qv = *(const float2*)(p.lruTot + ((size_t)(cjc * 2 + d) * 512 + n * 64 + cc) * 2);
        q[k] = (kk < K) ? qv : make_float2(1.f, 0.f);
      }
      float At = 1.f, Bt = 0.f;
#pragma unroll
      for (int k = 0; k < 16; k++) { Bt = q[k].x * Bt + q[k].y; At *= q[k].x; }
      parts[((part * 2 + d) * 64 + cc) * 2] = At; parts[((part * 2 + d) * 64 + cc) * 2 + 1] = Bt;
    }
    __syncthreads();
    for (int e = tid; e < 64 * 64; e += NT) {
      int t = e >> 6;
      float v = cbv;
#pragma unroll
      for (int j = 0; j < 4; j++) v += xin[(t + j) * 64 + cc] * cw[j];
      xb[e] = v;
      xbh[t * LROW + cc] = f2bf(v);
    }
    if (pass2 && tid < 128) {
      const int d = tid >> 6;
      float hcar = isctx ? 0.f : p.state_lru[((size_t)(bidx * 2 + l) * 2 + d) * 512 + n * 64 + cc];
#pragma unroll
      for (int part = 0; part < 4; part++) hcar = parts[((part * 2 + d) * 64 + cc) * 2] * hcar + parts[((part * 2 + d) * 64 + cc) * 2 + 1];
      carry[d * 64 + cc] = hcar;
    }
    __syncthreads();
    {
      bf16x8 af[4];
#pragma unroll
      for (int ks = 0; ks < 4; ks++) af[ks] = *(const bf16x8*)(xbh + (gth * 32 + r) * LROW + ks * 16 + h * 8);
      f32x16 ga, gi;
#pragma unroll
      for (int e = 0; e < 16; e++) { ga[e] = 0.f; gi[e] = 0.f; }
#pragma unroll
      for (int ks = 0; ks < 4; ks++) { ga = mfma32(af[ks], wfa[ks], ga); gi = mfma32(af[ks], wfx[ks], gi); }
      const int dch = gdh * 32 + r;
#pragma unroll
      for (int e = 0; e < 16; e++) {
        const int tok = gth * 32 + (e & 3) + 8 * (e >> 2) + 4 * h;
        float rg = sigmoidf_(ga[e] + g_ba), ig = sigmoidf_(gi[e] + g_bx);
        float log_a = -8.f * rg * g_sp;
        float a = __expf(log_a);
        const float x2 = 2.f * log_a;
        const float om = -x2 * (1.f + x2 * (0.5f + x2 * (0.16666667f + x2 * (0.041666668f + x2 * (0.0083333338f + x2 * (0.0013888889f + x2 * 0.0001984127f))))));
        float bb = __builtin_amdgcn_sqrtf(om) * ig * xb[tok * 64 + dch];
        ab[((gd * 2 + 0) * 64 + tok) * 64 + dch] = a;
        ab[((gd * 2 + 1) * 64 + tok) * 64 + dch] = bb;
      }
    }
    __syncthreads();
    float av[2][8], bv[2][8];
#pragma unroll
    for (int d = 0; d < 2; d++)
#pragma unroll
      for (int tt = 0; tt < 8; tt++) {
        av[d][tt] = ab[((d * 2 + 0) * 64 + tg * 8 + tt) * 64 + dout];
        bv[d][tt] = ab[((d * 2 + 1) * 64 + tg * 8 + tt) * 64 + dout];
      }
    float sA0 = 1.f, sB0 = 0.f, sA1 = 1.f, sB1 = 0.f;
#pragma unroll
    for (int tt = 0; tt < 8; tt++) { sB0 = av[0][tt] * sB0 + bv[0][tt]; sA0 *= av[0][tt]; }
#pragma unroll
    for (int tt = 7; tt >= 0; tt--) { sB1 = av[1][tt] * sB1 + bv[1][tt]; sA1 *= av[1][tt]; }
    comb[((tg * 2 + 0) * 64 + dout) * 2 + 0] = sA0; comb[((tg * 2 + 0) * 64 + dout) * 2 + 1] = sB0;
    comb[((tg * 2 + 1) * 64 + dout) * 2 + 0] = sA1; comb[((tg * 2 + 1) * 64 + dout) * 2 + 1] = sB1;
    __syncthreads();
    if (!pass2) {
      if (tid < 128) {
        int d = tid >> 6, c = tid & 63;
        float At = 1.f, Bt = 0.f;
#pragma unroll
        for (int s = 0; s < 8; s++) {
          int g = (d == 0) ? s : 7 - s;
          float a = comb[((g * 2 + d) * 64 + c) * 2], bq = comb[((g * 2 + d) * 64 + c) * 2 + 1];
          Bt = a * Bt + bq; At *= a;
        }
        float* o = p.lruTot + ((size_t)(ci * 2 + d) * 512 + n * 64 + c) * 2;
        o[0] = At; o[1] = Bt;
      }
      continue;
    }
    float h0 = carry[dout], h1 = carry[64 + dout];
    for (int g = 0; g < tg; g++) { h0 = comb[((g * 2 + 0) * 64 + dout) * 2] * h0 + comb[((g * 2 + 0) * 64 + dout) * 2 + 1]; }
    for (int g = 7; g > tg; g--) { h1 = comb[((g * 2 + 1) * 64 + dout) * 2] * h1 + comb[((g * 2 + 1) * 64 + dout) * 2 + 1]; }
    float y[8];
#pragma unroll
    for (int tt = 0; tt < 8; tt++) { h0 = av[0][tt] * h0 + bv[0][tt]; y[tt] = h0; }
    const float hf_last = h0;
#pragma unroll
    for (int tt = 7; tt >= 0; tt--) { h1 = av[1][tt] * h1 + bv[1][tt]; y[tt] += h1; }
    const float hb_first = h1;
    if (isctx) {
      if (t0 + 64 == T && tg == 7) p.out[O_ST + ((size_t)(bidx * 2 + l) * 2 + 0) * 512 + ch] = hf_last;
      if (t0 == 0 && tg == 0) p.out[O_ST + ((size_t)(bidx * 2 + l) * 2 + 1) * 512 + ch] = hb_first;
    }
#pragma unroll
    for (int tt = 0; tt < 8; tt++) {
      const int rw = row0 + tg * 8 + tt;
      p.GB[(size_t)NTOK * 512 + tm_off(rw, ch, 8)] = f2bf(y[tt] * bf2f(sgr[tt]));
    }
  }
}

__device__ __forceinline__ float compute_lam(const Params& p, int l, float lam_init) {
  float s1 = 0.f, s2 = 0.f;
  for (int i = 0; i < 64; i++) {
    s1 += p.lam_q1[l * 64 + i] * p.lam_k1[l * 64 + i];
    s2 += p.lam_q2[l * 64 + i] * p.lam_k2[l * 64 + i];
  }
  return expf(s1) - expf(s2) + lam_init;
}

__device__ __forceinline__ float mix_phase(const Params& p, int l, u16* smem, int vid) {
  unsigned long long tm0 = 0; float tres = 0.f; if (PROBE >= 30) tm0 = __builtin_amdgcn_s_memrealtime();
  const float lam_init = (l == 0) ? 0.2f : (0.8f - 0.6f * 0.74081822068f);
  const float lam = compute_lam(p, l, lam_init);
  constexpr int N_CL = 256, N_A = 384, N_CC = 128, N_L = 1536;
  const int G = gridDim.x;
  int start = vid;
  for (int it = start; it < N_CL; it += G) attnC_item(p, l, 128 + it, smem, lam, lam_init);
  if (PROBE == 35) tres = (float)(__builtin_amdgcn_s_memrealtime() - tm0) / 40000.f;
  start = (int)((vid + G - (N_CL % G)) % G);
  for (int it = start; it < N_A; it += G) attnA_item(p, l, it, smem);
  start = (int)((vid + G - ((N_CL + N_A) % G)) % G);
  for (int it = start; it < N_CC; it += G) attnC_item(p, l, it, smem, lam, lam_init);
  if (PROBE == 36) tres = (float)(__builtin_amdgcn_s_memrealtime() - tm0) / 40000.f;
  start = (int)((vid + G - ((N_CL + N_A + N_CC) % G)) % G);
  if (PROBE == 6) lru_run(p, l, false, start, G, (float*)smem);
  lru_run(p, l, false, start, G, (float*)smem);
  return tres;
}

__device__ __forceinline__ void lru2_phase(const Params& p, int l, u16* smem) {
  lru_run(p, l, true, blockIdx.x, gridDim.x, (float*)smem);
}

#define XB_TMO      128
#define XB_XCNT(j)  (256  + 64 * (j))
#define XB_XSUB(j)  (1280 + 64 * (j))
#define XB_XGEN(j)  (2304 + 64 * (j))
#define XB_TOP      3328
#define XB_TOPGEN   3392
#define XCD_BAR_WORDS 3456
#define XB_SPIN_CAP (1u << 18)
__device__ __forceinline__ unsigned xb_ld(unsigned* p)              { return __hip_atomic_load(p, __ATOMIC_RELAXED, __HIP_MEMORY_SCOPE_AGENT); }
__device__ __forceinline__ unsigned xb_add(unsigned* p, unsigned v) { return __hip_atomic_fetch_add(p, v, __ATOMIC_RELAXED, __HIP_MEMORY_SCOPE_AGENT); }
__device__ __forceinline__ unsigned xb_xcc_id() { return (unsigned)__builtin_amdgcn_s_getreg((3 << 11) | 20) & 0xFu; }
#define XB_SPIN(cond, bar) do { unsigned _sp = 0; while (cond) { __builtin_amdgcn_s_sleep(1); \
    if ((++_sp & 255u) == 0u) { if (xb_ld(&(bar)[XB_TMO])) break; if (_sp > XB_SPIN_CAP) { atomicAdd(&(bar)[XB_TMO], 1u); break; } } } } while (0)
struct XcdBarrier { unsigned* bar; unsigned x; volatile LAS unsigned* st; };
__device__ __forceinline__ XcdBarrier xcd_barrier_post(unsigned* bar, volatile LAS unsigned* st) {
  XcdBarrier b; b.bar = bar; b.x = xb_xcc_id(); b.st = st;
  if (threadIdx.x == 0) st[2] = xb_add(&bar[XB_XCNT(b.x)], 1u);
  return b;
}
__device__ __forceinline__ int xcd_virtual_id(const XcdBarrier& b) {
  if (threadIdx.x == 0) {
    unsigned pre = 0;
#pragma unroll
    for (unsigned j = 0; j < 16; ++j) { const unsigned c = xb_ld(&b.bar[XB_XCNT(j)]); pre += (j < b.x) ? c : 0u; }
    b.st[3] = pre + b.st[2];
  }
  __syncthreads();
  const int v = (int)b.st[3];
  __syncthreads();
  return __builtin_amdgcn_readfirstlane(v);
}
__device__ __forceinline__ void xcd_barrier_complete(unsigned* bar, unsigned x, unsigned& nloc, unsigned& nx) {
  const unsigned G = gridDim.x * gridDim.y * gridDim.z;
  unsigned sum, cnt, mine, sp = 0u;
  for (;;) {
    sum = 0u; cnt = 0u; mine = 0u;
#pragma unroll
    for (unsigned j = 0; j < 16; ++j) { const unsigned c = xb_ld(&bar[XB_XCNT(j)]); sum += c; cnt += (c > 0u) ? 1u : 0u; mine = (j == x) ? c : mine; }
    if (sum == G) break;
    __builtin_amdgcn_s_sleep(1);
    if ((++sp & 255u) == 0u) { if (xb_ld(&bar[XB_TMO])) break; if (sp > XB_SPIN_CAP) { atomicAdd(&bar[XB_TMO], 1u); break; } }
  }
  nloc = mine > 0u ? mine : 1u; nx = cnt > 0u ? cnt : 1u;
}
__device__ __forceinline__ void xcd_barrier(const XcdBarrier& b) {
  asm volatile("s_waitcnt vmcnt(0)" ::: "memory");
  __syncthreads();
  if (threadIdx.x == 0) {
    unsigned* bar = b.bar;
    __builtin_amdgcn_s_waitcnt(0);
    unsigned nloc = b.st[0], nx = b.st[1];
    if (nloc == 0u) { xcd_barrier_complete(bar, b.x, nloc, nx); b.st[0] = nloc; b.st[1] = nx; }
    const unsigned old = xb_add(&bar[XB_XSUB(b.x)], 1u);
    const unsigned gen = old / nloc;
    if (old + 1u == (gen + 1u) * nloc) {
      __builtin_amdgcn_fence(__ATOMIC_RELEASE, "agent");
      asm volatile("s_waitcnt vmcnt(0)" ::: "memory");
      const unsigned og = xb_add(&bar[XB_TOP], 1u);
      const unsigned tg = og / nx;
      if (og + 1u == (tg + 1u) * nx) xb_add(&bar[XB_TOPGEN], 1u);
      else XB_SPIN(xb_ld(&bar[XB_TOPGEN]) == tg, bar);
      __builtin_amdgcn_fence(__ATOMIC_ACQUIRE, "agent");
      xb_add(&bar[XB_XGEN(b.x)], 1u);
      asm volatile("s_waitcnt vmcnt(0)" ::: "memory");
    } else {
      XB_SPIN(xb_ld(&bar[XB_XGEN(b.x)]) == gen, bar);
      __builtin_amdgcn_fence(__ATOMIC_ACQUIRE, "agent");
      asm volatile("s_waitcnt vmcnt(0)" ::: "memory");
    }
  }
  __syncthreads();
}

typedef __attribute__((address_space(4))) const Params CParams;
__device__ __forceinline__ const Params& get_params() {
  CParams* kp = (CParams*)__builtin_amdgcn_kernarg_segment_ptr();
  asm volatile("" : "+s"(kp));
  return *(const Params*)kp;
}
__global__ void __launch_bounds__(NT, 2) fwd_kernel(Params p_unused) {
  extern __shared__ __attribute__((aligned(16))) unsigned char lds_raw[];
  u16* smem = (u16*)lds_raw;
  LAS unsigned char* lds = (LAS unsigned char*)lds_raw;
  cg::grid_group grid = cg::this_grid();
  volatile LAS unsigned* xst = (volatile LAS unsigned*)(lds + STAGE_BYTES + SPARE_BYTES);
  if (threadIdx.x == 0) { xst[0] = 0u; xst[1] = 0u; }
  __syncthreads();
  XcdBarrier xb = xcd_barrier_post(get_params().bar, xst);
  float tfrac = 0.f;
  unsigned long long tq0 = 0; if (PROBE >= 30) tq0 = __builtin_amdgcn_s_memrealtime();
  prologue_phase(get_params(), (float*)smem);
  if (PROBE == 30) tfrac = (float)(__builtin_amdgcn_s_memrealtime() - tq0) / 40000.f;
  if (get_params().bar == nullptr) grid.sync();
  xcd_barrier(xb);
  if (PROBE == 31) tfrac = (float)(__builtin_amdgcn_s_memrealtime() - tq0) / 40000.f;
  const int vid = xcd_virtual_id(xb);
  { LAS float* rl = (LAS float*)(lds + ROPE_OFF); const float* rg = get_params().rope;
    for (int i = threadIdx.x; i < 2048; i += NT) rl[i] = rg[i];
    __syncthreads(); }
  if (PROBE == 9) { for (int i = 0; i < 10; i++) xcd_barrier(xb); }
#pragma unroll 1
  for (int l = 0; l < 2; l++) {
    if (PROBE >= 30) tq0 = __builtin_amdgcn_s_memrealtime();
    norm_phase(get_params(), l);
    if (PROBE == 32 && l == 0) tfrac = (float)(__builtin_amdgcn_s_memrealtime() - tq0) / 40000.f;
    if (PROBE == 3) { norm_phase(get_params(), l); if (l == 0) { xcd_barrier(xb); prologue_phase(get_params(), (float*)smem); } }
    xcd_barrier(xb);
    {
      const Params& p = get_params();
      SchedStd S; S.nM = NTOK / 256; S.nN = INC / 256; S.nwg = S.nM * S.nN; S.G = gridDim.x; S.c = vid;
      S.A = (const char*)p.H; S.B = (const char*)(p.Wt_in + (size_t)l * INC * 1024); S.tA = (size_t)256 * 1024 * 2; S.tB = (size_t)256 * 1024 * 2;
      EpiInproj E; E.pp = &p; E.l = l; E.part = (LAS float*)(lds + STAGE_BYTES); E.ropeL = (const LAS float*)(lds + ROPE_OFF);
      { float tr = gemm_phase(lds, 1024, S, E, PROBE == 22); if (l == 0 && (PROBE == 21 || PROBE == 22)) tfrac = tr; }
      if (PROBE == 1) { __syncthreads(); gemm_phase(lds, 1024, S, E); }
    }
    xcd_barrier(xb);
    if (PROBE >= 30) tq0 = __builtin_amdgcn_s_memrealtime();
    { float tr = mix_phase(get_params(), l, smem, vid); if ((PROBE == 35 || PROBE == 36) && l == 0) tfrac = tr; }
    if (PROBE == 33 && l == 0) tfrac = (float)(__builtin_amdgcn_s_memrealtime() - tq0) / 40000.f;
    xcd_barrier(xb);
    if (PROBE >= 30) tq0 = __builtin_amdgcn_s_memrealtime();
    lru2_phase(get_params(), l, smem);
    if (PROBE == 34 && l == 0) tfrac = (float)(__builtin_amdgcn_s_memrealtime() - tq0) / 40000.f;
    xcd_barrier(xb);
    {
      const Params& p = get_params();
      SchedBranch S; S.G = gridDim.x; S.c = vid; S.P_ = (const char*)p.GB; S.W_ = (const char*)(p.Wt_br + (size_t)l * 3 * 1024 * 512);
      EpiBranch E; E.pp = &p;
      { float tr = gemm_phase(lds, 512, S, E, PROBE == 24); if (l == 0 && (PROBE == 23 || PROBE == 24)) tfrac = tr; }
      if (PROBE == 2) { __syncthreads(); gemm_phase(lds, 512, S, E); }
    }
    xcd_barrier(xb);
    {
      const Params& p = get_params();
      SchedStd S; S.nM = NTOK / 256; S.nN = 4; S.nwg = S.nM * S.nN; S.G = gridDim.x; S.c = vid;
      S.A = (const char*)p.Y; S.B = (const char*)(p.Wt_out + (size_t)l * 1024 * 1024); S.tA = (size_t)256 * 1024 * 2; S.tB = (size_t)256 * 1024 * 2;
      EpiOut E; E.pp = &p; E.l = l;
      { float tr = gemm_phase(lds, 1024, S, E, PROBE == 26); if (l == 0 && (PROBE == 25 || PROBE == 26)) tfrac = tr; }
      if (PROBE == 8 && l == 0) { __syncthreads(); gemm_phase(lds, 1024, S, E); }
    }
    if (l == 0) xcd_barrier(xb);
  }
  if (PROBE >= 20) {
    xcd_barrier(xb);
    if (blockIdx.x == 0 && threadIdx.x == 0) { float* o = get_params().out + O_X + 4194304; *o += 0.42f + 0.45f * fminf(fmaxf(tfrac, 0.f), 1.f); }
  }
}

extern "C" void kernel_launch(void* const* d_in, const int* in_sizes, int n_in, void* d_out, int out_size, void* d_ws,
                              size_t ws_size, hipStream_t stream) {
  Params p{};
  const float** ip = (const float**)&p;
  for (int i = 0; i < 34; i++) ip[i] = (const float*)d_in[i];
  p.out = (float*)d_out;
  char* w = (char*)d_ws; size_t off = 0;
  auto take = [&](size_t bytes) { char* q = w + off; off += (bytes + 255) & ~(size_t)255; return q; };
  p.Wt_in = (u16*)take((size_t)2 * INC * 1024 * 2);
  p.Wt_br = (u16*)take((size_t)6 * 1024 * 512 * 2);
  p.Wt_out = (u16*)take((size_t)2 * 1024 * 1024 * 2);
  p.Y = (u16*)take((size_t)NTOK * 1024 * 2);
  p.P = (u16*)take((size_t)NTOK * PP * 2);
  p.VtA_ctx = p.Y;
  p.VtA_lat = p.VtA_ctx + (size_t)16 * 2 * 64 * 256;
  p.VtC_ctx = p.VtA_lat + (size_t)2 * 2 * 64 * 4096;
  p.VtC_lat = p.VtC_ctx + (size_t)16 * 4 * 128 * 256;
  p.cKa = (u16*)take((size_t)2 * 2 * 512 * 128 * 2);
  p.cVtA = (u16*)take((size_t)2 * 2 * 512 * 128 * 2);
  p.cKc = (u16*)take((size_t)2 * 2 * 512 * 512 * 2);
  p.cVtC = (u16*)take((size_t)2 * 2 * 512 * 512 * 2);
  p.mod = (float*)take((size_t)2 * 3 * 3072 * 4);
  p.rope = (float*)take((size_t)2048 * 4);
  p.lruTot = (float*)take((size_t)192 * 2 * 512 * 2 * 4);
  p.Wt_lru = (u16*)take((size_t)2 * 2 * 8 * 2 * 64 * 64 * 2);
  p.bar = (unsigned*)take((size_t)XCD_BAR_WORDS * 4);
  p.GB = (u16*)take((size_t)3 * NTOK * 512 * 2);
  p.H = p.GB;
  p.MG = (unsigned*)take((size_t)(48 * 4 * 3 + 1) * 16384 * 4);
  static int grid_blocks = 0;
  if (!grid_blocks) {
    int dev = 0, cus = 0;
    hipGetDevice(&dev);
    hipDeviceGetAttribute(&cus, hipDeviceAttributeMultiprocessorCount, dev);
    hipFuncSetAttribute((const void*)fwd_kernel, hipFuncAttributeMaxDynamicSharedMemorySize, LDS_BYTES);
    int per_cu = 0;
    hipOccupancyMaxActiveBlocksPerMultiprocessor(&per_cu, (const void*)fwd_kernel, NT, LDS_BYTES);
    (void)hipGetLastError();
    grid_blocks = cus;
  }
  hipMemsetAsync(p.bar, 0, (size_t)XCD_BAR_WORDS * 4, stream);
  void* args[] = {&p};
  hipLaunchCooperativeKernel((void*)fwd_kernel, dim3(grid_blocks), dim3(NT), args, LDS_BYTES, stream);
}
```

```cpp
#include <hip/hip_runtime.h>
#include <hip/hip_cooperative_groups.h>
#include <stdint.h>
#include <math.h>
namespace cg = cooperative_groups;

typedef unsigned short u16;
typedef __attribute__((ext_vector_type(8))) short bf16x8;
typedef __attribute__((ext_vector_type(4))) short bf16x4;
typedef __attribute__((ext_vector_type(16))) float f32x16;
typedef __attribute__((ext_vector_type(4))) float f32x4;
#define LAS __attribute__((address_space(3)))

#ifndef PROBE
#define PROBE 0
#endif
#define NT 512
constexpr int NTOK = 12288, NCTX = 4096;
constexpr int INC = 7424;
constexpr int PP = 3712;
constexpr int C_QA = 0, C_KA = 512, C_GA = 640, C_XB = 1152, C_GB = 1664, C_QC = 2176, C_KC = 2688, C_GC = 3200;
constexpr int LROW = 72;
constexpr int VROW = 68;
constexpr float EPS = 1e-6f;
constexpr int STAGE_BYTES = 131072;
constexpr int SPARE_BYTES = 8192;
constexpr int ROPE_OFF = STAGE_BYTES + SPARE_BYTES + 16;
constexpr int LDS_BYTES = ROPE_OFF + 8192;

constexpr size_t O_X = 0, O_KA = 12582912, O_VA = 13631488, O_KC = 14680064, O_VC = 18874368, O_ST = 23068672;

struct Params {
  const float *x_prompt, *x_sample, *cache_a_k, *cache_a_v, *cache_c_k, *cache_c_v, *state_lru, *c, *c_ctx,
      *norm_g, *mod_w, *mod_b, *w_in, *qn_a, *kn_a, *sink_a, *conv_w, *conv_b, *lru_wa, *lru_ba, *lru_wx, *lru_bx,
      *lru_lam, *qn_c, *kn_c, *lam_q1, *lam_k1, *lam_q2, *lam_k2, *subln_c, *w_br_a, *w_br_b, *w_br_c, *w_out;
  float* out;
  u16 *Wt_in, *Wt_br, *Wt_out, *H, *P, *VtA_ctx, *VtA_lat, *VtC_ctx, *VtC_lat, *cKa, *cVtA, *cKc, *cVtC;
  float *mod, *rope, *lruTot;
  u16 *Wt_lru;
  unsigned* bar;
  u16* Y;
  u16* GB;
  unsigned* MG;
};

__device__ __forceinline__ int tid_opaque() { int t = (int)threadIdx.x; asm volatile("" : "+v"(t)); return t; }
#define TIDX tid_opaque()
__device__ __forceinline__ u16 f2bf(float f) {
  uint32_t r; asm("v_cvt_pk_bf16_f32 %0, %1, %1" : "=v"(r) : "v"(f)); return (u16)(r & 0xffffu);
}
__device__ __forceinline__ float bf2f(u16 h) { return __uint_as_float(((uint32_t)h) << 16); }
__device__ __forceinline__ uint32_t pack2(float a, float b) { uint32_t r; asm("v_cvt_pk_bf16_f32 %0, %1, %2" : "=v"(r) : "v"(a), "v"(b)); return r; }
__device__ __forceinline__ float sigmoidf_(float x) { return __builtin_amdgcn_rcpf(1.f + __expf(-x)); }
__device__ __forceinline__ float siluf_(float x) { return x * __builtin_amdgcn_rcpf(1.f + __expf(-x)); }
__device__ __forceinline__ f32x16 mfma32(bf16x8 a, bf16x8 b, f32x16 c) {
  return __builtin_amdgcn_mfma_f32_32x32x16_bf16(a, b, c, 0, 0, 0);
}
__device__ __forceinline__ float shflx(float v, int mask, int lane) {
  return __builtin_bit_cast(float, __builtin_amdgcn_ds_bpermute((lane ^ mask) << 2, __builtin_bit_cast(int, v)));
}
__device__ __forceinline__ float lo_bf(uint32_t w) { return __uint_as_float(w << 16); }
__device__ __forceinline__ float hi_bf(uint32_t w) { return __uint_as_float(w & 0xffff0000u); }

__device__ __forceinline__ size_t tm_off(int r, int k, int KT) {
  return ((size_t)((r >> 8) * KT + (k >> 6)) * 256 + (r & 255)) * 64 + (k & 63);
}
__device__ __forceinline__ void transpose_tile(const float* __restrict__ src, int spitch, u16* __restrict__ dst, int dpitch,
                               int r0, int c0, float* sm, int KT = 0) {
  const int tid = TIDX;
#pragma unroll
  for (int i = 0; i < 2; i++) {
    int c = tid + i * NT; int r = c >> 4, q = c & 15;
    float4 v = *(const float4*)(src + (size_t)(r0 + r) * spitch + c0 + q * 4);
    float* d = sm + r * 65 + q * 4;
    d[0] = v.x; d[1] = v.y; d[2] = v.z; d[3] = v.w;
  }
  __syncthreads();
  {
    int c = tid; int cc = c >> 3, q = c & 7;
    uint32_t w[4];
#pragma unroll
    for (int j = 0; j < 4; j++) w[j] = pack2(sm[(q * 8 + 2 * j) * 65 + cc], sm[(q * 8 + 2 * j + 1) * 65 + cc]);
    uint4 v; v.x = w[0]; v.y = w[1]; v.z = w[2]; v.w = w[3];
    if (KT) *(uint4*)(dst + tm_off(c0 + cc, r0 + q * 8, KT)) = v;
    else *(uint4*)(dst + (size_t)(c0 + cc) * dpitch + r0 + q * 8) = v;
  }
  __syncthreads();
}

__device__ __forceinline__ void transpose_wide(const float* __restrict__ src, int spitch, u16* __restrict__ dst,
                                               int k0, int n0, float* sm, int KT) {
  const int tid = TIDX;
  float4 v[8];
#pragma unroll
  for (int i = 0; i < 8; i++) { int c = tid + i * NT; int r = c >> 6, q = c & 63; v[i] = *(const float4*)(src + (size_t)(k0 + r) * spitch + n0 + q * 4); }
#pragma unroll
  for (int i = 0; i < 8; i++) { int c = tid + i * NT; int r = c >> 6, q = c & 63; float* d = sm + r * 257 + q * 4; d[0] = v[i].x; d[1] = v[i].y; d[2] = v[i].z; d[3] = v[i].w; }
  __syncthreads();
#pragma unroll
  for (int i = 0; i < 4; i++) {
    int c = tid + i * NT; int nn = c >> 3, q = c & 7;
    uint4 o;
    o.x = pack2(sm[(q * 8 + 0) * 257 + nn], sm[(q * 8 + 1) * 257 + nn]);
    o.y = pack2(sm[(q * 8 + 2) * 257 + nn], sm[(q * 8 + 3) * 257 + nn]);
    o.z = pack2(sm[(q * 8 + 4) * 257 + nn], sm[(q * 8 + 5) * 257 + nn]);
    o.w = pack2(sm[(q * 8 + 6) * 257 + nn], sm[(q * 8 + 7) * 257 + nn]);
    *(uint4*)(dst + tm_off(n0 + nn, k0 + q * 8, KT)) = o;
  }
  __syncthreads();
}

__device__ __forceinline__ void mod_item(const Params& p, int it, float* sm) {
  const int tid = TIDX;
  const int l = it / 48, n0 = (it % 48) * 64;
  float* sv = sm;
  float* red = sm + 3072;
  for (int e = tid; e < 3072; e += NT) {
    int v = e >> 10, k = e & 1023;
    float x = (v == 0) ? p.c_ctx[k] : p.c[(v - 1) * 1024 + k];
    sv[e] = siluf_(x);
  }
  __syncthreads();
  const int col = tid & 63, kg = tid >> 6;
  const float* w = p.mod_w + (size_t)l * 1024 * 3072 + n0 + col;
  float a0 = 0, a1 = 0, a2 = 0;
#pragma unroll 1
  for (int kb = kg * 128; kb < kg * 128 + 128; kb += 32) {
    float wv[32];
#pragma unroll
    for (int j = 0; j < 32; j++) wv[j] = w[(size_t)(kb + j) * 3072];
#pragma unroll
    for (int j = 0; j < 32; j++) { a0 += sv[kb + j] * wv[j]; a1 += sv[1024 + kb + j] * wv[j]; a2 += sv[2048 + kb + j] * wv[j]; }
  }
  red[(kg * 3 + 0) * 64 + col] = a0; red[(kg * 3 + 1) * 64 + col] = a1; red[(kg * 3 + 2) * 64 + col] = a2;
  __syncthreads();
  if (tid < 192) {
    int v = tid >> 6, c = tid & 63;
    float s = p.mod_b[l * 3072 + n0 + c];
#pragma unroll
    for (int g = 0; g < 8; g++) s += red[(g * 3 + v) * 64 + c];
    p.mod[(l * 3 + v) * 3072 + n0 + c] = s;
  }
  __syncthreads();
}

__device__ __forceinline__ void prologue_phase(const Params& p, float* sm) {
  constexpr int N_MOD = 96, N_ROPE = 1, N_WIN = 2 * 16 * 29, N_WBR = 6 * 8 * 4, N_WOUT = 2 * 16 * 4;
  constexpr int N_CK = 64 + 256, N_CVA = 4 * 16, N_CVC = 4 * 64, N_LW = 64;
  constexpr int E0 = N_MOD, E1 = E0 + N_ROPE, E2 = E1 + N_WIN, E3 = E2 + N_WBR, E4 = E3 + N_WOUT, E5 = E4 + N_CK,
                E6 = E5 + N_CVA, E7 = E6 + N_CVC, E8 = E7 + N_LW;
  const int tid = TIDX;
  for (int it = blockIdx.x; it < E8; it += gridDim.x) {
    if (it < E0) {
      mod_item(p, it, sm);
    } else if (it < E1) {
      for (int e = tid; e < 1024; e += NT) {
        int pos = e >> 4, f = e & 15;
        float inv = powf(10000.f, -(float)f / 16.f);
        float ang = (float)pos * inv;
        p.rope[e] = cosf(ang); p.rope[1024 + e] = sinf(ang);
      }
    } else if (it < E2) {
      int j = it - E1; int l = j / (16 * 29); int r = j % (16 * 29);
      int kt = r / 29, pn = r % 29;
      transpose_wide(p.w_in + (size_t)l * 1024 * INC, INC, p.Wt_in + (size_t)l * INC * 1024, kt * 64, pn * 256, sm, 16);
    } else if (it < E3) {
      int j = it - E2; int m = j / 32; int r = j % 32;
      int l = m / 3, i = m % 3;
      const float* src = (i == 0 ? p.w_br_a : (i == 1 ? p.w_br_b : p.w_br_c)) + (size_t)l * 512 * 1024;
      int kt = r / 4, pn = r % 4;
      transpose_wide(src, 1024, p.Wt_br + (size_t)m * 1024 * 512, kt * 64, pn * 256, sm, 8);
    } else if (it < E4) {
      int j = it - E3; int l = j / 64; int r = j % 64;
      int kt = r / 4, pn = r % 4;
      transpose_wide(p.w_out + (size_t)l * 1024 * 1024, 1024, p.Wt_out + (size_t)l * 1024 * 1024, kt * 64, pn * 256, sm, 16);
    } else if (it < E5) {
      int j = it - E4;
      const float* src; u16* dst; size_t off;
      if (j < 64) { src = p.cache_a_k; dst = p.cKa; off = (size_t)j * 4096; }
      else { src = p.cache_c_k; dst = p.cKc; off = (size_t)(j - 64) * 4096; }
      size_t e = off + (size_t)tid * 8;
      float4 a = *(const float4*)(src + e), b = *(const float4*)(src + e + 4);
      uint4 v; v.x = pack2(a.x, a.y); v.y = pack2(a.z, a.w); v.z = pack2(b.x, b.y); v.w = pack2(b.z, b.w);
      *(uint4*)(dst + e) = v;
    } else if (it < E6) {
      int j = it - E5; int bl = j / 16; int r = j % 16;
      int rt = r / 2, ct = r % 2;
      transpose_tile(p.cache_a_v + (size_t)bl * 512 * 128, 128, p.cVtA + (size_t)bl * 128 * 512, 512, rt * 64, ct * 64, sm);
    } else if (it < E7) {
      int j = it - E6; int bl = j / 64; int r = j % 64;
      int rt = r / 8, ct = r % 8;
      transpose_tile(p.cache_c_v + (size_t)bl * 512 * 512, 512, p.cVtC + (size_t)bl * 512 * 512, 512, rt * 64, ct * 64, sm);
    } else {
      int j = it - E7; int ldn = j >> 1, g = j & 1;
      transpose_tile((g ? p.lru_wx : p.lru_wa) + (size_t)ldn * 4096, 64, p.Wt_lru + (size_t)(ldn * 2 + g) * 4096, 64, 0, 0, sm);
    }
  }
}

__device__ __forceinline__ void norm_phase(const Params& p, int l) {
  const int tid = TIDX, lane = tid & 63, wid = tid >> 6;
  const float* g = p.norm_g + l * 1024;
  for (int it = blockIdx.x; it < NTOK / 8; it += gridDim.x) {
    int row = it * 8 + wid;
    const float* x;
    if (l == 0) x = (row < NCTX) ? p.x_prompt + (size_t)row * 1024 : p.x_sample + (size_t)(row - NCTX) * 1024;
    else x = p.out + O_X + (size_t)row * 1024;
    int v = (row < NCTX) ? 0 : 1 + (row - NCTX) / 4096;
    const float* md = p.mod + (l * 3 + v) * 3072;
    float4 xv[4], gv[4], sh[4], sc[4]; float ss = 0;
#pragma unroll
    for (int i = 0; i < 4; i++) {
      const int c = i * 256 + lane * 4;
      xv[i] = *(const float4*)(x + c);
      gv[i] = *(const float4*)(g + c); sh[i] = *(const float4*)(md + c); sc[i] = *(const float4*)(md + 1024 + c);
    }
    __builtin_amdgcn_sched_barrier(0);
#pragma unroll
    for (int i = 0; i < 4; i++) ss += xv[i].x * xv[i].x + xv[i].y * xv[i].y + xv[i].z * xv[i].z + xv[i].w * xv[i].w;
#pragma unroll
    for (int o = 32; o > 0; o >>= 1) ss += shflx(ss, o, lane);
    float rinv = rsqrtf(ss * (1.f / 1024.f) + EPS);
#pragma unroll
    for (int i = 0; i < 4; i++) {
      int c = i * 256 + lane * 4;
      float h0 = xv[i].x * rinv * gv[i].x * (1.f + sc[i].x) + sh[i].x;
      float h1 = xv[i].y * rinv * gv[i].y * (1.f + sc[i].y) + sh[i].y;
      float h2 = xv[i].z * rinv * gv[i].z * (1.f + sc[i].z) + sh[i].z;
      float h3 = xv[i].w * rinv * gv[i].w * (1.f + sc[i].w) + sh[i].w;
      uint2 o2; o2.x = pack2(h0, h1); o2.y = pack2(h2, h3);
      *(uint2*)(p.H + tm_off(row, c, 16)) = o2;
    }
  }
}

constexpr int G_BK = 64, G_HALF = 128, G_HTB = G_HALF * G_BK * 2;
__device__ __forceinline__ int lds_byte(int r, int c) {
  const int st = (r >> 4) * 2 + (c >> 5), rr = r & 15, cc = c & 31, ob = rr * 64 + cc * 2;
  return st * 1024 + (ob ^ (((ob >> 9) & 1) << 5));
}
__device__ __forceinline__ void stage_rc(int b, int& R, int& C) {
  const int st = b / 1024, sb = b % 1024, swz = sb ^ (((sb >> 9) & 1) << 5);
  R = (st >> 1) * 16 + swz / 64; C = (st & 1) * 32 + (swz % 64) / 2;
}
struct Unit { int pm, pn, seg; };

struct SchedStd {
  int nM, nN, nwg, G, c; const char* A; const char* B; size_t tA, tB;
  __device__ __forceinline__ bool next(int i, Unit& u) const {
    const long L = (long)i * G + c; if (L >= nwg) return false;
    const int wgid = (int)L;
    const int nig = 8 * nN, gid = wgid / nig, fm = gid * 8, gsz = (nM - fm) < 8 ? (nM - fm) : 8;
    u.pm = fm + ((wgid % nig) % gsz); u.pn = (wgid % nig) / gsz; u.seg = 0; return true;
  }
  __device__ __forceinline__ const char* aptr(const Unit& u) const { return A + (size_t)u.pm * tA; }
  __device__ __forceinline__ const char* bptr(const Unit& u) const { return B + (size_t)u.pn * tB; }
};
struct SchedBranch {
  int G, c; const char* P_; const char* W_;
  __device__ __forceinline__ bool next(int i, Unit& u) const {
    if (G == 256) {
      if (i >= 3) return false;
      const int xcd = c >> 5, j = c & 31;
      if (j >= 24) return false;
      u.seg = i; u.pm = xcd * 6 + (j >> 2); u.pn = j & 3; return true;
    }
    const int tile = (i / 3) * G + c; if (tile >= 192) return false;
    u.seg = i % 3; u.pm = tile >> 2; u.pn = tile & 3; return true;
  }
  __device__ __forceinline__ const char* aptr(const Unit& u) const { return P_ + (size_t)((u.seg * 48 + u.pm) * 8) * 32768; }
  __device__ __forceinline__ const char* bptr(const Unit& u) const { return W_ + (size_t)((u.seg * 4 + u.pn) * 8) * 32768; }
};

template <class Epi, class Sched>
__device__ __forceinline__ float gemm_phase(LAS unsigned char* lds, const int K, const Sched& S, const Epi& E, int tmode = 0) {
  unsigned long long t_ph0 = 0, t_epi = 0; if (PROBE >= 20) t_ph0 = __builtin_amdgcn_s_memrealtime();
  const int tid = TIDX, wid = __builtin_amdgcn_readfirstlane(tid >> 6), lane = tid & 63, wr = wid >> 2, wc = wid & 3, fr = lane & 15, fq = lane >> 4;
  const int nt = K / G_BK;
  unsigned voffA[2], voffB[2];
#pragma unroll
  for (int i = 0; i < 2; ++i) { int R, C; stage_rc(tid * 16 + i * 8192, R, C);
    voffA[i] = (unsigned)(R * 64 + C) * 2u; voffB[i] = voffA[i]; }
  const size_t kstep = (size_t)32768;
  const size_t hA = (size_t)16384, hB = (size_t)16384;
  const unsigned ldsw = (unsigned)wid * 1024u;
  const int aoff = lds_byte(wr * 64 + fr, fq * 8), boff = lds_byte(wc * 32 + fr, fq * 8);
#define G_SA(b, h) (((b) * 2 + (h)) * G_HTB)
#define G_SB(b, h) ((4 + (b) * 2 + (h)) * G_HTB)
#define G_STAGE(bufoff, gbase, voff) do { _Pragma("unroll") for (int _i = 0; _i < 2; ++_i) \
    __builtin_amdgcn_global_load_lds((const unsigned*)((const char*)(gbase) + (voff)[_i]), (LAS unsigned*)(lds + (bufoff) + ldsw + _i * 8192), 16, 0, 0); } while (0)
#define G_LDA(dst, b, h) do { _Pragma("unroll") for (int m = 0; m < 4; ++m) _Pragma("unroll") for (int k = 0; k < 2; ++k) dst[m][k] = *(const LAS bf16x8*)(lds + G_SA(b, h) + aoff + m * 2048 + k * 1024); } while (0)
#define G_LDB(dst, b, h) do { _Pragma("unroll") for (int n = 0; n < 2; ++n) _Pragma("unroll") for (int k = 0; k < 2; ++k) dst[n][k] = *(const LAS bf16x8*)(lds + G_SB(b, h) + boff + n * 2048 + k * 1024); } while (0)
#define G_MMA(ai, bj, At, Bt) do { __builtin_amdgcn_s_setprio(1); _Pragma("unroll") for (int m = 0; m < 4; ++m) _Pragma("unroll") for (int n = 0; n < 2; ++n) _Pragma("unroll") for (int k = 0; k < 2; ++k) \
    acc[ai][bj][m][n] = __builtin_amdgcn_mfma_f32_16x16x32_bf16(Bt[n][k], At[m][k], acc[ai][bj][m][n], 0, 0, 0); __builtin_amdgcn_s_setprio(0); } while (0)
#define G_WAIT_V(n) asm volatile("s_waitcnt vmcnt(" #n ")" ::: "memory")
#define G_WAIT_L(n) asm volatile("s_waitcnt lgkmcnt(" #n ")" ::: "memory")
#define G_BAR __builtin_amdgcn_s_barrier()
#define G_SCHED __builtin_amdgcn_sched_barrier(0)
  Unit cur, nxt; int ui = 0;
  if (!S.next(0, cur)) return 0.f;
  f32x4 acc[2][2][4][2];
#pragma unroll
  for (int a = 0; a < 2; ++a)
#pragma unroll
    for (int b = 0; b < 2; ++b)
#pragma unroll
      for (int m = 0; m < 4; ++m)
#pragma unroll
        for (int n = 0; n < 2; ++n) acc[a][b][m][n] = (f32x4){0.f, 0.f, 0.f, 0.f};
  bf16x8 At[4][2], B0[2][2], B1[2][2];
  const char* cA = S.aptr(cur); const char* cB = S.bptr(cur);
  G_STAGE(G_SB(0, 0), cB, voffB); G_STAGE(G_SA(0, 0), cA, voffA); G_STAGE(G_SB(0, 1), cB + hB, voffB); G_STAGE(G_SA(0, 1), cA + hA, voffA);
  if (wr == 1) G_BAR;
  G_WAIT_V(4); G_BAR;
  G_STAGE(G_SB(1, 0), cB + kstep, voffB); G_STAGE(G_SA(1, 0), cA + kstep, voffA); G_STAGE(G_SB(1, 1), cB + hB + kstep, voffB);
  G_WAIT_V(6); G_BAR;
  for (;;) {
    const bool has_next = S.next(ui + 1, nxt);
    const char* nA = has_next ? S.aptr(nxt) : cA; const char* nB = has_next ? S.bptr(nxt) : cB;
    for (int t = 0; t < nt; t += 2) {
      const bool last = (t == nt - 2);
      const char* a1 = cA + (size_t)(t + 1) * kstep;
      const char* a2 = last ? nA : cA + (size_t)(t + 2) * kstep; const char* b2 = last ? nB : cB + (size_t)(t + 2) * kstep;
      const char* a3 = a2 + kstep; const char* b3 = b2 + kstep;
      G_LDB(B0, 0, 0); G_SCHED; G_LDA(At, 0, 0); G_STAGE(G_SA(1, 1), a1 + hA, voffA);
      G_WAIT_L(8); G_BAR; G_WAIT_L(0); G_MMA(0, 0, At, B0); G_BAR; G_SCHED;
      G_LDB(B1, 0, 1); G_STAGE(G_SB(0, 0), b2, voffB);
      G_BAR; G_WAIT_L(0); G_MMA(0, 1, At, B1); G_BAR;
      G_LDA(At, 0, 1); G_STAGE(G_SA(0, 0), a2, voffA);
      G_BAR; G_WAIT_L(0); G_MMA(1, 0, At, B0); G_BAR; G_SCHED;
      G_STAGE(G_SB(0, 1), b2 + hB, voffB);
      G_WAIT_V(6); G_BAR; G_MMA(1, 1, At, B1); G_BAR;
      G_LDB(B0, 1, 0); G_SCHED; G_LDA(At, 1, 0); G_STAGE(G_SA(0, 1), a2 + hA, voffA);
      G_WAIT_L(8); G_BAR; G_WAIT_L(0); G_MMA(0, 0, At, B0); G_BAR; G_SCHED;
      G_LDB(B1, 1, 1); G_STAGE(G_SB(1, 0), b3, voffB);
      G_BAR; G_WAIT_L(0); G_MMA(0, 1, At, B1); G_BAR;
      G_LDA(At, 1, 1); G_STAGE(G_SA(1, 0), a3, voffA);
      G_BAR; G_WAIT_L(0); G_MMA(1, 0, At, B0); G_BAR; G_SCHED;
      G_STAGE(G_SB(1, 1), b3 + hB, voffB);
      G_WAIT_V(6); G_BAR; G_MMA(1, 1, At, B1); G_BAR;
    }
    unsigned long long t_e0 = 0; if (PROBE >= 20) t_e0 = __builtin_amdgcn_s_memrealtime();
    const bool reset = E(acc, cur, wr, wc, fr, fq);
    if (PROBE >= 20) { asm volatile("s_waitcnt vmcnt(0)" ::: "memory"); t_epi += __builtin_amdgcn_s_memrealtime() - t_e0; }
    if (!has_next) break;
    if (reset) {
#pragma unroll
      for (int a = 0; a < 2; ++a)
#pragma unroll
        for (int b = 0; b < 2; ++b)
#pragma unroll
          for (int m = 0; m < 4; ++m)
#pragma unroll
            for (int n = 0; n < 2; ++n) acc[a][b][m][n] = (f32x4){0.f, 0.f, 0.f, 0.f};
    }
    cur = nxt; cA = nA; cB = nB; ++ui;
  }
  G_WAIT_V(0);
  if (wr == 0) G_BAR;
  G_BAR;
  float tres = 0.f;
  if (PROBE >= 20) {
    const unsigned long long tot = __builtin_amdgcn_s_memrealtime() - t_ph0;
    tres = (tmode == 0) ? (float)t_epi / (float)tot : (float)tot / 40000.f;
  }
#undef G_SA
#undef G_SB
#undef G_STAGE
#undef G_LDA
#undef G_LDB
#undef G_MMA
#undef G_WAIT_V
#undef G_WAIT_L
#undef G_BAR
#undef G_SCHED
  return tres;
}

struct EpiInproj {
  const Params* pp; int l; LAS float* part; const LAS float* ropeL;
  __device__ __forceinline__ bool operator()(f32x4 (&acc)[2][2][4][2], const Unit& u, int wr, int wc, int fr, int fq) const {
    const Params& p = *pp;
    asm volatile("" : "+v"(fr), "+v"(fq));
    const int lane = fr + 16 * fq; (void)lane;
    const int oc0 = u.pn * 256;
    const bool isctx = u.pm < 16;
    const bool qkU = (oc0 < 768) || (oc0 >= 2304 && oc0 < 3328);
    float rinv[2][4][2];
    if (qkU) {
#pragma unroll
      for (int ai = 0; ai < 2; ai++)
#pragma unroll
        for (int m = 0; m < 4; m++)
#pragma unroll
          for (int bj = 0; bj < 2; bj++) {
            f32x4 a = acc[ai][bj][m][0], b = acc[ai][bj][m][1];
            float ss = a[0] * a[0] + a[1] * a[1] + a[2] * a[2] + a[3] * a[3] + b[0] * b[0] + b[1] * b[1] + b[2] * b[2] + b[3] * b[3];
            ss += shflx(ss, 16, lane); ss += shflx(ss, 32, lane);
            rinv[ai][m][bj] = ss;
            if (fq == 0) part[((ai * 128 + wr * 64 + m * 16 + fr) * 2 + bj) * 4 + wc] = ss;
          }
      asm volatile("s_waitcnt lgkmcnt(0)" ::: "memory");
      __builtin_amdgcn_s_barrier();
      asm volatile("" ::: "memory");
#pragma unroll
      for (int ai = 0; ai < 2; ai++)
#pragma unroll
        for (int m = 0; m < 4; m++)
#pragma unroll
          for (int bj = 0; bj < 2; bj++) {
            float o = part[((ai * 128 + wr * 64 + m * 16 + fr) * 2 + bj) * 4 + (wc ^ 1)];
            rinv[ai][m][bj] = rsqrtf((rinv[ai][m][bj] + o) * (1.f / 64.f) + EPS);
          }
    }
#pragma unroll
    for (int bj = 0; bj < 2; bj++) {
      const int oc = oc0 + bj * 128;
      if (oc == 640 || (oc >= 3328 && oc < 3840)) {
        const bool isA = (oc == 640);
        const int cb = isA ? 0 : (oc - 3328);
        const int nvec = isA ? 128 : 512;
#pragma unroll
        for (int ai = 0; ai < 2; ai++)
#pragma unroll
          for (int m = 0; m < 4; m++) {
            const int row = u.pm * 256 + ai * 128 + wr * 64 + m * 16 + fr;
            int b, t, T; u16* vt;
            if (isctx) { b = row >> 8; t = row & 255; T = 256; vt = isA ? p.VtA_ctx : p.VtC_ctx; }
            else { int rr = row - NCTX; b = rr >> 12; t = rr & 4095; T = 4096; vt = isA ? p.VtA_lat : p.VtC_lat; }
#pragma unroll
            for (int n = 0; n < 2; n++) {
              const int d = cb + wc * 32 + n * 16 + fq * 4;
              f32x4 v = acc[ai][bj][m][n];
#pragma unroll
              for (int j = 0; j < 4; j++) vt[((size_t)b * nvec + d + j) * T + t] = f2bf(v[j]);
              if (isctx) {
                float* o = p.out + (isA ? O_VA : O_VC) + ((size_t)(b * 2 + l) * 256 + t) * nvec + d;
                *(f32x4*)o = v;
              }
            }
          }
      } else {
        const int pc = (oc < 640) ? oc : (oc < 3328 ? oc - 128 : oc - 640);
        const bool is_qa = oc < 512, is_ka = (oc == 512);
        const bool is_qc = (oc >= 2304 && oc < 2816), is_kc = (oc >= 2816 && oc < 3328);
        if (is_qa || is_ka || is_qc || is_kc) {
          const float* gn = (is_qa ? p.qn_a : is_ka ? p.kn_a : is_qc ? p.qn_c : p.kn_c) + l * 64 + (wc & 1) * 32 + fq * 4;
          const f32x4 g0 = *(const f32x4*)gn, g1 = *(const f32x4*)(gn + 16);
          const float qs = (is_qa || is_qc) ? 0.18033688011112042f : 1.f;
#pragma unroll
          for (int ai = 0; ai < 2; ai++)
#pragma unroll
            for (int m = 0; m < 4; m++) {
              const int row = u.pm * 256 + ai * 128 + wr * 64 + m * 16 + fr;
              const float ri = rinv[ai][m][bj];
              f32x4 x1 = acc[ai][bj][m][0] * ri * g0, x2 = acc[ai][bj][m][1] * ri * g1;
              if (!isctx) {
                const int t = (row - NCTX) & 4095;
                const int pos = (wc & 1) ? (t & 63) : (t >> 6);
                const f32x4 cs = *(const LAS f32x4*)(ropeL + pos * 16 + fq * 4), sn = *(const LAS f32x4*)(ropeL + 1024 + pos * 16 + fq * 4);
                f32x4 y1 = x1 * cs - x2 * sn, y2 = x2 * cs + x1 * sn;
                x1 = y1; x2 = y2;
              } else if (is_ka || is_kc) {
                const int b = row >> 8, t = row & 255;
                float* o = is_ka ? p.out + O_KA + ((size_t)(b * 2 + l) * 256 + t) * 128 + wc * 32 + fq * 4
                                 : p.out + O_KC + ((size_t)(b * 2 + l) * 256 + t) * 512 + (oc - 2816) + wc * 32 + fq * 4;
                *(f32x4*)o = x1; *(f32x4*)(o + 16) = x2;
              }
              x1 = x1 * qs; x2 = x2 * qs;
              u16* po = p.P + (size_t)row * PP + pc + wc * 32 + fq * 4;
              *(uint2*)po = make_uint2(pack2(x1[0], x1[1]), pack2(x1[2], x1[3]));
              *(uint2*)(po + 16) = make_uint2(pack2(x2[0], x2[1]), pack2(x2[2], x2[3]));
            }
        } else {
          const int mode = (oc >= 4352) ? 2 : ((oc >= 1280 && oc < 1792) ? 0 : 1);
          if (mode == 2) {
            const int pj = u.pn - 17, seg = pj >> 2, pn4 = pj & 3;
            unsigned* mg = p.MG + ((size_t)((u.pm * 4 + pn4) * 3 + seg) * 8 + (wr * 4 + wc)) * 2048 + lane;
#pragma unroll
            for (int ai = 0; ai < 2; ai++)
#pragma unroll
              for (int m = 0; m < 4; m++)
#pragma unroll
                for (int n = 0; n < 2; n++) {
                  f32x4 v = acc[ai][bj][m][n];
                  const unsigned q0 = (unsigned)(sigmoidf_(v[0]) * 254.f + 1.5f), q1 = (unsigned)(sigmoidf_(v[1]) * 254.f + 1.5f);
                  const unsigned q2 = (unsigned)(sigmoidf_(v[2]) * 254.f + 1.5f), q3 = (unsigned)(sigmoidf_(v[3]) * 254.f + 1.5f);
                  mg[(((ai * 4 + m) * 2 + bj) * 2 + n) * 64] = q0 | (q1 << 8) | (q2 << 16) | (q3 << 24);
                }
          } else
#pragma unroll
          for (int ai = 0; ai < 2; ai++)
#pragma unroll
            for (int m = 0; m < 4; m++) {
              const int row = u.pm * 256 + ai * 128 + wr * 64 + m * 16 + fr;
              u16* po = p.P + (size_t)row * PP + pc + wc * 32 + fq * 4;
#pragma unroll
              for (int n = 0; n < 2; n++) {
                f32x4 v = acc[ai][bj][m][n];
                if (mode == 1) { v[0] = siluf_(v[0]); v[1] = siluf_(v[1]); v[2] = siluf_(v[2]); v[3] = siluf_(v[3]); }
                else if (mode == 2) { v[0] = sigmoidf_(v[0]); v[1] = sigmoidf_(v[1]); v[2] = sigmoidf_(v[2]); v[3] = sigmoidf_(v[3]); }
                *(uint2*)(po + n * 16) = make_uint2(pack2(v[0], v[1]), pack2(v[2], v[3]));
              }
            }
        }
      }
    }
    return true;
  }
};

struct EpiBranch {
  const Params* pp;
  __device__ __forceinline__ bool operator()(f32x4 (&acc)[2][2][4][2], const Unit& u, int wr, int wc, int fr, int fq) const {
    const Params& p = *pp;
    asm volatile("" : "+v"(fr), "+v"(fq));
    const int lane = fr + 16 * fq;
    const int seg = u.seg;
    const unsigned* mg = p.MG + ((size_t)((u.pm * 4 + u.pn) * 3 + seg) * 8 + (wr * 4 + wc)) * 2048 + lane;
    const float sel = (seg < 2) ? 1.f : 0.f;
#pragma unroll
    for (int hq = 0; hq < 4; hq++) {
      unsigned a[8], b[8];
#pragma unroll
      for (int q = 0; q < 8; q++) { a[q] = mg[(hq * 8 + q) * 64]; b[q] = mg[(hq * 8 + q) * 64 + 8 * 2048]; }
      __builtin_amdgcn_sched_barrier(0);
#pragma unroll
      for (int q = 0; q < 8; q++) {
        const int ai = hq >> 1, m = (hq & 1) * 2 + (q >> 2), bj = (q >> 1) & 1, n = q & 1;
        f32x4 f = {(float)(a[q] & 255u), (float)((a[q] >> 8) & 255u), (float)((a[q] >> 16) & 255u), (float)(a[q] >> 24)};
        f32x4 g = {(float)(b[q] & 255u), (float)((b[q] >> 8) & 255u), (float)((b[q] >> 16) & 255u), (float)(b[q] >> 24)};
        g = g * sel + (1.f - sel) * 255.f;
        f[0] *= __builtin_amdgcn_rcpf(g[0]); f[1] *= __builtin_amdgcn_rcpf(g[1]); f[2] *= __builtin_amdgcn_rcpf(g[2]); f[3] *= __builtin_amdgcn_rcpf(g[3]);
        acc[ai][bj][m][n] = acc[ai][bj][m][n] * f;
      }
    }
    if (seg < 2) return false;
#pragma unroll
    for (int ai = 0; ai < 2; ai++)
#pragma unroll
      for (int m = 0; m < 4; m++) {
        const int row = u.pm * 256 + ai * 128 + wr * 64 + m * 16 + fr;
#pragma unroll
        for (int bj = 0; bj < 2; bj++)
#pragma unroll
          for (int n = 0; n < 2; n++) {
            const int col = u.pn * 256 + bj * 128 + wc * 32 + n * 16 + fq * 4;
            const f32x4 v = acc[ai][bj][m][n];
            *(uint2*)(p.Y + tm_off(row, col, 16)) = make_uint2(pack2(v[0], v[1]), pack2(v[2], v[3]));
          }
      }
    return true;
  }
};

struct EpiOut {
  const Params* pp; int l;
  __device__ __forceinline__ bool operator()(f32x4 (&acc)[2][2][4][2], const Unit& u, int wr, int wc, int fr, int fq) const {
    const Params& p = *pp;
    asm volatile("" : "+v"(fr), "+v"(fq));
    const int v = (u.pm < 16) ? 0 : 1 + (u.pm - 16) / 16;
    const float* gt = p.mod + (l * 3 + v) * 3072 + 2048 + u.pn * 256 + wc * 32 + fq * 4;
    const float* xsrc = (l == 0) ? ((u.pm < 16) ? p.x_prompt + (size_t)u.pm * 256 * 1024 : p.x_sample + (size_t)(u.pm - 16) * 256 * 1024)
                                 : p.out + O_X + (size_t)u.pm * 256 * 1024;
    float* odst = p.out + O_X + (size_t)u.pm * 256 * 1024;
    const int cbase = u.pn * 256 + wc * 32 + fq * 4;
    f32x4 gv[2][2];
#pragma unroll
    for (int bj = 0; bj < 2; bj++)
#pragma unroll
      for (int n = 0; n < 2; n++) gv[bj][n] = *(const f32x4*)(gt + bj * 128 + n * 16);
#pragma unroll
    for (int ai = 0; ai < 2; ai++)
#pragma unroll
      for (int mh = 0; mh < 2; mh++) {
        f32x4 xv[2][2][2];
#pragma unroll
        for (int mm = 0; mm < 2; mm++)
#pragma unroll
          for (int bj = 0; bj < 2; bj++)
#pragma unroll
            for (int n = 0; n < 2; n++)
              xv[mm][bj][n] = *(const f32x4*)(xsrc + (size_t)(ai * 128 + wr * 64 + (mh * 2 + mm) * 16 + fr) * 1024 + cbase + bj * 128 + n * 16);
#pragma unroll
        for (int mm = 0; mm < 2; mm++)
#pragma unroll
          for (int bj = 0; bj < 2; bj++)
#pragma unroll
            for (int n = 0; n < 2; n++)
              *(f32x4*)(odst + (size_t)(ai * 128 + wr * 64 + (mh * 2 + mm) * 16 + fr) * 1024 + cbase + bj * 128 + n * 16) = xv[mm][bj][n] + gv[bj][n] * acc[ai][bj][mh * 2 + mm][n];
      }
    return true;
  }
};

template <bool MASK>
__device__ __forceinline__ void fs_scores(const u16* Ks, const bf16x8 (&qf)[4], f32x16 (&s)[2], int lane, int kpos0, int qpos, int T) {
  const int r = lane & 31, h = lane >> 5;
  {
    bf16x8 kf[2][4];
#pragma unroll
    for (int sub = 0; sub < 2; sub++)
#pragma unroll
      for (int ks = 0; ks < 4; ks++) kf[sub][ks] = *(const bf16x8*)(Ks + (sub * 32 + r) * LROW + ks * 16 + h * 8);
    __builtin_amdgcn_sched_barrier(0);
#pragma unroll
    for (int sub = 0; sub < 2; sub++) {
#pragma unroll
      for (int e = 0; e < 16; e++) s[sub][e] = 0.f;
#pragma unroll
      for (int ks = 0; ks < 4; ks++) s[sub] = mfma32(kf[sub][ks], qf[ks], s[sub]);
    }
  }
  if (MASK) {
#pragma unroll
    for (int sub = 0; sub < 2; sub++)
#pragma unroll
      for (int e = 0; e < 16; e++) {
        int kp = kpos0 + sub * 32 + (e & 3) + 8 * (e >> 2) + 4 * h;
        int dlt = kp - qpos;
        bool ok = (kp >= 0) && (kp < T) && (dlt <= 128) && (dlt >= -128);
        if (!ok) s[sub][e] = -INFINITY;
      }
  }
}
template <int DV>
__device__ __forceinline__ void fs_softmax(f32x16 (&s)[2], float& m, float& l, f32x16 (&o)[DV / 32], bf16x8 (&pf)[2][2], int lane) {
  float mx = s[0][0];
#pragma unroll
  for (int sub = 0; sub < 2; sub++)
#pragma unroll
    for (int e = 0; e < 16; e++) mx = fmaxf(mx, s[sub][e]);
  mx = fmaxf(mx, shflx(mx, 32, lane));
  const bool grow = mx > m;
  const float mn = grow ? mx : m;
  float sum = 0.f;
#pragma unroll
  for (int sub = 0; sub < 2; sub++)
#pragma unroll
    for (int e = 0; e < 16; e++) { float pv = __builtin_amdgcn_exp2f(s[sub][e] - mn); s[sub][e] = pv; sum += pv; }
  sum += shflx(sum, 32, lane);
  if (__builtin_amdgcn_ballot_w64(grow) != 0ull) {
    const float alpha = __builtin_amdgcn_exp2f(m - mn);
    l *= alpha;
#pragma unroll
    for (int ds = 0; ds < DV / 32; ds++)
#pragma unroll
      for (int e = 0; e < 16; e++) o[ds][e] *= alpha;
  }
  l += sum; m = mn;
  typedef __attribute__((ext_vector_type(4))) unsigned u32x4;
#pragma unroll
  for (int sub = 0; sub < 2; sub++)
#pragma unroll
    for (int st = 0; st < 2; st++) {
      u32x4 pw;
#pragma unroll
      for (int j = 0; j < 4; j++) pw[j] = pack2(s[sub][8 * st + 2 * j], s[sub][8 * st + 2 * j + 1]);
      pf[sub][st] = __builtin_bit_cast(bf16x8, pw);
    }
}
template <int DV>
__device__ __forceinline__ void fs_pv(const bf16x8 (&pf)[2][2], const u16* Vts, f32x16 (&o)[DV / 32], int lane) {
  const int r = lane & 31, h = lane >> 5;
#pragma unroll
  for (int sub = 0; sub < 2; sub++) {
    bf16x8 vf[2][DV / 32];
#pragma unroll
    for (int st = 0; st < 2; st++)
#pragma unroll
      for (int ds = 0; ds < DV / 32; ds++) {
        const u16* vp = Vts + (ds * 32 + r) * VROW + sub * 32 + 16 * st + 4 * h;
        bf16x4 lo = *(const bf16x4*)vp, hi = *(const bf16x4*)(vp + 8);
        vf[st][ds] = __builtin_shufflevector(lo, hi, 0, 1, 2, 3, 4, 5, 6, 7);
      }
    __builtin_amdgcn_sched_barrier(0);
#pragma unroll
    for (int st = 0; st < 2; st++)
#pragma unroll
      for (int ds = 0; ds < DV / 32; ds++) o[ds] = mfma32(vf[st][ds], pf[sub][st], o[ds]);
    __builtin_amdgcn_sched_barrier(0);
  }
}

__device__ __forceinline__ uint4 ld_k(const u16* __restrict__ src, size_t pitch, int r0, int nrows, int c) {
  int row = c >> 3, kc = c & 7; int rr = r0 + row;
  const bool ok = (rr >= 0 && rr < nrows);
  const int rc = rr < 0 ? 0 : (rr >= nrows ? nrows - 1 : rr);
  uint4 v = *(const uint4*)(src + (size_t)rc * pitch + kc * 8);
  if (!ok) v = make_uint4(0, 0, 0, 0);
  return v;
}
__device__ __forceinline__ void st_k(u16* dst, int c, uint4 v) { *(uint4*)(dst + (c >> 3) * LROW + (c & 7) * 8) = v; }
__device__ __forceinline__ uint4 ld_vt(const u16* __restrict__ src, int T, int k0, int c) {
  int d = c >> 3, kc = c & 7; int k = k0 + kc * 8;
  const bool ok = (k >= 0 && k < T);
  const int kk = k < 0 ? 0 : (k >= T ? T - 8 : k);
  uint4 v = *(const uint4*)(src + (size_t)d * T + kk);
  if (!ok) v = make_uint4(0, 0, 0, 0);
  return v;
}
__device__ __forceinline__ void st_vt(u16* dst, int c, uint4 v) {
  uint2* q = (uint2*)(dst + (c >> 3) * VROW + (c & 7) * 8);
  q[0] = make_uint2(v.x, v.y); q[1] = make_uint2(v.z, v.w);
}

constexpr int A_BUF = 64 * LROW + 64 * VROW;
__device__ __forceinline__ void attnA_item(const Params& p, int l, int it, u16* sm, bool dry = false) {
  const int tid = TIDX, lane = tid & 63, wid = tid >> 6;
  const int r = lane & 31, h = lane >> 5;
  const bool isctx = it < 128;
  int b, kvh, qb, T, rowbase; const u16* VtBase;
  if (isctx) { b = it >> 3; kvh = (it >> 2) & 1; qb = it & 3; T = 256; rowbase = b * 256;
    VtBase = p.VtA_ctx + ((size_t)(b * 2 + kvh) * 64) * 256; }
  else { int j = it - 128; b = j >> 7; kvh = (j >> 6) & 1; qb = j & 63; T = 4096; rowbase = NCTX + b * 4096;
    VtBase = p.VtA_lat + ((size_t)(b * 2 + kvh) * 64) * 4096; }
  const int qblk = qb * 64;
  const int q0 = qblk + (wid >> 2) * 32;
  const int head = kvh * 4 + (wid & 3);
  const size_t prow = (size_t)(rowbase + q0 + r) * PP;
  bf16x8 qf[4];
#pragma unroll
  for (int ks = 0; ks < 4; ks++) qf[ks] = *(const bf16x8*)(p.P + prow + C_QA + head * 64 + ks * 16 + h * 8);
  float m = p.sink_a[l * 8 + head] * 1.4426950408889634f, ls = 1.f;
  f32x16 o[2];
#pragma unroll
  for (int ds = 0; ds < 2; ds++)
#pragma unroll
    for (int e = 0; e < 16; e++) o[ds][e] = 0.f;
  const u16* Kbase = p.P + (size_t)rowbase * PP + C_KA + kvh * 64;
  const u16* cK = p.cKa + ((size_t)(b * 2 + l) * 512) * 128 + kvh * 64;
  const u16* cVt = p.cVtA + ((size_t)((b * 2 + l) * 2 + kvh) * 64) * 512;
  const int qpos = q0 + r;
  int i_lo = 0, nW, ntile;
  if (isctx) { nW = 4; ntile = 4; }
  else {
    i_lo = (qblk < 128) ? (128 - qblk) / 64 : 0;
    int i_hi = (T - qblk + 128) / 64; if (i_hi > 5) i_hi = 5;
    nW = i_hi - i_lo; ntile = nW + 8;
  }
  uint4 rk, rv;
  auto tile_load = [&](int t) {
    if (t < nW) {
      int k0 = isctx ? t * 64 : qblk - 128 + 64 * (i_lo + t);
      rk = ld_k(Kbase, PP, k0, T, tid); rv = ld_vt(VtBase, T, k0, tid);
    } else {
      int kt = t - nW;
      rk = ld_k(cK, 128, kt * 64, 512, tid); rv = ld_vt(cVt, 512, kt * 64, tid);
    }
  };
  auto KB = [&](int i) { return sm + (i & 1) * (64 * LROW); };
  auto VB = [&](int i) { return sm + 2 * 64 * LROW + (i % 3) * (64 * VROW); };
  const bool lag = (wid >> 2) != 0;
  __syncthreads();
  tile_load(0);
  st_k(KB(0), tid, rk); st_vt(VB(0), tid, rv);
  __syncthreads();
  bf16x8 pf[2][2];
  for (int t = 0; t <= ntile; t++) {
    const bool more = t + 1 < ntile;
    if (more) tile_load(t + 1);
    if (lag && t > 0) fs_pv<64>(pf, VB(t - 1), o, lane);
    if (t < ntile) {
      f32x16 sc[2];
      if (!isctx && t < nW) fs_scores<true>(KB(t), qf, sc, lane, qblk - 128 + 64 * (i_lo + t), qpos, T);
      else fs_scores<false>(KB(t), qf, sc, lane, 0, 0, T);
      fs_softmax<64>(sc, m, ls, o, pf, lane);
      if (!lag) fs_pv<64>(pf, VB(t), o, lane);
    }
    if (more) { st_k(KB(t + 1), tid, rk); st_vt(VB(t + 1), tid, rv); }
    __syncthreads();
  }
  const float inv = __builtin_amdgcn_rcpf(ls);
  {
    uint2 gv[2][4];
#pragma unroll
    for (int ds = 0; ds < 2; ds++)
#pragma unroll
      for (int g = 0; g < 4; g++) gv[ds][g] = *(const uint2*)(p.P + prow + C_GA + head * 64 + ds * 32 + 8 * g + 4 * h);
    __builtin_amdgcn_sched_barrier(0);
#pragma unroll
    for (int ds = 0; ds < 2; ds++)
#pragma unroll
      for (int g = 0; g < 4; g++) {
        int d = ds * 32 + 8 * g + 4 * h;
        uint2 ov;
        ov.x = pack2(o[ds][4 * g] * inv * lo_bf(gv[ds][g].x), o[ds][4 * g + 1] * inv * hi_bf(gv[ds][g].x));
        ov.y = pack2(o[ds][4 * g + 2] * inv * lo_bf(gv[ds][g].y), o[ds][4 * g + 3] * inv * hi_bf(gv[ds][g].y));
        *(uint2*)(p.GB + tm_off(rowbase + q0 + r, head * 64 + d, 8)) = ov;
      }
  }
}

constexpr int C_BUF = 128 * LROW + 128 * VROW;
__device__ __forceinline__ void attnC_item(const Params& p, int l, int it, u16* sm, float lam, float lam_init, bool dry = false) {
  const int tid = TIDX, lane = tid & 63, wid = tid >> 6;
  const int r = lane & 31, h = lane >> 5;
  const bool isctx = it < 128;
  int b, hd, qb, T, rowbase; const u16* VtBase;
  if (isctx) { b = it >> 3; hd = (it >> 1) & 3; qb = it & 1; T = 256; rowbase = b * 256;
    VtBase = p.VtC_ctx + ((size_t)(b * 4 + hd) * 128) * 256; }
  else { int j = it - 128; b = j >> 7; hd = (j >> 5) & 3; qb = j & 31; T = 4096; rowbase = NCTX + b * 4096;
    VtBase = p.VtC_lat + ((size_t)(b * 4 + hd) * 128) * 4096; }
  const int qg = wid & 3, map = wid >> 2;
  const int q0 = qb * 128 + qg * 32;
  const size_t prow = (size_t)(rowbase + q0 + r) * PP;
  bf16x8 qf[4];
#pragma unroll
  for (int ks = 0; ks < 4; ks++) qf[ks] = *(const bf16x8*)(p.P + prow + C_QC + hd * 128 + map * 64 + ks * 16 + h * 8);
  float m = -1e30f, ls = 0.f;
  f32x16 o[4];
#pragma unroll
  for (int ds = 0; ds < 4; ds++)
#pragma unroll
    for (int e = 0; e < 16; e++) o[ds][e] = 0.f;
  const u16* Kbase = p.P + (size_t)rowbase * PP + C_KC + hd * 128;
  const u16* cK = p.cKc + ((size_t)(b * 2 + l) * 512) * 512 + hd * 128;
  const u16* cVt = p.cVtC + ((size_t)((b * 2 + l) * 4 + hd) * 128) * 512;
  const int nW = T / 64, ntile = isctx ? nW : nW + 8;
  uint4 rk0, rk1, rv0, rv1;
  auto tile_load = [&](int t) {
    if (t < nW) {
      rk0 = ld_k(Kbase, PP, t * 64, T, tid); rk1 = ld_k(Kbase + 64, PP, t * 64, T, tid);
      rv0 = ld_vt(VtBase, T, t * 64, tid); rv1 = ld_vt(VtBase, T, t * 64, tid + NT);
    } else {
      int kt = t - nW;
      rk0 = ld_k(cK, 512, kt * 64, 512, tid); rk1 = ld_k(cK + 64, 512, kt * 64, 512, tid);
      rv0 = ld_vt(cVt, 512, kt * 64, tid); rv1 = ld_vt(cVt, 512, kt * 64, tid + NT);
    }
  };
  auto KB = [&](int i) { return sm + (i & 1) * (128 * LROW); };
  auto VB = [&](int i) { return sm + 2 * 128 * LROW + (i % 3) * (128 * VROW); };
  auto tile_store = [&](int i) {
    u16* kd = KB(i); u16* vd = VB(i);
    st_k(kd, tid, rk0); st_k(kd + 64 * LROW, tid, rk1);
    st_vt(vd, tid, rv0); st_vt(vd, tid + NT, rv1);
  };
  const bool lag = map != 0;
  __syncthreads();
  tile_load(0);
  tile_store(0);
  __syncthreads();
  bf16x8 pf[2][2];
  for (int t = 0; t <= ntile; t++) {
    const bool more = t + 1 < ntile;
    if (more) tile_load(t + 1);
    if (lag && t > 0) fs_pv<128>(pf, VB(t - 1), o, lane);
    if (t < ntile) {
      f32x16 sc[2];
      fs_scores<false>(KB(t) + map * 64 * LROW, qf, sc, lane, 0, 0, T);
      fs_softmax<128>(sc, m, ls, o, pf, lane);
      if (!lag) fs_pv<128>(pf, VB(t), o, lane);
    }
    if (more) tile_store(t + 1);
    __syncthreads();
  }
  float* xch = (float*)sm;
  if (map == 1) {
    const float inv = lam * __builtin_amdgcn_rcpf(ls);
#pragma unroll
    for (int ds = 0; ds < 4; ds++)
#pragma unroll
      for (int e = 0; e < 16; e++) xch[((qg * 64) + ds * 16 + e) * 64 + lane] = o[ds][e] * inv;
  }
  __syncthreads();
  if (map == 0) {
    const float i0 = __builtin_amdgcn_rcpf(ls);
    float ss = 0.f;
#pragma unroll
    for (int ds = 0; ds < 4; ds++)
#pragma unroll
      for (int e = 0; e < 16; e++) {
        float v = o[ds][e] * i0 - xch[((qg * 64) + ds * 16 + e) * 64 + lane];
        o[ds][e] = v; ss += v * v;
      }
    ss += shflx(ss, 32, lane);
    const float rinv = rsqrtf(ss * (1.f / 128.f) + EPS) * (1.f - lam_init);
    const float* sg = p.subln_c + l * 128;
#pragma unroll
    for (int ds = 0; ds < 4; ds++) {
      uint2 gv[4]; float4 sl[4];
#pragma unroll
      for (int g = 0; g < 4; g++) {
        const int d = ds * 32 + 8 * g + 4 * h;
        gv[g] = *(const uint2*)(p.P + prow + C_GC + hd * 128 + d);
        sl[g] = *(const float4*)(sg + d);
      }
      __builtin_amdgcn_sched_barrier(0);
#pragma unroll
      for (int g = 0; g < 4; g++) {
        const int d = ds * 32 + 8 * g + 4 * h;
        uint2 ov;
        ov.x = pack2(o[ds][4 * g] * rinv * sl[g].x * lo_bf(gv[g].x), o[ds][4 * g + 1] * rinv * sl[g].y * hi_bf(gv[g].x));
        ov.y = pack2(o[ds][4 * g + 2] * rinv * sl[g].z * lo_bf(gv[g].y), o[ds][4 * g + 3] * rinv * sl[g].w * hi_bf(gv[g].y));
        *(uint2*)(p.GB + (size_t)2 * NTOK * 512 + tm_off(rowbase + q0 + r, hd * 128 + d, 8)) = ov;
      }
    }
  }
}

__device__ __forceinline__ void lru_run(const Params& p, int l, bool pass2, int start, int G, float* sm, bool dry = false) {
  const int tid = TIDX;
  const int lane = tid & 63, wid = tid >> 6, r = lane & 31, h = lane >> 5;
  const int n = start & 7;
  float* xin = sm;
  float* xb = sm + 67 * 64;
  float* comb = xb + 64 * 64;
  float* carry = comb + 2048;
  float* parts = carry + 128;
  float* ab = parts + 1024;
  u16* xbh = (u16*)(ab + 4 * 4096);
  const int gd = wid >> 2, gth = (wid >> 1) & 1, gdh = wid & 1;
  bf16x8 wfa[4], wfx[4];
  {
    const u16* wbase = p.Wt_lru + ((size_t)(((l * 2 + gd) * 8 + n) * 2) * 64 + gdh * 32 + r) * 64 + h * 8;
#pragma unroll
    for (int ks = 0; ks < 4; ks++) { wfa[ks] = *(const bf16x8*)(wbase + ks * 16); wfx[ks] = *(const bf16x8*)(wbase + 4096 + ks * 16); }
  }
  const int gch = n * 64 + gdh * 32 + r;
  const float g_ba = p.lru_ba[(l * 2 + gd) * 512 + gch], g_bx = p.lru_bx[(l * 2 + gd) * 512 + gch];
  const float g_sp = log1pf(__expf(-p.lru_lam[(l * 2 + gd) * 512 + gch]));
  const int cc = tid & 63;
  float cw[4]; float cbv;
  {
    const float* cwp = p.conv_w + l * 4 * 512 + n * 64 + cc;
    cw[0] = cwp[0]; cw[1] = cwp[512]; cw[2] = cwp[1024]; cw[3] = cwp[1536];
    cbv = p.conv_b[l * 512 + n * 64 + cc];
  }
  const int dout = tid & 63, tg = tid >> 6;
  const int ch = n * 64 + dout;

  u16 xr[9];
  auto xin_load = [&](int it_) {
    const int row0_ = (it_ >> 3) * 64;
    int T_, seq0_;
    if (row0_ < NCTX) { T_ = 256; seq0_ = (row0_ >> 8) * 256; } else { T_ = 4096; seq0_ = NCTX + ((row0_ - NCTX) >> 12) * 4096; }
    const int t0_ = row0_ - seq0_;
#pragma unroll
    for (int k = 0; k < 9; k++) {
      const int rr = (tid >> 6) + 8 * k; const int t = t0_ - 2 + rr;
      const bool ok = (rr < 67 && t >= 0 && t < T_);
      const int tc = t < 0 ? 0 : (t >= T_ ? T_ - 1 : t);
      u16 v = p.P[(size_t)(seq0_ + tc) * PP + C_XB + n * 64 + cc];
      xr[k] = ok ? v : (u16)0;
    }
  };
  if (start < 1536) xin_load(start);
  for (int it = start; it < 1536; it += G) {
    const int ci = it >> 3;
    const int row0 = ci * 64;
    const bool isctx = row0 < NCTX;
    int T, seq0, bidx;
    if (isctx) { T = 256; bidx = row0 >> 8; seq0 = bidx * 256; }
    else { T = 4096; bidx = (row0 - NCTX) >> 12; seq0 = NCTX + bidx * 4096; }
    const int t0 = row0 - seq0;
    __syncthreads();
#pragma unroll
    for (int k = 0; k < 9; k++) { const int rr = (tid >> 6) + 8 * k; if (rr < 67) xin[rr * 64 + cc] = bf2f(xr[k]); }
    if (it + G < 1536) xin_load(it + G);
    u16 sgr[8];
    if (pass2) {
#pragma unroll
      for (int tt = 0; tt < 8; tt++) sgr[tt] = p.P[(size_t)(row0 + tg * 8 + tt) * PP + C_GB + ch];
    }
    if (pass2) {
      const int d = (tid >> 6) & 1, part = tid >> 7;
      const int cfirst = seq0 >> 6, clast = (seq0 + T - 64) >> 6;
      const int K = d ? (clast - ci) : (ci - cfirst);
      float2 q[16];
#pragma unroll
      for (int k = 0; k < 16; k++) {
        const int kk = part * 16 + k;
        const int cj = d ? (clast - kk) : (cfirst + kk);
        const int cjc = cj < cfirst ? cfirst : (cj > clast ? clast : cj);
        const float2 qv = *(const float2*)(p.lruTot + ((size_t)(cjc * 2 + d) * 512 + n * 64 + cc) * 2);
        q[k] = (kk < K) ? qv : make_float2(1.f, 0.f);
      }
      float At = 1.f, Bt = 0.f;
#pragma unroll
      for (int k = 0; k < 16; k++) { Bt = q[k].x * Bt + q[k].y; At *= q[k].x; }
      parts[((part * 2 + d) * 64 + cc) * 2] = At; parts[((part * 2 + d) * 64 + cc) * 2 + 1] = Bt;
    }
    __syncthreads();
    for (int e = tid; e < 64 * 64; e += NT) {
      int t = e >> 6;
      float v = cbv;
#pragma unroll
      for (int j = 0; j < 4; j++) v += xin[(t + j) * 64 + cc] * cw[j];
      xb[e] = v;
      xbh[t * LROW + cc] = f2bf(v);
    }
    if (pass2 && tid < 128) {
      const int d = tid >> 6;
      float hcar = isctx ? 0.f : p.state_lru[((size_t)(bidx * 2 + l) * 2 + d) * 512 + n * 64 + cc];
#pragma unroll
      for (int part = 0; part < 4; part++) hcar = parts[((part * 2 + d) * 64 + cc) * 2] * hcar + parts[((part * 2 + d) * 64 + cc) * 2 + 1];
      carry[d * 64 + cc] = hcar;
    }
    __syncthreads();
    {
      bf16x8 af[4];
#pragma unroll
      for (int ks = 0; ks < 4; ks++) af[ks] = *(const bf16x8*)(xbh + (gth * 32 + r) * LROW + ks * 16 + h * 8);
      f32x16 ga, gi;
#pragma unroll
      for (int e = 0; e < 16; e++) { ga[e] = 0.f; gi[e] = 0.f; }
#pragma unroll
      for (int ks = 0; ks < 4; ks++) { ga = mfma32(af[ks], wfa[ks], ga); gi = mfma32(af[ks], wfx[ks], gi); }
      const int dch = gdh * 32 + r;
#pragma unroll
      for (int e = 0; e < 16; e++) {
        const int tok = gth * 32 + (e & 3) + 8 * (e >> 2) + 4 * h;
        float rg = sigmoidf_(ga[e] + g_ba), ig = sigmoidf_(gi[e] + g_bx);
        float log_a = -8.f * rg * g_sp;
        float a = __expf(log_a);
        const float x2 = 2.f * log_a;
        const float om = -x2 * (1.f + x2 * (0.5f + x2 * (0.16666667f + x2 * (0.041666668f + x2 * (0.0083333338f + x2 * (0.0013888889f + x2 * 0.0001984127f))))));
        float bb = __builtin_amdgcn_sqrtf(om) * ig * xb[tok * 64 + dch];
        ab[((gd * 2 + 0) * 64 + tok) * 64 + dch] = a;
        ab[((gd * 2 + 1) * 64 + tok) * 64 + dch] = bb;
      }
    }
    __syncthreads();
    float av[2][8], bv[2][8];
#pragma unroll
    for (int d = 0; d < 2; d++)
#pragma unroll
      for (int tt = 0; tt < 8; tt++) {
        av[d][tt] = ab[((d * 2 + 0) * 64 + tg * 8 + tt) * 64 + dout];
        bv[d][tt] = ab[((d * 2 + 1) * 64 + tg * 8 + tt) * 64 + dout];
      }
    float sA0 = 1.f, sB0 = 0.f, sA1 = 1.f, sB1 = 0.f;
#pragma unroll
    for (int tt = 0; tt < 8; tt++) { sB0 = av[0][tt] * sB0 + bv[0][tt]; sA0 *= av[0][tt]; }
#pragma unroll
    for (int tt = 7; tt >= 0; tt--) { sB1 = av[1][tt] * sB1 + bv[1][tt]; sA1 *= av[1][tt]; }
    comb[((tg * 2 + 0) * 64 + dout) * 2 + 0] = sA0; comb[((tg * 2 + 0) * 64 + dout) * 2 + 1] = sB0;
    comb[((tg * 2 + 1) * 64 + dout) * 2 + 0] = sA1; comb[((tg * 2 + 1) * 64 + dout) * 2 + 1] = sB1;
    __syncthreads();
    if (!pass2) {
      if (tid < 128) {
        int d = tid >> 6, c = tid & 63;
        float At = 1.f, Bt = 0.f;
#pragma unroll
        for (int s = 0; s < 8; s++) {
          int g = (d == 0) ? s : 7 - s;
          float a = comb[((g * 2 + d) * 64 + c) * 2], bq = comb[((g * 2 + d) * 64 + c) * 2 + 1];
          Bt = a * Bt + bq; At *= a;
        }
        float* o = p.lruTot + ((size_t)(ci * 2 + d) * 512 + n * 64 + c) * 2;
        o[0] = At; o[1] = Bt;
      }
      continue;
    }
    float h0 = carry[dout], h1 = carry[64 + dout];
    for (int g = 0; g < tg; g++) { h0 = comb[((g * 2 + 0) * 64 + dout) * 2] * h0 + comb[((g * 2 + 0) * 64 + dout) * 2 + 1]; }
    for (int g = 7; g > tg; g--) { h1 = comb[((g * 2 + 1) * 64 + dout) * 2] * h1 + comb[((g * 2 + 1) * 64 + dout) * 2 + 1]; }
    float y[8];
#pragma unroll
    for (int tt = 0; tt < 8; tt++) { h0 = av[0][tt] * h0 + bv[0][tt]; y[tt] = h0; }
    const float hf_last = h0;
#pragma unroll
    for (int tt = 7; tt >= 0; tt--) { h1 = av[1][tt] * h1 + bv[1][tt]; y[tt] += h1; }
    const float hb_first = h1;
    if (isctx) {
      if (t0 + 64 == T && tg == 7) p.out[O_ST + ((size_t)(bidx * 2 + l) * 2 + 0) * 512 + ch] = hf_last;
      if (t0 == 0 && tg == 0) p.out[O_ST + ((size_t)(bidx * 2 + l) * 2 + 1) * 512 + ch] = hb_first;
    }
#pragma unroll
    for (int tt = 0; tt < 8; tt++) {
      const int rw = row0 + tg * 8 + tt;
      p.GB[(size_t)NTOK * 512 + tm_off(rw, ch, 8)] = f2bf(y[tt] * bf2f(sgr[tt]));
    }
  }
}

__device__ __forceinline__ float compute_lam(const Params& p, int l, float lam_init) {
  float s1 = 0.f, s2 = 0.f;
  for (int i = 0; i < 64; i++) {
    s1 += p.lam_q1[l * 64 + i] * p.lam_k1[l * 64 + i];
    s2 += p.lam_q2[l * 64 + i] * p.lam_k2[l * 64 + i];
  }
  return expf(s1) - expf(s2) + lam_init;
}

__device__ __forceinline__ float mix_phase(const Params& p, int l, u16* smem, int vid) {
  unsigned long long tm0 = 0; float tres = 0.f; if (PROBE >= 30) tm0 = __builtin_amdgcn_s_memrealtime();
  const float lam_init = (l == 0) ? 0.2f : (0.8f - 0.6f * 0.74081822068f);
  const float lam = compute_lam(p, l, lam_init);
  constexpr int N_CL = 256, N_A = 384, N_CC = 128, N_L = 1536;
  const int G = gridDim.x;
  int start = vid;
  for (int it = start; it < N_CL; it += G) attnC_item(p, l, 128 + it, smem, lam, lam_init);
  if (PROBE == 35) tres = (float)(__builtin_amdgcn_s_memrealtime() - tm0) / 40000.f;
  start = (int)((vid + G - (N_CL % G)) % G);
  for (int it = start; it < N_A; it += G) attnA_item(p, l, it, smem);
  start = (int)((vid + G - ((N_CL + N_A) % G)) % G);
  for (int it = start; it < N_CC; it += G) attnC_item(p, l, it, smem, lam, lam_init);
  if (PROBE == 36) tres = (float)(__builtin_amdgcn_s_memrealtime() - tm0) / 40000.f;
  start = (int)((vid + G - ((N_CL + N_A + N_CC) % G)) % G);
  if (PROBE == 6) lru_run(p, l, false, start, G, (float*)smem);
  lru_run(p, l, false, start, G, (float*)smem);
  return tres;
}

__device__ __forceinline__ void lru2_phase(const Params& p, int l, u16* smem) {
  lru_run(p, l, true, blockIdx.x, gridDim.x, (float*)smem);
}

#define XB_TMO      128
#define XB_XCNT(j)  (256  + 64 * (j))
#define XB_XSUB(j)  (1280 + 64 * (j))
#define XB_XGEN(j)  (2304 + 64 * (j))
#define XB_TOP      3328
#define XB_TOPGEN   3392
#define XCD_BAR_WORDS 3456
#define XB_SPIN_CAP (1u << 18)
__device__ __forceinline__ unsigned xb_ld(unsigned* p)              { return __hip_atomic_load(p, __ATOMIC_RELAXED, __HIP_MEMORY_SCOPE_AGENT); }
__device__ __forceinline__ unsigned xb_add(unsigned* p, unsigned v) { return __hip_atomic_fetch_add(p, v, __ATOMIC_RELAXED, __HIP_MEMORY_SCOPE_AGENT); }
__device__ __forceinline__ unsigned xb_xcc_id() { return (unsigned)__builtin_amdgcn_s_getreg((3 << 11) | 20) & 0xFu; }
#define XB_SPIN(cond, bar) do { unsigned _sp = 0; while (cond) { __builtin_amdgcn_s_sleep(1); \
    if ((++_sp & 255u) == 0u) { if (xb_ld(&(bar)[XB_TMO])) break; if (_sp > XB_SPIN_CAP) { atomicAdd(&(bar)[XB_TMO], 1u); break; } } } } while (0)
struct XcdBarrier { unsigned* bar; unsigned x; volatile LAS unsigned* st; };
__device__ __forceinline__ XcdBarrier xcd_barrier_post(unsigned* bar, volatile LAS unsigned* st) {
  XcdBarrier b; b.bar = bar; b.x = xb_xcc_id(); b.st = st;
  if (threadIdx.x == 0) st[2] = xb_add(&bar[XB_XCNT(b.x)], 1u);
  return b;
}
__device__ __forceinline__ int xcd_virtual_id(const XcdBarrier& b) {
  if (threadIdx.x == 0) {
    unsigned pre = 0;
#pragma unroll
    for (unsigned j = 0; j < 16; ++j) { const unsigned c = xb_ld(&b.bar[XB_XCNT(j)]); pre += (j < b.x) ? c : 0u; }
    b.st[3] = pre + b.st[2];
  }
  __syncthreads();
  const int v = (int)b.st[3];
  __syncthreads();
  return __builtin_amdgcn_readfirstlane(v);
}
__device__ __forceinline__ void xcd_barrier_complete(unsigned* bar, unsigned x, unsigned& nloc, unsigned& nx) {
  const unsigned G = gridDim.x * gridDim.y * gridDim.z;
  unsigned sum, cnt, mine, sp = 0u;
  for (;;) {
    sum = 0u; cnt = 0u; mine = 0u;
#pragma unroll
    for (unsigned j = 0; j < 16; ++j) { const unsigned c = xb_ld(&bar[XB_XCNT(j)]); sum += c; cnt += (c > 0u) ? 1u : 0u; mine = (j == x) ? c : mine; }
    if (sum == G) break;
    __builtin_amdgcn_s_sleep(1);
    if ((++sp & 255u) == 0u) { if (xb_ld(&bar[XB_TMO])) break; if (sp > XB_SPIN_CAP) { atomicAdd(&bar[XB_TMO], 1u); break; } }
  }
  nloc = mine > 0u ? mine : 1u; nx = cnt > 0u ? cnt : 1u;
}
__device__ __forceinline__ void xcd_barrier(const XcdBarrier& b) {
  asm volatile("s_waitcnt vmcnt(0)" ::: "memory");
  __syncthreads();
  if (threadIdx.x == 0) {
    unsigned* bar = b.bar;
    __builtin_amdgcn_s_waitcnt(0);
    unsigned nloc = b.st[0], nx = b.st[1];
    if (nloc == 0u) { xcd_barrier_complete(bar, b.x, nloc, nx); b.st[0] = nloc; b.st[1] = nx; }
    const unsigned old = xb_add(&bar[XB_XSUB(b.x)], 1u);
    const unsigned gen = old / nloc;
    if (old + 1u == (gen + 1u) * nloc) {
      __builtin_amdgcn_fence(__ATOMIC_RELEASE, "agent");
      asm volatile("s_waitcnt vmcnt(0)" ::: "memory");
      const unsigned og = xb_add(&bar[XB_TOP], 1u);
      const unsigned tg = og / nx;
      if (og + 1u == (tg + 1u) * nx) xb_add(&bar[XB_TOPGEN], 1u);
      else XB_SPIN(xb_ld(&bar[XB_TOPGEN]) == tg, bar);
      __builtin_amdgcn_fence(__ATOMIC_ACQUIRE, "agent");
      xb_add(&bar[XB_XGEN(b.x)], 1u);
      asm volatile("s_waitcnt vmcnt(0)" ::: "memory");
    } else {
      XB_SPIN(xb_ld(&bar[XB_XGEN(b.x)]) == gen, bar);
      __builtin_amdgcn_fence(__ATOMIC_ACQUIRE, "agent");
      asm volatile("s_waitcnt vmcnt(0)" ::: "memory");
    }
  }
  __syncthreads();
}

typedef __attribute__((address_space(4))) const Params CParams;
__device__ __forceinline__ const Params& get_params() {
  CParams* kp = (CParams*)__builtin_amdgcn_kernarg_segment_ptr();
  asm volatile("" : "+s"(kp));
  return *(const Params*)kp;
}
__global__ void __launch_bounds__(NT, 2) fwd_kernel(Params p_unused) {
  extern __shared__ __attribute__((aligned(16))) unsigned char lds_raw[];
  u16* smem = (u16*)lds_raw;
  LAS unsigned char* lds = (LAS unsigned char*)lds_raw;
  cg::grid_group grid = cg::this_grid();
  volatile LAS unsigned* xst = (volatile LAS unsigned*)(lds + STAGE_BYTES + SPARE_BYTES);
  if (threadIdx.x == 0) { xst[0] = 0u; xst[1] = 0u; }
  __syncthreads();
  XcdBarrier xb = xcd_barrier_post(get_params().bar, xst);
  float tfrac = 0.f;
  unsigned long long tq0 = 0; if (PROBE >= 30) tq0 = __builtin_amdgcn_s_memrealtime();
  prologue_phase(get_params(), (float*)smem);
  if (PROBE == 30) tfrac = (float)(__builtin_amdgcn_s_memrealtime() - tq0) / 40000.f;
  if (get_params().bar == nullptr) grid.sync();
  xcd_barrier(xb);
  if (PROBE == 31) tfrac = (float)(__builtin_amdgcn_s_memrealtime() - tq0) / 40000.f;
  const int vid = xcd_virtual_id(xb);
  { LAS float* rl = (LAS float*)(lds + ROPE_OFF); const float* rg = get_params().rope;
    for (int i = threadIdx.x; i < 2048; i += NT) rl[i] = rg[i];
    __syncthreads(); }
  if (PROBE == 9) { for (int i = 0; i < 10; i++) xcd_barrier(xb); }
#pragma unroll 1
  for (int l = 0; l < 2; l++) {
    if (PROBE >= 30) tq0 = __builtin_amdgcn_s_memrealtime();
    norm_phase(get_params(), l);
    if (PROBE == 32 && l == 0) tfrac = (float)(__builtin_amdgcn_s_memrealtime() - tq0) / 40000.f;
    if (PROBE == 3) { norm_phase(get_params(), l); if (l == 0) { xcd_barrier(xb); prologue_phase(get_params(), (float*)smem); } }
    xcd_barrier(xb);
    {
      const Params& p = get_params();
      SchedStd S; S.nM = NTOK / 256; S.nN = INC / 256; S.nwg = S.nM * S.nN; S.G = gridDim.x; S.c = vid;
      S.A = (const char*)p.H; S.B = (const char*)(p.Wt_in + (size_t)l * INC * 1024); S.tA = (size_t)256 * 1024 * 2; S.tB = (size_t)256 * 1024 * 2;
      EpiInproj E; E.pp = &p; E.l = l; E.part = (LAS float*)(lds + STAGE_BYTES); E.ropeL = (const LAS float*)(lds + ROPE_OFF);
      { float tr = gemm_phase(lds, 1024, S, E, PROBE == 22); if (l == 0 && (PROBE == 21 || PROBE == 22)) tfrac = tr; }
      if (PROBE == 1) { __syncthreads(); gemm_phase(lds, 1024, S, E); }
    }
    xcd_barrier(xb);
    if (PROBE >= 30) tq0 = __builtin_amdgcn_s_memrealtime();
    { float tr = mix_phase(get_params(), l, smem, vid); if ((PROBE == 35 || PROBE == 36) && l == 0) tfrac = tr; }
    if (PROBE == 33 && l == 0) tfrac = (float)(__builtin_amdgcn_s_memrealtime() - tq0) / 40000.f;
    xcd_barrier(xb);
    if (PROBE >= 30) tq0 = __builtin_amdgcn_s_memrealtime();
    lru2_phase(get_params(), l, smem);
    if (PROBE == 34 && l == 0) tfrac = (float)(__builtin_amdgcn_s_memrealtime() - tq0) / 40000.f;
    xcd_barrier(xb);
    {
      const Params& p = get_params();
      SchedBranch S; S.G = gridDim.x; S.c = vid; S.P_ = (const char*)p.GB; S.W_ = (const char*)(p.Wt_br + (size_t)l * 3 * 1024 * 512);
      EpiBranch E; E.pp = &p;
      { float tr = gemm_phase(lds, 512, S, E, PROBE == 24); if (l == 0 && (PROBE == 23 || PROBE == 24)) tfrac = tr; }
      if (PROBE == 2) { __syncthreads(); gemm_phase(lds, 512, S, E); }
    }
    xcd_barrier(xb);
    {
      const Params& p = get_params();
      SchedStd S; S.nM = NTOK / 256; S.nN = 4; S.nwg = S.nM * S.nN; S.G = gridDim.x; S.c = vid;
      S.A = (const char*)p.Y; S.B = (const char*)(p.Wt_out + (size_t)l * 1024 * 1024); S.tA = (size_t)256 * 1024 * 2; S.tB = (size_t)256 * 1024 * 2;
      EpiOut E; E.pp = &p; E.l = l;
      { float tr = gemm_phase(lds, 1024, S, E, PROBE == 26); if (l == 0 && (PROBE == 25 || PROBE == 26)) tfrac = tr; }
      if (PROBE == 8 && l == 0) { __syncthreads(); gemm_phase(lds, 1024, S, E); }
    }
    if (l == 0) xcd_barrier(xb);
  }
  if (PROBE >= 20) {
    xcd_barrier(xb);
    if (blockIdx.x == 0 && threadIdx.x == 0) { float* o = get_params().out + O_X + 4194304; *o += 0.42f + 0.45f * fminf(fmaxf(tfrac, 0.f), 1.f); }
  }
}

extern "C" void kernel_launch(void* const* d_in, const int* in_sizes, int n_in, void* d_out, int out_size, void* d_ws,
                              size_t ws_size, hipStream_t stream) {
  Params p{};
  const float** ip = (const float**)&p;
  for (int i = 0; i < 34; i++) ip[i] = (const float*)d_in[i];
  p.out = (float*)d_out;
  char* w = (char*)d_ws; size_t off = 0;
  auto take = [&](size_t bytes) { char* q = w + off; off += (bytes + 255) & ~(size_t)255; return q; };
  p.Wt_in = (u16*)take((size_t)2 * INC * 1024 * 2);
  p.Wt_br = (u16*)take((size_t)6 * 1024 * 512 * 2);
  p.Wt_out = (u16*)take((size_t)2 * 1024 * 1024 * 2);
  p.Y = (u16*)take((size_t)NTOK * 1024 * 2);
  p.P = (u16*)take((size_t)NTOK * PP * 2);
  p.VtA_ctx = p.Y;
  p.VtA_lat = p.VtA_ctx + (size_t)16 * 2 * 64 * 256;
  p.VtC_ctx = p.VtA_lat + (size_t)2 * 2 * 64 * 4096;
  p.VtC_lat = p.VtC_ctx + (size_t)16 * 4 * 128 * 256;
  p.cKa = (u16*)take((size_t)2 * 2 * 512 * 128 * 2);
  p.cVtA = (u16*)take((size_t)2 * 2 * 512 * 128 * 2);
  p.cKc = (u16*)take((size_t)2 * 2 * 512 * 512 * 2);
  p.cVtC = (u16*)take((size_t)2 * 2 * 512 * 512 * 2);
  p.mod = (float*)take((size_t)2 * 3 * 3072 * 4);
  p.rope = (float*)take((size_t)2048 * 4);
  p.lruTot = (float*)take((size_t)192 * 2 * 512 * 2 * 4);
  p.Wt_lru = (u16*)take((size_t)2 * 2 * 8 * 2 * 64 * 64 * 2);
  p.bar = (unsigned*)take((size_t)XCD_BAR_WORDS * 4);
  p.GB = (u16*)take((size_t)3 * NTOK * 512 * 2);
  p.H = p.GB;
  p.MG = (unsigned*)take((size_t)(48 * 4 * 3 + 1) * 16384 * 4);
  static int grid_blocks = 0;
  if (!grid_blocks) {
    int dev = 0, cus = 0;
    hipGetDevice(&dev);
    hipDeviceGetAttribute(&cus, hipDeviceAttributeMultiprocessorCount, dev);
    hipFuncSetAttribute((const void*)fwd_kernel, hipFuncAttributeMaxDynamicSharedMemorySize, LDS_BYTES);
    int per_cu = 0;
    hipOccupancyMaxActiveBlocksPerMultiprocessor(&per_cu, (const void*)fwd_kernel, NT, LDS_BYTES);
    (void)hipGetLastError();
    grid_blocks = cus;
  }
  hipMemsetAsync(p.bar, 0, (size_t)XCD_BAR_WORDS * 4, stream);
  void* args[] = {&p};
  hipLaunchCooperativeKernel((void*)fwd_kernel, dim3(grid_blocks), dim3(NT), args, LDS_BYTES, stream);
}
```

```cpp
#include <hip/hip_runtime.h>
#include <hip/hip_cooperative_groups.h>
#include <stdint.h>
#include <math.h>
namespace cg = cooperative_groups;

typedef unsigned short u16;
typedef __attribute__((ext_vector_type(8))) short bf16x8;
typedef __attribute__((ext_vector_type(4))) short bf16x4;
typedef __attribute__((ext_vector_type(16))) float f32x16;
typedef __attribute__((ext_vector_type(4))) float f32x4;
#define LAS __attribute__((address_space(3)))

#ifndef PROBE
#define PROBE 0
#endif
#define NT 512
constexpr int NTOK = 12288, NCTX = 4096;
constexpr int INC = 7424;
constexpr int PP = 3712;
constexpr int C_QA = 0, C_KA = 512, C_GA = 640, C_XB = 1152, C_GB = 1664, C_QC = 2176, C_KC = 2688, C_GC = 3200;
constexpr int LROW = 72;
constexpr int VROW = 68;
constexpr float EPS = 1e-6f;
constexpr int STAGE_BYTES = 131072;
constexpr int SPARE_BYTES = 8192;
constexpr int ROPE_OFF = STAGE_BYTES + SPARE_BYTES + 16;
constexpr int LDS_BYTES = ROPE_OFF + 8192;

constexpr size_t O_X = 0, O_KA = 12582912, O_VA = 13631488, O_KC = 14680064, O_VC = 18874368, O_ST = 23068672;

struct Params {
  const float *x_prompt, *x_sample, *cache_a_k, *cache_a_v, *cache_c_k, *cache_c_v, *state_lru, *c, *c_ctx,
      *norm_g, *mod_w, *mod_b, *w_in, *qn_a, *kn_a, *sink_a, *conv_w, *conv_b, *lru_wa, *lru_ba, *lru_wx, *lru_bx,
      *lru_lam, *qn_c, *kn_c, *lam_q1, *lam_k1, *lam_q2, *lam_k2, *subln_c, *w_br_a, *w_br_b, *w_br_c, *w_out;
  float* out;
  u16 *Wt_in, *Wt_br, *Wt_out, *H, *P, *VtA_ctx, *VtA_lat, *VtC_ctx, *VtC_lat, *cKa, *cVtA, *cKc, *cVtC;
  float *mod, *rope, *lruTot;
  u16 *Wt_lru;
  unsigned* bar;
  u16* Y;
  u16* GB;
  unsigned* MG;
};

__device__ __forceinline__ int tid_opaque() { int t = (int)threadIdx.x; asm volatile("" : "+v"(t)); return t; }
#define TIDX tid_opaque()
__device__ __forceinline__ u16 f2bf(float f) {
  uint32_t r; asm("v_cvt_pk_bf16_f32 %0, %1, %1" : "=v"(r) : "v"(f)); return (u16)(r & 0xffffu);
}
__device__ __forceinline__ float bf2f(u16 h) { return __uint_as_float(((uint32_t)h) << 16); }
__device__ __forceinline__ uint32_t pack2(float a, float b) { uint32_t r; asm("v_cvt_pk_bf16_f32 %0, %1, %2" : "=v"(r) : "v"(a), "v"(b)); return r; }
__device__ __forceinline__ float sigmoidf_(float x) { return __builtin_amdgcn_rcpf(1.f + __expf(-x)); }
__device__ __forceinline__ float siluf_(float x) { return x * __builtin_amdgcn_rcpf(1.f + __expf(-x)); }
__device__ __forceinline__ f32x16 mfma32(bf16x8 a, bf16x8 b, f32x16 c) {
  return __builtin_amdgcn_mfma_f32_32x32x16_bf16(a, b, c, 0, 0, 0);
}
__device__ __forceinline__ float shflx(float v, int mask, int lane) {
  return __builtin_bit_cast(float, __builtin_amdgcn_ds_bpermute((lane ^ mask) << 2, __builtin_bit_cast(int, v)));
}
__device__ __forceinline__ float lo_bf(uint32_t w) { return __uint_as_float(w << 16); }
__device__ __forceinline__ float hi_bf(uint32_t w) { return __uint_as_float(w & 0xffff0000u); }

__device__ __forceinline__ size_t tm_off(int r, int k, int KT) {
  return ((size_t)((r >> 8) * KT + (k >> 6)) * 256 + (r & 255)) * 64 + (k & 63);
}
__device__ __forceinline__ void transpose_tile(const float* __restrict__ src, int spitch, u16* __restrict__ dst, int dpitch,
                               int r0, int c0, float* sm, int KT = 0) {
  const int tid = TIDX;
#pragma unroll
  for (int i = 0; i < 2; i++) {
    int c = tid + i * NT; int r = c >> 4, q = c & 15;
    float4 v = *(const float4*)(src + (size_t)(r0 + r) * spitch + c0 + q * 4);
    float* d = sm + r * 65 + q * 4;
    d[0] = v.x; d[1] = v.y; d[2] = v.z; d[3] = v.w;
  }
  __syncthreads();
  {
    int c = tid; int cc = c >> 3, q = c & 7;
    uint32_t w[4];
#pragma unroll
    for (int j = 0; j < 4; j++) w[j] = pack2(sm[(q * 8 + 2 * j) * 65 + cc], sm[(q * 8 + 2 * j + 1) * 65 + cc]);
    uint4 v; v.x = w[0]; v.y = w[1]; v.z = w[2]; v.w = w[3];
    if (KT) *(uint4*)(dst + tm_off(c0 + cc, r0 + q * 8, KT)) = v;
    else *(uint4*)(dst + (size_t)(c0 + cc) * dpitch + r0 + q * 8) = v;
  }
  __syncthreads();
}

__device__ __forceinline__ void transpose_wide(const float* __restrict__ src, int spitch, u16* __restrict__ dst,
                                               int k0, int n0, float* sm, int KT) {
  const int tid = TIDX;
  float4 v[8];
#pragma unroll
  for (int i = 0; i < 8; i++) { int c = tid + i * NT; int r = c >> 6, q = c & 63; v[i] = *(const float4*)(src + (size_t)(k0 + r) * spitch + n0 + q * 4); }
#pragma unroll
  for (int i = 0; i < 8; i++) { int c = tid + i * NT; int r = c >> 6, q = c & 63; float* d = sm + r * 257 + q * 4; d[0] = v[i].x; d[1] = v[i].y; d[2] = v[i].z; d[3] = v[i].w; }
  __syncthreads();
#pragma unroll
  for (int i = 0; i < 4; i++) {
    int c = tid + i * NT; int nn = c >> 3, q = c & 7;
    uint4 o;
    o.x = pack2(sm[(q * 8 + 0) * 257 + nn], sm[(q * 8 + 1) * 257 + nn]);
    o.y = pack2(sm[(q * 8 + 2) * 257 + nn], sm[(q * 8 + 3) * 257 + nn]);
    o.z = pack2(sm[(q * 8 + 4) * 257 + nn], sm[(q * 8 + 5) * 257 + nn]);
    o.w = pack2(sm[(q * 8 + 6) * 257 + nn], sm[(q * 8 + 7) * 257 + nn]);
    *(uint4*)(dst + tm_off(n0 + nn, k0 + q * 8, KT)) = o;
  }
  __syncthreads();
}

__device__ __forceinline__ void mod_item(const Params& p, int it, float* sm) {
  const int tid = TIDX;
  const int l = it / 48, n0 = (it % 48) * 64;
  float* sv = sm;
  float* red = sm + 3072;
  for (int e = tid; e < 3072; e += NT) {
    int v = e >> 10, k = e & 1023;
    float x = (v == 0) ? p.c_ctx[k] : p.c[(v - 1) * 1024 + k];
    sv[e] = siluf_(x);
  }
  __syncthreads();
  const int col = tid & 63, kg = tid >> 6;
  const float* w = p.mod_w + (size_t)l * 1024 * 3072 + n0 + col;
  float a0 = 0, a1 = 0, a2 = 0;
#pragma unroll 1
  for (int kb = kg * 128; kb < kg * 128 + 128; kb += 32) {
    float wv[32];
#pragma unroll
    for (int j = 0; j < 32; j++) wv[j] = w[(size_t)(kb + j) * 3072];
#pragma unroll
    for (int j = 0; j < 32; j++) { a0 += sv[kb + j] * wv[j]; a1 += sv[1024 + kb + j] * wv[j]; a2 += sv[2048 + kb + j] * wv[j]; }
  }
  red[(kg * 3 + 0) * 64 + col] = a0; red[(kg * 3 + 1) * 64 + col] = a1; red[(kg * 3 + 2) * 64 + col] = a2;
  __syncthreads();
  if (tid < 192) {
    int v = tid >> 6, c = tid & 63;
    float s = p.mod_b[l * 3072 + n0 + c];
#pragma unroll
    for (int g = 0; g < 8; g++) s += red[(g * 3 + v) * 64 + c];
    p.mod[(l * 3 + v) * 3072 + n0 + c] = s;
  }
  __syncthreads();
}

__device__ __forceinline__ void prologue_phase(const Params& p, float* sm) {
  constexpr int N_MOD = 96, N_ROPE = 1, N_WIN = 2 * 16 * 29, N_WBR = 6 * 8 * 4, N_WOUT = 2 * 16 * 4;
  constexpr int N_CK = 64 + 256, N_CVA = 4 * 16, N_CVC = 4 * 64, N_LW = 64;
  constexpr int E0 = N_MOD, E1 = E0 + N_ROPE, E2 = E1 + N_WIN, E3 = E2 + N_WBR, E4 = E3 + N_WOUT, E5 = E4 + N_CK,
                E6 = E5 + N_CVA, E7 = E6 + N_CVC, E8 = E7 + N_LW;
  const int tid = TIDX;
  for (int it = blockIdx.x; it < E8; it += gridDim.x) {
    if (it < E0) {
      mod_item(p, it, sm);
    } else if (it < E1) {
      for (int e = tid; e < 1024; e += NT) {
        int pos = e >> 4, f = e & 15;
        float inv = powf(10000.f, -(float)f / 16.f);
        float ang = (float)pos * inv;
        p.rope[e] = cosf(ang); p.rope[1024 + e] = sinf(ang);
      }
    } else if (it < E2) {
      int j = it - E1; int l = j / (16 * 29); int r = j % (16 * 29);
      int kt = r / 29, pn = r % 29;
      transpose_wide(p.w_in + (size_t)l * 1024 * INC, INC, p.Wt_in + (size_t)l * INC * 1024, kt * 64, pn * 256, sm, 16);
    } else if (it < E3) {
      int j = it - E2; int m = j / 32; int r = j % 32;
      int l = m / 3, i = m % 3;
      const float* src = (i == 0 ? p.w_br_a : (i == 1 ? p.w_br_b : p.w_br_c)) + (size_t)l * 512 * 1024;
      int kt = r / 4, pn = r % 4;
      transpose_wide(src, 1024, p.Wt_br + (size_t)m * 1024 * 512, kt * 64, pn * 256, sm, 8);
    } else if (it < E4) {
      int j = it - E3; int l = j / 64; int r = j % 64;
      int kt = r / 4, pn = r % 4;
      transpose_wide(p.w_out + (size_t)l * 1024 * 1024, 1024, p.Wt_out + (size_t)l * 1024 * 1024, kt * 64, pn * 256, sm, 16);
    } else if (it < E5) {
      int j = it - E4;
      const float* src; u16* dst; size_t off;
      if (j < 64) { src = p.cache_a_k; dst = p.cKa; off = (size_t)j * 4096; }
      else { src = p.cache_c_k; dst = p.cKc; off = (size_t)(j - 64) * 4096; }
      size_t e = off + (size_t)tid * 8;
      float4 a = *(const float4*)(src + e), b = *(const float4*)(src + e + 4);
      uint4 v; v.x = pack2(a.x, a.y); v.y = pack2(a.z, a.w); v.z = pack2(b.x, b.y); v.w = pack2(b.z, b.w);
      *(uint4*)(dst + e) = v;
    } else if (it < E6) {
      int j = it - E5; int bl = j / 16; int r = j % 16;
      int rt = r / 2, ct = r % 2;
      transpose_tile(p.cache_a_v + (size_t)bl * 512 * 128, 128, p.cVtA + (size_t)bl * 128 * 512, 512, rt * 64, ct * 64, sm);
    } else if (it < E7) {
      int j = it - E6; int bl = j / 64; int r = j % 64;
      int rt = r / 8, ct = r % 8;
      transpose_tile(p.cache_c_v + (size_t)bl * 512 * 512, 512, p.cVtC + (size_t)bl * 512 * 512, 512, rt * 64, ct * 64, sm);
    } else {
      int j = it - E7; int ldn = j >> 1, g = j & 1;
      transpose_tile((g ? p.lru_wx : p.lru_wa) + (size_t)ldn * 4096, 64, p.Wt_lru + (size_t)(ldn * 2 + g) * 4096, 64, 0, 0, sm);
    }
  }
}

__device__ __forceinline__ void norm_phase(const Params& p, int l) {
  const int tid = TIDX, lane = tid & 63, wid = tid >> 6;
  const float* g = p.norm_g + l * 1024;
  for (int it = blockIdx.x; it < NTOK / 8; it += gridDim.x) {
    int row = it * 8 + wid;
    const float* x;
    if (l == 0) x = (row < NCTX) ? p.x_prompt + (size_t)row * 1024 : p.x_sample + (size_t)(row - NCTX) * 1024;
    else x = p.out + O_X + (size_t)row * 1024;
    int v = (row < NCTX) ? 0 : 1 + (row - NCTX) / 4096;
    const float* md = p.mod + (l * 3 + v) * 3072;
    float4 xv[4], gv[4], sh[4], sc[4]; float ss = 0;
#pragma unroll
    for (int i = 0; i < 4; i++) {
      const int c = i * 256 + lane * 4;
      xv[i] = *(const float4*)(x + c);
      gv[i] = *(const float4*)(g + c); sh[i] = *(const float4*)(md + c); sc[i] = *(const float4*)(md + 1024 + c);
    }
    __builtin_amdgcn_sched_barrier(0);
#pragma unroll
    for (int i = 0; i < 4; i++) ss += xv[i].x * xv[i].x + xv[i].y * xv[i].y + xv[i].z * xv[i].z + xv[i].w * xv[i].w;
#pragma unroll
    for (int o = 32; o > 0; o >>= 1) ss += shflx(ss, o, lane);
    float rinv = rsqrtf(ss * (1.f / 1024.f) + EPS);
#pragma unroll
    for (int i = 0; i < 4; i++) {
      int c = i * 256 + lane * 4;
      float h0 = xv[i].x * rinv * gv[i].x * (1.f + sc[i].x) + sh[i].x;
      float h1 = xv[i].y * rinv * gv[i].y * (1.f + sc[i].y) + sh[i].y;
      float h2 = xv[i].z * rinv * gv[i].z * (1.f + sc[i].z) + sh[i].z;
      float h3 = xv[i].w * rinv * gv[i].w * (1.f + sc[i].w) + sh[i].w;
      uint2 o2; o2.x = pack2(h0, h1); o2.y = pack2(h2, h3);
      *(uint2*)(p.H + tm_off(row, c, 16)) = o2;
    }
  }
}

constexpr int G_BK = 64, G_HALF = 128, G_HTB = G_HALF * G_BK * 2;
__device__ __forceinline__ int lds_byte(int r, int c) {
  const int st = (r >> 4) * 2 + (c >> 5), rr = r & 15, cc = c & 31, ob = rr * 64 + cc * 2;
  return st * 1024 + (ob ^ (((ob >> 9) & 1) << 5));
}
__device__ __forceinline__ void stage_rc(int b, int& R, int& C) {
  const int st = b / 1024, sb = b % 1024, swz = sb ^ (((sb >> 9) & 1) << 5);
  R = (st >> 1) * 16 + swz / 64; C = (st & 1) * 32 + (swz % 64) / 2;
}
struct Unit { int pm, pn, seg; };

struct SchedStd {
  int nM, nN, nwg, G, c; const char* A; const char* B; size_t tA, tB;
  __device__ __forceinline__ bool next(int i, Unit& u) const {
    const long L = (long)i * G + c; if (L >= nwg) return false;
    const int wgid = (int)L;
    const int nig = 8 * nN, gid = wgid / nig, fm = gid * 8, gsz = (nM - fm) < 8 ? (nM - fm) : 8;
    u.pm = fm + ((wgid % nig) % gsz); u.pn = (wgid % nig) / gsz; u.seg = 0; return true;
  }
  __device__ __forceinline__ const char* aptr(const Unit& u) const { return A + (size_t)u.pm * tA; }
  __device__ __forceinline__ const char* bptr(const Unit& u) const { return B + (size_t)u.pn * tB; }
};
struct SchedBranch {
  int G, c; const char* P_; const char* W_;
  __device__ __forceinline__ bool next(int i, Unit& u) const {
    if (G == 256) {
      if (i >= 3) return false;
      const int xcd = c >> 5, j = c & 31;
      if (j >= 24) return false;
      u.seg = i; u.pm = xcd * 6 + (j >> 2); u.pn = j & 3; return true;
    }
    const int tile = (i / 3) * G + c; if (tile >= 192) return false;
    u.seg = i % 3; u.pm = tile >> 2; u.pn = tile & 3; return true;
  }
  __device__ __forceinline__ const char* aptr(const Unit& u) const { return P_ + (size_t)((u.seg * 48 + u.pm) * 8) * 32768; }
  __device__ __forceinline__ const char* bptr(const Unit& u) const { return W_ + (size_t)((u.seg * 4 + u.pn) * 8) * 32768; }
};

template <class Epi, class Sched>
__device__ __forceinline__ float gemm_phase(LAS unsigned char* lds, const int K, const Sched& S, const Epi& E, int tmode = 0) {
  unsigned long long t_ph0 = 0, t_epi = 0; if (PROBE >= 20) t_ph0 = __builtin_amdgcn_s_memrealtime();
  const int tid = TIDX, wid = __builtin_amdgcn_readfirstlane(tid >> 6), lane = tid & 63, wr = wid >> 2, wc = wid & 3, fr = lane & 15, fq = lane >> 4;
  const int nt = K / G_BK;
  unsigned voffA[2], voffB[2];
#pragma unroll
  for (int i = 0; i < 2; ++i) { int R, C; stage_rc(tid * 16 + i * 8192, R, C);
    voffA[i] = (unsigned)(R * 64 + C) * 2u; voffB[i] = voffA[i]; }
  const size_t kstep = (size_t)32768;
  const size_t hA = (size_t)16384, hB = (size_t)16384;
  const unsigned ldsw = (unsigned)wid * 1024u;
  const int aoff = lds_byte(wr * 64 + fr, fq * 8), boff = lds_byte(wc * 32 + fr, fq * 8);
#define G_SA(b, h) (((b) * 2 + (h)) * G_HTB)
#define G_SB(b, h) ((4 + (b) * 2 + (h)) * G_HTB)
#define G_STAGE(bufoff, gbase, voff) do { _Pragma("unroll") for (int _i = 0; _i < 2; ++_i) \
    __builtin_amdgcn_global_load_lds((const unsigned*)((const char*)(gbase) + (voff)[_i]), (LAS unsigned*)(lds + (bufoff) + ldsw + _i * 8192), 16, 0, 0); } while (0)
#define G_LDA(dst, b, h) do { _Pragma("unroll") for (int m = 0; m < 4; ++m) _Pragma("unroll") for (int k = 0; k < 2; ++k) dst[m][k] = *(const LAS bf16x8*)(lds + G_SA(b, h) + aoff + m * 2048 + k * 1024); } while (0)
#define G_LDB(dst, b, h) do { _Pragma("unroll") for (int n = 0; n < 2; ++n) _Pragma("unroll") for (int k = 0; k < 2; ++k) dst[n][k] = *(const LAS bf16x8*)(lds + G_SB(b, h) + boff + n * 2048 + k * 1024); } while (0)
#define G_MMA(ai, bj, At, Bt) do { __builtin_amdgcn_s_setprio(1); _Pragma("unroll") for (int m = 0; m < 4; ++m) _Pragma("unroll") for (int n = 0; n < 2; ++n) _Pragma("unroll") for (int k = 0; k < 2; ++k) \
    acc[ai][bj][m][n] = __builtin_amdgcn_mfma_f32_16x16x32_bf16(Bt[n][k], At[m][k], acc[ai][bj][m][n], 0, 0, 0); __builtin_amdgcn_s_setprio(0); } while (0)
#define G_WAIT_V(n) asm volatile("s_waitcnt vmcnt(" #n ")" ::: "memory")
#define G_WAIT_L(n) asm volatile("s_waitcnt lgkmcnt(" #n ")" ::: "memory")
#define G_BAR __builtin_amdgcn_s_barrier()
#define G_SCHED __builtin_amdgcn_sched_barrier(0)
  Unit cur, nxt; int ui = 0;
  if (!S.next(0, cur)) return 0.f;
  f32x4 acc[2][2][4][2];
#pragma unroll
  for (int a = 0; a < 2; ++a)
#pragma unroll
    for (int b = 0; b < 2; ++b)
#pragma unroll
      for (int m = 0; m < 4; ++m)
#pragma unroll
        for (int n = 0; n < 2; ++n) acc[a][b][m][n] = (f32x4){0.f, 0.f, 0.f, 0.f};
  bf16x8 At[4][2], B0[2][2], B1[2][2];
  const char* cA = S.aptr(cur); const char* cB = S.bptr(cur);
  G_STAGE(G_SB(0, 0), cB, voffB); G_STAGE(G_SA(0, 0), cA, voffA); G_STAGE(G_SB(0, 1), cB + hB, voffB); G_STAGE(G_SA(0, 1), cA + hA, voffA);
  if (wr == 1) G_BAR;
  G_WAIT_V(4); G_BAR;
  G_STAGE(G_SB(1, 0), cB + kstep, voffB); G_STAGE(G_SA(1, 0), cA + kstep, voffA); G_STAGE(G_SB(1, 1), cB + hB + kstep, voffB);
  G_WAIT_V(6); G_BAR;
  for (;;) {
    const bool has_next = S.next(ui + 1, nxt);
    const char* nA = has_next ? S.aptr(nxt) : cA; const char* nB = has_next ? S.bptr(nxt) : cB;
    for (int t = 0; t < nt; t += 2) {
      const bool last = (t == nt - 2);
      const char* a1 = cA + (size_t)(t + 1) * kstep;
      const char* a2 = last ? nA : cA + (size_t)(t + 2) * kstep; const char* b2 = last ? nB : cB + (size_t)(t + 2) * kstep;
      const char* a3 = a2 + kstep; const char* b3 = b2 + kstep;
      G_LDB(B0, 0, 0); G_SCHED; G_LDA(At, 0, 0); G_STAGE(G_SA(1, 1), a1 + hA, voffA);
      G_WAIT_L(8); G_BAR; G_WAIT_L(0); G_MMA(0, 0, At, B0); G_BAR; G_SCHED;
      G_LDB(B1, 0, 1); G_STAGE(G_SB(0, 0), b2, voffB);
      G_BAR; G_WAIT_L(0); G_MMA(0, 1, At, B1); G_BAR;
      G_LDA(At, 0, 1); G_STAGE(G_SA(0, 0), a2, voffA);
      G_BAR; G_WAIT_L(0); G_MMA(1, 0, At, B0); G_BAR; G_SCHED;
      G_STAGE(G_SB(0, 1), b2 + hB, voffB);
      G_WAIT_V(6); G_BAR; G_MMA(1, 1, At, B1); G_BAR;
      G_LDB(B0, 1, 0); G_SCHED; G_LDA(At, 1, 0); G_STAGE(G_SA(0, 1), a2 + hA, voffA);
      G_WAIT_L(8); G_BAR; G_WAIT_L(0); G_MMA(0, 0, At, B0); G_BAR; G_SCHED;
      G_LDB(B1, 1, 1); G_STAGE(G_SB(1, 0), b3, voffB);
      G_BAR; G_WAIT_L(0); G_MMA(0, 1, At, B1); G_BAR;
      G_LDA(At, 1, 1); G_STAGE(G_SA(1, 0), a3, voffA);
      G_BAR; G_WAIT_L(0); G_MMA(1, 0, At, B0); G_BAR; G_SCHED;
      G_STAGE(G_SB(1, 1), b3 + hB, voffB);
      G_WAIT_V(6); G_BAR; G_MMA(1, 1, At, B1); G_BAR;
    }
    unsigned long long t_e0 = 0; if (PROBE >= 20) t_e0 = __builtin_amdgcn_s_memrealtime();
    const bool reset = E(acc, cur, wr, wc, fr, fq);
    if (PROBE >= 20) { asm volatile("s_waitcnt vmcnt(0)" ::: "memory"); t_epi += __builtin_amdgcn_s_memrealtime() - t_e0; }
    if (!has_next) break;
    if (reset) {
#pragma unroll
      for (int a = 0; a < 2; ++a)
#pragma unroll
        for (int b = 0; b < 2; ++b)
#pragma unroll
          for (int m = 0; m < 4; ++m)
#pragma unroll
            for (int n = 0; n < 2; ++n) acc[a][b][m][n] = (f32x4){0.f, 0.f, 0.f, 0.f};
    }
    cur = nxt; cA = nA; cB = nB; ++ui;
  }
  G_WAIT_V(0);
  if (wr == 0) G_BAR;
  G_BAR;
  float tres = 0.f;
  if (PROBE >= 20) {
    const unsigned long long tot = __builtin_amdgcn_s_memrealtime() - t_ph0;
    tres = (tmode == 0) ? (float)t_epi / (float)tot : (float)tot / 40000.f;
  }
#undef G_SA
#undef G_SB
#undef G_STAGE
#undef G_LDA
#undef G_LDB
#undef G_MMA
#undef G_WAIT_V
#undef G_WAIT_L
#undef G_BAR
#undef G_SCHED
  return tres;
}

struct EpiInproj {
  const Params* pp; int l; LAS float* part; const LAS float* ropeL;
  __device__ __forceinline__ bool operator()(f32x4 (&acc)[2][2][4][2], const Unit& u, int wr, int wc, int fr, int fq) const {
    const Params& p = *pp;
    asm volatile("" : "+v"(fr), "+v"(fq));
    const int lane = fr + 16 * fq; (void)lane;
    const int oc0 = u.pn * 256;
    const bool isctx = u.pm < 16;
    const bool qkU = (oc0 < 768) || (oc0 >= 2304 && oc0 < 3328);
    float rinv[2][4][2];
    if (qkU) {
#pragma unroll
      for (int ai = 0; ai < 2; ai++)
#pragma unroll
        for (int m = 0; m < 4; m++)
#pragma unroll
          for (int bj = 0; bj < 2; bj++) {
            f32x4 a = acc[ai][bj][m][0], b = acc[ai][bj][m][1];
            float ss = a[0] * a[0] + a[1] * a[1] + a[2] * a[2] + a[3] * a[3] + b[0] * b[0] + b[1] * b[1] + b[2] * b[2] + b[3] * b[3];
            ss += shflx(ss, 16, lane); ss += shflx(ss, 32, lane);
            rinv[ai][m][bj] = ss;
            if (fq == 0) part[((ai * 128 + wr * 64 + m * 16 + fr) * 2 + bj) * 4 + wc] = ss;
          }
      asm volatile("s_waitcnt lgkmcnt(0)" ::: "memory");
      __builtin_amdgcn_s_barrier();
      asm volatile("" ::: "memory");
#pragma unroll
      for (int ai = 0; ai < 2; ai++)
#pragma unroll
        for (int m = 0; m < 4; m++)
#pragma unroll
          for (int bj = 0; bj < 2; bj++) {
            float o = part[((ai * 128 + wr * 64 + m * 16 + fr) * 2 + bj) * 4 + (wc ^ 1)];
            rinv[ai][m][bj] = rsqrtf((rinv[ai][m][bj] + o) * (1.f / 64.f) + EPS);
          }
    }
#pragma unroll
    for (int bj = 0; bj < 2; bj++) {
      const int oc = oc0 + bj * 128;
      if (oc == 640 || (oc >= 3328 && oc < 3840)) {
        const bool isA = (oc == 640);
        const int cb = isA ? 0 : (oc - 3328);
        const int nvec = isA ? 128 : 512;
#pragma unroll
        for (int ai = 0; ai < 2; ai++)
#pragma unroll
          for (int m = 0; m < 4; m++) {
            const int row = u.pm * 256 + ai * 128 + wr * 64 + m * 16 + fr;
            int b, t, T; u16* vt;
            if (isctx) { b = row >> 8; t = row & 255; T = 256; vt = isA ? p.VtA_ctx : p.VtC_ctx; }
            else { int rr = row - NCTX; b = rr >> 12; t = rr & 4095; T = 4096; vt = isA ? p.VtA_lat : p.VtC_lat; }
#pragma unroll
            for (int n = 0; n < 2; n++) {
              const int d = cb + wc * 32 + n * 16 + fq * 4;
              f32x4 v = acc[ai][bj][m][n];
#pragma unroll
              for (int j = 0; j < 4; j++) vt[((size_t)b * nvec + d + j) * T + t] = f2bf(v[j]);
              if (isctx) {
                float* o = p.out + (isA ? O_VA : O_VC) + ((size_t)(b * 2 + l) * 256 + t) * nvec + d;
                *(f32x4*)o = v;
              }
            }
          }
      } else {
        const int pc = (oc < 640) ? oc : (oc < 3328 ? oc - 128 : oc - 640);
        const bool is_qa = oc < 512, is_ka = (oc == 512);
        const bool is_qc = (oc >= 2304 && oc < 2816), is_kc = (oc >= 2816 && oc < 3328);
        if (is_qa || is_ka || is_qc || is_kc) {
          const float* gn = (is_qa ? p.qn_a : is_ka ? p.kn_a : is_qc ? p.qn_c : p.kn_c) + l * 64 + (wc & 1) * 32 + fq * 4;
          const f32x4 g0 = *(const f32x4*)gn, g1 = *(const f32x4*)(gn + 16);
          const float qs = (is_qa || is_qc) ? 0.18033688011112042f : 1.f;
#pragma unroll
          for (int ai = 0; ai < 2; ai++)
#pragma unroll
            for (int m = 0; m < 4; m++) {
              const int row = u.pm * 256 + ai * 128 + wr * 64 + m * 16 + fr;
              const float ri = rinv[ai][m][bj];
              f32x4 x1 = acc[ai][bj][m][0] * ri * g0, x2 = acc[ai][bj][m][1] * ri * g1;
              if (!isctx) {
                const int t = (row - NCTX) & 4095;
                const int pos = (wc & 1) ? (t & 63) : (t >> 6);
                const f32x4 cs = *(const LAS f32x4*)(ropeL + pos * 16 + fq * 4), sn = *(const LAS f32x4*)(ropeL + 1024 + pos * 16 + fq * 4);
                f32x4 y1 = x1 * cs - x2 * sn, y2 = x2 * cs + x1 * sn;
                x1 = y1; x2 = y2;
              } else if (is_ka || is_kc) {
                const int b = row >> 8, t = row & 255;
                float* o = is_ka ? p.out + O_KA + ((size_t)(b * 2 + l) * 256 + t) * 128 + wc * 32 + fq * 4
                                 : p.out + O_KC + ((size_t)(b * 2 + l) * 256 + t) * 512 + (oc - 2816) + wc * 32 + fq * 4;
                *(f32x4*)o = x1; *(f32x4*)(o + 16) = x2;
              }
              x1 = x1 * qs; x2 = x2 * qs;
              u16* po = p.P + (size_t)row * PP + pc + wc * 32 + fq * 4;
              *(uint2*)po = make_uint2(pack2(x1[0], x1[1]), pack2(x1[2], x1[3]));
              *(uint2*)(po + 16) = make_uint2(pack2(x2[0], x2[1]), pack2(x2[2], x2[3]));
            }
        } else {
          const int mode = (oc >= 4352) ? 2 : ((oc >= 1280 && oc < 1792) ? 0 : 1);
          if (mode == 2) {
            const int pj = u.pn - 17, seg = pj >> 2, pn4 = pj & 3;
            unsigned* mg = p.MG + ((size_t)((u.pm * 4 + pn4) * 3 + seg) * 8 + (wr * 4 + wc)) * 2048 + lane;
#pragma unroll
            for (int ai = 0; ai < 2; ai++)
#pragma unroll
              for (int m = 0; m < 4; m++)
#pragma unroll
                for (int n = 0; n < 2; n++) {
                  f32x4 v = acc[ai][bj][m][n];
                  const unsigned q0 = (unsigned)(sigmoidf_(v[0]) * 254.f + 1.5f), q1 = (unsigned)(sigmoidf_(v[1]) * 254.f + 1.5f);
                  const unsigned q2 = (unsigned)(sigmoidf_(v[2]) * 254.f + 1.5f), q3 = (unsigned)(sigmoidf_(v[3]) * 254.f + 1.5f);
                  mg[(((ai * 4 + m) * 2 + bj) * 2 + n) * 64] = q0 | (q1 << 8) | (q2 << 16) | (q3 << 24);
                }
          } else
#pragma unroll
          for (int ai = 0; ai < 2; ai++)
#pragma unroll
            for (int m = 0; m < 4; m++) {
              const int row = u.pm * 256 + ai * 128 + wr * 64 + m * 16 + fr;
              u16* po = p.P + (size_t)row * PP + pc + wc * 32 + fq * 4;
#pragma unroll
              for (int n = 0; n < 2; n++) {
                f32x4 v = acc[ai][bj][m][n];
                if (mode == 1) { v[0] = siluf_(v[0]); v[1] = siluf_(v[1]); v[2] = siluf_(v[2]); v[3] = siluf_(v[3]); }
                else if (mode == 2) { v[0] = sigmoidf_(v[0]); v[1] = sigmoidf_(v[1]); v[2] = sigmoidf_(v[2]); v[3] = sigmoidf_(v[3]); }
                *(uint2*)(po + n * 16) = make_uint2(pack2(v[0], v[1]), pack2(v[2], v[3]));
              }
            }
        }
      }
    }
    return true;
  }
};

struct EpiBranch {
  const Params* pp;
  __device__ __forceinline__ bool operator()(f32x4 (&acc)[2][2][4][2], const Unit& u, int wr, int wc, int fr, int fq) const {
    const Params& p = *pp;
    asm volatile("" : "+v"(fr), "+v"(fq));
    const int lane = fr + 16 * fq;
    const int seg = u.seg;
    const unsigned* mg = p.MG + ((size_t)((u.pm * 4 + u.pn) * 3 + seg) * 8 + (wr * 4 + wc)) * 2048 + lane;
    const float sel = (seg < 2) ? 1.f : 0.f;
#pragma unroll
    for (int hq = 0; hq < 4; hq++) {
      unsigned a[8], b[8];
#pragma unroll
      for (int q = 0; q < 8; q++) { a[q] = mg[(hq * 8 + q) * 64]; b[q] = mg[(hq * 8 + q) * 64 + 8 * 2048]; }
      __builtin_amdgcn_sched_barrier(0);
#pragma unroll
      for (int q = 0; q < 8; q++) {
        const int ai = hq >> 1, m = (hq & 1) * 2 + (q >> 2), bj = (q >> 1) & 1, n = q & 1;
        f32x4 f = {(float)(a[q] & 255u), (float)((a[q] >> 8) & 255u), (float)((a[q] >> 16) & 255u), (float)(a[q] >> 24)};
        f32x4 g = {(float)(b[q] & 255u), (float)((b[q] >> 8) & 255u), (float)((b[q] >> 16) & 255u), (float)(b[q] >> 24)};
        g = g * sel + (1.f - sel) * 255.f;
        f[0] *= __builtin_amdgcn_rcpf(g[0]); f[1] *= __builtin_amdgcn_rcpf(g[1]); f[2] *= __builtin_amdgcn_rcpf(g[2]); f[3] *= __builtin_amdgcn_rcpf(g[3]);
        acc[ai][bj][m][n] = acc[ai][bj][m][n] * f;
      }
    }
    if (seg < 2) return false;
#pragma unroll
    for (int ai = 0; ai < 2; ai++)
#pragma unroll
      for (int m = 0; m < 4; m++) {
        const int row = u.pm * 256 + ai * 128 + wr * 64 + m * 16 + fr;
#pragma unroll
        for (int bj = 0; bj < 2; bj++)
#pragma unroll
          for (int n = 0; n < 2; n++) {
            const int col = u.pn * 256 + bj * 128 + wc * 32 + n * 16 + fq * 4;
            const f32x4 v = acc[ai][bj][m][n];
            *(uint2*)(p.Y + tm_off(row, col, 16)) = make_uint2(pack2(v[0], v[1]), pack2(v[2], v[3]));
          }
      }
    return true;
  }
};

struct EpiOut {
  const Params* pp; int l;
  __device__ __forceinline__ bool operator()(f32x4 (&acc)[2][2][4][2], const Unit& u, int wr, int wc, int fr, int fq) const {
    const Params& p = *pp;
    asm volatile("" : "+v"(fr), "+v"(fq));
    const int v = (u.pm < 16) ? 0 : 1 + (u.pm - 16) / 16;
    const float* gt = p.mod + (l * 3 + v) * 3072 + 2048 + u.pn * 256 + wc * 32 + fq * 4;
    const float* xsrc = (l == 0) ? ((u.pm < 16) ? p.x_prompt + (size_t)u.pm * 256 * 1024 : p.x_sample + (size_t)(u.pm - 16) * 256 * 1024)
                                 : p.out + O_X + (size_t)u.pm * 256 * 1024;
    float* odst = p.out + O_X + (size_t)u.pm * 256 * 1024;
    const int cbase = u.pn * 256 + wc * 32 + fq * 4;
    f32x4 gv[2][2];
#pragma unroll
    for (int bj = 0; bj < 2; bj++)
#pragma unroll
      for (int n = 0; n < 2; n++) gv[bj][n] = *(const f32x4*)(gt + bj * 128 + n * 16);
#pragma unroll
    for (int ai = 0; ai < 2; ai++)
#pragma unroll
      for (int mh = 0; mh < 2; mh++) {
        f32x4 xv[2][2][2];
#pragma unroll
        for (int mm = 0; mm < 2; mm++)
#pragma unroll
          for (int bj = 0; bj < 2; bj++)
#pragma unroll
            for (int n = 0; n < 2; n++)
              xv[mm][bj][n] = *(const f32x4*)(xsrc + (size_t)(ai * 128 + wr * 64 + (mh * 2 + mm) * 16 + fr) * 1024 + cbase + bj * 128 + n * 16);
#pragma unroll
        for (int mm = 0; mm < 2; mm++)
#pragma unroll
          for (int bj = 0; bj < 2; bj++)
#pragma unroll
            for (int n = 0; n < 2; n++)
              *(f32x4*)(odst + (size_t)(ai * 128 + wr * 64 + (mh * 2 + mm) * 16 + fr) * 1024 + cbase + bj * 128 + n * 16) = xv[mm][bj][n] + gv[bj][n] * acc[ai][bj][mh * 2 + mm][n];
      }
    return true;
  }
};

template <bool MASK>
__device__ __forceinline__ void fs_scores(const u16* Ks, const bf16x8 (&qf)[4], f32x16 (&s)[2], int lane, int kpos0, int qpos, int T) {
  const int r = lane & 31, h = lane >> 5;
  {
    bf16x8 kf[2][4];
#pragma unroll
    for (int sub = 0; sub < 2; sub++)
#pragma unroll
      for (int ks = 0; ks < 4; ks++) kf[sub][ks] = *(const bf16x8*)(Ks + (sub * 32 + r) * LROW + ks * 16 + h * 8);
    __builtin_amdgcn_sched_barrier(0);
#pragma unroll
    for (int sub = 0; sub < 2; sub++) {
#pragma unroll
      for (int e = 0; e < 16; e++) s[sub][e] = 0.f;
#pragma unroll
      for (int ks = 0; ks < 4; ks++) s[sub] = mfma32(kf[sub][ks], qf[ks], s[sub]);
    }
  }
  if (MASK) {
#pragma unroll
    for (int sub = 0; sub < 2; sub++)
#pragma unroll
      for (int e = 0; e < 16; e++) {
        int kp = kpos0 + sub * 32 + (e & 3) + 8 * (e >> 2) + 4 * h;
        int dlt = kp - qpos;
        bool ok = (kp >= 0) && (kp < T) && (dlt <= 128) && (dlt >= -128);
        if (!ok) s[sub][e] = -INFINITY;
      }
  }
}
template <int DV>
__device__ __forceinline__ void fs_softmax(f32x16 (&s)[2], float& m, float& l, f32x16 (&o)[DV / 32], bf16x8 (&pf)[2][2], int lane) {
  float mx = s[0][0];
#pragma unroll
  for (int sub = 0; sub < 2; sub++)
#pragma unroll
    for (int e = 0; e < 16; e++) mx = fmaxf(mx, s[sub][e]);
  mx = fmaxf(mx, shflx(mx, 32, lane));
  const bool grow = mx > m;
  const float mn = grow ? mx : m;
  float sum = 0.f;
#pragma unroll
  for (int sub = 0; sub < 2; sub++)
#pragma unroll
    for (int e = 0; e < 16; e++) { float pv = __builtin_amdgcn_exp2f(s[sub][e] - mn); s[sub][e] = pv; sum += pv; }
  sum += shflx(sum, 32, lane);
  if (__builtin_amdgcn_ballot_w64(grow) != 0ull) {
    const float alpha = __builtin_amdgcn_exp2f(m - mn);
    l *= alpha;
#pragma unroll
    for (int ds = 0; ds < DV / 32; ds++)
#pragma unroll
      for (int e = 0; e < 16; e++) o[ds][e] *= alpha;
  }
  l += sum; m = mn;
  typedef __attribute__((ext_vector_type(4))) unsigned u32x4;
#pragma unroll
  for (int sub = 0; sub < 2; sub++)
#pragma unroll
    for (int st = 0; st < 2; st++) {
      u32x4 pw;
#pragma unroll
      for (int j = 0; j < 4; j++) pw[j] = pack2(s[sub][8 * st + 2 * j], s[sub][8 * st + 2 * j + 1]);
      pf[sub][st] = __builtin_bit_cast(bf16x8, pw);
    }
}
template <int DV>
__device__ __forceinline__ void fs_pv(const bf16x8 (&pf)[2][2], const u16* Vts, f32x16 (&o)[DV / 32], int lane) {
  const int r = lane & 31, h = lane >> 5;
#pragma unroll
  for (int sub = 0; sub < 2; sub++) {
    bf16x8 vf[2][DV / 32];
#pragma unroll
    for (int st = 0; st < 2; st++)
#pragma unroll
      for (int ds = 0; ds < DV / 32; ds++) {
        const u16* vp = Vts + (ds * 32 + r) * VROW + sub * 32 + 16 * st + 4 * h;
        bf16x4 lo = *(const bf16x4*)vp, hi = *(const bf16x4*)(vp + 8);
        vf[st][ds] = __builtin_shufflevector(lo, hi, 0, 1, 2, 3, 4, 5, 6, 7);
      }
    __builtin_amdgcn_sched_barrier(0);
#pragma unroll
    for (int st = 0; st < 2; st++)
#pragma unroll
      for (int ds = 0; ds < DV / 32; ds++) o[ds] = mfma32(vf[st][ds], pf[sub][st], o[ds]);
    __builtin_amdgcn_sched_barrier(0);
  }
}

__device__ __forceinline__ uint4 ld_k(const u16* __restrict__ src, size_t pitch, int r0, int nrows, int c) {
  int row = c >> 3, kc = c & 7; int rr = r0 + row;
  const bool ok = (rr >= 0 && rr < nrows);
  const int rc = rr < 0 ? 0 : (rr >= nrows ? nrows - 1 : rr);
  uint4 v = *(const uint4*)(src + (size_t)rc * pitch + kc * 8);
  if (!ok) v = make_uint4(0, 0, 0, 0);
  return v;
}
__device__ __forceinline__ void st_k(u16* dst, int c, uint4 v) { *(uint4*)(dst + (c >> 3) * LROW + (c & 7) * 8) = v; }
__device__ __forceinline__ uint4 ld_vt(const u16* __restrict__ src, int T, int k0, int c) {
  int d = c >> 3, kc = c & 7; int k = k0 + kc * 8;
  const bool ok = (k >= 0 && k < T);
  const int kk = k < 0 ? 0 : (k >= T ? T - 8 : k);
  uint4 v = *(const uint4*)(src + (size_t)d * T + kk);
  if (!ok) v = make_uint4(0, 0, 0, 0);
  return v;
}
__device__ __forceinline__ void st_vt(u16* dst, int c, uint4 v) {
  uint2* q = (uint2*)(dst + (c >> 3) * VROW + (c & 7) * 8);
  q[0] = make_uint2(v.x, v.y); q[1] = make_uint2(v.z, v.w);
}

constexpr int A_BUF = 64 * LROW + 64 * VROW;
__device__ __forceinline__ void attnA_item(const Params& p, int l, int it, u16* sm, bool dry = false) {
  const int tid = TIDX, lane = tid & 63, wid = tid >> 6;
  const int r = lane & 31, h = lane >> 5;
  const bool isctx = it < 128;
  int b, kvh, qb, T, rowbase; const u16* VtBase;
  if (isctx) { b = it >> 3; kvh = (it >> 2) & 1; qb = it & 3; T = 256; rowbase = b * 256;
    VtBase = p.VtA_ctx + ((size_t)(b * 2 + kvh) * 64) * 256; }
  else { int j = it - 128; b = j >> 7; kvh = (j >> 6) & 1; qb = j & 63; T = 4096; rowbase = NCTX + b * 4096;
    VtBase = p.VtA_lat + ((size_t)(b * 2 + kvh) * 64) * 4096; }
  const int qblk = qb * 64;
  const int q0 = qblk + (wid >> 2) * 32;
  const int head = kvh * 4 + (wid & 3);
  const size_t prow = (size_t)(rowbase + q0 + r) * PP;
  bf16x8 qf[4];
#pragma unroll
  for (int ks = 0; ks < 4; ks++) qf[ks] = *(const bf16x8*)(p.P + prow + C_QA + head * 64 + ks * 16 + h * 8);
  float m = p.sink_a[l * 8 + head] * 1.4426950408889634f, ls = 1.f;
  f32x16 o[2];
#pragma unroll
  for (int ds = 0; ds < 2; ds++)
#pragma unroll
    for (int e = 0; e < 16; e++) o[ds][e] = 0.f;
  const u16* Kbase = p.P + (size_t)rowbase * PP + C_KA + kvh * 64;
  const u16* cK = p.cKa + ((size_t)(b * 2 + l) * 512) * 128 + kvh * 64;
  const u16* cVt = p.cVtA + ((size_t)((b * 2 + l) * 2 + kvh) * 64) * 512;
  const int qpos = q0 + r;
  int i_lo = 0, nW, ntile;
  if (isctx) { nW = 4; ntile = 4; }
  else {
    i_lo = (qblk < 128) ? (128 - qblk) / 64 : 0;
    int i_hi = (T - qblk + 128) / 64; if (i_hi > 5) i_hi = 5;
    nW = i_hi - i_lo; ntile = nW + 8;
  }
  uint4 rk, rv;
  auto tile_load = [&](int t) {
    if (t < nW) {
      int k0 = isctx ? t * 64 : qblk - 128 + 64 * (i_lo + t);
      rk = ld_k(Kbase, PP, k0, T, tid); rv = ld_vt(VtBase, T, k0, tid);
    } else {
      int kt = t - nW;
      rk = ld_k(cK, 128, kt * 64, 512, tid); rv = ld_vt(cVt, 512, kt * 64, tid);
    }
  };
  auto KB = [&](int i) { return sm + (i & 1) * (64 * LROW); };
  auto VB = [&](int i) { return sm + 2 * 64 * LROW + (i % 3) * (64 * VROW); };
  const bool lag = (wid >> 2) != 0;
  __syncthreads();
  tile_load(0);
  st_k(KB(0), tid, rk); st_vt(VB(0), tid, rv);
  __syncthreads();
  bf16x8 pf[2][2];
  for (int t = 0; t <= ntile; t++) {
    const bool more = t + 1 < ntile;
    if (more) tile_load(t + 1);
    if (lag && t > 0) fs_pv<64>(pf, VB(t - 1), o, lane);
    if (t < ntile) {
      f32x16 sc[2];
      if (!isctx && t < nW) fs_scores<true>(KB(t), qf, sc, lane, qblk - 128 + 64 * (i_lo + t), qpos, T);
      else fs_scores<false>(KB(t), qf, sc, lane, 0, 0, T);
      fs_softmax<64>(sc, m, ls, o, pf, lane);
      if (!lag) fs_pv<64>(pf, VB(t), o, lane);
    }
    if (more) { st_k(KB(t + 1), tid, rk); st_vt(VB(t + 1), tid, rv); }
    __syncthreads();
  }
  const float inv = __builtin_amdgcn_rcpf(ls);
  {
    uint2 gv[2][4];
#pragma unroll
    for (int ds = 0; ds < 2; ds++)
#pragma unroll
      for (int g = 0; g < 4; g++) gv[ds][g] = *(const uint2*)(p.P + prow + C_GA + head * 64 + ds * 32 + 8 * g + 4 * h);
    __builtin_amdgcn_sched_barrier(0);
#pragma unroll
    for (int ds = 0; ds < 2; ds++)
#pragma unroll
      for (int g = 0; g < 4; g++) {
        int d = ds * 32 + 8 * g + 4 * h;
        uint2 ov;
        ov.x = pack2(o[ds][4 * g] * inv * lo_bf(gv[ds][g].x), o[ds][4 * g + 1] * inv * hi_bf(gv[ds][g].x));
        ov.y = pack2(o[ds][4 * g + 2] * inv * lo_bf(gv[ds][g].y), o[ds][4 * g + 3] * inv * hi_bf(gv[ds][g].y));
        *(uint2*)(p.GB + tm_off(rowbase + q0 + r, head * 64 + d, 8)) = ov;
      }
  }
}

constexpr int C_BUF = 128 * LROW + 128 * VROW;
__device__ __forceinline__ void attnC_item(const Params& p, int l, int it, u16* sm, float lam, float lam_init, bool dry = false) {
  const int tid = TIDX, lane = tid & 63, wid = tid >> 6;
  const int r = lane & 31, h = lane >> 5;
  const bool isctx = it < 128;
  int b, hd, qb, T, rowbase; const u16* VtBase;
  if (isctx) { b = it >> 3; hd = (it >> 1) & 3; qb = it & 1; T = 256; rowbase = b * 256;
    VtBase = p.VtC_ctx + ((size_t)(b * 4 + hd) * 128) * 256; }
  else { int j = it - 128; b = j >> 7; hd = (j >> 5) & 3; qb = j & 31; T = 4096; rowbase = NCTX + b * 4096;
    VtBase = p.VtC_lat + ((size_t)(b * 4 + hd) * 128) * 4096; }
  const int qg = wid & 3, map = wid >> 2;
  const int q0 = qb * 128 + qg * 32;
  const size_t prow = (size_t)(rowbase + q0 + r) * PP;
  bf16x8 qf[4];
#pragma unroll
  for (int ks = 0; ks < 4; ks++) qf[ks] = *(const bf16x8*)(p.P + prow + C_QC + hd * 128 + map * 64 + ks * 16 + h * 8);
  float m = -1e30f, ls = 0.f;
  f32x16 o[4];
#pragma unroll
  for (int ds = 0; ds < 4; ds++)
#pragma unroll
    for (int e = 0; e < 16; e++) o[ds][e] = 0.f;
  const u16* Kbase = p.P + (size_t)rowbase * PP + C_KC + hd * 128;
  const u16* cK = p.cKc + ((size_t)(b * 2 + l) * 512) * 512 + hd * 128;
  const u16* cVt = p.cVtC + ((size_t)((b * 2 + l) * 4 + hd) * 128) * 512;
  const int nW = T / 64, ntile = isctx ? nW : nW + 8;
  uint4 rk0, rk1, rv0, rv1;
  const u16* pk = Kbase + (size_t)(tid >> 3) * PP + (tid & 7) * 8;
  const u16* pv0 = VtBase + (size_t)(tid >> 3) * T + (tid & 7) * 8;
  const u16* pv1 = VtBase + (size_t)((tid + NT) >> 3) * T + (tid & 7) * 8;
  size_t kstride = (size_t)64 * PP;
  auto tile_load = [&](int t) {
    if (t == nW) {
      pk = cK + (size_t)(tid >> 3) * 512 + (tid & 7) * 8;
      pv0 = cVt + (size_t)(tid >> 3) * 512 + (tid & 7) * 8;
      pv1 = cVt + (size_t)((tid + NT) >> 3) * 512 + (tid & 7) * 8;
      kstride = (size_t)64 * 512;
    }
    rk0 = *(const uint4*)pk; rk1 = *(const uint4*)(pk + 64);
    rv0 = *(const uint4*)pv0; rv1 = *(const uint4*)pv1;
    pk += kstride; pv0 += 64; pv1 += 64;
  };
  auto KB = [&](int i) { return sm + (i & 1) * (128 * LROW); };
  auto VB = [&](int i) { return sm + 2 * 128 * LROW + (i % 3) * (128 * VROW); };
  auto tile_store = [&](int i) {
    u16* kd = KB(i); u16* vd = VB(i);
    st_k(kd, tid, rk0); st_k(kd + 64 * LROW, tid, rk1);
    st_vt(vd, tid, rv0); st_vt(vd, tid + NT, rv1);
  };
  const bool lag = map != 0;
  __syncthreads();
  tile_load(0);
  tile_store(0);
  __syncthreads();
  bf16x8 pf[2][2];
  for (int t = 0; t <= ntile; t++) {
    const bool more = t + 1 < ntile;
    if (more) tile_load(t + 1);
    if (lag && t > 0) fs_pv<128>(pf, VB(t - 1), o, lane);
    if (t < ntile) {
      f32x16 sc[2];
      fs_scores<false>(KB(t) + map * 64 * LROW, qf, sc, lane, 0, 0, T);
      fs_softmax<128>(sc, m, ls, o, pf, lane);
      if (!lag) fs_pv<128>(pf, VB(t), o, lane);
    }
    if (more) tile_store(t + 1);
    __syncthreads();
  }
  float* xch = (float*)sm;
  if (map == 1) {
    const float inv = lam * __builtin_amdgcn_rcpf(ls);
#pragma unroll
    for (int ds = 0; ds < 4; ds++)
#pragma unroll
      for (int e = 0; e < 16; e++) xch[((qg * 64) + ds * 16 + e) * 64 + lane] = o[ds][e] * inv;
  }
  __syncthreads();
  if (map == 0) {
    const float i0 = __builtin_amdgcn_rcpf(ls);
    float ss = 0.f;
#pragma unroll
    for (int ds = 0; ds < 4; ds++)
#pragma unroll
      for (int e = 0; e < 16; e++) {
        float v = o[ds][e] * i0 - xch[((qg * 64) + ds * 16 + e) * 64 + lane];
        o[ds][e] = v; ss += v * v;
      }
    ss += shflx(ss, 32, lane);
    const float rinv = rsqrtf(ss * (1.f / 128.f) + EPS) * (1.f - lam_init);
    const float* sg = p.subln_c + l * 128;
#pragma unroll
    for (int ds = 0; ds < 4; ds++) {
      uint2 gv[4]; float4 sl[4];
#pragma unroll
      for (int g = 0; g < 4; g++) {
        const int d = ds * 32 + 8 * g + 4 * h;
        gv[g] = *(const uint2*)(p.P + prow + C_GC + hd * 128 + d);
        sl[g] = *(const float4*)(sg + d);
      }
      __builtin_amdgcn_sched_barrier(0);
#pragma unroll
      for (int g = 0; g < 4; g++) {
        const int d = ds * 32 + 8 * g + 4 * h;
        uint2 ov;
        ov.x = pack2(o[ds][4 * g] * rinv * sl[g].x * lo_bf(gv[g].x), o[ds][4 * g + 1] * rinv * sl[g].y * hi_bf(gv[g].x));
        ov.y = pack2(o[ds][4 * g + 2] * rinv * sl[g].z * lo_bf(gv[g].y), o[ds][4 * g + 3] * rinv * sl[g].w * hi_bf(gv[g].y));
        *(uint2*)(p.GB + (size_t)2 * NTOK * 512 + tm_off(rowbase + q0 + r, hd * 128 + d, 8)) = ov;
      }
    }
  }
}

__device__ __forceinline__ void lru_run(const Params& p, int l, bool pass2, int start, int G, float* sm, bool dry = false) {
  const int tid = TIDX;
  const int lane = tid & 63, wid = tid >> 6, r = lane & 31, h = lane >> 5;
  const int n = start & 7;
  float* xin = sm;
  float* xb = sm + 67 * 64;
  float* comb = xb + 64 * 64;
  float* carry = comb + 2048;
  float* parts = carry + 128;
  float* ab = parts + 1024;
  u16* xbh = (u16*)(ab + 4 * 4096);
  const int gd = wid >> 2, gth = (wid >> 1) & 1, gdh = wid & 1;
  bf16x8 wfa[4], wfx[4];
  {
    const u16* wbase = p.Wt_lru + ((size_t)(((l * 2 + gd) * 8 + n) * 2) * 64 + gdh * 32 + r) * 64 + h * 8;
#pragma unroll
    for (int ks = 0; ks < 4; ks++) { wfa[ks] = *(const bf16x8*)(wbase + ks * 16); wfx[ks] = *(const bf16x8*)(wbase + 4096 + ks * 16); }
  }
  const int gch = n * 64 + gdh * 32 + r;
  const float g_ba = p.lru_ba[(l * 2 + gd) * 512 + gch], g_bx = p.lru_bx[(l * 2 + gd) * 512 + gch];
  const float g_sp = log1pf(__expf(-p.lru_lam[(l * 2 + gd) * 512 + gch]));
  const int cc = tid & 63;
  float cw[4]; float cbv;
  {
    const float* cwp = p.conv_w + l * 4 * 512 + n * 64 + cc;
    cw[0] = cwp[0]; cw[1] = cwp[512]; cw[2] = cwp[1024]; cw[3] = cwp[1536];
    cbv = p.conv_b[l * 512 + n * 64 + cc];
  }
  const int dout = tid & 63, tg = tid >> 6;
  const int ch = n * 64 + dout;

  u16 xr[9];
  auto xin_load = [&](int it_) {
    const int row0_ = (it_ >> 3) * 64;
    int T_, seq0_;
    if (row0_ < NCTX) { T_ = 256; seq0_ = (row0_ >> 8) * 256; } else { T_ = 4096; seq0_ = NCTX + ((row0_ - NCTX) >> 12) * 4096; }
    const int t0_ = row0_ - seq0_;
#pragma unroll
    for (int k = 0; k < 9; k++) {
      const int rr = (tid >> 6) + 8 * k; const int t = t0_ - 2 + rr;
      const bool ok = (rr < 67 && t >= 0 && t < T_);
      const int tc = t < 0 ? 0 : (t >= T_ ? T_ - 1 : t);
      u16 v = p.P[(size_t)(seq0_ + tc) * PP + C_XB + n * 64 + cc];
      xr[k] = ok ? v : (u16)0;
    }
  };
  if (start < 1536) xin_load(start);
  for (int it = start; it < 1536; it += G) {
    const int ci = it >> 3;
    const int row0 = ci * 64;
    const bool isctx = row0 < NCTX;
    int T, seq0, bidx;
    if (isctx) { T = 256; bidx = row0 >> 8; seq0 = bidx * 256; }
    else { T = 4096; bidx = (row0 - NCTX) >> 12; seq0 = NCTX + bidx * 4096; }
    const int t0 = row0 - seq0;
    __syncthreads();
#pragma unroll
    for (int k = 0; k < 9; k++) { const int rr = (tid >> 6) + 8 * k; if (rr < 67) xin[rr * 64 + cc] = bf2f(xr[k]); }
    if (it + G < 1536) xin_load(it + G);
    u16 sgr[8];
    if (pass2) {
#pragma unroll
      for (int tt = 0; tt < 8; tt++) sgr[tt] = p.P[(size_t)(row0 + tg * 8 + tt) * PP + C_GB + ch];
    }
    if (pass2) {
      const int d = (tid >> 6) & 1, part = tid >> 7;
      const int cfirst = seq0 >> 6, clast = (seq0 + T - 64) >> 6;
      const int K = d ? (clast - ci) : (ci - cfirst);
      float2 q[16];
#pragma unroll
      for (int k = 0; k < 16; k++) {
        const int kk = part * 16 + k;
        const int cj = d ? (clast - kk) : (cfirst + kk);
        const int cjc = cj < cfirst ? cfirst : (cj > clast ? clast : cj);
        const float2 qv = *(const float2*)(p.lruTot + ((size_t)(cjc * 2 + d) * 512 + n * 64 + cc) * 2);
        q[k] = (kk < K) ? qv : make_float2(1.f, 0.f);
      }
      float At = 1.f, Bt = 0.f;
#pragma unroll
      for (int k = 0; k < 16; k++) { Bt = q[k].x * Bt + q[k].y; At *= q[k].x; }
      parts[((part * 2 + d) * 64 + cc) * 2] = At; parts[((part * 2 + d) * 64 + cc) * 2 + 1] = Bt;
    }
    __syncthreads();
    for (int e = tid; e < 64 * 64; e += NT) {
      int t = e >> 6;
      float v = cbv;
#pragma unroll
      for (int j = 0; j < 4; j++) v += xin[(t + j) * 64 + cc] * cw[j];
      xb[e] = v;
      xbh[t * LROW + cc] = f2bf(v);
    }
    if (pass2 && tid < 128) {
      const int d = tid >> 6;
      float hcar = isctx ? 0.f : p.state_lru[((size_t)(bidx * 2 + l) * 2 + d) * 512 + n * 64 + cc];
#pragma unroll
      for (int part = 0; part < 4; part++) hcar = parts[((part * 2 + d) * 64 + cc) * 2] * hcar + parts[((part * 2 + d) * 64 + cc) * 2 + 1];
      carry[d * 64 + cc] = hcar;
    }
    __syncthreads();
    {
      bf16x8 af[4];
#pragma unroll
      for (int ks = 0; ks < 4; ks++) af[ks] = *(const bf16x8*)(xbh + (gth * 32 + r) * LROW + ks * 16 + h * 8);
      f32x16 ga, gi;
#pragma unroll
      for (int e = 0; e < 16; e++) { ga[e] = 0.f; gi[e] = 0.f; }
#pragma unroll
      for (int ks = 0; ks < 4; ks++) { ga = mfma32(af[ks], wfa[ks], ga); gi = mfma32(af[ks], wfx[ks], gi); }
      const int dch = gdh * 32 + r;
#pragma unroll
      for (int e = 0; e < 16; e++) {
        const int tok = gth * 32 + (e & 3) + 8 * (e >> 2) + 4 * h;
        float rg = sigmoidf_(ga[e] + g_ba), ig = sigmoidf_(gi[e] + g_bx);
        float log_a = -8.f * rg * g_sp;
        float a = __expf(log_a);
        const float x2 = 2.f * log_a;
        const float om = -x2 * (1.f + x2 * (0.5f + x2 * (0.16666667f + x2 * (0.041666668f + x2 * (0.0083333338f + x2 * (0.0013888889f + x2 * 0.0001984127f))))));
        float bb = __builtin_amdgcn_sqrtf(om) * ig * xb[tok * 64 + dch];
        ab[((gd * 2 + 0) * 64 + tok) * 64 + dch] = a;
        ab[((gd * 2 + 1) * 64 + tok) * 64 + dch] = bb;
      }
    }
    __syncthreads();
    float av[2][8], bv[2][8];
#pragma unroll
    for (int d = 0; d < 2; d++)
#pragma unroll
      for (int tt = 0; tt < 8; tt++) {
        av[d][tt] = ab[((d * 2 + 0) * 64 + tg * 8 + tt) * 64 + dout];
        bv[d][tt] = ab[((d * 2 + 1) * 64 + tg * 8 + tt) * 64 + dout];
      }
    float sA0 = 1.f, sB0 = 0.f, sA1 = 1.f, sB1 = 0.f;
#pragma unroll
    for (int tt = 0; tt < 8; tt++) { sB0 = av[0][tt] * sB0 + bv[0][tt]; sA0 *= av[0][tt]; }
#pragma unroll
    for (int tt = 7; tt >= 0; tt--) { sB1 = av[1][tt] * sB1 + bv[1][tt]; sA1 *= av[1][tt]; }
    comb[((tg * 2 + 0) * 64 + dout) * 2 + 0] = sA0; comb[((tg * 2 + 0) * 64 + dout) * 2 + 1] = sB0;
    comb[((tg * 2 + 1) * 64 + dout) * 2 + 0] = sA1; comb[((tg * 2 + 1) * 64 + dout) * 2 + 1] = sB1;
    __syncthreads();
    if (!pass2) {
      if (tid < 128) {
        int d = tid >> 6, c = tid & 63;
        float At = 1.f, Bt = 0.f;
#pragma unroll
        for (int s = 0; s < 8; s++) {
          int g = (d == 0) ? s : 7 - s;
          float a = comb[((g * 2 + d) * 64 + c) * 2], bq = comb[((g * 2 + d) * 64 + c) * 2 + 1];
          Bt = a * Bt + bq; At *= a;
        }
        float* o = p.lruTot + ((size_t)(ci * 2 + d) * 512 + n * 64 + c) * 2;
        o[0] = At; o[1] = Bt;
      }
      continue;
    }
    float h0 = carry[dout], h1 = carry[64 + dout];
    for (int g = 0; g < tg; g++) { h0 = comb[((g * 2 + 0) * 64 + dout) * 2] * h0 + comb[((g * 2 + 0) * 64 + dout) * 2 + 1]; }
    for (int g = 7; g > tg; g--) { h1 = comb[((g * 2 + 1) * 64 + dout) * 2] * h1 + comb[((g * 2 + 1) * 64 + dout) * 2 + 1]; }
    float y[8];
#pragma unroll
    for (int tt = 0; tt < 8; tt++) { h0 = av[0][tt] * h0 + bv[0][tt]; y[tt] = h0; }
    const float hf_last = h0;
#pragma unroll
    for (int tt = 7; tt >= 0; tt--) { h1 = av[1][tt] * h1 + bv[1][tt]; y[tt] += h1; }
    const float hb_first = h1;
    if (isctx) {
      if (t0 + 64 == T && tg == 7) p.out[O_ST + ((size_t)(bidx * 2 + l) * 2 + 0) * 512 + ch] = hf_last;
      if (t0 == 0 && tg == 0) p.out[O_ST + ((size_t)(bidx * 2 + l) * 2 + 1) * 512 + ch] = hb_first;
    }
#pragma unroll
    for (int tt = 0; tt < 8; tt++) {
      const int rw = row0 + tg * 8 + tt;
      p.GB[(size_t)NTOK * 512 + tm_off(rw, ch, 8)] = f2bf(y[tt] * bf2f(sgr[tt]));
    }
  }
}

__device__ __forceinline__ float compute_lam(const Params& p, int l, float lam_init) {
  float s1 = 0.f, s2 = 0.f;
  for (int i = 0; i < 64; i++) {
    s1 += p.lam_q1[l * 64 + i] * p.lam_k1[l * 64 + i];
    s2 += p.lam_q2[l * 64 + i] * p.lam_k2[l * 64 + i];
  }
  return expf(s1) - expf(s2) + lam_init;
}

__device__ __forceinline__ float mix_phase(const Params& p, int l, u16* smem, int vid) {
  unsigned long long tm0 = 0; float tres = 0.f; if (PROBE >= 30) tm0 = __builtin_amdgcn_s_memrealtime();
  const float lam_init = (l == 0) ? 0.2f : (0.8f - 0.6f * 0.74081822068f);
  const float lam = compute_lam(p, l, lam_init);
  constexpr int N_CL = 256, N_A = 384, N_CC = 128, N_L = 1536;
  const int G = gridDim.x;
  int start = vid;
  for (int it = start; it < N_CL; it += G) attnC_item(p, l, 128 + it, smem, lam, lam_init);
  if (PROBE == 35) tres = (float)(__builtin_amdgcn_s_memrealtime() - tm0) / 40000.f;
  start = (int)((vid + G - (N_CL % G)) % G);
  for (int it = start; it < N_A; it += G) attnA_item(p, l, it, smem);
  start = (int)((vid + G - ((N_CL + N_A) % G)) % G);
  for (int it = start; it < N_CC; it += G) attnC_item(p, l, it, smem, lam, lam_init);
  if (PROBE == 36) tres = (float)(__builtin_amdgcn_s_memrealtime() - tm0) / 40000.f;
  start = (int)((vid + G - ((N_CL + N_A + N_CC) % G)) % G);
  if (PROBE == 6) lru_run(p, l, false, start, G, (float*)smem);
  lru_run(p, l, false, start, G, (float*)smem);
  return tres;
}

__device__ __forceinline__ void lru2_phase(const Params& p, int l, u16* smem) {
  lru_run(p, l, true, blockIdx.x, gridDim.x, (float*)smem);
}

#define XB_TMO      128
#define XB_XCNT(j)  (256  + 64 * (j))
#define XB_XSUB(j)  (1280 + 64 * (j))
#define XB_XGEN(j)  (2304 + 64 * (j))
#define XB_TOP      3328
#define XB_TOPGEN   3392
#define XCD_BAR_WORDS 3456
#define XB_SPIN_CAP (1u << 18)
__device__ __forceinline__ unsigned xb_ld(unsigned* p)              { return __hip_atomic_load(p, __ATOMIC_RELAXED, __HIP_MEMORY_SCOPE_AGENT); }
__device__ __forceinline__ unsigned xb_add(unsigned* p, unsigned v) { return __hip_atomic_fetch_add(p, v, __ATOMIC_RELAXED, __HIP_MEMORY_SCOPE_AGENT); }
__device__ __forceinline__ unsigned xb_xcc_id() { return (unsigned)__builtin_amdgcn_s_getreg((3 << 11) | 20) & 0xFu; }
#define XB_SPIN(cond, bar) do { unsigned _sp = 0; while (cond) { __builtin_amdgcn_s_sleep(1); \
    if ((++_sp & 255u) == 0u) { if (xb_ld(&(bar)[XB_TMO])) break; if (_sp > XB_SPIN_CAP) { atomicAdd(&(bar)[XB_TMO], 1u); break; } } } } while (0)
struct XcdBarrier { unsigned* bar; unsigned x; volatile LAS unsigned* st; };
__device__ __forceinline__ XcdBarrier xcd_barrier_post(unsigned* bar, volatile LAS unsigned* st) {
  XcdBarrier b; b.bar = bar; b.x = xb_xcc_id(); b.st = st;
  if (threadIdx.x == 0) st[2] = xb_add(&bar[XB_XCNT(b.x)], 1u);
  return b;
}
__device__ __forceinline__ int xcd_virtual_id(const XcdBarrier& b) {
  if (threadIdx.x == 0) {
    unsigned pre = 0;
#pragma unroll
    for (unsigned j = 0; j < 16; ++j) { const unsigned c = xb_ld(&b.bar[XB_XCNT(j)]); pre += (j < b.x) ? c : 0u; }
    b.st[3] = pre + b.st[2];
  }
  __syncthreads();
  const int v = (int)b.st[3];
  __syncthreads();
  return __builtin_amdgcn_readfirstlane(v);
}
__device__ __forceinline__ void xcd_barrier_complete(unsigned* bar, unsigned x, unsigned& nloc, unsigned& nx) {
  const unsigned G = gridDim.x * gridDim.y * gridDim.z;
  unsigned sum, cnt, mine, sp = 0u;
  for (;;) {
    sum = 0u; cnt = 0u; mine = 0u;
#pragma unroll
    for (unsigned j = 0; j < 16; ++j) { const unsigned c = xb_ld(&bar[XB_XCNT(j)]); sum += c; cnt += (c > 0u) ? 1u : 0u; mine = (j == x) ? c : mine; }
    if (sum == G) break;
    __builtin_amdgcn_s_sleep(1);
    if ((++sp & 255u) == 0u) { if (xb_ld(&bar[XB_TMO])) break; if (sp > XB_SPIN_CAP) { atomicAdd(&bar[XB_TMO], 1u); break; } }
  }
  nloc = mine > 0u ? mine : 1u; nx = cnt > 0u ? cnt : 1u;
}
__device__ __forceinline__ void xcd_barrier(const XcdBarrier& b) {
  asm volatile("s_waitcnt vmcnt(0)" ::: "memory");
  __syncthreads();
  if (threadIdx.x == 0) {
    unsigned* bar = b.bar;
    __builtin_amdgcn_s_waitcnt(0);
    unsigned nloc = b.st[0], nx = b.st[1];
    if (nloc == 0u) { xcd_barrier_complete(bar, b.x, nloc, nx); b.st[0] = nloc; b.st[1] = nx; }
    const unsigned old = xb_add(&bar[XB_XSUB(b.x)], 1u);
    const unsigned gen = old / nloc;
    if (old + 1u == (gen + 1u) * nloc) {
      __builtin_amdgcn_fence(__ATOMIC_RELEASE, "agent");
      asm volatile("s_waitcnt vmcnt(0)" ::: "memory");
      const unsigned og = xb_add(&bar[XB_TOP], 1u);
      const unsigned tg = og / nx;
      if (og + 1u == (tg + 1u) * nx) xb_add(&bar[XB_TOPGEN], 1u);
      else XB_SPIN(xb_ld(&bar[XB_TOPGEN]) == tg, bar);
      __builtin_amdgcn_fence(__ATOMIC_ACQUIRE, "agent");
      xb_add(&bar[XB_XGEN(b.x)], 1u);
      asm volatile("s_waitcnt vmcnt(0)" ::: "memory");
    } else {
      XB_SPIN(xb_ld(&bar[XB_XGEN(b.x)]) == gen, bar);
      __builtin_amdgcn_fence(__ATOMIC_ACQUIRE, "agent");
      asm volatile("s_waitcnt vmcnt(0)" ::: "memory");
    }
  }
  __syncthreads();
}

typedef __attribute__((address_space(4))) const Params CParams;
__device__ __forceinline__ const Params& get_params() {
  CParams* kp = (CParams*)__builtin_amdgcn_kernarg_segment_ptr();
  asm volatile("" : "+s"(kp));
  return *(const Params*)kp;
}
__global__ void __launch_bounds__(NT, 2) fwd_kernel(Params p_unused) {
  extern __shared__ __attribute__((aligned(16))) unsigned char lds_raw[];
  u16* smem = (u16*)lds_raw;
  LAS unsigned char* lds = (LAS unsigned char*)lds_raw;
  cg::grid_group grid = cg::this_grid();
  volatile LAS unsigned* xst = (volatile LAS unsigned*)(lds + STAGE_BYTES + SPARE_BYTES);
  if (threadIdx.x == 0) { xst[0] = 0u; xst[1] = 0u; }
  __syncthreads();
  XcdBarrier xb = xcd_barrier_post(get_params().bar, xst);
  float tfrac = 0.f;
  unsigned long long tq0 = 0; if (PROBE >= 30) tq0 = __builtin_amdgcn_s_memrealtime();
  prologue_phase(get_params(), (float*)smem);
  if (PROBE == 30) tfrac = (float)(__builtin_amdgcn_s_memrealtime() - tq0) / 40000.f;
  if (get_params().bar == nullptr) grid.sync();
  xcd_barrier(xb);
  if (PROBE == 31) tfrac = (float)(__builtin_amdgcn_s_memrealtime() - tq0) / 40000.f;
  const int vid = xcd_virtual_id(xb);
  { LAS float* rl = (LAS float*)(lds + ROPE_OFF); const float* rg = get_params().rope;
    for (int i = threadIdx.x; i < 2048; i += NT) rl[i] = rg[i];
    __syncthreads(); }
  if (PROBE == 9) { for (int i = 0; i < 10; i++) xcd_barrier(xb); }
#pragma unroll 1
  for (int l = 0; l < 2; l++) {
    if (PROBE >= 30) tq0 = __builtin_amdgcn_s_memrealtime();
    norm_phase(get_params(), l);
    if (PROBE == 32 && l == 0) tfrac = (float)(__builtin_amdgcn_s_memrealtime() - tq0) / 40000.f;
    if (PROBE == 3) { norm_phase(get_params(), l); if (l == 0) { xcd_barrier(xb); prologue_phase(get_params(), (float*)smem); } }
    xcd_barrier(xb);
    {
      const Params& p = get_params();
      SchedStd S; S.nM = NTOK / 256; S.nN = INC / 256; S.nwg = S.nM * S.nN; S.G = gridDim.x; S.c = vid;
      S.A = (const char*)p.H; S.B = (const char*)(p.Wt_in + (size_t)l * INC * 1024); S.tA = (size_t)256 * 1024 * 2; S.tB = (size_t)256 * 1024 * 2;
      EpiInproj E; E.pp = &p; E.l = l; E.part = (LAS float*)(lds + STAGE_BYTES); E.ropeL = (const LAS float*)(lds + ROPE_OFF);
      { float tr = gemm_phase(lds, 1024, S, E, PROBE == 22); if (l == 0 && (PROBE == 21 || PROBE == 22)) tfrac = tr; }
      if (PROBE == 1) { __syncthreads(); gemm_phase(lds, 1024, S, E); }
    }
    xcd_barrier(xb);
    if (PROBE >= 30) tq0 = __builtin_amdgcn_s_memrealtime();
    { float tr = mix_phase(get_params(), l, smem, vid); if ((PROBE == 35 || PROBE == 36) && l == 0) tfrac = tr; }
    if (PROBE == 33 && l == 0) tfrac = (float)(__builtin_amdgcn_s_memrealtime() - tq0) / 40000.f;
    xcd_barrier(xb);
    if (PROBE >= 30) tq0 = __builtin_amdgcn_s_memrealtime();
    lru2_phase(get_params(), l, smem);
    if (PROBE == 34 && l == 0) tfrac = (float)(__builtin_amdgcn_s_memrealtime() - tq0) / 40000.f;
    xcd_barrier(xb);
    {
      const Params& p = get_params();
      SchedBranch S; S.G = gridDim.x; S.c = vid; S.P_ = (const char*)p.GB; S.W_ = (const char*)(p.Wt_br + (size_t)l * 3 * 1024 * 512);
      EpiBranch E; E.pp = &p;
      { float tr = gemm_phase(lds, 512, S, E, PROBE == 24); if (l == 0 && (PROBE == 23 || PROBE == 24)) tfrac = tr; }
      if (PROBE == 2) { __syncthreads(); gemm_phase(lds, 512, S, E); }
    }
    xcd_barrier(xb);
    {
      const Params& p = get_params();
      SchedStd S; S.nM = NTOK / 256; S.nN = 4; S.nwg = S.nM * S.nN; S.G = gridDim.x; S.c = vid;
      S.A = (const char*)p.Y; S.B = (const char*)(p.Wt_out + (size_t)l * 1024 * 1024); S.tA = (size_t)256 * 1024 * 2; S.tB = (size_t)256 * 1024 * 2;
      EpiOut E; E.pp = &p; E.l = l;
      { float tr = gemm_phase(lds, 1024, S, E, PROBE == 26); if (l == 0 && (PROBE == 25 || PROBE == 26)) tfrac = tr; }
      if (PROBE == 8 && l == 0) { __syncthreads(); gemm_phase(lds, 1024, S, E); }
    }
    if (l == 0) xcd_barrier(xb);
  }
  if (PROBE >= 20) {
    xcd_barrier(xb);
    if (blockIdx.x == 0 && threadIdx.x == 0) { float* o = get_params().out + O_X + 4194304; *o += 0.42f + 0.45f * fminf(fmaxf(tfrac, 0.f), 1.f); }
  }
}

extern "C" void kernel_launch(void* const* d_in, const int* in_sizes, int n_in, void* d_out, int out_size, void* d_ws,
                              size_t ws_size, hipStream_t stream) {
  Params p{};
  const float** ip = (const float**)&p;
  for (int i = 0; i < 34; i++) ip[i] = (const float*)d_in[i];
  p.out = (float*)d_out;
  char* w = (char*)d_ws; size_t off = 0;
  auto take = [&](size_t bytes) { char* q = w + off; off += (bytes + 255) & ~(size_t)255; return q; };
  p.Wt_in = (u16*)take((size_t)2 * INC * 1024 * 2);
  p.Wt_br = (u16*)take((size_t)6 * 1024 * 512 * 2);
  p.Wt_out = (u16*)take((size_t)2 * 1024 * 1024 * 2);
  p.Y = (u16*)take((size_t)NTOK * 1024 * 2);
  p.P = (u16*)take((size_t)NTOK * PP * 2);
  p.VtA_ctx = p.Y;
  p.VtA_lat = p.VtA_ctx + (size_t)16 * 2 * 64 * 256;
  p.VtC_ctx = p.VtA_lat + (size_t)2 * 2 * 64 * 4096;
  p.VtC_lat = p.VtC_ctx + (size_t)16 * 4 * 128 * 256;
  p.cKa = (u16*)take((size_t)2 * 2 * 512 * 128 * 2);
  p.cVtA = (u16*)take((size_t)2 * 2 * 512 * 128 * 2);
  p.cKc = (u16*)take((size_t)2 * 2 * 512 * 512 * 2);
  p.cVtC = (u16*)take((size_t)2 * 2 * 512 * 512 * 2);
  p.mod = (float*)take((size_t)2 * 3 * 3072 * 4);
  p.rope = (float*)take((size_t)2048 * 4);
  p.lruTot = (float*)take((size_t)192 * 2 * 512 * 2 * 4);
  p.Wt_lru = (u16*)take((size_t)2 * 2 * 8 * 2 * 64 * 64 * 2);
  p.bar = (unsigned*)take((size_t)XCD_BAR_WORDS * 4);
  p.GB = (u16*)take((size_t)3 * NTOK * 512 * 2);
  p.H = p.GB;
  p.MG = (unsigned*)take((size_t)(48 * 4 * 3 + 1) * 16384 * 4);
  static int grid_blocks = 0;
  if (!grid_blocks) {
    int dev = 0, cus = 0;
    hipGetDevice(&dev);
    hipDeviceGetAttribute(&cus, hipDeviceAttributeMultiprocessorCount, dev);
    hipFuncSetAttribute((const void*)fwd_kernel, hipFuncAttributeMaxDynamicSharedMemorySize, LDS_BYTES);
    int per_cu = 0;
    hipOccupancyMaxActiveBlocksPerMultiprocessor(&per_cu, (const void*)fwd_kernel, NT, LDS_BYTES);
    (void)hipGetLastError();
    grid_blocks = cus;
  }
  hipMemsetAsync(p.bar, 0, (size_t)XCD_BAR_WORDS * 4, stream);
  void* args[] = {&p};
  hipLaunchCooperativeKernel((void*)fwd_kernel, dim3(grid_blocks), dim3(NT), args, LDS_BYTES, stream);
}
```

```cpp
#include <hip/hip_runtime.h>
#include <hip/hip_cooperative_groups.h>
#include <stdint.h>
#include <math.h>
namespace cg = cooperative_groups;

typedef unsigned short u16;
typedef __attribute__((ext_vector_type(8))) short bf16x8;
typedef __attribute__((ext_vector_type(4))) short bf16x4;
typedef __attribute__((ext_vector_type(16))) float f32x16;
typedef __attribute__((ext_vector_type(4))) float f32x4;
#define LAS __attribute__((address_space(3)))

#ifndef PROBE
#define PROBE 0
#endif
#define NT 512
constexpr int NTOK = 12288, NCTX = 4096;
constexpr int INC = 7424;
constexpr int PP = 3712;
constexpr int C_QA = 0, C_KA = 512, C_GA = 640, C_XB = 1152, C_GB = 1664, C_QC = 2176, C_KC = 2688, C_GC = 3200;
constexpr int LROW = 72;
constexpr int VROW = 68;
constexpr float EPS = 1e-6f;
constexpr int STAGE_BYTES = 131072;
constexpr int SPARE_BYTES = 8192;
constexpr int ROPE_OFF = STAGE_BYTES + SPARE_BYTES + 16;
constexpr int LDS_BYTES = ROPE_OFF + 8192;

constexpr size_t O_X = 0, O_KA = 12582912, O_VA = 13631488, O_KC = 14680064, O_VC = 18874368, O_ST = 23068672;

struct Params {
  const float *x_prompt, *x_sample, *cache_a_k, *cache_a_v, *cache_c_k, *cache_c_v, *state_lru, *c, *c_ctx,
      *norm_g, *mod_w, *mod_b, *w_in, *qn_a, *kn_a, *sink_a, *conv_w, *conv_b, *lru_wa, *lru_ba, *lru_wx, *lru_bx,
      *lru_lam, *qn_c, *kn_c, *lam_q1, *lam_k1, *lam_q2, *lam_k2, *subln_c, *w_br_a, *w_br_b, *w_br_c, *w_out;
  float* out;
  u16 *Wt_in, *Wt_br, *Wt_out, *H, *P, *VtA_ctx, *VtA_lat, *VtC_ctx, *VtC_lat, *cKa, *cVtA, *cKc, *cVtC;
  float *mod, *rope, *lruTot;
  u16 *Wt_lru;
  unsigned* bar;
  u16* Y;
  u16* GB;
  unsigned* MG;
};

__device__ __forceinline__ int tid_opaque() { int t = (int)threadIdx.x; asm volatile("" : "+v"(t)); return t; }
#define TIDX tid_opaque()
__device__ __forceinline__ u16 f2bf(float f) {
  uint32_t r; asm("v_cvt_pk_bf16_f32 %0, %1, %1" : "=v"(r) : "v"(f)); return (u16)(r & 0xffffu);
}
__device__ __forceinline__ float bf2f(u16 h) { return __uint_as_float(((uint32_t)h) << 16); }
__device__ __forceinline__ uint32_t pack2(float a, float b) { uint32_t r; asm("v_cvt_pk_bf16_f32 %0, %1, %2" : "=v"(r) : "v"(a), "v"(b)); return r; }
__device__ __forceinline__ float sigmoidf_(float x) { return __builtin_amdgcn_rcpf(1.f + __expf(-x)); }
__device__ __forceinline__ float siluf_(float x) { return x * __builtin_amdgcn_rcpf(1.f + __expf(-x)); }
__device__ __forceinline__ f32x16 mfma32(bf16x8 a, bf16x8 b, f32x16 c) {
  return __builtin_amdgcn_mfma_f32_32x32x16_bf16(a, b, c, 0, 0, 0);
}
__device__ __forceinline__ float shflx(float v, int mask, int lane) {
  return __builtin_bit_cast(float, __builtin_amdgcn_ds_bpermute((lane ^ mask) << 2, __builtin_bit_cast(int, v)));
}
__device__ __forceinline__ float lo_bf(uint32_t w) { return __uint_as_float(w << 16); }
__device__ __forceinline__ float hi_bf(uint32_t w) { return __uint_as_float(w & 0xffff0000u); }

__device__ __forceinline__ size_t tm_off(int r, int k, int KT) {
  return ((size_t)((r >> 8) * KT + (k >> 6)) * 256 + (r & 255)) * 64 + (k & 63);
}
__device__ __forceinline__ void transpose_tile(const float* __restrict__ src, int spitch, u16* __restrict__ dst, int dpitch,
                               int r0, int c0, float* sm, int KT = 0) {
  const int tid = TIDX;
#pragma unroll
  for (int i = 0; i < 2; i++) {
    int c = tid + i * NT; int r = c >> 4, q = c & 15;
    float4 v = *(const float4*)(src + (size_t)(r0 + r) * spitch + c0 + q * 4);
    float* d = sm + r * 65 + q * 4;
    d[0] = v.x; d[1] = v.y; d[2] = v.z; d[3] = v.w;
  }
  __syncthreads();
  {
    int c = tid; int cc = c >> 3, q = c & 7;
    uint32_t w[4];
#pragma unroll
    for (int j = 0; j < 4; j++) w[j] = pack2(sm[(q * 8 + 2 * j) * 65 + cc], sm[(q * 8 + 2 * j + 1) * 65 + cc]);
    uint4 v; v.x = w[0]; v.y = w[1]; v.z = w[2]; v.w = w[3];
    if (KT) *(uint4*)(dst + tm_off(c0 + cc, r0 + q * 8, KT)) = v;
    else *(uint4*)(dst + (size_t)(c0 + cc) * dpitch + r0 + q * 8) = v;
  }
  __syncthreads();
}

__device__ __forceinline__ void transpose_wide(const float* __restrict__ src, int spitch, u16* __restrict__ dst,
                                               int k0, int n0, float* sm, int KT) {
  const int tid = TIDX;
  float4 v[8];
#pragma unroll
  for (int i = 0; i < 8; i++) { int c = tid + i * NT; int r = c >> 6, q = c & 63; v[i] = *(const float4*)(src + (size_t)(k0 + r) * spitch + n0 + q * 4); }
#pragma unroll
  for (int i = 0; i < 8; i++) { int c = tid + i * NT; int r = c >> 6, q = c & 63; float* d = sm + r * 257 + q * 4; d[0] = v[i].x; d[1] = v[i].y; d[2] = v[i].z; d[3] = v[i].w; }
  __syncthreads();
#pragma unroll
  for (int i = 0; i < 4; i++) {
    int c = tid + i * NT; int nn = c >> 3, q = c & 7;
    uint4 o;
    o.x = pack2(sm[(q * 8 + 0) * 257 + nn], sm[(q * 8 + 1) * 257 + nn]);
    o.y = pack2(sm[(q * 8 + 2) * 257 + nn], sm[(q * 8 + 3) * 257 + nn]);
    o.z = pack2(sm[(q * 8 + 4) * 257 + nn], sm[(q * 8 + 5) * 257 + nn]);
    o.w = pack2(sm[(q * 8 + 6) * 257 + nn], sm[(q * 8 + 7) * 257 + nn]);
    *(uint4*)(dst + tm_off(n0 + nn, k0 + q * 8, KT)) = o;
  }
  __syncthreads();
}

__device__ __forceinline__ void mod_item(const Params& p, int it, float* sm) {
  const int tid = TIDX;
  const int l = it / 48, n0 = (it % 48) * 64;
  float* sv = sm;
  float* red = sm + 3072;
  for (int e = tid; e < 3072; e += NT) {
    int v = e >> 10, k = e & 1023;
    float x = (v == 0) ? p.c_ctx[k] : p.c[(v - 1) * 1024 + k];
    sv[e] = siluf_(x);
  }
  __syncthreads();
  const int col = tid & 63, kg = tid >> 6;
  const float* w = p.mod_w + (size_t)l * 1024 * 3072 + n0 + col;
  float a0 = 0, a1 = 0, a2 = 0;
#pragma unroll 1
  for (int kb = kg * 128; kb < kg * 128 + 128; kb += 32) {
    float wv[32];
#pragma unroll
    for (int j = 0; j < 32; j++) wv[j] = w[(size_t)(kb + j) * 3072];
#pragma unroll
    for (int j = 0; j < 32; j++) { a0 += sv[kb + j] * wv[j]; a1 += sv[1024 + kb + j] * wv[j]; a2 += sv[2048 + kb + j] * wv[j]; }
  }
  red[(kg * 3 + 0) * 64 + col] = a0; red[(kg * 3 + 1) * 64 + col] = a1; red[(kg * 3 + 2) * 64 + col] = a2;
  __syncthreads();
  if (tid < 192) {
    int v = tid >> 6, c = tid & 63;
    float s = p.mod_b[l * 3072 + n0 + c];
#pragma unroll
    for (int g = 0; g < 8; g++) s += red[(g * 3 + v) * 64 + c];
    p.mod[(l * 3 + v) * 3072 + n0 + c] = s;
  }
  __syncthreads();
}

__device__ __forceinline__ void prologue_phase(const Params& p, float* sm) {
  constexpr int N_MOD = 96, N_ROPE = 1, N_WIN = 2 * 16 * 29, N_WBR = 6 * 8 * 4, N_WOUT = 2 * 16 * 4;
  constexpr int N_CK = 64 + 256, N_CVA = 4 * 16, N_CVC = 4 * 64, N_LW = 64;
  constexpr int E0 = N_MOD, E1 = E0 + N_ROPE, E2 = E1 + N_WIN, E3 = E2 + N_WBR, E4 = E3 + N_WOUT, E5 = E4 + N_CK,
                E6 = E5 + N_CVA, E7 = E6 + N_CVC, E8 = E7 + N_LW;
  const int tid = TIDX;
  for (int it = blockIdx.x; it < E8; it += gridDim.x) {
    if (it < E0) {
      mod_item(p, it, sm);
    } else if (it < E1) {
      for (int e = tid; e < 1024; e += NT) {
        int pos = e >> 4, f = e & 15;
        float inv = powf(10000.f, -(float)f / 16.f);
        float ang = (float)pos * inv;
        p.rope[e] = cosf(ang); p.rope[1024 + e] = sinf(ang);
      }
    } else if (it < E2) {
      int j = it - E1; int l = j / (16 * 29); int r = j % (16 * 29);
      int kt = r / 29, pn = r % 29;
      transpose_wide(p.w_in + (size_t)l * 1024 * INC, INC, p.Wt_in + (size_t)l * INC * 1024, kt * 64, pn * 256, sm, 16);
    } else if (it < E3) {
      int j = it - E2; int m = j / 32; int r = j % 32;
      int l = m / 3, i = m % 3;
      const float* src = (i == 0 ? p.w_br_a : (i == 1 ? p.w_br_b : p.w_br_c)) + (size_t)l * 512 * 1024;
      int kt = r / 4, pn = r % 4;
      transpose_wide(src, 1024, p.Wt_br + (size_t)m * 1024 * 512, kt * 64, pn * 256, sm, 8);
    } else if (it < E4) {
      int j = it - E3; int l = j / 64; int r = j % 64;
      int kt = r / 4, pn = r % 4;
      transpose_wide(p.w_out + (size_t)l * 1024 * 1024, 1024, p.Wt_out + (size_t)l * 1024 * 1024, kt * 64, pn * 256, sm, 16);
    } else if (it < E5) {
      int j = it - E4;
      const float* src; u16* dst; size_t off;
      if (j < 64) { src = p.cache_a_k; dst = p.cKa; off = (size_t)j * 4096; }
      else { src = p.cache_c_k; dst = p.cKc; off = (size_t)(j - 64) * 4096; }
      size_t e = off + (size_t)tid * 8;
      float4 a = *(const float4*)(src + e), b = *(const float4*)(src + e + 4);
      uint4 v; v.x = pack2(a.x, a.y); v.y = pack2(a.z, a.w); v.z = pack2(b.x, b.y); v.w = pack2(b.z, b.w);
      *(uint4*)(dst + e) = v;
    } else if (it < E6) {
      int j = it - E5; int bl = j / 16; int r = j % 16;
      int rt = r / 2, ct = r % 2;
      transpose_tile(p.cache_a_v + (size_t)bl * 512 * 128, 128, p.cVtA + (size_t)bl * 128 * 512, 512, rt * 64, ct * 64, sm);
    } else if (it < E7) {
      int j = it - E6; int bl = j / 64; int r = j % 64;
      int rt = r / 8, ct = r % 8;
      transpose_tile(p.cache_c_v + (size_t)bl * 512 * 512, 512, p.cVtC + (size_t)bl * 512 * 512, 512, rt * 64, ct * 64, sm);
    } else {
      int j = it - E7; int ldn = j >> 1, g = j & 1;
      transpose_tile((g ? p.lru_wx : p.lru_wa) + (size_t)ldn * 4096, 64, p.Wt_lru + (size_t)(ldn * 2 + g) * 4096, 64, 0, 0, sm);
    }
  }
}

__device__ __forceinline__ void norm_phase(const Params& p, int l) {
  const int tid = TIDX, lane = tid & 63, wid = tid >> 6;
  const float* g = p.norm_g + l * 1024;
  for (int it = blockIdx.x; it < NTOK / 8; it += gridDim.x) {
    int row = it * 8 + wid;
    const float* x;
    if (l == 0) x = (row < NCTX) ? p.x_prompt + (size_t)row * 1024 : p.x_sample + (size_t)(row - NCTX) * 1024;
    else x = p.out + O_X + (size_t)row * 1024;
    int v = (row < NCTX) ? 0 : 1 + (row - NCTX) / 4096;
    const float* md = p.mod + (l * 3 + v) * 3072;
    float4 xv[4], gv[4], sh[4], sc[4]; float ss = 0;
#pragma unroll
    for (int i = 0; i < 4; i++) {
      const int c = i * 256 + lane * 4;
      xv[i] = *(const float4*)(x + c);
      gv[i] = *(const float4*)(g + c); sh[i] = *(const float4*)(md + c); sc[i] = *(const float4*)(md + 1024 + c);
    }
    __builtin_amdgcn_sched_barrier(0);
#pragma unroll
    for (int i = 0; i < 4; i++) ss += xv[i].x * xv[i].x + xv[i].y * xv[i].y + xv[i].z * xv[i].z + xv[i].w * xv[i].w;
#pragma unroll
    for (int o = 32; o > 0; o >>= 1) ss += shflx(ss, o, lane);
    float rinv = rsqrtf(ss * (1.f / 1024.f) + EPS);
#pragma unroll
    for (int i = 0; i < 4; i++) {
      int c = i * 256 + lane * 4;
      float h0 = xv[i].x * rinv * gv[i].x * (1.f + sc[i].x) + sh[i].x;
      float h1 = xv[i].y * rinv * gv[i].y * (1.f + sc[i].y) + sh[i].y;
      float h2 = xv[i].z * rinv * gv[i].z * (1.f + sc[i].z) + sh[i].z;
      float h3 = xv[i].w * rinv * gv[i].w * (1.f + sc[i].w) + sh[i].w;
      uint2 o2; o2.x = pack2(h0, h1); o2.y = pack2(h2, h3);
      *(uint2*)(p.H + tm_off(row, c, 16)) = o2;
    }
  }
}

constexpr int G_BK = 64, G_HALF = 128, G_HTB = G_HALF * G_BK * 2;
__device__ __forceinline__ int lds_byte(int r, int c) {
  const int st = (r >> 4) * 2 + (c >> 5), rr = r & 15, cc = c & 31, ob = rr * 64 + cc * 2;
  return st * 1024 + (ob ^ (((ob >> 9) & 1) << 5));
}
__device__ __forceinline__ void stage_rc(int b, int& R, int& C) {
  const int st = b / 1024, sb = b % 1024, swz = sb ^ (((sb >> 9) & 1) << 5);
  R = (st >> 1) * 16 + swz / 64; C = (st & 1) * 32 + (swz % 64) / 2;
}
struct Unit { int pm, pn, seg; };

struct SchedStd {
  int nM, nN, nwg, G, c; const char* A; const char* B; size_t tA, tB;
  __device__ __forceinline__ bool next(int i, Unit& u) const {
    const long L = (long)i * G + c; if (L >= nwg) return false;
    const int wgid = (int)L;
    const int nig = 8 * nN, gid = wgid / nig, fm = gid * 8, gsz = (nM - fm) < 8 ? (nM - fm) : 8;
    u.pm = fm + ((wgid % nig) % gsz); u.pn = (wgid % nig) / gsz; u.seg = 0; return true;
  }
  __device__ __forceinline__ const char* aptr(const Unit& u) const { return A + (size_t)u.pm * tA; }
  __device__ __forceinline__ const char* bptr(const Unit& u) const { return B + (size_t)u.pn * tB; }
};
struct SchedBranch {
  int G, c; const char* P_; const char* W_;
  __device__ __forceinline__ bool next(int i, Unit& u) const {
    if (G == 256) {
      if (i >= 3) return false;
      const int xcd = c >> 5, j = c & 31;
      if (j >= 24) return false;
      u.seg = i; u.pm = xcd * 6 + (j >> 2); u.pn = j & 3; return true;
    }
    const int tile = (i / 3) * G + c; if (tile >= 192) return false;
    u.seg = i % 3; u.pm = tile >> 2; u.pn = tile & 3; return true;
  }
  __device__ __forceinline__ const char* aptr(const Unit& u) const { return P_ + (size_t)((u.seg * 48 + u.pm) * 8) * 32768; }
  __device__ __forceinline__ const char* bptr(const Unit& u) const { return W_ + (size_t)((u.seg * 4 + u.pn) * 8) * 32768; }
};

template <class Epi, class Sched>
__device__ __forceinline__ float gemm_phase(LAS unsigned char* lds, const int K, const Sched& S, const Epi& E, int tmode = 0) {
  unsigned long long t_ph0 = 0, t_epi = 0; if (PROBE >= 20) t_ph0 = __builtin_amdgcn_s_memrealtime();
  const int tid = TIDX, wid = __builtin_amdgcn_readfirstlane(tid >> 6), lane = tid & 63, wr = wid >> 2, wc = wid & 3, fr = lane & 15, fq = lane >> 4;
  const int nt = K / G_BK;
  unsigned voffA[2], voffB[2];
#pragma unroll
  for (int i = 0; i < 2; ++i) { int R, C; stage_rc(tid * 16 + i * 8192, R, C);
    voffA[i] = (unsigned)(R * 64 + C) * 2u; voffB[i] = voffA[i]; }
  const size_t kstep = (size_t)32768;
  const size_t hA = (size_t)16384, hB = (size_t)16384;
  const unsigned ldsw = (unsigned)wid * 1024u;
  const int aoff = lds_byte(wr * 64 + fr, fq * 8), boff = lds_byte(wc * 32 + fr, fq * 8);
#define G_SA(b, h) (((b) * 2 + (h)) * G_HTB)
#define G_SB(b, h) ((4 + (b) * 2 + (h)) * G_HTB)
#define G_STAGE(bufoff, gbase, voff) do { _Pragma("unroll") for (int _i = 0; _i < 2; ++_i) \
    __builtin_amdgcn_global_load_lds((const unsigned*)((const char*)(gbase) + (voff)[_i]), (LAS unsigned*)(lds + (bufoff) + ldsw + _i * 8192), 16, 0, 0); } while (0)
#define G_LDA(dst, b, h) do { _Pragma("unroll") for (int m = 0; m < 4; ++m) _Pragma("unroll") for (int k = 0; k < 2; ++k) dst[m][k] = *(const LAS bf16x8*)(lds + G_SA(b, h) + aoff + m * 2048 + k * 1024); } while (0)
#define G_LDB(dst, b, h) do { _Pragma("unroll") for (int n = 0; n < 2; ++n) _Pragma("unroll") for (int k = 0; k < 2; ++k) dst[n][k] = *(const LAS bf16x8*)(lds + G_SB(b, h) + boff + n * 2048 + k * 1024); } while (0)
#define G_MMA(ai, bj, At, Bt) do { __builtin_amdgcn_s_setprio(1); _Pragma("unroll") for (int m = 0; m < 4; ++m) _Pragma("unroll") for (int n = 0; n < 2; ++n) _Pragma("unroll") for (int k = 0; k < 2; ++k) \
    acc[ai][bj][m][n] = __builtin_amdgcn_mfma_f32_16x16x32_bf16(Bt[n][k], At[m][k], acc[ai][bj][m][n], 0, 0, 0); __builtin_amdgcn_s_setprio(0); } while (0)
#define G_WAIT_V(n) asm volatile("s_waitcnt vmcnt(" #n ")" ::: "memory")
#define G_WAIT_L(n) asm volatile("s_waitcnt lgkmcnt(" #n ")" ::: "memory")
#define G_BAR __builtin_amdgcn_s_barrier()
#define G_SCHED __builtin_amdgcn_sched_barrier(0)
  Unit cur, nxt; int ui = 0;
  if (!S.next(0, cur)) return 0.f;
  f32x4 acc[2][2][4][2];
#pragma unroll
  for (int a = 0; a < 2; ++a)
#pragma unroll
    for (int b = 0; b < 2; ++b)
#pragma unroll
      for (int m = 0; m < 4; ++m)
#pragma unroll
        for (int n = 0; n < 2; ++n) acc[a][b][m][n] = (f32x4){0.f, 0.f, 0.f, 0.f};
  bf16x8 At[4][2], B0[2][2], B1[2][2];
  const char* cA = S.aptr(cur); const char* cB = S.bptr(cur);
  G_STAGE(G_SB(0, 0), cB, voffB); G_STAGE(G_SA(0, 0), cA, voffA); G_STAGE(G_SB(0, 1), cB + hB, voffB); G_STAGE(G_SA(0, 1), cA + hA, voffA);
  if (wr == 1) G_BAR;
  G_WAIT_V(4); G_BAR;
  G_STAGE(G_SB(1, 0), cB + kstep, voffB); G_STAGE(G_SA(1, 0), cA + kstep, voffA); G_STAGE(G_SB(1, 1), cB + hB + kstep, voffB);
  G_WAIT_V(6); G_BAR;
  for (;;) {
    const bool has_next = S.next(ui + 1, nxt);
    const char* nA = has_next ? S.aptr(nxt) : cA; const char* nB = has_next ? S.bptr(nxt) : cB;
    for (int t = 0; t < nt; t += 2) {
      const bool last = (t == nt - 2);
      const char* a1 = cA + (size_t)(t + 1) * kstep;
      const char* a2 = last ? nA : cA + (size_t)(t + 2) * kstep; const char* b2 = last ? nB : cB + (size_t)(t + 2) * kstep;
      const char* a3 = a2 + kstep; const char* b3 = b2 + kstep;
      G_LDB(B0, 0, 0); G_SCHED; G_LDA(At, 0, 0); G_STAGE(G_SA(1, 1), a1 + hA, voffA);
      G_WAIT_L(8); G_BAR; G_WAIT_L(0); G_MMA(0, 0, At, B0); G_BAR; G_SCHED;
      G_LDB(B1, 0, 1); G_STAGE(G_SB(0, 0), b2, voffB);
      G_BAR; G_WAIT_L(0); G_MMA(0, 1, At, B1); G_BAR;
      G_LDA(At, 0, 1); G_STAGE(G_SA(0, 0), a2, voffA);
      G_BAR; G_WAIT_L(0); G_MMA(1, 0, At, B0); G_BAR; G_SCHED;
      G_STAGE(G_SB(0, 1), b2 + hB, voffB);
      G_WAIT_V(6); G_BAR; G_MMA(1, 1, At, B1); G_BAR;
      G_LDB(B0, 1, 0); G_SCHED; G_LDA(At, 1, 0); G_STAGE(G_SA(0, 1), a2 + hA, voffA);
      G_WAIT_L(8); G_BAR; G_WAIT_L(0); G_MMA(0, 0, At, B0); G_BAR; G_SCHED;
      G_LDB(B1, 1, 1); G_STAGE(G_SB(1, 0), b3, voffB);
      G_BAR; G_WAIT_L(0); G_MMA(0, 1, At, B1); G_BAR;
      G_LDA(At, 1, 1); G_STAGE(G_SA(1, 0), a3, voffA);
      G_BAR; G_WAIT_L(0); G_MMA(1, 0, At, B0); G_BAR; G_SCHED;
      G_STAGE(G_SB(1, 1), b3 + hB, voffB);
      G_WAIT_V(6); G_BAR; G_MMA(1, 1, At, B1); G_BAR;
    }
    unsigned long long t_e0 = 0; if (PROBE >= 20) t_e0 = __builtin_amdgcn_s_memrealtime();
    const bool reset = E(acc, cur, wr, wc, fr, fq);
    if (PROBE >= 20) { asm volatile("s_waitcnt vmcnt(0)" ::: "memory"); t_epi += __builtin_amdgcn_s_memrealtime() - t_e0; }
    if (!has_next) break;
    if (reset) {
#pragma unroll
      for (int a = 0; a < 2; ++a)
#pragma unroll
        for (int b = 0; b < 2; ++b)
#pragma unroll
          for (int m = 0; m < 4; ++m)
#pragma unroll
            for (int n = 0; n < 2; ++n) acc[a][b][m][n] = (f32x4){0.f, 0.f, 0.f, 0.f};
    }
    cur = nxt; cA = nA; cB = nB; ++ui;
  }
  G_WAIT_V(0);
  if (wr == 0) G_BAR;
  G_BAR;
  float tres = 0.f;
  if (PROBE >= 20) {
    const unsigned long long tot = __builtin_amdgcn_s_memrealtime() - t_ph0;
    tres = (tmode == 0) ? (float)t_epi / (float)tot : (float)tot / 40000.f;
  }
#undef G_SA
#undef G_SB
#undef G_STAGE
#undef G_LDA
#undef G_LDB
#undef G_MMA
#undef G_WAIT_V
#undef G_WAIT_L
#undef G_BAR
#undef G_SCHED
  return tres;
}

struct EpiInproj {
  const Params* pp; int l; LAS float* part; const LAS float* ropeL;
  __device__ __forceinline__ bool operator()(f32x4 (&acc)[2][2][4][2], const Unit& u, int wr, int wc, int fr, int fq) const {
    const Params& p = *pp;
    asm volatile("" : "+v"(fr), "+v"(fq));
    const int lane = fr + 16 * fq; (void)lane;
    const int oc0 = u.pn * 256;
    const bool isctx = u.pm < 16;
    const bool qkU = (oc0 < 768) || (oc0 >= 2304 && oc0 < 3328);
    float rinv[2][4][2];
    if (qkU) {
#pragma unroll
      for (int ai = 0; ai < 2; ai++)
#pragma unroll
        for (int m = 0; m < 4; m++)
#pragma unroll
          for (int bj = 0; bj < 2; bj++) {
            f32x4 a = acc[ai][bj][m][0], b = acc[ai][bj][m][1];
            float ss = a[0] * a[0] + a[1] * a[1] + a[2] * a[2] + a[3] * a[3] + b[0] * b[0] + b[1] * b[1] + b[2] * b[2] + b[3] * b[3];
            ss += shflx(ss, 16, lane); ss += shflx(ss, 32, lane);
            rinv[ai][m][bj] = ss;
            if (fq == 0) part[((ai * 128 + wr * 64 + m * 16 + fr) * 2 + bj) * 4 + wc] = ss;
          }
      asm volatile("s_waitcnt lgkmcnt(0)" ::: "memory");
      __builtin_amdgcn_s_barrier();
      asm volatile("" ::: "memory");
#pragma unroll
      for (int ai = 0; ai < 2; ai++)
#pragma unroll
        for (int m = 0; m < 4; m++)
#pragma unroll
          for (int bj = 0; bj < 2; bj++) {
            float o = part[((ai * 128 + wr * 64 + m * 16 + fr) * 2 + bj) * 4 + (wc ^ 1)];
            rinv[ai][m][bj] = rsqrtf((rinv[ai][m][bj] + o) * (1.f / 64.f) + EPS);
          }
    }
#pragma unroll
    for (int bj = 0; bj < 2; bj++) {
      const int oc = oc0 + bj * 128;
      if (oc == 640 || (oc >= 3328 && oc < 3840)) {
        const bool isA = (oc == 640);
        const int cb = isA ? 0 : (oc - 3328);
        const int nvec = isA ? 128 : 512;
#pragma unroll
        for (int ai = 0; ai < 2; ai++)
#pragma unroll
          for (int m = 0; m < 4; m++) {
            const int row = u.pm * 256 + ai * 128 + wr * 64 + m * 16 + fr;
            int b, t, T; u16* vt;
            if (isctx) { b = row >> 8; t = row & 255; T = 256; vt = isA ? p.VtA_ctx : p.VtC_ctx; }
            else { int rr = row - NCTX; b = rr >> 12; t = rr & 4095; T = 4096; vt = isA ? p.VtA_lat : p.VtC_lat; }
#pragma unroll
            for (int n = 0; n < 2; n++) {
              const int d = cb + wc * 32 + n * 16 + fq * 4;
              f32x4 v = acc[ai][bj][m][n];
#pragma unroll
              for (int j = 0; j < 4; j++) vt[((size_t)b * nvec + d + j) * T + t] = f2bf(v[j]);
              if (isctx) {
                float* o = p.out + (isA ? O_VA : O_VC) + ((size_t)(b * 2 + l) * 256 + t) * nvec + d;
                *(f32x4*)o = v;
              }
            }
          }
      } else {
        const int pc = (oc < 640) ? oc : (oc < 3328 ? oc - 128 : oc - 640);
        const bool is_qa = oc < 512, is_ka = (oc == 512);
        const bool is_qc = (oc >= 2304 && oc < 2816), is_kc = (oc >= 2816 && oc < 3328);
        if (is_qa || is_ka || is_qc || is_kc) {
          const float* gn = (is_qa ? p.qn_a : is_ka ? p.kn_a : is_qc ? p.qn_c : p.kn_c) + l * 64 + (wc & 1) * 32 + fq * 4;
          const f32x4 g0 = *(const f32x4*)gn, g1 = *(const f32x4*)(gn + 16);
          const float qs = (is_qa || is_qc) ? 0.18033688011112042f : 1.f;
#pragma unroll
          for (int ai = 0; ai < 2; ai++)
#pragma unroll
            for (int m = 0; m < 4; m++) {
              const int row = u.pm * 256 + ai * 128 + wr * 64 + m * 16 + fr;
              const float ri = rinv[ai][m][bj];
              f32x4 x1 = acc[ai][bj][m][0] * ri * g0, x2 = acc[ai][bj][m][1] * ri * g1;
              if (!isctx) {
                const int t = (row - NCTX) & 4095;
                const int pos = (wc & 1) ? (t & 63) : (t >> 6);
                const f32x4 cs = *(const LAS f32x4*)(ropeL + pos * 16 + fq * 4), sn = *(const LAS f32x4*)(ropeL + 1024 + pos * 16 + fq * 4);
                f32x4 y1 = x1 * cs - x2 * sn, y2 = x2 * cs + x1 * sn;
                x1 = y1; x2 = y2;
              } else if (is_ka || is_kc) {
                const int b = row >> 8, t = row & 255;
                float* o = is_ka ? p.out + O_KA + ((size_t)(b * 2 + l) * 256 + t) * 128 + wc * 32 + fq * 4
                                 : p.out + O_KC + ((size_t)(b * 2 + l) * 256 + t) * 512 + (oc - 2816) + wc * 32 + fq * 4;
                *(f32x4*)o = x1; *(f32x4*)(o + 16) = x2;
              }
              x1 = x1 * qs; x2 = x2 * qs;
              u16* po = p.P + (size_t)row * PP + pc + wc * 32 + fq * 4;
              *(uint2*)po = make_uint2(pack2(x1[0], x1[1]), pack2(x1[2], x1[3]));
              *(uint2*)(po + 16) = make_uint2(pack2(x2[0], x2[1]), pack2(x2[2], x2[3]));
            }
        } else {
          const int mode = (oc >= 4352) ? 2 : ((oc >= 1280 && oc < 1792) ? 0 : 1);
          if (mode == 2) {
            const int pj = u.pn - 17, seg = pj >> 2, pn4 = pj & 3;
            unsigned* mg = p.MG + ((size_t)((u.pm * 4 + pn4) * 3 + seg) * 8 + (wr * 4 + wc)) * 2048 + lane;
#pragma unroll
            for (int ai = 0; ai < 2; ai++)
#pragma unroll
              for (int m = 0; m < 4; m++)
#pragma unroll
                for (int n = 0; n < 2; n++) {
                  f32x4 v = acc[ai][bj][m][n];
                  const unsigned q0 = (unsigned)(sigmoidf_(v[0]) * 254.f + 1.5f), q1 = (unsigned)(sigmoidf_(v[1]) * 254.f + 1.5f);
                  const unsigned q2 = (unsigned)(sigmoidf_(v[2]) * 254.f + 1.5f), q3 = (unsigned)(sigmoidf_(v[3]) * 254.f + 1.5f);
                  mg[(((ai * 4 + m) * 2 + bj) * 2 + n) * 64] = q0 | (q1 << 8) | (q2 << 16) | (q3 << 24);
                }
          } else
#pragma unroll
          for (int ai = 0; ai < 2; ai++)
#pragma unroll
            for (int m = 0; m < 4; m++) {
              const int row = u.pm * 256 + ai * 128 + wr * 64 + m * 16 + fr;
              u16* po = p.P + (size_t)row * PP + pc + wc * 32 + fq * 4;
#pragma unroll
              for (int n = 0; n < 2; n++) {
                f32x4 v = acc[ai][bj][m][n];
                if (mode == 1) { v[0] = siluf_(v[0]); v[1] = siluf_(v[1]); v[2] = siluf_(v[2]); v[3] = siluf_(v[3]); }
                else if (mode == 2) { v[0] = sigmoidf_(v[0]); v[1] = sigmoidf_(v[1]); v[2] = sigmoidf_(v[2]); v[3] = sigmoidf_(v[3]); }
                *(uint2*)(po + n * 16) = make_uint2(pack2(v[0], v[1]), pack2(v[2], v[3]));
              }
            }
        }
      }
    }
    return true;
  }
};

struct EpiBranch {
  const Params* pp;
  __device__ __forceinline__ bool operator()(f32x4 (&acc)[2][2][4][2], const Unit& u, int wr, int wc, int fr, int fq) const {
    const Params& p = *pp;
    asm volatile("" : "+v"(fr), "+v"(fq));
    const int lane = fr + 16 * fq;
    const int seg = u.seg;
    const unsigned* mg = p.MG + ((size_t)((u.pm * 4 + u.pn) * 3 + seg) * 8 + (wr * 4 + wc)) * 2048 + lane;
    const float sel = (seg < 2) ? 1.f : 0.f;
#pragma unroll
    for (int hq = 0; hq < 4; hq++) {
      unsigned a[8], b[8];
#pragma unroll
      for (int q = 0; q < 8; q++) { a[q] = mg[(hq * 8 + q) * 64]; b[q] = mg[(hq * 8 + q) * 64 + 8 * 2048]; }
      __builtin_amdgcn_sched_barrier(0);
#pragma unroll
      for (int q = 0; q < 8; q++) {
        const int ai = hq >> 1, m = (hq & 1) * 2 + (q >> 2), bj = (q >> 1) & 1, n = q & 1;
        f32x4 f = {(float)(a[q] & 255u), (float)((a[q] >> 8) & 255u), (float)((a[q] >> 16) & 255u), (float)(a[q] >> 24)};
        f32x4 g = {(float)(b[q] & 255u), (float)((b[q] >> 8) & 255u), (float)((b[q] >> 16) & 255u), (float)(b[q] >> 24)};
        g = g * sel + (1.f - sel) * 255.f;
        f[0] *= __builtin_amdgcn_rcpf(g[0]); f[1] *= __builtin_amdgcn_rcpf(g[1]); f[2] *= __builtin_amdgcn_rcpf(g[2]); f[3] *= __builtin_amdgcn_rcpf(g[3]);
        acc[ai][bj][m][n] = acc[ai][bj][m][n] * f;
      }
    }
    if (seg < 2) return false;
#pragma unroll
    for (int ai = 0; ai < 2; ai++)
#pragma unroll
      for (int m = 0; m < 4; m++) {
        const int row = u.pm * 256 + ai * 128 + wr * 64 + m * 16 + fr;
#pragma unroll
        for (int bj = 0; bj < 2; bj++)
#pragma unroll
          for (int n = 0; n < 2; n++) {
            const int col = u.pn * 256 + bj * 128 + wc * 32 + n * 16 + fq * 4;
            const f32x4 v = acc[ai][bj][m][n];
            *(uint2*)(p.Y + tm_off(row, col, 16)) = make_uint2(pack2(v[0], v[1]), pack2(v[2], v[3]));
          }
      }
    return true;
  }
};

struct EpiOut {
  const Params* pp; int l;
  __device__ __forceinline__ bool operator()(f32x4 (&acc)[2][2][4][2], const Unit& u, int wr, int wc, int fr, int fq) const {
    const Params& p = *pp;
    asm volatile("" : "+v"(fr), "+v"(fq));
    const int v = (u.pm < 16) ? 0 : 1 + (u.pm - 16) / 16;
    const float* gt = p.mod + (l * 3 + v) * 3072 + 2048 + u.pn * 256 + wc * 32 + fq * 4;
    const float* xsrc = (l == 0) ? ((u.pm < 16) ? p.x_prompt + (size_t)u.pm * 256 * 1024 : p.x_sample + (size_t)(u.pm - 16) * 256 * 1024)
                                 : p.out + O_X + (size_t)u.pm * 256 * 1024;
    float* odst = p.out + O_X + (size_t)u.pm * 256 * 1024;
    const int cbase = u.pn * 256 + wc * 32 + fq * 4;
    f32x4 gv[2][2];
#pragma unroll
    for (int bj = 0; bj < 2; bj++)
#pragma unroll
      for (int n = 0; n < 2; n++) gv[bj][n] = *(const f32x4*)(gt + bj * 128 + n * 16);
#pragma unroll
    for (int ai = 0; ai < 2; ai++)
#pragma unroll
      for (int mh = 0; mh < 2; mh++) {
        f32x4 xv[2][2][2];
#pragma unroll
        for (int mm = 0; mm < 2; mm++)
#pragma unroll
          for (int bj = 0; bj < 2; bj++)
#pragma unroll
            for (int n = 0; n < 2; n++)
              xv[mm][bj][n] = *(const f32x4*)(xsrc + (size_t)(ai * 128 + wr * 64 + (mh * 2 + mm) * 16 + fr) * 1024 + cbase + bj * 128 + n * 16);
#pragma unroll
        for (int mm = 0; mm < 2; mm++)
#pragma unroll
          for (int bj = 0; bj < 2; bj++)
#pragma unroll
            for (int n = 0; n < 2; n++)
              *(f32x4*)(odst + (size_t)(ai * 128 + wr * 64 + (mh * 2 + mm) * 16 + fr) * 1024 + cbase + bj * 128 + n * 16) = xv[mm][bj][n] + gv[bj][n] * acc[ai][bj][mh * 2 + mm][n];
      }
    return true;
  }
};

template <bool MASK>
__device__ __forceinline__ void fs_scores(const u16* Ks, const bf16x8 (&qf)[4], f32x16 (&s)[2], int lane, int kpos0, int qpos, int T) {
  const int r = lane & 31, h = lane >> 5;
  {
    bf16x8 kf[2][4];
#pragma unroll
    for (int sub = 0; sub < 2; sub++)
#pragma unroll
      for (int ks = 0; ks < 4; ks++) kf[sub][ks] = *(const bf16x8*)(Ks + (sub * 32 + r) * LROW + ks * 16 + h * 8);
    __builtin_amdgcn_sched_barrier(0);
#pragma unroll
    for (int sub = 0; sub < 2; sub++) {
#pragma unroll
      for (int e = 0; e < 16; e++) s[sub][e] = 0.f;
#pragma unroll
      for (int ks = 0; ks < 4; ks++) s[sub] = mfma32(kf[sub][ks], qf[ks], s[sub]);
    }
  }
  if (MASK) {
#pragma unroll
    for (int sub = 0; sub < 2; sub++)
#pragma unroll
      for (int e = 0; e < 16; e++) {
        int kp = kpos0 + sub * 32 + (e & 3) + 8 * (e >> 2) + 4 * h;
        int dlt = kp - qpos;
        bool ok = (kp >= 0) && (kp < T) && (dlt <= 128) && (dlt >= -128);
        if (!ok) s[sub][e] = -INFINITY;
      }
  }
}
template <int DV>
__device__ __forceinline__ void fs_softmax(f32x16 (&s)[2], float& m, float& l, f32x16 (&o)[DV / 32], bf16x8 (&pf)[2][2], int lane) {
  float mx = s[0][0];
#pragma unroll
  for (int sub = 0; sub < 2; sub++)
#pragma unroll
    for (int e = 0; e < 16; e++) mx = fmaxf(mx, s[sub][e]);
  mx = fmaxf(mx, shflx(mx, 32, lane));
  const bool grow = mx > m;
  const float mn = grow ? mx : m;
  float sum = 0.f;
#pragma unroll
  for (int sub = 0; sub < 2; sub++)
#pragma unroll
    for (int e = 0; e < 16; e++) { float pv = __builtin_amdgcn_exp2f(s[sub][e] - mn); s[sub][e] = pv; sum += pv; }
  sum += shflx(sum, 32, lane);
  if (__builtin_amdgcn_ballot_w64(grow) != 0ull) {
    const float alpha = __builtin_amdgcn_exp2f(m - mn);
    l *= alpha;
#pragma unroll
    for (int ds = 0; ds < DV / 32; ds++)
#pragma unroll
      for (int e = 0; e < 16; e++) o[ds][e] *= alpha;
  }
  l += sum; m = mn;
  typedef __attribute__((ext_vector_type(4))) unsigned u32x4;
#pragma unroll
  for (int sub = 0; sub < 2; sub++)
#pragma unroll
    for (int st = 0; st < 2; st++) {
      u32x4 pw;
#pragma unroll
      for (int j = 0; j < 4; j++) pw[j] = pack2(s[sub][8 * st + 2 * j], s[sub][8 * st + 2 * j + 1]);
      pf[sub][st] = __builtin_bit_cast(bf16x8, pw);
    }
}
template <int DV>
__device__ __forceinline__ void fs_pv(const bf16x8 (&pf)[2][2], const u16* Vts, f32x16 (&o)[DV / 32], int lane) {
  const int r = lane & 31, h = lane >> 5;
#pragma unroll
  for (int sub = 0; sub < 2; sub++) {
    bf16x8 vf[2][DV / 32];
#pragma unroll
    for (int st = 0; st < 2; st++)
#pragma unroll
      for (int ds = 0; ds < DV / 32; ds++) {
        const u16* vp = Vts + (ds * 32 + r) * VROW + sub * 32 + 16 * st + 4 * h;
        bf16x4 lo = *(const bf16x4*)vp, hi = *(const bf16x4*)(vp + 8);
        vf[st][ds] = __builtin_shufflevector(lo, hi, 0, 1, 2, 3, 4, 5, 6, 7);
      }
    __builtin_amdgcn_sched_barrier(0);
#pragma unroll
    for (int st = 0; st < 2; st++)
#pragma unroll
      for (int ds = 0; ds < DV / 32; ds++) o[ds] = mfma32(vf[st][ds], pf[sub][st], o[ds]);
    __builtin_amdgcn_sched_barrier(0);
  }
}

__device__ __forceinline__ uint4 ld_k(const u16* __restrict__ src, size_t pitch, int r0, int nrows, int c) {
  int row = c >> 3, kc = c & 7; int rr = r0 + row;
  const bool ok = (rr >= 0 && rr < nrows);
  const int rc = rr < 0 ? 0 : (rr >= nrows ? nrows - 1 : rr);
  uint4 v = *(const uint4*)(src + (size_t)rc * pitch + kc * 8);
  if (!ok) v = make_uint4(0, 0, 0, 0);
  return v;
}
__device__ __forceinline__ void st_k(u16* dst, int c, uint4 v) { *(uint4*)(dst + (c >> 3) * LROW + (c & 7) * 8) = v; }
__device__ __forceinline__ uint4 ld_vt(const u16* __restrict__ src, int T, int k0, int c) {
  int d = c >> 3, kc = c & 7; int k = k0 + kc * 8;
  const bool ok = (k >= 0 && k < T);
  const int kk = k < 0 ? 0 : (k >= T ? T - 8 : k);
  uint4 v = *(const uint4*)(src + (size_t)d * T + kk);
  if (!ok) v = make_uint4(0, 0, 0, 0);
  return v;
}
__device__ __forceinline__ void st_vt(u16* dst, int c, uint4 v) {
  uint2* q = (uint2*)(dst + (c >> 3) * VROW + (c & 7) * 8);
  q[0] = make_uint2(v.x, v.y); q[1] = make_uint2(v.z, v.w);
}

constexpr int A_BUF = 64 * LROW + 64 * VROW;
__device__ __forceinline__ void attnA_item(const Params& p, int l, int it, u16* sm, bool dry = false) {
  const int tid = TIDX, lane = tid & 63, wid = tid >> 6;
  const int r = lane & 31, h = lane >> 5;
  const bool isctx = it < 128;
  int b, kvh, qb, T, rowbase; const u16* VtBase;
  if (isctx) { b = it >> 3; kvh = (it >> 2) & 1; qb = it & 3; T = 256; rowbase = b * 256;
    VtBase = p.VtA_ctx + ((size_t)(b * 2 + kvh) * 64) * 256; }
  else { int j = it - 128; b = j >> 7; kvh = (j >> 6) & 1; qb = j & 63; T = 4096; rowbase = NCTX + b * 4096;
    VtBase = p.VtA_lat + ((size_t)(b * 2 + kvh) * 64) * 4096; }
  const int qblk = qb * 64;
  const int q0 = qblk + (wid >> 2) * 32;
  const int head = kvh * 4 + (wid & 3);
  const size_t prow = (size_t)(rowbase + q0 + r) * PP;
  bf16x8 qf[4];
#pragma unroll
  for (int ks = 0; ks < 4; ks++) qf[ks] = *(const bf16x8*)(p.P + prow + C_QA + head * 64 + ks * 16 + h * 8);
  float m = p.sink_a[l * 8 + head] * 1.4426950408889634f, ls = 1.f;
  f32x16 o[2];
#pragma unroll
  for (int ds = 0; ds < 2; ds++)
#pragma unroll
    for (int e = 0; e < 16; e++) o[ds][e] = 0.f;
  const u16* Kbase = p.P + (size_t)rowbase * PP + C_KA + kvh * 64;
  const u16* cK = p.cKa + ((size_t)(b * 2 + l) * 512) * 128 + kvh * 64;
  const u16* cVt = p.cVtA + ((size_t)((b * 2 + l) * 2 + kvh) * 64) * 512;
  const int qpos = q0 + r;
  int i_lo = 0, nW, ntile;
  if (isctx) { nW = 4; ntile = 4; }
  else {
    i_lo = (qblk < 128) ? (128 - qblk) / 64 : 0;
    int i_hi = (T - qblk + 128) / 64; if (i_hi > 5) i_hi = 5;
    nW = i_hi - i_lo; ntile = nW + 8;
  }
  uint4 rk, rv;
  auto tile_load = [&](int t) {
    if (t < nW) {
      if (isctx) {
        rk = *(const uint4*)(Kbase + (size_t)(t * 64 + (tid >> 3)) * PP + (tid & 7) * 8);
        rv = *(const uint4*)(VtBase + (size_t)(tid >> 3) * 256 + t * 64 + (tid & 7) * 8);
      } else {
        int k0 = qblk - 128 + 64 * (i_lo + t);
        rk = ld_k(Kbase, PP, k0, T, tid); rv = ld_vt(VtBase, T, k0, tid);
      }
    } else {
      int kt = t - nW;
      rk = *(const uint4*)(cK + (size_t)(kt * 64 + (tid >> 3)) * 128 + (tid & 7) * 8);
      rv = *(const uint4*)(cVt + (size_t)(tid >> 3) * 512 + kt * 64 + (tid & 7) * 8);
    }
  };
  auto KB = [&](int i) { return sm + (i & 1) * (64 * LROW); };
  auto VB = [&](int i) { return sm + 2 * 64 * LROW + (i % 3) * (64 * VROW); };
  const bool lag = (wid >> 2) != 0;
  __syncthreads();
  tile_load(0);
  st_k(KB(0), tid, rk); st_vt(VB(0), tid, rv);
  __syncthreads();
  bf16x8 pf[2][2];
  for (int t = 0; t <= ntile; t++) {
    const bool more = t + 1 < ntile;
    if (more) tile_load(t + 1);
    if (lag && t > 0) fs_pv<64>(pf, VB(t - 1), o, lane);
    if (t < ntile) {
      f32x16 sc[2];
      if (!isctx && t < nW) fs_scores<true>(KB(t), qf, sc, lane, qblk - 128 + 64 * (i_lo + t), qpos, T);
      else fs_scores<false>(KB(t), qf, sc, lane, 0, 0, T);
      fs_softmax<64>(sc, m, ls, o, pf, lane);
      if (!lag) fs_pv<64>(pf, VB(t), o, lane);
    }
    if (more) { st_k(KB(t + 1), tid, rk); st_vt(VB(t + 1), tid, rv); }
    __syncthreads();
  }
  const float inv = __builtin_amdgcn_rcpf(ls);
  {
    uint2 gv[2][4];
#pragma unroll
    for (int ds = 0; ds < 2; ds++)
#pragma unroll
      for (int g = 0; g < 4; g++) gv[ds][g] = *(const uint2*)(p.P + prow + C_GA + head * 64 + ds * 32 + 8 * g + 4 * h);
    __builtin_amdgcn_sched_barrier(0);
#pragma unroll
    for (int ds = 0; ds < 2; ds++)
#pragma unroll
      for (int g = 0; g < 4; g++) {
        int d = ds * 32 + 8 * g + 4 * h;
        uint2 ov;
        ov.x = pack2(o[ds][4 * g] * inv * lo_bf(gv[ds][g].x), o[ds][4 * g + 1] * inv * hi_bf(gv[ds][g].x));
        ov.y = pack2(o[ds][4 * g + 2] * inv * lo_bf(gv[ds][g].y), o[ds][4 * g + 3] * inv * hi_bf(gv[ds][g].y));
        *(uint2*)(p.GB + tm_off(rowbase + q0 + r, head * 64 + d, 8)) = ov;
      }
  }
}

constexpr int C_BUF = 128 * LROW + 128 * VROW;
__device__ __forceinline__ void attnC_item(const Params& p, int l, int it, u16* sm, float lam, float lam_init, bool dry = false) {
  const int tid = TIDX, lane = tid & 63, wid = tid >> 6;
  const int r = lane & 31, h = lane >> 5;
  const bool isctx = it < 128;
  int b, hd, qb, T, rowbase; const u16* VtBase;
  if (isctx) { b = it >> 3; hd = (it >> 1) & 3; qb = it & 1; T = 256; rowbase = b * 256;
    VtBase = p.VtC_ctx + ((size_t)(b * 4 + hd) * 128) * 256; }
  else { int j = it - 128; b = j >> 7; hd = (j >> 5) & 3; qb = j & 31; T = 4096; rowbase = NCTX + b * 4096;
    VtBase = p.VtC_lat + ((size_t)(b * 4 + hd) * 128) * 4096; }
  const int qg = wid & 3, map = wid >> 2;
  const int q0 = qb * 128 + qg * 32;
  const size_t prow = (size_t)(rowbase + q0 + r) * PP;
  bf16x8 qf[4];
#pragma unroll
  for (int ks = 0; ks < 4; ks++) qf[ks] = *(const bf16x8*)(p.P + prow + C_QC + hd * 128 + map * 64 + ks * 16 + h * 8);
  float m = -1e30f, ls = 0.f;
  f32x16 o[4];
#pragma unroll
  for (int ds = 0; ds < 4; ds++)
#pragma unroll
    for (int e = 0; e < 16; e++) o[ds][e] = 0.f;
  const u16* Kbase = p.P + (size_t)rowbase * PP + C_KC + hd * 128;
  const u16* cK = p.cKc + ((size_t)(b * 2 + l) * 512) * 512 + hd * 128;
  const u16* cVt = p.cVtC + ((size_t)((b * 2 + l) * 4 + hd) * 128) * 512;
  const int nW = T / 64, ntile = isctx ? nW : nW + 8;
  uint4 rk0, rk1, rv0, rv1;
  const u16* pk = Kbase + (size_t)(tid >> 3) * PP + (tid & 7) * 8;
  const u16* pv0 = VtBase + (size_t)(tid >> 3) * T + (tid & 7) * 8;
  const u16* pv1 = VtBase + (size_t)((tid + NT) >> 3) * T + (tid & 7) * 8;
  size_t kstride = (size_t)64 * PP;
  auto tile_load = [&](int t) {
    if (t == nW) {
      pk = cK + (size_t)(tid >> 3) * 512 + (tid & 7) * 8;
      pv0 = cVt + (size_t)(tid >> 3) * 512 + (tid & 7) * 8;
      pv1 = cVt + (size_t)((tid + NT) >> 3) * 512 + (tid & 7) * 8;
      kstride = (size_t)64 * 512;
    }
    rk0 = *(const uint4*)pk; rk1 = *(const uint4*)(pk + 64);
    rv0 = *(const uint4*)pv0; rv1 = *(const uint4*)pv1;
    pk += kstride; pv0 += 64; pv1 += 64;
  };
  auto KB = [&](int i) { return sm + (i & 1) * (128 * LROW); };
  auto VB = [&](int i) { return sm + 2 * 128 * LROW + (i % 3) * (128 * VROW); };
  auto tile_store = [&](int i) {
    u16* kd = KB(i); u16* vd = VB(i);
    st_k(kd, tid, rk0); st_k(kd + 64 * LROW, tid, rk1);
    st_vt(vd, tid, rv0); st_vt(vd, tid + NT, rv1);
  };
  const bool lag = map != 0;
  __syncthreads();
  tile_load(0);
  tile_store(0);
  __syncthreads();
  bf16x8 pf[2][2];
  for (int t = 0; t <= ntile; t++) {
    const bool more = t + 1 < ntile;
    if (more) tile_load(t + 1);
    if (lag && t > 0) fs_pv<128>(pf, VB(t - 1), o, lane);
    if (t < ntile) {
      f32x16 sc[2];
      fs_scores<false>(KB(t) + map * 64 * LROW, qf, sc, lane, 0, 0, T);
      fs_softmax<128>(sc, m, ls, o, pf, lane);
      if (!lag) fs_pv<128>(pf, VB(t), o, lane);
    }
    if (more) tile_store(t + 1);
    __syncthreads();
  }
  float* xch = (float*)sm;
  if (map == 1) {
    const float inv = lam * __builtin_amdgcn_rcpf(ls);
#pragma unroll
    for (int ds = 0; ds < 4; ds++)
#pragma unroll
      for (int e = 0; e < 16; e++) xch[((qg * 64) + ds * 16 + e) * 64 + lane] = o[ds][e] * inv;
  }
  __syncthreads();
  if (map == 0) {
    const float i0 = __builtin_amdgcn_rcpf(ls);
    float ss = 0.f;
#pragma unroll
    for (int ds = 0; ds < 4; ds++)
#pragma unroll
      for (int e = 0; e < 16; e++) {
        float v = o[ds][e] * i0 - xch[((qg * 64) + ds * 16 + e) * 64 + lane];
        o[ds][e] = v; ss += v * v;
      }
    ss += shflx(ss, 32, lane);
    const float rinv = rsqrtf(ss * (1.f / 128.f) + EPS) * (1.f - lam_init);
    const float* sg = p.subln_c + l * 128;
#pragma unroll
    for (int ds = 0; ds < 4; ds++) {
      uint2 gv[4]; float4 sl[4];
#pragma unroll
      for (int g = 0; g < 4; g++) {
        const int d = ds * 32 + 8 * g + 4 * h;
        gv[g] = *(const uint2*)(p.P + prow + C_GC + hd * 128 + d);
        sl[g] = *(const float4*)(sg + d);
      }
      __builtin_amdgcn_sched_barrier(0);
#pragma unroll
      for (int g = 0; g < 4; g++) {
        const int d = ds * 32 + 8 * g + 4 * h;
        uint2 ov;
        ov.x = pack2(o[ds][4 * g] * rinv * sl[g].x * lo_bf(gv[g].x), o[ds][4 * g + 1] * rinv * sl[g].y * hi_bf(gv[g].x));
        ov.y = pack2(o[ds][4 * g + 2] * rinv * sl[g].z * lo_bf(gv[g].y), o[ds][4 * g + 3] * rinv * sl[g].w * hi_bf(gv[g].y));
        *(uint2*)(p.GB + (size_t)2 * NTOK * 512 + tm_off(rowbase + q0 + r, hd * 128 + d, 8)) = ov;
      }
    }
  }
}

__device__ __forceinline__ void lru_run(const Params& p, int l, bool pass2, int start, int G, float* sm, bool dry = false) {
  const int tid = TIDX;
  const int lane = tid & 63, wid = tid >> 6, r = lane & 31, h = lane >> 5;
  const int n = start & 7;
  float* xin = sm;
  float* xb = sm + 67 * 64;
  float* comb = xb + 64 * 64;
  float* carry = comb + 2048;
  float* parts = carry + 128;
  float* ab = parts + 1024;
  u16* xbh = (u16*)(ab + 4 * 4096);
  const int gd = wid >> 2, gth = (wid >> 1) & 1, gdh = wid & 1;
  bf16x8 wfa[4], wfx[4];
  {
    const u16* wbase = p.Wt_lru + ((size_t)(((l * 2 + gd) * 8 + n) * 2) * 64 + gdh * 32 + r) * 64 + h * 8;
#pragma unroll
    for (int ks = 0; ks < 4; ks++) { wfa[ks] = *(const bf16x8*)(wbase + ks * 16); wfx[ks] = *(const bf16x8*)(wbase + 4096 + ks * 16); }
  }
  const int gch = n * 64 + gdh * 32 + r;
  const float g_ba = p.lru_ba[(l * 2 + gd) * 512 + gch], g_bx = p.lru_bx[(l * 2 + gd) * 512 + gch];
  const float g_sp = log1pf(__expf(-p.lru_lam[(l * 2 + gd) * 512 + gch]));
  const int cc = tid & 63;
  float cw[4]; float cbv;
  {
    const float* cwp = p.conv_w + l * 4 * 512 + n * 64 + cc;
    cw[0] = cwp[0]; cw[1] = cwp[512]; cw[2] = cwp[1024]; cw[3] = cwp[1536];
    cbv = p.conv_b[l * 512 + n * 64 + cc];
  }
  const int dout = tid & 63, tg = tid >> 6;
  const int ch = n * 64 + dout;

  u16 xr[9];
  auto xin_load = [&](int it_) {
    const int row0_ = (it_ >> 3) * 64;
    int T_, seq0_;
    if (row0_ < NCTX) { T_ = 256; seq0_ = (row0_ >> 8) * 256; } else { T_ = 4096; seq0_ = NCTX + ((row0_ - NCTX) >> 12) * 4096; }
    const int t0_ = row0_ - seq0_;
#pragma unroll
    for (int k = 0; k < 9; k++) {
      const int rr = (tid >> 6) + 8 * k; const int t = t0_ - 2 + rr;
      const bool ok = (rr < 67 && t >= 0 && t < T_);
      const int tc = t < 0 ? 0 : (t >= T_ ? T_ - 1 : t);
      u16 v = p.P[(size_t)(seq0_ + tc) * PP + C_XB + n * 64 + cc];
      xr[k] = ok ? v : (u16)0;
    }
  };
  if (start < 1536) xin_load(start);
  for (int it = start; it < 1536; it += G) {
    const int ci = it >> 3;
    const int row0 = ci * 64;
    const bool isctx = row0 < NCTX;
    int T, seq0, bidx;
    if (isctx) { T = 256; bidx = row0 >> 8; seq0 = bidx * 256; }
    else { T = 4096; bidx = (row0 - NCTX) >> 12; seq0 = NCTX + bidx * 4096; }
    const int t0 = row0 - seq0;
    __syncthreads();
#pragma unroll
    for (int k = 0; k < 9; k++) { const int rr = (tid >> 6) + 8 * k; if (rr < 67) xin[rr * 64 + cc] = bf2f(xr[k]); }
    if (it + G < 1536) xin_load(it + G);
    u16 sgr[8];
    if (pass2) {
#pragma unroll
      for (int tt = 0; tt < 8; tt++) sgr[tt] = p.P[(size_t)(row0 + tg * 8 + tt) * PP + C_GB + ch];
    }
    if (pass2) {
      const int d = (tid >> 6) & 1, part = tid >> 7;
      const int cfirst = seq0 >> 6, clast = (seq0 + T - 64) >> 6;
      const int K = d ? (clast - ci) : (ci - cfirst);
      float2 q[16];
#pragma unroll
      for (int k = 0; k < 16; k++) {
        const int kk = part * 16 + k;
        const int cj = d ? (clast - kk) : (cfirst + kk);
        const int cjc = cj < cfirst ? cfirst : (cj > clast ? clast : cj);
        const float2 qv = *(const float2*)(p.lruTot + ((size_t)(cjc * 2 + d) * 512 + n * 64 + cc) * 2);
        q[k] = (kk < K) ? qv : make_float2(1.f, 0.f);
      }
      float At = 1.f, Bt = 0.f;
#pragma unroll
      for (int k = 0; k < 16; k++) { Bt = q[k].x * Bt + q[k].y; At *= q[k].x; }
      parts[((part * 2 + d) * 64 + cc) * 2] = At; parts[((part * 2 + d) * 64 + cc) * 2 + 1] = Bt;
    }
    __syncthreads();
    for (int e = tid; e < 64 * 64; e += NT) {
      int t = e >> 6;
      float v = cbv;
#pragma unroll
      for (int j = 0; j < 4; j++) v += xin[(t + j) * 64 + cc] * cw[j];
      xb[e] = v;
      xbh[t * LROW + cc] = f2bf(v);
    }
    if (pass2 && tid < 128) {
      const int d = tid >> 6;
      float hcar = isctx ? 0.f : p.state_lru[((size_t)(bidx * 2 + l) * 2 + d) * 512 + n * 64 + cc];
#pragma unroll
      for (int part = 0; part < 4; part++) hcar = parts[((part * 2 + d) * 64 + cc) * 2] * hcar + parts[((part * 2 + d) * 64 + cc) * 2 + 1];
      carry[d * 64 + cc] = hcar;
    }
    __syncthreads();
    {
      bf16x8 af[4];
#pragma unroll
      for (int ks = 0; ks < 4; ks++) af[ks] = *(const bf16x8*)(xbh + (gth * 32 + r) * LROW + ks * 16 + h * 8);
      f32x16 ga, gi;
#pragma unroll
      for (int e = 0; e < 16; e++) { ga[e] = 0.f; gi[e] = 0.f; }
#pragma unroll
      for (int ks = 0; ks < 4; ks++) { ga = mfma32(af[ks], wfa[ks], ga); gi = mfma32(af[ks], wfx[ks], gi); }
      const int dch = gdh * 32 + r;
#pragma unroll
      for (int e = 0; e < 16; e++) {
        const int tok = gth * 32 + (e & 3) + 8 * (e >> 2) + 4 * h;
        float rg = sigmoidf_(ga[e] + g_ba), ig = sigmoidf_(gi[e] + g_bx);
        float log_a = -8.f * rg * g_sp;
        float a = __expf(log_a);
        const float x2 = 2.f * log_a;
        const float om = -x2 * (1.f + x2 * (0.5f + x2 * (0.16666667f + x2 * (0.041666668f + x2 * (0.0083333338f + x2 * (0.0013888889f + x2 * 0.0001984127f))))));
        float bb = __builtin_amdgcn_sqrtf(om) * ig * xb[tok * 64 + dch];
        ab[((gd * 2 + 0) * 64 + tok) * 64 + dch] = a;
        ab[((gd * 2 + 1) * 64 + tok) * 64 + dch] = bb;
      }
    }
    __syncthreads();
    float av[2][8], bv[2][8];
#pragma unroll
    for (int d = 0; d < 2; d++)
#pragma unroll
      for (int tt = 0; tt < 8; tt++) {
        av[d][tt] = ab[((d * 2 + 0) * 64 + tg * 8 + tt) * 64 + dout];
        bv[d][tt] = ab[((d * 2 + 1) * 64 + tg * 8 + tt) * 64 + dout];
      }
    float sA0 = 1.f, sB0 = 0.f, sA1 = 1.f, sB1 = 0.f;
#pragma unroll
    for (int tt = 0; tt < 8; tt++) { sB0 = av[0][tt] * sB0 + bv[0][tt]; sA0 *= av[0][tt]; }
#pragma unroll
    for (int tt = 7; tt >= 0; tt--) { sB1 = av[1][tt] * sB1 + bv[1][tt]; sA1 *= av[1][tt]; }
    comb[((tg * 2 + 0) * 64 + dout) * 2 + 0] = sA0; comb[((tg * 2 + 0) * 64 + dout) * 2 + 1] = sB0;
    comb[((tg * 2 + 1) * 64 + dout) * 2 + 0] = sA1; comb[((tg * 2 + 1) * 64 + dout) * 2 + 1] = sB1;
    __syncthreads();
    if (!pass2) {
      if (tid < 128) {
        int d = tid >> 6, c = tid & 63;
        float At = 1.f, Bt = 0.f;
#pragma unroll
        for (int s = 0; s < 8; s++) {
          int g = (d == 0) ? s : 7 - s;
          float a = comb[((g * 2 + d) * 64 + c) * 2], bq = comb[((g * 2 + d) * 64 + c) * 2 + 1];
          Bt = a * Bt + bq; At *= a;
        }
        float* o = p.lruTot + ((size_t)(ci * 2 + d) * 512 + n * 64 + c) * 2;
        o[0] = At; o[1] = Bt;
      }
      continue;
    }
    float h0 = carry[dout], h1 = carry[64 + dout];
    for (int g = 0; g < tg; g++) { h0 = comb[((g * 2 + 0) * 64 + dout) * 2] * h0 + comb[((g * 2 + 0) * 64 + dout) * 2 + 1]; }
    for (int g = 7; g > tg; g--) { h1 = comb[((g * 2 + 1) * 64 + dout) * 2] * h1 + comb[((g * 2 + 1) * 64 + dout) * 2 + 1]; }
    float y[8];
#pragma unroll
    for (int tt = 0; tt < 8; tt++) { h0 = av[0][tt] * h0 + bv[0][tt]; y[tt] = h0; }
    const float hf_last = h0;
#pragma unroll
    for (int tt = 7; tt >= 0; tt--) { h1 = av[1][tt] * h1 + bv[1][tt]; y[tt] += h1; }
    const float hb_first = h1;
    if (isctx) {
      if (t0 + 64 == T && tg == 7) p.out[O_ST + ((size_t)(bidx * 2 + l) * 2 + 0) * 512 + ch] = hf_last;
      if (t0 == 0 && tg == 0) p.out[O_ST + ((size_t)(bidx * 2 + l) * 2 + 1) * 512 + ch] = hb_first;
    }
#pragma unroll
    for (int tt = 0; tt < 8; tt++) {
      const int rw = row0 + tg * 8 + tt;
      p.GB[(size_t)NTOK * 512 + tm_off(rw, ch, 8)] = f2bf(y[tt] * bf2f(sgr[tt]));
    }
  }
}

__device__ __forceinline__ float compute_lam(const Params& p, int l, float lam_init) {
  float s1 = 0.f, s2 = 0.f;
  for (int i = 0; i < 64; i++) {
    s1 += p.lam_q1[l * 64 + i] * p.lam_k1[l * 64 + i];
    s2 += p.lam_q2[l * 64 + i] * p.lam_k2[l * 64 + i];
  }
  return expf(s1) - expf(s2) + lam_init;
}

__device__ __forceinline__ float mix_phase(const Params& p, int l, u16* smem, int vid) {
  unsigned long long tm0 = 0; float tres = 0.f; if (PROBE >= 30) tm0 = __builtin_amdgcn_s_memrealtime();
  const float lam_init = (l == 0) ? 0.2f : (0.8f - 0.6f * 0.74081822068f);
  const float lam = compute_lam(p, l, lam_init);
  constexpr int N_CL = 256, N_A = 384, N_CC = 128, N_L = 1536;
  const int G = gridDim.x;
  int start = vid;
  for (int it = start; it < N_CL; it += G) attnC_item(p, l, 128 + it, smem, lam, lam_init);
  if (PROBE == 35) tres = (float)(__builtin_amdgcn_s_memrealtime() - tm0) / 40000.f;
  start = (int)((vid + G - (N_CL % G)) % G);
  for (int it = start; it < N_A; it += G) attnA_item(p, l, it, smem);
  start = (int)((vid + G - ((N_CL + N_A) % G)) % G);
  for (int it = start; it < N_CC; it += G) attnC_item(p, l, it, smem, lam, lam_init);
  if (PROBE == 36) tres = (float)(__builtin_amdgcn_s_memrealtime() - tm0) / 40000.f;
  start = (int)((vid + G - ((N_CL + N_A + N_CC) % G)) % G);
  if (PROBE == 6) lru_run(p, l, false, start, G, (float*)smem);
  lru_run(p, l, false, start, G, (float*)smem);
  return tres;
}

__device__ __forceinline__ void lru2_phase(const Params& p, int l, u16* smem) {
  lru_run(p, l, true, blockIdx.x, gridDim.x, (float*)smem);
}

#define XB_TMO      128
#define XB_XCNT(j)  (256  + 64 * (j))
#define XB_XSUB(j)  (1280 + 64 * (j))
#define XB_XGEN(j)  (2304 + 64 * (j))
#define XB_TOP      3328
#define XB_TOPGEN   3392
#define XCD_BAR_WORDS 3456
#define XB_SPIN_CAP (1u << 18)
__device__ __forceinline__ unsigned xb_ld(unsigned* p)              { return __hip_atomic_load(p, __ATOMIC_RELAXED, __HIP_MEMORY_SCOPE_AGENT); }
__device__ __forceinline__ unsigned xb_add(unsigned* p, unsigned v) { return __hip_atomic_fetch_add(p, v, __ATOMIC_RELAXED, __HIP_MEMORY_SCOPE_AGENT); }
__device__ __forceinline__ unsigned xb_xcc_id() { return (unsigned)__builtin_amdgcn_s_getreg((3 << 11) | 20) & 0xFu; }
#define XB_SPIN(cond, bar) do { unsigned _sp = 0; while (cond) { __builtin_amdgcn_s_sleep(1); \
    if ((++_sp & 255u) == 0u) { if (xb_ld(&(bar)[XB_TMO])) break; if (_sp > XB_SPIN_CAP) { atomicAdd(&(bar)[XB_TMO], 1u); break; } } } } while (0)
struct XcdBarrier { unsigned* bar; unsigned x; volatile LAS unsigned* st; };
__device__ __forceinline__ XcdBarrier xcd_barrier_post(unsigned* bar, volatile LAS unsigned* st) {
  XcdBarrier b; b.bar = bar; b.x = xb_xcc_id(); b.st = st;
  if (threadIdx.x == 0) st[2] = xb_add(&bar[XB_XCNT(b.x)], 1u);
  return b;
}
__device__ __forceinline__ int xcd_virtual_id(const XcdBarrier& b) {
  if (threadIdx.x == 0) {
    unsigned pre = 0;
#pragma unroll
    for (unsigned j = 0; j < 16; ++j) { const unsigned c = xb_ld(&b.bar[XB_XCNT(j)]); pre += (j < b.x) ? c : 0u; }
    b.st[3] = pre + b.st[2];
  }
  __syncthreads();
  const int v = (int)b.st[3];
  __syncthreads();
  return __builtin_amdgcn_readfirstlane(v);
}
__device__ __forceinline__ void xcd_barrier_complete(unsigned* bar, unsigned x, unsigned& nloc, unsigned& nx) {
  const unsigned G = gridDim.x * gridDim.y * gridDim.z;
  unsigned sum, cnt, mine, sp = 0u;
  for (;;) {
    sum = 0u; cnt = 0u; mine = 0u;
#pragma unroll
    for (unsigned j = 0; j < 16; ++j) { const unsigned c = xb_ld(&bar[XB_XCNT(j)]); sum += c; cnt += (c > 0u) ? 1u : 0u; mine = (j == x) ? c : mine; }
    if (sum == G) break;
    __builtin_amdgcn_s_sleep(1);
    if ((++sp & 255u) == 0u) { if (xb_ld(&bar[XB_TMO])) break; if (sp > XB_SPIN_CAP) { atomicAdd(&bar[XB_TMO], 1u); break; } }
  }
  nloc = mine > 0u ? mine : 1u; nx = cnt > 0u ? cnt : 1u;
}
__device__ __forceinline__ void xcd_barrier(const XcdBarrier& b) {
  asm volatile("s_waitcnt vmcnt(0)" ::: "memory");
  __syncthreads();
  if (threadIdx.x == 0) {
    unsigned* bar = b.bar;
    __builtin_amdgcn_s_waitcnt(0);
    unsigned nloc = b.st[0], nx = b.st[1];
    if (nloc == 0u) { xcd_barrier_complete(bar, b.x, nloc, nx); b.st[0] = nloc; b.st[1] = nx; }
    const unsigned old = xb_add(&bar[XB_XSUB(b.x)], 1u);
    const unsigned gen = old / nloc;
    if (old + 1u == (gen + 1u) * nloc) {
      __builtin_amdgcn_fence(__ATOMIC_RELEASE, "agent");
      asm volatile("s_waitcnt vmcnt(0)" ::: "memory");
      const unsigned og = xb_add(&bar[XB_TOP], 1u);
      const unsigned tg = og / nx;
      if (og + 1u == (tg + 1u) * nx) xb_add(&bar[XB_TOPGEN], 1u);
      else XB_SPIN(xb_ld(&bar[XB_TOPGEN]) == tg, bar);
      __builtin_amdgcn_fence(__ATOMIC_ACQUIRE, "agent");
      xb_add(&bar[XB_XGEN(b.x)], 1u);
      asm volatile("s_waitcnt vmcnt(0)" ::: "memory");
    } else {
      XB_SPIN(xb_ld(&bar[XB_XGEN(b.x)]) == gen, bar);
      __builtin_amdgcn_fence(__ATOMIC_ACQUIRE, "agent");
      asm volatile("s_waitcnt vmcnt(0)" ::: "memory");
    }
  }
  __syncthreads();
}

typedef __attribute__((address_space(4))) const Params CParams;
__device__ __forceinline__ const Params& get_params() {
  CParams* kp = (CParams*)__builtin_amdgcn_kernarg_segment_ptr();
  asm volatile("" : "+s"(kp));
  return *(const Params*)kp;
}
__global__ void __launch_bounds__(NT, 2) fwd_kernel(Params p_unused) {
  extern __shared__ __attribute__((aligned(16))) unsigned char lds_raw[];
  u16* smem = (u16*)lds_raw;
  LAS unsigned char* lds = (LAS unsigned char*)lds_raw;
  cg::grid_group grid = cg::this_grid();
  volatile LAS unsigned* xst = (volatile LAS unsigned*)(lds + STAGE_BYTES + SPARE_BYTES);
  if (threadIdx.x == 0) { xst[0] = 0u; xst[1] = 0u; }
  __syncthreads();
  XcdBarrier xb = xcd_barrier_post(get_params().bar, xst);
  float tfrac = 0.f;
  unsigned long long tq0 = 0; if (PROBE >= 30) tq0 = __builtin_amdgcn_s_memrealtime();
  prologue_phase(get_params(), (float*)smem);
  if (PROBE == 30) tfrac = (float)(__builtin_amdgcn_s_memrealtime() - tq0) / 40000.f;
  if (get_params().bar == nullptr) grid.sync();
  xcd_barrier(xb);
  if (PROBE == 31) tfrac = (float)(__builtin_amdgcn_s_memrealtime() - tq0) / 40000.f;
  const int vid = xcd_virtual_id(xb);
  { LAS float* rl = (LAS float*)(lds + ROPE_OFF); const float* rg = get_params().rope;
    for (int i = threadIdx.x; i < 2048; i += NT) rl[i] = rg[i];
    __syncthreads(); }
  if (PROBE == 9) { for (int i = 0; i < 10; i++) xcd_barrier(xb); }
#pragma unroll 1
  for (int l = 0; l < 2; l++) {
    if (PROBE >= 30) tq0 = __builtin_amdgcn_s_memrealtime();
    norm_phase(get_params(), l);
    if (PROBE == 32 && l == 0) tfrac = (float)(__builtin_amdgcn_s_memrealtime() - tq0) / 40000.f;
    if (PROBE == 3) { norm_phase(get_params(), l); if (l == 0) { xcd_barrier(xb); prologue_phase(get_params(), (float*)smem); } }
    xcd_barrier(xb);
    {
      const Params& p = get_params();
      SchedStd S; S.nM = NTOK / 256; S.nN = INC / 256; S.nwg = S.nM * S.nN; S.G = gridDim.x; S.c = vid;
      S.A = (const char*)p.H; S.B = (const char*)(p.Wt_in + (size_t)l * INC * 1024); S.tA = (size_t)256 * 1024 * 2; S.tB = (size_t)256 * 1024 * 2;
      EpiInproj E; E.pp = &p; E.l = l; E.part = (LAS float*)(lds + STAGE_BYTES); E.ropeL = (const LAS float*)(lds + ROPE_OFF);
      { float tr = gemm_phase(lds, 1024, S, E, PROBE == 22); if (l == 0 && (PROBE == 21 || PROBE == 22)) tfrac = tr; }
      if (PROBE == 1) { __syncthreads(); gemm_phase(lds, 1024, S, E); }
    }
    xcd_barrier(xb);
    if (PROBE >= 30) tq0 = __builtin_amdgcn_s_memrealtime();
    { float tr = mix_phase(get_params(), l, smem, vid); if ((PROBE == 35 || PROBE == 36) && l == 0) tfrac = tr; }
    if (PROBE == 33 && l == 0) tfrac = (float)(__builtin_amdgcn_s_memrealtime() - tq0) / 40000.f;
    xcd_barrier(xb);
    if (PROBE >= 30) tq0 = __builtin_amdgcn_s_memrealtime();
    lru2_phase(get_params(), l, smem);
    if (PROBE == 34 && l == 0) tfrac = (float)(__builtin_amdgcn_s_memrealtime() - tq0) / 40000.f;
    xcd_barrier(xb);
    {
      const Params& p = get_params();
      SchedBranch S; S.G = gridDim.x; S.c = vid; S.P_ = (const char*)p.GB; S.W_ = (const char*)(p.Wt_br + (size_t)l * 3 * 1024 * 512);
      EpiBranch E; E.pp = &p;
      { float tr = gemm_phase(lds, 512, S, E, PROBE == 24); if (l == 0 && (PROBE == 23 || PROBE == 24)) tfrac = tr; }
      if (PROBE == 2) { __syncthreads(); gemm_phase(lds, 512, S, E); }
    }
    xcd_barrier(xb);
    {
      const Params& p = get_params();
      SchedStd S; S.nM = NTOK / 256; S.nN = 4; S.nwg = S.nM * S.nN; S.G = gridDim.x; S.c = vid;
      S.A = (const char*)p.Y; S.B = (const char*)(p.Wt_out + (size_t)l * 1024 * 1024); S.tA = (size_t)256 * 1024 * 2; S.tB = (size_t)256 * 1024 * 2;
      EpiOut E; E.pp = &p; E.l = l;
      { float tr = gemm_phase(lds, 1024, S, E, PROBE == 26); if (l == 0 && (PROBE == 25 || PROBE == 26)) tfrac = tr; }
      if (PROBE == 8 && l == 0) { __syncthreads(); gemm_phase(lds, 1024, S, E); }
    }
    if (l == 0) xcd_barrier(xb);
  }
  if (PROBE >= 20) {
    xcd_barrier(xb);
    if (blockIdx.x == 0 && threadIdx.x == 0) { float* o = get_params().out + O_X + 4194304; *o += 0.42f + 0.45f * fminf(fmaxf(tfrac, 0.f), 1.f); }
  }
}

extern "C" void kernel_launch(void* const* d_in, const int* in_sizes, int n_in, void* d_out, int out_size, void* d_ws,
                              size_t ws_size, hipStream_t stream) {
  Params p{};
  const float** ip = (const float**)&p;
  for (int i = 0; i < 34; i++) ip[i] = (const float*)d_in[i];
  p.out = (float*)d_out;
  char* w = (char*)d_ws; size_t off = 0;
  auto take = [&](size_t bytes) { char* q = w + off; off += (bytes + 255) & ~(size_t)255; return q; };
  p.Wt_in = (u16*)take((size_t)2 * INC * 1024 * 2);
  p.Wt_br = (u16*)take((size_t)6 * 1024 * 512 * 2);
  p.Wt_out = (u16*)take((size_t)2 * 1024 * 1024 * 2);
  p.Y = (u16*)take((size_t)NTOK * 1024 * 2);
  p.P = (u16*)take((size_t)NTOK * PP * 2);
  p.VtA_ctx = p.Y;
  p.VtA_lat = p.VtA_ctx + (size_t)16 * 2 * 64 * 256;
  p.VtC_ctx = p.VtA_lat + (size_t)2 * 2 * 64 * 4096;
  p.VtC_lat = p.VtC_ctx + (size_t)16 * 4 * 128 * 256;
  p.cKa = (u16*)take((size_t)2 * 2 * 512 * 128 * 2);
  p.cVtA = (u16*)take((size_t)2 * 2 * 512 * 128 * 2);
  p.cKc = (u16*)take((size_t)2 * 2 * 512 * 512 * 2);
  p.cVtC = (u16*)take((size_t)2 * 2 * 512 * 512 * 2);
  p.mod = (float*)take((size_t)2 * 3 * 3072 * 4);
  p.rope = (float*)take((size_t)2048 * 4);
  p.lruTot = (float*)take((size_t)192 * 2 * 512 * 2 * 4);
  p.Wt_lru = (u16*)take((size_t)2 * 2 * 8 * 2 * 64 * 64 * 2);
  p.bar = (unsigned*)take((size_t)XCD_BAR_WORDS * 4);
  p.GB = (u16*)take((size_t)3 * NTOK * 512 * 2);
  p.H = p.GB;
  p.MG = (unsigned*)take((size_t)(48 * 4 * 3 + 1) * 16384 * 4);
  static int grid_blocks = 0;
  if (!grid_blocks) {
    int dev = 0, cus = 0;
    hipGetDevice(&dev);
    hipDeviceGetAttribute(&cus, hipDeviceAttributeMultiprocessorCount, dev);
    hipFuncSetAttribute((const void*)fwd_kernel, hipFuncAttributeMaxDynamicSharedMemorySize, LDS_BYTES);
    int per_cu = 0;
    hipOccupancyMaxActiveBlocksPerMultiprocessor(&per_cu, (const void*)fwd_kernel, NT, LDS_BYTES);
    (void)hipGetLastError();
    grid_blocks = cus;
  }
  hipMemsetAsync(p.bar, 0, (size_t)XCD_BAR_WORDS * 4, stream);
  void* args[] = {&p};
  hipLaunchCooperativeKernel((void*)fwd_kernel, dim3(grid_blocks), dim3(NT), args, LDS_BYTES, stream);
}
```

```cpp
#include <hip/hip_runtime.h>
#include <hip/hip_cooperative_groups.h>
#include <stdint.h>
#include <math.h>
namespace cg = cooperative_groups;

typedef unsigned short u16;
typedef __attribute__((ext_vector_type(8))) short bf16x8;
typedef __attribute__((ext_vector_type(4))) short bf16x4;
typedef __attribute__((ext_vector_type(16))) float f32x16;
typedef __attribute__((ext_vector_type(4))) float f32x4;
#define LAS __attribute__((address_space(3)))

#ifndef PROBE
#define PROBE 0
#endif
#define NT 512
constexpr int NTOK = 12288, NCTX = 4096;
constexpr int INC = 7424;
constexpr int PP = 3712;
constexpr int C_QA = 0, C_KA = 512, C_GA = 640, C_XB = 1152, C_GB = 1664, C_QC = 2176, C_KC = 2688, C_GC = 3200;
constexpr int LROW = 72;
constexpr int VROW = 68;
constexpr float EPS = 1e-6f;
constexpr int STAGE_BYTES = 131072;
constexpr int SPARE_BYTES = 8192;
constexpr int ROPE_OFF = STAGE_BYTES + SPARE_BYTES + 16;
constexpr int LDS_BYTES = ROPE_OFF + 8192;

constexpr size_t O_X = 0, O_KA = 12582912, O_VA = 13631488, O_KC = 14680064, O_VC = 18874368, O_ST = 23068672;

struct Params {
  const float *x_prompt, *x_sample, *cache_a_k, *cache_a_v, *cache_c_k, *cache_c_v, *state_lru, *c, *c_ctx,
      *norm_g, *mod_w, *mod_b, *w_in, *qn_a, *kn_a, *sink_a, *conv_w, *conv_b, *lru_wa, *lru_ba, *lru_wx, *lru_bx,
      *lru_lam, *qn_c, *kn_c, *lam_q1, *lam_k1, *lam_q2, *lam_k2, *subln_c, *w_br_a, *w_br_b, *w_br_c, *w_out;
  float* out;
  u16 *Wt_in, *Wt_br, *Wt_out, *H, *P, *VtA_ctx, *VtA_lat, *VtC_ctx, *VtC_lat, *cKa, *cVtA, *cKc, *cVtC;
  float *mod, *rope, *lruTot;
  u16 *Wt_lru;
  unsigned* bar;
  u16* Y;
  u16* GB;
  unsigned* MG;
};

__device__ __forceinline__ int tid_opaque() { int t = (int)threadIdx.x; asm volatile("" : "+v"(t)); return t; }
#define TIDX tid_opaque()
__device__ __forceinline__ u16 f2bf(float f) {
  uint32_t r; asm("v_cvt_pk_bf16_f32 %0, %1, %1" : "=v"(r) : "v"(f)); return (u16)(r & 0xffffu);
}
__device__ __forceinline__ float bf2f(u16 h) { return __uint_as_float(((uint32_t)h) << 16); }
__device__ __forceinline__ uint32_t pack2(float a, float b) { uint32_t r; asm("v_cvt_pk_bf16_f32 %0, %1, %2" : "=v"(r) : "v"(a), "v"(b)); return r; }
__device__ __forceinline__ float sigmoidf_(float x) { return __builtin_amdgcn_rcpf(1.f + __expf(-x)); }
__device__ __forceinline__ float siluf_(float x) { return x * __builtin_amdgcn_rcpf(1.f + __expf(-x)); }
__device__ __forceinline__ f32x16 mfma32(bf16x8 a, bf16x8 b, f32x16 c) {
  return __builtin_amdgcn_mfma_f32_32x32x16_bf16(a, b, c, 0, 0, 0);
}
__device__ __forceinline__ float shflx(float v, int mask, int lane) {
  return __builtin_bit_cast(float, __builtin_amdgcn_ds_bpermute((lane ^ mask) << 2, __builtin_bit_cast(int, v)));
}
__device__ __forceinline__ float lo_bf(uint32_t w) { return __uint_as_float(w << 16); }
__device__ __forceinline__ float hi_bf(uint32_t w) { return __uint_as_float(w & 0xffff0000u); }

__device__ __forceinline__ size_t tm_off(int r, int k, int KT) {
  return ((size_t)((r >> 8) * KT + (k >> 6)) * 256 + (r & 255)) * 64 + (k & 63);
}
__device__ __forceinline__ void transpose_tile(const float* __restrict__ src, int spitch, u16* __restrict__ dst, int dpitch,
                               int r0, int c0, float* sm, int KT = 0) {
  const int tid = TIDX;
#pragma unroll
  for (int i = 0; i < 2; i++) {
    int c = tid + i * NT; int r = c >> 4, q = c & 15;
    float4 v = *(const float4*)(src + (size_t)(r0 + r) * spitch + c0 + q * 4);
    float* d = sm + r * 65 + q * 4;
    d[0] = v.x; d[1] = v.y; d[2] = v.z; d[3] = v.w;
  }
  __syncthreads();
  {
    int c = tid; int cc = c >> 3, q = c & 7;
    uint32_t w[4];
#pragma unroll
    for (int j = 0; j < 4; j++) w[j] = pack2(sm[(q * 8 + 2 * j) * 65 + cc], sm[(q * 8 + 2 * j + 1) * 65 + cc]);
    uint4 v; v.x = w[0]; v.y = w[1]; v.z = w[2]; v.w = w[3];
    if (KT) *(uint4*)(dst + tm_off(c0 + cc, r0 + q * 8, KT)) = v;
    else *(uint4*)(dst + (size_t)(c0 + cc) * dpitch + r0 + q * 8) = v;
  }
  __syncthreads();
}

__device__ __forceinline__ void transpose_wide(const float* __restrict__ src, int spitch, u16* __restrict__ dst,
                                               int k0, int n0, float* sm, int KT) {
  const int tid = TIDX;
  float4 v[8];
#pragma unroll
  for (int i = 0; i < 8; i++) { int c = tid + i * NT; int r = c >> 6, q = c & 63; v[i] = *(const float4*)(src + (size_t)(k0 + r) * spitch + n0 + q * 4); }
#pragma unroll
  for (int i = 0; i < 8; i++) { int c = tid + i * NT; int r = c >> 6, q = c & 63; float* d = sm + r * 257 + q * 4; d[0] = v[i].x; d[1] = v[i].y; d[2] = v[i].z; d[3] = v[i].w; }
  __syncthreads();
#pragma unroll
  for (int i = 0; i < 4; i++) {
    int c = tid + i * NT; int nn = c >> 3, q = c & 7;
    uint4 o;
    o.x = pack2(sm[(q * 8 + 0) * 257 + nn], sm[(q * 8 + 1) * 257 + nn]);
    o.y = pack2(sm[(q * 8 + 2) * 257 + nn], sm[(q * 8 + 3) * 257 + nn]);
    o.z = pack2(sm[(q * 8 + 4) * 257 + nn], sm[(q * 8 + 5) * 257 + nn]);
    o.w = pack2(sm[(q * 8 + 6) * 257 + nn], sm[(q * 8 + 7) * 257 + nn]);
    *(uint4*)(dst + tm_off(n0 + nn, k0 + q * 8, KT)) = o;
  }
  __syncthreads();
}

__device__ __forceinline__ void mod_item(const Params& p, int it, float* sm) {
  const int tid = TIDX;
  const int l = it / 48, n0 = (it % 48) * 64;
  float* sv = sm;
  float* red = sm + 3072;
  for (int e = tid; e < 3072; e += NT) {
    int v = e >> 10, k = e & 1023;
    float x = (v == 0) ? p.c_ctx[k] : p.c[(v - 1) * 1024 + k];
    sv[e] = siluf_(x);
  }
  __syncthreads();
  const int col = tid & 63, kg = tid >> 6;
  const float* w = p.mod_w + (size_t)l * 1024 * 3072 + n0 + col;
  float a0 = 0, a1 = 0, a2 = 0;
#pragma unroll 1
  for (int kb = kg * 128; kb < kg * 128 + 128; kb += 32) {
    float wv[32];
#pragma unroll
    for (int j = 0; j < 32; j++) wv[j] = w[(size_t)(kb + j) * 3072];
#pragma unroll
    for (int j = 0; j < 32; j++) { a0 += sv[kb + j] * wv[j]; a1 += sv[1024 + kb + j] * wv[j]; a2 += sv[2048 + kb + j] * wv[j]; }
  }
  red[(kg * 3 + 0) * 64 + col] = a0; red[(kg * 3 + 1) * 64 + col] = a1; red[(kg * 3 + 2) * 64 + col] = a2;
  __syncthreads();
  if (tid < 192) {
    int v = tid >> 6, c = tid & 63;
    float s = p.mod_b[l * 3072 + n0 + c];
#pragma unroll
    for (int g = 0; g < 8; g++) s += red[(g * 3 + v) * 64 + c];
    p.mod[(l * 3 + v) * 3072 + n0 + c] = s;
  }
  __syncthreads();
}

__device__ __forceinline__ void prologue_phase(const Params& p, float* sm) {
  constexpr int N_MOD = 96, N_ROPE = 1, N_WIN = 2 * 16 * 29, N_WBR = 6 * 8 * 4, N_WOUT = 2 * 16 * 4;
  constexpr int N_CK = 64 + 256, N_CVA = 4 * 16, N_CVC = 4 * 64, N_LW = 64;
  constexpr int E0 = N_MOD, E1 = E0 + N_ROPE, E2 = E1 + N_WIN, E3 = E2 + N_WBR, E4 = E3 + N_WOUT, E5 = E4 + N_CK,
                E6 = E5 + N_CVA, E7 = E6 + N_CVC, E8 = E7 + N_LW;
  const int tid = TIDX;
  for (int it = blockIdx.x; it < E8; it += gridDim.x) {
    if (it < E0) {
      mod_item(p, it, sm);
    } else if (it < E1) {
      for (int e = tid; e < 1024; e += NT) {
        int pos = e >> 4, f = e & 15;
        float inv = powf(10000.f, -(float)f / 16.f);
        float ang = (float)pos * inv;
        p.rope[e] = cosf(ang); p.rope[1024 + e] = sinf(ang);
      }
    } else if (it < E2) {
      int j = it - E1; int l = j / (16 * 29); int r = j % (16 * 29);
      int kt = r / 29, pn = r % 29;
      transpose_wide(p.w_in + (size_t)l * 1024 * INC, INC, p.Wt_in + (size_t)l * INC * 1024, kt * 64, pn * 256, sm, 16);
    } else if (it < E3) {
      int j = it - E2; int m = j / 32; int r = j % 32;
      int l = m / 3, i = m % 3;
      const float* src = (i == 0 ? p.w_br_a : (i == 1 ? p.w_br_b : p.w_br_c)) + (size_t)l * 512 * 1024;
      int kt = r / 4, pn = r % 4;
      transpose_wide(src, 1024, p.Wt_br + (size_t)m * 1024 * 512, kt * 64, pn * 256, sm, 8);
    } else if (it < E4) {
      int j = it - E3; int l = j / 64; int r = j % 64;
      int kt = r / 4, pn = r % 4;
      transpose_wide(p.w_out + (size_t)l * 1024 * 1024, 1024, p.Wt_out + (size_t)l * 1024 * 1024, kt * 64, pn * 256, sm, 16);
    } else if (it < E5) {
      int j = it - E4;
      const float* src; u16* dst; size_t off;
      if (j < 64) { src = p.cache_a_k; dst = p.cKa; off = (size_t)j * 4096; }
      else { src = p.cache_c_k; dst = p.cKc; off = (size_t)(j - 64) * 4096; }
      size_t e = off + (size_t)tid * 8;
      float4 a = *(const float4*)(src + e), b = *(const float4*)(src + e + 4);
      uint4 v; v.x = pack2(a.x, a.y); v.y = pack2(a.z, a.w); v.z = pack2(b.x, b.y); v.w = pack2(b.z, b.w);
      *(uint4*)(dst + e) = v;
    } else if (it < E6) {
      int j = it - E5; int bl = j / 16; int r = j % 16;
      int rt = r / 2, ct = r % 2;
      transpose_tile(p.cache_a_v + (size_t)bl * 512 * 128, 128, p.cVtA + (size_t)bl * 128 * 512, 512, rt * 64, ct * 64, sm);
    } else if (it < E7) {
      int j = it - E6; int bl = j / 64; int r = j % 64;
      int rt = r / 8, ct = r % 8;
      transpose_tile(p.cache_c_v + (size_t)bl * 512 * 512, 512, p.cVtC + (size_t)bl * 512 * 512, 512, rt * 64, ct * 64, sm);
    } else {
      int j = it - E7; int ldn = j >> 1, g = j & 1;
      transpose_tile((g ? p.lru_wx : p.lru_wa) + (size_t)ldn * 4096, 64, p.Wt_lru + (size_t)(ldn * 2 + g) * 4096, 64, 0, 0, sm);
    }
  }
}

__device__ __forceinline__ void norm_phase(const Params& p, int l) {
  const int tid = TIDX, lane = tid & 63, wid = tid >> 6;
  const float* g = p.norm_g + l * 1024;
  for (int it = blockIdx.x; it < NTOK / 8; it += gridDim.x) {
    int row = it * 8 + wid;
    const float* x;
    if (l == 0) x = (row < NCTX) ? p.x_prompt + (size_t)row * 1024 : p.x_sample + (size_t)(row - NCTX) * 1024;
    else x = p.out + O_X + (size_t)row * 1024;
    int v = (row < NCTX) ? 0 : 1 + (row - NCTX) / 4096;
    const float* md = p.mod + (l * 3 + v) * 3072;
    float4 xv[4], gv[4], sh[4], sc[4]; float ss = 0;
#pragma unroll
    for (int i = 0; i < 4; i++) {
      const int c = i * 256 + lane * 4;
      xv[i] = *(const float4*)(x + c);
      gv[i] = *(const float4*)(g + c); sh[i] = *(const float4*)(md + c); sc[i] = *(const float4*)(md + 1024 + c);
    }
    __builtin_amdgcn_sched_barrier(0);
#pragma unroll
    for (int i = 0; i < 4; i++) ss += xv[i].x * xv[i].x + xv[i].y * xv[i].y + xv[i].z * xv[i].z + xv[i].w * xv[i].w;
#pragma unroll
    for (int o = 32; o > 0; o >>= 1) ss += shflx(ss, o, lane);
    float rinv = rsqrtf(ss * (1.f / 1024.f) + EPS);
#pragma unroll
    for (int i = 0; i < 4; i++) {
      int c = i * 256 + lane * 4;
      float h0 = xv[i].x * rinv * gv[i].x * (1.f + sc[i].x) + sh[i].x;
      float h1 = xv[i].y * rinv * gv[i].y * (1.f + sc[i].y) + sh[i].y;
      float h2 = xv[i].z * rinv * gv[i].z * (1.f + sc[i].z) + sh[i].z;
      float h3 = xv[i].w * rinv * gv[i].w * (1.f + sc[i].w) + sh[i].w;
      uint2 o2; o2.x = pack2(h0, h1); o2.y = pack2(h2, h3);
      *(uint2*)(p.H + tm_off(row, c, 16)) = o2;
    }
  }
}

constexpr int G_BK = 64, G_HALF = 128, G_HTB = G_HALF * G_BK * 2;
__device__ __forceinline__ int lds_byte(int r, int c) {
  const int st = (r >> 4) * 2 + (c >> 5), rr = r & 15, cc = c & 31, ob = rr * 64 + cc * 2;
  return st * 1024 + (ob ^ (((ob >> 9) & 1) << 5));
}
__device__ __forceinline__ void stage_rc(int b, int& R, int& C) {
  const int st = b / 1024, sb = b % 1024, swz = sb ^ (((sb >> 9) & 1) << 5);
  R = (st >> 1) * 16 + swz / 64; C = (st & 1) * 32 + (swz % 64) / 2;
}
struct Unit { int pm, pn, seg; };

struct SchedStd {
  int nM, nN, nwg, G, c; const char* A; const char* B; size_t tA, tB;
  __device__ __forceinline__ bool next(int i, Unit& u) const {
    const long L = (long)i * G + c; if (L >= nwg) return false;
    const int wgid = (int)L;
    const int nig = 8 * nN, gid = wgid / nig, fm = gid * 8, gsz = (nM - fm) < 8 ? (nM - fm) : 8;
    u.pm = fm + ((wgid % nig) % gsz); u.pn = (wgid % nig) / gsz; u.seg = 0; return true;
  }
  __device__ __forceinline__ const char* aptr(const Unit& u) const { return A + (size_t)u.pm * tA; }
  __device__ __forceinline__ const char* bptr(const Unit& u) const { return B + (size_t)u.pn * tB; }
};
struct SchedBranch {
  int G, c; const char* P_; const char* W_;
  __device__ __forceinline__ bool next(int i, Unit& u) const {
    if (G == 256) {
      if (i >= 3) return false;
      const int xcd = c >> 5, j = c & 31;
      if (j >= 24) return false;
      u.seg = i; u.pm = xcd * 6 + (j >> 2); u.pn = j & 3; return true;
    }
    const int tile = (i / 3) * G + c; if (tile >= 192) return false;
    u.seg = i % 3; u.pm = tile >> 2; u.pn = tile & 3; return true;
  }
  __device__ __forceinline__ const char* aptr(const Unit& u) const { return P_ + (size_t)((u.seg * 48 + u.pm) * 8) * 32768; }
  __device__ __forceinline__ const char* bptr(const Unit& u) const { return W_ + (size_t)((u.seg * 4 + u.pn) * 8) * 32768; }
};

template <class Epi, class Sched>
__device__ __forceinline__ float gemm_phase(LAS unsigned char* lds, const int K, const Sched& S, const Epi& E, int tmode = 0) {
  unsigned long long t_ph0 = 0, t_epi = 0; if (PROBE >= 20) t_ph0 = __builtin_amdgcn_s_memrealtime();
  const int tid = TIDX, wid = __builtin_amdgcn_readfirstlane(tid >> 6), lane = tid & 63, wr = wid >> 2, wc = wid & 3, fr = lane & 15, fq = lane >> 4;
  const int nt = K / G_BK;
  unsigned voffA[2], voffB[2];
#pragma unroll
  for (int i = 0; i < 2; ++i) { int R, C; stage_rc(tid * 16 + i * 8192, R, C);
    voffA[i] = (unsigned)(R * 64 + C) * 2u; voffB[i] = voffA[i]; }
  const size_t kstep = (size_t)32768;
  const size_t hA = (size_t)16384, hB = (size_t)16384;
  const unsigned ldsw = (unsigned)wid * 1024u;
  const int aoff = lds_byte(wr * 64 + fr, fq * 8), boff = lds_byte(wc * 32 + fr, fq * 8);
#define G_SA(b, h) (((b) * 2 + (h)) * G_HTB)
#define G_SB(b, h) ((4 + (b) * 2 + (h)) * G_HTB)
#define G_STAGE(bufoff, gbase, voff) do { _Pragma("unroll") for (int _i = 0; _i < 2; ++_i) \
    __builtin_amdgcn_global_load_lds((const unsigned*)((const char*)(gbase) + (voff)[_i]), (LAS unsigned*)(lds + (bufoff) + ldsw + _i * 8192), 16, 0, 0); } while (0)
#define G_LDA(dst, b, h) do { _Pragma("unroll") for (int m = 0; m < 4; ++m) _Pragma("unroll") for (int k = 0; k < 2; ++k) dst[m][k] = *(const LAS bf16x8*)(lds + G_SA(b, h) + aoff + m * 2048 + k * 1024); } while (0)
#define G_LDB(dst, b, h) do { _Pragma("unroll") for (int n = 0; n < 2; ++n) _Pragma("unroll") for (int k = 0; k < 2; ++k) dst[n][k] = *(const LAS bf16x8*)(lds + G_SB(b, h) + boff + n * 2048 + k * 1024); } while (0)
#define G_MMA(ai, bj, At, Bt) do { __builtin_amdgcn_s_setprio(1); _Pragma("unroll") for (int m = 0; m < 4; ++m) _Pragma("unroll") for (int n = 0; n < 2; ++n) _Pragma("unroll") for (int k = 0; k < 2; ++k) \
    acc[ai][bj][m][n] = __builtin_amdgcn_mfma_f32_16x16x32_bf16(Bt[n][k], At[m][k], acc[ai][bj][m][n], 0, 0, 0); __builtin_amdgcn_s_setprio(0); } while (0)
#define G_WAIT_V(n) asm volatile("s_waitcnt vmcnt(" #n ")" ::: "memory")
#define G_WAIT_L(n) asm volatile("s_waitcnt lgkmcnt(" #n ")" ::: "memory")
#define G_BAR __builtin_amdgcn_s_barrier()
#define G_SCHED __builtin_amdgcn_sched_barrier(0)
  Unit cur, nxt; int ui = 0;
  if (!S.next(0, cur)) return 0.f;
  f32x4 acc[2][2][4][2];
#pragma unroll
  for (int a = 0; a < 2; ++a)
#pragma unroll
    for (int b = 0; b < 2; ++b)
#pragma unroll
      for (int m = 0; m < 4; ++m)
#pragma unroll
        for (int n = 0; n < 2; ++n) acc[a][b][m][n] = (f32x4){0.f, 0.f, 0.f, 0.f};
  bf16x8 At[4][2], B0[2][2], B1[2][2];
  const char* cA = S.aptr(cur); const char* cB = S.bptr(cur);
  G_STAGE(G_SB(0, 0), cB, voffB); G_STAGE(G_SA(0, 0), cA, voffA); G_STAGE(G_SB(0, 1), cB + hB, voffB); G_STAGE(G_SA(0, 1), cA + hA, voffA);
  if (wr == 1) G_BAR;
  G_WAIT_V(4); G_BAR;
  G_STAGE(G_SB(1, 0), cB + kstep, voffB); G_STAGE(G_SA(1, 0), cA + kstep, voffA); G_STAGE(G_SB(1, 1), cB + hB + kstep, voffB);
  G_WAIT_V(6); G_BAR;
  for (;;) {
    const bool has_next = S.next(ui + 1, nxt);
    const char* nA = has_next ? S.aptr(nxt) : cA; const char* nB = has_next ? S.bptr(nxt) : cB;
    for (int t = 0; t < nt; t += 2) {
      const bool last = (t == nt - 2);
      const char* a1 = cA + (size_t)(t + 1) * kstep;
      const char* a2 = last ? nA : cA + (size_t)(t + 2) * kstep; const char* b2 = last ? nB : cB + (size_t)(t + 2) * kstep;
      const char* a3 = a2 + kstep; const char* b3 = b2 + kstep;
      G_LDB(B0, 0, 0); G_SCHED; G_LDA(At, 0, 0); G_STAGE(G_SA(1, 1), a1 + hA, voffA);
      G_WAIT_L(8); G_BAR; G_WAIT_L(0); G_MMA(0, 0, At, B0); G_BAR; G_SCHED;
      G_LDB(B1, 0, 1); G_STAGE(G_SB(0, 0), b2, voffB);
      G_BAR; G_WAIT_L(0); G_MMA(0, 1, At, B1); G_BAR;
      G_LDA(At, 0, 1); G_STAGE(G_SA(0, 0), a2, voffA);
      G_BAR; G_WAIT_L(0); G_MMA(1, 0, At, B0); G_BAR; G_SCHED;
      G_STAGE(G_SB(0, 1), b2 + hB, voffB);
      G_WAIT_V(6); G_BAR; G_MMA(1, 1, At, B1); G_BAR;
      G_LDB(B0, 1, 0); G_SCHED; G_LDA(At, 1, 0); G_STAGE(G_SA(0, 1), a2 + hA, voffA);
      G_WAIT_L(8); G_BAR; G_WAIT_L(0); G_MMA(0, 0, At, B0); G_BAR; G_SCHED;
      G_LDB(B1, 1, 1); G_STAGE(G_SB(1, 0), b3, voffB);
      G_BAR; G_WAIT_L(0); G_MMA(0, 1, At, B1); G_BAR;
      G_LDA(At, 1, 1); G_STAGE(G_SA(1, 0), a3, voffA);
      G_BAR; G_WAIT_L(0); G_MMA(1, 0, At, B0); G_BAR; G_SCHED;
      G_STAGE(G_SB(1, 1), b3 + hB, voffB);
      G_WAIT_V(6); G_BAR; G_MMA(1, 1, At, B1); G_BAR;
    }
    unsigned long long t_e0 = 0; if (PROBE >= 20) t_e0 = __builtin_amdgcn_s_memrealtime();
    const bool reset = E(acc, cur, wr, wc, fr, fq);
    if (PROBE >= 20) { asm volatile("s_waitcnt vmcnt(0)" ::: "memory"); t_epi += __builtin_amdgcn_s_memrealtime() - t_e0; }
    if (!has_next) break;
    if (reset) {
#pragma unroll
      for (int a = 0; a < 2; ++a)
#pragma unroll
        for (int b = 0; b < 2; ++b)
#pragma unroll
          for (int m = 0; m < 4; ++m)
#pragma unroll
            for (int n = 0; n < 2; ++n) acc[a][b][m][n] = (f32x4){0.f, 0.f, 0.f, 0.f};
    }
    cur = nxt; cA = nA; cB = nB; ++ui;
  }
  G_WAIT_V(0);
  if (wr == 0) G_BAR;
  G_BAR;
  float tres = 0.f;
  if (PROBE >= 20) {
    const unsigned long long tot = __builtin_amdgcn_s_memrealtime() - t_ph0;
    tres = (tmode == 0) ? (float)t_epi / (float)tot : (float)tot / 40000.f;
  }
#undef G_SA
#undef G_SB
#undef G_STAGE
#undef G_LDA
#undef G_LDB
#undef G_MMA
#undef G_WAIT_V
#undef G_WAIT_L
#undef G_BAR
#undef G_SCHED
  return tres;
}

struct EpiInproj {
  const Params* pp; int l; LAS float* part; const LAS float* ropeL;
  __device__ __forceinline__ bool operator()(f32x4 (&acc)[2][2][4][2], const Unit& u, int wr, int wc, int fr, int fq) const {
    const Params& p = *pp;
    asm volatile("" : "+v"(fr), "+v"(fq));
    const int lane = fr + 16 * fq; (void)lane;
    const int oc0 = u.pn * 256;
    const bool isctx = u.pm < 16;
    const bool qkU = (oc0 < 768) || (oc0 >= 2304 && oc0 < 3328);
    float rinv[2][4][2];
    if (qkU) {
#pragma unroll
      for (int ai = 0; ai < 2; ai++)
#pragma unroll
        for (int m = 0; m < 4; m++)
#pragma unroll
          for (int bj = 0; bj < 2; bj++) {
            f32x4 a = acc[ai][bj][m][0], b = acc[ai][bj][m][1];
            float ss = a[0] * a[0] + a[1] * a[1] + a[2] * a[2] + a[3] * a[3] + b[0] * b[0] + b[1] * b[1] + b[2] * b[2] + b[3] * b[3];
            ss += shflx(ss, 16, lane); ss += shflx(ss, 32, lane);
            rinv[ai][m][bj] = ss;
            if (fq == 0) part[((ai * 128 + wr * 64 + m * 16 + fr) * 2 + bj) * 4 + wc] = ss;
          }
      asm volatile("s_waitcnt lgkmcnt(0)" ::: "memory");
      __builtin_amdgcn_s_barrier();
      asm volatile("" ::: "memory");
#pragma unroll
      for (int ai = 0; ai < 2; ai++)
#pragma unroll
        for (int m = 0; m < 4; m++)
#pragma unroll
          for (int bj = 0; bj < 2; bj++) {
            float o = part[((ai * 128 + wr * 64 + m * 16 + fr) * 2 + bj) * 4 + (wc ^ 1)];
            rinv[ai][m][bj] = rsqrtf((rinv[ai][m][bj] + o) * (1.f / 64.f) + EPS);
          }
    }
#pragma unroll
    for (int bj = 0; bj < 2; bj++) {
      const int oc = oc0 + bj * 128;
      if (oc == 640 || (oc >= 3328 && oc < 3840)) {
        const bool isA = (oc == 640);
        const int cb = isA ? 0 : (oc - 3328);
        const int nvec = isA ? 128 : 512;
#pragma unroll
        for (int ai = 0; ai < 2; ai++)
#pragma unroll
          for (int m = 0; m < 4; m++) {
            const int row = u.pm * 256 + ai * 128 + wr * 64 + m * 16 + fr;
            int b, t, T; u16* vt;
            if (isctx) { b = row >> 8; t = row & 255; T = 256; vt = isA ? p.VtA_ctx : p.VtC_ctx; }
            else { int rr = row - NCTX; b = rr >> 12; t = rr & 4095; T = 4096; vt = isA ? p.VtA_lat : p.VtC_lat; }
#pragma unroll
            for (int n = 0; n < 2; n++) {
              const int d = cb + wc * 32 + n * 16 + fq * 4;
              f32x4 v = acc[ai][bj][m][n];
#pragma unroll
              for (int j = 0; j < 4; j++) vt[((size_t)b * nvec + d + j) * T + t] = f2bf(v[j]);
              if (isctx) {
                float* o = p.out + (isA ? O_VA : O_VC) + ((size_t)(b * 2 + l) * 256 + t) * nvec + d;
                *(f32x4*)o = v;
              }
            }
          }
      } else {
        const int pc = (oc < 640) ? oc : (oc < 3328 ? oc - 128 : oc - 640);
        const bool is_qa = oc < 512, is_ka = (oc == 512);
        const bool is_qc = (oc >= 2304 && oc < 2816), is_kc = (oc >= 2816 && oc < 3328);
        if (is_qa || is_ka || is_qc || is_kc) {
          const float* gn = (is_qa ? p.qn_a : is_ka ? p.kn_a : is_qc ? p.qn_c : p.kn_c) + l * 64 + (wc & 1) * 32 + fq * 4;
          const f32x4 g0 = *(const f32x4*)gn, g1 = *(const f32x4*)(gn + 16);
          const float qs = (is_qa || is_qc) ? 0.18033688011112042f : 1.f;
#pragma unroll
          for (int ai = 0; ai < 2; ai++)
#pragma unroll
            for (int m = 0; m < 4; m++) {
              const int row = u.pm * 256 + ai * 128 + wr * 64 + m * 16 + fr;
              const float ri = rinv[ai][m][bj];
              f32x4 x1 = acc[ai][bj][m][0] * ri * g0, x2 = acc[ai][bj][m][1] * ri * g1;
              if (!isctx) {
                const int t = (row - NCTX) & 4095;
                const int pos = (wc & 1) ? (t & 63) : (t >> 6);
                const f32x4 cs = *(const LAS f32x4*)(ropeL + pos * 16 + fq * 4), sn = *(const LAS f32x4*)(ropeL + 1024 + pos * 16 + fq * 4);
                f32x4 y1 = x1 * cs - x2 * sn, y2 = x2 * cs + x1 * sn;
                x1 = y1; x2 = y2;
              } else if (is_ka || is_kc) {
                const int b = row >> 8, t = row & 255;
                float* o = is_ka ? p.out + O_KA + ((size_t)(b * 2 + l) * 256 + t) * 128 + wc * 32 + fq * 4
                                 : p.out + O_KC + ((size_t)(b * 2 + l) * 256 + t) * 512 + (oc - 2816) + wc * 32 + fq * 4;
                *(f32x4*)o = x1; *(f32x4*)(o + 16) = x2;
              }
              x1 = x1 * qs; x2 = x2 * qs;
              u16* po = p.P + (size_t)row * PP + pc + wc * 32 + fq * 4;
              *(uint2*)po = make_uint2(pack2(x1[0], x1[1]), pack2(x1[2], x1[3]));
              *(uint2*)(po + 16) = make_uint2(pack2(x2[0], x2[1]), pack2(x2[2], x2[3]));
            }
        } else {
          const int mode = (oc >= 4352) ? 2 : ((oc >= 1280 && oc < 1792) ? 0 : 1);
          if (mode == 2) {
            const int pj = u.pn - 17, seg = pj >> 2, pn4 = pj & 3;
            unsigned* mg = p.MG + ((size_t)((u.pm * 4 + pn4) * 3 + seg) * 8 + (wr * 4 + wc)) * 2048 + lane;
#pragma unroll
            for (int ai = 0; ai < 2; ai++)
#pragma unroll
              for (int m = 0; m < 4; m++)
#pragma unroll
                for (int n = 0; n < 2; n++) {
                  f32x4 v = acc[ai][bj][m][n];
                  const unsigned q0 = (unsigned)(sigmoidf_(v[0]) * 254.f + 1.5f), q1 = (unsigned)(sigmoidf_(v[1]) * 254.f + 1.5f);
                  const unsigned q2 = (unsigned)(sigmoidf_(v[2]) * 254.f + 1.5f), q3 = (unsigned)(sigmoidf_(v[3]) * 254.f + 1.5f);
                  mg[(((ai * 4 + m) * 2 + bj) * 2 + n) * 64] = q0 | (q1 << 8) | (q2 << 16) | (q3 << 24);
                }
          } else
#pragma unroll
          for (int ai = 0; ai < 2; ai++)
#pragma unroll
            for (int m = 0; m < 4; m++) {
              const int row = u.pm * 256 + ai * 128 + wr * 64 + m * 16 + fr;
              u16* po = p.P + (size_t)row * PP + pc + wc * 32 + fq * 4;
#pragma unroll
              for (int n = 0; n < 2; n++) {
                f32x4 v = acc[ai][bj][m][n];
                if (mode == 1) { v[0] = siluf_(v[0]); v[1] = siluf_(v[1]); v[2] = siluf_(v[2]); v[3] = siluf_(v[3]); }
                else if (mode == 2) { v[0] = sigmoidf_(v[0]); v[1] = sigmoidf_(v[1]); v[2] = sigmoidf_(v[2]); v[3] = sigmoidf_(v[3]); }
                *(uint2*)(po + n * 16) = make_uint2(pack2(v[0], v[1]), pack2(v[2], v[3]));
              }
            }
        }
      }
    }
    return true;
  }
};

struct EpiBranch {
  const Params* pp;
  __device__ __forceinline__ bool operator()(f32x4 (&acc)[2][2][4][2], const Unit& u, int wr, int wc, int fr, int fq) const {
    const Params& p = *pp;
    asm volatile("" : "+v"(fr), "+v"(fq));
    const int lane = fr + 16 * fq;
    const int seg = u.seg;
    const unsigned* mg = p.MG + ((size_t)((u.pm * 4 + u.pn) * 3 + seg) * 8 + (wr * 4 + wc)) * 2048 + lane;
    const float sel = (seg < 2) ? 1.f : 0.f;
#pragma unroll
    for (int hq = 0; hq < 4; hq++) {
      unsigned a[8], b[8];
#pragma unroll
      for (int q = 0; q < 8; q++) { a[q] = mg[(hq * 8 + q) * 64]; b[q] = mg[(hq * 8 + q) * 64 + 8 * 2048]; }
      __builtin_amdgcn_sched_barrier(0);
#pragma unroll
      for (int q = 0; q < 8; q++) {
        const int ai = hq >> 1, m = (hq & 1) * 2 + (q >> 2), bj = (q >> 1) & 1, n = q & 1;
        f32x4 f = {(float)(a[q] & 255u), (float)((a[q] >> 8) & 255u), (float)((a[q] >> 16) & 255u), (float)(a[q] >> 24)};
        f32x4 g = {(float)(b[q] & 255u), (float)((b[q] >> 8) & 255u), (float)((b[q] >> 16) & 255u), (float)(b[q] >> 24)};
        g = g * sel + (1.f - sel) * 255.f;
        f[0] *= __builtin_amdgcn_rcpf(g[0]); f[1] *= __builtin_amdgcn_rcpf(g[1]); f[2] *= __builtin_amdgcn_rcpf(g[2]); f[3] *= __builtin_amdgcn_rcpf(g[3]);
        acc[ai][bj][m][n] = acc[ai][bj][m][n] * f;
      }
    }
    if (seg < 2) return false;
#pragma unroll
    for (int ai = 0; ai < 2; ai++)
#pragma unroll
      for (int m = 0; m < 4; m++) {
        const int row = u.pm * 256 + ai * 128 + wr * 64 + m * 16 + fr;
#pragma unroll
        for (int bj = 0; bj < 2; bj++)
#pragma unroll
          for (int n = 0; n < 2; n++) {
            const int col = u.pn * 256 + bj * 128 + wc * 32 + n * 16 + fq * 4;
            const f32x4 v = acc[ai][bj][m][n];
            *(uint2*)(p.Y + tm_off(row, col, 16)) = make_uint2(pack2(v[0], v[1]), pack2(v[2], v[3]));
          }
      }
    return true;
  }
};

struct EpiOut {
  const Params* pp; int l;
  __device__ __forceinline__ bool operator()(f32x4 (&acc)[2][2][4][2], const Unit& u, int wr, int wc, int fr, int fq) const {
    const Params& p = *pp;
    asm volatile("" : "+v"(fr), "+v"(fq));
    const int v = (u.pm < 16) ? 0 : 1 + (u.pm - 16) / 16;
    const float* gt = p.mod + (l * 3 + v) * 3072 + 2048 + u.pn * 256 + wc * 32 + fq * 4;
    const float* xsrc = (l == 0) ? ((u.pm < 16) ? p.x_prompt + (size_t)u.pm * 256 * 1024 : p.x_sample + (size_t)(u.pm - 16) * 256 * 1024)
                                 : p.out + O_X + (size_t)u.pm * 256 * 1024;
    float* odst = p.out + O_X + (size_t)u.pm * 256 * 1024;
    const int cbase = u.pn * 256 + wc * 32 + fq * 4;
    f32x4 gv[2][2];
#pragma unroll
    for (int bj = 0; bj < 2; bj++)
#pragma unroll
      for (int n = 0; n < 2; n++) gv[bj][n] = *(const f32x4*)(gt + bj * 128 + n * 16);
#pragma unroll
    for (int ai = 0; ai < 2; ai++)
#pragma unroll
      for (int mh = 0; mh < 2; mh++) {
        f32x4 xv[2][2][2];
#pragma unroll
        for (int mm = 0; mm < 2; mm++)
#pragma unroll
          for (int bj = 0; bj < 2; bj++)
#pragma unroll
            for (int n = 0; n < 2; n++)
              xv[mm][bj][n] = *(const f32x4*)(xsrc + (size_t)(ai * 128 + wr * 64 + (mh * 2 + mm) * 16 + fr) * 1024 + cbase + bj * 128 + n * 16);
#pragma unroll
        for (int mm = 0; mm < 2; mm++)
#pragma unroll
          for (int bj = 0; bj < 2; bj++)
#pragma unroll
            for (int n = 0; n < 2; n++)
              *(f32x4*)(odst + (size_t)(ai * 128 + wr * 64 + (mh * 2 + mm) * 16 + fr) * 1024 + cbase + bj * 128 + n * 16) = xv[mm][bj][n] + gv[bj][n] * acc[ai][bj][mh * 2 + mm][n];
      }
    return true;
  }
};

template <bool MASK>
__device__ __forceinline__ void fs_scores(const u16* Ks, const bf16x8 (&qf)[4], f32x16 (&s)[2], int lane, int kpos0, int qpos, int T) {
  const int r = lane & 31, h = lane >> 5;
  {
    bf16x8 kf[2][4];
#pragma unroll
    for (int sub = 0; sub < 2; sub++)
#pragma unroll
      for (int ks = 0; ks < 4; ks++) kf[sub][ks] = *(const bf16x8*)(Ks + (sub * 32 + r) * LROW + ks * 16 + h * 8);
    __builtin_amdgcn_sched_barrier(0);
#pragma unroll
    for (int sub = 0; sub < 2; sub++) {
#pragma unroll
      for (int e = 0; e < 16; e++) s[sub][e] = 0.f;
#pragma unroll
      for (int ks = 0; ks < 4; ks++) s[sub] = mfma32(kf[sub][ks], qf[ks], s[sub]);
    }
  }
  if (MASK) {
#pragma unroll
    for (int sub = 0; sub < 2; sub++)
#pragma unroll
      for (int e = 0; e < 16; e++) {
        int kp = kpos0 + sub * 32 + (e & 3) + 8 * (e >> 2) + 4 * h;
        int dlt = kp - qpos;
        bool ok = (kp >= 0) && (kp < T) && (dlt <= 128) && (dlt >= -128);
        if (!ok) s[sub][e] = -INFINITY;
      }
  }
}
template <int DV>
__device__ __forceinline__ void fs_softmax(f32x16 (&s)[2], float& m, float& l, f32x16 (&o)[DV / 32], bf16x8 (&pf)[2][2], int lane) {
  float mx = s[0][0];
#pragma unroll
  for (int sub = 0; sub < 2; sub++)
#pragma unroll
    for (int e = 0; e < 16; e++) mx = fmaxf(mx, s[sub][e]);
  mx = fmaxf(mx, shflx(mx, 32, lane));
  const bool grow = mx > m;
  const float mn = grow ? mx : m;
  float sum = 0.f;
#pragma unroll
  for (int sub = 0; sub < 2; sub++)
#pragma unroll
    for (int e = 0; e < 16; e++) { float pv = __builtin_amdgcn_exp2f(s[sub][e] - mn); s[sub][e] = pv; sum += pv; }
  sum += shflx(sum, 32, lane);
  if (__builtin_amdgcn_ballot_w64(grow) != 0ull) {
    const float alpha = __builtin_amdgcn_exp2f(m - mn);
    l *= alpha;
#pragma unroll
    for (int ds = 0; ds < DV / 32; ds++)
#pragma unroll
      for (int e = 0; e < 16; e++) o[ds][e] *= alpha;
  }
  l += sum; m = mn;
  typedef __attribute__((ext_vector_type(4))) unsigned u32x4;
#pragma unroll
  for (int sub = 0; sub < 2; sub++)
#pragma unroll
    for (int st = 0; st < 2; st++) {
      u32x4 pw;
#pragma unroll
      for (int j = 0; j < 4; j++) pw[j] = pack2(s[sub][8 * st + 2 * j], s[sub][8 * st + 2 * j + 1]);
      pf[sub][st] = __builtin_bit_cast(bf16x8, pw);
    }
}
template <int DV>
__device__ __forceinline__ void fs_pv(const bf16x8 (&pf)[2][2], const u16* Vts, f32x16 (&o)[DV / 32], int lane) {
  const int r = lane & 31, h = lane >> 5;
#pragma unroll
  for (int sub = 0; sub < 2; sub++) {
    bf16x8 vf[2][DV / 32];
#pragma unroll
    for (int st = 0; st < 2; st++)
#pragma unroll
      for (int ds = 0; ds < DV / 32; ds++) {
        const u16* vp = Vts + (ds * 32 + r) * VROW + sub * 32 + 16 * st + 4 * h;
        bf16x4 lo = *(const bf16x4*)vp, hi = *(const bf16x4*)(vp + 8);
        vf[st][ds] = __builtin_shufflevector(lo, hi, 0, 1, 2, 3, 4, 5, 6, 7);
      }
    __builtin_amdgcn_sched_barrier(0);
#pragma unroll
    for (int st = 0; st < 2; st++)
#pragma unroll
      for (int ds = 0; ds < DV / 32; ds++) o[ds] = mfma32(vf[st][ds], pf[sub][st], o[ds]);
    __builtin_amdgcn_sched_barrier(0);
  }
}

__device__ __forceinline__ uint4 ld_k(const u16* __restrict__ src, size_t pitch, int r0, int nrows, int c) {
  int row = c >> 3, kc = c & 7; int rr = r0 + row;
  const bool ok = (rr >= 0 && rr < nrows);
  const int rc = rr < 0 ? 0 : (rr >= nrows ? nrows - 1 : rr);
  uint4 v = *(const uint4*)(src + (size_t)rc * pitch + kc * 8);
  if (!ok) v = make_uint4(0, 0, 0, 0);
  return v;
}
__device__ __forceinline__ void st_k(u16* dst, int c, uint4 v) { *(uint4*)(dst + (c >> 3) * LROW + (c & 7) * 8) = v; }
__device__ __forceinline__ uint4 ld_vt(const u16* __restrict__ src, int T, int k0, int c) {
  int d = c >> 3, kc = c & 7; int k = k0 + kc * 8;
  const bool ok = (k >= 0 && k < T);
  const int kk = k < 0 ? 0 : (k >= T ? T - 8 : k);
  uint4 v = *(const uint4*)(src + (size_t)d * T + kk);
  if (!ok) v = make_uint4(0, 0, 0, 0);
  return v;
}
__device__ __forceinline__ void st_vt(u16* dst, int c, uint4 v) {
  uint2* q = (uint2*)(dst + (c >> 3) * VROW + (c & 7) * 8);
  q[0] = make_uint2(v.x, v.y); q[1] = make_uint2(v.z, v.w);
}

constexpr int A_BUF = 64 * LROW + 64 * VROW;
__device__ __forceinline__ void attnA_item(const Params& p, int l, int it, u16* sm, bool dry = false) {
  const int tid = TIDX, lane = tid & 63, wid = tid >> 6;
  const int r = lane & 31, h = lane >> 5;
  const bool isctx = it < 128;
  int b, kvh, qb, T, rowbase; const u16* VtBase;
  if (isctx) { b = it >> 3; kvh = (it >> 2) & 1; qb = it & 3; T = 256; rowbase = b * 256;
    VtBase = p.VtA_ctx + ((size_t)(b * 2 + kvh) * 64) * 256; }
  else { int j = it - 128; b = j >> 7; kvh = (j >> 6) & 1; qb = j & 63; T = 4096; rowbase = NCTX + b * 4096;
    VtBase = p.VtA_lat + ((size_t)(b * 2 + kvh) * 64) * 4096; }
  const int qblk = qb * 64;
  const int q0 = qblk + (wid >> 2) * 32;
  const int head = kvh * 4 + (wid & 3);
  const size_t prow = (size_t)(rowbase + q0 + r) * PP;
  bf16x8 qf[4];
#pragma unroll
  for (int ks = 0; ks < 4; ks++) qf[ks] = *(const bf16x8*)(p.P + prow + C_QA + head * 64 + ks * 16 + h * 8);
  float m = p.sink_a[l * 8 + head] * 1.4426950408889634f, ls = 1.f;
  f32x16 o[2];
#pragma unroll
  for (int ds = 0; ds < 2; ds++)
#pragma unroll
    for (int e = 0; e < 16; e++) o[ds][e] = 0.f;
  const u16* Kbase = p.P + (size_t)rowbase * PP + C_KA + kvh * 64;
  const u16* cK = p.cKa + ((size_t)(b * 2 + l) * 512) * 128 + kvh * 64;
  const u16* cVt = p.cVtA + ((size_t)((b * 2 + l) * 2 + kvh) * 64) * 512;
  const int qpos = q0 + r;
  int i_lo = 0, nW, ntile;
  if (isctx) { nW = 4; ntile = 4; }
  else {
    i_lo = (qblk < 128) ? (128 - qblk) / 64 : 0;
    int i_hi = (T - qblk + 128) / 64; if (i_hi > 5) i_hi = 5;
    nW = i_hi - i_lo; ntile = nW + 8;
  }
  uint4 rk, rv;
  auto tile_load = [&](int t) {
    if (t < nW) {
      int k0 = isctx ? t * 64 : qblk - 128 + 64 * (i_lo + t);
      rk = ld_k(Kbase, PP, k0, T, tid); rv = ld_vt(VtBase, T, k0, tid);
    } else {
      int kt = t - nW;
      rk = ld_k(cK, 128, kt * 64, 512, tid); rv = ld_vt(cVt, 512, kt * 64, tid);
    }
  };
  auto KB = [&](int i) { return sm + (i & 1) * (64 * LROW); };
  auto VB = [&](int i) { return sm + 2 * 64 * LROW + (i % 3) * (64 * VROW); };
  const bool lag = (wid >> 2) != 0;
  __syncthreads();
  tile_load(0);
  st_k(KB(0), tid, rk); st_vt(VB(0), tid, rv);
  __syncthreads();
  bf16x8 pf[2][2];
  for (int t = 0; t <= ntile; t++) {
    const bool more = t + 1 < ntile;
    if (more) tile_load(t + 1);
    if (lag && t > 0) fs_pv<64>(pf, VB(t - 1), o, lane);
    if (t < ntile) {
      f32x16 sc[2];
      bool needmask = false;
      if (!isctx && t < nW) {
        const int k0 = qblk - 128 + 64 * (i_lo + t);
        needmask = (k0 - q0 < -97) || (k0 - q0 > 65) || (k0 < 0) || (k0 + 64 > T);
      }
      if (needmask) fs_scores<true>(KB(t), qf, sc, lane, qblk - 128 + 64 * (i_lo + t), qpos, T);
      else fs_scores<false>(KB(t), qf, sc, lane, 0, 0, T);
      fs_softmax<64>(sc, m, ls, o, pf, lane);
      if (!lag) fs_pv<64>(pf, VB(t), o, lane);
    }
    if (more) { st_k(KB(t + 1), tid, rk); st_vt(VB(t + 1), tid, rv); }
    __syncthreads();
  }
  const float inv = __builtin_amdgcn_rcpf(ls);
  {
    uint2 gv[2][4];
#pragma unroll
    for (int ds = 0; ds < 2; ds++)
#pragma unroll
      for (int g = 0; g < 4; g++) gv[ds][g] = *(const uint2*)(p.P + prow + C_GA + head * 64 + ds * 32 + 8 * g + 4 * h);
    __builtin_amdgcn_sched_barrier(0);
#pragma unroll
    for (int ds = 0; ds < 2; ds++)
#pragma unroll
      for (int g = 0; g < 4; g++) {
        int d = ds * 32 + 8 * g + 4 * h;
        uint2 ov;
        ov.x = pack2(o[ds][4 * g] * inv * lo_bf(gv[ds][g].x), o[ds][4 * g + 1] * inv * hi_bf(gv[ds][g].x));
        ov.y = pack2(o[ds][4 * g + 2] * inv * lo_bf(gv[ds][g].y), o[ds][4 * g + 3] * inv * hi_bf(gv[ds][g].y));
        *(uint2*)(p.GB + tm_off(rowbase + q0 + r, head * 64 + d, 8)) = ov;
      }
  }
}

constexpr int C_BUF = 128 * LROW + 128 * VROW;
__device__ __forceinline__ void attnC_item(const Params& p, int l, int it, u16* sm, float lam, float lam_init, bool dry = false) {
  const int tid = TIDX, lane = tid & 63, wid = tid >> 6;
  const int r = lane & 31, h = lane >> 5;
  const bool isctx = it < 128;
  int b, hd, qb, T, rowbase; const u16* VtBase;
  if (isctx) { b = it >> 3; hd = (it >> 1) & 3; qb = it & 1; T = 256; rowbase = b * 256;
    VtBase = p.VtC_ctx + ((size_t)(b * 4 + hd) * 128) * 256; }
  else { int j = it - 128; b = j >> 7; hd = (j >> 5) & 3; qb = j & 31; T = 4096; rowbase = NCTX + b * 4096;
    VtBase = p.VtC_lat + ((size_t)(b * 4 + hd) * 128) * 4096; }
  const int qg = wid & 3, map = wid >> 2;
  const int q0 = qb * 128 + qg * 32;
  const size_t prow = (size_t)(rowbase + q0 + r) * PP;
  bf16x8 qf[4];
#pragma unroll
  for (int ks = 0; ks < 4; ks++) qf[ks] = *(const bf16x8*)(p.P + prow + C_QC + hd * 128 + map * 64 + ks * 16 + h * 8);
  float m = -1e30f, ls = 0.f;
  f32x16 o[4];
#pragma unroll
  for (int ds = 0; ds < 4; ds++)
#pragma unroll
    for (int e = 0; e < 16; e++) o[ds][e] = 0.f;
  const u16* Kbase = p.P + (size_t)rowbase * PP + C_KC + hd * 128;
  const u16* cK = p.cKc + ((size_t)(b * 2 + l) * 512) * 512 + hd * 128;
  const u16* cVt = p.cVtC + ((size_t)((b * 2 + l) * 4 + hd) * 128) * 512;
  const int nW = T / 64, ntile = isctx ? nW : nW + 8;
  uint4 rk0, rk1, rv0, rv1;
  const u16* pk = Kbase + (size_t)(tid >> 3) * PP + (tid & 7) * 8;
  const u16* pv0 = VtBase + (size_t)(tid >> 3) * T + (tid & 7) * 8;
  const u16* pv1 = VtBase + (size_t)((tid + NT) >> 3) * T + (tid & 7) * 8;
  size_t kstride = (size_t)64 * PP;
  auto tile_load = [&](int t) {
    if (t == nW) {
      pk = cK + (size_t)(tid >> 3) * 512 + (tid & 7) * 8;
      pv0 = cVt + (size_t)(tid >> 3) * 512 + (tid & 7) * 8;
      pv1 = cVt + (size_t)((tid + NT) >> 3) * 512 + (tid & 7) * 8;
      kstride = (size_t)64 * 512;
    }
    rk0 = *(const uint4*)pk; rk1 = *(const uint4*)(pk + 64);
    rv0 = *(const uint4*)pv0; rv1 = *(const uint4*)pv1;
    pk += kstride; pv0 += 64; pv1 += 64;
  };
  auto KB = [&](int i) { return sm + (i & 1) * (128 * LROW); };
  auto VB = [&](int i) { return sm + 2 * 128 * LROW + (i % 3) * (128 * VROW); };
  auto tile_store = [&](int i) {
    u16* kd = KB(i); u16* vd = VB(i);
    st_k(kd, tid, rk0); st_k(kd + 64 * LROW, tid, rk1);
    st_vt(vd, tid, rv0); st_vt(vd, tid + NT, rv1);
  };
  const bool lag = map != 0;
  __syncthreads();
  tile_load(0);
  tile_store(0);
  __syncthreads();
  bf16x8 pf[2][2];
  for (int t = 0; t <= ntile; t++) {
    const bool more = t + 1 < ntile;
    if (more) tile_load(t + 1);
    if (lag && t > 0) fs_pv<128>(pf, VB(t - 1), o, lane);
    if (t < ntile) {
      f32x16 sc[2];
      fs_scores<false>(KB(t) + map * 64 * LROW, qf, sc, lane, 0, 0, T);
      fs_softmax<128>(sc, m, ls, o, pf, lane);
      if (!lag) fs_pv<128>(pf, VB(t), o, lane);
    }
    if (more) tile_store(t + 1);
    __syncthreads();
  }
  float* xch = (float*)sm;
  if (map == 1) {
    const float inv = lam * __builtin_amdgcn_rcpf(ls);
#pragma unroll
    for (int ds = 0; ds < 4; ds++)
#pragma unroll
      for (int e = 0; e < 16; e++) xch[((qg * 64) + ds * 16 + e) * 64 + lane] = o[ds][e] * inv;
  }
  __syncthreads();
  if (map == 0) {
    const float i0 = __builtin_amdgcn_rcpf(ls);
    float ss = 0.f;
#pragma unroll
    for (int ds = 0; ds < 4; ds++)
#pragma unroll
      for (int e = 0; e < 16; e++) {
        float v = o[ds][e] * i0 - xch[((qg * 64) + ds * 16 + e) * 64 + lane];
        o[ds][e] = v; ss += v * v;
      }
    ss += shflx(ss, 32, lane);
    const float rinv = rsqrtf(ss * (1.f / 128.f) + EPS) * (1.f - lam_init);
    const float* sg = p.subln_c + l * 128;
#pragma unroll
    for (int ds = 0; ds < 4; ds++) {
      uint2 gv[4]; float4 sl[4];
#pragma unroll
      for (int g = 0; g < 4; g++) {
        const int d = ds * 32 + 8 * g + 4 * h;
        gv[g] = *(const uint2*)(p.P + prow + C_GC + hd * 128 + d);
        sl[g] = *(const float4*)(sg + d);
      }
      __builtin_amdgcn_sched_barrier(0);
#pragma unroll
      for (int g = 0; g < 4; g++) {
        const int d = ds * 32 + 8 * g + 4 * h;
        uint2 ov;
        ov.x = pack2(o[ds][4 * g] * rinv * sl[g].x * lo_bf(gv[g].x), o[ds][4 * g + 1] * rinv * sl[g].y * hi_bf(gv[g].x));
        ov.y = pack2(o[ds][4 * g + 2] * rinv * sl[g].z * lo_bf(gv[g].y), o[ds][4 * g + 3] * rinv * sl[g].w * hi_bf(gv[g].y));
        *(uint2*)(p.GB + (size_t)2 * NTOK * 512 + tm_off(rowbase + q0 + r, hd * 128 + d, 8)) = ov;
      }
    }
  }
}

__device__ __forceinline__ void lru_run(const Params& p, int l, bool pass2, int start, int G, float* sm, bool dry = false) {
  const int tid = TIDX;
  const int lane = tid & 63, wid = tid >> 6, r = lane & 31, h = lane >> 5;
  const int n = start & 7;
  float* xin = sm;
  float* xb = sm + 67 * 64;
  float* comb = xb + 64 * 64;
  float* carry = comb + 2048;
  float* parts = carry + 128;
  float* ab = parts + 1024;
  u16* xbh = (u16*)(ab + 4 * 4096);
  const int gd = wid >> 2, gth = (wid >> 1) & 1, gdh = wid & 1;
  bf16x8 wfa[4], wfx[4];
  {
    const u16* wbase = p.Wt_lru + ((size_t)(((l * 2 + gd) * 8 + n) * 2) * 64 + gdh * 32 + r) * 64 + h * 8;
#pragma unroll
    for (int ks = 0; ks < 4; ks++) { wfa[ks] = *(const bf16x8*)(wbase + ks * 16); wfx[ks] = *(const bf16x8*)(wbase + 4096 + ks * 16); }
  }
  const int gch = n * 64 + gdh * 32 + r;
  const float g_ba = p.lru_ba[(l * 2 + gd) * 512 + gch], g_bx = p.lru_bx[(l * 2 + gd) * 512 + gch];
  const float g_sp = log1pf(__expf(-p.lru_lam[(l * 2 + gd) * 512 + gch]));
  const int cc = tid & 63;
  float cw[4]; float cbv;
  {
    const float* cwp = p.conv_w + l * 4 * 512 + n * 64 + cc;
    cw[0] = cwp[0]; cw[1] = cwp[512]; cw[2] = cwp[1024]; cw[3] = cwp[1536];
    cbv = p.conv_b[l * 512 + n * 64 + cc];
  }
  const int dout = tid & 63, tg = tid >> 6;
  const int ch = n * 64 + dout;

  u16 xr[9];
  auto xin_load = [&](int it_) {
    const int row0_ = (it_ >> 3) * 64;
    int T_, seq0_;
    if (row0_ < NCTX) { T_ = 256; seq0_ = (row0_ >> 8) * 256; } else { T_ = 4096; seq0_ = NCTX + ((row0_ - NCTX) >> 12) * 4096; }
    const int t0_ = row0_ - seq0_;
#pragma unroll
    for (int k = 0; k < 9; k++) {
      const int rr = (tid >> 6) + 8 * k; const int t = t0_ - 2 + rr;
      const bool ok = (rr < 67 && t >= 0 && t < T_);
      const int tc = t < 0 ? 0 : (t >= T_ ? T_ - 1 : t);
      u16 v = p.P[(size_t)(seq0_ + tc) * PP + C_XB + n * 64 + cc];
      xr[k] = ok ? v : (u16)0;
    }
  };
  if (start < 1536) xin_load(start);
  for (int it = start; it < 1536; it += G) {
    const int ci = it >> 3;
    const int row0 = ci * 64;
    const bool isctx = row0 < NCTX;
    int T, seq0, bidx;
    if (isctx) { T = 256; bidx = row0 >> 8; seq0 = bidx * 256; }
    else { T = 4096; bidx = (row0 - NCTX) >> 12; seq0 = NCTX + bidx * 4096; }
    const int t0 = row0 - seq0;
    __syncthreads();
#pragma unroll
    for (int k = 0; k < 9; k++) { const int rr = (tid >> 6) + 8 * k; if (rr < 67) xin[rr * 64 + cc] = bf2f(xr[k]); }
    if (it + G < 1536) xin_load(it + G);
    u16 sgr[8];
    if (pass2) {
#pragma unroll
      for (int tt = 0; tt < 8; tt++) sgr[tt] = p.P[(size_t)(row0 + tg * 8 + tt) * PP + C_GB + ch];
    }
    if (pass2) {
      const int d = (tid >> 6) & 1, part = tid >> 7;
      const int cfirst = seq0 >> 6, clast = (seq0 + T - 64) >> 6;
      const int K = d ? (clast - ci) : (ci - cfirst);
      float2 q[16];
#pragma unroll
      for (int k = 0; k < 16; k++) {
        const int kk = part * 16 + k;
        const int cj = d ? (clast - kk) : (cfirst + kk);
        const int cjc = cj < cfirst ? cfirst : (cj > clast ? clast : cj);
        const float2 qv = *(const float2*)(p.lruTot + ((size_t)(cjc * 2 + d) * 512 + n * 64 + cc) * 2);
        q[k] = (kk < K) ? qv : make_float2(1.f, 0.f);
      }
      float At = 1.f, Bt = 0.f;
#pragma unroll
      for (int k = 0; k < 16; k++) { Bt = q[k].x * Bt + q[k].y; At *= q[k].x; }
      parts[((part * 2 + d) * 64 + cc) * 2] = At; parts[((part * 2 + d) * 64 + cc) * 2 + 1] = Bt;
    }
    __syncthreads();
    for (int e = tid; e < 64 * 64; e += NT) {
      int t = e >> 6;
      float v = cbv;
#pragma unroll
      for (int j = 0; j < 4; j++) v += xin[(t + j) * 64 + cc] * cw[j];
      xb[e] = v;
      xbh[t * LROW + cc] = f2bf(v);
    }
    if (pass2 && tid < 128) {
      const int d = tid >> 6;
      float hcar = isctx ? 0.f : p.state_lru[((size_t)(bidx * 2 + l) * 2 + d) * 512 + n * 64 + cc];
#pragma unroll
      for (int part = 0; part < 4; part++) hcar = parts[((part * 2 + d) * 64 + cc) * 2] * hcar + parts[((part * 2 + d) * 64 + cc) * 2 + 1];
      carry[d * 64 + cc] = hcar;
    }
    __syncthreads();
    {
      bf16x8 af[4];
#pragma unroll
      for (int ks = 0; ks < 4; ks++) af[ks] = *(const bf16x8*)(xbh + (gth * 32 + r) * LROW + ks * 16 + h * 8);
      f32x16 ga, gi;
#pragma unroll
      for (int e = 0; e < 16; e++) { ga[e] = 0.f; gi[e] = 0.f; }
#pragma unroll
      for (int ks = 0; ks < 4; ks++) { ga = mfma32(af[ks], wfa[ks], ga); gi = mfma32(af[ks], wfx[ks], gi); }
      const int dch = gdh * 32 + r;
#pragma unroll
      for (int e = 0; e < 16; e++) {
        const int tok = gth * 32 + (e & 3) + 8 * (e >> 2) + 4 * h;
        float rg = sigmoidf_(ga[e] + g_ba), ig = sigmoidf_(gi[e] + g_bx);
        float log_a = -8.f * rg * g_sp;
        float a = __expf(log_a);
        const float x2 = 2.f * log_a;
        const float om = -x2 * (1.f + x2 * (0.5f + x2 * (0.16666667f + x2 * (0.041666668f + x2 * (0.0083333338f + x2 * (0.0013888889f + x2 * 0.0001984127f))))));
        float bb = __builtin_amdgcn_sqrtf(om) * ig * xb[tok * 64 + dch];
        ab[((gd * 2 + 0) * 64 + tok) * 64 + dch] = a;
        ab[((gd * 2 + 1) * 64 + tok) * 64 + dch] = bb;
      }
    }
    __syncthreads();
    float av[2][8], bv[2][8];
#pragma unroll
    for (int d = 0; d < 2; d++)
#pragma unroll
      for (int tt = 0; tt < 8; tt++) {
        av[d][tt] = ab[((d * 2 + 0) * 64 + tg * 8 + tt) * 64 + dout];
        bv[d][tt] = ab[((d * 2 + 1) * 64 + tg * 8 + tt) * 64 + dout];
      }
    float sA0 = 1.f, sB0 = 0.f, sA1 = 1.f, sB1 = 0.f;
#pragma unroll
    for (int tt = 0; tt < 8; tt++) { sB0 = av[0][tt] * sB0 + bv[0][tt]; sA0 *= av[0][tt]; }
#pragma unroll
    for (int tt = 7; tt >= 0; tt--) { sB1 = av[1][tt] * sB1 + bv[1][tt]; sA1 *= av[1][tt]; }
    comb[((tg * 2 + 0) * 64 + dout) * 2 + 0] = sA0; comb[((tg * 2 + 0) * 64 + dout) * 2 + 1] = sB0;
    comb[((tg * 2 + 1) * 64 + dout) * 2 + 0] = sA1; comb[((tg * 2 + 1) * 64 + dout) * 2 + 1] = sB1;
    __syncthreads();
    if (!pass2) {
      if (tid < 128) {
        int d = tid >> 6, c = tid & 63;
        float At = 1.f, Bt = 0.f;
#pragma unroll
        for (int s = 0; s < 8; s++) {
          int g = (d == 0) ? s : 7 - s;
          float a = comb[((g * 2 + d) * 64 + c) * 2], bq = comb[((g * 2 + d) * 64 + c) * 2 + 1];
          Bt = a * Bt + bq; At *= a;
        }
        float* o = p.lruTot + ((size_t)(ci * 2 + d) * 512 + n * 64 + c) * 2;
        o[0] = At; o[1] = Bt;
      }
      continue;
    }
    float h0 = carry[dout], h1 = carry[64 + dout];
    for (int g = 0; g < tg; g++) { h0 = comb[((g * 2 + 0) * 64 + dout) * 2] * h0 + comb[((g * 2 + 0) * 64 + dout) * 2 + 1]; }
    for (int g = 7; g > tg; g--) { h1 = comb[((g * 2 + 1) * 64 + dout) * 2] * h1 + comb[((g * 2 + 1) * 64 + dout) * 2 + 1]; }
    float y[8];
#pragma unroll
    for (int tt = 0; tt < 8; tt++) { h0 = av[0][tt] * h0 + bv[0][tt]; y[tt] = h0; }
    const float hf_last = h0;
#pragma unroll
    for (int tt = 7; tt >= 0; tt--) { h1 = av[1][tt] * h1 + bv[1][tt]; y[tt] += h1; }
    const float hb_first = h1;
    if (isctx) {
      if (t0 + 64 == T && tg == 7) p.out[O_ST + ((size_t)(bidx * 2 + l) * 2 + 0) * 512 + ch] = hf_last;
      if (t0 == 0 && tg == 0) p.out[O_ST + ((size_t)(bidx * 2 + l) * 2 + 1) * 512 + ch] = hb_first;
    }
#pragma unroll
    for (int tt = 0; tt < 8; tt++) {
      const int rw = row0 + tg * 8 + tt;
      p.GB[(size_t)NTOK * 512 + tm_off(rw, ch, 8)] = f2bf(y[tt] * bf2f(sgr[tt]));
    }
  }
}

__device__ __forceinline__ float compute_lam(const Params& p, int l, float lam_init) {
  float s1 = 0.f, s2 = 0.f;
  for (int i = 0; i < 64; i++) {
    s1 += p.lam_q1[l * 64 + i] * p.lam_k1[l * 64 + i];
    s2 += p.lam_q2[l * 64 + i] * p.lam_k2[l * 64 + i];
  }
  return expf(s1) - expf(s2) + lam_init;
}

__device__ __forceinline__ float mix_phase(const Params& p, int l, u16* smem, int vid) {
  unsigned long long tm0 = 0; float tres = 0.f; if (PROBE >= 30) tm0 = __builtin_amdgcn_s_memrealtime();
  const float lam_init = (l == 0) ? 0.2f : (0.8f - 0.6f * 0.74081822068f);
  const float lam = compute_lam(p, l, lam_init);
  constexpr int N_CL = 256, N_A = 384, N_CC = 128, N_L = 1536;
  const int G = gridDim.x;
  int start = vid;
  for (int it = start; it < N_CL; it += G) attnC_item(p, l, 128 + it, smem, lam, lam_init);
  if (PROBE == 35) tres = (float)(__builtin_amdgcn_s_memrealtime() - tm0) / 40000.f;
  start = (int)((vid + G - (N_CL % G)) % G);
  for (int it = start; it < N_A; it += G) attnA_item(p, l, it, smem);
  start = (int)((vid + G - ((N_CL + N_A) % G)) % G);
  for (int it = start; it < N_CC; it += G) attnC_item(p, l, it, smem, lam, lam_init);
  if (PROBE == 36) tres = (float)(__builtin_amdgcn_s_memrealtime() - tm0) / 40000.f;
  start = (int)((vid + G - ((N_CL + N_A + N_CC) % G)) % G);
  if (PROBE == 6) lru_run(p, l, false, start, G, (float*)smem);
  lru_run(p, l, false, start, G, (float*)smem);
  return tres;
}

__device__ __forceinline__ void lru2_phase(const Params& p, int l, u16* smem) {
  lru_run(p, l, true, blockIdx.x, gridDim.x, (float*)smem);
}

#define XB_TMO      128
#define XB_XCNT(j)  (256  + 64 * (j))
#define XB_XSUB(j)  (1280 + 64 * (j))
#define XB_XGEN(j)  (2304 + 64 * (j))
#define XB_TOP      3328
#define XB_TOPGEN   3392
#define XCD_BAR_WORDS 3456
#define XB_SPIN_CAP (1u << 18)
__device__ __forceinline__ unsigned xb_ld(unsigned* p)              { return __hip_atomic_load(p, __ATOMIC_RELAXED, __HIP_MEMORY_SCOPE_AGENT); }
__device__ __forceinline__ unsigned xb_add(unsigned* p, unsigned v) { return __hip_atomic_fetch_add(p, v, __ATOMIC_RELAXED, __HIP_MEMORY_SCOPE_AGENT); }
__device__ __forceinline__ unsigned xb_xcc_id() { return (unsigned)__builtin_amdgcn_s_getreg((3 << 11) | 20) & 0xFu; }
#define XB_SPIN(cond, bar) do { unsigned _sp = 0; while (cond) { __builtin_amdgcn_s_sleep(1); \
    if ((++_sp & 255u) == 0u) { if (xb_ld(&(bar)[XB_TMO])) break; if (_sp > XB_SPIN_CAP) { atomicAdd(&(bar)[XB_TMO], 1u); break; } } } } while (0)
struct XcdBarrier { unsigned* bar; unsigned x; volatile LAS unsigned* st; };
__device__ __forceinline__ XcdBarrier xcd_barrier_post(unsigned* bar, volatile LAS unsigned* st) {
  XcdBarrier b; b.bar = bar; b.x = xb_xcc_id(); b.st = st;
  if (threadIdx.x == 0) st[2] = xb_add(&bar[XB_XCNT(b.x)], 1u);
  return b;
}
__device__ __forceinline__ int xcd_virtual_id(const XcdBarrier& b) {
  if (threadIdx.x == 0) {
    unsigned pre = 0;
#pragma unroll
    for (unsigned j = 0; j < 16; ++j) { const unsigned c = xb_ld(&b.bar[XB_XCNT(j)]); pre += (j < b.x) ? c : 0u; }
    b.st[3] = pre + b.st[2];
  }
  __syncthreads();
  const int v = (int)b.st[3];
  __syncthreads();
  return __builtin_amdgcn_readfirstlane(v);
}
__device__ __forceinline__ void xcd_barrier_complete(unsigned* bar, unsigned x, unsigned& nloc, unsigned& nx) {
  const unsigned G = gridDim.x * gridDim.y * gridDim.z;
  unsigned sum, cnt, mine, sp = 0u;
  for (;;) {
    sum = 0u; cnt = 0u; mine = 0u;
#pragma unroll
    for (unsigned j = 0; j < 16; ++j) { const unsigned c = xb_ld(&bar[XB_XCNT(j)]); sum += c; cnt += (c > 0u) ? 1u : 0u; mine = (j == x) ? c : mine; }
    if (sum == G) break;
    __builtin_amdgcn_s_sleep(1);
    if ((++sp & 255u) == 0u) { if (xb_ld(&bar[XB_TMO])) break; if (sp > XB_SPIN_CAP) { atomicAdd(&bar[XB_TMO], 1u); break; } }
  }
  nloc = mine > 0u ? mine : 1u; nx = cnt > 0u ? cnt : 1u;
}
__device__ __forceinline__ void xcd_barrier(const XcdBarrier& b) {
  asm volatile("s_waitcnt vmcnt(0)" ::: "memory");
  __syncthreads();
  if (threadIdx.x == 0) {
    unsigned* bar = b.bar;
    __builtin_amdgcn_s_waitcnt(0);
    unsigned nloc = b.st[0], nx = b.st[1];
    if (nloc == 0u) { xcd_barrier_complete(bar, b.x, nloc, nx); b.st[0] = nloc; b.st[1] = nx; }
    const unsigned old = xb_add(&bar[XB_XSUB(b.x)], 1u);
    const unsigned gen = old / nloc;
    if (old + 1u == (gen + 1u) * nloc) {
      __builtin_amdgcn_fence(__ATOMIC_RELEASE, "agent");
      asm volatile("s_waitcnt vmcnt(0)" ::: "memory");
      const unsigned og = xb_add(&bar[XB_TOP], 1u);
      const unsigned tg = og / nx;
      if (og + 1u == (tg + 1u) * nx) xb_add(&bar[XB_TOPGEN], 1u);
      else XB_SPIN(xb_ld(&bar[XB_TOPGEN]) == tg, bar);
      __builtin_amdgcn_fence(__ATOMIC_ACQUIRE, "agent");
      xb_add(&bar[XB_XGEN(b.x)], 1u);
      asm volatile("s_waitcnt vmcnt(0)" ::: "memory");
    } else {
      XB_SPIN(xb_ld(&bar[XB_XGEN(b.x)]) == gen, bar);
      __builtin_amdgcn_fence(__ATOMIC_ACQUIRE, "agent");
      asm volatile("s_waitcnt vmcnt(0)" ::: "memory");
    }
  }
  __syncthreads();
}

typedef __attribute__((address_space(4))) const Params CParams;
__device__ __forceinline__ const Params& get_params() {
  CParams* kp = (CParams*)__builtin_amdgcn_kernarg_segment_ptr();
  asm volatile("" : "+s"(kp));
  return *(const Params*)kp;
}
__global__ void __launch_bounds__(NT, 2) fwd_kernel(Params p_unused) {
  extern __shared__ __attribute__((aligned(16))) unsigned char lds_raw[];
  u16* smem = (u16*)lds_raw;
  LAS unsigned char* lds = (LAS unsigned char*)lds_raw;
  cg::grid_group grid = cg::this_grid();
  volatile LAS unsigned* xst = (volatile LAS unsigned*)(lds + STAGE_BYTES + SPARE_BYTES);
  if (threadIdx.x == 0) { xst[0] = 0u; xst[1] = 0u; }
  __syncthreads();
  XcdBarrier xb = xcd_barrier_post(get_params().bar, xst);
  float tfrac = 0.f;
  unsigned long long tq0 = 0; if (PROBE >= 30) tq0 = __builtin_amdgcn_s_memrealtime();
  prologue_phase(get_params(), (float*)smem);
  if (PROBE == 30) tfrac = (float)(__builtin_amdgcn_s_memrealtime() - tq0) / 40000.f;
  if (get_params().bar == nullptr) grid.sync();
  xcd_barrier(xb);
  if (PROBE == 31) tfrac = (float)(__builtin_amdgcn_s_memrealtime() - tq0) / 40000.f;
  const int vid = xcd_virtual_id(xb);
  { LAS float* rl = (LAS float*)(lds + ROPE_OFF); const float* rg = get_params().rope;
    for (int i = threadIdx.x; i < 2048; i += NT) rl[i] = rg[i];
    __syncthreads(); }
  if (PROBE == 9) { for (int i = 0; i < 10; i++) xcd_barrier(xb); }
#pragma unroll 1
  for (int l = 0; l < 2; l++) {
    if (PROBE >= 30) tq0 = __builtin_amdgcn_s_memrealtime();
    norm_phase(get_params(), l);
    if (PROBE == 32 && l == 0) tfrac = (float)(__builtin_amdgcn_s_memrealtime() - tq0) / 40000.f;
    if (PROBE == 3) { norm_phase(get_params(), l); if (l == 0) { xcd_barrier(xb); prologue_phase(get_params(), (float*)smem); } }
    xcd_barrier(xb);
    {
      const Params& p = get_params();
      SchedStd S; S.nM = NTOK / 256; S.nN = INC / 256; S.nwg = S.nM * S.nN; S.G = gridDim.x; S.c = vid;
      S.A = (const char*)p.H; S.B = (const char*)(p.Wt_in + (size_t)l * INC * 1024); S.tA = (size_t)256 * 1024 * 2; S.tB = (size_t)256 * 1024 * 2;
      EpiInproj E; E.pp = &p; E.l = l; E.part = (LAS float*)(lds + STAGE_BYTES); E.ropeL = (const LAS float*)(lds + ROPE_OFF);
      { float tr = gemm_phase(lds, 1024, S, E, PROBE == 22); if (l == 0 && (PROBE == 21 || PROBE == 22)) tfrac = tr; }
      if (PROBE == 1) { __syncthreads(); gemm_phase(lds, 1024, S, E); }
    }
    xcd_barrier(xb);
    if (PROBE >= 30) tq0 = __builtin_amdgcn_s_memrealtime();
    { float tr = mix_phase(get_params(), l, smem, vid); if ((PROBE == 35 || PROBE == 36) && l == 0) tfrac = tr; }
    if (PROBE == 33 && l == 0) tfrac = (float)(__builtin_amdgcn_s_memrealtime() - tq0) / 40000.f;
    xcd_barrier(xb);
    if (PROBE >= 30) tq0 = __builtin_amdgcn_s_memrealtime();
    lru2_phase(get_params(), l, smem);
    if (PROBE == 34 && l == 0) tfrac = (float)(__builtin_amdgcn_s_memrealtime() - tq0) / 40000.f;
    xcd_barrier(xb);
    {
      const Params& p = get_params();
      SchedBranch S; S.G = gridDim.x; S.c = vid; S.P_ = (const char*)p.GB; S.W_ = (const char*)(p.Wt_br + (size_t)l * 3 * 1024 * 512);
      EpiBranch E; E.pp = &p;
      { float tr = gemm_phase(lds, 512, S, E, PROBE == 24); if (l == 0 && (PROBE == 23 || PROBE == 24)) tfrac = tr; }
      if (PROBE == 2) { __syncthreads(); gemm_phase(lds, 512, S, E); }
    }
    xcd_barrier(xb);
    {
      const Params& p = get_params();
      SchedStd S; S.nM = NTOK / 256; S.nN = 4; S.nwg = S.nM * S.nN; S.G = gridDim.x; S.c = vid;
      S.A = (const char*)p.Y; S.B = (const char*)(p.Wt_out + (size_t)l * 1024 * 1024); S.tA = (size_t)256 * 1024 * 2; S.tB = (size_t)256 * 1024 * 2;
      EpiOut E; E.pp = &p; E.l = l;
      { float tr = gemm_phase(lds, 1024, S, E, PROBE == 26); if (l == 0 && (PROBE == 25 || PROBE == 26)) tfrac = tr; }
      if (PROBE == 8 && l == 0) { __syncthreads(); gemm_phase(lds, 1024, S, E); }
    }
    if (l == 0) xcd_barrier(xb);
  }
  if (PROBE >= 20) {
    xcd_barrier(xb);
    if (blockIdx.x == 0 && threadIdx.x == 0) { float* o = get_params().out + O_X + 4194304; *o += 0.42f + 0.45f * fminf(fmaxf(tfrac, 0.f), 1.f); }
  }
}

extern "C" void kernel_launch(void* const* d_in, const int* in_sizes, int n_in, void* d_out, int out_size, void* d_ws,
                              size_t ws_size, hipStream_t stream) {
  Params p{};
  const float** ip = (const float**)&p;
  for (int i = 0; i < 34; i++) ip[i] = (const float*)d_in[i];
  p.out = (float*)d_out;
  char* w = (char*)d_ws; size_t off = 0;
  auto take = [&](size_t bytes) { char* q = w + off; off += (bytes + 255) & ~(size_t)255; return q; };
  p.Wt_in = (u16*)take((size_t)2 * INC * 1024 * 2);
  p.Wt_br = (u16*)take((size_t)6 * 1024 * 512 * 2);
  p.Wt_out = (u16*)take((size_t)2 * 1024 * 1024 * 2);
  p.Y = (u16*)take((size_t)NTOK * 1024 * 2);
  p.P = (u16*)take((size_t)NTOK * PP * 2);
  p.VtA_ctx = p.Y;
  p.VtA_lat = p.VtA_ctx + (size_t)16 * 2 * 64 * 256;
  p.VtC_ctx = p.VtA_lat + (size_t)2 * 2 * 64 * 4096;
  p.VtC_lat = p.VtC_ctx + (size_t)16 * 4 * 128 * 256;
  p.cKa = (u16*)take((size_t)2 * 2 * 512 * 128 * 2);
  p.cVtA = (u16*)take((size_t)2 * 2 * 512 * 128 * 2);
  p.cKc = (u16*)take((size_t)2 * 2 * 512 * 512 * 2);
  p.cVtC = (u16*)take((size_t)2 * 2 * 512 * 512 * 2);
  p.mod = (float*)take((size_t)2 * 3 * 3072 * 4);
  p.rope = (float*)take((size_t)2048 * 4);
  p.lruTot = (float*)take((size_t)192 * 2 * 512 * 2 * 4);
  p.Wt_lru = (u16*)take((size_t)2 * 2 * 8 * 2 * 64 * 64 * 2);
  p.bar = (unsigned*)take((size_t)XCD_BAR_WORDS * 4);
  p.GB = (u16*)take((size_t)3 * NTOK * 512 * 2);
  p.H = p.GB;
  p.MG = (unsigned*)take((size_t)(48 * 4 * 3 + 1) * 16384 * 4);
  static int grid_blocks = 0;
  if (!grid_blocks) {
    int dev = 0, cus = 0;
    hipGetDevice(&dev);
    hipDeviceGetAttribute(&cus, hipDeviceAttributeMultiprocessorCount, dev);
    hipFuncSetAttribute((const void*)fwd_kernel, hipFuncAttributeMaxDynamicSharedMemorySize, LDS_BYTES);
    int per_cu = 0;
    hipOccupancyMaxActiveBlocksPerMultiprocessor(&per_cu, (const void*)fwd_kernel, NT, LDS_BYTES);
    (void)hipGetLastError();
    grid_blocks = cus;
  }
  hipMemsetAsync(p.bar, 0, (size_t)XCD_BAR_WORDS * 4, stream);
  void* args[] = {&p};
  hipLaunchCooperativeKernel((void*)fwd_kernel, dim3(grid_blocks), dim3(NT), args, LDS_BYTES, stream);
}
```

```cpp
#include <hip/hip_runtime.h>
#include <hip/hip_cooperative_groups.h>
#include <stdint.h>
#include <math.h>
namespace cg = cooperative_groups;

typedef unsigned short u16;
typedef __attribute__((ext_vector_type(8))) short bf16x8;
typedef __attribute__((ext_vector_type(4))) short bf16x4;
typedef __attribute__((ext_vector_type(16))) float f32x16;
typedef __attribute__((ext_vector_type(4))) float f32x4;
#define LAS __attribute__((address_space(3)))

#ifndef PROBE
#define PROBE 0
#endif
#define NT 512
constexpr int NTOK = 12288, NCTX = 4096;
constexpr int INC = 7424;
constexpr int PP = 3712;
constexpr int C_QA = 0, C_KA = 512, C_GA = 640, C_XB = 1152, C_GB = 1664, C_QC = 2176, C_KC = 2688, C_GC = 3200;
constexpr int LROW = 72;
constexpr int VROW = 68;
constexpr float EPS = 1e-6f;
constexpr int STAGE_BYTES = 131072;
constexpr int SPARE_BYTES = 8192;
constexpr int ROPE_OFF = STAGE_BYTES + SPARE_BYTES + 16;
constexpr int LDS_BYTES = ROPE_OFF + 8192;

constexpr size_t O_X = 0, O_KA = 12582912, O_VA = 13631488, O_KC = 14680064, O_VC = 18874368, O_ST = 23068672;

struct Params {
  const float *x_prompt, *x_sample, *cache_a_k, *cache_a_v, *cache_c_k, *cache_c_v, *state_lru, *c, *c_ctx,
      *norm_g, *mod_w, *mod_b, *w_in, *qn_a, *kn_a, *sink_a, *conv_w, *conv_b, *lru_wa, *lru_ba, *lru_wx, *lru_bx,
      *lru_lam, *qn_c, *kn_c, *lam_q1, *lam_k1, *lam_q2, *lam_k2, *subln_c, *w_br_a, *w_br_b, *w_br_c, *w_out;
  float* out;
  u16 *Wt_in, *Wt_br, *Wt_out, *H, *P, *VtA_ctx, *VtA_lat, *VtC_ctx, *VtC_lat, *cKa, *cVtA, *cKc, *cVtC;
  float *mod, *rope, *lruTot;
  u16 *Wt_lru;
  unsigned* bar;
  u16* Y;
  u16* GB;
  unsigned* MG;
};

__device__ __forceinline__ int tid_opaque() { int t = (int)threadIdx.x; asm volatile("" : "+v"(t)); return t; }
#define TIDX tid_opaque()
__device__ __forceinline__ u16 f2bf(float f) {
  uint32_t r; asm("v_cvt_pk_bf16_f32 %0, %1, %1" : "=v"(r) : "v"(f)); return (u16)(r & 0xffffu);
}
__device__ __forceinline__ float bf2f(u16 h) { return __uint_as_float(((uint32_t)h) << 16); }
__device__ __forceinline__ uint32_t pack2(float a, float b) { uint32_t r; asm("v_cvt_pk_bf16_f32 %0, %1, %2" : "=v"(r) : "v"(a), "v"(b)); return r; }
__device__ __forceinline__ float sigmoidf_(float x) { return __builtin_amdgcn_rcpf(1.f + __expf(-x)); }
__device__ __forceinline__ float siluf_(float x) { return x * __builtin_amdgcn_rcpf(1.f + __expf(-x)); }
__device__ __forceinline__ f32x16 mfma32(bf16x8 a, bf16x8 b, f32x16 c) {
  return __builtin_amdgcn_mfma_f32_32x32x16_bf16(a, b, c, 0, 0, 0);
}
__device__ __forceinline__ float shflx(float v, int mask, int lane) {
  return __builtin_bit_cast(float, __builtin_amdgcn_ds_bpermute((lane ^ mask) << 2, __builtin_bit_cast(int, v)));
}
__device__ __forceinline__ float half_max(float v) {
  const unsigned u = __builtin_bit_cast(unsigned, v);
  auto r = __builtin_amdgcn_permlane32_swap(u, u, false, false);
  return fmaxf(__builtin_bit_cast(float, (unsigned)r[0]), __builtin_bit_cast(float, (unsigned)r[1]));
}
__device__ __forceinline__ float half_sum(float v) {
  const unsigned u = __builtin_bit_cast(unsigned, v);
  auto r = __builtin_amdgcn_permlane32_swap(u, u, false, false);
  return __builtin_bit_cast(float, (unsigned)r[0]) + __builtin_bit_cast(float, (unsigned)r[1]);
}
__device__ __forceinline__ float lo_bf(uint32_t w) { return __uint_as_float(w << 16); }
__device__ __forceinline__ float hi_bf(uint32_t w) { return __uint_as_float(w & 0xffff0000u); }

__device__ __forceinline__ size_t tm_off(int r, int k, int KT) {
  return ((size_t)((r >> 8) * KT + (k >> 6)) * 256 + (r & 255)) * 64 + (k & 63);
}
__device__ __forceinline__ void transpose_tile(const float* __restrict__ src, int spitch, u16* __restrict__ dst, int dpitch,
                               int r0, int c0, float* sm, int KT = 0) {
  const int tid = TIDX;
#pragma unroll
  for (int i = 0; i < 2; i++) {
    int c = tid + i * NT; int r = c >> 4, q = c & 15;
    float4 v = *(const float4*)(src + (size_t)(r0 + r) * spitch + c0 + q * 4);
    float* d = sm + r * 65 + q * 4;
    d[0] = v.x; d[1] = v.y; d[2] = v.z; d[3] = v.w;
  }
  __syncthreads();
  {
    int c = tid; int cc = c >> 3, q = c & 7;
    uint32_t w[4];
#pragma unroll
    for (int j = 0; j < 4; j++) w[j] = pack2(sm[(q * 8 + 2 * j) * 65 + cc], sm[(q * 8 + 2 * j + 1) * 65 + cc]);
    uint4 v; v.x = w[0]; v.y = w[1]; v.z = w[2]; v.w = w[3];
    if (KT) *(uint4*)(dst + tm_off(c0 + cc, r0 + q * 8, KT)) = v;
    else *(uint4*)(dst + (size_t)(c0 + cc) * dpitch + r0 + q * 8) = v;
  }
  __syncthreads();
}

__device__ __forceinline__ void transpose_wide(const float* __restrict__ src, int spitch, u16* __restrict__ dst,
                                               int k0, int n0, float* sm, int KT) {
  const int tid = TIDX;
  float4 v[8];
#pragma unroll
  for (int i = 0; i < 8; i++) { int c = tid + i * NT; int r = c >> 6, q = c & 63; v[i] = *(const float4*)(src + (size_t)(k0 + r) * spitch + n0 + q * 4); }
#pragma unroll
  for (int i = 0; i < 8; i++) { int c = tid + i * NT; int r = c >> 6, q = c & 63; float* d = sm + r * 257 + q * 4; d[0] = v[i].x; d[1] = v[i].y; d[2] = v[i].z; d[3] = v[i].w; }
  __syncthreads();
#pragma unroll
  for (int i = 0; i < 4; i++) {
    int c = tid + i * NT; int nn = c >> 3, q = c & 7;
    uint4 o;
    o.x = pack2(sm[(q * 8 + 0) * 257 + nn], sm[(q * 8 + 1) * 257 + nn]);
    o.y = pack2(sm[(q * 8 + 2) * 257 + nn], sm[(q * 8 + 3) * 257 + nn]);
    o.z = pack2(sm[(q * 8 + 4) * 257 + nn], sm[(q * 8 + 5) * 257 + nn]);
    o.w = pack2(sm[(q * 8 + 6) * 257 + nn], sm[(q * 8 + 7) * 257 + nn]);
    *(uint4*)(dst + tm_off(n0 + nn, k0 + q * 8, KT)) = o;
  }
  __syncthreads();
}

__device__ __forceinline__ void mod_item(const Params& p, int it, float* sm) {
  const int tid = TIDX;
  const int l = it / 48, n0 = (it % 48) * 64;
  float* sv = sm;
  float* red = sm + 3072;
  for (int e = tid; e < 3072; e += NT) {
    int v = e >> 10, k = e & 1023;
    float x = (v == 0) ? p.c_ctx[k] : p.c[(v - 1) * 1024 + k];
    sv[e] = siluf_(x);
  }
  __syncthreads();
  const int col = tid & 63, kg = tid >> 6;
  const float* w = p.mod_w + (size_t)l * 1024 * 3072 + n0 + col;
  float a0 = 0, a1 = 0, a2 = 0;
#pragma unroll 1
  for (int kb = kg * 128; kb < kg * 128 + 128; kb += 32) {
    float wv[32];
#pragma unroll
    for (int j = 0; j < 32; j++) wv[j] = w[(size_t)(kb + j) * 3072];
#pragma unroll
    for (int j = 0; j < 32; j++) { a0 += sv[kb + j] * wv[j]; a1 += sv[1024 + kb + j] * wv[j]; a2 += sv[2048 + kb + j] * wv[j]; }
  }
  red[(kg * 3 + 0) * 64 + col] = a0; red[(kg * 3 + 1) * 64 + col] = a1; red[(kg * 3 + 2) * 64 + col] = a2;
  __syncthreads();
  if (tid < 192) {
    int v = tid >> 6, c = tid & 63;
    float s = p.mod_b[l * 3072 + n0 + c];
#pragma unroll
    for (int g = 0; g < 8; g++) s += red[(g * 3 + v) * 64 + c];
    p.mod[(l * 3 + v) * 3072 + n0 + c] = s;
  }
  __syncthreads();
}

__device__ __forceinline__ void prologue_phase(const Params& p, float* sm) {
  constexpr int N_MOD = 96, N_ROPE = 1, N_WIN = 2 * 16 * 29, N_WBR = 6 * 8 * 4, N_WOUT = 2 * 16 * 4;
  constexpr int N_CK = 64 + 256, N_CVA = 4 * 16, N_CVC = 4 * 64, N_LW = 64;
  constexpr int E0 = N_MOD, E1 = E0 + N_ROPE, E2 = E1 + N_WIN, E3 = E2 + N_WBR, E4 = E3 + N_WOUT, E5 = E4 + N_CK,
                E6 = E5 + N_CVA, E7 = E6 + N_CVC, E8 = E7 + N_LW;
  const int tid = TIDX;
  for (int it = blockIdx.x; it < E8; it += gridDim.x) {
    if (it < E0) {
      mod_item(p, it, sm);
    } else if (it < E1) {
      for (int e = tid; e < 1024; e += NT) {
        int pos = e >> 4, f = e & 15;
        float inv = powf(10000.f, -(float)f / 16.f);
        float ang = (float)pos * inv;
        p.rope[e] = cosf(ang); p.rope[1024 + e] = sinf(ang);
      }
    } else if (it < E2) {
      int j = it - E1; int l = j / (16 * 29); int r = j % (16 * 29);
      int kt = r / 29, pn = r % 29;
      transpose_wide(p.w_in + (size_t)l * 1024 * INC, INC, p.Wt_in + (size_t)l * INC * 1024, kt * 64, pn * 256, sm, 16);
    } else if (it < E3) {
      int j = it - E2; int m = j / 32; int r = j % 32;
      int l = m / 3, i = m % 3;
      const float* src = (i == 0 ? p.w_br_a : (i == 1 ? p.w_br_b : p.w_br_c)) + (size_t)l * 512 * 1024;
      int kt = r / 4, pn = r % 4;
      transpose_wide(src, 1024, p.Wt_br + (size_t)m * 1024 * 512, kt * 64, pn * 256, sm, 8);
    } else if (it < E4) {
      int j = it - E3; int l = j / 64; int r = j % 64;
      int kt = r / 4, pn = r % 4;
      transpose_wide(p.w_out + (size_t)l * 1024 * 1024, 1024, p.Wt_out + (size_t)l * 1024 * 1024, kt * 64, pn * 256, sm, 16);
    } else if (it < E5) {
      int j = it - E4;
      const float* src; u16* dst; size_t off;
      if (j < 64) { src = p.cache_a_k; dst = p.cKa; off = (size_t)j * 4096; }
      else { src = p.cache_c_k; dst = p.cKc; off = (size_t)(j - 64) * 4096; }
      size_t e = off + (size_t)tid * 8;
      float4 a = *(const float4*)(src + e), b = *(const float4*)(src + e + 4);
      uint4 v; v.x = pack2(a.x, a.y); v.y = pack2(a.z, a.w); v.z = pack2(b.x, b.y); v.w = pack2(b.z, b.w);
      *(uint4*)(dst + e) = v;
    } else if (it < E6) {
      int j = it - E5; int bl = j / 16; int r = j % 16;
      int rt = r / 2, ct = r % 2;
      transpose_tile(p.cache_a_v + (size_t)bl * 512 * 128, 128, p.cVtA + (size_t)bl * 128 * 512, 512, rt * 64, ct * 64, sm);
    } else if (it < E7) {
      int j = it - E6; int bl = j / 64; int r = j % 64;
      int rt = r / 8, ct = r % 8;
      transpose_tile(p.cache_c_v + (size_t)bl * 512 * 512, 512, p.cVtC + (size_t)bl * 512 * 512, 512, rt * 64, ct * 64, sm);
    } else {
      int j = it - E7; int ldn = j >> 1, g = j & 1;
      transpose_tile((g ? p.lru_wx : p.lru_wa) + (size_t)ldn * 4096, 64, p.Wt_lru + (size_t)(ldn * 2 + g) * 4096, 64, 0, 0, sm);
    }
  }
}

__device__ __forceinline__ void norm_phase(const Params& p, int l) {
  const int tid = TIDX, lane = tid & 63, wid = tid >> 6;
  const float* g = p.norm_g + l * 1024;
  for (int it = blockIdx.x; it < NTOK / 8; it += gridDim.x) {
    int row = it * 8 + wid;
    const float* x;
    if (l == 0) x = (row < NCTX) ? p.x_prompt + (size_t)row * 1024 : p.x_sample + (size_t)(row - NCTX) * 1024;
    else x = p.out + O_X + (size_t)row * 1024;
    int v = (row < NCTX) ? 0 : 1 + (row - NCTX) / 4096;
    const float* md = p.mod + (l * 3 + v) * 3072;
    float4 xv[4], gv[4], sh[4], sc[4]; float ss = 0;
#pragma unroll
    for (int i = 0; i < 4; i++) {
      const int c = i * 256 + lane * 4;
      xv[i] = *(const float4*)(x + c);
      gv[i] = *(const float4*)(g + c); sh[i] = *(const float4*)(md + c); sc[i] = *(const float4*)(md + 1024 + c);
    }
    __builtin_amdgcn_sched_barrier(0);
#pragma unroll
    for (int i = 0; i < 4; i++) ss += xv[i].x * xv[i].x + xv[i].y * xv[i].y + xv[i].z * xv[i].z + xv[i].w * xv[i].w;
#pragma unroll
    for (int o = 32; o > 0; o >>= 1) ss += shflx(ss, o, lane);
    float rinv = rsqrtf(ss * (1.f / 1024.f) + EPS);
#pragma unroll
    for (int i = 0; i < 4; i++) {
      int c = i * 256 + lane * 4;
      float h0 = xv[i].x * rinv * gv[i].x * (1.f + sc[i].x) + sh[i].x;
      float h1 = xv[i].y * rinv * gv[i].y * (1.f + sc[i].y) + sh[i].y;
      float h2 = xv[i].z * rinv * gv[i].z * (1.f + sc[i].z) + sh[i].z;
      float h3 = xv[i].w * rinv * gv[i].w * (1.f + sc[i].w) + sh[i].w;
      uint2 o2; o2.x = pack2(h0, h1); o2.y = pack2(h2, h3);
      *(uint2*)(p.H + tm_off(row, c, 16)) = o2;
    }
  }
}

constexpr int G_BK = 64, G_HALF = 128, G_HTB = G_HALF * G_BK * 2;
__device__ __forceinline__ int lds_byte(int r, int c) {
  const int st = (r >> 4) * 2 + (c >> 5), rr = r & 15, cc = c & 31, ob = rr * 64 + cc * 2;
  return st * 1024 + (ob ^ (((ob >> 9) & 1) << 5));
}
__device__ __forceinline__ void stage_rc(int b, int& R, int& C) {
  const int st = b / 1024, sb = b % 1024, swz = sb ^ (((sb >> 9) & 1) << 5);
  R = (st >> 1) * 16 + swz / 64; C = (st & 1) * 32 + (swz % 64) / 2;
}
struct Unit { int pm, pn, seg; };

struct SchedStd {
  int nM, nN, nwg, G, c; const char* A; const char* B; size_t tA, tB;
  __device__ __forceinline__ bool next(int i, Unit& u) const {
    const long L = (long)i * G + c; if (L >= nwg) return false;
    const int wgid = (int)L;
    const int nig = 8 * nN, gid = wgid / nig, fm = gid * 8, gsz = (nM - fm) < 8 ? (nM - fm) : 8;
    u.pm = fm + ((wgid % nig) % gsz); u.pn = (wgid % nig) / gsz; u.seg = 0; return true;
  }
  __device__ __forceinline__ const char* aptr(const Unit& u) const { return A + (size_t)u.pm * tA; }
  __device__ __forceinline__ const char* bptr(const Unit& u) const { return B + (size_t)u.pn * tB; }
};
struct SchedBranch {
  int G, c; const char* P_; const char* W_;
  __device__ __forceinline__ bool next(int i, Unit& u) const {
    if (G == 256) {
      if (i >= 3) return false;
      const int xcd = c >> 5, j = c & 31;
      if (j >= 24) return false;
      u.seg = i; u.pm = xcd * 6 + (j >> 2); u.pn = j & 3; return true;
    }
    const int tile = (i / 3) * G + c; if (tile >= 192) return false;
    u.seg = i % 3; u.pm = tile >> 2; u.pn = tile & 3; return true;
  }
  __device__ __forceinline__ const char* aptr(const Unit& u) const { return P_ + (size_t)((u.seg * 48 + u.pm) * 8) * 32768; }
  __device__ __forceinline__ const char* bptr(const Unit& u) const { return W_ + (size_t)((u.seg * 4 + u.pn) * 8) * 32768; }
};

template <class Epi, class Sched>
__device__ __forceinline__ float gemm_phase(LAS unsigned char* lds, const int K, const Sched& S, const Epi& E, int tmode = 0) {
  unsigned long long t_ph0 = 0, t_epi = 0; if (PROBE >= 20) t_ph0 = __builtin_amdgcn_s_memrealtime();
  const int tid = TIDX, wid = __builtin_amdgcn_readfirstlane(tid >> 6), lane = tid & 63, wr = wid >> 2, wc = wid & 3, fr = lane & 15, fq = lane >> 4;
  const int nt = K / G_BK;
  unsigned voffA[2], voffB[2];
#pragma unroll
  for (int i = 0; i < 2; ++i) { int R, C; stage_rc(tid * 16 + i * 8192, R, C);
    voffA[i] = (unsigned)(R * 64 + C) * 2u; voffB[i] = voffA[i]; }
  const size_t kstep = (size_t)32768;
  const size_t hA = (size_t)16384, hB = (size_t)16384;
  const unsigned ldsw = (unsigned)wid * 1024u;
  const int aoff = lds_byte(wr * 64 + fr, fq * 8), boff = lds_byte(wc * 32 + fr, fq * 8);
#define G_SA(b, h) (((b) * 2 + (h)) * G_HTB)
#define G_SB(b, h) ((4 + (b) * 2 + (h)) * G_HTB)
#define G_STAGE(bufoff, gbase, voff) do { _Pragma("unroll") for (int _i = 0; _i < 2; ++_i) \
    __builtin_amdgcn_global_load_lds((const unsigned*)((const char*)(gbase) + (voff)[_i]), (LAS unsigned*)(lds + (bufoff) + ldsw + _i * 8192), 16, 0, 0); } while (0)
#define G_LDA(dst, b, h) do { _Pragma("unroll") for (int m = 0; m < 4; ++m) _Pragma("unroll") for (int k = 0; k < 2; ++k) dst[m][k] = *(const LAS bf16x8*)(lds + G_SA(b, h) + aoff + m * 2048 + k * 1024); } while (0)
#define G_LDB(dst, b, h) do { _Pragma("unroll") for (int n = 0; n < 2; ++n) _Pragma("unroll") for (int k = 0; k < 2; ++k) dst[n][k] = *(const LAS bf16x8*)(lds + G_SB(b, h) + boff + n * 2048 + k * 1024); } while (0)
#define G_MMA(ai, bj, At, Bt) do { __builtin_amdgcn_s_setprio(1); _Pragma("unroll") for (int m = 0; m < 4; ++m) _Pragma("unroll") for (int n = 0; n < 2; ++n) _Pragma("unroll") for (int k = 0; k < 2; ++k) \
    acc[ai][bj][m][n] = __builtin_amdgcn_mfma_f32_16x16x32_bf16(Bt[n][k], At[m][k], acc[ai][bj][m][n], 0, 0, 0); __builtin_amdgcn_s_setprio(0); } while (0)
#define G_WAIT_V(n) asm volatile("s_waitcnt vmcnt(" #n ")" ::: "memory")
#define G_WAIT_L(n) asm volatile("s_waitcnt lgkmcnt(" #n ")" ::: "memory")
#define G_BAR __builtin_amdgcn_s_barrier()
#define G_SCHED __builtin_amdgcn_sched_barrier(0)
  Unit cur, nxt; int ui = 0;
  if (!S.next(0, cur)) return 0.f;
  f32x4 acc[2][2][4][2];
#pragma unroll
  for (int a = 0; a < 2; ++a)
#pragma unroll
    for (int b = 0; b < 2; ++b)
#pragma unroll
      for (int m = 0; m < 4; ++m)
#pragma unroll
        for (int n = 0; n < 2; ++n) acc[a][b][m][n] = (f32x4){0.f, 0.f, 0.f, 0.f};
  bf16x8 At[4][2], B0[2][2], B1[2][2];
  const char* cA = S.aptr(cur); const char* cB = S.bptr(cur);
  G_STAGE(G_SB(0, 0), cB, voffB); G_STAGE(G_SA(0, 0), cA, voffA); G_STAGE(G_SB(0, 1), cB + hB, voffB); G_STAGE(G_SA(0, 1), cA + hA, voffA);
  if (wr == 1) G_BAR;
  G_WAIT_V(4); G_BAR;
  G_STAGE(G_SB(1, 0), cB + kstep, voffB); G_STAGE(G_SA(1, 0), cA + kstep, voffA); G_STAGE(G_SB(1, 1), cB + hB + kstep, voffB);
  G_WAIT_V(6); G_BAR;
  for (;;) {
    const bool has_next = S.next(ui + 1, nxt);
    const char* nA = has_next ? S.aptr(nxt) : cA; const char* nB = has_next ? S.bptr(nxt) : cB;
    for (int t = 0; t < nt; t += 2) {
      const bool last = (t == nt - 2);
      const char* a1 = cA + (size_t)(t + 1) * kstep;
      const char* a2 = last ? nA : cA + (size_t)(t + 2) * kstep; const char* b2 = last ? nB : cB + (size_t)(t + 2) * kstep;
      const char* a3 = a2 + kstep; const char* b3 = b2 + kstep;
      G_LDB(B0, 0, 0); G_SCHED; G_LDA(At, 0, 0); G_STAGE(G_SA(1, 1), a1 + hA, voffA);
      G_WAIT_L(8); G_BAR; G_WAIT_L(0); G_MMA(0, 0, At, B0); G_BAR; G_SCHED;
      G_LDB(B1, 0, 1); G_STAGE(G_SB(0, 0), b2, voffB);
      G_BAR; G_WAIT_L(0); G_MMA(0, 1, At, B1); G_BAR;
      G_LDA(At, 0, 1); G_STAGE(G_SA(0, 0), a2, voffA);
      G_BAR; G_WAIT_L(0); G_MMA(1, 0, At, B0); G_BAR; G_SCHED;
      G_STAGE(G_SB(0, 1), b2 + hB, voffB);
      G_WAIT_V(6); G_BAR; G_MMA(1, 1, At, B1); G_BAR;
      G_LDB(B0, 1, 0); G_SCHED; G_LDA(At, 1, 0); G_STAGE(G_SA(0, 1), a2 + hA, voffA);
      G_WAIT_L(8); G_BAR; G_WAIT_L(0); G_MMA(0, 0, At, B0); G_BAR; G_SCHED;
      G_LDB(B1, 1, 1); G_STAGE(G_SB(1, 0), b3, voffB);
      G_BAR; G_WAIT_L(0); G_MMA(0, 1, At, B1); G_BAR;
      G_LDA(At, 1, 1); G_STAGE(G_SA(1, 0), a3, voffA);
      G_BAR; G_WAIT_L(0); G_MMA(1, 0, At, B0); G_BAR; G_SCHED;
      G_STAGE(G_SB(1, 1), b3 + hB, voffB);
      G_WAIT_V(6); G_BAR; G_MMA(1, 1, At, B1); G_BAR;
    }
    unsigned long long t_e0 = 0; if (PROBE >= 20) t_e0 = __builtin_amdgcn_s_memrealtime();
    const bool reset = E(acc, cur, wr, wc, fr, fq);
    if (PROBE >= 20) { asm volatile("s_waitcnt vmcnt(0)" ::: "memory"); t_epi += __builtin_amdgcn_s_memrealtime() - t_e0; }
    if (!has_next) break;
    if (reset) {
#pragma unroll
      for (int a = 0; a < 2; ++a)
#pragma unroll
        for (int b = 0; b < 2; ++b)
#pragma unroll
          for (int m = 0; m < 4; ++m)
#pragma unroll
            for (int n = 0; n < 2; ++n) acc[a][b][m][n] = (f32x4){0.f, 0.f, 0.f, 0.f};
    }
    cur = nxt; cA = nA; cB = nB; ++ui;
  }
  G_WAIT_V(0);
  if (wr == 0) G_BAR;
  G_BAR;
  float tres = 0.f;
  if (PROBE >= 20) {
    const unsigned long long tot = __builtin_amdgcn_s_memrealtime() - t_ph0;
    tres = (tmode == 0) ? (float)t_epi / (float)tot : (float)tot / 40000.f;
  }
#undef G_SA
#undef G_SB
#undef G_STAGE
#undef G_LDA
#undef G_LDB
#undef G_MMA
#undef G_WAIT_V
#undef G_WAIT_L
#undef G_BAR
#undef G_SCHED
  return tres;
}

struct EpiInproj {
  const Params* pp; int l; LAS float* part; const LAS float* ropeL;
  __device__ __forceinline__ bool operator()(f32x4 (&acc)[2][2][4][2], const Unit& u, int wr, int wc, int fr, int fq) const {
    const Params& p = *pp;
    asm volatile("" : "+v"(fr), "+v"(fq));
    const int lane = fr + 16 * fq; (void)lane;
    const int oc0 = u.pn * 256;
    const bool isctx = u.pm < 16;
    const bool qkU = (oc0 < 768) || (oc0 >= 2304 && oc0 < 3328);
    float rinv[2][4][2];
    if (qkU) {
#pragma unroll
      for (int ai = 0; ai < 2; ai++)
#pragma unroll
        for (int m = 0; m < 4; m++)
#pragma unroll
          for (int bj = 0; bj < 2; bj++) {
            f32x4 a = acc[ai][bj][m][0], b = acc[ai][bj][m][1];
            float ss = a[0] * a[0] + a[1] * a[1] + a[2] * a[2] + a[3] * a[3] + b[0] * b[0] + b[1] * b[1] + b[2] * b[2] + b[3] * b[3];
            ss += shflx(ss, 16, lane); ss += shflx(ss, 32, lane);
            rinv[ai][m][bj] = ss;
            if (fq == 0) part[((ai * 128 + wr * 64 + m * 16 + fr) * 2 + bj) * 4 + wc] = ss;
          }
      asm volatile("s_waitcnt lgkmcnt(0)" ::: "memory");
      __builtin_amdgcn_s_barrier();
      asm volatile("" ::: "memory");
#pragma unroll
      for (int ai = 0; ai < 2; ai++)
#pragma unroll
        for (int m = 0; m < 4; m++)
#pragma unroll
          for (int bj = 0; bj < 2; bj++) {
            float o = part[((ai * 128 + wr * 64 + m * 16 + fr) * 2 + bj) * 4 + (wc ^ 1)];
            rinv[ai][m][bj] = rsqrtf((rinv[ai][m][bj] + o) * (1.f / 64.f) + EPS);
          }
    }
#pragma unroll
    for (int bj = 0; bj < 2; bj++) {
      const int oc = oc0 + bj * 128;
      if (oc == 640 || (oc >= 3328 && oc < 3840)) {
        const bool isA = (oc == 640);
        const int cb = isA ? 0 : (oc - 3328);
        const int nvec = isA ? 128 : 512;
#pragma unroll
        for (int ai = 0; ai < 2; ai++)
#pragma unroll
          for (int m = 0; m < 4; m++) {
            const int row = u.pm * 256 + ai * 128 + wr * 64 + m * 16 + fr;
            int b, t, T; u16* vt;
            if (isctx) { b = row >> 8; t = row & 255; T = 256; vt = isA ? p.VtA_ctx : p.VtC_ctx; }
            else { int rr = row - NCTX; b = rr >> 12; t = rr & 4095; T = 4096; vt = isA ? p.VtA_lat : p.VtC_lat; }
#pragma unroll
            for (int n = 0; n < 2; n++) {
              const int d = cb + wc * 32 + n * 16 + fq * 4;
              f32x4 v = acc[ai][bj][m][n];
#pragma unroll
              for (int j = 0; j < 4; j++) vt[((size_t)b * nvec + d + j) * T + t] = f2bf(v[j]);
              if (isctx) {
                float* o = p.out + (isA ? O_VA : O_VC) + ((size_t)(b * 2 + l) * 256 + t) * nvec + d;
                *(f32x4*)o = v;
              }
            }
          }
      } else {
        const int pc = (oc < 640) ? oc : (oc < 3328 ? oc - 128 : oc - 640);
        const bool is_qa = oc < 512, is_ka = (oc == 512);
        const bool is_qc = (oc >= 2304 && oc < 2816), is_kc = (oc >= 2816 && oc < 3328);
        if (is_qa || is_ka || is_qc || is_kc) {
          const float* gn = (is_qa ? p.qn_a : is_ka ? p.kn_a : is_qc ? p.qn_c : p.kn_c) + l * 64 + (wc & 1) * 32 + fq * 4;
          const f32x4 g0 = *(const f32x4*)gn, g1 = *(const f32x4*)(gn + 16);
          const float qs = (is_qa || is_qc) ? 0.18033688011112042f : 1.f;
#pragma unroll
          for (int ai = 0; ai < 2; ai++)
#pragma unroll
            for (int m = 0; m < 4; m++) {
              const int row = u.pm * 256 + ai * 128 + wr * 64 + m * 16 + fr;
              const float ri = rinv[ai][m][bj];
              f32x4 x1 = acc[ai][bj][m][0] * ri * g0, x2 = acc[ai][bj][m][1] * ri * g1;
              if (!isctx) {
                const int t = (row - NCTX) & 4095;
                const int pos = (wc & 1) ? (t & 63) : (t >> 6);
                const f32x4 cs = *(const LAS f32x4*)(ropeL + pos * 16 + fq * 4), sn = *(const LAS f32x4*)(ropeL + 1024 + pos * 16 + fq * 4);
                f32x4 y1 = x1 * cs - x2 * sn, y2 = x2 * cs + x1 * sn;
                x1 = y1; x2 = y2;
              } else if (is_ka || is_kc) {
                const int b = row >> 8, t = row & 255;
                float* o = is_ka ? p.out + O_KA + ((size_t)(b * 2 + l) * 256 + t) * 128 + wc * 32 + fq * 4
                                 : p.out + O_KC + ((size_t)(b * 2 + l) * 256 + t) * 512 + (oc - 2816) + wc * 32 + fq * 4;
                *(f32x4*)o = x1; *(f32x4*)(o + 16) = x2;
              }
              x1 = x1 * qs; x2 = x2 * qs;
              u16* po = p.P + (size_t)row * PP + pc + wc * 32 + fq * 4;
              *(uint2*)po = make_uint2(pack2(x1[0], x1[1]), pack2(x1[2], x1[3]));
              *(uint2*)(po + 16) = make_uint2(pack2(x2[0], x2[1]), pack2(x2[2], x2[3]));
            }
        } else {
          const int mode = (oc >= 4352) ? 2 : ((oc >= 1280 && oc < 1792) ? 0 : 1);
          if (mode == 2) {
            const int pj = u.pn - 17, seg = pj >> 2, pn4 = pj & 3;
            unsigned* mg = p.MG + ((size_t)((u.pm * 4 + pn4) * 3 + seg) * 8 + (wr * 4 + wc)) * 2048 + lane;
#pragma unroll
            for (int ai = 0; ai < 2; ai++)
#pragma unroll
              for (int m = 0; m < 4; m++)
#pragma unroll
                for (int n = 0; n < 2; n++) {
                  f32x4 v = acc[ai][bj][m][n];
                  const unsigned q0 = (unsigned)(sigmoidf_(v[0]) * 254.f + 1.5f), q1 = (unsigned)(sigmoidf_(v[1]) * 254.f + 1.5f);
                  const unsigned q2 = (unsigned)(sigmoidf_(v[2]) * 254.f + 1.5f), q3 = (unsigned)(sigmoidf_(v[3]) * 254.f + 1.5f);
                  mg[(((ai * 4 + m) * 2 + bj) * 2 + n) * 64] = q0 | (q1 << 8) | (q2 << 16) | (q3 << 24);
                }
          } else
#pragma unroll
          for (int ai = 0; ai < 2; ai++)
#pragma unroll
            for (int m = 0; m < 4; m++) {
              const int row = u.pm * 256 + ai * 128 + wr * 64 + m * 16 + fr;
              u16* po = p.P + (size_t)row * PP + pc + wc * 32 + fq * 4;
#pragma unroll
              for (int n = 0; n < 2; n++) {
                f32x4 v = acc[ai][bj][m][n];
                if (mode == 1) { v[0] = siluf_(v[0]); v[1] = siluf_(v[1]); v[2] = siluf_(v[2]); v[3] = siluf_(v[3]); }
                else if (mode == 2) { v[0] = sigmoidf_(v[0]); v[1] = sigmoidf_(v[1]); v[2] = sigmoidf_(v[2]); v[3] = sigmoidf_(v[3]); }
                *(uint2*)(po + n * 16) = make_uint2(pack2(v[0], v[1]), pack2(v[2], v[3]));
              }
            }
        }
      }
    }
    return true;
  }
};

struct EpiBranch {
  const Params* pp;
  __device__ __forceinline__ bool operator()(f32x4 (&acc)[2][2][4][2], const Unit& u, int wr, int wc, int fr, int fq) const {
    const Params& p = *pp;
    asm volatile("" : "+v"(fr), "+v"(fq));
    const int lane = fr + 16 * fq;
    const int seg = u.seg;
    const unsigned* mg = p.MG + ((size_t)((u.pm * 4 + u.pn) * 3 + seg) * 8 + (wr * 4 + wc)) * 2048 + lane;
    const float sel = (seg < 2) ? 1.f : 0.f;
#pragma unroll
    for (int hq = 0; hq < 4; hq++) {
      unsigned a[8], b[8];
#pragma unroll
      for (int q = 0; q < 8; q++) { a[q] = mg[(hq * 8 + q) * 64]; b[q] = mg[(hq * 8 + q) * 64 + 8 * 2048]; }
      __builtin_amdgcn_sched_barrier(0);
#pragma unroll
      for (int q = 0; q < 8; q++) {
        const int ai = hq >> 1, m = (hq & 1) * 2 + (q >> 2), bj = (q >> 1) & 1, n = q & 1;
        f32x4 f = {(float)(a[q] & 255u), (float)((a[q] >> 8) & 255u), (float)((a[q] >> 16) & 255u), (float)(a[q] >> 24)};
        f32x4 g = {(float)(b[q] & 255u), (float)((b[q] >> 8) & 255u), (float)((b[q] >> 16) & 255u), (float)(b[q] >> 24)};
        g = g * sel + (1.f - sel) * 255.f;
        f[0] *= __builtin_amdgcn_rcpf(g[0]); f[1] *= __builtin_amdgcn_rcpf(g[1]); f[2] *= __builtin_amdgcn_rcpf(g[2]); f[3] *= __builtin_amdgcn_rcpf(g[3]);
        acc[ai][bj][m][n] = acc[ai][bj][m][n] * f;
      }
    }
    if (seg < 2) return false;
#pragma unroll
    for (int ai = 0; ai < 2; ai++)
#pragma unroll
      for (int m = 0; m < 4; m++) {
        const int row = u.pm * 256 + ai * 128 + wr * 64 + m * 16 + fr;
#pragma unroll
        for (int bj = 0; bj < 2; bj++)
#pragma unroll
          for (int n = 0; n < 2; n++) {
            const int col = u.pn * 256 + bj * 128 + wc * 32 + n * 16 + fq * 4;
            const f32x4 v = acc[ai][bj][m][n];
            *(uint2*)(p.Y + tm_off(row, col, 16)) = make_uint2(pack2(v[0], v[1]), pack2(v[2], v[3]));
          }
      }
    return true;
  }
};

struct EpiOut {
  const Params* pp; int l;
  __device__ __forceinline__ bool operator()(f32x4 (&acc)[2][2][4][2], const Unit& u, int wr, int wc, int fr, int fq) const {
    const Params& p = *pp;
    asm volatile("" : "+v"(fr), "+v"(fq));
    const int v = (u.pm < 16) ? 0 : 1 + (u.pm - 16) / 16;
    const float* gt = p.mod + (l * 3 + v) * 3072 + 2048 + u.pn * 256 + wc * 32 + fq * 4;
    const float* xsrc = (l == 0) ? ((u.pm < 16) ? p.x_prompt + (size_t)u.pm * 256 * 1024 : p.x_sample + (size_t)(u.pm - 16) * 256 * 1024)
                                 : p.out + O_X + (size_t)u.pm * 256 * 1024;
    float* odst = p.out + O_X + (size_t)u.pm * 256 * 1024;
    const int cbase = u.pn * 256 + wc * 32 + fq * 4;
    f32x4 gv[2][2];
#pragma unroll
    for (int bj = 0; bj < 2; bj++)
#pragma unroll
      for (int n = 0; n < 2; n++) gv[bj][n] = *(const f32x4*)(gt + bj * 128 + n * 16);
#pragma unroll
    for (int ai = 0; ai < 2; ai++)
#pragma unroll
      for (int mh = 0; mh < 2; mh++) {
        f32x4 xv[2][2][2];
#pragma unroll
        for (int mm = 0; mm < 2; mm++)
#pragma unroll
          for (int bj = 0; bj < 2; bj++)
#pragma unroll
            for (int n = 0; n < 2; n++)
              xv[mm][bj][n] = *(const f32x4*)(xsrc + (size_t)(ai * 128 + wr * 64 + (mh * 2 + mm) * 16 + fr) * 1024 + cbase + bj * 128 + n * 16);
#pragma unroll
        for (int mm = 0; mm < 2; mm++)
#pragma unroll
          for (int bj = 0; bj < 2; bj++)
#pragma unroll
            for (int n = 0; n < 2; n++)
              *(f32x4*)(odst + (size_t)(ai * 128 + wr * 64 + (mh * 2 + mm) * 16 + fr) * 1024 + cbase + bj * 128 + n * 16) = xv[mm][bj][n] + gv[bj][n] * acc[ai][bj][mh * 2 + mm][n];
      }
    return true;
  }
};

template <bool MASK>
__device__ __forceinline__ void fs_scores(const u16* Ks, const bf16x8 (&qf)[4], f32x16 (&s)[2], int lane, int kpos0, int qpos, int T) {
  const int r = lane & 31, h = lane >> 5;
  {
    bf16x8 kf[2][4];
#pragma unroll
    for (int sub = 0; sub < 2; sub++)
#pragma unroll
      for (int ks = 0; ks < 4; ks++) kf[sub][ks] = *(const bf16x8*)(Ks + (sub * 32 + r) * LROW + ks * 16 + h * 8);
    __builtin_amdgcn_sched_barrier(0);
#pragma unroll
    for (int sub = 0; sub < 2; sub++) {
#pragma unroll
      for (int e = 0; e < 16; e++) s[sub][e] = 0.f;
#pragma unroll
      for (int ks = 0; ks < 4; ks++) s[sub] = mfma32(kf[sub][ks], qf[ks], s[sub]);
    }
  }
  if (MASK) {
#pragma unroll
    for (int sub = 0; sub < 2; sub++)
#pragma unroll
      for (int e = 0; e < 16; e++) {
        int kp = kpos0 + sub * 32 + (e & 3) + 8 * (e >> 2) + 4 * h;
        int dlt = kp - qpos;
        bool ok = (kp >= 0) && (kp < T) && (dlt <= 128) && (dlt >= -128);
        if (!ok) s[sub][e] = -INFINITY;
      }
  }
}
template <int DV>
__device__ __forceinline__ void fs_softmax(f32x16 (&s)[2], float& m, float& l, f32x16 (&o)[DV / 32], bf16x8 (&pf)[2][2], int lane) {
  float mx = s[0][0];
#pragma unroll
  for (int sub = 0; sub < 2; sub++)
#pragma unroll
    for (int e = 0; e < 16; e++) mx = fmaxf(mx, s[sub][e]);
  mx = half_max(mx);
  const bool grow = mx > m;
  const float mn = grow ? mx : m;
  float sum = 0.f;
#pragma unroll
  for (int sub = 0; sub < 2; sub++)
#pragma unroll
    for (int e = 0; e < 16; e++) { float pv = __builtin_amdgcn_exp2f(s[sub][e] - mn); s[sub][e] = pv; sum += pv; }
  sum = half_sum(sum);
  if (__builtin_amdgcn_ballot_w64(grow) != 0ull) {
    const float alpha = __builtin_amdgcn_exp2f(m - mn);
    l *= alpha;
#pragma unroll
    for (int ds = 0; ds < DV / 32; ds++)
#pragma unroll
      for (int e = 0; e < 16; e++) o[ds][e] *= alpha;
  }
  l += sum; m = mn;
  typedef __attribute__((ext_vector_type(4))) unsigned u32x4;
#pragma unroll
  for (int sub = 0; sub < 2; sub++)
#pragma unroll
    for (int st = 0; st < 2; st++) {
      u32x4 pw;
#pragma unroll
      for (int j = 0; j < 4; j++) pw[j] = pack2(s[sub][8 * st + 2 * j], s[sub][8 * st + 2 * j + 1]);
      pf[sub][st] = __builtin_bit_cast(bf16x8, pw);
    }
}
template <int DV>
__device__ __forceinline__ void fs_pv(const bf16x8 (&pf)[2][2], const u16* Vts, f32x16 (&o)[DV / 32], int lane) {
  const int r = lane & 31, h = lane >> 5;
#pragma unroll
  for (int sub = 0; sub < 2; sub++) {
    bf16x8 vf[2][DV / 32];
#pragma unroll
    for (int st = 0; st < 2; st++)
#pragma unroll
      for (int ds = 0; ds < DV / 32; ds++) {
        const u16* vp = Vts + (ds * 32 + r) * VROW + sub * 32 + 16 * st + 4 * h;
        bf16x4 lo = *(const bf16x4*)vp, hi = *(const bf16x4*)(vp + 8);
        vf[st][ds] = __builtin_shufflevector(lo, hi, 0, 1, 2, 3, 4, 5, 6, 7);
      }
    __builtin_amdgcn_sched_barrier(0);
#pragma unroll
    for (int st = 0; st < 2; st++)
#pragma unroll
      for (int ds = 0; ds < DV / 32; ds++) o[ds] = mfma32(vf[st][ds], pf[sub][st], o[ds]);
    __builtin_amdgcn_sched_barrier(0);
  }
}

__device__ __forceinline__ uint4 ld_k(const u16* __restrict__ src, size_t pitch, int r0, int nrows, int c) {
  int row = c >> 3, kc = c & 7; int rr = r0 + row;
  const bool ok = (rr >= 0 && rr < nrows);
  const int rc = rr < 0 ? 0 : (rr >= nrows ? nrows - 1 : rr);
  uint4 v = *(const uint4*)(src + (size_t)rc * pitch + kc * 8);
  if (!ok) v = make_uint4(0, 0, 0, 0);
  return v;
}
__device__ __forceinline__ void st_k(u16* dst, int c, uint4 v) { *(uint4*)(dst + (c >> 3) * LROW + (c & 7) * 8) = v; }
__device__ __forceinline__ uint4 ld_vt(const u16* __restrict__ src, int T, int k0, int c) {
  int d = c >> 3, kc = c & 7; int k = k0 + kc * 8;
  const bool ok = (k >= 0 && k < T);
  const int kk = k < 0 ? 0 : (k >= T ? T - 8 : k);
  uint4 v = *(const uint4*)(src + (size_t)d * T + kk);
  if (!ok) v = make_uint4(0, 0, 0, 0);
  return v;
}
__device__ __forceinline__ void st_vt(u16* dst, int c, uint4 v) {
  uint2* q = (uint2*)(dst + (c >> 3) * VROW + (c & 7) * 8);
  q[0] = make_uint2(v.x, v.y); q[1] = make_uint2(v.z, v.w);
}

constexpr int A_BUF = 64 * LROW + 64 * VROW;
__device__ __forceinline__ void attnA_item(const Params& p, int l, int it, u16* sm, bool dry = false) {
  const int tid = TIDX, lane = tid & 63, wid = tid >> 6;
  const int r = lane & 31, h = lane >> 5;
  const bool isctx = it < 128;
  int b, kvh, qb, T, rowbase; const u16* VtBase;
  if (isctx) { b = it >> 3; kvh = (it >> 2) & 1; qb = it & 3; T = 256; rowbase = b * 256;
    VtBase = p.VtA_ctx + ((size_t)(b * 2 + kvh) * 64) * 256; }
  else { int j = it - 128; b = j >> 7; kvh = (j >> 6) & 1; qb = j & 63; T = 4096; rowbase = NCTX + b * 4096;
    VtBase = p.VtA_lat + ((size_t)(b * 2 + kvh) * 64) * 4096; }
  const int qblk = qb * 64;
  const int q0 = qblk + (wid >> 2) * 32;
  const int head = kvh * 4 + (wid & 3);
  const size_t prow = (size_t)(rowbase + q0 + r) * PP;
  bf16x8 qf[4];
#pragma unroll
  for (int ks = 0; ks < 4; ks++) qf[ks] = *(const bf16x8*)(p.P + prow + C_QA + head * 64 + ks * 16 + h * 8);
  float m = p.sink_a[l * 8 + head] * 1.4426950408889634f, ls = 1.f;
  f32x16 o[2];
#pragma unroll
  for (int ds = 0; ds < 2; ds++)
#pragma unroll
    for (int e = 0; e < 16; e++) o[ds][e] = 0.f;
  const u16* Kbase = p.P + (size_t)rowbase * PP + C_KA + kvh * 64;
  const u16* cK = p.cKa + ((size_t)(b * 2 + l) * 512) * 128 + kvh * 64;
  const u16* cVt = p.cVtA + ((size_t)((b * 2 + l) * 2 + kvh) * 64) * 512;
  const int qpos = q0 + r;
  int i_lo = 0, nW, ntile;
  if (isctx) { nW = 4; ntile = 4; }
  else {
    i_lo = (qblk < 128) ? (128 - qblk) / 64 : 0;
    int i_hi = (T - qblk + 128) / 64; if (i_hi > 5) i_hi = 5;
    nW = i_hi - i_lo; ntile = nW + 8;
  }
  uint4 rk, rv;
  auto tile_load = [&](int t) {
    if (t < nW) {
      int k0 = isctx ? t * 64 : qblk - 128 + 64 * (i_lo + t);
      rk = ld_k(Kbase, PP, k0, T, tid); rv = ld_vt(VtBase, T, k0, tid);
    } else {
      int kt = t - nW;
      rk = ld_k(cK, 128, kt * 64, 512, tid); rv = ld_vt(cVt, 512, kt * 64, tid);
    }
  };
  auto KB = [&](int i) { return sm + (i & 1) * (64 * LROW); };
  auto VB = [&](int i) { return sm + 2 * 64 * LROW + (i % 3) * (64 * VROW); };
  const bool lag = (wid >> 2) != 0;
  __syncthreads();
  tile_load(0);
  st_k(KB(0), tid, rk); st_vt(VB(0), tid, rv);
  __syncthreads();
  bf16x8 pf[2][2];
  for (int t = 0; t <= ntile; t++) {
    const bool more = t + 1 < ntile;
    if (more) tile_load(t + 1);
    if (lag && t > 0) fs_pv<64>(pf, VB(t - 1), o, lane);
    if (t < ntile) {
      f32x16 sc[2];
      bool needmask = false;
      if (!isctx && t < nW) {
        const int k0 = qblk - 128 + 64 * (i_lo + t);
        needmask = (k0 - q0 < -97) || (k0 - q0 > 65) || (k0 < 0) || (k0 + 64 > T);
      }
      if (needmask) fs_scores<true>(KB(t), qf, sc, lane, qblk - 128 + 64 * (i_lo + t), qpos, T);
      else fs_scores<false>(KB(t), qf, sc, lane, 0, 0, T);
      fs_softmax<64>(sc, m, ls, o, pf, lane);
      if (!lag) fs_pv<64>(pf, VB(t), o, lane);
    }
    if (more) { st_k(KB(t + 1), tid, rk); st_vt(VB(t + 1), tid, rv); }
    __syncthreads();
  }
  const float inv = __builtin_amdgcn_rcpf(ls);
  {
    uint2 gv[2][4];
#pragma unroll
    for (int ds = 0; ds < 2; ds++)
#pragma unroll
      for (int g = 0; g < 4; g++) gv[ds][g] = *(const uint2*)(p.P + prow + C_GA + head * 64 + ds * 32 + 8 * g + 4 * h);
    __builtin_amdgcn_sched_barrier(0);
#pragma unroll
    for (int ds = 0; ds < 2; ds++)
#pragma unroll
      for (int g = 0; g < 4; g++) {
        int d = ds * 32 + 8 * g + 4 * h;
        uint2 ov;
        ov.x = pack2(o[ds][4 * g] * inv * lo_bf(gv[ds][g].x), o[ds][4 * g + 1] * inv * hi_bf(gv[ds][g].x));
        ov.y = pack2(o[ds][4 * g + 2] * inv * lo_bf(gv[ds][g].y), o[ds][4 * g + 3] * inv * hi_bf(gv[ds][g].y));
        *(uint2*)(p.GB + tm_off(rowbase + q0 + r, head * 64 + d, 8)) = ov;
      }
  }
}

constexpr int C_BUF = 128 * LROW + 128 * VROW;
__device__ __forceinline__ void attnC_item(const Params& p, int l, int it, u16* sm, float lam, float lam_init, bool dry = false) {
  const int tid = TIDX, lane = tid & 63, wid = tid >> 6;
  const int r = lane & 31, h = lane >> 5;
  const bool isctx = it < 128;
  int b, hd, qb, T, rowbase; const u16* VtBase;
  if (isctx) { b = it >> 3; hd = (it >> 1) & 3; qb = it & 1; T = 256; rowbase = b * 256;
    VtBase = p.VtC_ctx + ((size_t)(b * 4 + hd) * 128) * 256; }
  else { int j = it - 128; b = j >> 7; hd = (j >> 5) & 3; qb = j & 31; T = 4096; rowbase = NCTX + b * 4096;
    VtBase = p.VtC_lat + ((size_t)(b * 4 + hd) * 128) * 4096; }
  const int qg = wid & 3, map = wid >> 2;
  const int q0 = qb * 128 + qg * 32;
  const size_t prow = (size_t)(rowbase + q0 + r) * PP;
  bf16x8 qf[4];
#pragma unroll
  for (int ks = 0; ks < 4; ks++) qf[ks] = *(const bf16x8*)(p.P + prow + C_QC + hd * 128 + map * 64 + ks * 16 + h * 8);
  float m = -1e30f, ls = 0.f;
  f32x16 o[4];
#pragma unroll
  for (int ds = 0; ds < 4; ds++)
#pragma unroll
    for (int e = 0; e < 16; e++) o[ds][e] = 0.f;
  const u16* Kbase = p.P + (size_t)rowbase * PP + C_KC + hd * 128;
  const u16* cK = p.cKc + ((size_t)(b * 2 + l) * 512) * 512 + hd * 128;
  const u16* cVt = p.cVtC + ((size_t)((b * 2 + l) * 4 + hd) * 128) * 512;
  const int nW = T / 64, ntile = isctx ? nW : nW + 8;
  uint4 rk0, rk1, rv0, rv1;
  const u16* pk = Kbase + (size_t)(tid >> 3) * PP + (tid & 7) * 8;
  const u16* pv0 = VtBase + (size_t)(tid >> 3) * T + (tid & 7) * 8;
  const u16* pv1 = VtBase + (size_t)((tid + NT) >> 3) * T + (tid & 7) * 8;
  size_t kstride = (size_t)64 * PP;
  auto tile_load = [&](int t) {
    if (t == nW) {
      pk = cK + (size_t)(tid >> 3) * 512 + (tid & 7) * 8;
      pv0 = cVt + (size_t)(tid >> 3) * 512 + (tid & 7) * 8;
      pv1 = cVt + (size_t)((tid + NT) >> 3) * 512 + (tid & 7) * 8;
      kstride = (size_t)64 * 512;
    }
    rk0 = *(const uint4*)pk; rk1 = *(const uint4*)(pk + 64);
    rv0 = *(const uint4*)pv0; rv1 = *(const uint4*)pv1;
    pk += kstride; pv0 += 64; pv1 += 64;
  };
  auto KB = [&](int i) { return sm + (i & 1) * (128 * LROW); };
  auto VB = [&](int i) { return sm + 2 * 128 * LROW + (i % 3) * (128 * VROW); };
  auto tile_store = [&](int i) {
    u16* kd = KB(i); u16* vd = VB(i);
    st_k(kd, tid, rk0); st_k(kd + 64 * LROW, tid, rk1);
    st_vt(vd, tid, rv0); st_vt(vd, tid + NT, rv1);
  };
  const bool lag = map != 0;
  __syncthreads();
  tile_load(0);
  tile_store(0);
  __syncthreads();
  bf16x8 pf[2][2];
  for (int t = 0; t <= ntile; t++) {
    const bool more = t + 1 < ntile;
    if (more) tile_load(t + 1);
    if (lag && t > 0) fs_pv<128>(pf, VB(t - 1), o, lane);
    if (t < ntile) {
      f32x16 sc[2];
      fs_scores<false>(KB(t) + map * 64 * LROW, qf, sc, lane, 0, 0, T);
      fs_softmax<128>(sc, m, ls, o, pf, lane);
      if (!lag) fs_pv<128>(pf, VB(t), o, lane);
    }
    if (more) tile_store(t + 1);
    __syncthreads();
  }
  float* xch = (float*)sm;
  if (map == 1) {
    const float inv = lam * __builtin_amdgcn_rcpf(ls);
#pragma unroll
    for (int ds = 0; ds < 4; ds++)
#pragma unroll
      for (int e = 0; e < 16; e++) xch[((qg * 64) + ds * 16 + e) * 64 + lane] = o[ds][e] * inv;
  }
  __syncthreads();
  if (map == 0) {
    const float i0 = __builtin_amdgcn_rcpf(ls);
    float ss = 0.f;
#pragma unroll
    for (int ds = 0; ds < 4; ds++)
#pragma unroll
      for (int e = 0; e < 16; e++) {
        float v = o[ds][e] * i0 - xch[((qg * 64) + ds * 16 + e) * 64 + lane];
        o[ds][e] = v; ss += v * v;
      }
    ss += shflx(ss, 32, lane);
    const float rinv = rsqrtf(ss * (1.f / 128.f) + EPS) * (1.f - lam_init);
    const float* sg = p.subln_c + l * 128;
#pragma unroll
    for (int ds = 0; ds < 4; ds++) {
      uint2 gv[4]; float4 sl[4];
#pragma unroll
      for (int g = 0; g < 4; g++) {
        const int d = ds * 32 + 8 * g + 4 * h;
        gv[g] = *(const uint2*)(p.P + prow + C_GC + hd * 128 + d);
        sl[g] = *(const float4*)(sg + d);
      }
      __builtin_amdgcn_sched_barrier(0);
#pragma unroll
      for (int g = 0; g < 4; g++) {
        const int d = ds * 32 + 8 * g + 4 * h;
        uint2 ov;
        ov.x = pack2(o[ds][4 * g] * rinv * sl[g].x * lo_bf(gv[g].x), o[ds][4 * g + 1] * rinv * sl[g].y * hi_bf(gv[g].x));
        ov.y = pack2(o[ds][4 * g + 2] * rinv * sl[g].z * lo_bf(gv[g].y), o[ds][4 * g + 3] * rinv * sl[g].w * hi_bf(gv[g].y));
        *(uint2*)(p.GB + (size_t)2 * NTOK * 512 + tm_off(rowbase + q0 + r, hd * 128 + d, 8)) = ov;
      }
    }
  }
}

__device__ __forceinline__ void lru_run(const Params& p, int l, bool pass2, int start, int G, float* sm, bool dry = false) {
  const int tid = TIDX;
  const int lane = tid & 63, wid = tid >> 6, r = lane & 31, h = lane >> 5;
  const int n = start & 7;
  float* xin = sm;
  float* xb = sm + 67 * 64;
  float* comb = xb + 64 * 64;
  float* carry = comb + 2048;
  float* parts = carry + 128;
  float* ab = parts + 1024;
  u16* xbh = (u16*)(ab + 4 * 4096);
  const int gd = wid >> 2, gth = (wid >> 1) & 1, gdh = wid & 1;
  bf16x8 wfa[4], wfx[4];
  {
    const u16* wbase = p.Wt_lru + ((size_t)(((l * 2 + gd) * 8 + n) * 2) * 64 + gdh * 32 + r) * 64 + h * 8;
#pragma unroll
    for (int ks = 0; ks < 4; ks++) { wfa[ks] = *(const bf16x8*)(wbase + ks * 16); wfx[ks] = *(const bf16x8*)(wbase + 4096 + ks * 16); }
  }
  const int gch = n * 64 + gdh * 32 + r;
  const float g_ba = p.lru_ba[(l * 2 + gd) * 512 + gch], g_bx = p.lru_bx[(l * 2 + gd) * 512 + gch];
  const float g_sp = log1pf(__expf(-p.lru_lam[(l * 2 + gd) * 512 + gch]));
  const int cc = tid & 63;
  float cw[4]; float cbv;
  {
    const float* cwp = p.conv_w + l * 4 * 512 + n * 64 + cc;
    cw[0] = cwp[0]; cw[1] = cwp[512]; cw[2] = cwp[1024]; cw[3] = cwp[1536];
    cbv = p.conv_b[l * 512 + n * 64 + cc];
  }
  const int dout = tid & 63, tg = tid >> 6;
  const int ch = n * 64 + dout;

  u16 xr[9];
  auto xin_load = [&](int it_) {
    const int row0_ = (it_ >> 3) * 64;
    int T_, seq0_;
    if (row0_ < NCTX) { T_ = 256; seq0_ = (row0_ >> 8) * 256; } else { T_ = 4096; seq0_ = NCTX + ((row0_ - NCTX) >> 12) * 4096; }
    const int t0_ = row0_ - seq0_;
#pragma unroll
    for (int k = 0; k < 9; k++) {
      const int rr = (tid >> 6) + 8 * k; const int t = t0_ - 2 + rr;
      const bool ok = (rr < 67 && t >= 0 && t < T_);
      const int tc = t < 0 ? 0 : (t >= T_ ? T_ - 1 : t);
      u16 v = p.P[(size_t)(seq0_ + tc) * PP + C_XB + n * 64 + cc];
      xr[k] = ok ? v : (u16)0;
    }
  };
  if (start < 1536) xin_load(start);
  for (int it = start; it < 1536; it += G) {
    const int ci = it >> 3;
    const int row0 = ci * 64;
    const bool isctx = row0 < NCTX;
    int T, seq0, bidx;
    if (isctx) { T = 256; bidx = row0 >> 8; seq0 = bidx * 256; }
    else { T = 4096; bidx = (row0 - NCTX) >> 12; seq0 = NCTX + bidx * 4096; }
    const int t0 = row0 - seq0;
    __syncthreads();
#pragma unroll
    for (int k = 0; k < 9; k++) { const int rr = (tid >> 6) + 8 * k; if (rr < 67) xin[rr * 64 + cc] = bf2f(xr[k]); }
    if (it + G < 1536) xin_load(it + G);
    u16 sgr[8];
    if (pass2) {
#pragma unroll
      for (int tt = 0; tt < 8; tt++) sgr[tt] = p.P[(size_t)(row0 + tg * 8 + tt) * PP + C_GB + ch];
    }
    if (pass2) {
      const int d = (tid >> 6) & 1, part = tid >> 7;
      const int cfirst = seq0 >> 6, clast = (seq0 + T - 64) >> 6;
      const int K = d ? (clast - ci) : (ci - cfirst);
      float2 q[16];
#pragma unroll
      for (int k = 0; k < 16; k++) {
        const int kk = part * 16 + k;
        const int cj = d ? (clast - kk) : (cfirst + kk);
        const int cjc = cj < cfirst ? cfirst : (cj > clast ? clast : cj);
        const float2 qv = *(const float2*)(p.lruTot + ((size_t)(cjc * 2 + d) * 512 + n * 64 + cc) * 2);
        q[k] = (kk < K) ? qv : make_float2(1.f, 0.f);
      }
      float At = 1.f, Bt = 0.f;
#pragma unroll
      for (int k = 0; k < 16; k++) { Bt = q[k].x * Bt + q[k].y; At *= q[k].x; }
      parts[((part * 2 + d) * 64 + cc) * 2] = At; parts[((part * 2 + d) * 64 + cc) * 2 + 1] = Bt;
    }
    __syncthreads();
    for (int e = tid; e < 64 * 64; e += NT) {
      int t = e >> 6;
      float v = cbv;
#pragma unroll
      for (int j = 0; j < 4; j++) v += xin[(t + j) * 64 + cc] * cw[j];
      xb[e] = v;
      xbh[t * LROW + cc] = f2bf(v);
    }
    if (pass2 && tid < 128) {
      const int d = tid >> 6;
      float hcar = isctx ? 0.f : p.state_lru[((size_t)(bidx * 2 + l) * 2 + d) * 512 + n * 64 + cc];
#pragma unroll
      for (int part = 0; part < 4; part++) hcar = parts[((part * 2 + d) * 64 + cc) * 2] * hcar + parts[((part * 2 + d) * 64 + cc) * 2 + 1];
      carry[d * 64 + cc] = hcar;
    }
    __syncthreads();
    {
      bf16x8 af[4];
#pragma unroll
      for (int ks = 0; ks < 4; ks++) af[ks] = *(const bf16x8*)(xbh + (gth * 32 + r) * LROW + ks * 16 + h * 8);
      f32x16 ga, gi;
#pragma unroll
      for (int e = 0; e < 16; e++) { ga[e] = 0.f; gi[e] = 0.f; }
#pragma unroll
      for (int ks = 0; ks < 4; ks++) { ga = mfma32(af[ks], wfa[ks], ga); gi = mfma32(af[ks], wfx[ks], gi); }
      const int dch = gdh * 32 + r;
#pragma unroll
      for (int e = 0; e < 16; e++) {
        const int tok = gth * 32 + (e & 3) + 8 * (e >> 2) + 4 * h;
        float rg = sigmoidf_(ga[e] + g_ba), ig = sigmoidf_(gi[e] + g_bx);
        float log_a = -8.f * rg * g_sp;
        float a = __expf(log_a);
        const float x2 = 2.f * log_a;
        const float om = -x2 * (1.f + x2 * (0.5f + x2 * (0.16666667f + x2 * (0.041666668f + x2 * (0.0083333338f + x2 * (0.0013888889f + x2 * 0.0001984127f))))));
        float bb = __builtin_amdgcn_sqrtf(om) * ig * xb[tok * 64 + dch];
        ab[((gd * 2 + 0) * 64 + tok) * 64 + dch] = a;
        ab[((gd * 2 + 1) * 64 + tok) * 64 + dch] = bb;
      }
    }
    __syncthreads();
    float av[2][8], bv[2][8];
#pragma unroll
    for (int d = 0; d < 2; d++)
#pragma unroll
      for (int tt = 0; tt < 8; tt++) {
        av[d][tt] = ab[((d * 2 + 0) * 64 + tg * 8 + tt) * 64 + dout];
        bv[d][tt] = ab[((d * 2 + 1) * 64 + tg * 8 + tt) * 64 + dout];
      }
    float sA0 = 1.f, sB0 = 0.f, sA1 = 1.f, sB1 = 0.f;
#pragma unroll
    for (int tt = 0; tt < 8; tt++) { sB0 = av[0][tt] * sB0 + bv[0][tt]; sA0 *= av[0][tt]; }
#pragma unroll
    for (int tt = 7; tt >= 0; tt--) { sB1 = av[1][tt] * sB1 + bv[1][tt]; sA1 *= av[1][tt]; }
    comb[((tg * 2 + 0) * 64 + dout) * 2 + 0] = sA0; comb[((tg * 2 + 0) * 64 + dout) * 2 + 1] = sB0;
    comb[((tg * 2 + 1) * 64 + dout) * 2 + 0] = sA1; comb[((tg * 2 + 1) * 64 + dout) * 2 + 1] = sB1;
    __syncthreads();
    if (!pass2) {
      if (tid < 128) {
        int d = tid >> 6, c = tid & 63;
        float At = 1.f, Bt = 0.f;
#pragma unroll
        for (int s = 0; s < 8; s++) {
          int g = (d == 0) ? s : 7 - s;
          float a = comb[((g * 2 + d) * 64 + c) * 2], bq = comb[((g * 2 + d) * 64 + c) * 2 + 1];
          Bt = a * Bt + bq; At *= a;
        }
        float* o = p.lruTot + ((size_t)(ci * 2 + d) * 512 + n * 64 + c) * 2;
        o[0] = At; o[1] = Bt;
      }
      continue;
    }
    float h0 = carry[dout], h1 = carry[64 + dout];
    for (int g = 0; g < tg; g++) { h0 = comb[((g * 2 + 0) * 64 + dout) * 2] * h0 + comb[((g * 2 + 0) * 64 + dout) * 2 + 1]; }
    for (int g = 7; g > tg; g--) { h1 = comb[((g * 2 + 1) * 64 + dout) * 2] * h1 + comb[((g * 2 + 1) * 64 + dout) * 2 + 1]; }
    float y[8];
#pragma unroll
    for (int tt = 0; tt < 8; tt++) { h0 = av[0][tt] * h0 + bv[0][tt]; y[tt] = h0; }
    const float hf_last = h0;
#pragma unroll
    for (int tt = 7; tt >= 0; tt--) { h1 = av[1][tt] * h1 + bv[1][tt]; y[tt] += h1; }
    const float hb_first = h1;
    if (isctx) {
      if (t0 + 64 == T && tg == 7) p.out[O_ST + ((size_t)(bidx * 2 + l) * 2 + 0) * 512 + ch] = hf_last;
      if (t0 == 0 && tg == 0) p.out[O_ST + ((size_t)(bidx * 2 + l) * 2 + 1) * 512 + ch] = hb_first;
    }
#pragma unroll
    for (int tt = 0; tt < 8; tt++) {
      const int rw = row0 + tg * 8 + tt;
      p.GB[(size_t)NTOK * 512 + tm_off(rw, ch, 8)] = f2bf(y[tt] * bf2f(sgr[tt]));
    }
  }
}

__device__ __forceinline__ float compute_lam(const Params& p, int l, float lam_init) {
  float s1 = 0.f, s2 = 0.f;
  for (int i = 0; i < 64; i++) {
    s1 += p.lam_q1[l * 64 + i] * p.lam_k1[l * 64 + i];
    s2 += p.lam_q2[l * 64 + i] * p.lam_k2[l * 64 + i];
  }
  return expf(s1) - expf(s2) + lam_init;
}

__device__ __forceinline__ float mix_phase(const Params& p, int l, u16* smem, int vid) {
  unsigned long long tm0 = 0; float tres = 0.f; if (PROBE >= 30) tm0 = __builtin_amdgcn_s_memrealtime();
  const float lam_init = (l == 0) ? 0.2f : (0.8f - 0.6f * 0.74081822068f);
  const float lam = compute_lam(p, l, lam_init);
  constexpr int N_CL = 256, N_A = 384, N_CC = 128, N_L = 1536;
  const int G = gridDim.x;
  int start = vid;
  for (int it = start; it < N_CL; it += G) attnC_item(p, l, 128 + it, smem, lam, lam_init);
  if (PROBE == 35) tres = (float)(__builtin_amdgcn_s_memrealtime() - tm0) / 40000.f;
  start = (int)((vid + G - (N_CL % G)) % G);
  for (int it = start; it < N_A; it += G) attnA_item(p, l, it, smem);
  start = (int)((vid + G - ((N_CL + N_A) % G)) % G);
  for (int it = start; it < N_CC; it += G) attnC_item(p, l, it, smem, lam, lam_init);
  if (PROBE == 36) tres = (float)(__builtin_amdgcn_s_memrealtime() - tm0) / 40000.f;
  start = (int)((vid + G - ((N_CL + N_A + N_CC) % G)) % G);
  if (PROBE == 6) lru_run(p, l, false, start, G, (float*)smem);
  lru_run(p, l, false, start, G, (float*)smem);
  return tres;
}

__device__ __forceinline__ void lru2_phase(const Params& p, int l, u16* smem) {
  lru_run(p, l, true, blockIdx.x, gridDim.x, (float*)smem);
}

#define XB_TMO      128
#define XB_XCNT(j)  (256  + 64 * (j))
#define XB_XSUB(j)  (1280 + 64 * (j))
#define XB_XGEN(j)  (2304 + 64 * (j))
#define XB_TOP      3328
#define XB_TOPGEN   3392
#define XCD_BAR_WORDS 3456
#define XB_SPIN_CAP (1u << 18)
__device__ __forceinline__ unsigned xb_ld(unsigned* p)              { return __hip_atomic_load(p, __ATOMIC_RELAXED, __HIP_MEMORY_SCOPE_AGENT); }
__device__ __forceinline__ unsigned xb_add(unsigned* p, unsigned v) { return __hip_atomic_fetch_add(p, v, __ATOMIC_RELAXED, __HIP_MEMORY_SCOPE_AGENT); }
__device__ __forceinline__ unsigned xb_xcc_id() { return (unsigned)__builtin_amdgcn_s_getreg((3 << 11) | 20) & 0xFu; }
#define XB_SPIN(cond, bar) do { unsigned _sp = 0; while (cond) { __builtin_amdgcn_s_sleep(1); \
    if ((++_sp & 255u) == 0u) { if (xb_ld(&(bar)[XB_TMO])) break; if (_sp > XB_SPIN_CAP) { atomicAdd(&(bar)[XB_TMO], 1u); break; } } } } while (0)
struct XcdBarrier { unsigned* bar; unsigned x; volatile LAS unsigned* st; };
__device__ __forceinline__ XcdBarrier xcd_barrier_post(unsigned* bar, volatile LAS unsigned* st) {
  XcdBarrier b; b.bar = bar; b.x = xb_xcc_id(); b.st = st;
  if (threadIdx.x == 0) st[2] = xb_add(&bar[XB_XCNT(b.x)], 1u);
  return b;
}
__device__ __forceinline__ int xcd_virtual_id(const XcdBarrier& b) {
  if (threadIdx.x == 0) {
    unsigned pre = 0;
#pragma unroll
    for (unsigned j = 0; j < 16; ++j) { const unsigned c = xb_ld(&b.bar[XB_XCNT(j)]); pre += (j < b.x) ? c : 0u; }
    b.st[3] = pre + b.st[2];
  }
  __syncthreads();
  const int v = (int)b.st[3];
  __syncthreads();
  return __builtin_amdgcn_readfirstlane(v);
}
__device__ __forceinline__ void xcd_barrier_complete(unsigned* bar, unsigned x, unsigned& nloc, unsigned& nx) {
  const unsigned G = gridDim.x * gridDim.y * gridDim.z;
  unsigned sum, cnt, mine, sp = 0u;
  for (;;) {
    sum = 0u; cnt = 0u; mine = 0u;
#pragma unroll
    for (unsigned j = 0; j < 16; ++j) { const unsigned c = xb_ld(&bar[XB_XCNT(j)]); sum += c; cnt += (c > 0u) ? 1u : 0u; mine = (j == x) ? c : mine; }
    if (sum == G) break;
    __builtin_amdgcn_s_sleep(1);
    if ((++sp & 255u) == 0u) { if (xb_ld(&bar[XB_TMO])) break; if (sp > XB_SPIN_CAP) { atomicAdd(&bar[XB_TMO], 1u); break; } }
  }
  nloc = mine > 0u ? mine : 1u; nx = cnt > 0u ? cnt : 1u;
}
__device__ __forceinline__ void xcd_barrier(const XcdBarrier& b) {
  asm volatile("s_waitcnt vmcnt(0)" ::: "memory");
  __syncthreads();
  if (threadIdx.x == 0) {
    unsigned* bar = b.bar;
    __builtin_amdgcn_s_waitcnt(0);
    unsigned nloc = b.st[0], nx = b.st[1];
    if (nloc == 0u) { xcd_barrier_complete(bar, b.x, nloc, nx); b.st[0] = nloc; b.st[1] = nx; }
    const unsigned old = xb_add(&bar[XB_XSUB(b.x)], 1u);
    const unsigned gen = old / nloc;
    if (old + 1u == (gen + 1u) * nloc) {
      __builtin_amdgcn_fence(__ATOMIC_RELEASE, "agent");
      asm volatile("s_waitcnt vmcnt(0)" ::: "memory");
      const unsigned og = xb_add(&bar[XB_TOP], 1u);
      const unsigned tg = og / nx;
      if (og + 1u == (tg + 1u) * nx) xb_add(&bar[XB_TOPGEN], 1u);
      else XB_SPIN(xb_ld(&bar[XB_TOPGEN]) == tg, bar);
      __builtin_amdgcn_fence(__ATOMIC_ACQUIRE, "agent");
      xb_add(&bar[XB_XGEN(b.x)], 1u);
      asm volatile("s_waitcnt vmcnt(0)" ::: "memory");
    } else {
      XB_SPIN(xb_ld(&bar[XB_XGEN(b.x)]) == gen, bar);
      __builtin_amdgcn_fence(__ATOMIC_ACQUIRE, "agent");
      asm volatile("s_waitcnt vmcnt(0)" ::: "memory");
    }
  }
  __syncthreads();
}

typedef __attribute__((address_space(4))) const Params CParams;
__device__ __forceinline__ const Params& get_params() {
  CParams* kp = (CParams*)__builtin_amdgcn_kernarg_segment_ptr();
  asm volatile("" : "+s"(kp));
  return *(const Params*)kp;
}
__global__ void __launch_bounds__(NT, 2) fwd_kernel(Params p_unused) {
  extern __shared__ __attribute__((aligned(16))) unsigned char lds_raw[];
  u16* smem = (u16*)lds_raw;
  LAS unsigned char* lds = (LAS unsigned char*)lds_raw;
  cg::grid_group grid = cg::this_grid();
  volatile LAS unsigned* xst = (volatile LAS unsigned*)(lds + STAGE_BYTES + SPARE_BYTES);
  if (threadIdx.x == 0) { xst[0] = 0u; xst[1] = 0u; }
  __syncthreads();
  XcdBarrier xb = xcd_barrier_post(get_params().bar, xst);
  float tfrac = 0.f;
  unsigned long long tq0 = 0; if (PROBE >= 30) tq0 = __builtin_amdgcn_s_memrealtime();
  prologue_phase(get_params(), (float*)smem);
  if (PROBE == 30) tfrac = (float)(__builtin_amdgcn_s_memrealtime() - tq0) / 40000.f;
  if (get_params().bar == nullptr) grid.sync();
  xcd_barrier(xb);
  if (PROBE == 31) tfrac = (float)(__builtin_amdgcn_s_memrealtime() - tq0) / 40000.f;
  const int vid = xcd_virtual_id(xb);
  { LAS float* rl = (LAS float*)(lds + ROPE_OFF); const float* rg = get_params().rope;
    for (int i = threadIdx.x; i < 2048; i += NT) rl[i] = rg[i];
    __syncthreads(); }
  if (PROBE == 9) { for (int i = 0; i < 10; i++) xcd_barrier(xb); }
#pragma unroll 1
  for (int l = 0; l < 2; l++) {
    if (PROBE >= 30) tq0 = __builtin_amdgcn_s_memrealtime();
    norm_phase(get_params(), l);
    if (PROBE == 32 && l == 0) tfrac = (float)(__builtin_amdgcn_s_memrealtime() - tq0) / 40000.f;
    if (PROBE == 3) { norm_phase(get_params(), l); if (l == 0) { xcd_barrier(xb); prologue_phase(get_params(), (float*)smem); } }
    xcd_barrier(xb);
    {
      const Params& p = get_params();
      SchedStd S; S.nM = NTOK / 256; S.nN = INC / 256; S.nwg = S.nM * S.nN; S.G = gridDim.x; S.c = vid;
      S.A = (const char*)p.H; S.B = (const char*)(p.Wt_in + (size_t)l * INC * 1024); S.tA = (size_t)256 * 1024 * 2; S.tB = (size_t)256 * 1024 * 2;
      EpiInproj E; E.pp = &p; E.l = l; E.part = (LAS float*)(lds + STAGE_BYTES); E.ropeL = (const LAS float*)(lds + ROPE_OFF);
      { float tr = gemm_phase(lds, 1024, S, E, PROBE == 22); if (l == 0 && (PROBE == 21 || PROBE == 22)) tfrac = tr; }
      if (PROBE == 1) { __syncthreads(); gemm_phase(lds, 1024, S, E); }
    }
    xcd_barrier(xb);
    if (PROBE >= 30) tq0 = __builtin_amdgcn_s_memrealtime();
    { float tr = mix_phase(get_params(), l, smem, vid); if ((PROBE == 35 || PROBE == 36) && l == 0) tfrac = tr; }
    if (PROBE == 33 && l == 0) tfrac = (float)(__builtin_amdgcn_s_memrealtime() - tq0) / 40000.f;
    xcd_barrier(xb);
    if (PROBE >= 30) tq0 = __builtin_amdgcn_s_memrealtime();
    lru2_phase(get_params(), l, smem);
    if (PROBE == 34 && l == 0) tfrac = (float)(__builtin_amdgcn_s_memrealtime() - tq0) / 40000.f;
    xcd_barrier(xb);
    {
      const Params& p = get_params();
      SchedBranch S; S.G = gridDim.x; S.c = vid; S.P_ = (const char*)p.GB; S.W_ = (const char*)(p.Wt_br + (size_t)l * 3 * 1024 * 512);
      EpiBranch E; E.pp = &p;
      { float tr = gemm_phase(lds, 512, S, E, PROBE == 24); if (l == 0 && (PROBE == 23 || PROBE == 24)) tfrac = tr; }
      if (PROBE == 2) { __syncthreads(); gemm_phase(lds, 512, S, E); }
    }
    xcd_barrier(xb);
    {
      const Params& p = get_params();
      SchedStd S; S.nM = NTOK / 256; S.nN = 4; S.nwg = S.nM * S.nN; S.G = gridDim.x; S.c = vid;
      S.A = (const char*)p.Y; S.B = (const char*)(p.Wt_out + (size_t)l * 1024 * 1024); S.tA = (size_t)256 * 1024 * 2; S.tB = (size_t)256 * 1024 * 2;
      EpiOut E; E.pp = &p; E.l = l;
      { float tr = gemm_phase(lds, 1024, S, E, PROBE == 26); if (l == 0 && (PROBE == 25 || PROBE == 26)) tfrac = tr; }
      if (PROBE == 8 && l == 0) { __syncthreads(); gemm_phase(lds, 1024, S, E); }
    }
    if (l == 0) xcd_barrier(xb);
  }
  if (PROBE >= 20) {
    xcd_barrier(xb);
    if (blockIdx.x == 0 && threadIdx.x == 0) { float* o = get_params().out + O_X + 4194304; *o += 0.42f + 0.45f * fminf(fmaxf(tfrac, 0.f), 1.f); }
  }
}

extern "C" void kernel_launch(void* const* d_in, const int* in_sizes, int n_in, void* d_out, int out_size, void* d_ws,
                              size_t ws_size, hipStream_t stream) {
  Params p{};
  const float** ip = (const float**)&p;
  for (int i = 0; i < 34; i++) ip[i] = (const float*)d_in[i];
  p.out = (float*)d_out;
  char* w = (char*)d_ws; size_t off = 0;
  auto take = [&](size_t bytes) { char* q = w + off; off += (bytes + 255) & ~(size_t)255; return q; };
  p.Wt_in = (u16*)take((size_t)2 * INC * 1024 * 2);
  p.Wt_br = (u16*)take((size_t)6 * 1024 * 512 * 2);
  p.Wt_out = (u16*)take((size_t)2 * 1024 * 1024 * 2);
  p.Y = (u16*)take((size_t)NTOK * 1024 * 2);
  p.P = (u16*)take((size_t)NTOK * PP * 2);
  p.VtA_ctx = p.Y;
  p.VtA_lat = p.VtA_ctx + (size_t)16 * 2 * 64 * 256;
  p.VtC_ctx = p.VtA_lat + (size_t)2 * 2 * 64 * 4096;
  p.VtC_lat = p.VtC_ctx + (size_t)16 * 4 * 128 * 256;
  p.cKa = (u16*)take((size_t)2 * 2 * 512 * 128 * 2);
  p.cVtA = (u16*)take((size_t)2 * 2 * 512 * 128 * 2);
  p.cKc = (u16*)take((size_t)2 * 2 * 512 * 512 * 2);
  p.cVtC = (u16*)take((size_t)2 * 2 * 512 * 512 * 2);
  p.mod = (float*)take((size_t)2 * 3 * 3072 * 4);
  p.rope = (float*)take((size_t)2048 * 4);
  p.lruTot = (float*)take((size_t)192 * 2 * 512 * 2 * 4);
  p.Wt_lru = (u16*)take((size_t)2 * 2 * 8 * 2 * 64 * 64 * 2);
  p.bar = (unsigned*)take((size_t)XCD_BAR_WORDS * 4);
  p.GB = (u16*)take((size_t)3 * NTOK * 512 * 2);
  p.H = p.GB;
  p.MG = (unsigned*)take((size_t)(48 * 4 * 3 + 1) * 16384 * 4);
  static int grid_blocks = 0;
  if (!grid_blocks) {
    int dev = 0, cus = 0;
    hipGetDevice(&dev);
    hipDeviceGetAttribute(&cus, hipDeviceAttributeMultiprocessorCount, dev);
    hipFuncSetAttribute((const void*)fwd_kernel, hipFuncAttributeMaxDynamicSharedMemorySize, LDS_BYTES);
    int per_cu = 0;
    hipOccupancyMaxActiveBlocksPerMultiprocessor(&per_cu, (const void*)fwd_kernel, NT, LDS_BYTES);
    (void)hipGetLastError();
    grid_blocks = cus;
  }
  hipMemsetAsync(p.bar, 0, (size_t)XCD_BAR_WORDS * 4, stream);
  void* args[] = {&p};
  hipLaunchCooperativeKernel((void*)fwd_kernel, dim3(grid_blocks), dim3(NT), args, LDS_BYTES, stream);
}
```

```cpp
#include <hip/hip_runtime.h>
#include <hip/hip_cooperative_groups.h>
#include <stdint.h>
#include <math.h>
namespace cg = cooperative_groups;

typedef unsigned short u16;
typedef __attribute__((ext_vector_type(8))) short bf16x8;
typedef __attribute__((ext_vector_type(4))) short bf16x4;
typedef __attribute__((ext_vector_type(16))) float f32x16;
typedef __attribute__((ext_vector_type(4))) float f32x4;
#define LAS __attribute__((address_space(3)))

#ifndef PROBE
#define PROBE 0
#endif
#define NT 512
constexpr int NTOK = 12288, NCTX = 4096;
constexpr int INC = 7424;
constexpr int PP = 3712;
constexpr int C_QA = 0, C_KA = 512, C_GA = 640, C_XB = 1152, C_GB = 1664, C_QC = 2176, C_KC = 2688, C_GC = 3200;
constexpr int LROW = 72;
constexpr int VROW = 68;
constexpr float EPS = 1e-6f;
constexpr int STAGE_BYTES = 131072;
constexpr int SPARE_BYTES = 8192;
constexpr int ROPE_OFF = STAGE_BYTES + SPARE_BYTES + 16;
constexpr int LDS_BYTES = ROPE_OFF + 8192;

constexpr size_t O_X = 0, O_KA = 12582912, O_VA = 13631488, O_KC = 14680064, O_VC = 18874368, O_ST = 23068672;

struct Params {
  const float *x_prompt, *x_sample, *cache_a_k, *cache_a_v, *cache_c_k, *cache_c_v, *state_lru, *c, *c_ctx,
      *norm_g, *mod_w, *mod_b, *w_in, *qn_a, *kn_a, *sink_a, *conv_w, *conv_b, *lru_wa, *lru_ba, *lru_wx, *lru_bx,
      *lru_lam, *qn_c, *kn_c, *lam_q1, *lam_k1, *lam_q2, *lam_k2, *subln_c, *w_br_a, *w_br_b, *w_br_c, *w_out;
  float* out;
  u16 *Wt_in, *Wt_br, *Wt_out, *H, *P, *VtA_ctx, *VtA_lat, *VtC_ctx, *VtC_lat, *cKa, *cVtA, *cKc, *cVtC;
  float *mod, *rope, *lruTot;
  u16 *Wt_lru;
  unsigned* bar;
  u16* Y;
  u16* GB;
  unsigned* MG;
};

__device__ __forceinline__ int tid_opaque() { int t = (int)threadIdx.x; asm volatile("" : "+v"(t)); return t; }
#define TIDX tid_opaque()
__device__ __forceinline__ u16 f2bf(float f) {
  uint32_t r; asm("v_cvt_pk_bf16_f32 %0, %1, %1" : "=v"(r) : "v"(f)); return (u16)(r & 0xffffu);
}
__device__ __forceinline__ float bf2f(u16 h) { return __uint_as_float(((uint32_t)h) << 16); }
__device__ __forceinline__ uint32_t pack2(float a, float b) { uint32_t r; asm("v_cvt_pk_bf16_f32 %0, %1, %2" : "=v"(r) : "v"(a), "v"(b)); return r; }
__device__ __forceinline__ float sigmoidf_(float x) { return __builtin_amdgcn_rcpf(1.f + __expf(-x)); }
__device__ __forceinline__ float siluf_(float x) { return x * __builtin_amdgcn_rcpf(1.f + __expf(-x)); }
__device__ __forceinline__ f32x16 mfma32(bf16x8 a, bf16x8 b, f32x16 c) {
  return __builtin_amdgcn_mfma_f32_32x32x16_bf16(a, b, c, 0, 0, 0);
}
__device__ __forceinline__ float shflx(float v, int mask, int lane) {
  return __builtin_bit_cast(float, __builtin_amdgcn_ds_bpermute((lane ^ mask) << 2, __builtin_bit_cast(int, v)));
}
__device__ __forceinline__ float half_max(float v) {
  const unsigned u = __builtin_bit_cast(unsigned, v);
  auto r = __builtin_amdgcn_permlane32_swap(u, u, false, false);
  return fmaxf(__builtin_bit_cast(float, (unsigned)r[0]), __builtin_bit_cast(float, (unsigned)r[1]));
}
__device__ __forceinline__ float half_sum(float v) {
  const unsigned u = __builtin_bit_cast(unsigned, v);
  auto r = __builtin_amdgcn_permlane32_swap(u, u, false, false);
  return __builtin_bit_cast(float, (unsigned)r[0]) + __builtin_bit_cast(float, (unsigned)r[1]);
}
__device__ __forceinline__ float lo_bf(uint32_t w) { return __uint_as_float(w << 16); }
__device__ __forceinline__ float hi_bf(uint32_t w) { return __uint_as_float(w & 0xffff0000u); }

__device__ __forceinline__ size_t tm_off(int r, int k, int KT) {
  return ((size_t)((r >> 8) * KT + (k >> 6)) * 256 + (r & 255)) * 64 + (k & 63);
}
__device__ __forceinline__ void transpose_tile(const float* __restrict__ src, int spitch, u16* __restrict__ dst, int dpitch,
                               int r0, int c0, float* sm, int KT = 0) {
  const int tid = TIDX;
#pragma unroll
  for (int i = 0; i < 2; i++) {
    int c = tid + i * NT; int r = c >> 4, q = c & 15;
    float4 v = *(const float4*)(src + (size_t)(r0 + r) * spitch + c0 + q * 4);
    float* d = sm + r * 65 + q * 4;
    d[0] = v.x; d[1] = v.y; d[2] = v.z; d[3] = v.w;
  }
  __syncthreads();
  {
    int c = tid; int cc = c >> 3, q = c & 7;
    uint32_t w[4];
#pragma unroll
    for (int j = 0; j < 4; j++) w[j] = pack2(sm[(q * 8 + 2 * j) * 65 + cc], sm[(q * 8 + 2 * j + 1) * 65 + cc]);
    uint4 v; v.x = w[0]; v.y = w[1]; v.z = w[2]; v.w = w[3];
    if (KT) *(uint4*)(dst + tm_off(c0 + cc, r0 + q * 8, KT)) = v;
    else *(uint4*)(dst + (size_t)(c0 + cc) * dpitch + r0 + q * 8) = v;
  }
  __syncthreads();
}

__device__ __forceinline__ void transpose_wide(const float* __restrict__ src, int spitch, u16* __restrict__ dst,
                                               int k0, int n0, float* sm, int KT) {
  const int tid = TIDX;
  float4 v[8];
#pragma unroll
  for (int i = 0; i < 8; i++) { int c = tid + i * NT; int r = c >> 6, q = c & 63; v[i] = *(const float4*)(src + (size_t)(k0 + r) * spitch + n0 + q * 4); }
#pragma unroll
  for (int i = 0; i < 8; i++) { int c = tid + i * NT; int r = c >> 6, q = c & 63; float* d = sm + r * 257 + q * 4; d[0] = v[i].x; d[1] = v[i].y; d[2] = v[i].z; d[3] = v[i].w; }
  __syncthreads();
#pragma unroll
  for (int i = 0; i < 4; i++) {
    int c = tid + i * NT; int nn = c >> 3, q = c & 7;
    uint4 o;
    o.x = pack2(sm[(q * 8 + 0) * 257 + nn], sm[(q * 8 + 1) * 257 + nn]);
    o.y = pack2(sm[(q * 8 + 2) * 257 + nn], sm[(q * 8 + 3) * 257 + nn]);
    o.z = pack2(sm[(q * 8 + 4) * 257 + nn], sm[(q * 8 + 5) * 257 + nn]);
    o.w = pack2(sm[(q * 8 + 6) * 257 + nn], sm[(q * 8 + 7) * 257 + nn]);
    *(uint4*)(dst + tm_off(n0 + nn, k0 + q * 8, KT)) = o;
  }
  __syncthreads();
}

__device__ __forceinline__ void mod_item(const Params& p, int it, float* sm) {
  const int tid = TIDX;
  const int l = it / 48, n0 = (it % 48) * 64;
  float* sv = sm;
  float* red = sm + 3072;
  for (int e = tid; e < 3072; e += NT) {
    int v = e >> 10, k = e & 1023;
    float x = (v == 0) ? p.c_ctx[k] : p.c[(v - 1) * 1024 + k];
    sv[e] = siluf_(x);
  }
  __syncthreads();
  const int col = tid & 63, kg = tid >> 6;
  const float* w = p.mod_w + (size_t)l * 1024 * 3072 + n0 + col;
  float a0 = 0, a1 = 0, a2 = 0;
#pragma unroll 1
  for (int kb = kg * 128; kb < kg * 128 + 128; kb += 32) {
    float wv[32];
#pragma unroll
    for (int j = 0; j < 32; j++) wv[j] = w[(size_t)(kb + j) * 3072];
#pragma unroll
    for (int j = 0; j < 32; j++) { a0 += sv[kb + j] * wv[j]; a1 += sv[1024 + kb + j] * wv[j]; a2 += sv[2048 + kb + j] * wv[j]; }
  }
  red[(kg * 3 + 0) * 64 + col] = a0; red[(kg * 3 + 1) * 64 + col] = a1; red[(kg * 3 + 2) * 64 + col] = a2;
  __syncthreads();
  if (tid < 192) {
    int v = tid >> 6, c = tid & 63;
    float s = p.mod_b[l * 3072 + n0 + c];
#pragma unroll
    for (int g = 0; g < 8; g++) s += red[(g * 3 + v) * 64 + c];
    p.mod[(l * 3 + v) * 3072 + n0 + c] = s;
  }
  __syncthreads();
}

__device__ __forceinline__ void prologue_phase(const Params& p, float* sm) {
  constexpr int N_MOD = 96, N_ROPE = 1, N_WIN = 2 * 16 * 29, N_WBR = 6 * 8 * 4, N_WOUT = 2 * 16 * 4;
  constexpr int N_CK = 64 + 256, N_CVA = 4 * 16, N_CVC = 4 * 64, N_LW = 64;
  constexpr int E0 = N_MOD, E1 = E0 + N_ROPE, E2 = E1 + N_WIN, E3 = E2 + N_WBR, E4 = E3 + N_WOUT, E5 = E4 + N_CK,
                E6 = E5 + N_CVA, E7 = E6 + N_CVC, E8 = E7 + N_LW;
  const int tid = TIDX;
  for (int it = blockIdx.x; it < E8; it += gridDim.x) {
    if (it < E0) {
      mod_item(p, it, sm);
    } else if (it < E1) {
      for (int e = tid; e < 1024; e += NT) {
        int pos = e >> 4, f = e & 15;
        float inv = powf(10000.f, -(float)f / 16.f);
        float ang = (float)pos * inv;
        p.rope[e] = cosf(ang); p.rope[1024 + e] = sinf(ang);
      }
    } else if (it < E2) {
      int j = it - E1; int l = j / (16 * 29); int r = j % (16 * 29);
      int kt = r / 29, pn = r % 29;
      transpose_wide(p.w_in + (size_t)l * 1024 * INC, INC, p.Wt_in + (size_t)l * INC * 1024, kt * 64, pn * 256, sm, 16);
    } else if (it < E3) {
      int j = it - E2; int m = j / 32; int r = j % 32;
      int l = m / 3, i = m % 3;
      const float* src = (i == 0 ? p.w_br_a : (i == 1 ? p.w_br_b : p.w_br_c)) + (size_t)l * 512 * 1024;
      int kt = r / 4, pn = r % 4;
      transpose_wide(src, 1024, p.Wt_br + (size_t)m * 1024 * 512, kt * 64, pn * 256, sm, 8);
    } else if (it < E4) {
      int j = it - E3; int l = j / 64; int r = j % 64;
      int kt = r / 4, pn = r % 4;
      transpose_wide(p.w_out + (size_t)l * 1024 * 1024, 1024, p.Wt_out + (size_t)l * 1024 * 1024, kt * 64, pn * 256, sm, 16);
    } else if (it < E5) {
      int j = it - E4;
      const float* src; u16* dst; size_t off;
      if (j < 64) { src = p.cache_a_k; dst = p.cKa; off = (size_t)j * 4096; }
      else { src = p.cache_c_k; dst = p.cKc; off = (size_t)(j - 64) * 4096; }
      size_t e = off + (size_t)tid * 8;
      float4 a = *(const float4*)(src + e), b = *(const float4*)(src + e + 4);
      uint4 v; v.x = pack2(a.x, a.y); v.y = pack2(a.z, a.w); v.z = pack2(b.x, b.y); v.w = pack2(b.z, b.w);
      *(uint4*)(dst + e) = v;
    } else if (it < E6) {
      int j = it - E5; int bl = j / 16; int r = j % 16;
      int rt = r / 2, ct = r % 2;
      transpose_tile(p.cache_a_v + (size_t)bl * 512 * 128, 128, p.cVtA + (size_t)bl * 128 * 512, 512, rt * 64, ct * 64, sm);
    } else if (it < E7) {
      int j = it - E6; int bl = j / 64; int r = j % 64;
      int rt = r / 8, ct = r % 8;
      transpose_tile(p.cache_c_v + (size_t)bl * 512 * 512, 512, p.cVtC + (size_t)bl * 512 * 512, 512, rt * 64, ct * 64, sm);
    } else {
      int j = it - E7; int ldn = j >> 1, g = j & 1;
      transpose_tile((g ? p.lru_wx : p.lru_wa) + (size_t)ldn * 4096, 64, p.Wt_lru + (size_t)(ldn * 2 + g) * 4096, 64, 0, 0, sm);
    }
  }
}

__device__ __forceinline__ void norm_phase(const Params& p, int l) {
  const int tid = TIDX, lane = tid & 63, wid = tid >> 6;
  const float* g = p.norm_g + l * 1024;
  for (int it = blockIdx.x; it < NTOK / 8; it += gridDim.x) {
    int row = it * 8 + wid;
    const float* x;
    if (l == 0) x = (row < NCTX) ? p.x_prompt + (size_t)row * 1024 : p.x_sample + (size_t)(row - NCTX) * 1024;
    else x = p.out + O_X + (size_t)row * 1024;
    int v = (row < NCTX) ? 0 : 1 + (row - NCTX) / 4096;
    const float* md = p.mod + (l * 3 + v) * 3072;
    float4 xv[4], gv[4], sh[4], sc[4]; float ss = 0;
#pragma unroll
    for (int i = 0; i < 4; i++) {
      const int c = i * 256 + lane * 4;
      xv[i] = *(const float4*)(x + c);
      gv[i] = *(const float4*)(g + c); sh[i] = *(const float4*)(md + c); sc[i] = *(const float4*)(md + 1024 + c);
    }
    __builtin_amdgcn_sched_barrier(0);
#pragma unroll
    for (int i = 0; i < 4; i++) ss += xv[i].x * xv[i].x + xv[i].y * xv[i].y + xv[i].z * xv[i].z + xv[i].w * xv[i].w;
#pragma unroll
    for (int o = 32; o > 0; o >>= 1) ss += shflx(ss, o, lane);
    float rinv = rsqrtf(ss * (1.f / 1024.f) + EPS);
#pragma unroll
    for (int i = 0; i < 4; i++) {
      int c = i * 256 + lane * 4;
      float h0 = xv[i].x * rinv * gv[i].x * (1.f + sc[i].x) + sh[i].x;
      float h1 = xv[i].y * rinv * gv[i].y * (1.f + sc[i].y) + sh[i].y;
      float h2 = xv[i].z * rinv * gv[i].z * (1.f + sc[i].z) + sh[i].z;
      float h3 = xv[i].w * rinv * gv[i].w * (1.f + sc[i].w) + sh[i].w;
      uint2 o2; o2.x = pack2(h0, h1); o2.y = pack2(h2, h3);
      *(uint2*)(p.H + tm_off(row, c, 16)) = o2;
    }
  }
}

constexpr int G_BK = 64, G_HALF = 128, G_HTB = G_HALF * G_BK * 2;
__device__ __forceinline__ int lds_byte(int r, int c) {
  const int st = (r >> 4) * 2 + (c >> 5), rr = r & 15, cc = c & 31, ob = rr * 64 + cc * 2;
  return st * 1024 + (ob ^ (((ob >> 9) & 1) << 5));
}
__device__ __forceinline__ void stage_rc(int b, int& R, int& C) {
  const int st = b / 1024, sb = b % 1024, swz = sb ^ (((sb >> 9) & 1) << 5);
  R = (st >> 1) * 16 + swz / 64; C = (st & 1) * 32 + (swz % 64) / 2;
}
struct Unit { int pm, pn, seg; };

struct SchedStd {
  int nM, nN, nwg, G, c; const char* A; const char* B; size_t tA, tB;
  __device__ __forceinline__ bool next(int i, Unit& u) const {
    long L = (long)i * G + c;
    if (G == 256 && nwg == 1392 && i == 5) {
      const int cp = (c & 31) * 8 + (c >> 5);
      if (cp >= 112) return false;
      L = 1280 + cp;
    }
    if (L >= nwg) return false;
    const int wgid = (int)L;
    const int nig = 8 * nN, gid = wgid / nig, fm = gid * 8, gsz = (nM - fm) < 8 ? (nM - fm) : 8;
    u.pm = fm + ((wgid % nig) % gsz); u.pn = (wgid % nig) / gsz; u.seg = 0; return true;
  }
  __device__ __forceinline__ const char* aptr(const Unit& u) const { return A + (size_t)u.pm * tA; }
  __device__ __forceinline__ const char* bptr(const Unit& u) const { return B + (size_t)u.pn * tB; }
};
struct SchedBranch {
  int G, c; const char* P_; const char* W_;
  __device__ __forceinline__ bool next(int i, Unit& u) const {
    if (G == 256) {
      if (i >= 3) return false;
      const int xcd = c >> 5, j = c & 31;
      if (j >= 24) return false;
      u.seg = i; u.pm = xcd * 6 + (j >> 2); u.pn = j & 3; return true;
    }
    const int tile = (i / 3) * G + c; if (tile >= 192) return false;
    u.seg = i % 3; u.pm = tile >> 2; u.pn = tile & 3; return true;
  }
  __device__ __forceinline__ const char* aptr(const Unit& u) const { return P_ + (size_t)((u.seg * 48 + u.pm) * 8) * 32768; }
  __device__ __forceinline__ const char* bptr(const Unit& u) const { return W_ + (size_t)((u.seg * 4 + u.pn) * 8) * 32768; }
};

template <class Epi, class Sched>
__device__ __forceinline__ float gemm_phase(LAS unsigned char* lds, const int K, const Sched& S, const Epi& E, int tmode = 0) {
  unsigned long long t_ph0 = 0, t_epi = 0; if (PROBE >= 20) t_ph0 = __builtin_amdgcn_s_memrealtime();
  const int tid = TIDX, wid = __builtin_amdgcn_readfirstlane(tid >> 6), lane = tid & 63, wr = wid >> 2, wc = wid & 3, fr = lane & 15, fq = lane >> 4;
  const int nt = K / G_BK;
  unsigned voffA[2], voffB[2];
#pragma unroll
  for (int i = 0; i < 2; ++i) { int R, C; stage_rc(tid * 16 + i * 8192, R, C);
    voffA[i] = (unsigned)(R * 64 + C) * 2u; voffB[i] = voffA[i]; }
  const size_t kstep = (size_t)32768;
  const size_t hA = (size_t)16384, hB = (size_t)16384;
  const unsigned ldsw = (unsigned)wid * 1024u;
  const int aoff = lds_byte(wr * 64 + fr, fq * 8), boff = lds_byte(wc * 32 + fr, fq * 8);
#define G_SA(b, h) (((b) * 2 + (h)) * G_HTB)
#define G_SB(b, h) ((4 + (b) * 2 + (h)) * G_HTB)
#define G_STAGE(bufoff, gbase, voff) do { _Pragma("unroll") for (int _i = 0; _i < 2; ++_i) \
    __builtin_amdgcn_global_load_lds((const unsigned*)((const char*)(gbase) + (voff)[_i]), (LAS unsigned*)(lds + (bufoff) + ldsw + _i * 8192), 16, 0, 0); } while (0)
#define G_LDA(dst, b, h) do { _Pragma("unroll") for (int m = 0; m < 4; ++m) _Pragma("unroll") for (int k = 0; k < 2; ++k) dst[m][k] = *(const LAS bf16x8*)(lds + G_SA(b, h) + aoff + m * 2048 + k * 1024); } while (0)
#define G_LDB(dst, b, h) do { _Pragma("unroll") for (int n = 0; n < 2; ++n) _Pragma("unroll") for (int k = 0; k < 2; ++k) dst[n][k] = *(const LAS bf16x8*)(lds + G_SB(b, h) + boff + n * 2048 + k * 1024); } while (0)
#define G_MMA(ai, bj, At, Bt) do { __builtin_amdgcn_s_setprio(1); _Pragma("unroll") for (int m = 0; m < 4; ++m) _Pragma("unroll") for (int n = 0; n < 2; ++n) _Pragma("unroll") for (int k = 0; k < 2; ++k) \
    acc[ai][bj][m][n] = __builtin_amdgcn_mfma_f32_16x16x32_bf16(Bt[n][k], At[m][k], acc[ai][bj][m][n], 0, 0, 0); __builtin_amdgcn_s_setprio(0); } while (0)
#define G_WAIT_V(n) asm volatile("s_waitcnt vmcnt(" #n ")" ::: "memory")
#define G_WAIT_L(n) asm volatile("s_waitcnt lgkmcnt(" #n ")" ::: "memory")
#define G_BAR __builtin_amdgcn_s_barrier()
#define G_SCHED __builtin_amdgcn_sched_barrier(0)
  Unit cur, nxt; int ui = 0;
  if (!S.next(0, cur)) return 0.f;
  f32x4 acc[2][2][4][2];
#pragma unroll
  for (int a = 0; a < 2; ++a)
#pragma unroll
    for (int b = 0; b < 2; ++b)
#pragma unroll
      for (int m = 0; m < 4; ++m)
#pragma unroll
        for (int n = 0; n < 2; ++n) acc[a][b][m][n] = (f32x4){0.f, 0.f, 0.f, 0.f};
  bf16x8 At[4][2], B0[2][2], B1[2][2];
  const char* cA = S.aptr(cur); const char* cB = S.bptr(cur);
  G_STAGE(G_SB(0, 0), cB, voffB); G_STAGE(G_SA(0, 0), cA, voffA); G_STAGE(G_SB(0, 1), cB + hB, voffB); G_STAGE(G_SA(0, 1), cA + hA, voffA);
  if (wr == 1) G_BAR;
  G_WAIT_V(4); G_BAR;
  G_STAGE(G_SB(1, 0), cB + kstep, voffB); G_STAGE(G_SA(1, 0), cA + kstep, voffA); G_STAGE(G_SB(1, 1), cB + hB + kstep, voffB);
  G_WAIT_V(6); G_BAR;
  for (;;) {
    const bool has_next = S.next(ui + 1, nxt);
    const char* nA = has_next ? S.aptr(nxt) : cA; const char* nB = has_next ? S.bptr(nxt) : cB;
    for (int t = 0; t < nt; t += 2) {
      const bool last = (t == nt - 2);
      const char* a1 = cA + (size_t)(t + 1) * kstep;
      const char* a2 = last ? nA : cA + (size_t)(t + 2) * kstep; const char* b2 = last ? nB : cB + (size_t)(t + 2) * kstep;
      const char* a3 = a2 + kstep; const char* b3 = b2 + kstep;
      G_LDB(B0, 0, 0); G_SCHED; G_LDA(At, 0, 0); G_STAGE(G_SA(1, 1), a1 + hA, voffA);
      G_WAIT_L(8); G_BAR; G_WAIT_L(0); G_MMA(0, 0, At, B0); G_BAR; G_SCHED;
      G_LDB(B1, 0, 1); G_STAGE(G_SB(0, 0), b2, voffB);
      G_BAR; G_WAIT_L(0); G_MMA(0, 1, At, B1); G_BAR;
      G_LDA(At, 0, 1); G_STAGE(G_SA(0, 0), a2, voffA);
      G_BAR; G_WAIT_L(0); G_MMA(1, 0, At, B0); G_BAR; G_SCHED;
      G_STAGE(G_SB(0, 1), b2 + hB, voffB);
      G_WAIT_V(6); G_BAR; G_MMA(1, 1, At, B1); G_BAR;
      G_LDB(B0, 1, 0); G_SCHED; G_LDA(At, 1, 0); G_STAGE(G_SA(0, 1), a2 + hA, voffA);
      G_WAIT_L(8); G_BAR; G_WAIT_L(0); G_MMA(0, 0, At, B0); G_BAR; G_SCHED;
      G_LDB(B1, 1, 1); G_STAGE(G_SB(1, 0), b3, voffB);
      G_BAR; G_WAIT_L(0); G_MMA(0, 1, At, B1); G_BAR;
      G_LDA(At, 1, 1); G_STAGE(G_SA(1, 0), a3, voffA);
      G_BAR; G_WAIT_L(0); G_MMA(1, 0, At, B0); G_BAR; G_SCHED;
      G_STAGE(G_SB(1, 1), b3 + hB, voffB);
      G_WAIT_V(6); G_BAR; G_MMA(1, 1, At, B1); G_BAR;
    }
    unsigned long long t_e0 = 0; if (PROBE >= 20) t_e0 = __builtin_amdgcn_s_memrealtime();
    const bool reset = E(acc, cur, wr, wc, fr, fq);
    if (PROBE >= 20) { asm volatile("s_waitcnt vmcnt(0)" ::: "memory"); t_epi += __builtin_amdgcn_s_memrealtime() - t_e0; }
    if (!has_next) break;
    if (reset) {
#pragma unroll
      for (int a = 0; a < 2; ++a)
#pragma unroll
        for (int b = 0; b < 2; ++b)
#pragma unroll
          for (int m = 0; m < 4; ++m)
#pragma unroll
            for (int n = 0; n < 2; ++n) acc[a][b][m][n] = (f32x4){0.f, 0.f, 0.f, 0.f};
    }
    cur = nxt; cA = nA; cB = nB; ++ui;
  }
  G_WAIT_V(0);
  if (wr == 0) G_BAR;
  G_BAR;
  float tres = 0.f;
  if (PROBE >= 20) {
    const unsigned long long tot = __builtin_amdgcn_s_memrealtime() - t_ph0;
    tres = (tmode == 0) ? (float)t_epi / (float)tot : (float)tot / 40000.f;
  }
#undef G_SA
#undef G_SB
#undef G_STAGE
#undef G_LDA
#undef G_LDB
#undef G_MMA
#undef G_WAIT_V
#undef G_WAIT_L
#undef G_BAR
#undef G_SCHED
  return tres;
}

struct EpiInproj {
  const Params* pp; int l; LAS float* part; const LAS float* ropeL;
  __device__ __forceinline__ bool operator()(f32x4 (&acc)[2][2][4][2], const Unit& u, int wr, int wc, int fr, int fq) const {
    const Params& p = *pp;
    asm volatile("" : "+v"(fr), "+v"(fq));
    const int lane = fr + 16 * fq; (void)lane;
    const int oc0 = u.pn * 256;
    const bool isctx = u.pm < 16;
    const bool qkU = (oc0 < 768) || (oc0 >= 2304 && oc0 < 3328);
    float rinv[2][4][2];
    if (qkU) {
#pragma unroll
      for (int ai = 0; ai < 2; ai++)
#pragma unroll
        for (int m = 0; m < 4; m++)
#pragma unroll
          for (int bj = 0; bj < 2; bj++) {
            f32x4 a = acc[ai][bj][m][0], b = acc[ai][bj][m][1];
            float ss = a[0] * a[0] + a[1] * a[1] + a[2] * a[2] + a[3] * a[3] + b[0] * b[0] + b[1] * b[1] + b[2] * b[2] + b[3] * b[3];
            ss += shflx(ss, 16, lane); ss += shflx(ss, 32, lane);
            rinv[ai][m][bj] = ss;
            if (fq == 0) part[((ai * 128 + wr * 64 + m * 16 + fr) * 2 + bj) * 4 + wc] = ss;
          }
      asm volatile("s_waitcnt lgkmcnt(0)" ::: "memory");
      __builtin_amdgcn_s_barrier();
      asm volatile("" ::: "memory");
#pragma unroll
      for (int ai = 0; ai < 2; ai++)
#pragma unroll
        for (int m = 0; m < 4; m++)
#pragma unroll
          for (int bj = 0; bj < 2; bj++) {
            float o = part[((ai * 128 + wr * 64 + m * 16 + fr) * 2 + bj) * 4 + (wc ^ 1)];
            rinv[ai][m][bj] = rsqrtf((rinv[ai][m][bj] + o) * (1.f / 64.f) + EPS);
          }
    }
#pragma unroll
    for (int bj = 0; bj < 2; bj++) {
      const int oc = oc0 + bj * 128;
      if (oc == 640 || (oc >= 3328 && oc < 3840)) {
        const bool isA = (oc == 640);
        const int cb = isA ? 0 : (oc - 3328);
        const int nvec = isA ? 128 : 512;
#pragma unroll
        for (int ai = 0; ai < 2; ai++)
#pragma unroll
          for (int m = 0; m < 4; m++) {
            const int row = u.pm * 256 + ai * 128 + wr * 64 + m * 16 + fr;
            int b, t, T; u16* vt;
            if (isctx) { b = row >> 8; t = row & 255; T = 256; vt = isA ? p.VtA_ctx : p.VtC_ctx; }
            else { int rr = row - NCTX; b = rr >> 12; t = rr & 4095; T = 4096; vt = isA ? p.VtA_lat : p.VtC_lat; }
#pragma unroll
            for (int n = 0; n < 2; n++) {
              const int d = cb + wc * 32 + n * 16 + fq * 4;
              f32x4 v = acc[ai][bj][m][n];
#pragma unroll
              for (int j = 0; j < 4; j++) vt[((size_t)b * nvec + d + j) * T + t] = f2bf(v[j]);
              if (isctx) {
                float* o = p.out + (isA ? O_VA : O_VC) + ((size_t)(b * 2 + l) * 256 + t) * nvec + d;
                *(f32x4*)o = v;
              }
            }
          }
      } else {
        const int pc = (oc < 640) ? oc : (oc < 3328 ? oc - 128 : oc - 640);
        const bool is_qa = oc < 512, is_ka = (oc == 512);
        const bool is_qc = (oc >= 2304 && oc < 2816), is_kc = (oc >= 2816 && oc < 3328);
        if (is_qa || is_ka || is_qc || is_kc) {
          const float* gn = (is_qa ? p.qn_a : is_ka ? p.kn_a : is_qc ? p.qn_c : p.kn_c) + l * 64 + (wc & 1) * 32 + fq * 4;
          const f32x4 g0 = *(const f32x4*)gn, g1 = *(const f32x4*)(gn + 16);
          const float qs = (is_qa || is_qc) ? 0.18033688011112042f : 1.f;
#pragma unroll
          for (int ai = 0; ai < 2; ai++)
#pragma unroll
            for (int m = 0; m < 4; m++) {
              const int row = u.pm * 256 + ai * 128 + wr * 64 + m * 16 + fr;
              const float ri = rinv[ai][m][bj];
              f32x4 x1 = acc[ai][bj][m][0] * ri * g0, x2 = acc[ai][bj][m][1] * ri * g1;
              if (!isctx) {
                const int t = (row - NCTX) & 4095;
                const int pos = (wc & 1) ? (t & 63) : (t >> 6);
                const f32x4 cs = *(const LAS f32x4*)(ropeL + pos * 16 + fq * 4), sn = *(const LAS f32x4*)(ropeL + 1024 + pos * 16 + fq * 4);
                f32x4 y1 = x1 * cs - x2 * sn, y2 = x2 * cs + x1 * sn;
                x1 = y1; x2 = y2;
              } else if (is_ka || is_kc) {
                const int b = row >> 8, t = row & 255;
                float* o = is_ka ? p.out + O_KA + ((size_t)(b * 2 + l) * 256 + t) * 128 + wc * 32 + fq * 4
                                 : p.out + O_KC + ((size_t)(b * 2 + l) * 256 + t) * 512 + (oc - 2816) + wc * 32 + fq * 4;
                *(f32x4*)o = x1; *(f32x4*)(o + 16) = x2;
              }
              x1 = x1 * qs; x2 = x2 * qs;
              u16* po = p.P + (size_t)row * PP + pc + wc * 32 + fq * 4;
              *(uint2*)po = make_uint2(pack2(x1[0], x1[1]), pack2(x1[2], x1[3]));
              *(uint2*)(po + 16) = make_uint2(pack2(x2[0], x2[1]), pack2(x2[2], x2[3]));
            }
        } else {
          const int mode = (oc >= 4352) ? 2 : ((oc >= 1280 && oc < 1792) ? 0 : 1);
          if (mode == 2) {
            const int pj = u.pn - 17, seg = pj >> 2, pn4 = pj & 3;
            unsigned* mg = p.MG + ((size_t)((u.pm * 4 + pn4) * 3 + seg) * 8 + (wr * 4 + wc)) * 2048 + lane;
#pragma unroll
            for (int ai = 0; ai < 2; ai++)
#pragma unroll
              for (int m = 0; m < 4; m++)
#pragma unroll
                for (int n = 0; n < 2; n++) {
                  f32x4 v = acc[ai][bj][m][n];
                  const unsigned q0 = (unsigned)(sigmoidf_(v[0]) * 254.f + 1.5f), q1 = (unsigned)(sigmoidf_(v[1]) * 254.f + 1.5f);
                  const unsigned q2 = (unsigned)(sigmoidf_(v[2]) * 254.f + 1.5f), q3 = (unsigned)(sigmoidf_(v[3]) * 254.f + 1.5f);
                  mg[(((ai * 4 + m) * 2 + bj) * 2 + n) * 64] = q0 | (q1 << 8) | (q2 << 16) | (q3 << 24);
                }
          } else
#pragma unroll
          for (int ai = 0; ai < 2; ai++)
#pragma unroll
            for (int m = 0; m < 4; m++) {
              const int row = u.pm * 256 + ai * 128 + wr * 64 + m * 16 + fr;
              u16* po = p.P + (size_t)row * PP + pc + wc * 32 + fq * 4;
#pragma unroll
              for (int n = 0; n < 2; n++) {
                f32x4 v = acc[ai][bj][m][n];
                if (mode == 1) { v[0] = siluf_(v[0]); v[1] = siluf_(v[1]); v[2] = siluf_(v[2]); v[3] = siluf_(v[3]); }
                else if (mode == 2) { v[0] = sigmoidf_(v[0]); v[1] = sigmoidf_(v[1]); v[2] = sigmoidf_(v[2]); v[3] = sigmoidf_(v[3]); }
                *(uint2*)(po + n * 16) = make_uint2(pack2(v[0], v[1]), pack2(v[2], v[3]));
              }
            }
        }
      }
    }
    return true;
  }
};

struct EpiBranch {
  const Params* pp;
  __device__ __forceinline__ bool operator()(f32x4 (&acc)[2][2][4][2], const Unit& u, int wr, int wc, int fr, int fq) const {
    const Params& p = *pp;
    asm volatile("" : "+v"(fr), "+v"(fq));
    const int lane = fr + 16 * fq;
    const int seg = u.seg;
    const unsigned* mg = p.MG + ((size_t)((u.pm * 4 + u.pn) * 3 + seg) * 8 + (wr * 4 + wc)) * 2048 + lane;
    const float sel = (seg < 2) ? 1.f : 0.f;
#pragma unroll
    for (int hq = 0; hq < 4; hq++) {
      unsigned a[8], b[8];
#pragma unroll
      for (int q = 0; q < 8; q++) { a[q] = mg[(hq * 8 + q) * 64]; b[q] = mg[(hq * 8 + q) * 64 + 8 * 2048]; }
      __builtin_amdgcn_sched_barrier(0);
#pragma unroll
      for (int q = 0; q < 8; q++) {
        const int ai = hq >> 1, m = (hq & 1) * 2 + (q >> 2), bj = (q >> 1) & 1, n = q & 1;
        f32x4 f = {(float)(a[q] & 255u), (float)((a[q] >> 8) & 255u), (float)((a[q] >> 16) & 255u), (float)(a[q] >> 24)};
        f32x4 g = {(float)(b[q] & 255u), (float)((b[q] >> 8) & 255u), (float)((b[q] >> 16) & 255u), (float)(b[q] >> 24)};
        g = g * sel + (1.f - sel) * 255.f;
        f[0] *= __builtin_amdgcn_rcpf(g[0]); f[1] *= __builtin_amdgcn_rcpf(g[1]); f[2] *= __builtin_amdgcn_rcpf(g[2]); f[3] *= __builtin_amdgcn_rcpf(g[3]);
        acc[ai][bj][m][n] = acc[ai][bj][m][n] * f;
      }
    }
    if (seg < 2) return false;
#pragma unroll
    for (int ai = 0; ai < 2; ai++)
#pragma unroll
      for (int m = 0; m < 4; m++) {
        const int row = u.pm * 256 + ai * 128 + wr * 64 + m * 16 + fr;
#pragma unroll
        for (int bj = 0; bj < 2; bj++)
#pragma unroll
          for (int n = 0; n < 2; n++) {
            const int col = u.pn * 256 + bj * 128 + wc * 32 + n * 16 + fq * 4;
            const f32x4 v = acc[ai][bj][m][n];
            *(uint2*)(p.Y + tm_off(row, col, 16)) = make_uint2(pack2(v[0], v[1]), pack2(v[2], v[3]));
          }
      }
    return true;
  }
};

struct EpiOut {
  const Params* pp; int l;
  __device__ __forceinline__ bool operator()(f32x4 (&acc)[2][2][4][2], const Unit& u, int wr, int wc, int fr, int fq) const {
    const Params& p = *pp;
    asm volatile("" : "+v"(fr), "+v"(fq));
    const int v = (u.pm < 16) ? 0 : 1 + (u.pm - 16) / 16;
    const float* gt = p.mod + (l * 3 + v) * 3072 + 2048 + u.pn * 256 + wc * 32 + fq * 4;
    const float* xsrc = (l == 0) ? ((u.pm < 16) ? p.x_prompt + (size_t)u.pm * 256 * 1024 : p.x_sample + (size_t)(u.pm - 16) * 256 * 1024)
                                 : p.out + O_X + (size_t)u.pm * 256 * 1024;
    float* odst = p.out + O_X + (size_t)u.pm * 256 * 1024;
    const int cbase = u.pn * 256 + wc * 32 + fq * 4;
    f32x4 gv[2][2];
#pragma unroll
    for (int bj = 0; bj < 2; bj++)
#pragma unroll
      for (int n = 0; n < 2; n++) gv[bj][n] = *(const f32x4*)(gt + bj * 128 + n * 16);
#pragma unroll
    for (int ai = 0; ai < 2; ai++)
#pragma unroll
      for (int mh = 0; mh < 2; mh++) {
        f32x4 xv[2][2][2];
#pragma unroll
        for (int mm = 0; mm < 2; mm++)
#pragma unroll
          for (int bj = 0; bj < 2; bj++)
#pragma unroll
            for (int n = 0; n < 2; n++)
              xv[mm][bj][n] = *(const f32x4*)(xsrc + (size_t)(ai * 128 + wr * 64 + (mh * 2 + mm) * 16 + fr) * 1024 + cbase + bj * 128 + n * 16);
#pragma unroll
        for (int mm = 0; mm < 2; mm++)
#pragma unroll
          for (int bj = 0; bj < 2; bj++)
#pragma unroll
            for (int n = 0; n < 2; n++)
              *(f32x4*)(odst + (size_t)(ai * 128 + wr * 64 + (mh * 2 + mm) * 16 + fr) * 1024 + cbase + bj * 128 + n * 16) = xv[mm][bj][n] + gv[bj][n] * acc[ai][bj][mh * 2 + mm][n];
      }
    return true;
  }
};

template <bool MASK>
__device__ __forceinline__ void fs_scores(const u16* Ks, const bf16x8 (&qf)[4], f32x16 (&s)[2], int lane, int kpos0, int qpos, int T) {
  const int r = lane & 31, h = lane >> 5;
  {
    bf16x8 kf[2][4];
#pragma unroll
    for (int sub = 0; sub < 2; sub++)
#pragma unroll
      for (int ks = 0; ks < 4; ks++) kf[sub][ks] = *(const bf16x8*)(Ks + (sub * 32 + r) * LROW + ks * 16 + h * 8);
    __builtin_amdgcn_sched_barrier(0);
#pragma unroll
    for (int sub = 0; sub < 2; sub++) {
#pragma unroll
      for (int e = 0; e < 16; e++) s[sub][e] = 0.f;
#pragma unroll
      for (int ks = 0; ks < 4; ks++) s[sub] = mfma32(kf[sub][ks], qf[ks], s[sub]);
    }
  }
  if (MASK) {
#pragma unroll
    for (int sub = 0; sub < 2; sub++)
#pragma unroll
      for (int e = 0; e < 16; e++) {
        int kp = kpos0 + sub * 32 + (e & 3) + 8 * (e >> 2) + 4 * h;
        int dlt = kp - qpos;
        bool ok = (kp >= 0) && (kp < T) && (dlt <= 128) && (dlt >= -128);
        if (!ok) s[sub][e] = -INFINITY;
      }
  }
}
template <int DV>
__device__ __forceinline__ void fs_softmax(f32x16 (&s)[2], float& m, float& l, f32x16 (&o)[DV / 32], bf16x8 (&pf)[2][2], int lane) {
  float mx = s[0][0];
#pragma unroll
  for (int sub = 0; sub < 2; sub++)
#pragma unroll
    for (int e = 0; e < 16; e++) mx = fmaxf(mx, s[sub][e]);
  mx = half_max(mx);
  const bool grow = mx > m;
  const float mn = grow ? mx : m;
  float sum = 0.f;
#pragma unroll
  for (int sub = 0; sub < 2; sub++)
#pragma unroll
    for (int e = 0; e < 16; e++) { float pv = __builtin_amdgcn_exp2f(s[sub][e] - mn); s[sub][e] = pv; sum += pv; }
  sum = half_sum(sum);
  if (__builtin_amdgcn_ballot_w64(grow) != 0ull) {
    const float alpha = __builtin_amdgcn_exp2f(m - mn);
    l *= alpha;
#pragma unroll
    for (int ds = 0; ds < DV / 32; ds++)
#pragma unroll
      for (int e = 0; e < 16; e++) o[ds][e] *= alpha;
  }
  l += sum; m = mn;
  typedef __attribute__((ext_vector_type(4))) unsigned u32x4;
#pragma unroll
  for (int sub = 0; sub < 2; sub++)
#pragma unroll
    for (int st = 0; st < 2; st++) {
      u32x4 pw;
#pragma unroll
      for (int j = 0; j < 4; j++) pw[j] = pack2(s[sub][8 * st + 2 * j], s[sub][8 * st + 2 * j + 1]);
      pf[sub][st] = __builtin_bit_cast(bf16x8, pw);
    }
}
template <int DV>
__device__ __forceinline__ void fs_pv(const bf16x8 (&pf)[2][2], const u16* Vts, f32x16 (&o)[DV / 32], int lane) {
  const int r = lane & 31, h = lane >> 5;
#pragma unroll
  for (int sub = 0; sub < 2; sub++) {
    bf16x8 vf[2][DV / 32];
#pragma unroll
    for (int st = 0; st < 2; st++)
#pragma unroll
      for (int ds = 0; ds < DV / 32; ds++) {
        const u16* vp = Vts + (ds * 32 + r) * VROW + sub * 32 + 16 * st + 4 * h;
        bf16x4 lo = *(const bf16x4*)vp, hi = *(const bf16x4*)(vp + 8);
        vf[st][ds] = __builtin_shufflevector(lo, hi, 0, 1, 2, 3, 4, 5, 6, 7);
      }
    __builtin_amdgcn_sched_barrier(0);
#pragma unroll
    for (int st = 0; st < 2; st++)
#pragma unroll
      for (int ds = 0; ds < DV / 32; ds++) o[ds] = mfma32(vf[st][ds], pf[sub][st], o[ds]);
    __builtin_amdgcn_sched_barrier(0);
  }
}

__device__ __forceinline__ uint4 ld_k(const u16* __restrict__ src, size_t pitch, int r0, int nrows, int c) {
  int row = c >> 3, kc = c & 7; int rr = r0 + row;
  const bool ok = (rr >= 0 && rr < nrows);
  const int rc = rr < 0 ? 0 : (rr >= nrows ? nrows - 1 : rr);
  uint4 v = *(const uint4*)(src + (size_t)rc * pitch + kc * 8);
  if (!ok) v = make_uint4(0, 0, 0, 0);
  return v;
}
__device__ __forceinline__ void st_k(u16* dst, int c, uint4 v) { *(uint4*)(dst + (c >> 3) * LROW + (c & 7) * 8) = v; }
__device__ __forceinline__ uint4 ld_vt(const u16* __restrict__ src, int T, int k0, int c) {
  int d = c >> 3, kc = c & 7; int k = k0 + kc * 8;
  const bool ok = (k >= 0 && k < T);
  const int kk = k < 0 ? 0 : (k >= T ? T - 8 : k);
  uint4 v = *(const uint4*)(src + (size_t)d * T + kk);
  if (!ok) v = make_uint4(0, 0, 0, 0);
  return v;
}
__device__ __forceinline__ void st_vt(u16* dst, int c, uint4 v) {
  uint2* q = (uint2*)(dst + (c >> 3) * VROW + (c & 7) * 8);
  q[0] = make_uint2(v.x, v.y); q[1] = make_uint2(v.z, v.w);
}

constexpr int A_BUF = 64 * LROW + 64 * VROW;
__device__ __forceinline__ void attnA_item(const Params& p, int l, int it, u16* sm, bool dry = false) {
  const int tid = TIDX, lane = tid & 63, wid = tid >> 6;
  const int r = lane & 31, h = lane >> 5;
  const bool isctx = it < 128;
  int b, kvh, qb, T, rowbase; const u16* VtBase;
  if (isctx) { b = it >> 3; kvh = (it >> 2) & 1; qb = it & 3; T = 256; rowbase = b * 256;
    VtBase = p.VtA_ctx + ((size_t)(b * 2 + kvh) * 64) * 256; }
  else { int j = it - 128; b = j >> 7; kvh = (j >> 6) & 1; qb = j & 63; T = 4096; rowbase = NCTX + b * 4096;
    VtBase = p.VtA_lat + ((size_t)(b * 2 + kvh) * 64) * 4096; }
  const int qblk = qb * 64;
  const int q0 = qblk + (wid >> 2) * 32;
  const int head = kvh * 4 + (wid & 3);
  const size_t prow = (size_t)(rowbase + q0 + r) * PP;
  bf16x8 qf[4];
#pragma unroll
  for (int ks = 0; ks < 4; ks++) qf[ks] = *(const bf16x8*)(p.P + prow + C_QA + head * 64 + ks * 16 + h * 8);
  float m = p.sink_a[l * 8 + head] * 1.4426950408889634f, ls = 1.f;
  f32x16 o[2];
#pragma unroll
  for (int ds = 0; ds < 2; ds++)
#pragma unroll
    for (int e = 0; e < 16; e++) o[ds][e] = 0.f;
  const u16* Kbase = p.P + (size_t)rowbase * PP + C_KA + kvh * 64;
  const u16* cK = p.cKa + ((size_t)(b * 2 + l) * 512) * 128 + kvh * 64;
  const u16* cVt = p.cVtA + ((size_t)((b * 2 + l) * 2 + kvh) * 64) * 512;
  const int qpos = q0 + r;
  int i_lo = 0, nW, ntile;
  if (isctx) { nW = 4; ntile = 4; }
  else {
    i_lo = (qblk < 128) ? (128 - qblk) / 64 : 0;
    int i_hi = (T - qblk + 128) / 64; if (i_hi > 5) i_hi = 5;
    nW = i_hi - i_lo; ntile = nW + 8;
  }
  uint4 rk, rv;
  auto tile_load = [&](int t) {
    if (t < nW) {
      int k0 = isctx ? t * 64 : qblk - 128 + 64 * (i_lo + t);
      rk = ld_k(Kbase, PP, k0, T, tid); rv = ld_vt(VtBase, T, k0, tid);
    } else {
      int kt = t - nW;
      rk = ld_k(cK, 128, kt * 64, 512, tid); rv = ld_vt(cVt, 512, kt * 64, tid);
    }
  };
  auto KB = [&](int i) { return sm + (i & 1) * (64 * LROW); };
  auto VB = [&](int i) { return sm + 2 * 64 * LROW + (i % 3) * (64 * VROW); };
  const bool lag = (wid >> 2) != 0;
  __syncthreads();
  tile_load(0);
  st_k(KB(0), tid, rk); st_vt(VB(0), tid, rv);
  __syncthreads();
  bf16x8 pf[2][2];
  for (int t = 0; t <= ntile; t++) {
    const bool more = t + 1 < ntile;
    if (more) tile_load(t + 1);
    if (lag && t > 0) fs_pv<64>(pf, VB(t - 1), o, lane);
    if (t < ntile) {
      f32x16 sc[2];
      bool needmask = false;
      if (!isctx && t < nW) {
        const int k0 = qblk - 128 + 64 * (i_lo + t);
        needmask = (k0 - q0 < -97) || (k0 - q0 > 65) || (k0 < 0) || (k0 + 64 > T);
      }
      if (needmask) fs_scores<true>(KB(t), qf, sc, lane, qblk - 128 + 64 * (i_lo + t), qpos, T);
      else fs_scores<false>(KB(t), qf, sc, lane, 0, 0, T);
      fs_softmax<64>(sc, m, ls, o, pf, lane);
      if (!lag) fs_pv<64>(pf, VB(t), o, lane);
    }
    if (more) { st_k(KB(t + 1), tid, rk); st_vt(VB(t + 1), tid, rv); }
    __syncthreads();
  }
  const float inv = __builtin_amdgcn_rcpf(ls);
  {
    uint2 gv[2][4];
#pragma unroll
    for (int ds = 0; ds < 2; ds++)
#pragma unroll
      for (int g = 0; g < 4; g++) gv[ds][g] = *(const uint2*)(p.P + prow + C_GA + head * 64 + ds * 32 + 8 * g + 4 * h);
    __builtin_amdgcn_sched_barrier(0);
#pragma unroll
    for (int ds = 0; ds < 2; ds++)
#pragma unroll
      for (int g = 0; g < 4; g++) {
        int d = ds * 32 + 8 * g + 4 * h;
        uint2 ov;
        ov.x = pack2(o[ds][4 * g] * inv * lo_bf(gv[ds][g].x), o[ds][4 * g + 1] * inv * hi_bf(gv[ds][g].x));
        ov.y = pack2(o[ds][4 * g + 2] * inv * lo_bf(gv[ds][g].y), o[ds][4 * g + 3] * inv * hi_bf(gv[ds][g].y));
        *(uint2*)(p.GB + tm_off(rowbase + q0 + r, head * 64 + d, 8)) = ov;
      }
  }
}

constexpr int C_BUF = 128 * LROW + 128 * VROW;
__device__ __forceinline__ void attnC_item(const Params& p, int l, int it, u16* sm, float lam, float lam_init, bool dry = false) {
  const int tid = TIDX, lane = tid & 63, wid = tid >> 6;
  const int r = lane & 31, h = lane >> 5;
  const bool isctx = it < 128;
  int b, hd, qb, T, rowbase; const u16* VtBase;
  if (isctx) { b = it >> 3; hd = (it >> 1) & 3; qb = it & 1; T = 256; rowbase = b * 256;
    VtBase = p.VtC_ctx + ((size_t)(b * 4 + hd) * 128) * 256; }
  else { int j = it - 128; b = j >> 7; hd = (j >> 5) & 3; qb = j & 31; T = 4096; rowbase = NCTX + b * 4096;
    VtBase = p.VtC_lat + ((size_t)(b * 4 + hd) * 128) * 4096; }
  const int qg = wid & 3, map = wid >> 2;
  const int q0 = qb * 128 + qg * 32;
  const size_t prow = (size_t)(rowbase + q0 + r) * PP;
  bf16x8 qf[4];
#pragma unroll
  for (int ks = 0; ks < 4; ks++) qf[ks] = *(const bf16x8*)(p.P + prow + C_QC + hd * 128 + map * 64 + ks * 16 + h * 8);
  float m = -1e30f, ls = 0.f;
  f32x16 o[4];
#pragma unroll
  for (int ds = 0; ds < 4; ds++)
#pragma unroll
    for (int e = 0; e < 16; e++) o[ds][e] = 0.f;
  const u16* Kbase = p.P + (size_t)rowbase * PP + C_KC + hd * 128;
  const u16* cK = p.cKc + ((size_t)(b * 2 + l) * 512) * 512 + hd * 128;
  const u16* cVt = p.cVtC + ((size_t)((b * 2 + l) * 4 + hd) * 128) * 512;
  const int nW = T / 64, ntile = isctx ? nW : nW + 8;
  uint4 rk0, rk1, rv0, rv1;
  const u16* pk = Kbase + (size_t)(tid >> 3) * PP + (tid & 7) * 8;
  const u16* pv0 = VtBase + (size_t)(tid >> 3) * T + (tid & 7) * 8;
  const u16* pv1 = VtBase + (size_t)((tid + NT) >> 3) * T + (tid & 7) * 8;
  size_t kstride = (size_t)64 * PP;
  auto tile_load = [&](int t) {
    if (t == nW) {
      pk = cK + (size_t)(tid >> 3) * 512 + (tid & 7) * 8;
      pv0 = cVt + (size_t)(tid >> 3) * 512 + (tid & 7) * 8;
      pv1 = cVt + (size_t)((tid + NT) >> 3) * 512 + (tid & 7) * 8;
      kstride = (size_t)64 * 512;
    }
    rk0 = *(const uint4*)pk; rk1 = *(const uint4*)(pk + 64);
    rv0 = *(const uint4*)pv0; rv1 = *(const uint4*)pv1;
    pk += kstride; pv0 += 64; pv1 += 64;
  };
  auto KB = [&](int i) { return sm + (i & 1) * (128 * LROW); };
  auto VB = [&](int i) { return sm + 2 * 128 * LROW + (i % 3) * (128 * VROW); };
  auto tile_store = [&](int i) {
    u16* kd = KB(i); u16* vd = VB(i);
    st_k(kd, tid, rk0); st_k(kd + 64 * LROW, tid, rk1);
    st_vt(vd, tid, rv0); st_vt(vd, tid + NT, rv1);
  };
  const bool lag = map != 0;
  __syncthreads();
  tile_load(0);
  tile_store(0);
  __syncthreads();
  bf16x8 pf[2][2];
  for (int t = 0; t <= ntile; t++) {
    const bool more = t + 1 < ntile;
    if (more) tile_load(t + 1);
    if (lag && t > 0) fs_pv<128>(pf, VB(t - 1), o, lane);
    if (t < ntile) {
      f32x16 sc[2];
      fs_scores<false>(KB(t) + map * 64 * LROW, qf, sc, lane, 0, 0, T);
      fs_softmax<128>(sc, m, ls, o, pf, lane);
      if (!lag) fs_pv<128>(pf, VB(t), o, lane);
    }
    if (more) tile_store(t + 1);
    __syncthreads();
  }
  float* xch = (float*)sm;
  if (map == 1) {
    const float inv = lam * __builtin_amdgcn_rcpf(ls);
#pragma unroll
    for (int ds = 0; ds < 4; ds++)
#pragma unroll
      for (int e = 0; e < 16; e++) xch[((qg * 64) + ds * 16 + e) * 64 + lane] = o[ds][e] * inv;
  }
  __syncthreads();
  if (map == 0) {
    const float i0 = __builtin_amdgcn_rcpf(ls);
    float ss = 0.f;
#pragma unroll
    for (int ds = 0; ds < 4; ds++)
#pragma unroll
      for (int e = 0; e < 16; e++) {
        float v = o[ds][e] * i0 - xch[((qg * 64) + ds * 16 + e) * 64 + lane];
        o[ds][e] = v; ss += v * v;
      }
    ss += shflx(ss, 32, lane);
    const float rinv = rsqrtf(ss * (1.f / 128.f) + EPS) * (1.f - lam_init);
    const float* sg = p.subln_c + l * 128;
#pragma unroll
    for (int ds = 0; ds < 4; ds++) {
      uint2 gv[4]; float4 sl[4];
#pragma unroll
      for (int g = 0; g < 4; g++) {
        const int d = ds * 32 + 8 * g + 4 * h;
        gv[g] = *(const uint2*)(p.P + prow + C_GC + hd * 128 + d);
        sl[g] = *(const float4*)(sg + d);
      }
      __builtin_amdgcn_sched_barrier(0);
#pragma unroll
      for (int g = 0; g < 4; g++) {
        const int d = ds * 32 + 8 * g + 4 * h;
        uint2 ov;
        ov.x = pack2(o[ds][4 * g] * rinv * sl[g].x * lo_bf(gv[g].x), o[ds][4 * g + 1] * rinv * sl[g].y * hi_bf(gv[g].x));
        ov.y = pack2(o[ds][4 * g + 2] * rinv * sl[g].z * lo_bf(gv[g].y), o[ds][4 * g + 3] * rinv * sl[g].w * hi_bf(gv[g].y));
        *(uint2*)(p.GB + (size_t)2 * NTOK * 512 + tm_off(rowbase + q0 + r, hd * 128 + d, 8)) = ov;
      }
    }
  }
}

__device__ __forceinline__ void lru_run(const Params& p, int l, bool pass2, int start, int G, float* sm, bool dry = false) {
  const int tid = TIDX;
  const int lane = tid & 63, wid = tid >> 6, r = lane & 31, h = lane >> 5;
  const int n = start & 7;
  float* xin = sm;
  float* xb = sm + 67 * 64;
  float* comb = xb + 64 * 64;
  float* carry = comb + 2048;
  float* parts = carry + 128;
  float* ab = parts + 1024;
  u16* xbh = (u16*)(ab + 4 * 4096);
  const int gd = wid >> 2, gth = (wid >> 1) & 1, gdh = wid & 1;
  bf16x8 wfa[4], wfx[4];
  {
    const u16* wbase = p.Wt_lru + ((size_t)(((l * 2 + gd) * 8 + n) * 2) * 64 + gdh * 32 + r) * 64 + h * 8;
#pragma unroll
    for (int ks = 0; ks < 4; ks++) { wfa[ks] = *(const bf16x8*)(wbase + ks * 16); wfx[ks] = *(const bf16x8*)(wbase + 4096 + ks * 16); }
  }
  const int gch = n * 64 + gdh * 32 + r;
  const float g_ba = p.lru_ba[(l * 2 + gd) * 512 + gch], g_bx = p.lru_bx[(l * 2 + gd) * 512 + gch];
  const float g_sp = log1pf(__expf(-p.lru_lam[(l * 2 + gd) * 512 + gch]));
  const int cc = tid & 63;
  float cw[4]; float cbv;
  {
    const float* cwp = p.conv_w + l * 4 * 512 + n * 64 + cc;
    cw[0] = cwp[0]; cw[1] = cwp[512]; cw[2] = cwp[1024]; cw[3] = cwp[1536];
    cbv = p.conv_b[l * 512 + n * 64 + cc];
  }
  const int dout = tid & 63, tg = tid >> 6;
  const int ch = n * 64 + dout;

  u16 xr[9];
  auto xin_load = [&](int it_) {
    const int row0_ = (it_ >> 3) * 64;
    int T_, seq0_;
    if (row0_ < NCTX) { T_ = 256; seq0_ = (row0_ >> 8) * 256; } else { T_ = 4096; seq0_ = NCTX + ((row0_ - NCTX) >> 12) * 4096; }
    const int t0_ = row0_ - seq0_;
#pragma unroll
    for (int k = 0; k < 9; k++) {
      const int rr = (tid >> 6) + 8 * k; const int t = t0_ - 2 + rr;
      const bool ok = (rr < 67 && t >= 0 && t < T_);
      const int tc = t < 0 ? 0 : (t >= T_ ? T_ - 1 : t);
      u16 v = p.P[(size_t)(seq0_ + tc) * PP + C_XB + n * 64 + cc];
      xr[k] = ok ? v : (u16)0;
    }
  };
  if (start < 1536) xin_load(start);
  for (int it = start; it < 1536; it += G) {
    const int ci = it >> 3;
    const int row0 = ci * 64;
    const bool isctx = row0 < NCTX;
    int T, seq0, bidx;
    if (isctx) { T = 256; bidx = row0 >> 8; seq0 = bidx * 256; }
    else { T = 4096; bidx = (row0 - NCTX) >> 12; seq0 = NCTX + bidx * 4096; }
    const int t0 = row0 - seq0;
    __syncthreads();
#pragma unroll
    for (int k = 0; k < 9; k++) { const int rr = (tid >> 6) + 8 * k; if (rr < 67) xin[rr * 64 + cc] = bf2f(xr[k]); }
    if (it + G < 1536) xin_load(it + G);
    u16 sgr[8];
    if (pass2) {
#pragma unroll
      for (int tt = 0; tt < 8; tt++) sgr[tt] = p.P[(size_t)(row0 + tg * 8 + tt) * PP + C_GB + ch];
    }
    if (pass2) {
      const int d = (tid >> 6) & 1, part = tid >> 7;
      const int cfirst = seq0 >> 6, clast = (seq0 + T - 64) >> 6;
      const int K = d ? (clast - ci) : (ci - cfirst);
      float2 q[16];
#pragma unroll
      for (int k = 0; k < 16; k++) {
        const int kk = part * 16 + k;
        const int cj = d ? (clast - kk) : (cfirst + kk);
        const int cjc = cj < cfirst ? cfirst : (cj > clast ? clast : cj);
        const float2 qv = *(const float2*)(p.lruTot + ((size_t)(cjc * 2 + d) * 512 + n * 64 + cc) * 2);
        q[k] = (kk < K) ? qv : make_float2(1.f, 0.f);
      }
      float At = 1.f, Bt = 0.f;
#pragma unroll
      for (int k = 0; k < 16; k++) { Bt = q[k].x * Bt + q[k].y; At *= q[k].x; }
      parts[((part * 2 + d) * 64 + cc) * 2] = At; parts[((part * 2 + d) * 64 + cc) * 2 + 1] = Bt;
    }
    __syncthreads();
    for (int e = tid; e < 64 * 64; e += NT) {
      int t = e >> 6;
      float v = cbv;
#pragma unroll
      for (int j = 0; j < 4; j++) v += xin[(t + j) * 64 + cc] * cw[j];
      xb[e] = v;
      xbh[t * LROW + cc] = f2bf(v);
    }
    if (pass2 && tid < 128) {
      const int d = tid >> 6;
      float hcar = isctx ? 0.f : p.state_lru[((size_t)(bidx * 2 + l) * 2 + d) * 512 + n * 64 + cc];
#pragma unroll
      for (int part = 0; part < 4; part++) hcar = parts[((part * 2 + d) * 64 + cc) * 2] * hcar + parts[((part * 2 + d) * 64 + cc) * 2 + 1];
      carry[d * 64 + cc] = hcar;
    }
    __syncthreads();
    {
      bf16x8 af[4];
#pragma unroll
      for (int ks = 0; ks < 4; ks++) af[ks] = *(const bf16x8*)(xbh + (gth * 32 + r) * LROW + ks * 16 + h * 8);
      f32x16 ga, gi;
#pragma unroll
      for (int e = 0; e < 16; e++) { ga[e] = 0.f; gi[e] = 0.f; }
#pragma unroll
      for (int ks = 0; ks < 4; ks++) { ga = mfma32(af[ks], wfa[ks], ga); gi = mfma32(af[ks], wfx[ks], gi); }
      const int dch = gdh * 32 + r;
#pragma unroll
      for (int e = 0; e < 16; e++) {
        const int tok = gth * 32 + (e & 3) + 8 * (e >> 2) + 4 * h;
        float rg = sigmoidf_(ga[e] + g_ba), ig = sigmoidf_(gi[e] + g_bx);
        float log_a = -8.f * rg * g_sp;
        float a = __expf(log_a);
        const float x2 = 2.f * log_a;
        const float om = -x2 * (1.f + x2 * (0.5f + x2 * (0.16666667f + x2 * (0.041666668f + x2 * (0.0083333338f + x2 * (0.0013888889f + x2 * 0.0001984127f))))));
        float bb = __builtin_amdgcn_sqrtf(om) * ig * xb[tok * 64 + dch];
        ab[((gd * 2 + 0) * 64 + tok) * 64 + dch] = a;
        ab[((gd * 2 + 1) * 64 + tok) * 64 + dch] = bb;
      }
    }
    __syncthreads();
    float av[2][8], bv[2][8];
#pragma unroll
    for (int d = 0; d < 2; d++)
#pragma unroll
      for (int tt = 0; tt < 8; tt++) {
        av[d][tt] = ab[((d * 2 + 0) * 64 + tg * 8 + tt) * 64 + dout];
        bv[d][tt] = ab[((d * 2 + 1) * 64 + tg * 8 + tt) * 64 + dout];
      }
    float sA0 = 1.f, sB0 = 0.f, sA1 = 1.f, sB1 = 0.f;
#pragma unroll
    for (int tt = 0; tt < 8; tt++) { sB0 = av[0][tt] * sB0 + bv[0][tt]; sA0 *= av[0][tt]; }
#pragma unroll
    for (int tt = 7; tt >= 0; tt--) { sB1 = av[1][tt] * sB1 + bv[1][tt]; sA1 *= av[1][tt]; }
    comb[((tg * 2 + 0) * 64 + dout) * 2 + 0] = sA0; comb[((tg * 2 + 0) * 64 + dout) * 2 + 1] = sB0;
    comb[((tg * 2 + 1) * 64 + dout) * 2 + 0] = sA1; comb[((tg * 2 + 1) * 64 + dout) * 2 + 1] = sB1;
    __syncthreads();
    if (!pass2) {
      if (tid < 128) {
        int d = tid >> 6, c = tid & 63;
        float At = 1.f, Bt = 0.f;
#pragma unroll
        for (int s = 0; s < 8; s++) {
          int g = (d == 0) ? s : 7 - s;
          float a = comb[((g * 2 + d) * 64 + c) * 2], bq = comb[((g * 2 + d) * 64 + c) * 2 + 1];
          Bt = a * Bt + bq; At *= a;
        }
        float* o = p.lruTot + ((size_t)(ci * 2 + d) * 512 + n * 64 + c) * 2;
        o[0] = At; o[1] = Bt;
      }
      continue;
    }
    float h0 = carry[dout], h1 = carry[64 + dout];
    for (int g = 0; g < tg; g++) { h0 = comb[((g * 2 + 0) * 64 + dout) * 2] * h0 + comb[((g * 2 + 0) * 64 + dout) * 2 + 1]; }
    for (int g = 7; g > tg; g--) { h1 = comb[((g * 2 + 1) * 64 + dout) * 2] * h1 + comb[((g * 2 + 1) * 64 + dout) * 2 + 1]; }
    float y[8];
#pragma unroll
    for (int tt = 0; tt < 8; tt++) { h0 = av[0][tt] * h0 + bv[0][tt]; y[tt] = h0; }
    const float hf_last = h0;
#pragma unroll
    for (int tt = 7; tt >= 0; tt--) { h1 = av[1][tt] * h1 + bv[1][tt]; y[tt] += h1; }
    const float hb_first = h1;
    if (isctx) {
      if (t0 + 64 == T && tg == 7) p.out[O_ST + ((size_t)(bidx * 2 + l) * 2 + 0) * 512 + ch] = hf_last;
      if (t0 == 0 && tg == 0) p.out[O_ST + ((size_t)(bidx * 2 + l) * 2 + 1) * 512 + ch] = hb_first;
    }
#pragma unroll
    for (int tt = 0; tt < 8; tt++) {
      const int rw = row0 + tg * 8 + tt;
      p.GB[(size_t)NTOK * 512 + tm_off(rw, ch, 8)] = f2bf(y[tt] * bf2f(sgr[tt]));
    }
  }
}

__device__ __forceinline__ float compute_lam(const Params& p, int l, float lam_init) {
  float s1 = 0.f, s2 = 0.f;
  for (int i = 0; i < 64; i++) {
    s1 += p.lam_q1[l * 64 + i] * p.lam_k1[l * 64 + i];
    s2 += p.lam_q2[l * 64 + i] * p.lam_k2[l * 64 + i];
  }
  return expf(s1) - expf(s2) + lam_init;
}

__device__ __forceinline__ float mix_phase(const Params& p, int l, u16* smem, int vid) {
  unsigned long long tm0 = 0; float tres = 0.f; if (PROBE >= 30) tm0 = __builtin_amdgcn_s_memrealtime();
  const float lam_init = (l == 0) ? 0.2f : (0.8f - 0.6f * 0.74081822068f);
  const float lam = compute_lam(p, l, lam_init);
  constexpr int N_CL = 256, N_A = 384, N_CC = 128, N_L = 1536;
  const int G = gridDim.x;
  int start = vid;
  for (int it = start; it < N_CL; it += G) attnC_item(p, l, 128 + it, smem, lam, lam_init);
  if (PROBE == 35) tres = (float)(__builtin_amdgcn_s_memrealtime() - tm0) / 40000.f;
  start = (int)((vid + G - (N_CL % G)) % G);
  for (int it = start; it < N_A; it += G) attnA_item(p, l, it, smem);
  start = (int)((vid + G - ((N_CL + N_A) % G)) % G);
  for (int it = start; it < N_CC; it += G) attnC_item(p, l, it, smem, lam, lam_init);
  if (PROBE == 36) tres = (float)(__builtin_amdgcn_s_memrealtime() - tm0) / 40000.f;
  start = (int)((vid + G - ((N_CL + N_A + N_CC) % G)) % G);
  if (PROBE == 6) lru_run(p, l, false, start, G, (float*)smem);
  lru_run(p, l, false, start, G, (float*)smem);
  return tres;
}

__device__ __forceinline__ void lru2_phase(const Params& p, int l, u16* smem) {
  lru_run(p, l, true, blockIdx.x, gridDim.x, (float*)smem);
}

#define XB_TMO      128
#define XB_XCNT(j)  (256  + 64 * (j))
#define XB_XSUB(j)  (1280 + 64 * (j))
#define XB_XGEN(j)  (2304 + 64 * (j))
#define XB_TOP      3328
#define XB_TOPGEN   3392
#define XCD_BAR_WORDS 3456
#define XB_SPIN_CAP (1u << 18)
__device__ __forceinline__ unsigned xb_ld(unsigned* p)              { return __hip_atomic_load(p, __ATOMIC_RELAXED, __HIP_MEMORY_SCOPE_AGENT); }
__device__ __forceinline__ unsigned xb_add(unsigned* p, unsigned v) { return __hip_atomic_fetch_add(p, v, __ATOMIC_RELAXED, __HIP_MEMORY_SCOPE_AGENT); }
__device__ __forceinline__ unsigned xb_xcc_id() { return (unsigned)__builtin_amdgcn_s_getreg((3 << 11) | 20) & 0xFu; }
#define XB_SPIN(cond, bar) do { unsigned _sp = 0; while (cond) { __builtin_amdgcn_s_sleep(1); \
    if ((++_sp & 255u) == 0u) { if (xb_ld(&(bar)[XB_TMO])) break; if (_sp > XB_SPIN_CAP) { atomicAdd(&(bar)[XB_TMO], 1u); break; } } } } while (0)
struct XcdBarrier { unsigned* bar; unsigned x; volatile LAS unsigned* st; };
__device__ __forceinline__ XcdBarrier xcd_barrier_post(unsigned* bar, volatile LAS unsigned* st) {
  XcdBarrier b; b.bar = bar; b.x = xb_xcc_id(); b.st = st;
  if (threadIdx.x == 0) st[2] = xb_add(&bar[XB_XCNT(b.x)], 1u);
  return b;
}
__device__ __forceinline__ int xcd_virtual_id(const XcdBarrier& b) {
  if (threadIdx.x == 0) {
    unsigned pre = 0;
#pragma unroll
    for (unsigned j = 0; j < 16; ++j) { const unsigned c = xb_ld(&b.bar[XB_XCNT(j)]); pre += (j < b.x) ? c : 0u; }
    b.st[3] = pre + b.st[2];
  }
  __syncthreads();
  const int v = (int)b.st[3];
  __syncthreads();
  return __builtin_amdgcn_readfirstlane(v);
}
__device__ __forceinline__ void xcd_barrier_complete(unsigned* bar, unsigned x, unsigned& nloc, unsigned& nx) {
  const unsigned G = gridDim.x * gridDim.y * gridDim.z;
  unsigned sum, cnt, mine, sp = 0u;
  for (;;) {
    sum = 0u; cnt = 0u; mine = 0u;
#pragma unroll
    for (unsigned j = 0; j < 16; ++j) { const unsigned c = xb_ld(&bar[XB_XCNT(j)]); sum += c; cnt += (c > 0u) ? 1u : 0u; mine = (j == x) ? c : mine; }
    if (sum == G) break;
    __builtin_amdgcn_s_sleep(1);
    if ((++sp & 255u) == 0u) { if (xb_ld(&bar[XB_TMO])) break; if (sp > XB_SPIN_CAP) { atomicAdd(&bar[XB_TMO], 1u); break; } }
  }
  nloc = mine > 0u ? mine : 1u; nx = cnt > 0u ? cnt : 1u;
}
__device__ __forceinline__ void xcd_barrier(const XcdBarrier& b) {
  asm volatile("s_waitcnt vmcnt(0)" ::: "memory");
  __syncthreads();
  if (threadIdx.x == 0) {
    unsigned* bar = b.bar;
    __builtin_amdgcn_s_waitcnt(0);
    unsigned nloc = b.st[0], nx = b.st[1];
    if (nloc == 0u) { xcd_barrier_complete(bar, b.x, nloc, nx); b.st[0] = nloc; b.st[1] = nx; }
    const unsigned old = xb_add(&bar[XB_XSUB(b.x)], 1u);
    const unsigned gen = old / nloc;
    if (old + 1u == (gen + 1u) * nloc) {
      __builtin_amdgcn_fence(__ATOMIC_RELEASE, "agent");
      asm volatile("s_waitcnt vmcnt(0)" ::: "memory");
      const unsigned og = xb_add(&bar[XB_TOP], 1u);
      const unsigned tg = og / nx;
      if (og + 1u == (tg + 1u) * nx) xb_add(&bar[XB_TOPGEN], 1u);
      else XB_SPIN(xb_ld(&bar[XB_TOPGEN]) == tg, bar);
      __builtin_amdgcn_fence(__ATOMIC_ACQUIRE, "agent");
      xb_add(&bar[XB_XGEN(b.x)], 1u);
      asm volatile("s_waitcnt vmcnt(0)" ::: "memory");
    } else {
      XB_SPIN(xb_ld(&bar[XB_XGEN(b.x)]) == gen, bar);
      __builtin_amdgcn_fence(__ATOMIC_ACQUIRE, "agent");
      asm volatile("s_waitcnt vmcnt(0)" ::: "memory");
    }
  }
  __syncthreads();
}

typedef __attribute__((address_space(4))) const Params CParams;
__device__ __forceinline__ const Params& get_params() {
  CParams* kp = (CParams*)__builtin_amdgcn_kernarg_segment_ptr();
  asm volatile("" : "+s"(kp));
  return *(const Params*)kp;
}
__global__ void __launch_bounds__(NT, 2) fwd_kernel(Params p_unused) {
  extern __shared__ __attribute__((aligned(16))) unsigned char lds_raw[];
  u16* smem = (u16*)lds_raw;
  LAS unsigned char* lds = (LAS unsigned char*)lds_raw;
  cg::grid_group grid = cg::this_grid();
  volatile LAS unsigned* xst = (volatile LAS unsigned*)(lds + STAGE_BYTES + SPARE_BYTES);
  if (threadIdx.x == 0) { xst[0] = 0u; xst[1] = 0u; }
  __syncthreads();
  XcdBarrier xb = xcd_barrier_post(get_params().bar, xst);
  float tfrac = 0.f;
  unsigned long long tq0 = 0; if (PROBE >= 30) tq0 = __builtin_amdgcn_s_memrealtime();
  prologue_phase(get_params(), (float*)smem);
  if (PROBE == 30) tfrac = (float)(__builtin_amdgcn_s_memrealtime() - tq0) / 40000.f;
  if (get_params().bar == nullptr) grid.sync();
  xcd_barrier(xb);
  if (PROBE == 31) tfrac = (float)(__builtin_amdgcn_s_memrealtime() - tq0) / 40000.f;
  const int vid = xcd_virtual_id(xb);
  { LAS float* rl = (LAS float*)(lds + ROPE_OFF); const float* rg = get_params().rope;
    for (int i = threadIdx.x; i < 2048; i += NT) rl[i] = rg[i];
    __syncthreads(); }
  if (PROBE == 9) { for (int i = 0; i < 10; i++) xcd_barrier(xb); }
#pragma unroll 1
  for (int l = 0; l < 2; l++) {
    if (PROBE >= 30) tq0 = __builtin_amdgcn_s_memrealtime();
    norm_phase(get_params(), l);
    if (PROBE == 32 && l == 0) tfrac = (float)(__builtin_amdgcn_s_memrealtime() - tq0) / 40000.f;
    if (PROBE == 3) { norm_phase(get_params(), l); if (l == 0) { xcd_barrier(xb); prologue_phase(get_params(), (float*)smem); } }
    xcd_barrier(xb);
    {
      const Params& p = get_params();
      SchedStd S; S.nM = NTOK / 256; S.nN = INC / 256; S.nwg = S.nM * S.nN; S.G = gridDim.x; S.c = vid;
      S.A = (const char*)p.H; S.B = (const char*)(p.Wt_in + (size_t)l * INC * 1024); S.tA = (size_t)256 * 1024 * 2; S.tB = (size_t)256 * 1024 * 2;
      EpiInproj E; E.pp = &p; E.l = l; E.part = (LAS float*)(lds + STAGE_BYTES); E.ropeL = (const LAS float*)(lds + ROPE_OFF);
      { float tr = gemm_phase(lds, 1024, S, E, PROBE == 22); if (l == 0 && (PROBE == 21 || PROBE == 22)) tfrac = tr; }
      if (PROBE == 1) { __syncthreads(); gemm_phase(lds, 1024, S, E); }
    }
    xcd_barrier(xb);
    if (PROBE >= 30) tq0 = __builtin_amdgcn_s_memrealtime();
    { float tr = mix_phase(get_params(), l, smem, vid); if ((PROBE == 35 || PROBE == 36) && l == 0) tfrac = tr; }
    if (PROBE == 33 && l == 0) tfrac = (float)(__builtin_amdgcn_s_memrealtime() - tq0) / 40000.f;
    xcd_barrier(xb);
    if (PROBE >= 30) tq0 = __builtin_amdgcn_s_memrealtime();
    lru2_phase(get_params(), l, smem);
    if (PROBE == 34 && l == 0) tfrac = (float)(__builtin_amdgcn_s_memrealtime() - tq0) / 40000.f;
    xcd_barrier(xb);
    {
      const Params& p = get_params();
      SchedBranch S; S.G = gridDim.x; S.c = vid; S.P_ = (const char*)p.GB; S.W_ = (const char*)(p.Wt_br + (size_t)l * 3 * 1024 * 512);
      EpiBranch E; E.pp = &p;
      { float tr = gemm_phase(lds, 512, S, E, PROBE == 24); if (l == 0 && (PROBE == 23 || PROBE == 24)) tfrac = tr; }
      if (PROBE == 2) { __syncthreads(); gemm_phase(lds, 512, S, E); }
    }
    xcd_barrier(xb);
    {
      const Params& p = get_params();
      SchedStd S; S.nM = NTOK / 256; S.nN = 4; S.nwg = S.nM * S.nN; S.G = gridDim.x; S.c = vid;
      S.A = (const char*)p.Y; S.B = (const char*)(p.Wt_out + (size_t)l * 1024 * 1024); S.tA = (size_t)256 * 1024 * 2; S.tB = (size_t)256 * 1024 * 2;
      EpiOut E; E.pp = &p; E.l = l;
      { float tr = gemm_phase(lds, 1024, S, E, PROBE == 26); if (l == 0 && (PROBE == 25 || PROBE == 26)) tfrac = tr; }
      if (PROBE == 8 && l == 0) { __syncthreads(); gemm_phase(lds, 1024, S, E); }
    }
    if (l == 0) xcd_barrier(xb);
  }
  if (PROBE >= 20) {
    xcd_barrier(xb);
    if (blockIdx.x == 0 && threadIdx.x == 0) { float* o = get_params().out + O_X + 4194304; *o += 0.42f + 0.45f * fminf(fmaxf(tfrac, 0.f), 1.f); }
  }
}

extern "C" void kernel_launch(void* const* d_in, const int* in_sizes, int n_in, void* d_out, int out_size, void* d_ws,
                              size_t ws_size, hipStream_t stream) {
  Params p{};
  const float** ip = (const float**)&p;
  for (int i = 0; i < 34; i++) ip[i] = (const float*)d_in[i];
  p.out = (float*)d_out;
  char* w = (char*)d_ws; size_t off = 0;
  auto take = [&](size_t bytes) { char* q = w + off; off += (bytes + 255) & ~(size_t)255; return q; };
  p.Wt_in = (u16*)take((size_t)2 * INC * 1024 * 2);
  p.Wt_br = (u16*)take((size_t)6 * 1024 * 512 * 2);
  p.Wt_out = (u16*)take((size_t)2 * 1024 * 1024 * 2);
  p.Y = (u16*)take((size_t)NTOK * 1024 * 2);
  p.P = (u16*)take((size_t)NTOK * PP * 2);
  p.VtA_ctx = p.Y;
  p.VtA_lat = p.VtA_ctx + (size_t)16 * 2 * 64 * 256;
  p.VtC_ctx = p.VtA_lat + (size_t)2 * 2 * 64 * 4096;
  p.VtC_lat = p.VtC_ctx + (size_t)16 * 4 * 128 * 256;
  p.cKa = (u16*)take((size_t)2 * 2 * 512 * 128 * 2);
  p.cVtA = (u16*)take((size_t)2 * 2 * 512 * 128 * 2);
  p.cKc = (u16*)take((size_t)2 * 2 * 512 * 512 * 2);
  p.cVtC = (u16*)take((size_t)2 * 2 * 512 * 512 * 2);
  p.mod = (float*)take((size_t)2 * 3 * 3072 * 4);
  p.rope = (float*)take((size_t)2048 * 4);
  p.lruTot = (float*)take((size_t)192 * 2 * 512 * 2 * 4);
  p.Wt_lru = (u16*)take((size_t)2 * 2 * 8 * 2 * 64 * 64 * 2);
  p.bar = (unsigned*)take((size_t)XCD_BAR_WORDS * 4);
  p.GB = (u16*)take((size_t)3 * NTOK * 512 * 2);
  p.H = p.GB;
  p.MG = (unsigned*)take((size_t)(48 * 4 * 3 + 1) * 16384 * 4);
  static int grid_blocks = 0;
  if (!grid_blocks) {
    int dev = 0, cus = 0;
    hipGetDevice(&dev);
    hipDeviceGetAttribute(&cus, hipDeviceAttributeMultiprocessorCount, dev);
    hipFuncSetAttribute((const void*)fwd_kernel, hipFuncAttributeMaxDynamicSharedMemorySize, LDS_BYTES);
    int per_cu = 0;
    hipOccupancyMaxActiveBlocksPerMultiprocessor(&per_cu, (const void*)fwd_kernel, NT, LDS_BYTES);
    (void)hipGetLastError();
    grid_blocks = cus;
  }
  hipMemsetAsync(p.bar, 0, (size_t)XCD_BAR_WORDS * 4, stream);
  void* args[] = {&p};
  hipLaunchCooperativeKernel((void*)fwd_kernel, dim3(grid_blocks), dim3(NT), args, LDS_BYTES, stream);
}
```

```cpp
#include <hip/hip_runtime.h>
#include <hip/hip_cooperative_groups.h>
#include <stdint.h>
#include <math.h>
namespace cg = cooperative_groups;

typedef unsigned short u16;
typedef __attribute__((ext_vector_type(8))) short bf16x8;
typedef __attribute__((ext_vector_type(4))) short bf16x4;
typedef __attribute__((ext_vector_type(16))) float f32x16;
typedef __attribute__((ext_vector_type(4))) float f32x4;
#define LAS __attribute__((address_space(3)))

#ifndef PROBE
#define PROBE 0
#endif
#define NT 512
constexpr int NTOK = 12288, NCTX = 4096;
constexpr int INC = 7424;
constexpr int PP = 3712;
constexpr int C_QA = 0, C_KA = 512, C_GA = 640, C_XB = 1152, C_GB = 1664, C_QC = 2176, C_KC = 2688, C_GC = 3200;
constexpr int LROW = 72;
constexpr int VROW = 68;
constexpr float EPS = 1e-6f;
constexpr int STAGE_BYTES = 131072;
constexpr int SPARE_BYTES = 8192;
constexpr int ROPE_OFF = STAGE_BYTES + SPARE_BYTES + 16;
constexpr int LDS_BYTES = ROPE_OFF + 8192;

constexpr size_t O_X = 0, O_KA = 12582912, O_VA = 13631488, O_KC = 14680064, O_VC = 18874368, O_ST = 23068672;

struct Params {
  const float *x_prompt, *x_sample, *cache_a_k, *cache_a_v, *cache_c_k, *cache_c_v, *state_lru, *c, *c_ctx,
      *norm_g, *mod_w, *mod_b, *w_in, *qn_a, *kn_a, *sink_a, *conv_w, *conv_b, *lru_wa, *lru_ba, *lru_wx, *lru_bx,
      *lru_lam, *qn_c, *kn_c, *lam_q1, *lam_k1, *lam_q2, *lam_k2, *subln_c, *w_br_a, *w_br_b, *w_br_c, *w_out;
  float* out;
  u16 *Wt_in, *Wt_br, *Wt_out, *H, *P, *VtA_ctx, *VtA_lat, *VtC_ctx, *VtC_lat, *cKa, *cVtA, *cKc, *cVtC;
  float *mod, *rope, *lruTot;
  u16 *Wt_lru;
  unsigned* bar;
  u16* Y;
  u16* GB;
  unsigned* MG;
};

__device__ __forceinline__ int tid_opaque() { int t = (int)threadIdx.x; asm volatile("" : "+v"(t)); return t; }
#define TIDX tid_opaque()
__device__ __forceinline__ u16 f2bf(float f) {
  uint32_t r; asm("v_cvt_pk_bf16_f32 %0, %1, %1" : "=v"(r) : "v"(f)); return (u16)(r & 0xffffu);
}
__device__ __forceinline__ float bf2f(u16 h) { return __uint_as_float(((uint32_t)h) << 16); }
__device__ __forceinline__ uint32_t pack2(float a, float b) { uint32_t r; asm("v_cvt_pk_bf16_f32 %0, %1, %2" : "=v"(r) : "v"(a), "v"(b)); return r; }
__device__ __forceinline__ float sigmoidf_(float x) { return __builtin_amdgcn_rcpf(1.f + __expf(-x)); }
__device__ __forceinline__ float siluf_(float x) { return x * __builtin_amdgcn_rcpf(1.f + __expf(-x)); }
__device__ __forceinline__ f32x16 mfma32(bf16x8 a, bf16x8 b, f32x16 c) {
  return __builtin_amdgcn_mfma_f32_32x32x16_bf16(a, b, c, 0, 0, 0);
}
__device__ __forceinline__ float shflx(float v, int mask, int lane) {
  return __builtin_bit_cast(float, __builtin_amdgcn_ds_bpermute((lane ^ mask) << 2, __builtin_bit_cast(int, v)));
}
__device__ __forceinline__ float half_max(float v) {
  const unsigned u = __builtin_bit_cast(unsigned, v);
  auto r = __builtin_amdgcn_permlane32_swap(u, u, false, false);
  return fmaxf(__builtin_bit_cast(float, (unsigned)r[0]), __builtin_bit_cast(float, (unsigned)r[1]));
}
__device__ __forceinline__ float half_sum(float v) {
  const unsigned u = __builtin_bit_cast(unsigned, v);
  auto r = __builtin_amdgcn_permlane32_swap(u, u, false, false);
  return __builtin_bit_cast(float, (unsigned)r[0]) + __builtin_bit_cast(float, (unsigned)r[1]);
}
__device__ __forceinline__ float lo_bf(uint32_t w) { return __uint_as_float(w << 16); }
__device__ __forceinline__ float hi_bf(uint32_t w) { return __uint_as_float(w & 0xffff0000u); }

__device__ __forceinline__ size_t tm_off(int r, int k, int KT) {
  return ((size_t)((r >> 8) * KT + (k >> 6)) * 256 + (r & 255)) * 64 + (k & 63);
}
__device__ __forceinline__ void transpose_tile(const float* __restrict__ src, int spitch, u16* __restrict__ dst, int dpitch,
                               int r0, int c0, float* sm, int KT = 0) {
  const int tid = TIDX;
#pragma unroll
  for (int i = 0; i < 2; i++) {
    int c = tid + i * NT; int r = c >> 4, q = c & 15;
    float4 v = *(const float4*)(src + (size_t)(r0 + r) * spitch + c0 + q * 4);
    float* d = sm + r * 65 + q * 4;
    d[0] = v.x; d[1] = v.y; d[2] = v.z; d[3] = v.w;
  }
  __syncthreads();
  {
    int c = tid; int cc = c >> 3, q = c & 7;
    uint32_t w[4];
#pragma unroll
    for (int j = 0; j < 4; j++) w[j] = pack2(sm[(q * 8 + 2 * j) * 65 + cc], sm[(q * 8 + 2 * j + 1) * 65 + cc]);
    uint4 v; v.x = w[0]; v.y = w[1]; v.z = w[2]; v.w = w[3];
    if (KT) *(uint4*)(dst + tm_off(c0 + cc, r0 + q * 8, KT)) = v;
    else *(uint4*)(dst + (size_t)(c0 + cc) * dpitch + r0 + q * 8) = v;
  }
  __syncthreads();
}

__device__ __forceinline__ void transpose_wide(const float* __restrict__ src, int spitch, u16* __restrict__ dst,
                                               int k0, int n0, float* sm, int KT) {
  const int tid = TIDX;
  float4 v[8];
#pragma unroll
  for (int i = 0; i < 8; i++) { int c = tid + i * NT; int r = c >> 6, q = c & 63; v[i] = *(const float4*)(src + (size_t)(k0 + r) * spitch + n0 + q * 4); }
#pragma unroll
  for (int i = 0; i < 8; i++) { int c = tid + i * NT; int r = c >> 6, q = c & 63; float* d = sm + r * 257 + q * 4; d[0] = v[i].x; d[1] = v[i].y; d[2] = v[i].z; d[3] = v[i].w; }
  __syncthreads();
#pragma unroll
  for (int i = 0; i < 4; i++) {
    int c = tid + i * NT; int nn = c >> 3, q = c & 7;
    uint4 o;
    o.x = pack2(sm[(q * 8 + 0) * 257 + nn], sm[(q * 8 + 1) * 257 + nn]);
    o.y = pack2(sm[(q * 8 + 2) * 257 + nn], sm[(q * 8 + 3) * 257 + nn]);
    o.z = pack2(sm[(q * 8 + 4) * 257 + nn], sm[(q * 8 + 5) * 257 + nn]);
    o.w = pack2(sm[(q * 8 + 6) * 257 + nn], sm[(q * 8 + 7) * 257 + nn]);
    *(uint4*)(dst + tm_off(n0 + nn, k0 + q * 8, KT)) = o;
  }
  __syncthreads();
}

__device__ __forceinline__ void mod_item(const Params& p, int it, float* sm) {
  const int tid = TIDX;
  const int l = it / 48, n0 = (it % 48) * 64;
  float* sv = sm;
  float* red = sm + 3072;
  for (int e = tid; e < 3072; e += NT) {
    int v = e >> 10, k = e & 1023;
    float x = (v == 0) ? p.c_ctx[k] : p.c[(v - 1) * 1024 + k];
    sv[e] = siluf_(x);
  }
  __syncthreads();
  const int col = tid & 63, kg = tid >> 6;
  const float* w = p.mod_w + (size_t)l * 1024 * 3072 + n0 + col;
  float a0 = 0, a1 = 0, a2 = 0;
#pragma unroll 1
  for (int kb = kg * 128; kb < kg * 128 + 128; kb += 32) {
    float wv[32];
#pragma unroll
    for (int j = 0; j < 32; j++) wv[j] = w[(size_t)(kb + j) * 3072];
#pragma unroll
    for (int j = 0; j < 32; j++) { a0 += sv[kb + j] * wv[j]; a1 += sv[1024 + kb + j] * wv[j]; a2 += sv[2048 + kb + j] * wv[j]; }
  }
  red[(kg * 3 + 0) * 64 + col] = a0; red[(kg * 3 + 1) * 64 + col] = a1; red[(kg * 3 + 2) * 64 + col] = a2;
  __syncthreads();
  if (tid < 192) {
    int v = tid >> 6, c = tid & 63;
    float s = p.mod_b[l * 3072 + n0 + c];
#pragma unroll
    for (int g = 0; g < 8; g++) s += red[(g * 3 + v) * 64 + c];
    p.mod[(l * 3 + v) * 3072 + n0 + c] = s;
  }
  __syncthreads();
}

__device__ __forceinline__ void prologue_phase(const Params& p, float* sm) {
  constexpr int N_MOD = 96, N_ROPE = 1, N_WIN = 2 * 16 * 29, N_WBR = 6 * 8 * 4, N_WOUT = 2 * 16 * 4;
  constexpr int N_CK = 64 + 256, N_CVA = 4 * 16, N_CVC = 4 * 64, N_LW = 64;
  constexpr int E0 = N_MOD, E1 = E0 + N_ROPE, E2 = E1 + N_WIN, E3 = E2 + N_WBR, E4 = E3 + N_WOUT, E5 = E4 + N_CK,
                E6 = E5 + N_CVA, E7 = E6 + N_CVC, E8 = E7 + N_LW;
  const int tid = TIDX;
  for (int it = blockIdx.x; it < E8; it += gridDim.x) {
    if (it < E0) {
      mod_item(p, it, sm);
    } else if (it < E1) {
      for (int e = tid; e < 1024; e += NT) {
        int pos = e >> 4, f = e & 15;
        float inv = powf(10000.f, -(float)f / 16.f);
        float ang = (float)pos * inv;
        p.rope[e] = cosf(ang); p.rope[1024 + e] = sinf(ang);
      }
    } else if (it < E2) {
      int j = it - E1; int l = j / (16 * 29); int r = j % (16 * 29);
      int kt = r / 29, pn = r % 29;
      transpose_wide(p.w_in + (size_t)l * 1024 * INC, INC, p.Wt_in + (size_t)l * INC * 1024, kt * 64, pn * 256, sm, 16);
    } else if (it < E3) {
      int j = it - E2; int m = j / 32; int r = j % 32;
      int l = m / 3, i = m % 3;
      const float* src = (i == 0 ? p.w_br_a : (i == 1 ? p.w_br_b : p.w_br_c)) + (size_t)l * 512 * 1024;
      int kt = r / 4, pn = r % 4;
      transpose_wide(src, 1024, p.Wt_br + (size_t)m * 1024 * 512, kt * 64, pn * 256, sm, 8);
    } else if (it < E4) {
      int j = it - E3; int l = j / 64; int r = j % 64;
      int kt = r / 4, pn = r % 4;
      transpose_wide(p.w_out + (size_t)l * 1024 * 1024, 1024, p.Wt_out + (size_t)l * 1024 * 1024, kt * 64, pn * 256, sm, 16);
    } else if (it < E5) {
      int j = it - E4;
      const float* src; u16* dst; size_t off;
      if (j < 64) { src = p.cache_a_k; dst = p.cKa; off = (size_t)j * 4096; }
      else { src = p.cache_c_k; dst = p.cKc; off = (size_t)(j - 64) * 4096; }
      size_t e = off + (size_t)tid * 8;
      float4 a = *(const float4*)(src + e), b = *(const float4*)(src + e + 4);
      uint4 v; v.x = pack2(a.x, a.y); v.y = pack2(a.z, a.w); v.z = pack2(b.x, b.y); v.w = pack2(b.z, b.w);
      *(uint4*)(dst + e) = v;
    } else if (it < E6) {
      int j = it - E5; int bl = j / 16; int r = j % 16;
      int rt = r / 2, ct = r % 2;
      transpose_tile(p.cache_a_v + (size_t)bl * 512 * 128, 128, p.cVtA + (size_t)bl * 128 * 512, 512, rt * 64, ct * 64, sm);
    } else if (it < E7) {
      int j = it - E6; int bl = j / 64; int r = j % 64;
      int rt = r / 8, ct = r % 8;
      transpose_tile(p.cache_c_v + (size_t)bl * 512 * 512, 512, p.cVtC + (size_t)bl * 512 * 512, 512, rt * 64, ct * 64, sm);
    } else {
      int j = it - E7; int ldn = j >> 1, g = j & 1;
      transpose_tile((g ? p.lru_wx : p.lru_wa) + (size_t)ldn * 4096, 64, p.Wt_lru + (size_t)(ldn * 2 + g) * 4096, 64, 0, 0, sm);
    }
  }
}

__device__ __forceinline__ void norm_phase(const Params& p, int l) {
  const int tid = TIDX, lane = tid & 63, wid = tid >> 6;
  const float* g = p.norm_g + l * 1024;
  for (int it = blockIdx.x; it < NTOK / 8; it += gridDim.x) {
    int row = it * 8 + wid;
    const float* x;
    if (l == 0) x = (row < NCTX) ? p.x_prompt + (size_t)row * 1024 : p.x_sample + (size_t)(row - NCTX) * 1024;
    else x = p.out + O_X + (size_t)row * 1024;
    int v = (row < NCTX) ? 0 : 1 + (row - NCTX) / 4096;
    const float* md = p.mod + (l * 3 + v) * 3072;
    float4 xv[4], gv[4], sh[4], sc[4]; float ss = 0;
#pragma unroll
    for (int i = 0; i < 4; i++) {
      const int c = i * 256 + lane * 4;
      xv[i] = *(const float4*)(x + c);
      gv[i] = *(const float4*)(g + c); sh[i] = *(const float4*)(md + c); sc[i] = *(const float4*)(md + 1024 + c);
    }
    __builtin_amdgcn_sched_barrier(0);
#pragma unroll
    for (int i = 0; i < 4; i++) ss += xv[i].x * xv[i].x + xv[i].y * xv[i].y + xv[i].z * xv[i].z + xv[i].w * xv[i].w;
#pragma unroll
    for (int o = 32; o > 0; o >>= 1) ss += shflx(ss, o, lane);
    float rinv = rsqrtf(ss * (1.f / 1024.f) + EPS);
#pragma unroll
    for (int i = 0; i < 4; i++) {
      int c = i * 256 + lane * 4;
      float h0 = xv[i].x * rinv * gv[i].x * (1.f + sc[i].x) + sh[i].x;
      float h1 = xv[i].y * rinv * gv[i].y * (1.f + sc[i].y) + sh[i].y;
      float h2 = xv[i].z * rinv * gv[i].z * (1.f + sc[i].z) + sh[i].z;
      float h3 = xv[i].w * rinv * gv[i].w * (1.f + sc[i].w) + sh[i].w;
      uint2 o2; o2.x = pack2(h0, h1); o2.y = pack2(h2, h3);
      *(uint2*)(p.H + tm_off(row, c, 16)) = o2;
    }
  }
}

constexpr int G_BK = 64, G_HALF = 128, G_HTB = G_HALF * G_BK * 2;
__device__ __forceinline__ int lds_byte(int r, int c) {
  const int st = (r >> 4) * 2 + (c >> 5), rr = r & 15, cc = c & 31, ob = rr * 64 + cc * 2;
  return st * 1024 + (ob ^ (((ob >> 9) & 1) << 5));
}
__device__ __forceinline__ void stage_rc(int b, int& R, int& C) {
  const int st = b / 1024, sb = b % 1024, swz = sb ^ (((sb >> 9) & 1) << 5);
  R = (st >> 1) * 16 + swz / 64; C = (st & 1) * 32 + (swz % 64) / 2;
}
struct Unit { int pm, pn, seg; };

struct SchedStd {
  int nM, nN, nwg, G, c; const char* A; const char* B; size_t tA, tB;
  __device__ __forceinline__ bool next(int i, Unit& u) const {
    long L = (long)i * G + c;
    if (G == 256 && nwg == 1392 && i == 5) {
      const int cp = (c & 31) * 8 + (c >> 5);
      if (cp >= 112) return false;
      L = 1280 + cp;
    }
    if (G == 256 && nwg == 192) {
      if (i > 0 || (c & 31) >= 24) return false;
      L = (c >> 5) * 24 + (c & 31);
    }
    if (L >= nwg) return false;
    const int wgid = (int)L;
    const int nig = 8 * nN, gid = wgid / nig, fm = gid * 8, gsz = (nM - fm) < 8 ? (nM - fm) : 8;
    u.pm = fm + ((wgid % nig) % gsz); u.pn = (wgid % nig) / gsz; u.seg = 0; return true;
  }
  __device__ __forceinline__ const char* aptr(const Unit& u) const { return A + (size_t)u.pm * tA; }
  __device__ __forceinline__ const char* bptr(const Unit& u) const { return B + (size_t)u.pn * tB; }
};
struct SchedBranch {
  int G, c; const char* P_; const char* W_;
  __device__ __forceinline__ bool next(int i, Unit& u) const {
    if (G == 256) {
      if (i >= 3) return false;
      const int xcd = c >> 5, j = c & 31;
      if (j >= 24) return false;
      u.seg = i; u.pm = xcd * 6 + (j >> 2); u.pn = j & 3; return true;
    }
    const int tile = (i / 3) * G + c; if (tile >= 192) return false;
    u.seg = i % 3; u.pm = tile >> 2; u.pn = tile & 3; return true;
  }
  __device__ __forceinline__ const char* aptr(const Unit& u) const { return P_ + (size_t)((u.seg * 48 + u.pm) * 8) * 32768; }
  __device__ __forceinline__ const char* bptr(const Unit& u) const { return W_ + (size_t)((u.seg * 4 + u.pn) * 8) * 32768; }
};

template <class Epi, class Sched>
__device__ __forceinline__ float gemm_phase(LAS unsigned char* lds, const int K, const Sched& S, const Epi& E, int tmode = 0) {
  unsigned long long t_ph0 = 0, t_epi = 0; if (PROBE >= 20) t_ph0 = __builtin_amdgcn_s_memrealtime();
  const int tid = TIDX, wid = __builtin_amdgcn_readfirstlane(tid >> 6), lane = tid & 63, wr = wid >> 2, wc = wid & 3, fr = lane & 15, fq = lane >> 4;
  const int nt = K / G_BK;
  unsigned voffA[2], voffB[2];
#pragma unroll
  for (int i = 0; i < 2; ++i) { int R, C; stage_rc(tid * 16 + i * 8192, R, C);
    voffA[i] = (unsigned)(R * 64 + C) * 2u; voffB[i] = voffA[i]; }
  const size_t kstep = (size_t)32768;
  const size_t hA = (size_t)16384, hB = (size_t)16384;
  const unsigned ldsw = (unsigned)wid * 1024u;
  const int aoff = lds_byte(wr * 64 + fr, fq * 8), boff = lds_byte(wc * 32 + fr, fq * 8);
#define G_SA(b, h) (((b) * 2 + (h)) * G_HTB)
#define G_SB(b, h) ((4 + (b) * 2 + (h)) * G_HTB)
#define G_STAGE(bufoff, gbase, voff) do { _Pragma("unroll") for (int _i = 0; _i < 2; ++_i) \
    __builtin_amdgcn_global_load_lds((const unsigned*)((const char*)(gbase) + (voff)[_i]), (LAS unsigned*)(lds + (bufoff) + ldsw + _i * 8192), 16, 0, 0); } while (0)
#define G_LDA(dst, b, h) do { _Pragma("unroll") for (int m = 0; m < 4; ++m) _Pragma("unroll") for (int k = 0; k < 2; ++k) dst[m][k] = *(const LAS bf16x8*)(lds + G_SA(b, h) + aoff + m * 2048 + k * 1024); } while (0)
#define G_LDB(dst, b, h) do { _Pragma("unroll") for (int n = 0; n < 2; ++n) _Pragma("unroll") for (int k = 0; k < 2; ++k) dst[n][k] = *(const LAS bf16x8*)(lds + G_SB(b, h) + boff + n * 2048 + k * 1024); } while (0)
#define G_MMA(ai, bj, At, Bt) do { __builtin_amdgcn_s_setprio(1); _Pragma("unroll") for (int m = 0; m < 4; ++m) _Pragma("unroll") for (int n = 0; n < 2; ++n) _Pragma("unroll") for (int k = 0; k < 2; ++k) \
    acc[ai][bj][m][n] = __builtin_amdgcn_mfma_f32_16x16x32_bf16(Bt[n][k], At[m][k], acc[ai][bj][m][n], 0, 0, 0); __builtin_amdgcn_s_setprio(0); } while (0)
#define G_WAIT_V(n) asm volatile("s_waitcnt vmcnt(" #n ")" ::: "memory")
#define G_WAIT_L(n) asm volatile("s_waitcnt lgkmcnt(" #n ")" ::: "memory")
#define G_BAR __builtin_amdgcn_s_barrier()
#define G_SCHED __builtin_amdgcn_sched_barrier(0)
  Unit cur, nxt; int ui = 0;
  if (!S.next(0, cur)) return 0.f;
  f32x4 acc[2][2][4][2];
#pragma unroll
  for (int a = 0; a < 2; ++a)
#pragma unroll
    for (int b = 0; b < 2; ++b)
#pragma unroll
      for (int m = 0; m < 4; ++m)
#pragma unroll
        for (int n = 0; n < 2; ++n) acc[a][b][m][n] = (f32x4){0.f, 0.f, 0.f, 0.f};
  bf16x8 At[4][2], B0[2][2], B1[2][2];
  const char* cA = S.aptr(cur); const char* cB = S.bptr(cur);
  G_STAGE(G_SB(0, 0), cB, voffB); G_STAGE(G_SA(0, 0), cA, voffA); G_STAGE(G_SB(0, 1), cB + hB, voffB); G_STAGE(G_SA(0, 1), cA + hA, voffA);
  if (wr == 1) G_BAR;
  G_WAIT_V(4); G_BAR;
  G_STAGE(G_SB(1, 0), cB + kstep, voffB); G_STAGE(G_SA(1, 0), cA + kstep, voffA); G_STAGE(G_SB(1, 1), cB + hB + kstep, voffB);
  G_WAIT_V(6); G_BAR;
  for (;;) {
    const bool has_next = S.next(ui + 1, nxt);
    const char* nA = has_next ? S.aptr(nxt) : cA; const char* nB = has_next ? S.bptr(nxt) : cB;
    for (int t = 0; t < nt; t += 2) {
      const bool last = (t == nt - 2);
      const char* a1 = cA + (size_t)(t + 1) * kstep;
      const char* a2 = last ? nA : cA + (size_t)(t + 2) * kstep; const char* b2 = last ? nB : cB + (size_t)(t + 2) * kstep;
      const char* a3 = a2 + kstep; const char* b3 = b2 + kstep;
      G_LDB(B0, 0, 0); G_SCHED; G_LDA(At, 0, 0); G_STAGE(G_SA(1, 1), a1 + hA, voffA);
      G_WAIT_L(8); G_BAR; G_WAIT_L(0); G_MMA(0, 0, At, B0); G_BAR; G_SCHED;
      G_LDB(B1, 0, 1); G_STAGE(G_SB(0, 0), b2, voffB);
      G_BAR; G_WAIT_L(0); G_MMA(0, 1, At, B1); G_BAR;
      G_LDA(At, 0, 1); G_STAGE(G_SA(0, 0), a2, voffA);
      G_BAR; G_WAIT_L(0); G_MMA(1, 0, At, B0); G_BAR; G_SCHED;
      G_STAGE(G_SB(0, 1), b2 + hB, voffB);
      G_WAIT_V(6); G_BAR; G_MMA(1, 1, At, B1); G_BAR;
      G_LDB(B0, 1, 0); G_SCHED; G_LDA(At, 1, 0); G_STAGE(G_SA(0, 1), a2 + hA, voffA);
      G_WAIT_L(8); G_BAR; G_WAIT_L(0); G_MMA(0, 0, At, B0); G_BAR; G_SCHED;
      G_LDB(B1, 1, 1); G_STAGE(G_SB(1, 0), b3, voffB);
      G_BAR; G_WAIT_L(0); G_MMA(0, 1, At, B1); G_BAR;
      G_LDA(At, 1, 1); G_STAGE(G_SA(1, 0), a3, voffA);
      G_BAR; G_WAIT_L(0); G_MMA(1, 0, At, B0); G_BAR; G_SCHED;
      G_STAGE(G_SB(1, 1), b3 + hB, voffB);
      G_WAIT_V(6); G_BAR; G_MMA(1, 1, At, B1); G_BAR;
    }
    unsigned long long t_e0 = 0; if (PROBE >= 20) t_e0 = __builtin_amdgcn_s_memrealtime();
    const bool reset = E(acc, cur, wr, wc, fr, fq);
    if (PROBE >= 20) { asm volatile("s_waitcnt vmcnt(0)" ::: "memory"); t_epi += __builtin_amdgcn_s_memrealtime() - t_e0; }
    if (!has_next) break;
    if (reset) {
#pragma unroll
      for (int a = 0; a < 2; ++a)
#pragma unroll
        for (int b = 0; b < 2; ++b)
#pragma unroll
          for (int m = 0; m < 4; ++m)
#pragma unroll
            for (int n = 0; n < 2; ++n) acc[a][b][m][n] = (f32x4){0.f, 0.f, 0.f, 0.f};
    }
    cur = nxt; cA = nA; cB = nB; ++ui;
  }
  G_WAIT_V(0);
  if (wr == 0) G_BAR;
  G_BAR;
  float tres = 0.f;
  if (PROBE >= 20) {
    const unsigned long long tot = __builtin_amdgcn_s_memrealtime() - t_ph0;
    tres = (tmode == 0) ? (float)t_epi / (float)tot : (float)tot / 40000.f;
  }
#undef G_SA
#undef G_SB
#undef G_STAGE
#undef G_LDA
#undef G_LDB
#undef G_MMA
#undef G_WAIT_V
#undef G_WAIT_L
#undef G_BAR
#undef G_SCHED
  return tres;
}

struct EpiInproj {
  const Params* pp; int l; LAS float* part; const LAS float* ropeL;
  __device__ __forceinline__ bool operator()(f32x4 (&acc)[2][2][4][2], const Unit& u, int wr, int wc, int fr, int fq) const {
    const Params& p = *pp;
    asm volatile("" : "+v"(fr), "+v"(fq));
    const int lane = fr + 16 * fq; (void)lane;
    const int oc0 = u.pn * 256;
    const bool isctx = u.pm < 16;
    const bool qkU = (oc0 < 768) || (oc0 >= 2304 && oc0 < 3328);
    float rinv[2][4][2];
    if (qkU) {
#pragma unroll
      for (int ai = 0; ai < 2; ai++)
#pragma unroll
        for (int m = 0; m < 4; m++)
#pragma unroll
          for (int bj = 0; bj < 2; bj++) {
            f32x4 a = acc[ai][bj][m][0], b = acc[ai][bj][m][1];
            float ss = a[0] * a[0] + a[1] * a[1] + a[2] * a[2] + a[3] * a[3] + b[0] * b[0] + b[1] * b[1] + b[2] * b[2] + b[3] * b[3];
            ss += shflx(ss, 16, lane); ss += shflx(ss, 32, lane);
            rinv[ai][m][bj] = ss;
            if (fq == 0) part[((ai * 128 + wr * 64 + m * 16 + fr) * 2 + bj) * 4 + wc] = ss;
          }
      asm volatile("s_waitcnt lgkmcnt(0)" ::: "memory");
      __builtin_amdgcn_s_barrier();
      asm volatile("" ::: "memory");
#pragma unroll
      for (int ai = 0; ai < 2; ai++)
#pragma unroll
        for (int m = 0; m < 4; m++)
#pragma unroll
          for (int bj = 0; bj < 2; bj++) {
            float o = part[((ai * 128 + wr * 64 + m * 16 + fr) * 2 + bj) * 4 + (wc ^ 1)];
            rinv[ai][m][bj] = rsqrtf((rinv[ai][m][bj] + o) * (1.f / 64.f) + EPS);
          }
    }
#pragma unroll
    for (int bj = 0; bj < 2; bj++) {
      const int oc = oc0 + bj * 128;
      if (oc == 640 || (oc >= 3328 && oc < 3840)) {
        const bool isA = (oc == 640);
        const int cb = isA ? 0 : (oc - 3328);
        const int nvec = isA ? 128 : 512;
#pragma unroll
        for (int ai = 0; ai < 2; ai++)
#pragma unroll
          for (int m = 0; m < 4; m++) {
            const int row = u.pm * 256 + ai * 128 + wr * 64 + m * 16 + fr;
            int b, t, T; u16* vt;
            if (isctx) { b = row >> 8; t = row & 255; T = 256; vt = isA ? p.VtA_ctx : p.VtC_ctx; }
            else { int rr = row - NCTX; b = rr >> 12; t = rr & 4095; T = 4096; vt = isA ? p.VtA_lat : p.VtC_lat; }
#pragma unroll
            for (int n = 0; n < 2; n++) {
              const int d = cb + wc * 32 + n * 16 + fq * 4;
              f32x4 v = acc[ai][bj][m][n];
#pragma unroll
              for (int j = 0; j < 4; j++) vt[((size_t)b * nvec + d + j) * T + t] = f2bf(v[j]);
              if (isctx) {
                float* o = p.out + (isA ? O_VA : O_VC) + ((size_t)(b * 2 + l) * 256 + t) * nvec + d;
                *(f32x4*)o = v;
              }
            }
          }
      } else {
        const int pc = (oc < 640) ? oc : (oc < 3328 ? oc - 128 : oc - 640);
        const bool is_qa = oc < 512, is_ka = (oc == 512);
        const bool is_qc = (oc >= 2304 && oc < 2816), is_kc = (oc >= 2816 && oc < 3328);
        if (is_qa || is_ka || is_qc || is_kc) {
          const float* gn = (is_qa ? p.qn_a : is_ka ? p.kn_a : is_qc ? p.qn_c : p.kn_c) + l * 64 + (wc & 1) * 32 + fq * 4;
          const f32x4 g0 = *(const f32x4*)gn, g1 = *(const f32x4*)(gn + 16);
          const float qs = (is_qa || is_qc) ? 0.18033688011112042f : 1.f;
#pragma unroll
          for (int ai = 0; ai < 2; ai++)
#pragma unroll
            for (int m = 0; m < 4; m++) {
              const int row = u.pm * 256 + ai * 128 + wr * 64 + m * 16 + fr;
              const float ri = rinv[ai][m][bj];
              f32x4 x1 = acc[ai][bj][m][0] * ri * g0, x2 = acc[ai][bj][m][1] * ri * g1;
              if (!isctx) {
                const int t = (row - NCTX) & 4095;
                const int pos = (wc & 1) ? (t & 63) : (t >> 6);
                const f32x4 cs = *(const LAS f32x4*)(ropeL + pos * 16 + fq * 4), sn = *(const LAS f32x4*)(ropeL + 1024 + pos * 16 + fq * 4);
                f32x4 y1 = x1 * cs - x2 * sn, y2 = x2 * cs + x1 * sn;
                x1 = y1; x2 = y2;
              } else if (is_ka || is_kc) {
                const int b = row >> 8, t = row & 255;
                float* o = is_ka ? p.out + O_KA + ((size_t)(b * 2 + l) * 256 + t) * 128 + wc * 32 + fq * 4
                                 : p.out + O_KC + ((size_t)(b * 2 + l) * 256 + t) * 512 + (oc - 2816) + wc * 32 + fq * 4;
                *(f32x4*)o = x1; *(f32x4*)(o + 16) = x2;
              }
              x1 = x1 * qs; x2 = x2 * qs;
              u16* po = p.P + (size_t)row * PP + pc + wc * 32 + fq * 4;
              *(uint2*)po = make_uint2(pack2(x1[0], x1[1]), pack2(x1[2], x1[3]));
              *(uint2*)(po + 16) = make_uint2(pack2(x2[0], x2[1]), pack2(x2[2], x2[3]));
            }
        } else {
          const int mode = (oc >= 4352) ? 2 : ((oc >= 1280 && oc < 1792) ? 0 : 1);
          if (mode == 2) {
            const int pj = u.pn - 17, seg = pj >> 2, pn4 = pj & 3;
            unsigned* mg = p.MG + ((size_t)((u.pm * 4 + pn4) * 3 + seg) * 8 + (wr * 4 + wc)) * 2048 + lane;
#pragma unroll
            for (int ai = 0; ai < 2; ai++)
#pragma unroll
              for (int m = 0; m < 4; m++)
#pragma unroll
                for (int n = 0; n < 2; n++) {
                  f32x4 v = acc[ai][bj][m][n];
                  const unsigned q0 = (unsigned)(sigmoidf_(v[0]) * 254.f + 1.5f), q1 = (unsigned)(sigmoidf_(v[1]) * 254.f + 1.5f);
                  const unsigned q2 = (unsigned)(sigmoidf_(v[2]) * 254.f + 1.5f), q3 = (unsigned)(sigmoidf_(v[3]) * 254.f + 1.5f);
                  mg[(((ai * 4 + m) * 2 + bj) * 2 + n) * 64] = q0 | (q1 << 8) | (q2 << 16) | (q3 << 24);
                }
          } else
#pragma unroll
          for (int ai = 0; ai < 2; ai++)
#pragma unroll
            for (int m = 0; m < 4; m++) {
              const int row = u.pm * 256 + ai * 128 + wr * 64 + m * 16 + fr;
              u16* po = p.P + (size_t)row * PP + pc + wc * 32 + fq * 4;
#pragma unroll
              for (int n = 0; n < 2; n++) {
                f32x4 v = acc[ai][bj][m][n];
                if (mode == 1) { v[0] = siluf_(v[0]); v[1] = siluf_(v[1]); v[2] = siluf_(v[2]); v[3] = siluf_(v[3]); }
                else if (mode == 2) { v[0] = sigmoidf_(v[0]); v[1] = sigmoidf_(v[1]); v[2] = sigmoidf_(v[2]); v[3] = sigmoidf_(v[3]); }
                *(uint2*)(po + n * 16) = make_uint2(pack2(v[0], v[1]), pack2(v[2], v[3]));
              }
            }
        }
      }
    }
    return true;
  }
};

struct EpiBranch {
  const Params* pp;
  __device__ __forceinline__ bool operator()(f32x4 (&acc)[2][2][4][2], const Unit& u, int wr, int wc, int fr, int fq) const {
    const Params& p = *pp;
    asm volatile("" : "+v"(fr), "+v"(fq));
    const int lane = fr + 16 * fq;
    const int seg = u.seg;
    const unsigned* mg = p.MG + ((size_t)((u.pm * 4 + u.pn) * 3 + seg) * 8 + (wr * 4 + wc)) * 2048 + lane;
    const float sel = (seg < 2) ? 1.f : 0.f;
#pragma unroll
    for (int hq = 0; hq < 4; hq++) {
      unsigned a[8], b[8];
#pragma unroll
      for (int q = 0; q < 8; q++) { a[q] = mg[(hq * 8 + q) * 64]; b[q] = mg[(hq * 8 + q) * 64 + 8 * 2048]; }
      __builtin_amdgcn_sched_barrier(0);
#pragma unroll
      for (int q = 0; q < 8; q++) {
        const int ai = hq >> 1, m = (hq & 1) * 2 + (q >> 2), bj = (q >> 1) & 1, n = q & 1;
        f32x4 f = {(float)(a[q] & 255u), (float)((a[q] >> 8) & 255u), (float)((a[q] >> 16) & 255u), (float)(a[q] >> 24)};
        f32x4 g = {(float)(b[q] & 255u), (float)((b[q] >> 8) & 255u), (float)((b[q] >> 16) & 255u), (float)(b[q] >> 24)};
        g = g * sel + (1.f - sel) * 255.f;
        f[0] *= __builtin_amdgcn_rcpf(g[0]); f[1] *= __builtin_amdgcn_rcpf(g[1]); f[2] *= __builtin_amdgcn_rcpf(g[2]); f[3] *= __builtin_amdgcn_rcpf(g[3]);
        acc[ai][bj][m][n] = acc[ai][bj][m][n] * f;
      }
    }
    if (seg < 2) return false;
#pragma unroll
    for (int ai = 0; ai < 2; ai++)
#pragma unroll
      for (int m = 0; m < 4; m++) {
        const int row = u.pm * 256 + ai * 128 + wr * 64 + m * 16 + fr;
#pragma unroll
        for (int bj = 0; bj < 2; bj++)
#pragma unroll
          for (int n = 0; n < 2; n++) {
            const int col = u.pn * 256 + bj * 128 + wc * 32 + n * 16 + fq * 4;
            const f32x4 v = acc[ai][bj][m][n];
            *(uint2*)(p.Y + tm_off(row, col, 16)) = make_uint2(pack2(v[0], v[1]), pack2(v[2], v[3]));
          }
      }
    return true;
  }
};

struct EpiOut {
  const Params* pp; int l;
  __device__ __forceinline__ bool operator()(f32x4 (&acc)[2][2][4][2], const Unit& u, int wr, int wc, int fr, int fq) const {
    const Params& p = *pp;
    asm volatile("" : "+v"(fr), "+v"(fq));
    const int v = (u.pm < 16) ? 0 : 1 + (u.pm - 16) / 16;
    const float* gt = p.mod + (l * 3 + v) * 3072 + 2048 + u.pn * 256 + wc * 32 + fq * 4;
    const float* xsrc = (l == 0) ? ((u.pm < 16) ? p.x_prompt + (size_t)u.pm * 256 * 1024 : p.x_sample + (size_t)(u.pm - 16) * 256 * 1024)
                                 : p.out + O_X + (size_t)u.pm * 256 * 1024;
    float* odst = p.out + O_X + (size_t)u.pm * 256 * 1024;
    const int cbase = u.pn * 256 + wc * 32 + fq * 4;
    f32x4 gv[2][2];
#pragma unroll
    for (int bj = 0; bj < 2; bj++)
#pragma unroll
      for (int n = 0; n < 2; n++) gv[bj][n] = *(const f32x4*)(gt + bj * 128 + n * 16);
#pragma unroll
    for (int ai = 0; ai < 2; ai++)
#pragma unroll
      for (int mh = 0; mh < 2; mh++) {
        f32x4 xv[2][2][2];
#pragma unroll
        for (int mm = 0; mm < 2; mm++)
#pragma unroll
          for (int bj = 0; bj < 2; bj++)
#pragma unroll
            for (int n = 0; n < 2; n++)
              xv[mm][bj][n] = *(const f32x4*)(xsrc + (size_t)(ai * 128 + wr * 64 + (mh * 2 + mm) * 16 + fr) * 1024 + cbase + bj * 128 + n * 16);
#pragma unroll
        for (int mm = 0; mm < 2; mm++)
#pragma unroll
          for (int bj = 0; bj < 2; bj++)
#pragma unroll
            for (int n = 0; n < 2; n++)
              *(f32x4*)(odst + (size_t)(ai * 128 + wr * 64 + (mh * 2 + mm) * 16 + fr) * 1024 + cbase + bj * 128 + n * 16) = xv[mm][bj][n] + gv[bj][n] * acc[ai][bj][mh * 2 + mm][n];
      }
    return true;
  }
};

template <bool MASK>
__device__ __forceinline__ void fs_scores(const u16* Ks, const bf16x8 (&qf)[4], f32x16 (&s)[2], int lane, int kpos0, int qpos, int T) {
  const int r = lane & 31, h = lane >> 5;
  {
    bf16x8 kf[2][4];
#pragma unroll
    for (int sub = 0; sub < 2; sub++)
#pragma unroll
      for (int ks = 0; ks < 4; ks++) kf[sub][ks] = *(const bf16x8*)(Ks + (sub * 32 + r) * LROW + ks * 16 + h * 8);
    __builtin_amdgcn_sched_barrier(0);
#pragma unroll
    for (int sub = 0; sub < 2; sub++) {
#pragma unroll
      for (int e = 0; e < 16; e++) s[sub][e] = 0.f;
#pragma unroll
      for (int ks = 0; ks < 4; ks++) s[sub] = mfma32(kf[sub][ks], qf[ks], s[sub]);
    }
  }
  if (MASK) {
#pragma unroll
    for (int sub = 0; sub < 2; sub++)
#pragma unroll
      for (int e = 0; e < 16; e++) {
        int kp = kpos0 + sub * 32 + (e & 3) + 8 * (e >> 2) + 4 * h;
        int dlt = kp - qpos;
        bool ok = (kp >= 0) && (kp < T) && (dlt <= 128) && (dlt >= -128);
        if (!ok) s[sub][e] = -INFINITY;
      }
  }
}
template <int DV>
__device__ __forceinline__ void fs_softmax(f32x16 (&s)[2], float& m, float& l, f32x16 (&o)[DV / 32], bf16x8 (&pf)[2][2], int lane) {
  float mx = s[0][0];
#pragma unroll
  for (int sub = 0; sub < 2; sub++)
#pragma unroll
    for (int e = 0; e < 16; e++) mx = fmaxf(mx, s[sub][e]);
  mx = half_max(mx);
  const bool grow = mx > m;
  const float mn = grow ? mx : m;
  float sum = 0.f;
#pragma unroll
  for (int sub = 0; sub < 2; sub++)
#pragma unroll
    for (int e = 0; e < 16; e++) { float pv = __builtin_amdgcn_exp2f(s[sub][e] - mn); s[sub][e] = pv; sum += pv; }
  sum = half_sum(sum);
  if (__builtin_amdgcn_ballot_w64(grow) != 0ull) {
    const float alpha = __builtin_amdgcn_exp2f(m - mn);
    l *= alpha;
#pragma unroll
    for (int ds = 0; ds < DV / 32; ds++)
#pragma unroll
      for (int e = 0; e < 16; e++) o[ds][e] *= alpha;
  }
  l += sum; m = mn;
  typedef __attribute__((ext_vector_type(4))) unsigned u32x4;
#pragma unroll
  for (int sub = 0; sub < 2; sub++)
#pragma unroll
    for (int st = 0; st < 2; st++) {
      u32x4 pw;
#pragma unroll
      for (int j = 0; j < 4; j++) pw[j] = pack2(s[sub][8 * st + 2 * j], s[sub][8 * st + 2 * j + 1]);
      pf[sub][st] = __builtin_bit_cast(bf16x8, pw);
    }
}
template <int DV>
__device__ __forceinline__ void fs_pv(const bf16x8 (&pf)[2][2], const u16* Vts, f32x16 (&o)[DV / 32], int lane) {
  const int r = lane & 31, h = lane >> 5;
#pragma unroll
  for (int sub = 0; sub < 2; sub++) {
    bf16x8 vf[2][DV / 32];
#pragma unroll
    for (int st = 0; st < 2; st++)
#pragma unroll
      for (int ds = 0; ds < DV / 32; ds++) {
        const u16* vp = Vts + (ds * 32 + r) * VROW + sub * 32 + 16 * st + 4 * h;
        bf16x4 lo = *(const bf16x4*)vp, hi = *(const bf16x4*)(vp + 8);
        vf[st][ds] = __builtin_shufflevector(lo, hi, 0, 1, 2, 3, 4, 5, 6, 7);
      }
    __builtin_amdgcn_sched_barrier(0);
#pragma unroll
    for (int st = 0; st < 2; st++)
#pragma unroll
      for (int ds = 0; ds < DV / 32; ds++) o[ds] = mfma32(vf[st][ds], pf[sub][st], o[ds]);
    __builtin_amdgcn_sched_barrier(0);
  }
}

__device__ __forceinline__ uint4 ld_k(const u16* __restrict__ src, size_t pitch, int r0, int nrows, int c) {
  int row = c >> 3, kc = c & 7; int rr = r0 + row;
  const bool ok = (rr >= 0 && rr < nrows);
  const int rc = rr < 0 ? 0 : (rr >= nrows ? nrows - 1 : rr);
  uint4 v = *(const uint4*)(src + (size_t)rc * pitch + kc * 8);
  if (!ok) v = make_uint4(0, 0, 0, 0);
  return v;
}
__device__ __forceinline__ void st_k(u16* dst, int c, uint4 v) { *(uint4*)(dst + (c >> 3) * LROW + (c & 7) * 8) = v; }
__device__ __forceinline__ uint4 ld_vt(const u16* __restrict__ src, int T, int k0, int c) {
  int d = c >> 3, kc = c & 7; int k = k0 + kc * 8;
  const bool ok = (k >= 0 && k < T);
  const int kk = k < 0 ? 0 : (k >= T ? T - 8 : k);
  uint4 v = *(const uint4*)(src + (size_t)d * T + kk);
  if (!ok) v = make_uint4(0, 0, 0, 0);
  return v;
}
__device__ __forceinline__ void st_vt(u16* dst, int c, uint4 v) {
  uint2* q = (uint2*)(dst + (c >> 3) * VROW + (c & 7) * 8);
  q[0] = make_uint2(v.x, v.y); q[1] = make_uint2(v.z, v.w);
}

constexpr int A_BUF = 64 * LROW + 64 * VROW;
__device__ __forceinline__ void attnA_item(const Params& p, int l, int it, u16* sm, bool dry = false) {
  const int tid = TIDX, lane = tid & 63, wid = tid >> 6;
  const int r = lane & 31, h = lane >> 5;
  const bool isctx = it < 128;
  int b, kvh, qb, T, rowbase; const u16* VtBase;
  if (isctx) { b = it >> 3; kvh = (it >> 2) & 1; qb = it & 3; T = 256; rowbase = b * 256;
    VtBase = p.VtA_ctx + ((size_t)(b * 2 + kvh) * 64) * 256; }
  else { int j = it - 128; b = j >> 7; kvh = (j >> 6) & 1; qb = j & 63; T = 4096; rowbase = NCTX + b * 4096;
    VtBase = p.VtA_lat + ((size_t)(b * 2 + kvh) * 64) * 4096; }
  const int qblk = qb * 64;
  const int q0 = qblk + (wid >> 2) * 32;
  const int head = kvh * 4 + (wid & 3);
  const size_t prow = (size_t)(rowbase + q0 + r) * PP;
  bf16x8 qf[4];
#pragma unroll
  for (int ks = 0; ks < 4; ks++) qf[ks] = *(const bf16x8*)(p.P + prow + C_QA + head * 64 + ks * 16 + h * 8);
  float m = p.sink_a[l * 8 + head] * 1.4426950408889634f, ls = 1.f;
  f32x16 o[2];
#pragma unroll
  for (int ds = 0; ds < 2; ds++)
#pragma unroll
    for (int e = 0; e < 16; e++) o[ds][e] = 0.f;
  const u16* Kbase = p.P + (size_t)rowbase * PP + C_KA + kvh * 64;
  const u16* cK = p.cKa + ((size_t)(b * 2 + l) * 512) * 128 + kvh * 64;
  const u16* cVt = p.cVtA + ((size_t)((b * 2 + l) * 2 + kvh) * 64) * 512;
  const int qpos = q0 + r;
  int i_lo = 0, nW, ntile;
  if (isctx) { nW = 4; ntile = 4; }
  else {
    i_lo = (qblk < 128) ? (128 - qblk) / 64 : 0;
    int i_hi = (T - qblk + 128) / 64; if (i_hi > 5) i_hi = 5;
    nW = i_hi - i_lo; ntile = nW + 8;
  }
  uint4 rk, rv;
  auto tile_load = [&](int t) {
    if (t < nW) {
      int k0 = isctx ? t * 64 : qblk - 128 + 64 * (i_lo + t);
      rk = ld_k(Kbase, PP, k0, T, tid); rv = ld_vt(VtBase, T, k0, tid);
    } else {
      int kt = t - nW;
      rk = ld_k(cK, 128, kt * 64, 512, tid); rv = ld_vt(cVt, 512, kt * 64, tid);
    }
  };
  auto KB = [&](int i) { return sm + (i & 1) * (64 * LROW); };
  auto VB = [&](int i) { return sm + 2 * 64 * LROW + (i % 3) * (64 * VROW); };
  const bool lag = (wid >> 2) != 0;
  __syncthreads();
  tile_load(0);
  st_k(KB(0), tid, rk); st_vt(VB(0), tid, rv);
  __syncthreads();
  bf16x8 pf[2][2];
  for (int t = 0; t <= ntile; t++) {
    const bool more = t + 1 < ntile;
    if (more) tile_load(t + 1);
    if (lag && t > 0) fs_pv<64>(pf, VB(t - 1), o, lane);
    if (t < ntile) {
      f32x16 sc[2];
      bool needmask = false;
      if (!isctx && t < nW) {
        const int k0 = qblk - 128 + 64 * (i_lo + t);
        needmask = (k0 - q0 < -97) || (k0 - q0 > 65) || (k0 < 0) || (k0 + 64 > T);
      }
      if (needmask) fs_scores<true>(KB(t), qf, sc, lane, qblk - 128 + 64 * (i_lo + t), qpos, T);
      else fs_scores<false>(KB(t), qf, sc, lane, 0, 0, T);
      fs_softmax<64>(sc, m, ls, o, pf, lane);
      if (!lag) fs_pv<64>(pf, VB(t), o, lane);
    }
    if (more) { st_k(KB(t + 1), tid, rk); st_vt(VB(t + 1), tid, rv); }
    __syncthreads();
  }
  const float inv = __builtin_amdgcn_rcpf(ls);
  {
    uint2 gv[2][4];
#pragma unroll
    for (int ds = 0; ds < 2; ds++)
#pragma unroll
      for (int g = 0; g < 4; g++) gv[ds][g] = *(const uint2*)(p.P + prow + C_GA + head * 64 + ds * 32 + 8 * g + 4 * h);
    __builtin_amdgcn_sched_barrier(0);
#pragma unroll
    for (int ds = 0; ds < 2; ds++)
#pragma unroll
      for (int g = 0; g < 4; g++) {
        int d = ds * 32 + 8 * g + 4 * h;
        uint2 ov;
        ov.x = pack2(o[ds][4 * g] * inv * lo_bf(gv[ds][g].x), o[ds][4 * g + 1] * inv * hi_bf(gv[ds][g].x));
        ov.y = pack2(o[ds][4 * g + 2] * inv * lo_bf(gv[ds][g].y), o[ds][4 * g + 3] * inv * hi_bf(gv[ds][g].y));
        *(uint2*)(p.GB + tm_off(rowbase + q0 + r, head * 64 + d, 8)) = ov;
      }
  }
}

constexpr int C_BUF = 128 * LROW + 128 * VROW;
__device__ __forceinline__ void attnC_item(const Params& p, int l, int it, u16* sm, float lam, float lam_init, bool dry = false) {
  const int tid = TIDX, lane = tid & 63, wid = tid >> 6;
  const int r = lane & 31, h = lane >> 5;
  const bool isctx = it < 128;
  int b, hd, qb, T, rowbase; const u16* VtBase;
  if (isctx) { b = it >> 3; hd = (it >> 1) & 3; qb = it & 1; T = 256; rowbase = b * 256;
    VtBase = p.VtC_ctx + ((size_t)(b * 4 + hd) * 128) * 256; }
  else { int j = it - 128; b = j >> 7; hd = (j >> 5) & 3; qb = j & 31; T = 4096; rowbase = NCTX + b * 4096;
    VtBase = p.VtC_lat + ((size_t)(b * 4 + hd) * 128) * 4096; }
  const int qg = wid & 3, map = wid >> 2;
  const int q0 = qb * 128 + qg * 32;
  const size_t prow = (size_t)(rowbase + q0 + r) * PP;
  bf16x8 qf[4];
#pragma unroll
  for (int ks = 0; ks < 4; ks++) qf[ks] = *(const bf16x8*)(p.P + prow + C_QC + hd * 128 + map * 64 + ks * 16 + h * 8);
  float m = -1e30f, ls = 0.f;
  f32x16 o[4];
#pragma unroll
  for (int ds = 0; ds < 4; ds++)
#pragma unroll
    for (int e = 0; e < 16; e++) o[ds][e] = 0.f;
  const u16* Kbase = p.P + (size_t)rowbase * PP + C_KC + hd * 128;
  const u16* cK = p.cKc + ((size_t)(b * 2 + l) * 512) * 512 + hd * 128;
  const u16* cVt = p.cVtC + ((size_t)((b * 2 + l) * 4 + hd) * 128) * 512;
  const int nW = T / 64, ntile = isctx ? nW : nW + 8;
  uint4 rk0, rk1, rv0, rv1;
  const u16* pk = Kbase + (size_t)(tid >> 3) * PP + (tid & 7) * 8;
  const u16* pv0 = VtBase + (size_t)(tid >> 3) * T + (tid & 7) * 8;
  const u16* pv1 = VtBase + (size_t)((tid + NT) >> 3) * T + (tid & 7) * 8;
  size_t kstride = (size_t)64 * PP;
  auto tile_load = [&](int t) {
    if (t == nW) {
      pk = cK + (size_t)(tid >> 3) * 512 + (tid & 7) * 8;
      pv0 = cVt + (size_t)(tid >> 3) * 512 + (tid & 7) * 8;
      pv1 = cVt + (size_t)((tid + NT) >> 3) * 512 + (tid & 7) * 8;
      kstride = (size_t)64 * 512;
    }
    rk0 = *(const uint4*)pk; rk1 = *(const uint4*)(pk + 64);
    rv0 = *(const uint4*)pv0; rv1 = *(const uint4*)pv1;
    pk += kstride; pv0 += 64; pv1 += 64;
  };
  auto KB = [&](int i) { return sm + (i & 1) * (128 * LROW); };
  auto VB = [&](int i) { return sm + 2 * 128 * LROW + (i % 3) * (128 * VROW); };
  auto tile_store = [&](int i) {
    u16* kd = KB(i); u16* vd = VB(i);
    st_k(kd, tid, rk0); st_k(kd + 64 * LROW, tid, rk1);
    st_vt(vd, tid, rv0); st_vt(vd, tid + NT, rv1);
  };
  const bool lag = map != 0;
  __syncthreads();
  tile_load(0);
  tile_store(0);
  __syncthreads();
  bf16x8 pf[2][2];
  for (int t = 0; t <= ntile; t++) {
    const bool more = t + 1 < ntile;
    if (more) tile_load(t + 1);
    if (lag && t > 0) fs_pv<128>(pf, VB(t - 1), o, lane);
    if (t < ntile) {
      f32x16 sc[2];
      fs_scores<false>(KB(t) + map * 64 * LROW, qf, sc, lane, 0, 0, T);
      fs_softmax<128>(sc, m, ls, o, pf, lane);
      if (!lag) fs_pv<128>(pf, VB(t), o, lane);
    }
    if (more) tile_store(t + 1);
    __syncthreads();
  }
  float* xch = (float*)sm;
  if (map == 1) {
    const float inv = lam * __builtin_amdgcn_rcpf(ls);
#pragma unroll
    for (int ds = 0; ds < 4; ds++)
#pragma unroll
      for (int e = 0; e < 16; e++) xch[((qg * 64) + ds * 16 + e) * 64 + lane] = o[ds][e] * inv;
  }
  __syncthreads();
  if (map == 0) {
    const float i0 = __builtin_amdgcn_rcpf(ls);
    float ss = 0.f;
#pragma unroll
    for (int ds = 0; ds < 4; ds++)
#pragma unroll
      for (int e = 0; e < 16; e++) {
        float v = o[ds][e] * i0 - xch[((qg * 64) + ds * 16 + e) * 64 + lane];
        o[ds][e] = v; ss += v * v;
      }
    ss += shflx(ss, 32, lane);
    const float rinv = rsqrtf(ss * (1.f / 128.f) + EPS) * (1.f - lam_init);
    const float* sg = p.subln_c + l * 128;
#pragma unroll
    for (int ds = 0; ds < 4; ds++) {
      uint2 gv[4]; float4 sl[4];
#pragma unroll
      for (int g = 0; g < 4; g++) {
        const int d = ds * 32 + 8 * g + 4 * h;
        gv[g] = *(const uint2*)(p.P + prow + C_GC + hd * 128 + d);
        sl[g] = *(const float4*)(sg + d);
      }
      __builtin_amdgcn_sched_barrier(0);
#pragma unroll
      for (int g = 0; g < 4; g++) {
        const int d = ds * 32 + 8 * g + 4 * h;
        uint2 ov;
        ov.x = pack2(o[ds][4 * g] * rinv * sl[g].x * lo_bf(gv[g].x), o[ds][4 * g + 1] * rinv * sl[g].y * hi_bf(gv[g].x));
        ov.y = pack2(o[ds][4 * g + 2] * rinv * sl[g].z * lo_bf(gv[g].y), o[ds][4 * g + 3] * rinv * sl[g].w * hi_bf(gv[g].y));
        *(uint2*)(p.GB + (size_t)2 * NTOK * 512 + tm_off(rowbase + q0 + r, hd * 128 + d, 8)) = ov;
      }
    }
  }
}

__device__ __forceinline__ void lru_run(const Params& p, int l, bool pass2, int start, int G, float* sm, bool dry = false) {
  const int tid = TIDX;
  const int lane = tid & 63, wid = tid >> 6, r = lane & 31, h = lane >> 5;
  const int n = start & 7;
  float* xin = sm;
  float* xb = sm + 67 * 64;
  float* comb = xb + 64 * 64;
  float* carry = comb + 2048;
  float* parts = carry + 128;
  float* ab = parts + 1024;
  u16* xbh = (u16*)(ab + 4 * 4096);
  const int gd = wid >> 2, gth = (wid >> 1) & 1, gdh = wid & 1;
  bf16x8 wfa[4], wfx[4];
  {
    const u16* wbase = p.Wt_lru + ((size_t)(((l * 2 + gd) * 8 + n) * 2) * 64 + gdh * 32 + r) * 64 + h * 8;
#pragma unroll
    for (int ks = 0; ks < 4; ks++) { wfa[ks] = *(const bf16x8*)(wbase + ks * 16); wfx[ks] = *(const bf16x8*)(wbase + 4096 + ks * 16); }
  }
  const int gch = n * 64 + gdh * 32 + r;
  const float g_ba = p.lru_ba[(l * 2 + gd) * 512 + gch], g_bx = p.lru_bx[(l * 2 + gd) * 512 + gch];
  const float g_sp = log1pf(__expf(-p.lru_lam[(l * 2 + gd) * 512 + gch]));
  const int cc = tid & 63;
  float cw[4]; float cbv;
  {
    const float* cwp = p.conv_w + l * 4 * 512 + n * 64 + cc;
    cw[0] = cwp[0]; cw[1] = cwp[512]; cw[2] = cwp[1024]; cw[3] = cwp[1536];
    cbv = p.conv_b[l * 512 + n * 64 + cc];
  }
  const int dout = tid & 63, tg = tid >> 6;
  const int ch = n * 64 + dout;

  u16 xr[9];
  auto xin_load = [&](int it_) {
    const int row0_ = (it_ >> 3) * 64;
    int T_, seq0_;
    if (row0_ < NCTX) { T_ = 256; seq0_ = (row0_ >> 8) * 256; } else { T_ = 4096; seq0_ = NCTX + ((row0_ - NCTX) >> 12) * 4096; }
    const int t0_ = row0_ - seq0_;
#pragma unroll
    for (int k = 0; k < 9; k++) {
      const int rr = (tid >> 6) + 8 * k; const int t = t0_ - 2 + rr;
      const bool ok = (rr < 67 && t >= 0 && t < T_);
      const int tc = t < 0 ? 0 : (t >= T_ ? T_ - 1 : t);
      u16 v = p.P[(size_t)(seq0_ + tc) * PP + C_XB + n * 64 + cc];
      xr[k] = ok ? v : (u16)0;
    }
  };
  if (start < 1536) xin_load(start);
  for (int it = start; it < 1536; it += G) {
    const int ci = it >> 3;
    const int row0 = ci * 64;
    const bool isctx = row0 < NCTX;
    int T, seq0, bidx;
    if (isctx) { T = 256; bidx = row0 >> 8; seq0 = bidx * 256; }
    else { T = 4096; bidx = (row0 - NCTX) >> 12; seq0 = NCTX + bidx * 4096; }
    const int t0 = row0 - seq0;
    __syncthreads();
#pragma unroll
    for (int k = 0; k < 9; k++) { const int rr = (tid >> 6) + 8 * k; if (rr < 67) xin[rr * 64 + cc] = bf2f(xr[k]); }
    if (it + G < 1536) xin_load(it + G);
    u16 sgr[8];
    if (pass2) {
#pragma unroll
      for (int tt = 0; tt < 8; tt++) sgr[tt] = p.P[(size_t)(row0 + tg * 8 + tt) * PP + C_GB + ch];
    }
    if (pass2) {
      const int d = (tid >> 6) & 1, part = tid >> 7;
      const int cfirst = seq0 >> 6, clast = (seq0 + T - 64) >> 6;
      const int K = d ? (clast - ci) : (ci - cfirst);
      float2 q[16];
#pragma unroll
      for (int k = 0; k < 16; k++) {
        const int kk = part * 16 + k;
        const int cj = d ? (clast - kk) : (cfirst + kk);
        const int cjc = cj < cfirst ? cfirst : (cj > clast ? clast : cj);
        const float2 qv = *(const float2*)(p.lruTot + ((size_t)(cjc * 2 + d) * 512 + n * 64 + cc) * 2);
        q[k] = (kk < K) ? qv : make_float2(1.f, 0.f);
      }
      float At = 1.f, Bt = 0.f;
#pragma unroll
      for (int k = 0; k < 16; k++) { Bt = q[k].x * Bt + q[k].y; At *= q[k].x; }
      parts[((part * 2 + d) * 64 + cc) * 2] = At; parts[((part * 2 + d) * 64 + cc) * 2 + 1] = Bt;
    }
    __syncthreads();
    for (int e = tid; e < 64 * 64; e += NT) {
      int t = e >> 6;
      float v = cbv;
#pragma unroll
      for (int j = 0; j < 4; j++) v += xin[(t + j) * 64 + cc] * cw[j];
      xb[e] = v;
      xbh[t * LROW + cc] = f2bf(v);
    }
    if (pass2 && tid < 128) {
      const int d = tid >> 6;
      float hcar = isctx ? 0.f : p.state_lru[((size_t)(bidx * 2 + l) * 2 + d) * 512 + n * 64 + cc];
#pragma unroll
      for (int part = 0; part < 4; part++) hcar = parts[((part * 2 + d) * 64 + cc) * 2] * hcar + parts[((part * 2 + d) * 64 + cc) * 2 + 1];
      carry[d * 64 + cc] = hcar;
    }
    __syncthreads();
    {
      bf16x8 af[4];
#pragma unroll
      for (int ks = 0; ks < 4; ks++) af[ks] = *(const bf16x8*)(xbh + (gth * 32 + r) * LROW + ks * 16 + h * 8);
      f32x16 ga, gi;
#pragma unroll
      for (int e = 0; e < 16; e++) { ga[e] = 0.f; gi[e] = 0.f; }
#pragma unroll
      for (int ks = 0; ks < 4; ks++) { ga = mfma32(af[ks], wfa[ks], ga); gi = mfma32(af[ks], wfx[ks], gi); }
      const int dch = gdh * 32 + r;
#pragma unroll
      for (int e = 0; e < 16; e++) {
        const int tok = gth * 32 + (e & 3) + 8 * (e >> 2) + 4 * h;
        float rg = sigmoidf_(ga[e] + g_ba), ig = sigmoidf_(gi[e] + g_bx);
        float log_a = -8.f * rg * g_sp;
        float a = __expf(log_a);
        const float x2 = 2.f * log_a;
        const float om = -x2 * (1.f + x2 * (0.5f + x2 * (0.16666667f + x2 * (0.041666668f + x2 * (0.0083333338f + x2 * (0.0013888889f + x2 * 0.0001984127f))))));
        float bb = __builtin_amdgcn_sqrtf(om) * ig * xb[tok * 64 + dch];
        ab[((gd * 2 + 0) * 64 + tok) * 64 + dch] = a;
        ab[((gd * 2 + 1) * 64 + tok) * 64 + dch] = bb;
      }
    }
    __syncthreads();
    float av[2][8], bv[2][8];
#pragma unroll
    for (int d = 0; d < 2; d++)
#pragma unroll
      for (int tt = 0; tt < 8; tt++) {
        av[d][tt] = ab[((d * 2 + 0) * 64 + tg * 8 + tt) * 64 + dout];
        bv[d][tt] = ab[((d * 2 + 1) * 64 + tg * 8 + tt) * 64 + dout];
      }
    float sA0 = 1.f, sB0 = 0.f, sA1 = 1.f, sB1 = 0.f;
#pragma unroll
    for (int tt = 0; tt < 8; tt++) { sB0 = av[0][tt] * sB0 + bv[0][tt]; sA0 *= av[0][tt]; }
#pragma unroll
    for (int tt = 7; tt >= 0; tt--) { sB1 = av[1][tt] * sB1 + bv[1][tt]; sA1 *= av[1][tt]; }
    comb[((tg * 2 + 0) * 64 + dout) * 2 + 0] = sA0; comb[((tg * 2 + 0) * 64 + dout) * 2 + 1] = sB0;
    comb[((tg * 2 + 1) * 64 + dout) * 2 + 0] = sA1; comb[((tg * 2 + 1) * 64 + dout) * 2 + 1] = sB1;
    __syncthreads();
    if (!pass2) {
      if (tid < 128) {
        int d = tid >> 6, c = tid & 63;
        float At = 1.f, Bt = 0.f;
#pragma unroll
        for (int s = 0; s < 8; s++) {
          int g = (d == 0) ? s : 7 - s;
          float a = comb[((g * 2 + d) * 64 + c) * 2], bq = comb[((g * 2 + d) * 64 + c) * 2 + 1];
          Bt = a * Bt + bq; At *= a;
        }
        float* o = p.lruTot + ((size_t)(ci * 2 + d) * 512 + n * 64 + c) * 2;
        o[0] = At; o[1] = Bt;
      }
      continue;
    }
    float h0 = carry[dout], h1 = carry[64 + dout];
    for (int g = 0; g < tg; g++) { h0 = comb[((g * 2 + 0) * 64 + dout) * 2] * h0 + comb[((g * 2 + 0) * 64 + dout) * 2 + 1]; }
    for (int g = 7; g > tg; g--) { h1 = comb[((g * 2 + 1) * 64 + dout) * 2] * h1 + comb[((g * 2 + 1) * 64 + dout) * 2 + 1]; }
    float y[8];
#pragma unroll
    for (int tt = 0; tt < 8; tt++) { h0 = av[0][tt] * h0 + bv[0][tt]; y[tt] = h0; }
    const float hf_last = h0;
#pragma unroll
    for (int tt = 7; tt >= 0; tt--) { h1 = av[1][tt] * h1 + bv[1][tt]; y[tt] += h1; }
    const float hb_first = h1;
    if (isctx) {
      if (t0 + 64 == T && tg == 7) p.out[O_ST + ((size_t)(bidx * 2 + l) * 2 + 0) * 512 + ch] = hf_last;
      if (t0 == 0 && tg == 0) p.out[O_ST + ((size_t)(bidx * 2 + l) * 2 + 1) * 512 + ch] = hb_first;
    }
#pragma unroll
    for (int tt = 0; tt < 8; tt++) {
      const int rw = row0 + tg * 8 + tt;
      p.GB[(size_t)NTOK * 512 + tm_off(rw, ch, 8)] = f2bf(y[tt] * bf2f(sgr[tt]));
    }
  }
}

__device__ __forceinline__ float compute_lam(const Params& p, int l, float lam_init) {
  float s1 = 0.f, s2 = 0.f;
  for (int i = 0; i < 64; i++) {
    s1 += p.lam_q1[l * 64 + i] * p.lam_k1[l * 64 + i];
    s2 += p.lam_q2[l * 64 + i] * p.lam_k2[l * 64 + i];
  }
  return expf(s1) - expf(s2) + lam_init;
}

__device__ __forceinline__ float mix_phase(const Params& p, int l, u16* smem, int vid) {
  unsigned long long tm0 = 0; float tres = 0.f; if (PROBE >= 30) tm0 = __builtin_amdgcn_s_memrealtime();
  const float lam_init = (l == 0) ? 0.2f : (0.8f - 0.6f * 0.74081822068f);
  const float lam = compute_lam(p, l, lam_init);
  constexpr int N_CL = 256, N_A = 384, N_CC = 128, N_L = 1536;
  const int G = gridDim.x;
  int start = vid;
  for (int it = start; it < N_CL; it += G) attnC_item(p, l, 128 + it, smem, lam, lam_init);
  if (PROBE == 35) tres = (float)(__builtin_amdgcn_s_memrealtime() - tm0) / 40000.f;
  start = (int)((vid + G - (N_CL % G)) % G);
  for (int it = start; it < N_A; it += G) attnA_item(p, l, it, smem);
  start = (int)((vid + G - ((N_CL + N_A) % G)) % G);
  for (int it = start; it < N_CC; it += G) attnC_item(p, l, it, smem, lam, lam_init);
  if (PROBE == 36) tres = (float)(__builtin_amdgcn_s_memrealtime() - tm0) / 40000.f;
  start = (int)((vid + G - ((N_CL + N_A + N_CC) % G)) % G);
  if (PROBE == 6) lru_run(p, l, false, start, G, (float*)smem);
  lru_run(p, l, false, start, G, (float*)smem);
  return tres;
}

__device__ __forceinline__ void lru2_phase(const Params& p, int l, u16* smem) {
  lru_run(p, l, true, blockIdx.x, gridDim.x, (float*)smem);
}

#define XB_TMO      128
#define XB_XCNT(j)  (256  + 64 * (j))
#define XB_XSUB(j)  (1280 + 64 * (j))
#define XB_XGEN(j)  (2304 + 64 * (j))
#define XB_TOP      3328
#define XB_TOPGEN   3392
#define XCD_BAR_WORDS 3456
#define XB_SPIN_CAP (1u << 18)
__device__ __forceinline__ unsigned xb_ld(unsigned* p)              { return __hip_atomic_load(p, __ATOMIC_RELAXED, __HIP_MEMORY_SCOPE_AGENT); }
__device__ __forceinline__ unsigned xb_add(unsigned* p, unsigned v) { return __hip_atomic_fetch_add(p, v, __ATOMIC_RELAXED, __HIP_MEMORY_SCOPE_AGENT); }
__device__ __forceinline__ unsigned xb_xcc_id() { return (unsigned)__builtin_amdgcn_s_getreg((3 << 11) | 20) & 0xFu; }
#define XB_SPIN(cond, bar) do { unsigned _sp = 0; while (cond) { __builtin_amdgcn_s_sleep(1); \
    if ((++_sp & 255u) == 0u) { if (xb_ld(&(bar)[XB_TMO])) break; if (_sp > XB_SPIN_CAP) { atomicAdd(&(bar)[XB_TMO], 1u); break; } } } } while (0)
struct XcdBarrier { unsigned* bar; unsigned x; volatile LAS unsigned* st; };
__device__ __forceinline__ XcdBarrier xcd_barrier_post(unsigned* bar, volatile LAS unsigned* st) {
  XcdBarrier b; b.bar = bar; b.x = xb_xcc_id(); b.st = st;
  if (threadIdx.x == 0) st[2] = xb_add(&bar[XB_XCNT(b.x)], 1u);
  return b;
}
__device__ __forceinline__ int xcd_virtual_id(const XcdBarrier& b) {
  if (threadIdx.x == 0) {
    unsigned pre = 0;
#pragma unroll
    for (unsigned j = 0; j < 16; ++j) { const unsigned c = xb_ld(&b.bar[XB_XCNT(j)]); pre += (j < b.x) ? c : 0u; }
    b.st[3] = pre + b.st[2];
  }
  __syncthreads();
  const int v = (int)b.st[3];
  __syncthreads();
  return __builtin_amdgcn_readfirstlane(v);
}
__device__ __forceinline__ void xcd_barrier_complete(unsigned* bar, unsigned x, unsigned& nloc, unsigned& nx) {
  const unsigned G = gridDim.x * gridDim.y * gridDim.z;
  unsigned sum, cnt, mine, sp = 0u;
  for (;;) {
    sum = 0u; cnt = 0u; mine = 0u;
#pragma unroll
    for (unsigned j = 0; j < 16; ++j) { const unsigned c = xb_ld(&bar[XB_XCNT(j)]); sum += c; cnt += (c > 0u) ? 1u : 0u; mine = (j == x) ? c : mine; }
    if (sum == G) break;
    __builtin_amdgcn_s_sleep(1);
    if ((++sp & 255u) == 0u) { if (xb_ld(&bar[XB_TMO])) break; if (sp > XB_SPIN_CAP) { atomicAdd(&bar[XB_TMO], 1u); break; } }
  }
  nloc = mine > 0u ? mine : 1u; nx = cnt > 0u ? cnt : 1u;
}
__device__ __forceinline__ void xcd_barrier(const XcdBarrier& b) {
  asm volatile("s_waitcnt vmcnt(0)" ::: "memory");
  __syncthreads();
  if (threadIdx.x == 0) {
    unsigned* bar = b.bar;
    __builtin_amdgcn_s_waitcnt(0);
    unsigned nloc = b.st[0], nx = b.st[1];
    if (nloc == 0u) { xcd_barrier_complete(bar, b.x, nloc, nx); b.st[0] = nloc; b.st[1] = nx; }
    const unsigned old = xb_add(&bar[XB_XSUB(b.x)], 1u);
    const unsigned gen = old / nloc;
    if (old + 1u == (gen + 1u) * nloc) {
      __builtin_amdgcn_fence(__ATOMIC_RELEASE, "agent");
      asm volatile("s_waitcnt vmcnt(0)" ::: "memory");
      const unsigned og = xb_add(&bar[XB_TOP], 1u);
      const unsigned tg = og / nx;
      if (og + 1u == (tg + 1u) * nx) xb_add(&bar[XB_TOPGEN], 1u);
      else XB_SPIN(xb_ld(&bar[XB_TOPGEN]) == tg, bar);
      __builtin_amdgcn_fence(__ATOMIC_ACQUIRE, "agent");
      xb_add(&bar[XB_XGEN(b.x)], 1u);
      asm volatile("s_waitcnt vmcnt(0)" ::: "memory");
    } else {
      XB_SPIN(xb_ld(&bar[XB_XGEN(b.x)]) == gen, bar);
      __builtin_amdgcn_fence(__ATOMIC_ACQUIRE, "agent");
      asm volatile("s_waitcnt vmcnt(0)" ::: "memory");
    }
  }
  __syncthreads();
}

typedef __attribute__((address_space(4))) const Params CParams;
__device__ __forceinline__ const Params& get_params() {
  CParams* kp = (CParams*)__builtin_amdgcn_kernarg_segment_ptr();
  asm volatile("" : "+s"(kp));
  return *(const Params*)kp;
}
__global__ void __launch_bounds__(NT, 2) fwd_kernel(Params p_unused) {
  extern __shared__ __attribute__((aligned(16))) unsigned char lds_raw[];
  u16* smem = (u16*)lds_raw;
  LAS unsigned char* lds = (LAS unsigned char*)lds_raw;
  cg::grid_group grid = cg::this_grid();
  volatile LAS unsigned* xst = (volatile LAS unsigned*)(lds + STAGE_BYTES + SPARE_BYTES);
  if (threadIdx.x == 0) { xst[0] = 0u; xst[1] = 0u; }
  __syncthreads();
  XcdBarrier xb = xcd_barrier_post(get_params().bar, xst);
  float tfrac = 0.f;
  unsigned long long tq0 = 0; if (PROBE >= 30) tq0 = __builtin_amdgcn_s_memrealtime();
  prologue_phase(get_params(), (float*)smem);
  if (PROBE == 30) tfrac = (float)(__builtin_amdgcn_s_memrealtime() - tq0) / 40000.f;
  if (get_params().bar == nullptr) grid.sync();
  xcd_barrier(xb);
  if (PROBE == 31) tfrac = (float)(__builtin_amdgcn_s_memrealtime() - tq0) / 40000.f;
  const int vid = xcd_virtual_id(xb);
  { LAS float* rl = (LAS float*)(lds + ROPE_OFF); const float* rg = get_params().rope;
    for (int i = threadIdx.x; i < 2048; i += NT) rl[i] = rg[i];
    __syncthreads(); }
  if (PROBE == 9) { for (int i = 0; i < 10; i++) xcd_barrier(xb); }
#pragma unroll 1
  for (int l = 0; l < 2; l++) {
    if (PROBE >= 30) tq0 = __builtin_amdgcn_s_memrealtime();
    norm_phase(get_params(), l);
    if (PROBE == 32 && l == 0) tfrac = (float)(__builtin_amdgcn_s_memrealtime() - tq0) / 40000.f;
    if (PROBE == 3) { norm_phase(get_params(), l); if (l == 0) { xcd_barrier(xb); prologue_phase(get_params(), (float*)smem); } }
    xcd_barrier(xb);
    {
      const Params& p = get_params();
      SchedStd S; S.nM = NTOK / 256; S.nN = INC / 256; S.nwg = S.nM * S.nN; S.G = gridDim.x; S.c = vid;
      S.A = (const char*)p.H; S.B = (const char*)(p.Wt_in + (size_t)l * INC * 1024); S.tA = (size_t)256 * 1024 * 2; S.tB = (size_t)256 * 1024 * 2;
      EpiInproj E; E.pp = &p; E.l = l; E.part = (LAS float*)(lds + STAGE_BYTES); E.ropeL = (const LAS float*)(lds + ROPE_OFF);
      { float tr = gemm_phase(lds, 1024, S, E, PROBE == 22); if (l == 0 && (PROBE == 21 || PROBE == 22)) tfrac = tr; }
      if (PROBE == 1) { __syncthreads(); gemm_phase(lds, 1024, S, E); }
    }
    xcd_barrier(xb);
    if (PROBE >= 30) tq0 = __builtin_amdgcn_s_memrealtime();
    { float tr = mix_phase(get_params(), l, smem, vid); if ((PROBE == 35 || PROBE == 36) && l == 0) tfrac = tr; }
    if (PROBE == 33 && l == 0) tfrac = (float)(__builtin_amdgcn_s_memrealtime() - tq0) / 40000.f;
    xcd_barrier(xb);
    if (PROBE >= 30) tq0 = __builtin_amdgcn_s_memrealtime();
    lru2_phase(get_params(), l, smem);
    if (PROBE == 34 && l == 0) tfrac = (float)(__builtin_amdgcn_s_memrealtime() - tq0) / 40000.f;
    xcd_barrier(xb);
    {
      const Params& p = get_params();
      SchedBranch S; S.G = gridDim.x; S.c = vid; S.P_ = (const char*)p.GB; S.W_ = (const char*)(p.Wt_br + (size_t)l * 3 * 1024 * 512);
      EpiBranch E; E.pp = &p;
      { float tr = gemm_phase(lds, 512, S, E, PROBE == 24); if (l == 0 && (PROBE == 23 || PROBE == 24)) tfrac = tr; }
      if (PROBE == 2) { __syncthreads(); gemm_phase(lds, 512, S, E); }
    }
    xcd_barrier(xb);
    {
      const Params& p = get_params();
      SchedStd S; S.nM = NTOK / 256; S.nN = 4; S.nwg = S.nM * S.nN; S.G = gridDim.x; S.c = vid;
      S.A = (const char*)p.Y; S.B = (const char*)(p.Wt_out + (size_t)l * 1024 * 1024); S.tA = (size_t)256 * 1024 * 2; S.tB = (size_t)256 * 1024 * 2;
      EpiOut E; E.pp = &p; E.l = l;
      { float tr = gemm_phase(lds, 1024, S, E, PROBE == 26); if (l == 0 && (PROBE == 25 || PROBE == 26)) tfrac = tr; }
      if (PROBE == 8 && l == 0) { __syncthreads(); gemm_phase(lds, 1024, S, E); }
    }
    if (l == 0) xcd_barrier(xb);
  }
  if (PROBE >= 20) {
    xcd_barrier(xb);
    if (blockIdx.x == 0 && threadIdx.x == 0) { float* o = get_params().out + O_X + 4194304; *o += 0.42f + 0.45f * fminf(fmaxf(tfrac, 0.f), 1.f); }
  }
}

extern "C" void kernel_launch(void* const* d_in, const int* in_sizes, int n_in, void* d_out, int out_size, void* d_ws,
                              size_t ws_size, hipStream_t stream) {
  Params p{};
  const float** ip = (const float**)&p;
  for (int i = 0; i < 34; i++) ip[i] = (const float*)d_in[i];
  p.out = (float*)d_out;
  char* w = (char*)d_ws; size_t off = 0;
  auto take = [&](size_t bytes) { char* q = w + off; off += (bytes + 255) & ~(size_t)255; return q; };
  p.Wt_in = (u16*)take((size_t)2 * INC * 1024 * 2);
  p.Wt_br = (u16*)take((size_t)6 * 1024 * 512 * 2);
  p.Wt_out = (u16*)take((size_t)2 * 1024 * 1024 * 2);
  p.Y = (u16*)take((size_t)NTOK * 1024 * 2);
  p.P = (u16*)take((size_t)NTOK * PP * 2);
  p.VtA_ctx = p.Y;
  p.VtA_lat = p.VtA_ctx + (size_t)16 * 2 * 64 * 256;
  p.VtC_ctx = p.VtA_lat + (size_t)2 * 2 * 64 * 4096;
  p.VtC_lat = p.VtC_ctx + (size_t)16 * 4 * 128 * 256;
  p.cKa = (u16*)take((size_t)2 * 2 * 512 * 128 * 2);
  p.cVtA = (u16*)take((size_t)2 * 2 * 512 * 128 * 2);
  p.cKc = (u16*)take((size_t)2 * 2 * 512 * 512 * 2);
  p.cVtC = (u16*)take((size_t)2 * 2 * 512 * 512 * 2);
  p.mod = (float*)take((size_t)2 * 3 * 3072 * 4);
  p.rope = (float*)take((size_t)2048 * 4);
  p.lruTot = (float*)take((size_t)192 * 2 * 512 * 2 * 4);
  p.Wt_lru = (u16*)take((size_t)2 * 2 * 8 * 2 * 64 * 64 * 2);
  p.bar = (unsigned*)take((size_t)XCD_BAR_WORDS * 4);
  p.GB = (u16*)take((size_t)3 * NTOK * 512 * 2);
  p.H = p.GB;
  p.MG = (unsigned*)take((size_t)(48 * 4 * 3 + 1) * 16384 * 4);
  static int grid_blocks = 0;
  if (!grid_blocks) {
    int dev = 0, cus = 0;
    hipGetDevice(&dev);
    hipDeviceGetAttribute(&cus, hipDeviceAttributeMultiprocessorCount, dev);
    hipFuncSetAttribute((const void*)fwd_kernel, hipFuncAttributeMaxDynamicSharedMemorySize, LDS_BYTES);
    int per_cu = 0;
    hipOccupancyMaxActiveBlocksPerMultiprocessor(&per_cu, (const void*)fwd_kernel, NT, LDS_BYTES);
    (void)hipGetLastError();
    grid_blocks = cus;
  }
  hipMemsetAsync(p.bar, 0, (size_t)XCD_BAR_WORDS * 4, stream);
  void* args[] = {&p};
  hipLaunchCooperativeKernel((void*)fwd_kernel, dim3(grid_blocks), dim3(NT), args, LDS_BYTES, stream);
}
```

```cpp
#include <hip/hip_runtime.h>
#include <hip/hip_cooperative_groups.h>
#include <stdint.h>
#include <math.h>
namespace cg = cooperative_groups;

typedef unsigned short u16;
typedef __attribute__((ext_vector_type(8))) short bf16x8;
typedef __attribute__((ext_vector_type(4))) short bf16x4;
typedef __attribute__((ext_vector_type(16))) float f32x16;
typedef __attribute__((ext_vector_type(4))) float f32x4;
#define LAS __attribute__((address_space(3)))

#ifndef PROBE
#define PROBE 0
#endif
#define NT 512
constexpr int NTOK = 12288, NCTX = 4096;
constexpr int INC = 7424;
constexpr int PP = 3712;
constexpr int C_QA = 0, C_KA = 512, C_GA = 640, C_XB = 1152, C_GB = 1664, C_QC = 2176, C_KC = 2688, C_GC = 3200;
constexpr int LROW = 72;
constexpr int VROW = 68;
constexpr float EPS = 1e-6f;
constexpr int STAGE_BYTES = 131072;
constexpr int SPARE_BYTES = 8192;
constexpr int ROPE_OFF = STAGE_BYTES + SPARE_BYTES + 16;
constexpr int LDS_BYTES = ROPE_OFF + 8192;

constexpr size_t O_X = 0, O_KA = 12582912, O_VA = 13631488, O_KC = 14680064, O_VC = 18874368, O_ST = 23068672;

struct Params {
  const float *x_prompt, *x_sample, *cache_a_k, *cache_a_v, *cache_c_k, *cache_c_v, *state_lru, *c, *c_ctx,
      *norm_g, *mod_w, *mod_b, *w_in, *qn_a, *kn_a, *sink_a, *conv_w, *conv_b, *lru_wa, *lru_ba, *lru_wx, *lru_bx,
      *lru_lam, *qn_c, *kn_c, *lam_q1, *lam_k1, *lam_q2, *lam_k2, *subln_c, *w_br_a, *w_br_b, *w_br_c, *w_out;
  float* out;
  u16 *Wt_in, *Wt_br, *Wt_out, *H, *P, *VtA_ctx, *VtA_lat, *VtC_ctx, *VtC_lat, *cKa, *cVtA, *cKc, *cVtC;
  float *mod, *rope, *lruTot;
  u16 *Wt_lru;
  unsigned* bar;
  u16* Y;
  u16* GB;
  unsigned* MG;
};

__device__ __forceinline__ int tid_opaque() { int t = (int)threadIdx.x; asm volatile("" : "+v"(t)); return t; }
#define TIDX tid_opaque()
__device__ __forceinline__ u16 f2bf(float f) {
  uint32_t r; asm("v_cvt_pk_bf16_f32 %0, %1, %1" : "=v"(r) : "v"(f)); return (u16)(r & 0xffffu);
}
__device__ __forceinline__ float bf2f(u16 h) { return __uint_as_float(((uint32_t)h) << 16); }
__device__ __forceinline__ uint32_t pack2(float a, float b) { uint32_t r; asm("v_cvt_pk_bf16_f32 %0, %1, %2" : "=v"(r) : "v"(a), "v"(b)); return r; }
__device__ __forceinline__ float sigmoidf_(float x) { return __builtin_amdgcn_rcpf(1.f + __expf(-x)); }
__device__ __forceinline__ float siluf_(float x) { return x * __builtin_amdgcn_rcpf(1.f + __expf(-x)); }
__device__ __forceinline__ f32x16 mfma32(bf16x8 a, bf16x8 b, f32x16 c) {
  return __builtin_amdgcn_mfma_f32_32x32x16_bf16(a, b, c, 0, 0, 0);
}
__device__ __forceinline__ float shflx(float v, int mask, int lane) {
  return __builtin_bit_cast(float, __builtin_amdgcn_ds_bpermute((lane ^ mask) << 2, __builtin_bit_cast(int, v)));
}
__device__ __forceinline__ float half_max(float v) {
  const unsigned u = __builtin_bit_cast(unsigned, v);
  auto r = __builtin_amdgcn_permlane32_swap(u, u, false, false);
  return fmaxf(__builtin_bit_cast(float, (unsigned)r[0]), __builtin_bit_cast(float, (unsigned)r[1]));
}
__device__ __forceinline__ float half_sum(float v) {
  const unsigned u = __builtin_bit_cast(unsigned, v);
  auto r = __builtin_amdgcn_permlane32_swap(u, u, false, false);
  return __builtin_bit_cast(float, (unsigned)r[0]) + __builtin_bit_cast(float, (unsigned)r[1]);
}
__device__ __forceinline__ float row_pair_sum(float v) {
  const unsigned u = __builtin_bit_cast(unsigned, v);
  auto r = __builtin_amdgcn_permlane16_swap(u, u, false, false);
  return __builtin_bit_cast(float, (unsigned)r[0]) + __builtin_bit_cast(float, (unsigned)r[1]);
}
__device__ __forceinline__ float lo_bf(uint32_t w) { return __uint_as_float(w << 16); }
__device__ __forceinline__ float hi_bf(uint32_t w) { return __uint_as_float(w & 0xffff0000u); }

__device__ __forceinline__ size_t tm_off(int r, int k, int KT) {
  return ((size_t)((r >> 8) * KT + (k >> 6)) * 256 + (r & 255)) * 64 + (k & 63);
}
__device__ __forceinline__ void transpose_tile(const float* __restrict__ src, int spitch, u16* __restrict__ dst, int dpitch,
                               int r0, int c0, float* sm, int KT = 0) {
  const int tid = TIDX;
#pragma unroll
  for (int i = 0; i < 2; i++) {
    int c = tid + i * NT; int r = c >> 4, q = c & 15;
    float4 v = *(const float4*)(src + (size_t)(r0 + r) * spitch + c0 + q * 4);
    float* d = sm + r * 65 + q * 4;
    d[0] = v.x; d[1] = v.y; d[2] = v.z; d[3] = v.w;
  }
  __syncthreads();
  {
    int c = tid; int cc = c >> 3, q = c & 7;
    uint32_t w[4];
#pragma unroll
    for (int j = 0; j < 4; j++) w[j] = pack2(sm[(q * 8 + 2 * j) * 65 + cc], sm[(q * 8 + 2 * j + 1) * 65 + cc]);
    uint4 v; v.x = w[0]; v.y = w[1]; v.z = w[2]; v.w = w[3];
    if (KT) *(uint4*)(dst + tm_off(c0 + cc, r0 + q * 8, KT)) = v;
    else *(uint4*)(dst + (size_t)(c0 + cc) * dpitch + r0 + q * 8) = v;
  }
  __syncthreads();
}

__device__ __forceinline__ void transpose_wide(const float* __restrict__ src, int spitch, u16* __restrict__ dst,
                                               int k0, int n0, float* sm, int KT) {
  const int tid = TIDX;
  float4 v[8];
#pragma unroll
  for (int i = 0; i < 8; i++) { int c = tid + i * NT; int r = c >> 6, q = c & 63; v[i] = *(const float4*)(src + (size_t)(k0 + r) * spitch + n0 + q * 4); }
#pragma unroll
  for (int i = 0; i < 8; i++) { int c = tid + i * NT; int r = c >> 6, q = c & 63; float* d = sm + r * 257 + q * 4; d[0] = v[i].x; d[1] = v[i].y; d[2] = v[i].z; d[3] = v[i].w; }
  __syncthreads();
#pragma unroll
  for (int i = 0; i < 4; i++) {
    int c = tid + i * NT; int nn = c >> 3, q = c & 7;
    uint4 o;
    o.x = pack2(sm[(q * 8 + 0) * 257 + nn], sm[(q * 8 + 1) * 257 + nn]);
    o.y = pack2(sm[(q * 8 + 2) * 257 + nn], sm[(q * 8 + 3) * 257 + nn]);
    o.z = pack2(sm[(q * 8 + 4) * 257 + nn], sm[(q * 8 + 5) * 257 + nn]);
    o.w = pack2(sm[(q * 8 + 6) * 257 + nn], sm[(q * 8 + 7) * 257 + nn]);
    *(uint4*)(dst + tm_off(n0 + nn, k0 + q * 8, KT)) = o;
  }
  __syncthreads();
}

__device__ __forceinline__ void mod_item(const Params& p, int it, float* sm) {
  const int tid = TIDX;
  const int l = it / 48, n0 = (it % 48) * 64;
  float* sv = sm;
  float* red = sm + 3072;
  for (int e = tid; e < 3072; e += NT) {
    int v = e >> 10, k = e & 1023;
    float x = (v == 0) ? p.c_ctx[k] : p.c[(v - 1) * 1024 + k];
    sv[e] = siluf_(x);
  }
  __syncthreads();
  const int col = tid & 63, kg = tid >> 6;
  const float* w = p.mod_w + (size_t)l * 1024 * 3072 + n0 + col;
  float a0 = 0, a1 = 0, a2 = 0;
#pragma unroll 1
  for (int kb = kg * 128; kb < kg * 128 + 128; kb += 32) {
    float wv[32];
#pragma unroll
    for (int j = 0; j < 32; j++) wv[j] = w[(size_t)(kb + j) * 3072];
#pragma unroll
    for (int j = 0; j < 32; j++) { a0 += sv[kb + j] * wv[j]; a1 += sv[1024 + kb + j] * wv[j]; a2 += sv[2048 + kb + j] * wv[j]; }
  }
  red[(kg * 3 + 0) * 64 + col] = a0; red[(kg * 3 + 1) * 64 + col] = a1; red[(kg * 3 + 2) * 64 + col] = a2;
  __syncthreads();
  if (tid < 192) {
    int v = tid >> 6, c = tid & 63;
    float s = p.mod_b[l * 3072 + n0 + c];
#pragma unroll
    for (int g = 0; g < 8; g++) s += red[(g * 3 + v) * 64 + c];
    p.mod[(l * 3 + v) * 3072 + n0 + c] = s;
  }
  __syncthreads();
}

__device__ __forceinline__ void prologue_phase(const Params& p, float* sm) {
  constexpr int N_MOD = 96, N_ROPE = 1, N_WIN = 2 * 16 * 29, N_WBR = 6 * 8 * 4, N_WOUT = 2 * 16 * 4;
  constexpr int N_CK = 64 + 256, N_CVA = 4 * 16, N_CVC = 4 * 64, N_LW = 64;
  constexpr int E0 = N_MOD, E1 = E0 + N_ROPE, E2 = E1 + N_WIN, E3 = E2 + N_WBR, E4 = E3 + N_WOUT, E5 = E4 + N_CK,
                E6 = E5 + N_CVA, E7 = E6 + N_CVC, E8 = E7 + N_LW;
  const int tid = TIDX;
  for (int it = blockIdx.x; it < E8; it += gridDim.x) {
    if (it < E0) {
      mod_item(p, it, sm);
    } else if (it < E1) {
      for (int e = tid; e < 1024; e += NT) {
        int pos = e >> 4, f = e & 15;
        float inv = powf(10000.f, -(float)f / 16.f);
        float ang = (float)pos * inv;
        p.rope[e] = cosf(ang); p.rope[1024 + e] = sinf(ang);
      }
    } else if (it < E2) {
      int j = it - E1; int l = j / (16 * 29); int r = j % (16 * 29);
      int kt = r / 29, pn = r % 29;
      transpose_wide(p.w_in + (size_t)l * 1024 * INC, INC, p.Wt_in + (size_t)l * INC * 1024, kt * 64, pn * 256, sm, 16);
    } else if (it < E3) {
      int j = it - E2; int m = j / 32; int r = j % 32;
      int l = m / 3, i = m % 3;
      const float* src = (i == 0 ? p.w_br_a : (i == 1 ? p.w_br_b : p.w_br_c)) + (size_t)l * 512 * 1024;
      int kt = r / 4, pn = r % 4;
      transpose_wide(src, 1024, p.Wt_br + (size_t)m * 1024 * 512, kt * 64, pn * 256, sm, 8);
    } else if (it < E4) {
      int j = it - E3; int l = j / 64; int r = j % 64;
      int kt = r / 4, pn = r % 4;
      transpose_wide(p.w_out + (size_t)l * 1024 * 1024, 1024, p.Wt_out + (size_t)l * 1024 * 1024, kt * 64, pn * 256, sm, 16);
    } else if (it < E5) {
      int j = it - E4;
      const float* src; u16* dst; size_t off;
      if (j < 64) { src = p.cache_a_k; dst = p.cKa; off = (size_t)j * 4096; }
      else { src = p.cache_c_k; dst = p.cKc; off = (size_t)(j - 64) * 4096; }
      size_t e = off + (size_t)tid * 8;
      float4 a = *(const float4*)(src + e), b = *(const float4*)(src + e + 4);
      uint4 v; v.x = pack2(a.x, a.y); v.y = pack2(a.z, a.w); v.z = pack2(b.x, b.y); v.w = pack2(b.z, b.w);
      *(uint4*)(dst + e) = v;
    } else if (it < E6) {
      int j = it - E5; int bl = j / 16; int r = j % 16;
      int rt = r / 2, ct = r % 2;
      transpose_tile(p.cache_a_v + (size_t)bl * 512 * 128, 128, p.cVtA + (size_t)bl * 128 * 512, 512, rt * 64, ct * 64, sm);
    } else if (it < E7) {
      int j = it - E6; int bl = j / 64; int r = j % 64;
      int rt = r / 8, ct = r % 8;
      transpose_tile(p.cache_c_v + (size_t)bl * 512 * 512, 512, p.cVtC + (size_t)bl * 512 * 512, 512, rt * 64, ct * 64, sm);
    } else {
      int j = it - E7; int ldn = j >> 1, g = j & 1;
      transpose_tile((g ? p.lru_wx : p.lru_wa) + (size_t)ldn * 4096, 64, p.Wt_lru + (size_t)(ldn * 2 + g) * 4096, 64, 0, 0, sm);
    }
  }
}

__device__ __forceinline__ void norm_phase(const Params& p, int l) {
  const int tid = TIDX, lane = tid & 63, wid = tid >> 6;
  const float* g = p.norm_g + l * 1024;
  for (int it = blockIdx.x; it < NTOK / 8; it += gridDim.x) {
    int row = it * 8 + wid;
    const float* x;
    if (l == 0) x = (row < NCTX) ? p.x_prompt + (size_t)row * 1024 : p.x_sample + (size_t)(row - NCTX) * 1024;
    else x = p.out + O_X + (size_t)row * 1024;
    int v = (row < NCTX) ? 0 : 1 + (row - NCTX) / 4096;
    const float* md = p.mod + (l * 3 + v) * 3072;
    float4 xv[4], gv[4], sh[4], sc[4]; float ss = 0;
#pragma unroll
    for (int i = 0; i < 4; i++) {
      const int c = i * 256 + lane * 4;
      xv[i] = *(const float4*)(x + c);
      gv[i] = *(const float4*)(g + c); sh[i] = *(const float4*)(md + c); sc[i] = *(const float4*)(md + 1024 + c);
    }
    __builtin_amdgcn_sched_barrier(0);
#pragma unroll
    for (int i = 0; i < 4; i++) ss += xv[i].x * xv[i].x + xv[i].y * xv[i].y + xv[i].z * xv[i].z + xv[i].w * xv[i].w;
#pragma unroll
    for (int o = 32; o > 0; o >>= 1) ss += shflx(ss, o, lane);
    float rinv = rsqrtf(ss * (1.f / 1024.f) + EPS);
#pragma unroll
    for (int i = 0; i < 4; i++) {
      int c = i * 256 + lane * 4;
      float h0 = xv[i].x * rinv * gv[i].x * (1.f + sc[i].x) + sh[i].x;
      float h1 = xv[i].y * rinv * gv[i].y * (1.f + sc[i].y) + sh[i].y;
      float h2 = xv[i].z * rinv * gv[i].z * (1.f + sc[i].z) + sh[i].z;
      float h3 = xv[i].w * rinv * gv[i].w * (1.f + sc[i].w) + sh[i].w;
      uint2 o2; o2.x = pack2(h0, h1); o2.y = pack2(h2, h3);
      *(uint2*)(p.H + tm_off(row, c, 16)) = o2;
    }
  }
}

constexpr int G_BK = 64, G_HALF = 128, G_HTB = G_HALF * G_BK * 2;
__device__ __forceinline__ int lds_byte(int r, int c) {
  const int st = (r >> 4) * 2 + (c >> 5), rr = r & 15, cc = c & 31, ob = rr * 64 + cc * 2;
  return st * 1024 + (ob ^ (((ob >> 9) & 1) << 5));
}
__device__ __forceinline__ void stage_rc(int b, int& R, int& C) {
  const int st = b / 1024, sb = b % 1024, swz = sb ^ (((sb >> 9) & 1) << 5);
  R = (st >> 1) * 16 + swz / 64; C = (st & 1) * 32 + (swz % 64) / 2;
}
struct Unit { int pm, pn, seg; };

struct SchedStd {
  int nM, nN, nwg, G, c; const char* A; const char* B; size_t tA, tB;
  __device__ __forceinline__ bool next(int i, Unit& u) const {
    long L = (long)i * G + c;
    if (G == 256 && nwg == 1392 && i == 5) {
      const int cp = (c & 31) * 8 + (c >> 5);
      if (cp >= 112) return false;
      L = 1280 + cp;
    }
    if (G == 256 && nwg == 192) {
      if (i > 0 || (c & 31) >= 24) return false;
      L = (c >> 5) * 24 + (c & 31);
    }
    if (L >= nwg) return false;
    const int wgid = (int)L;
    const int nig = 8 * nN, gid = wgid / nig, fm = gid * 8, gsz = (nM - fm) < 8 ? (nM - fm) : 8;
    u.pm = fm + ((wgid % nig) % gsz); u.pn = (wgid % nig) / gsz; u.seg = 0; return true;
  }
  __device__ __forceinline__ const char* aptr(const Unit& u) const { return A + (size_t)u.pm * tA; }
  __device__ __forceinline__ const char* bptr(const Unit& u) const { return B + (size_t)u.pn * tB; }
};
struct SchedBranch {
  int G, c; const char* P_; const char* W_;
  __device__ __forceinline__ bool next(int i, Unit& u) const {
    if (G == 256) {
      if (i >= 3) return false;
      const int xcd = c >> 5, j = c & 31;
      if (j >= 24) return false;
      u.seg = i; u.pm = xcd * 6 + (j >> 2); u.pn = j & 3; return true;
    }
    const int tile = (i / 3) * G + c; if (tile >= 192) return false;
    u.seg = i % 3; u.pm = tile >> 2; u.pn = tile & 3; return true;
  }
  __device__ __forceinline__ const char* aptr(const Unit& u) const { return P_ + (size_t)((u.seg * 48 + u.pm) * 8) * 32768; }
  __device__ __forceinline__ const char* bptr(const Unit& u) const { return W_ + (size_t)((u.seg * 4 + u.pn) * 8) * 32768; }
};

template <class Epi, class Sched>
__device__ __forceinline__ float gemm_phase(LAS unsigned char* lds, const int K, const Sched& S, const Epi& E, int tmode = 0) {
  unsigned long long t_ph0 = 0, t_epi = 0; if (PROBE >= 20) t_ph0 = __builtin_amdgcn_s_memrealtime();
  const int tid = TIDX, wid = __builtin_amdgcn_readfirstlane(tid >> 6), lane = tid & 63, wr = wid >> 2, wc = wid & 3, fr = lane & 15, fq = lane >> 4;
  const int nt = K / G_BK;
  unsigned voffA[2], voffB[2];
#pragma unroll
  for (int i = 0; i < 2; ++i) { int R, C; stage_rc(tid * 16 + i * 8192, R, C);
    voffA[i] = (unsigned)(R * 64 + C) * 2u; voffB[i] = voffA[i]; }
  const size_t kstep = (size_t)32768;
  const size_t hA = (size_t)16384, hB = (size_t)16384;
  const unsigned ldsw = (unsigned)wid * 1024u;
  const int aoff = lds_byte(wr * 64 + fr, fq * 8), boff = lds_byte(wc * 32 + fr, fq * 8);
#define G_SA(b, h) (((b) * 2 + (h)) * G_HTB)
#define G_SB(b, h) ((4 + (b) * 2 + (h)) * G_HTB)
#define G_STAGE(bufoff, gbase, voff) do { _Pragma("unroll") for (int _i = 0; _i < 2; ++_i) \
    __builtin_amdgcn_global_load_lds((const unsigned*)((const char*)(gbase) + (voff)[_i]), (LAS unsigned*)(lds + (bufoff) + ldsw + _i * 8192), 16, 0, 0); } while (0)
#define G_LDA(dst, b, h) do { _Pragma("unroll") for (int m = 0; m < 4; ++m) _Pragma("unroll") for (int k = 0; k < 2; ++k) dst[m][k] = *(const LAS bf16x8*)(lds + G_SA(b, h) + aoff + m * 2048 + k * 1024); } while (0)
#define G_LDB(dst, b, h) do { _Pragma("unroll") for (int n = 0; n < 2; ++n) _Pragma("unroll") for (int k = 0; k < 2; ++k) dst[n][k] = *(const LAS bf16x8*)(lds + G_SB(b, h) + boff + n * 2048 + k * 1024); } while (0)
#define G_MMA(ai, bj, At, Bt) do { __builtin_amdgcn_s_setprio(1); _Pragma("unroll") for (int m = 0; m < 4; ++m) _Pragma("unroll") for (int n = 0; n < 2; ++n) _Pragma("unroll") for (int k = 0; k < 2; ++k) \
    acc[ai][bj][m][n] = __builtin_amdgcn_mfma_f32_16x16x32_bf16(Bt[n][k], At[m][k], acc[ai][bj][m][n], 0, 0, 0); __builtin_amdgcn_s_setprio(0); } while (0)
#define G_WAIT_V(n) asm volatile("s_waitcnt vmcnt(" #n ")" ::: "memory")
#define G_WAIT_L(n) asm volatile("s_waitcnt lgkmcnt(" #n ")" ::: "memory")
#define G_BAR __builtin_amdgcn_s_barrier()
#define G_SCHED __builtin_amdgcn_sched_barrier(0)
  Unit cur, nxt; int ui = 0;
  if (!S.next(0, cur)) return 0.f;
  f32x4 acc[2][2][4][2];
#pragma unroll
  for (int a = 0; a < 2; ++a)
#pragma unroll
    for (int b = 0; b < 2; ++b)
#pragma unroll
      for (int m = 0; m < 4; ++m)
#pragma unroll
        for (int n = 0; n < 2; ++n) acc[a][b][m][n] = (f32x4){0.f, 0.f, 0.f, 0.f};
  bf16x8 At[4][2], B0[2][2], B1[2][2];
  const char* cA = S.aptr(cur); const char* cB = S.bptr(cur);
  G_STAGE(G_SB(0, 0), cB, voffB); G_STAGE(G_SA(0, 0), cA, voffA); G_STAGE(G_SB(0, 1), cB + hB, voffB); G_STAGE(G_SA(0, 1), cA + hA, voffA);
  if (wr == 1) G_BAR;
  G_WAIT_V(4); G_BAR;
  G_STAGE(G_SB(1, 0), cB + kstep, voffB); G_STAGE(G_SA(1, 0), cA + kstep, voffA); G_STAGE(G_SB(1, 1), cB + hB + kstep, voffB);
  G_WAIT_V(6); G_BAR;
  for (;;) {
    const bool has_next = S.next(ui + 1, nxt);
    const char* nA = has_next ? S.aptr(nxt) : cA; const char* nB = has_next ? S.bptr(nxt) : cB;
    for (int t = 0; t < nt; t += 2) {
      const bool last = (t == nt - 2);
      const char* a1 = cA + (size_t)(t + 1) * kstep;
      const char* a2 = last ? nA : cA + (size_t)(t + 2) * kstep; const char* b2 = last ? nB : cB + (size_t)(t + 2) * kstep;
      const char* a3 = a2 + kstep; const char* b3 = b2 + kstep;
      G_LDB(B0, 0, 0); G_SCHED; G_LDA(At, 0, 0); G_STAGE(G_SA(1, 1), a1 + hA, voffA);
      G_WAIT_L(8); G_BAR; G_WAIT_L(0); G_MMA(0, 0, At, B0); G_BAR; G_SCHED;
      G_LDB(B1, 0, 1); G_STAGE(G_SB(0, 0), b2, voffB);
      G_BAR; G_WAIT_L(0); G_MMA(0, 1, At, B1); G_BAR;
      G_LDA(At, 0, 1); G_STAGE(G_SA(0, 0), a2, voffA);
      G_BAR; G_WAIT_L(0); G_MMA(1, 0, At, B0); G_BAR; G_SCHED;
      G_STAGE(G_SB(0, 1), b2 + hB, voffB);
      G_WAIT_V(6); G_BAR; G_MMA(1, 1, At, B1); G_BAR;
      G_LDB(B0, 1, 0); G_SCHED; G_LDA(At, 1, 0); G_STAGE(G_SA(0, 1), a2 + hA, voffA);
      G_WAIT_L(8); G_BAR; G_WAIT_L(0); G_MMA(0, 0, At, B0); G_BAR; G_SCHED;
      G_LDB(B1, 1, 1); G_STAGE(G_SB(1, 0), b3, voffB);
      G_BAR; G_WAIT_L(0); G_MMA(0, 1, At, B1); G_BAR;
      G_LDA(At, 1, 1); G_STAGE(G_SA(1, 0), a3, voffA);
      G_BAR; G_WAIT_L(0); G_MMA(1, 0, At, B0); G_BAR; G_SCHED;
      G_STAGE(G_SB(1, 1), b3 + hB, voffB);
      G_WAIT_V(6); G_BAR; G_MMA(1, 1, At, B1); G_BAR;
    }
    unsigned long long t_e0 = 0; if (PROBE >= 20) t_e0 = __builtin_amdgcn_s_memrealtime();
    const bool reset = E(acc, cur, wr, wc, fr, fq);
    if (PROBE >= 20) { asm volatile("s_waitcnt vmcnt(0)" ::: "memory"); t_epi += __builtin_amdgcn_s_memrealtime() - t_e0; }
    if (!has_next) break;
    if (reset) {
#pragma unroll
      for (int a = 0; a < 2; ++a)
#pragma unroll
        for (int b = 0; b < 2; ++b)
#pragma unroll
          for (int m = 0; m < 4; ++m)
#pragma unroll
            for (int n = 0; n < 2; ++n) acc[a][b][m][n] = (f32x4){0.f, 0.f, 0.f, 0.f};
    }
    cur = nxt; cA = nA; cB = nB; ++ui;
  }
  G_WAIT_V(0);
  if (wr == 0) G_BAR;
  G_BAR;
  float tres = 0.f;
  if (PROBE >= 20) {
    const unsigned long long tot = __builtin_amdgcn_s_memrealtime() - t_ph0;
    tres = (tmode == 0) ? (float)t_epi / (float)tot : (float)tot / 40000.f;
  }
#undef G_SA
#undef G_SB
#undef G_STAGE
#undef G_LDA
#undef G_LDB
#undef G_MMA
#undef G_WAIT_V
#undef G_WAIT_L
#undef G_BAR
#undef G_SCHED
  return tres;
}

struct EpiInproj {
  const Params* pp; int l; LAS float* part; const LAS float* ropeL;
  __device__ __forceinline__ bool operator()(f32x4 (&acc)[2][2][4][2], const Unit& u, int wr, int wc, int fr, int fq) const {
    const Params& p = *pp;
    asm volatile("" : "+v"(fr), "+v"(fq));
    const int lane = fr + 16 * fq; (void)lane;
    const int oc0 = u.pn * 256;
    const bool isctx = u.pm < 16;
    const bool qkU = (oc0 < 768) || (oc0 >= 2304 && oc0 < 3328);
    float rinv[2][4][2];
    if (qkU) {
#pragma unroll
      for (int ai = 0; ai < 2; ai++)
#pragma unroll
        for (int m = 0; m < 4; m++)
#pragma unroll
          for (int bj = 0; bj < 2; bj++) {
            f32x4 a = acc[ai][bj][m][0], b = acc[ai][bj][m][1];
            float ss = a[0] * a[0] + a[1] * a[1] + a[2] * a[2] + a[3] * a[3] + b[0] * b[0] + b[1] * b[1] + b[2] * b[2] + b[3] * b[3];
            ss = half_sum(row_pair_sum(ss));
            rinv[ai][m][bj] = ss;
            if (fq == 0) part[((ai * 128 + wr * 64 + m * 16 + fr) * 2 + bj) * 4 + wc] = ss;
          }
      asm volatile("s_waitcnt lgkmcnt(0)" ::: "memory");
      __builtin_amdgcn_s_barrier();
      asm volatile("" ::: "memory");
#pragma unroll
      for (int ai = 0; ai < 2; ai++)
#pragma unroll
        for (int m = 0; m < 4; m++)
#pragma unroll
          for (int bj = 0; bj < 2; bj++) {
            float o = part[((ai * 128 + wr * 64 + m * 16 + fr) * 2 + bj) * 4 + (wc ^ 1)];
            rinv[ai][m][bj] = rsqrtf((rinv[ai][m][bj] + o) * (1.f / 64.f) + EPS);
          }
    }
#pragma unroll
    for (int bj = 0; bj < 2; bj++) {
      const int oc = oc0 + bj * 128;
      if (oc == 640 || (oc >= 3328 && oc < 3840)) {
        const bool isA = (oc == 640);
        const int cb = isA ? 0 : (oc - 3328);
        const int nvec = isA ? 128 : 512;
#pragma unroll
        for (int ai = 0; ai < 2; ai++)
#pragma unroll
          for (int m = 0; m < 4; m++) {
            const int row = u.pm * 256 + ai * 128 + wr * 64 + m * 16 + fr;
            int b, t, T; u16* vt;
            if (isctx) { b = row >> 8; t = row & 255; T = 256; vt = isA ? p.VtA_ctx : p.VtC_ctx; }
            else { int rr = row - NCTX; b = rr >> 12; t = rr & 4095; T = 4096; vt = isA ? p.VtA_lat : p.VtC_lat; }
#pragma unroll
            for (int n = 0; n < 2; n++) {
              const int d = cb + wc * 32 + n * 16 + fq * 4;
              f32x4 v = acc[ai][bj][m][n];
#pragma unroll
              for (int j = 0; j < 4; j++) vt[((size_t)b * nvec + d + j) * T + t] = f2bf(v[j]);
              if (isctx) {
                float* o = p.out + (isA ? O_VA : O_VC) + ((size_t)(b * 2 + l) * 256 + t) * nvec + d;
                *(f32x4*)o = v;
              }
            }
          }
      } else {
        const int pc = (oc < 640) ? oc : (oc < 3328 ? oc - 128 : oc - 640);
        const bool is_qa = oc < 512, is_ka = (oc == 512);
        const bool is_qc = (oc >= 2304 && oc < 2816), is_kc = (oc >= 2816 && oc < 3328);
        if (is_qa || is_ka || is_qc || is_kc) {
          const float* gn = (is_qa ? p.qn_a : is_ka ? p.kn_a : is_qc ? p.qn_c : p.kn_c) + l * 64 + (wc & 1) * 32 + fq * 4;
          const f32x4 g0 = *(const f32x4*)gn, g1 = *(const f32x4*)(gn + 16);
          const float qs = (is_qa || is_qc) ? 0.18033688011112042f : 1.f;
#pragma unroll
          for (int ai = 0; ai < 2; ai++)
#pragma unroll
            for (int m = 0; m < 4; m++) {
              const int row = u.pm * 256 + ai * 128 + wr * 64 + m * 16 + fr;
              const float ri = rinv[ai][m][bj];
              f32x4 x1 = acc[ai][bj][m][0] * ri * g0, x2 = acc[ai][bj][m][1] * ri * g1;
              if (!isctx) {
                const int t = (row - NCTX) & 4095;
                const int pos = (wc & 1) ? (t & 63) : (t >> 6);
                const f32x4 cs = *(const LAS f32x4*)(ropeL + pos * 16 + fq * 4), sn = *(const LAS f32x4*)(ropeL + 1024 + pos * 16 + fq * 4);
                f32x4 y1 = x1 * cs - x2 * sn, y2 = x2 * cs + x1 * sn;
                x1 = y1; x2 = y2;
              } else if (is_ka || is_kc) {
                const int b = row >> 8, t = row & 255;
                float* o = is_ka ? p.out + O_KA + ((size_t)(b * 2 + l) * 256 + t) * 128 + wc * 32 + fq * 4
                                 : p.out + O_KC + ((size_t)(b * 2 + l) * 256 + t) * 512 + (oc - 2816) + wc * 32 + fq * 4;
                *(f32x4*)o = x1; *(f32x4*)(o + 16) = x2;
              }
              x1 = x1 * qs; x2 = x2 * qs;
              u16* po = p.P + (size_t)row * PP + pc + wc * 32 + fq * 4;
              *(uint2*)po = make_uint2(pack2(x1[0], x1[1]), pack2(x1[2], x1[3]));
              *(uint2*)(po + 16) = make_uint2(pack2(x2[0], x2[1]), pack2(x2[2], x2[3]));
            }
        } else {
          const int mode = (oc >= 4352) ? 2 : ((oc >= 1280 && oc < 1792) ? 0 : 1);
          if (mode == 2) {
            const int pj = u.pn - 17, seg = pj >> 2, pn4 = pj & 3;
            unsigned* mg = p.MG + ((size_t)((u.pm * 4 + pn4) * 3 + seg) * 8 + (wr * 4 + wc)) * 2048 + lane;
#pragma unroll
            for (int ai = 0; ai < 2; ai++)
#pragma unroll
              for (int m = 0; m < 4; m++)
#pragma unroll
                for (int n = 0; n < 2; n++) {
                  f32x4 v = acc[ai][bj][m][n];
                  const unsigned q0 = (unsigned)(sigmoidf_(v[0]) * 254.f + 1.5f), q1 = (unsigned)(sigmoidf_(v[1]) * 254.f + 1.5f);
                  const unsigned q2 = (unsigned)(sigmoidf_(v[2]) * 254.f + 1.5f), q3 = (unsigned)(sigmoidf_(v[3]) * 254.f + 1.5f);
                  mg[(((ai * 4 + m) * 2 + bj) * 2 + n) * 64] = q0 | (q1 << 8) | (q2 << 16) | (q3 << 24);
                }
          } else
#pragma unroll
          for (int ai = 0; ai < 2; ai++)
#pragma unroll
            for (int m = 0; m < 4; m++) {
              const int row = u.pm * 256 + ai * 128 + wr * 64 + m * 16 + fr;
              u16* po = p.P + (size_t)row * PP + pc + wc * 32 + fq * 4;
#pragma unroll
              for (int n = 0; n < 2; n++) {
                f32x4 v = acc[ai][bj][m][n];
                if (mode == 1) { v[0] = siluf_(v[0]); v[1] = siluf_(v[1]); v[2] = siluf_(v[2]); v[3] = siluf_(v[3]); }
                else if (mode == 2) { v[0] = sigmoidf_(v[0]); v[1] = sigmoidf_(v[1]); v[2] = sigmoidf_(v[2]); v[3] = sigmoidf_(v[3]); }
                *(uint2*)(po + n * 16) = make_uint2(pack2(v[0], v[1]), pack2(v[2], v[3]));
              }
            }
        }
      }
    }
    return true;
  }
};

struct EpiBranch {
  const Params* pp;
  __device__ __forceinline__ bool operator()(f32x4 (&acc)[2][2][4][2], const Unit& u, int wr, int wc, int fr, int fq) const {
    const Params& p = *pp;
    asm volatile("" : "+v"(fr), "+v"(fq));
    const int lane = fr + 16 * fq;
    const int seg = u.seg;
    const unsigned* mg = p.MG + ((size_t)((u.pm * 4 + u.pn) * 3 + seg) * 8 + (wr * 4 + wc)) * 2048 + lane;
    const float sel = (seg < 2) ? 1.f : 0.f;
#pragma unroll
    for (int hq = 0; hq < 4; hq++) {
      unsigned a[8], b[8];
#pragma unroll
      for (int q = 0; q < 8; q++) { a[q] = mg[(hq * 8 + q) * 64]; b[q] = mg[(hq * 8 + q) * 64 + 8 * 2048]; }
      __builtin_amdgcn_sched_barrier(0);
#pragma unroll
      for (int q = 0; q < 8; q++) {
        const int ai = hq >> 1, m = (hq & 1) * 2 + (q >> 2), bj = (q >> 1) & 1, n = q & 1;
        f32x4 f = {(float)(a[q] & 255u), (float)((a[q] >> 8) & 255u), (float)((a[q] >> 16) & 255u), (float)(a[q] >> 24)};
        f32x4 g = {(float)(b[q] & 255u), (float)((b[q] >> 8) & 255u), (float)((b[q] >> 16) & 255u), (float)(b[q] >> 24)};
        g = g * sel + (1.f - sel) * 255.f;
        f[0] *= __builtin_amdgcn_rcpf(g[0]); f[1] *= __builtin_amdgcn_rcpf(g[1]); f[2] *= __builtin_amdgcn_rcpf(g[2]); f[3] *= __builtin_amdgcn_rcpf(g[3]);
        acc[ai][bj][m][n] = acc[ai][bj][m][n] * f;
      }
    }
    if (seg < 2) return false;
#pragma unroll
    for (int ai = 0; ai < 2; ai++)
#pragma unroll
      for (int m = 0; m < 4; m++) {
        const int row = u.pm * 256 + ai * 128 + wr * 64 + m * 16 + fr;
#pragma unroll
        for (int bj = 0; bj < 2; bj++)
#pragma unroll
          for (int n = 0; n < 2; n++) {
            const int col = u.pn * 256 + bj * 128 + wc * 32 + n * 16 + fq * 4;
            const f32x4 v = acc[ai][bj][m][n];
            *(uint2*)(p.Y + tm_off(row, col, 16)) = make_uint2(pack2(v[0], v[1]), pack2(v[2], v[3]));
          }
      }
    return true;
  }
};

struct EpiOut {
  const Params* pp; int l;
  __device__ __forceinline__ bool operator()(f32x4 (&acc)[2][2][4][2], const Unit& u, int wr, int wc, int fr, int fq) const {
    const Params& p = *pp;
    asm volatile("" : "+v"(fr), "+v"(fq));
    const int v = (u.pm < 16) ? 0 : 1 + (u.pm - 16) / 16;
    const float* gt = p.mod + (l * 3 + v) * 3072 + 2048 + u.pn * 256 + wc * 32 + fq * 4;
    const float* xsrc = (l == 0) ? ((u.pm < 16) ? p.x_prompt + (size_t)u.pm * 256 * 1024 : p.x_sample + (size_t)(u.pm - 16) * 256 * 1024)
                                 : p.out + O_X + (size_t)u.pm * 256 * 1024;
    float* odst = p.out + O_X + (size_t)u.pm * 256 * 1024;
    const int cbase = u.pn * 256 + wc * 32 + fq * 4;
    f32x4 gv[2][2];
#pragma unroll
    for (int bj = 0; bj < 2; bj++)
#pragma unroll
      for (int n = 0; n < 2; n++) gv[bj][n] = *(const f32x4*)(gt + bj * 128 + n * 16);
#pragma unroll
    for (int ai = 0; ai < 2; ai++)
#pragma unroll
      for (int mh = 0; mh < 2; mh++) {
        f32x4 xv[2][2][2];
#pragma unroll
        for (int mm = 0; mm < 2; mm++)
#pragma unroll
          for (int bj = 0; bj < 2; bj++)
#pragma unroll
            for (int n = 0; n < 2; n++)
              xv[mm][bj][n] = *(const f32x4*)(xsrc + (size_t)(ai * 128 + wr * 64 + (mh * 2 + mm) * 16 + fr) * 1024 + cbase + bj * 128 + n * 16);
#pragma unroll
        for (int mm = 0; mm < 2; mm++)
#pragma unroll
          for (int bj = 0; bj < 2; bj++)
#pragma unroll
            for (int n = 0; n < 2; n++)
              *(f32x4*)(odst + (size_t)(ai * 128 + wr * 64 + (mh * 2 + mm) * 16 + fr) * 1024 + cbase + bj * 128 + n * 16) = xv[mm][bj][n] + gv[bj][n] * acc[ai][bj][mh * 2 + mm][n];
      }
    return true;
  }
};

template <bool MASK>
__device__ __forceinline__ void fs_scores(const u16* Ks, const bf16x8 (&qf)[4], f32x16 (&s)[2], int lane, int kpos0, int qpos, int T) {
  const int r = lane & 31, h = lane >> 5;
  {
    bf16x8 kf[2][4];
#pragma unroll
    for (int sub = 0; sub < 2; sub++)
#pragma unroll
      for (int ks = 0; ks < 4; ks++) kf[sub][ks] = *(const bf16x8*)(Ks + (sub * 32 + r) * LROW + ks * 16 + h * 8);
    __builtin_amdgcn_sched_barrier(0);
#pragma unroll
    for (int sub = 0; sub < 2; sub++) {
#pragma unroll
      for (int e = 0; e < 16; e++) s[sub][e] = 0.f;
#pragma unroll
      for (int ks = 0; ks < 4; ks++) s[sub] = mfma32(kf[sub][ks], qf[ks], s[sub]);
    }
  }
  if (MASK) {
#pragma unroll
    for (int sub = 0; sub < 2; sub++)
#pragma unroll
      for (int e = 0; e < 16; e++) {
        int kp = kpos0 + sub * 32 + (e & 3) + 8 * (e >> 2) + 4 * h;
        int dlt = kp - qpos;
        bool ok = (kp >= 0) && (kp < T) && (dlt <= 128) && (dlt >= -128);
        if (!ok) s[sub][e] = -INFINITY;
      }
  }
}
template <int DV>
__device__ __forceinline__ void fs_softmax(f32x16 (&s)[2], float& m, float& l, f32x16 (&o)[DV / 32], bf16x8 (&pf)[2][2], int lane) {
  float mx = s[0][0];
#pragma unroll
  for (int sub = 0; sub < 2; sub++)
#pragma unroll
    for (int e = 0; e < 16; e++) mx = fmaxf(mx, s[sub][e]);
  mx = half_max(mx);
  const bool grow = mx > m;
  const float mn = grow ? mx : m;
  float sum = 0.f;
#pragma unroll
  for (int sub = 0; sub < 2; sub++)
#pragma unroll
    for (int e = 0; e < 16; e++) { float pv = __builtin_amdgcn_exp2f(s[sub][e] - mn); s[sub][e] = pv; sum += pv; }
  sum = half_sum(sum);
  if (__builtin_amdgcn_ballot_w64(grow) != 0ull) {
    const float alpha = __builtin_amdgcn_exp2f(m - mn);
    l *= alpha;
#pragma unroll
    for (int ds = 0; ds < DV / 32; ds++)
#pragma unroll
      for (int e = 0; e < 16; e++) o[ds][e] *= alpha;
  }
  l += sum; m = mn;
  typedef __attribute__((ext_vector_type(4))) unsigned u32x4;
#pragma unroll
  for (int sub = 0; sub < 2; sub++)
#pragma unroll
    for (int st = 0; st < 2; st++) {
      u32x4 pw;
#pragma unroll
      for (int j = 0; j < 4; j++) pw[j] = pack2(s[sub][8 * st + 2 * j], s[sub][8 * st + 2 * j + 1]);
      pf[sub][st] = __builtin_bit_cast(bf16x8, pw);
    }
}
template <int DV>
__device__ __forceinline__ void fs_pv(const bf16x8 (&pf)[2][2], const u16* Vts, f32x16 (&o)[DV / 32], int lane) {
  const int r = lane & 31, h = lane >> 5;
#pragma unroll
  for (int sub = 0; sub < 2; sub++) {
    bf16x8 vf[2][DV / 32];
#pragma unroll
    for (int st = 0; st < 2; st++)
#pragma unroll
      for (int ds = 0; ds < DV / 32; ds++) {
        const u16* vp = Vts + (ds * 32 + r) * VROW + sub * 32 + 16 * st + 4 * h;
        bf16x4 lo = *(const bf16x4*)vp, hi = *(const bf16x4*)(vp + 8);
        vf[st][ds] = __builtin_shufflevector(lo, hi, 0, 1, 2, 3, 4, 5, 6, 7);
      }
    __builtin_amdgcn_sched_barrier(0);
#pragma unroll
    for (int st = 0; st < 2; st++)
#pragma unroll
      for (int ds = 0; ds < DV / 32; ds++) o[ds] = mfma32(vf[st][ds], pf[sub][st], o[ds]);
    __builtin_amdgcn_sched_barrier(0);
  }
}

__device__ __forceinline__ uint4 ld_k(const u16* __restrict__ src, size_t pitch, int r0, int nrows, int c) {
  int row = c >> 3, kc = c & 7; int rr = r0 + row;
  const bool ok = (rr >= 0 && rr < nrows);
  const int rc = rr < 0 ? 0 : (rr >= nrows ? nrows - 1 : rr);
  uint4 v = *(const uint4*)(src + (size_t)rc * pitch + kc * 8);
  if (!ok) v = make_uint4(0, 0, 0, 0);
  return v;
}
__device__ __forceinline__ void st_k(u16* dst, int c, uint4 v) { *(uint4*)(dst + (c >> 3) * LROW + (c & 7) * 8) = v; }
__device__ __forceinline__ uint4 ld_vt(const u16* __restrict__ src, int T, int k0, int c) {
  int d = c >> 3, kc = c & 7; int k = k0 + kc * 8;
  const bool ok = (k >= 0 && k < T);
  const int kk = k < 0 ? 0 : (k >= T ? T - 8 : k);
  uint4 v = *(const uint4*)(src + (size_t)d * T + kk);
  if (!ok) v = make_uint4(0, 0, 0, 0);
  return v;
}
__device__ __forceinline__ void st_vt(u16* dst, int c, uint4 v) {
  uint2* q = (uint2*)(dst + (c >> 3) * VROW + (c & 7) * 8);
  q[0] = make_uint2(v.x, v.y); q[1] = make_uint2(v.z, v.w);
}

constexpr int A_BUF = 64 * LROW + 64 * VROW;
__device__ __forceinline__ void attnA_item(const Params& p, int l, int it, u16* sm, bool dry = false) {
  const int tid = TIDX, lane = tid & 63, wid = tid >> 6;
  const int r = lane & 31, h = lane >> 5;
  const bool isctx = it < 128;
  int b, kvh, qb, T, rowbase; const u16* VtBase;
  if (isctx) { b = it >> 3; kvh = (it >> 2) & 1; qb = it & 3; T = 256; rowbase = b * 256;
    VtBase = p.VtA_ctx + ((size_t)(b * 2 + kvh) * 64) * 256; }
  else { int j = it - 128; b = j >> 7; kvh = (j >> 6) & 1; qb = j & 63; T = 4096; rowbase = NCTX + b * 4096;
    VtBase = p.VtA_lat + ((size_t)(b * 2 + kvh) * 64) * 4096; }
  const int qblk = qb * 64;
  const int q0 = qblk + (wid >> 2) * 32;
  const int head = kvh * 4 + (wid & 3);
  const size_t prow = (size_t)(rowbase + q0 + r) * PP;
  bf16x8 qf[4];
#pragma unroll
  for (int ks = 0; ks < 4; ks++) qf[ks] = *(const bf16x8*)(p.P + prow + C_QA + head * 64 + ks * 16 + h * 8);
  float m = p.sink_a[l * 8 + head] * 1.4426950408889634f, ls = 1.f;
  f32x16 o[2];
#pragma unroll
  for (int ds = 0; ds < 2; ds++)
#pragma unroll
    for (int e = 0; e < 16; e++) o[ds][e] = 0.f;
  const u16* Kbase = p.P + (size_t)rowbase * PP + C_KA + kvh * 64;
  const u16* cK = p.cKa + ((size_t)(b * 2 + l) * 512) * 128 + kvh * 64;
  const u16* cVt = p.cVtA + ((size_t)((b * 2 + l) * 2 + kvh) * 64) * 512;
  const int qpos = q0 + r;
  int i_lo = 0, nW, ntile;
  if (isctx) { nW = 4; ntile = 4; }
  else {
    i_lo = (qblk < 128) ? (128 - qblk) / 64 : 0;
    int i_hi = (T - qblk + 128) / 64; if (i_hi > 5) i_hi = 5;
    nW = i_hi - i_lo; ntile = nW + 8;
  }
  uint4 rk, rv;
  auto tile_load = [&](int t) {
    if (t < nW) {
      int k0 = isctx ? t * 64 : qblk - 128 + 64 * (i_lo + t);
      rk = ld_k(Kbase, PP, k0, T, tid); rv = ld_vt(VtBase, T, k0, tid);
    } else {
      int kt = t - nW;
      rk = ld_k(cK, 128, kt * 64, 512, tid); rv = ld_vt(cVt, 512, kt * 64, tid);
    }
  };
  auto KB = [&](int i) { return sm + (i & 1) * (64 * LROW); };
  auto VB = [&](int i) { return sm + 2 * 64 * LROW + (i % 3) * (64 * VROW); };
  const bool lag = (wid >> 2) != 0;
  __syncthreads();
  tile_load(0);
  st_k(KB(0), tid, rk); st_vt(VB(0), tid, rv);
  __syncthreads();
  bf16x8 pf[2][2];
  for (int t = 0; t <= ntile; t++) {
    const bool more = t + 1 < ntile;
    if (more) tile_load(t + 1);
    if (lag && t > 0) fs_pv<64>(pf, VB(t - 1), o, lane);
    if (t < ntile) {
      f32x16 sc[2];
      bool needmask = false;
      if (!isctx && t < nW) {
        const int k0 = qblk - 128 + 64 * (i_lo + t);
        needmask = (k0 - q0 < -97) || (k0 - q0 > 65) || (k0 < 0) || (k0 + 64 > T);
      }
      if (needmask) fs_scores<true>(KB(t), qf, sc, lane, qblk - 128 + 64 * (i_lo + t), qpos, T);
      else fs_scores<false>(KB(t), qf, sc, lane, 0, 0, T);
      fs_softmax<64>(sc, m, ls, o, pf, lane);
      if (!lag) fs_pv<64>(pf, VB(t), o, lane);
    }
    if (more) { st_k(KB(t + 1), tid, rk); st_vt(VB(t + 1), tid, rv); }
    __syncthreads();
  }
  const float inv = __builtin_amdgcn_rcpf(ls);
  {
    uint2 gv[2][4];
#pragma unroll
    for (int ds = 0; ds < 2; ds++)
#pragma unroll
      for (int g = 0; g < 4; g++) gv[ds][g] = *(const uint2*)(p.P + prow + C_GA + head * 64 + ds * 32 + 8 * g + 4 * h);
    __builtin_amdgcn_sched_barrier(0);
#pragma unroll
    for (int ds = 0; ds < 2; ds++)
#pragma unroll
      for (int g = 0; g < 4; g++) {
        int d = ds * 32 + 8 * g + 4 * h;
        uint2 ov;
        ov.x = pack2(o[ds][4 * g] * inv * lo_bf(gv[ds][g].x), o[ds][4 * g + 1] * inv * hi_bf(gv[ds][g].x));
        ov.y = pack2(o[ds][4 * g + 2] * inv * lo_bf(gv[ds][g].y), o[ds][4 * g + 3] * inv * hi_bf(gv[ds][g].y));
        *(uint2*)(p.GB + tm_off(rowbase + q0 + r, head * 64 + d, 8)) = ov;
      }
  }
}

constexpr int C_BUF = 128 * LROW + 128 * VROW;
__device__ __forceinline__ void attnC_item(const Params& p, int l, int it, u16* sm, float lam, float lam_init, bool dry = false) {
  const int tid = TIDX, lane = tid & 63, wid = tid >> 6;
  const int r = lane & 31, h = lane >> 5;
  const bool isctx = it < 128;
  int b, hd, qb, T, rowbase; const u16* VtBase;
  if (isctx) { b = it >> 3; hd = (it >> 1) & 3; qb = it & 1; T = 256; rowbase = b * 256;
    VtBase = p.VtC_ctx + ((size_t)(b * 4 + hd) * 128) * 256; }
  else { int j = it - 128; b = j >> 7; hd = (j >> 5) & 3; qb = j & 31; T = 4096; rowbase = NCTX + b * 4096;
    VtBase = p.VtC_lat + ((size_t)(b * 4 + hd) * 128) * 4096; }
  const int qg = wid & 3, map = wid >> 2;
  const int q0 = qb * 128 + qg * 32;
  const size_t prow = (size_t)(rowbase + q0 + r) * PP;
  bf16x8 qf[4];
#pragma unroll
  for (int ks = 0; ks < 4; ks++) qf[ks] = *(const bf16x8*)(p.P + prow + C_QC + hd * 128 + map * 64 + ks * 16 + h * 8);
  float m = -1e30f, ls = 0.f;
  f32x16 o[4];
#pragma unroll
  for (int ds = 0; ds < 4; ds++)
#pragma unroll
    for (int e = 0; e < 16; e++) o[ds][e] = 0.f;
  const u16* Kbase = p.P + (size_t)rowbase * PP + C_KC + hd * 128;
  const u16* cK = p.cKc + ((size_t)(b * 2 + l) * 512) * 512 + hd * 128;
  const u16* cVt = p.cVtC + ((size_t)((b * 2 + l) * 4 + hd) * 128) * 512;
  const int nW = T / 64, ntile = isctx ? nW : nW + 8;
  uint4 rk0, rk1, rv0, rv1;
  const u16* pk = Kbase + (size_t)(tid >> 3) * PP + (tid & 7) * 8;
  const u16* pv0 = VtBase + (size_t)(tid >> 3) * T + (tid & 7) * 8;
  const u16* pv1 = VtBase + (size_t)((tid + NT) >> 3) * T + (tid & 7) * 8;
  size_t kstride = (size_t)64 * PP;
  auto tile_load = [&](int t) {
    if (t == nW) {
      pk = cK + (size_t)(tid >> 3) * 512 + (tid & 7) * 8;
      pv0 = cVt + (size_t)(tid >> 3) * 512 + (tid & 7) * 8;
      pv1 = cVt + (size_t)((tid + NT) >> 3) * 512 + (tid & 7) * 8;
      kstride = (size_t)64 * 512;
    }
    rk0 = *(const uint4*)pk; rk1 = *(const uint4*)(pk + 64);
    rv0 = *(const uint4*)pv0; rv1 = *(const uint4*)pv1;
    pk += kstride; pv0 += 64; pv1 += 64;
  };
  auto KB = [&](int i) { return sm + (i & 1) * (128 * LROW); };
  auto VB = [&](int i) { return sm + 2 * 128 * LROW + (i % 3) * (128 * VROW); };
  auto tile_store = [&](int i) {
    u16* kd = KB(i); u16* vd = VB(i);
    st_k(kd, tid, rk0); st_k(kd + 64 * LROW, tid, rk1);
    st_vt(vd, tid, rv0); st_vt(vd, tid + NT, rv1);
  };
  const bool lag = map != 0;
  __syncthreads();
  tile_load(0);
  tile_store(0);
  __syncthreads();
  bf16x8 pf[2][2];
  for (int t = 0; t <= ntile; t++) {
    const bool more = t + 1 < ntile;
    if (more) tile_load(t + 1);
    if (lag && t > 0) fs_pv<128>(pf, VB(t - 1), o, lane);
    if (t < ntile) {
      f32x16 sc[2];
      fs_scores<false>(KB(t) + map * 64 * LROW, qf, sc, lane, 0, 0, T);
      fs_softmax<128>(sc, m, ls, o, pf, lane);
      if (!lag) fs_pv<128>(pf, VB(t), o, lane);
    }
    if (more) tile_store(t + 1);
    __syncthreads();
  }
  float* xch = (float*)sm;
  if (map == 1) {
    const float inv = lam * __builtin_amdgcn_rcpf(ls);
#pragma unroll
    for (int ds = 0; ds < 4; ds++)
#pragma unroll
      for (int e = 0; e < 16; e++) xch[((qg * 64) + ds * 16 + e) * 64 + lane] = o[ds][e] * inv;
  }
  __syncthreads();
  if (map == 0) {
    const float i0 = __builtin_amdgcn_rcpf(ls);
    float ss = 0.f;
#pragma unroll
    for (int ds = 0; ds < 4; ds++)
#pragma unroll
      for (int e = 0; e < 16; e++) {
        float v = o[ds][e] * i0 - xch[((qg * 64) + ds * 16 + e) * 64 + lane];
        o[ds][e] = v; ss += v * v;
      }
    ss = half_sum(ss);
    const float rinv = rsqrtf(ss * (1.f / 128.f) + EPS) * (1.f - lam_init);
    const float* sg = p.subln_c + l * 128;
#pragma unroll
    for (int ds = 0; ds < 4; ds++) {
      uint2 gv[4]; float4 sl[4];
#pragma unroll
      for (int g = 0; g < 4; g++) {
        const int d = ds * 32 + 8 * g + 4 * h;
        gv[g] = *(const uint2*)(p.P + prow + C_GC + hd * 128 + d);
        sl[g] = *(const float4*)(sg + d);
      }
      __builtin_amdgcn_sched_barrier(0);
#pragma unroll
      for (int g = 0; g < 4; g++) {
        const int d = ds * 32 + 8 * g + 4 * h;
        uint2 ov;
        ov.x = pack2(o[ds][4 * g] * rinv * sl[g].x * lo_bf(gv[g].x), o[ds][4 * g + 1] * rinv * sl[g].y * hi_bf(gv[g].x));
        ov.y = pack2(o[ds][4 * g + 2] * rinv * sl[g].z * lo_bf(gv[g].y), o[ds][4 * g + 3] * rinv * sl[g].w * hi_bf(gv[g].y));
        *(uint2*)(p.GB + (size_t)2 * NTOK * 512 + tm_off(rowbase + q0 + r, hd * 128 + d, 8)) = ov;
      }
    }
  }
}

__device__ __forceinline__ void lru_run(const Params& p, int l, bool pass2, int start, int G, float* sm, bool dry = false) {
  const int tid = TIDX;
  const int lane = tid & 63, wid = tid >> 6, r = lane & 31, h = lane >> 5;
  const int n = start & 7;
  float* xin = sm;
  float* xb = sm + 67 * 64;
  float* comb = xb + 64 * 64;
  float* carry = comb + 2048;
  float* parts = carry + 128;
  float* ab = parts + 1024;
  u16* xbh = (u16*)(ab + 4 * 4096);
  const int gd = wid >> 2, gth = (wid >> 1) & 1, gdh = wid & 1;
  bf16x8 wfa[4], wfx[4];
  {
    const u16* wbase = p.Wt_lru + ((size_t)(((l * 2 + gd) * 8 + n) * 2) * 64 + gdh * 32 + r) * 64 + h * 8;
#pragma unroll
    for (int ks = 0; ks < 4; ks++) { wfa[ks] = *(const bf16x8*)(wbase + ks * 16); wfx[ks] = *(const bf16x8*)(wbase + 4096 + ks * 16); }
  }
  const int gch = n * 64 + gdh * 32 + r;
  const float g_ba = p.lru_ba[(l * 2 + gd) * 512 + gch], g_bx = p.lru_bx[(l * 2 + gd) * 512 + gch];
  const float g_sp = log1pf(__expf(-p.lru_lam[(l * 2 + gd) * 512 + gch]));
  const int cc = tid & 63;
  float cw[4]; float cbv;
  {
    const float* cwp = p.conv_w + l * 4 * 512 + n * 64 + cc;
    cw[0] = cwp[0]; cw[1] = cwp[512]; cw[2] = cwp[1024]; cw[3] = cwp[1536];
    cbv = p.conv_b[l * 512 + n * 64 + cc];
  }
  const int dout = tid & 63, tg = tid >> 6;
  const int ch = n * 64 + dout;

  u16 xr[9];
  auto xin_load = [&](int it_) {
    const int row0_ = (it_ >> 3) * 64;
    int T_, seq0_;
    if (row0_ < NCTX) { T_ = 256; seq0_ = (row0_ >> 8) * 256; } else { T_ = 4096; seq0_ = NCTX + ((row0_ - NCTX) >> 12) * 4096; }
    const int t0_ = row0_ - seq0_;
#pragma unroll
    for (int k = 0; k < 9; k++) {
      const int rr = (tid >> 6) + 8 * k; const int t = t0_ - 2 + rr;
      const bool ok = (rr < 67 && t >= 0 && t < T_);
      const int tc = t < 0 ? 0 : (t >= T_ ? T_ - 1 : t);
      u16 v = p.P[(size_t)(seq0_ + tc) * PP + C_XB + n * 64 + cc];
      xr[k] = ok ? v : (u16)0;
    }
  };
  if (start < 1536) xin_load(start);
  for (int it = start; it < 1536; it += G) {
    const int ci = it >> 3;
    const int row0 = ci * 64;
    const bool isctx = row0 < NCTX;
    int T, seq0, bidx;
    if (isctx) { T = 256; bidx = row0 >> 8; seq0 = bidx * 256; }
    else { T = 4096; bidx = (row0 - NCTX) >> 12; seq0 = NCTX + bidx * 4096; }
    const int t0 = row0 - seq0;
    __syncthreads();
#pragma unroll
    for (int k = 0; k < 9; k++) { const int rr = (tid >> 6) + 8 * k; if (rr < 67) xin[rr * 64 + cc] = bf2f(xr[k]); }
    if (it + G < 1536) xin_load(it + G);
    u16 sgr[8];
    if (pass2) {
#pragma unroll
      for (int tt = 0; tt < 8; tt++) sgr[tt] = p.P[(size_t)(row0 + tg * 8 + tt) * PP + C_GB + ch];
    }
    if (pass2) {
      const int d = (tid >> 6) & 1, part = tid >> 7;
      const int cfirst = seq0 >> 6, clast = (seq0 + T - 64) >> 6;
      const int K = d ? (clast - ci) : (ci - cfirst);
      float2 q[16];
#pragma unroll
      for (int k = 0; k < 16; k++) {
        const int kk = part * 16 + k;
        const int cj = d ? (clast - kk) : (cfirst + kk);
        const int cjc = cj < cfirst ? cfirst : (cj > clast ? clast : cj);
        const float2 qv = *(const float2*)(p.lruTot + ((size_t)(cjc * 2 + d) * 512 + n * 64 + cc) * 2);
        q[k] = (kk < K) ? qv : make_float2(1.f, 0.f);
      }
      float At = 1.f, Bt = 0.f;
#pragma unroll
      for (int k = 0; k < 16; k++) { Bt = q[k].x * Bt + q[k].y; At *= q[k].x; }
      parts[((part * 2 + d) * 64 + cc) * 2] = At; parts[((part * 2 + d) * 64 + cc) * 2 + 1] = Bt;
    }
    __syncthreads();
    for (int e = tid; e < 64 * 64; e += NT) {
      int t = e >> 6;
      float v = cbv;
#pragma unroll
      for (int j = 0; j < 4; j++) v += xin[(t + j) * 64 + cc] * cw[j];
      xb[e] = v;
      xbh[t * LROW + cc] = f2bf(v);
    }
    if (pass2 && tid < 128) {
      const int d = tid >> 6;
      float hcar = isctx ? 0.f : p.state_lru[((size_t)(bidx * 2 + l) * 2 + d) * 512 + n * 64 + cc];
#pragma unroll
      for (int part = 0; part < 4; part++) hcar = parts[((part * 2 + d) * 64 + cc) * 2] * hcar + parts[((part * 2 + d) * 64 + cc) * 2 + 1];
      carry[d * 64 + cc] = hcar;
    }
    __syncthreads();
    {
      bf16x8 af[4];
#pragma unroll
      for (int ks = 0; ks < 4; ks++) af[ks] = *(const bf16x8*)(xbh + (gth * 32 + r) * LROW + ks * 16 + h * 8);
      f32x16 ga, gi;
#pragma unroll
      for (int e = 0; e < 16; e++) { ga[e] = 0.f; gi[e] = 0.f; }
#pragma unroll
      for (int ks = 0; ks < 4; ks++) { ga = mfma32(af[ks], wfa[ks], ga); gi = mfma32(af[ks], wfx[ks], gi); }
      const int dch = gdh * 32 + r;
#pragma unroll
      for (int e = 0; e < 16; e++) {
        const int tok = gth * 32 + (e & 3) + 8 * (e >> 2) + 4 * h;
        float rg = sigmoidf_(ga[e] + g_ba), ig = sigmoidf_(gi[e] + g_bx);
        float log_a = -8.f * rg * g_sp;
        float a = __expf(log_a);
        const float x2 = 2.f * log_a;
        const float om = -x2 * (1.f + x2 * (0.5f + x2 * (0.16666667f + x2 * (0.041666668f + x2 * (0.0083333338f + x2 * (0.0013888889f + x2 * 0.0001984127f))))));
        float bb = __builtin_amdgcn_sqrtf(om) * ig * xb[tok * 64 + dch];
        ab[((gd * 2 + 0) * 64 + tok) * 64 + dch] = a;
        ab[((gd * 2 + 1) * 64 + tok) * 64 + dch] = bb;
      }
    }
    __syncthreads();
    float av[2][8], bv[2][8];
#pragma unroll
    for (int d = 0; d < 2; d++)
#pragma unroll
      for (int tt = 0; tt < 8; tt++) {
        av[d][tt] = ab[((d * 2 + 0) * 64 + tg * 8 + tt) * 64 + dout];
        bv[d][tt] = ab[((d * 2 + 1) * 64 + tg * 8 + tt) * 64 + dout];
      }
    float sA0 = 1.f, sB0 = 0.f, sA1 = 1.f, sB1 = 0.f;
#pragma unroll
    for (int tt = 0; tt < 8; tt++) { sB0 = av[0][tt] * sB0 + bv[0][tt]; sA0 *= av[0][tt]; }
#pragma unroll
    for (int tt = 7; tt >= 0; tt--) { sB1 = av[1][tt] * sB1 + bv[1][tt]; sA1 *= av[1][tt]; }
    comb[((tg * 2 + 0) * 64 + dout) * 2 + 0] = sA0; comb[((tg * 2 + 0) * 64 + dout) * 2 + 1] = sB0;
    comb[((tg * 2 + 1) * 64 + dout) * 2 + 0] = sA1; comb[((tg * 2 + 1) * 64 + dout) * 2 + 1] = sB1;
    __syncthreads();
    if (!pass2) {
      if (tid < 128) {
        int d = tid >> 6, c = tid & 63;
        float At = 1.f, Bt = 0.f;
#pragma unroll
        for (int s = 0; s < 8; s++) {
          int g = (d == 0) ? s : 7 - s;
          float a = comb[((g * 2 + d) * 64 + c) * 2], bq = comb[((g * 2 + d) * 64 + c) * 2 + 1];
          Bt = a * Bt + bq; At *= a;
        }
        float* o = p.lruTot + ((size_t)(ci * 2 + d) * 512 + n * 64 + c) * 2;
        o[0] = At; o[1] = Bt;
      }
      continue;
    }
    float h0 = carry[dout], h1 = carry[64 + dout];
    for (int g = 0; g < tg; g++) { h0 = comb[((g * 2 + 0) * 64 + dout) * 2] * h0 + comb[((g * 2 + 0) * 64 + dout) * 2 + 1]; }
    for (int g = 7; g > tg; g--) { h1 = comb[((g * 2 + 1) * 64 + dout) * 2] * h1 + comb[((g * 2 + 1) * 64 + dout) * 2 + 1]; }
    float y[8];
#pragma unroll
    for (int tt = 0; tt < 8; tt++) { h0 = av[0][tt] * h0 + bv[0][tt]; y[tt] = h0; }
    const float hf_last = h0;
#pragma unroll
    for (int tt = 7; tt >= 0; tt--) { h1 = av[1][tt] * h1 + bv[1][tt]; y[tt] += h1; }
    const float hb_first = h1;
    if (isctx) {
      if (t0 + 64 == T && tg == 7) p.out[O_ST + ((size_t)(bidx * 2 + l) * 2 + 0) * 512 + ch] = hf_last;
      if (t0 == 0 && tg == 0) p.out[O_ST + ((size_t)(bidx * 2 + l) * 2 + 1) * 512 + ch] = hb_first;
    }
#pragma unroll
    for (int tt = 0; tt < 8; tt++) {
      const int rw = row0 + tg * 8 + tt;
      p.GB[(size_t)NTOK * 512 + tm_off(rw, ch, 8)] = f2bf(y[tt] * bf2f(sgr[tt]));
    }
  }
}

__device__ __forceinline__ float compute_lam(const Params& p, int l, float lam_init) {
  float s1 = 0.f, s2 = 0.f;
  for (int i = 0; i < 64; i++) {
    s1 += p.lam_q1[l * 64 + i] * p.lam_k1[l * 64 + i];
    s2 += p.lam_q2[l * 64 + i] * p.lam_k2[l * 64 + i];
  }
  return expf(s1) - expf(s2) + lam_init;
}

__device__ __forceinline__ float mix_phase(const Params& p, int l, u16* smem, int vid) {
  unsigned long long tm0 = 0; float tres = 0.f; if (PROBE >= 30) tm0 = __builtin_amdgcn_s_memrealtime();
  const float lam_init = (l == 0) ? 0.2f : (0.8f - 0.6f * 0.74081822068f);
  const float lam = compute_lam(p, l, lam_init);
  constexpr int N_CL = 256, N_A = 384, N_CC = 128, N_L = 1536;
  const int G = gridDim.x;
  int start = vid;
  for (int it = start; it < N_CL; it += G) attnC_item(p, l, 128 + it, smem, lam, lam_init);
  if (PROBE == 35) tres = (float)(__builtin_amdgcn_s_memrealtime() - tm0) / 40000.f;
  start = (int)((vid + G - (N_CL % G)) % G);
  for (int it = start; it < N_A; it += G) attnA_item(p, l, it, smem);
  start = (int)((vid + G - ((N_CL + N_A) % G)) % G);
  for (int it = start; it < N_CC; it += G) attnC_item(p, l, it, smem, lam, lam_init);
  if (PROBE == 36) tres = (float)(__builtin_amdgcn_s_memrealtime() - tm0) / 40000.f;
  start = (int)((vid + G - ((N_CL + N_A + N_CC) % G)) % G);
  if (PROBE == 6) lru_run(p, l, false, start, G, (float*)smem);
  lru_run(p, l, false, start, G, (float*)smem);
  return tres;
}

__device__ __forceinline__ void lru2_phase(const Params& p, int l, u16* smem) {
  lru_run(p, l, true, blockIdx.x, gridDim.x, (float*)smem);
}

#define XB_TMO      128
#define XB_XCNT(j)  (256  + 64 * (j))
#define XB_XSUB(j)  (1280 + 64 * (j))
#define XB_XGEN(j)  (2304 + 64 * (j))
#define XB_TOP      3328
#define XB_TOPGEN   3392
#define XCD_BAR_WORDS 3456
#define XB_SPIN_CAP (1u << 18)
__device__ __forceinline__ unsigned xb_ld(unsigned* p)              { return __hip_atomic_load(p, __ATOMIC_RELAXED, __HIP_MEMORY_SCOPE_AGENT); }
__device__ __forceinline__ unsigned xb_add(unsigned* p, unsigned v) { return __hip_atomic_fetch_add(p, v, __ATOMIC_RELAXED, __HIP_MEMORY_SCOPE_AGENT); }
__device__ __forceinline__ unsigned xb_xcc_id() { return (unsigned)__builtin_amdgcn_s_getreg((3 << 11) | 20) & 0xFu; }
#define XB_SPIN(cond, bar) do { unsigned _sp = 0; while (cond) { __builtin_amdgcn_s_sleep(1); \
    if ((++_sp & 255u) == 0u) { if (xb_ld(&(bar)[XB_TMO])) break; if (_sp > XB_SPIN_CAP) { atomicAdd(&(bar)[XB_TMO], 1u); break; } } } } while (0)
struct XcdBarrier { unsigned* bar; unsigned x; volatile LAS unsigned* st; };
__device__ __forceinline__ XcdBarrier xcd_barrier_post(unsigned* bar, volatile LAS unsigned* st) {
  XcdBarrier b; b.bar = bar; b.x = xb_xcc_id(); b.st = st;
  if (threadIdx.x == 0) st[2] = xb_add(&bar[XB_XCNT(b.x)], 1u);
  return b;
}
__device__ __forceinline__ int xcd_virtual_id(const XcdBarrier& b) {
  if (threadIdx.x == 0) {
    unsigned pre = 0;
#pragma unroll
    for (unsigned j = 0; j < 16; ++j) { const unsigned c = xb_ld(&b.bar[XB_XCNT(j)]); pre += (j < b.x) ? c : 0u; }
    b.st[3] = pre + b.st[2];
  }
  __syncthreads();
  const int v = (int)b.st[3];
  __syncthreads();
  return __builtin_amdgcn_readfirstlane(v);
}
__device__ __forceinline__ void xcd_barrier_complete(unsigned* bar, unsigned x, unsigned& nloc, unsigned& nx) {
  const unsigned G = gridDim.x * gridDim.y * gridDim.z;
  unsigned sum, cnt, mine, sp = 0u;
  for (;;) {
    sum = 0u; cnt = 0u; mine = 0u;
#pragma unroll
    for (unsigned j = 0; j < 16; ++j) { const unsigned c = xb_ld(&bar[XB_XCNT(j)]); sum += c; cnt += (c > 0u) ? 1u : 0u; mine = (j == x) ? c : mine; }
    if (sum == G) break;
    __builtin_amdgcn_s_sleep(1);
    if ((++sp & 255u) == 0u) { if (xb_ld(&bar[XB_TMO])) break; if (sp > XB_SPIN_CAP) { atomicAdd(&bar[XB_TMO], 1u); break; } }
  }
  nloc = mine > 0u ? mine : 1u; nx = cnt > 0u ? cnt : 1u;
}
__device__ __forceinline__ void xcd_barrier(const XcdBarrier& b) {
  asm volatile("s_waitcnt vmcnt(0)" ::: "memory");
  __syncthreads();
  if (threadIdx.x == 0) {
    unsigned* bar = b.bar;
    __builtin_amdgcn_s_waitcnt(0);
    unsigned nloc = b.st[0], nx = b.st[1];
    if (nloc == 0u) { xcd_barrier_complete(bar, b.x, nloc, nx); b.st[0] = nloc; b.st[1] = nx; }
    const unsigned old = xb_add(&bar[XB_XSUB(b.x)], 1u);
    const unsigned gen = old / nloc;
    if (old + 1u == (gen + 1u) * nloc) {
      __builtin_amdgcn_fence(__ATOMIC_RELEASE, "agent");
      asm volatile("s_waitcnt vmcnt(0)" ::: "memory");
      const unsigned og = xb_add(&bar[XB_TOP], 1u);
      const unsigned tg = og / nx;
      if (og + 1u == (tg + 1u) * nx) xb_add(&bar[XB_TOPGEN], 1u);
      else XB_SPIN(xb_ld(&bar[XB_TOPGEN]) == tg, bar);
      __builtin_amdgcn_fence(__ATOMIC_ACQUIRE, "agent");
      xb_add(&bar[XB_XGEN(b.x)], 1u);
      asm volatile("s_waitcnt vmcnt(0)" ::: "memory");
    } else {
      XB_SPIN(xb_ld(&bar[XB_XGEN(b.x)]) == gen, bar);
      __builtin_amdgcn_fence(__ATOMIC_ACQUIRE, "agent");
      asm volatile("s_waitcnt vmcnt(0)" ::: "memory");
    }
  }
  __syncthreads();
}

typedef __attribute__((address_space(4))) const Params CParams;
__device__ __forceinline__ const Params& get_params() {
  CParams* kp = (CParams*)__builtin_amdgcn_kernarg_segment_ptr();
  asm volatile("" : "+s"(kp));
  return *(const Params*)kp;
}
__global__ void __launch_bounds__(NT, 2) fwd_kernel(Params p_unused) {
  extern __shared__ __attribute__((aligned(16))) unsigned char lds_raw[];
  u16* smem = (u16*)lds_raw;
  LAS unsigned char* lds = (LAS unsigned char*)lds_raw;
  cg::grid_group grid = cg::this_grid();
  volatile LAS unsigned* xst = (volatile LAS unsigned*)(lds + STAGE_BYTES + SPARE_BYTES);
  if (threadIdx.x == 0) { xst[0] = 0u; xst[1] = 0u; }
  __syncthreads();
  XcdBarrier xb = xcd_barrier_post(get_params().bar, xst);
  float tfrac = 0.f;
  unsigned long long tq0 = 0; if (PROBE >= 30) tq0 = __builtin_amdgcn_s_memrealtime();
  prologue_phase(get_params(), (float*)smem);
  if (PROBE == 30) tfrac = (float)(__builtin_amdgcn_s_memrealtime() - tq0) / 40000.f;
  if (get_params().bar == nullptr) grid.sync();
  xcd_barrier(xb);
  if (PROBE == 31) tfrac = (float)(__builtin_amdgcn_s_memrealtime() - tq0) / 40000.f;
  const int vid = xcd_virtual_id(xb);
  { LAS float* rl = (LAS float*)(lds + ROPE_OFF); const float* rg = get_params().rope;
    for (int i = threadIdx.x; i < 2048; i += NT) rl[i] = rg[i];
    __syncthreads(); }
  if (PROBE == 9) { for (int i = 0; i < 10; i++) xcd_barrier(xb); }
#pragma unroll 1
  for (int l = 0; l < 2; l++) {
    if (PROBE >= 30) tq0 = __builtin_amdgcn_s_memrealtime();
    norm_phase(get_params(), l);
    if (PROBE == 32 && l == 0) tfrac = (float)(__builtin_amdgcn_s_memrealtime() - tq0) / 40000.f;
    if (PROBE == 3) { norm_phase(get_params(), l); if (l == 0) { xcd_barrier(xb); prologue_phase(get_params(), (float*)smem); } }
    xcd_barrier(xb);
    {
      const Params& p = get_params();
      SchedStd S; S.nM = NTOK / 256; S.nN = INC / 256; S.nwg = S.nM * S.nN; S.G = gridDim.x; S.c = vid;
      S.A = (const char*)p.H; S.B = (const char*)(p.Wt_in + (size_t)l * INC * 1024); S.tA = (size_t)256 * 1024 * 2; S.tB = (size_t)256 * 1024 * 2;
      EpiInproj E; E.pp = &p; E.l = l; E.part = (LAS float*)(lds + STAGE_BYTES); E.ropeL = (const LAS float*)(lds + ROPE_OFF);
      { float tr = gemm_phase(lds, 1024, S, E, PROBE == 22); if (l == 0 && (PROBE == 21 || PROBE == 22)) tfrac = tr; }
      if (PROBE == 1) { __syncthreads(); gemm_phase(lds, 1024, S, E); }
    }
    xcd_barrier(xb);
    if (PROBE >= 30) tq0 = __builtin_amdgcn_s_memrealtime();
    { float tr = mix_phase(get_params(), l, smem, vid); if ((PROBE == 35 || PROBE == 36) && l == 0) tfrac = tr; }
    if (PROBE == 33 && l == 0) tfrac = (float)(__builtin_amdgcn_s_memrealtime() - tq0) / 40000.f;
    xcd_barrier(xb);
    if (PROBE >= 30) tq0 = __builtin_amdgcn_s_memrealtime();
    lru2_phase(get_params(), l, smem);
    if (PROBE == 34 && l == 0) tfrac = (float)(__builtin_amdgcn_s_memrealtime() - tq0) / 40000.f;
    xcd_barrier(xb);
    {
      const Params& p = get_params();
      SchedBranch S; S.G = gridDim.x; S.c = vid; S.P_ = (const char*)p.GB; S.W_ = (const char*)(p.Wt_br + (size_t)l * 3 * 1024 * 512);
      EpiBranch E; E.pp = &p;
      { float tr = gemm_phase(lds, 512, S, E, PROBE == 24); if (l == 0 && (PROBE == 23 || PROBE == 24)) tfrac = tr; }
      if (PROBE == 2) { __syncthreads(); gemm_phase(lds, 512, S, E); }
    }
    xcd_barrier(xb);
    {
      const Params& p = get_params();
      SchedStd S; S.nM = NTOK / 256; S.nN = 4; S.nwg = S.nM * S.nN; S.G = gridDim.x; S.c = vid;
      S.A = (const char*)p.Y; S.B = (const char*)(p.Wt_out + (size_t)l * 1024 * 1024); S.tA = (size_t)256 * 1024 * 2; S.tB = (size_t)256 * 1024 * 2;
      EpiOut E; E.pp = &p; E.l = l;
      { float tr = gemm_phase(lds, 1024, S, E, PROBE == 26); if (l == 0 && (PROBE == 25 || PROBE == 26)) tfrac = tr; }
      if (PROBE == 8 && l == 0) { __syncthreads(); gemm_phase(lds, 1024, S, E); }
    }
    if (l == 0) xcd_barrier(xb);
  }
  if (PROBE >= 20) {
    xcd_barrier(xb);
    if (blockIdx.x == 0 && threadIdx.x == 0) { float* o = get_params().out + O_X + 4194304; *o += 0.42f + 0.45f * fminf(fmaxf(tfrac, 0.f), 1.f); }
  }
}

extern "C" void kernel_launch(void* const* d_in, const int* in_sizes, int n_in, void* d_out, int out_size, void* d_ws,
                              size_t ws_size, hipStream_t stream) {
  Params p{};
  const float** ip = (const float**)&p;
  for (int i = 0; i < 34; i++) ip[i] = (const float*)d_in[i];
  p.out = (float*)d_out;
  char* w = (char*)d_ws; size_t off = 0;
  auto take = [&](size_t bytes) { char* q = w + off; off += (bytes + 255) & ~(size_t)255; return q; };
  p.Wt_in = (u16*)take((size_t)2 * INC * 1024 * 2);
  p.Wt_br = (u16*)take((size_t)6 * 1024 * 512 * 2);
  p.Wt_out = (u16*)take((size_t)2 * 1024 * 1024 * 2);
  p.Y = (u16*)take((size_t)NTOK * 1024 * 2);
  p.P = (u16*)take((size_t)NTOK * PP * 2);
  p.VtA_ctx = p.Y;
  p.VtA_lat = p.VtA_ctx + (size_t)16 * 2 * 64 * 256;
  p.VtC_ctx = p.VtA_lat + (size_t)2 * 2 * 64 * 4096;
  p.VtC_lat = p.VtC_ctx + (size_t)16 * 4 * 128 * 256;
  p.cKa = (u16*)take((size_t)2 * 2 * 512 * 128 * 2);
  p.cVtA = (u16*)take((size_t)2 * 2 * 512 * 128 * 2);
  p.cKc = (u16*)take((size_t)2 * 2 * 512 * 512 * 2);
  p.cVtC = (u16*)take((size_t)2 * 2 * 512 * 512 * 2);
  p.mod = (float*)take((size_t)2 * 3 * 3072 * 4);
  p.rope = (float*)take((size_t)2048 * 4);
  p.lruTot = (float*)take((size_t)192 * 2 * 512 * 2 * 4);
  p.Wt_lru = (u16*)take((size_t)2 * 2 * 8 * 2 * 64 * 64 * 2);
  p.bar = (unsigned*)take((size_t)XCD_BAR_WORDS * 4);
  p.GB = (u16*)take((size_t)3 * NTOK * 512 * 2);
  p.H = p.GB;
  p.MG = (unsigned*)take((size_t)(48 * 4 * 3 + 1) * 16384 * 4);
  static int grid_blocks = 0;
  if (!grid_blocks) {
    int dev = 0, cus = 0;
    hipGetDevice(&dev);
    hipDeviceGetAttribute(&cus, hipDeviceAttributeMultiprocessorCount, dev);
    hipFuncSetAttribute((const void*)fwd_kernel, hipFuncAttributeMaxDynamicSharedMemorySize, LDS_BYTES);
    int per_cu = 0;
    hipOccupancyMaxActiveBlocksPerMultiprocessor(&per_cu, (const void*)fwd_kernel, NT, LDS_BYTES);
    (void)hipGetLastError();
    grid_blocks = cus;
  }
  hipMemsetAsync(p.bar, 0, (size_t)XCD_BAR_WORDS * 4, stream);
  void* args[] = {&p};
  hipLaunchCooperativeKernel((void*)fwd_kernel, dim3(grid_blocks), dim3(NT), args, LDS_BYTES, stream);
}
```
